# Optimizing an MI355X kernel written in HIP

```python
import math
import jax, jax.numpy as jnp
from jax import lax
import numpy as np

D_MODEL = 1024
BATCH = 2
SEQ = 8192
DEPTH = 4

GRID_W = 64
CTX_LEN = 256
N_MIXERS = 3
GDN_HEADS = 8
GDN_DK = 128
GDN_DV = 128
GDN_WIDTH = GDN_HEADS * GDN_DK
GDN_CHUNK = 64
SHORT_CONV = 3
SCONV_WIDTH = D_MODEL
DIFF_HEADS = 8
DIFF_DH = D_MODEL // (2 * DIFF_HEADS)
DIFF_DV = 2 * DIFF_DH
DIFF_WIDTH = DIFF_HEADS * DIFF_DV
Q_BLOCK = 128
ROPE_BASE = 10000.0
D_FF = 4 * D_MODEL
N_ADA = 6
EPS = 1e-6
N_A = (DEPTH + 2) // 3
N_B = (DEPTH + 1) // 3
N_C = DEPTH // 3

kernel_name = 'hybrid_gdn_shortconv_diffattn_dit'

F32 = jnp.float32


def rmsnorm(x, g):
    xf = x.astype(F32)
    y = xf * lax.rsqrt(jnp.mean(xf * xf, axis=-1, keepdims=True) + EPS)
    return (y * g.astype(F32)).astype(x.dtype)


def l2norm(x):
    xf = x.astype(F32)
    return (xf * lax.rsqrt(jnp.sum(xf * xf, axis=-1, keepdims=True) + EPS)).astype(x.dtype)


def modulate(h, shift, scale):
    return h * (1.0 + scale) + shift


def conv_centred(x, w):
    k = w.shape[0]
    pad = k // 2
    t = x.shape[1]
    xp = jnp.pad(x, ((0, 0), (pad, pad), (0, 0)))
    y = xp[:, 0:t] * w[0]
    for j in range(1, k):
        y = y + xp[:, j:j + t] * w[j]
    return y


def axial_rope(n_tokens, dim, dtype):
    n_rows = n_tokens // GRID_W
    row = jnp.repeat(jnp.arange(n_rows), GRID_W).astype(F32)
    col = jnp.tile(jnp.arange(GRID_W), n_rows).astype(F32)
    nf = dim // 4
    inv = ROPE_BASE ** (-jnp.arange(nf, dtype=F32) / nf)
    ang = jnp.concatenate([row[:, None] * inv, col[:, None] * inv], axis=-1)
    return jnp.cos(ang).astype(dtype), jnp.sin(ang).astype(dtype)


def apply_rope(x, cos, sin):
    xp = x.reshape(x.shape[:-1] + (x.shape[-1] // 2, 2))
    x0, x1 = xp[..., 0], xp[..., 1]
    shape = (1, cos.shape[0]) + (1,) * (x.ndim - 3) + (cos.shape[1],)
    c, s = cos.reshape(shape), sin.reshape(shape)
    return jnp.stack([x0 * c - x1 * s, x0 * s + x1 * c], axis=-1).reshape(x.shape)


def mlp_sqrelu(h, w1, w2):
    return jnp.square(jax.nn.relu(h @ w1)) @ w2


def gated_delta_chunked(q, k, v, g, beta, s0):
    out_dtype = v.dtype
    b, h, t, dk = q.shape
    dv = v.shape[-1]
    c = GDN_CHUNK
    n = t // c
    q = q.astype(F32).reshape(b, h, n, c, dk)
    k = k.astype(F32).reshape(b, h, n, c, dk)
    v = v.astype(F32).reshape(b, h, n, c, dv)
    g = g.astype(F32).reshape(b, h, n, c)
    beta = beta.astype(F32).reshape(b, h, n, c)
    gc = jnp.cumsum(g, axis=-1)
    incl = jnp.tril(jnp.ones((c, c), dtype=bool))
    strict = jnp.tril(jnp.ones((c, c), dtype=bool), -1)
    decay = jnp.where(incl, jnp.exp(jnp.where(incl, gc[..., :, None] - gc[..., None, :], 0.0)), 0.0)
    kk = jnp.einsum('bhncd,bhnsd->bhncs', k, k)
    a_mat = jnp.where(strict, beta[..., :, None] * kk * decay, 0.0) + jnp.eye(c, dtype=F32)
    rhs = jnp.concatenate([v * beta[..., None], k * (beta * jnp.exp(gc))[..., None]], axis=-1)
    sol = lax.linalg.triangular_solve(a_mat, rhs, left_side=True, lower=True, unit_diagonal=True)
    u, w = sol[..., :dv], sol[..., dv:]
    attn = jnp.where(incl, jnp.einsum('bhncd,bhnsd->bhncs', q, k) * decay, 0.0)
    qd = q * jnp.exp(gc)[..., None]
    kt = k * jnp.exp(gc[..., -1:] - gc)[..., None]
    cd = jnp.exp(gc[..., -1])
    xs = tuple(jnp.moveaxis(z, 2, 0) for z in (qd, kt, u, w, attn, cd))

    def step(s, inp):
        qd_c, kt_c, u_c, w_c, attn_c, cd_c = inp
        v_new = u_c - jnp.einsum('bhcd,bhde->bhce', w_c, s)
        o_c = jnp.einsum('bhcd,bhde->bhce', qd_c, s) + jnp.einsum('bhcs,bhse->bhce', attn_c, v_new)
        s = s * cd_c[..., None, None] + jnp.einsum('bhcd,bhce->bhde', kt_c, v_new)
        return s, o_c

    s_fin, o = lax.scan(step, s0.astype(F32), xs)
    o = jnp.moveaxis(o, 0, 2).reshape(b, h, t, dv)
    return o.astype(out_dtype), s_fin


def gdn_mixer(h_ctx, h_lat, w_in, conv_w, a_log, dt_bias, norm_g, w_out):
    def prep(hh):
        b, t, _ = hh.shape
        z = hh @ w_in
        qkv = jax.nn.silu(conv_centred(z[..., :3 * GDN_WIDTH], conv_w))
        gate = z[..., 3 * GDN_WIDTH:4 * GDN_WIDTH]
        ab = z[..., 4 * GDN_WIDTH:].reshape(b, t, 2, 2, GDN_HEADS)
        heads = lambda y: y.reshape(b, t, GDN_HEADS, -1).transpose(0, 2, 1, 3)
        q = l2norm(heads(qkv[..., :GDN_WIDTH])) * (GDN_DK ** -0.5)
        k = l2norm(heads(qkv[..., GDN_WIDTH:2 * GDN_WIDTH]))
        v = heads(qkv[..., 2 * GDN_WIDTH:])
        g = -jnp.exp(a_log.astype(F32)) * jax.nn.softplus(ab[:, :, 0].astype(F32) + dt_bias.astype(F32))
        beta = jax.nn.sigmoid(ab[:, :, 1].astype(F32))
        return q, k, v, g.transpose(2, 0, 3, 1), beta.transpose(2, 0, 3, 1), gate

    qc, kc, vc, gcx, bcx, zc = prep(h_ctx)
    ql, kl, vl, glt, blt, zl = prep(h_lat)
    s0 = jnp.zeros((h_lat.shape[0], GDN_HEADS, GDN_DK, GDN_DV), F32)
    flip = lambda y: jnp.flip(y, axis=2)
    oc_f, sc_f = gated_delta_chunked(qc, kc, vc, gcx[0], bcx[0], s0)
    ol_f, _ = gated_delta_chunked(ql, kl, vl, glt[0], blt[0], sc_f)
    oc_b, sc_b = gated_delta_chunked(flip(qc), flip(kc), flip(vc), flip(gcx[1]), flip(bcx[1]), s0)
    ol_b, _ = gated_delta_chunked(flip(ql), flip(kl), flip(vl), flip(glt[1]), flip(blt[1]), sc_b)
    o_ctx = oc_f + flip(oc_b)
    o_lat = ol_f + flip(ol_b)

    def out(o, z):
        b, h, t, dv = o.shape
        o = o.transpose(0, 2, 1, 3)
        o = rmsnorm(o, norm_g) * jax.nn.silu(z.reshape(b, t, h, dv))
        return o.reshape(b, t, h * dv) @ w_out

    return out(o_ctx, zc), out(o_lat, zl)


def short_conv_mixer(h_ctx, h_lat, w_in, conv_w, w_out):
    def mix(hh):
        z = hh @ w_in
        bg, cg, hv = jnp.split(z, 3, axis=-1)
        return (bg * conv_centred(cg * hv, conv_w)) @ w_out
    return mix(h_ctx), mix(h_lat)


def diff_attn_mixer(h_ctx, h_lat, w_in, lam, norm_g, w_out, lambda_init):
    def prep(hh):
        b, t, _ = hh.shape
        z = hh @ w_in
        q = z[..., :DIFF_WIDTH].reshape(b, t, DIFF_HEADS, 2, DIFF_DH)
        k = z[..., DIFF_WIDTH:2 * DIFF_WIDTH].reshape(b, t, DIFF_HEADS, 2, DIFF_DH)
        v = z[..., 2 * DIFF_WIDTH:].reshape(b, t, DIFF_HEADS, DIFF_DV)
        return q, k, v

    qc, kc, vc = prep(h_ctx)
    ql, kl, vl = prep(h_lat)
    b, t = h_lat.shape[0], h_lat.shape[1]
    cos, sin = axial_rope(t, DIFF_DH, ql.dtype)
    ql = apply_rope(ql, cos, sin)
    kl = apply_rope(kl, cos, sin)
    lf = lam.astype(F32)
    lmb = jnp.exp(jnp.sum(lf[0] * lf[1])) - jnp.exp(jnp.sum(lf[2] * lf[3])) + lambda_init
    scale = DIFF_DH ** -0.5

    def attend(q, k, v):
        s = jnp.einsum('bqhmd,bkhmd->bhmqk', q, k).astype(F32) * scale
        p = jax.nn.softmax(s, axis=-1)
        a = (p[:, :, 0] - lmb * p[:, :, 1]).astype(v.dtype)
        return jnp.einsum('bhqk,bkhe->bqhe', a, v)

    o_ctx = attend(qc, kc, vc)
    k_all = jnp.concatenate([kc, kl], axis=1)
    v_all = jnp.concatenate([vc, vl], axis=1)
    nb = t // Q_BLOCK
    qb = jnp.moveaxis(ql.reshape(b, nb, Q_BLOCK, DIFF_HEADS, 2, DIFF_DH), 1, 0)
    o_lat = lax.map(lambda qq: attend(qq, k_all, v_all), qb)
    o_lat = jnp.moveaxis(o_lat, 0, 1).reshape(b, t, DIFF_HEADS, DIFF_DV)

    def out(o):
        o = rmsnorm(o, norm_g) * (1.0 - lambda_init)
        return o.reshape(o.shape[0], o.shape[1], DIFF_WIDTH) @ w_out

    return out(o_ctx), out(o_lat)


def setup_inputs(seed: int = 0) -> dict:
    key = jax.random.key(seed)
    ks = jax.random.split(key, 24)
    D = D_MODEL

    def nrm(k, shape, s):
        return jax.random.normal(k, shape, F32) * s

    gdn_cols = 4 * GDN_WIDTH + 4 * GDN_HEADS
    dt = jnp.exp(jax.random.uniform(ks[13], (N_A, 2, GDN_HEADS), F32, math.log(1e-3), math.log(1e-1)))
    return {
        'x': nrm(ks[0], (BATCH, SEQ, D), 1.0),
        'c': nrm(ks[1], (BATCH, D), 1.0),
        'ctx': nrm(ks[2], (BATCH, CTX_LEN, D), 1.0),
        'c_ctx': nrm(ks[3], (D,), 1.0),
        'norm1_g': 1.0 + nrm(ks[4], (DEPTH, D), 0.02),
        'norm2_g': 1.0 + nrm(ks[5], (DEPTH, D), 0.02),
        'ada_w': nrm(ks[6], (DEPTH, D, N_ADA * D), 0.5 * D ** -0.5),
        'ada_b': nrm(ks[7], (DEPTH, N_ADA * D), 0.02),
        'mlp_w1': nrm(ks[8], (DEPTH, D, D_FF), D ** -0.5),
        'mlp_w2': nrm(ks[9], (DEPTH, D_FF, D), D_FF ** -0.5),
        'gdn_w_in': nrm(ks[10], (N_A, D, gdn_cols), D ** -0.5),
        'gdn_conv': nrm(ks[11], (N_A, SHORT_CONV, 3 * GDN_WIDTH), SHORT_CONV ** -0.5),
        'gdn_a_log': jnp.log(jax.random.uniform(ks[12], (N_A, 2, GDN_HEADS), F32, 1.0, 16.0)),
        'gdn_dt_bias': dt + jnp.log(-jnp.expm1(-dt)),
        'gdn_norm_g': 1.0 + nrm(ks[14], (N_A, GDN_DV), 0.02),
        'gdn_w_out': nrm(ks[15], (N_A, GDN_WIDTH, D), GDN_WIDTH ** -0.5),
        'sconv_w_in': nrm(ks[16], (N_B, D, 3 * SCONV_WIDTH), D ** -0.5),
        'sconv_conv': nrm(ks[17], (N_B, SHORT_CONV, SCONV_WIDTH), SHORT_CONV ** -0.5),
        'sconv_w_out': nrm(ks[18], (N_B, SCONV_WIDTH, D), SCONV_WIDTH ** -0.5),
        'diff_w_in': nrm(ks[19], (N_C, D, 3 * DIFF_WIDTH), D ** -0.5),
        'diff_lambda': nrm(ks[20], (N_C, 4, DIFF_DH), 0.1),
        'diff_norm_g': 1.0 + nrm(ks[21], (N_C, DIFF_DV), 0.02),
        'diff_w_out': nrm(ks[22], (N_C, DIFF_WIDTH, D), DIFF_WIDTH ** -0.5),
        'final_g': 1.0 + nrm(ks[23], (D,), 0.02),
    }


def reference(x, c, ctx, c_ctx, norm1_g, norm2_g, ada_w, ada_b, mlp_w1, mlp_w2,
              gdn_w_in, gdn_conv, gdn_a_log, gdn_dt_bias, gdn_norm_g, gdn_w_out,
              sconv_w_in, sconv_conv, sconv_w_out,
              diff_w_in, diff_lambda, diff_norm_g, diff_w_out, final_g):
    s_lat = jax.nn.silu(c)
    s_ctx = jax.nn.silu(c_ctx)
    x_ctx = ctx
    for i in range(DEPTH):
        kind, j = i % N_MIXERS, i // N_MIXERS
        last = i == DEPTH - 1
        mod_lat = (s_lat @ ada_w[i] + ada_b[i])[:, None, :]
        mod_ctx = (s_ctx @ ada_w[i] + ada_b[i])[None, None, :]
        sh1, sc1, g1, sh2, sc2, g2 = jnp.split(mod_lat, N_ADA, axis=-1)
        csh1, csc1, cg1, csh2, csc2, cg2 = jnp.split(mod_ctx, N_ADA, axis=-1)
        h_lat = modulate(rmsnorm(x, norm1_g[i]), sh1, sc1)
        h_ctx = modulate(rmsnorm(x_ctx, norm1_g[i]), csh1, csc1)
        if kind == 0:
            y_ctx, y_lat = gdn_mixer(h_ctx, h_lat, gdn_w_in[j], gdn_conv[j], gdn_a_log[j],
                                     gdn_dt_bias[j], gdn_norm_g[j], gdn_w_out[j])
        elif kind == 1:
            y_ctx, y_lat = short_conv_mixer(h_ctx, h_lat, sconv_w_in[j], sconv_conv[j], sconv_w_out[j])
        else:
            lambda_init = 0.8 - 0.6 * math.exp(-0.3 * i)
            y_ctx, y_lat = diff_attn_mixer(h_ctx, h_lat, diff_w_in[j], diff_lambda[j],
                                           diff_norm_g[j], diff_w_out[j], lambda_init)
        x = x + g1 * y_lat
        x = x + g2 * mlp_sqrelu(modulate(rmsnorm(x, norm2_g[i]), sh2, sc2), mlp_w1[i], mlp_w2[i])
        if not last:
            x_ctx = x_ctx + cg1 * y_ctx
            x_ctx = x_ctx + cg2 * mlp_sqrelu(modulate(rmsnorm(x_ctx, norm2_g[i]), csh2, csc2),
                                             mlp_w1[i], mlp_w2[i])
    return rmsnorm(x, final_g)
```

```cpp
#include <hip/hip_runtime.h>
#include <hip/hip_cooperative_groups.h>
#include <cstdio>
#include <cstdint>
namespace cg = cooperative_groups;
namespace pg8 {
#define PG8_LAS __attribute__((address_space(3)))
typedef unsigned short bf16_t;
typedef short bf16x8 __attribute__((ext_vector_type(8)));
typedef float f32x4 __attribute__((ext_vector_type(4)));
typedef unsigned u32x4 __attribute__((ext_vector_type(4)));
constexpr int BM = 256, BK = 64, HALF = 128, HTB = HALF * BK * 2  , STAGE_BYTES = 8 * HTB, NXCD = 8, WGM = 8;

__host__ __device__ __forceinline__ int lds_byte(int r, int c) { const int st = (r >> 4) * 2 + (c >> 5), rr = r & 15, cc = c & 31, ob = rr * 64 + cc * 2; return st * 1024 + (ob ^ (((ob >> 9) & 1) << 5)); }
__host__ __device__ __forceinline__ void stage_rc(int b, int& R, int& C) { const int st = b / 1024, sb = b % 1024, swz = sb ^ (((sb >> 9) & 1) << 5); R = (st >> 1) * 16 + swz / 64; C = (st & 1) * 32 + (swz % 64) / 2; }
__host__ __device__ __forceinline__ int perm32(int rho) { const int n = rho >> 4, i = rho & 15; return 8 * (i >> 2) + 4 * n + (i & 3); }

struct Unit { int pm, pn; };
struct Gemm { const bf16_t* A; const bf16_t* Bt; int M, N, K; };

struct StaticOrder {
    int nM, nN, nwg, G, c;
    __host__ __device__ void init(int M, int N, int G_, int c_) { nM = M / BM; nN = N / BM; nwg = nM * nN; G = G_; c = c_; }
    __host__ __device__ bool next(int i, Unit& u) const {
        const long L = (long)i * G + c; if (L >= nwg) return false;
        int wgid = (int)L; { const int q = nwg / NXCD, r = nwg % NXCD, xcd = wgid % NXCD, off = wgid / NXCD; wgid = (xcd < r ? xcd * (q + 1) : r * (q + 1) + (xcd - r) * q) + off; }
        const int nig = WGM * nN, gid = wgid / nig, fm = gid * WGM, gsz = (nM - fm) < WGM ? (nM - fm) : WGM;
        u.pm = fm + ((wgid % nig) % gsz); u.pn = (wgid % nig) / gsz; return true;
    }
    __device__ __forceinline__ void a_ready(const Unit&) const {}
    __device__ __forceinline__ void done(const Unit&) const {}
};

typedef float f32x2 __attribute__((ext_vector_type(2)));
typedef __bf16 bf16x2_t __attribute__((ext_vector_type(2)));
__device__ __forceinline__ unsigned cvt_pk_bf16(float lo, float hi) { f32x2 v = {lo, hi}; bf16x2_t b = __builtin_convertvector(v, bf16x2_t); return __builtin_bit_cast(unsigned, b); }

template <int ACT> struct EpiStore {
    static constexpr bool PERM = true, AFTER_DRAIN = false;
    bf16_t* O; int ldc; float* AB; int ab_tile;
    __device__ __forceinline__ void operator()(const f32x4 (&acc)[2][2][4][2], const Unit& u, int wr, int wc, int fr, int fq) const {
        const int row0 = u.pm * BM + wr * 64 + fr;
        if (u.pn == ab_tile) {
            if (wc == 0) {
#pragma unroll
                for (int ai = 0; ai < 2; ++ai)
#pragma unroll
                    for (int m = 0; m < 4; ++m) { float* p = AB + (size_t)(row0 + ai * HALF + m * 16) * 32 + 8 * fq; *(f32x4*)p = acc[ai][0][m][0]; *(f32x4*)(p + 4) = acc[ai][0][m][1]; }
            }
            return;
        }
        const int col0 = u.pn * BM + wc * 32 + 8 * fq;
#pragma unroll
        for (int ai = 0; ai < 2; ++ai)
#pragma unroll
            for (int m = 0; m < 4; ++m) { bf16_t* rowp = O + (size_t)(row0 + ai * HALF + m * 16) * ldc + col0;
#pragma unroll
                for (int bj = 0; bj < 2; ++bj) { f32x4 v0 = acc[ai][bj][m][0], v1 = acc[ai][bj][m][1];
                    if (ACT == 1) {
#pragma unroll
                        for (int i = 0; i < 4; ++i) { const float a = fmaxf(v0[i], 0.f), b = fmaxf(v1[i], 0.f); v0[i] = a * a; v1[i] = b * b; } }
                    u32x4 w; w.x = cvt_pk_bf16(v0[0], v0[1]); w.y = cvt_pk_bf16(v0[2], v0[3]); w.z = cvt_pk_bf16(v1[0], v1[1]); w.w = cvt_pk_bf16(v1[2], v1[3]);
                    *(u32x4*)(rowp + bj * HALF) = w; } }
    }
};
struct EpiResid {
    static constexpr bool PERM = false, AFTER_DRAIN = false;
    float* X; int ldc; const float* gate; int gstride;
    __device__ __forceinline__ void operator()(const f32x4 (&acc)[2][2][4][2], const Unit& u, int wr, int wc, int fr, int fq) const {
        const int row0 = u.pm * BM + wr * 64 + fr, col0 = u.pn * BM + wc * 32 + 4 * fq;
        const float* g = gate + (size_t)(u.pm < 32 ? 0 : (u.pm < 64 ? 1 : 2)) * gstride + col0;
        f32x4 gv[2][2];
#pragma unroll
        for (int bj = 0; bj < 2; ++bj)
#pragma unroll
            for (int n = 0; n < 2; ++n) gv[bj][n] = *(const f32x4*)(g + bj * HALF + n * 16);
#pragma unroll
        for (int ai = 0; ai < 2; ++ai)
#pragma unroll
            for (int m = 0; m < 4; ++m) { float* p = X + (size_t)(row0 + ai * HALF + m * 16) * ldc + col0;
#pragma unroll
                for (int bj = 0; bj < 2; ++bj)
#pragma unroll
                    for (int n = 0; n < 2; ++n) { float* q = p + bj * HALF + n * 16; *(f32x4*)q = *(const f32x4*)q + gv[bj][n] * acc[ai][bj][m][n]; }
                if (m & 1) asm volatile("" ::: "memory"); }
    }
};

template <class Epi, class Sched, bool ALIGN_EPI = false, bool SP2 = false>
__device__ __forceinline__ void gemm_phase(PG8_LAS unsigned char* lds, const Gemm g, const Sched& S, const Epi& E) {
    int tid_ = threadIdx.x; asm volatile("" : "+v"(tid_)); const int tid = tid_, wid = __builtin_amdgcn_readfirstlane(tid >> 6), lane = tid & 63, wr = wid >> 2, wc = wid & 3, fr = lane & 15, fq = lane >> 4;
    const int K = g.K, nt = K / BK;
    unsigned voffA[2], voffB[2];
#pragma unroll
    for (int i = 0; i < 2; ++i) { int R, C; stage_rc(tid * 16 + i * 8192, R, C); const int Rb = Epi::PERM ? ((R & ~31) + perm32(R & 31)) : R;
        voffA[i] = (unsigned)(R * K + C) * 2u; voffB[i] = (unsigned)(Rb * K + C) * 2u; }
    const size_t kstep = (size_t)(BK * 2);
    const size_t hstep = (size_t)HALF * K * 2;
    const size_t tstep = 2 * hstep;
    const unsigned ldsw = (unsigned)wid * 1024u;
    const int aoff = lds_byte(wr * 64 + fr, fq * 8), boff = lds_byte(wc * 32 + fr, fq * 8);
#define PG8_SA(b, h) (((b) * 2 + (h)) * HTB)
#define PG8_SB(b, h) ((4 + (b) * 2 + (h)) * HTB)
#define PG8_STAGE(bufoff, gbase, voff) do { _Pragma("unroll") for (int _i = 0; _i < 2; ++_i) \
        __builtin_amdgcn_global_load_lds((const unsigned*)((const char*)(gbase) + (voff)[_i]), (PG8_LAS unsigned*)(lds + (bufoff) + ldsw + _i * 8192), 16, 0, 0); } while (0)
#define PG8_LDA(dst, b, h) do { _Pragma("unroll") for (int m = 0; m < 4; ++m) _Pragma("unroll") for (int k = 0; k < 2; ++k) dst[m][k] = *(const PG8_LAS bf16x8*)(lds + PG8_SA(b, h) + aoff + m * 2048 + k * 1024); } while (0)
#define PG8_LDB(dst, b, h) do { _Pragma("unroll") for (int n = 0; n < 2; ++n) _Pragma("unroll") for (int k = 0; k < 2; ++k) dst[n][k] = *(const PG8_LAS bf16x8*)(lds + PG8_SB(b, h) + boff + n * 2048 + k * 1024); } while (0)
#define PG8_MMA(ai, bj, At, Bt) do { __builtin_amdgcn_s_setprio(1); _Pragma("unroll") for (int m = 0; m < 4; ++m) _Pragma("unroll") for (int n = 0; n < 2; ++n) _Pragma("unroll") for (int k = 0; k < 2; ++k) \
        acc[ai][bj][m][n] = __builtin_amdgcn_mfma_f32_16x16x32_bf16(Bt[n][k], At[m][k], acc[ai][bj][m][n], 0, 0, 0); __builtin_amdgcn_s_setprio(0); } while (0)
#define PG8_WAIT_V(n) asm volatile("s_waitcnt vmcnt(" #n ")" ::: "memory")
#define PG8_WAIT_L(n) asm volatile("s_waitcnt lgkmcnt(" #n ")" ::: "memory")
#define PG8_BAR __builtin_amdgcn_s_barrier()
#define PG8_SCHED __builtin_amdgcn_sched_barrier(0)
    Unit cur, nxt; int ui = 0;
    if (!S.next(0, cur)) return;
    f32x4 acc[2][2][4][2];
#pragma unroll
    for (int a = 0; a < 2; ++a)
#pragma unroll
        for (int b = 0; b < 2; ++b)
#pragma unroll
            for (int m = 0; m < 4; ++m)
#pragma unroll
                for (int n = 0; n < 2; ++n) acc[a][b][m][n] = (f32x4){0.f, 0.f, 0.f, 0.f};
    bf16x8 At[4][2], B0[2][2], B1[2][2];
    const char* cA = (const char*)g.A + (size_t)cur.pm * tstep; const char* cB = (const char*)g.Bt + (size_t)cur.pn * tstep;
    S.a_ready(cur);
    if constexpr (SP2) {
        PG8_STAGE(PG8_SB(0, 0), cB, voffB); PG8_STAGE(PG8_SB(0, 1), cB + hstep, voffB); PG8_STAGE(PG8_SA(0, 0), cA, voffA); PG8_STAGE(PG8_SA(0, 1), cA + hstep, voffA);
        if (wr == 1) PG8_BAR;
        PG8_WAIT_V(2); PG8_BAR;
        PG8_STAGE(PG8_SB(1, 0), cB + kstep, voffB); PG8_STAGE(PG8_SA(1, 0), cA + kstep, voffA); PG8_STAGE(PG8_SB(1, 1), cB + hstep + kstep, voffB);
        PG8_WAIT_V(6); PG8_BAR;
    } else {
        PG8_STAGE(PG8_SB(0, 0), cB, voffB); PG8_STAGE(PG8_SA(0, 0), cA, voffA); PG8_STAGE(PG8_SB(0, 1), cB + hstep, voffB); PG8_STAGE(PG8_SA(0, 1), cA + hstep, voffA);
        if (wr == 1) PG8_BAR;
        PG8_WAIT_V(4); PG8_BAR;
        PG8_STAGE(PG8_SB(1, 0), cB + kstep, voffB); PG8_STAGE(PG8_SA(1, 0), cA + kstep, voffA); PG8_STAGE(PG8_SB(1, 1), cB + hstep + kstep, voffB);
        PG8_WAIT_V(6); PG8_BAR;
    }
    for (;;) {
        const bool has_next = S.next(ui + 1, nxt);
        const char* nA = has_next ? (const char*)g.A + (size_t)nxt.pm * tstep : cA; const char* nB = has_next ? (const char*)g.Bt + (size_t)nxt.pn * tstep : cB;
        for (int t = 0; t < nt; t += 2) {
            const bool last = (t == nt - 2);
            const char* a1 = cA + (size_t)(t + 1) * kstep;
            const char* a2 = last ? nA : cA + (size_t)(t + 2) * kstep; const char* b2 = last ? nB : cB + (size_t)(t + 2) * kstep;
            const char* a3 = a2 + kstep; const char* b3 = b2 + kstep;
            if (last && has_next) S.a_ready(nxt);
            if constexpr (SP2) {
            PG8_LDB(B0, 0, 0); PG8_LDB(B1, 0, 1); PG8_SCHED; PG8_LDA(At, 0, 0); PG8_STAGE(PG8_SA(1, 1), a1 + hstep, voffA);
            PG8_WAIT_V(8); PG8_WAIT_L(0); PG8_BAR; PG8_MMA(0, 0, At, B0); PG8_MMA(0, 1, At, B1); PG8_BAR; PG8_SCHED;
            PG8_LDA(At, 0, 1); PG8_STAGE(PG8_SB(0, 0), b2, voffB); PG8_STAGE(PG8_SB(0, 1), b2 + hstep, voffB); PG8_STAGE(PG8_SA(0, 0), a2, voffA);
            PG8_WAIT_V(8); PG8_WAIT_L(0); PG8_BAR; PG8_MMA(1, 0, At, B0); PG8_MMA(1, 1, At, B1); PG8_BAR; PG8_SCHED;
            PG8_LDB(B0, 1, 0); PG8_LDB(B1, 1, 1); PG8_SCHED; PG8_LDA(At, 1, 0); PG8_STAGE(PG8_SA(0, 1), a2 + hstep, voffA);
            PG8_WAIT_V(8); PG8_WAIT_L(0); PG8_BAR; PG8_MMA(0, 0, At, B0); PG8_MMA(0, 1, At, B1); PG8_BAR; PG8_SCHED;
            PG8_LDA(At, 1, 1); PG8_STAGE(PG8_SB(1, 0), b3, voffB); PG8_STAGE(PG8_SB(1, 1), b3 + hstep, voffB); PG8_STAGE(PG8_SA(1, 0), a3, voffA);
            PG8_WAIT_V(8); PG8_WAIT_L(0); PG8_BAR; PG8_MMA(1, 0, At, B0); PG8_MMA(1, 1, At, B1); PG8_BAR; PG8_SCHED;
            } else {
            PG8_LDB(B0, 0, 0); PG8_SCHED; PG8_LDA(At, 0, 0); PG8_STAGE(PG8_SA(1, 1), a1 + hstep, voffA);
            PG8_WAIT_L(8); PG8_BAR; PG8_WAIT_L(0); PG8_MMA(0, 0, At, B0); PG8_BAR; PG8_SCHED;
            PG8_LDB(B1, 0, 1); PG8_STAGE(PG8_SB(0, 0), b2, voffB);
            PG8_BAR; PG8_WAIT_L(0); PG8_MMA(0, 1, At, B1); PG8_BAR;
            PG8_LDA(At, 0, 1); PG8_STAGE(PG8_SA(0, 0), a2, voffA);
            PG8_BAR; PG8_WAIT_L(0); PG8_MMA(1, 0, At, B0); PG8_BAR; PG8_SCHED;
            PG8_STAGE(PG8_SB(0, 1), b2 + hstep, voffB);
            PG8_WAIT_V(6); PG8_BAR; PG8_MMA(1, 1, At, B1); PG8_BAR;
            PG8_LDB(B0, 1, 0); PG8_SCHED; PG8_LDA(At, 1, 0); PG8_STAGE(PG8_SA(0, 1), a2 + hstep, voffA);
            PG8_WAIT_L(8); PG8_BAR; PG8_WAIT_L(0); PG8_MMA(0, 0, At, B0); PG8_BAR; PG8_SCHED;
            PG8_LDB(B1, 1, 1); PG8_STAGE(PG8_SB(1, 0), b3, voffB);
            PG8_BAR; PG8_WAIT_L(0); PG8_MMA(0, 1, At, B1); PG8_BAR;
            PG8_LDA(At, 1, 1); PG8_STAGE(PG8_SA(1, 0), a3, voffA);
            PG8_BAR; PG8_WAIT_L(0); PG8_MMA(1, 0, At, B0); PG8_BAR; PG8_SCHED;
            PG8_STAGE(PG8_SB(1, 1), b3 + hstep, voffB);
            PG8_WAIT_V(6); PG8_BAR; PG8_MMA(1, 1, At, B1); PG8_BAR;
            }
        }
        if constexpr (ALIGN_EPI) { if (wr == 0) PG8_BAR; }
        if constexpr (!Epi::AFTER_DRAIN) { E(acc, cur, wr, wc, fr, fq); S.done(cur); }
        if (!has_next) break;
#pragma unroll
        for (int a = 0; a < 2; ++a)
#pragma unroll
            for (int b = 0; b < 2; ++b)
#pragma unroll
                for (int m = 0; m < 4; ++m)
#pragma unroll
                    for (int n = 0; n < 2; ++n) acc[a][b][m][n] = (f32x4){0.f, 0.f, 0.f, 0.f};
        cur = nxt; cA = nA; cB = nB; ++ui;
        if constexpr (ALIGN_EPI) { if (wr == 1) PG8_BAR; }
    }
    PG8_WAIT_V(0);
    if constexpr (!ALIGN_EPI) { if (wr == 0) PG8_BAR; }
    PG8_BAR;
    if constexpr (Epi::AFTER_DRAIN) { E.fused(acc, cur, wr, wc, fr, fq, lds, wid, lane); S.done(cur); }
#undef PG8_SA
#undef PG8_SB
#undef PG8_STAGE
#undef PG8_LDA
#undef PG8_LDB
#undef PG8_MMA
#undef PG8_WAIT_V
#undef PG8_WAIT_L
#undef PG8_BAR
#undef PG8_SCHED
}
}

constexpr int D = 1024, NB = 2, T = 8192, CT = 256, DEPTH = 4, FF = 4096;
constexpr int ML = NB * T, MC = NB * CT, M = ML + MC;
constexpr int NADA = 6 * D;
constexpr int GDN_N = 4128, GDN_NP = 4352;
constexpr int NH = 8, HD = 128;
constexpr int NKV = CT + T;
constexpr float EPS = 1e-6f;
constexpr int NWAVES = 8, NTHR = 512;
constexpr float QSCALE = 0.125f * 1.4426950408889634f;
constexpr float LAMBDA_INIT = 0.47071302f;

constexpr size_t MiB = 1u << 20;
constexpr size_t WS_CTL = 0, CTL_ZERO_BYTES = 1 * MiB;
constexpr size_t WS_MOD = 1 * MiB;
constexpr size_t WS_ROPE = 2 * MiB;
constexpr size_t WS_AB = 4 * MiB;
constexpr size_t WS_OFC = 7 * MiB;
constexpr size_t WS_W1T = 10 * MiB, WS_W2T = 42 * MiB, WS_GINT = 74 * MiB, WS_GOUTT = 91 * MiB, WS_SINT = 95 * MiB, WS_SOUTT = 101 * MiB, WS_DINT = 103 * MiB, WS_DOUTT = 109 * MiB;
constexpr size_t WS_X = 112 * MiB;
constexpr size_t WS_H = 178 * MiB;
constexpr size_t WS_Y = 211 * MiB;
constexpr size_t WS_Z = 244 * MiB;
constexpr size_t WS_END = 376 * MiB;

constexpr int LDS_BYTES = 147456;

#define LAS __attribute__((address_space(3)))
typedef unsigned short bf16;
typedef unsigned u32x4 __attribute__((ext_vector_type(4)));
typedef unsigned u32x2 __attribute__((ext_vector_type(2)));
typedef float f32x4 __attribute__((ext_vector_type(4)));
typedef float f32x2 __attribute__((ext_vector_type(2)));
typedef float f32x16 __attribute__((ext_vector_type(16)));
typedef short bf16x8 __attribute__((ext_vector_type(8)));
typedef short s16x4 __attribute__((ext_vector_type(4)));
#define LDS_WAIT() asm volatile("s_waitcnt lgkmcnt(0)" ::: "memory")

__device__ __forceinline__ float bf2f(unsigned u) { return __uint_as_float(u << 16); }
__device__ __forceinline__ unsigned pk2(float lo, float hi) { return pg8::cvt_pk_bf16(lo, hi); }
__device__ __forceinline__ float wave_sum(float v) {
#pragma unroll
    for (int o = 1; o < 64; o <<= 1) v += __shfl_xor(v, o);
    return v;
}
__device__ __forceinline__ float silu_f(float x) { return x / (1.f + expf(-x)); }
__device__ __forceinline__ int crow(int r, int hi) { return (r & 3) + 8 * (r >> 2) + 4 * hi; }

struct Args { const float* in[24]; float* out; unsigned char* ws; int step_lo, step_hi, coop, pad; };
typedef const __attribute__((address_space(4))) Args* KArgs;
__device__ __forceinline__ KArgs kargs() { unsigned long long p = (unsigned long long)__builtin_amdgcn_kernarg_segment_ptr(); asm volatile("" : "+s"(p)); return (KArgs)p; }
#define INP(k) (kargs()->in[k])
extern __shared__ __attribute__((aligned(16))) unsigned char lds_raw[];
struct Frame { LAS unsigned char* lds; int tid, lane, wave, G, bid; float* out; unsigned char* ws; };
__device__ __forceinline__ Frame make_frame() {
    Frame F; F.lds = (LAS unsigned char*)lds_raw; F.tid = threadIdx.x; asm volatile("" : "+v"(F.tid)); F.lane = F.tid & 63; F.wave = __builtin_amdgcn_readfirstlane(F.tid >> 6); F.G = gridDim.x; F.bid = blockIdx.x; asm volatile("" : "+s"(F.G), "+s"(F.bid));
    KArgs a = kargs(); F.out = a->out; F.ws = a->ws; return F;
}
enum { I_X = 0, I_C, I_CTX, I_CCTX, I_N1G, I_N2G, I_ADAW, I_ADAB, I_W1, I_W2, I_GIN, I_GCONV, I_GALOG, I_GDT, I_GNG, I_GOUT, I_SIN, I_SCONV, I_SOUT, I_DIN, I_DLAM, I_DNG, I_DOUT, I_FG };

__device__ __forceinline__ void transpose_item(const float* W, int K, int ldw, bf16* WT, LAS float* scr, int item, int nblk, int lane) {
    const int kb = item / nblk, nb = item % nblk, k0 = 64 * kb, n0 = 32 * nb;
#pragma unroll 8
    for (int i = 0; i < 32; ++i) { const int kk = 2 * i + (lane >> 5); scr[kk * 33 + (lane & 31)] = W[(size_t)(k0 + kk) * ldw + n0 + (lane & 31)]; }
    LDS_WAIT(); asm volatile("" ::: "memory");
    const int c = lane & 7;
#pragma unroll
    for (int j = 0; j < 4; ++j) { const int n = (lane >> 3) + 8 * j; const LAS float* s = scr + (8 * c) * 33 + n;
        u32x4 o; o.x = pk2(s[0 * 33], s[1 * 33]); o.y = pk2(s[2 * 33], s[3 * 33]); o.z = pk2(s[4 * 33], s[5 * 33]); o.w = pk2(s[6 * 33], s[7 * 33]);
        *(u32x4*)(WT + (size_t)(n0 + n) * K + k0 + 8 * c) = o; }
    LDS_WAIT(); asm volatile("" ::: "memory");
}
__device__ __forceinline__ void get_mat(unsigned char* ws_, int idx, const float*& src, bf16*& dst, int& K, int& N, int& ld) {
    unsigned char* ws = ws_;
    if (idx < 4)       { src = INP(I_W1) + (size_t)idx * D * FF; dst = (bf16*)(ws + WS_W1T) + (size_t)idx * D * FF; K = D; N = FF; ld = FF; }
    else if (idx < 8)  { const int i = idx - 4; src = INP(I_W2) + (size_t)i * D * FF; dst = (bf16*)(ws + WS_W2T) + (size_t)i * D * FF; K = FF; N = D; ld = D; }
    else if (idx < 10) { const int j = idx - 8; src = INP(I_GIN) + (size_t)j * D * GDN_N; dst = (bf16*)(ws + WS_GINT) + (size_t)j * GDN_NP * D; K = D; N = GDN_N; ld = GDN_N; }
    else if (idx < 12) { const int j = idx - 10; src = INP(I_GOUT) + (size_t)j * D * D; dst = (bf16*)(ws + WS_GOUTT) + (size_t)j * D * D; K = D; N = D; ld = D; }
    else if (idx == 12) { src = INP(I_SIN); dst = (bf16*)(ws + WS_SINT); K = D; N = 3 * D; ld = 3 * D; }
    else if (idx == 13) { src = INP(I_SOUT); dst = (bf16*)(ws + WS_SOUTT); K = D; N = D; ld = D; }
    else if (idx == 14) { src = INP(I_DIN); dst = (bf16*)(ws + WS_DINT); K = D; N = 3 * D; ld = 3 * D; }
    else { src = INP(I_DOUT); dst = (bf16*)(ws + WS_DOUTT); K = D; N = D; ld = D; }
}
__device__ __forceinline__ void step_prologue() {
    const Frame F = make_frame();
    const int gw = F.bid * NWAVES + F.wave, NGW = F.G * NWAVES;
    const int gt = F.bid * NTHR + F.tid, NGT = F.G * NTHR;
    {
        LAS float* scr = (LAS float*)(F.lds + F.wave * 16384);
        for (int mi = 0; mi < 16; ++mi) {
            const float* src; bf16* dst; int K, N, ld; get_mat(F.ws, mi, src, dst, K, N, ld);
            const int nblk = N / 32, nitems = (K / 64) * nblk;
            for (int it = gw; it < nitems; it += NGW) transpose_item(src, K, ld, dst, scr, it, nblk, F.lane);
        }
        for (int j = 0; j < 2; ++j) { u32x4* z = (u32x4*)((bf16*)(F.ws + WS_GINT) + (size_t)j * GDN_NP * D + (size_t)GDN_N * D);
            for (int i = gt; i < (GDN_NP - GDN_N) * D / 8; i += NGT) z[i] = (u32x4){0u, 0u, 0u, 0u}; }
    }
    __syncthreads();
    {
        LAS float* sv = (LAS float*)F.lds;
        LAS float* red = sv + 3 * D;
        for (int i = F.tid; i < 3 * D; i += NTHR) { const int g = i / D, k = i % D; const float c = g < 2 ? INP(I_C)[g * D + k] : INP(I_CCTX)[k]; sv[i] = silu_f(c); }
        __syncthreads();
        float* MOD = (float*)(F.ws + WS_MOD);
        const int c = F.tid & 63, ks = F.tid >> 6;
        for (int it = F.bid; it < DEPTH * (NADA / 64); it += F.G) {
            const int li = it / (NADA / 64), n0 = (it % (NADA / 64)) * 64;
            const float* w = INP(I_ADAW) + (size_t)li * D * NADA + (size_t)(ks * 128) * NADA + n0 + c;
            float a0 = 0.f, a1 = 0.f, a2 = 0.f;
#pragma unroll 8
            for (int k = 0; k < 128; ++k) { const float wv = w[(size_t)k * NADA]; const int kk = ks * 128 + k; a0 += sv[kk] * wv; a1 += sv[D + kk] * wv; a2 += sv[2 * D + kk] * wv; }
            red[(ks * 3 + 0) * 64 + c] = a0; red[(ks * 3 + 1) * 64 + c] = a1; red[(ks * 3 + 2) * 64 + c] = a2;
            __syncthreads();
            if (F.tid < 192) { const int g = F.tid >> 6; float s = INP(I_ADAB)[li * NADA + n0 + c];
#pragma unroll
                for (int q = 0; q < 8; ++q) s += red[(q * 3 + g) * 64 + c];
                MOD[((size_t)li * 3 + g) * NADA + n0 + c] = s; }
            __syncthreads();
        }
    }
    {
        f32x4* X4 = (f32x4*)(F.ws + WS_X); const f32x4* x4 = (const f32x4*)INP(I_X); const f32x4* c4 = (const f32x4*)INP(I_CTX);
        for (int i = gt; i < M * (D / 4); i += NGT) X4[i] = i < ML * (D / 4) ? x4[i] : c4[i - ML * (D / 4)];
    }
    {
        f32x2* R = (f32x2*)(F.ws + WS_ROPE);
        for (int i = gt; i < T * 32; i += NGT) { const int t = i >> 5, p = i & 31, f = p & 15;
            const float inv = powf(10000.0f, -(float)f / 16.0f); const float pos = (float)(p < 16 ? (t >> 6) : (t & 63)); const float ang = pos * inv;
            R[i] = (f32x2){cosf(ang), sinf(ang)}; }
    }
}

__device__ __forceinline__ void step_norm(int layer, int which, int nrows, bool zero_of) {
    const Frame F = make_frame();
    const int gw = F.bid * NWAVES + F.wave, NGW = F.G * NWAVES;
    const float* X = (const float*)(F.ws + WS_X); bf16* H = (bf16*)(F.ws + WS_H);
    const float* ng = (which ? INP(I_N2G) : INP(I_N1G)) + layer * D;
    const float* MOD = (const float*)(F.ws + WS_MOD) + (size_t)layer * 3 * NADA + which * 3 * D;
    for (int row = gw; row < nrows; row += NGW) {
        const int grp = row < T ? 0 : (row < ML ? 1 : 2);
        const f32x4* xr = (const f32x4*)(X + (size_t)row * D) + F.lane;
        const f32x4* sh = (const f32x4*)(MOD + (size_t)grp * NADA) + F.lane; const f32x4* sc = (const f32x4*)(MOD + (size_t)grp * NADA + D) + F.lane; const f32x4* gg = (const f32x4*)ng + F.lane;
        f32x4 v[4]; float s = 0.f;
#pragma unroll
        for (int j = 0; j < 4; ++j) { v[j] = xr[64 * j]; s += (v[j].x * v[j].x + v[j].y * v[j].y) + (v[j].z * v[j].z + v[j].w * v[j].w); }
        const float rstd = 1.0f / sqrtf(wave_sum(s) * (1.f / D) + EPS);
        u32x2* o = (u32x2*)(H + (size_t)row * D) + F.lane;
#pragma unroll
        for (int j = 0; j < 4; ++j) { const f32x4 g4 = gg[64 * j], s4 = sc[64 * j], h4 = sh[64 * j]; const f32x4 y = (v[j] * rstd) * g4; const f32x4 h = y * (1.0f + s4) + h4;
            o[64 * j] = (u32x2){pk2(h.x, h.y), pk2(h.z, h.w)}; }
    }
    if (zero_of) {
        const int gt = F.bid * NTHR + F.tid, NGT = F.G * NTHR;
        f32x4* a = (f32x4*)F.out; for (int i = gt; i < ML * (D / 4); i += NGT) a[i] = (f32x4){0.f, 0.f, 0.f, 0.f};
        f32x4* b = (f32x4*)(F.ws + WS_OFC); for (int i = gt; i < MC * (D / 4); i += NGT) b[i] = (f32x4){0.f, 0.f, 0.f, 0.f};
    }
}
__device__ __forceinline__ void step_final() {
    const Frame F = make_frame();
    const int gw = F.bid * NWAVES + F.wave, NGW = F.G * NWAVES;
    const float* X = (const float*)(F.ws + WS_X);
    for (int row = gw; row < ML; row += NGW) {
        const f32x4* xr = (const f32x4*)(X + (size_t)row * D) + F.lane; const f32x4* gg = (const f32x4*)INP(I_FG) + F.lane;
        f32x4 v[4]; float s = 0.f;
#pragma unroll
        for (int j = 0; j < 4; ++j) { v[j] = xr[64 * j]; s += (v[j].x * v[j].x + v[j].y * v[j].y) + (v[j].z * v[j].z + v[j].w * v[j].w); }
        const float rstd = 1.0f / sqrtf(wave_sum(s) * (1.f / D) + EPS);
        f32x4* o = (f32x4*)(F.out + (size_t)row * D) + F.lane;
#pragma unroll
        for (int j = 0; j < 4; ++j) o[64 * j] = (v[j] * rstd) * gg[64 * j];
    }
}

__device__ __forceinline__ void step_gdn_scan(int j) {
    const Frame F = make_frame();
    LAS float* qs = (LAS float*)F.lds;
    LAS float* ks = qs + 64 * 128;
    LAS float* vs = ks + 64 * 128;
    LAS float* ga = vs + 64 * 128;
    LAS float* be = ga + 64;
    const bf16* Z = (const bf16*)(F.ws + WS_Z);
    const float* AB = (const float*)(F.ws + WS_AB);
    const float* cw = INP(I_GCONV) + (size_t)j * 3 * 3072;
    float* OFC = (float*)(F.ws + WS_OFC);
    for (int it = F.bid; it < 32; it += F.G) {
        const int b = it >> 4, h = (it >> 1) & 7, dir = it & 1;
        const float Aco = expf(INP(I_GALOG)[j * 16 + dir * 8 + h]); const float dtb = INP(I_GDT)[j * 16 + dir * 8 + h];
        float S[64];
#pragma unroll
        for (int i = 0; i < 64; ++i) S[i] = 0.f;
        const int jcol = F.tid >> 1, half = F.tid & 1;
        for (int n = 0; n < 132; ++n) {
            const bool isctx = n < 4; const int L = isctx ? CT : T; const int p0 = isctx ? 64 * n : 64 * (n - 4); const int rbase = isctx ? ML + b * CT : b * T;
            for (int idx = F.tid; idx < 64 * 384; idx += NTHR) {
                const int c = idx / 384, ch = idx % 384, part = ch >> 7, e = ch & 127;
                const int p = p0 + c; const int t = dir ? (L - 1 - p) : p; const int col = part * 1024 + h * 128 + e;
                float acc = 0.f;
#pragma unroll
                for (int tap = 0; tap < 3; ++tap) { const int tt = t + tap - 1; if (tt >= 0 && tt < L) acc += cw[tap * 3072 + col] * bf2f(Z[(size_t)(rbase + tt) * 4096 + col]); }
                acc = silu_f(acc);
                LAS float* dst = part == 0 ? qs : (part == 1 ? ks : vs); dst[c * 128 + e] = acc;
            }
            if (F.tid < 64) { const int p = p0 + F.tid; const int t = dir ? (L - 1 - p) : p; const size_t row = (size_t)(rbase + t);
                const float av = AB[row * 32 + dir * 8 + h], bv = AB[row * 32 + 16 + dir * 8 + h];
                const float x = av + dtb; const float sp = x > 20.f ? x : log1pf(expf(x));
                ga[F.tid] = expf(-Aco * sp); be[F.tid] = 1.f / (1.f + expf(-bv)); }
            __syncthreads();
#pragma unroll 1
            for (int rr = 0; rr < 8; ++rr) { const int c = F.wave * 8 + rr;
                const float q0 = qs[c * 128 + F.lane], q1 = qs[c * 128 + 64 + F.lane]; const float sq = 0.08838834764831845f / sqrtf(wave_sum(q0 * q0 + q1 * q1) + EPS);
                qs[c * 128 + F.lane] = q0 * sq; qs[c * 128 + 64 + F.lane] = q1 * sq;
                const float k0 = ks[c * 128 + F.lane], k1 = ks[c * 128 + 64 + F.lane]; const float sk = 1.0f / sqrtf(wave_sum(k0 * k0 + k1 * k1) + EPS);
                ks[c * 128 + F.lane] = k0 * sk; ks[c * 128 + 64 + F.lane] = k1 * sk; }
            __syncthreads();
            if (F.tid < 256) {
#pragma unroll 1
                for (int c = 0; c < 64; ++c) {
                    const float a = ga[c], bt = be[c];
                    const LAS f32x4* k4 = (const LAS f32x4*)(ks + c * 128 + 64 * half); const LAS f32x4* q4 = (const LAS f32x4*)(qs + c * 128 + 64 * half);
                    float dot = 0.f;
#pragma unroll
                    for (int i = 0; i < 16; ++i) { const f32x4 kv = k4[i]; dot += kv.x * S[4 * i] + kv.y * S[4 * i + 1] + kv.z * S[4 * i + 2] + kv.w * S[4 * i + 3]; }
                    dot += __shfl_xor(dot, 1);
                    const float tmp = bt * (vs[c * 128 + jcol] - a * dot);
                    float o = 0.f;
#pragma unroll
                    for (int i = 0; i < 16; ++i) { const f32x4 kv = k4[i]; const f32x4 qv = q4[i];
                        S[4 * i] = a * S[4 * i] + kv.x * tmp; S[4 * i + 1] = a * S[4 * i + 1] + kv.y * tmp; S[4 * i + 2] = a * S[4 * i + 2] + kv.z * tmp; S[4 * i + 3] = a * S[4 * i + 3] + kv.w * tmp;
                        o += qv.x * S[4 * i] + qv.y * S[4 * i + 1] + qv.z * S[4 * i + 2] + qv.w * S[4 * i + 3]; }
                    o += __shfl_xor(o, 1);
                    const int p = p0 + c; const int t = dir ? (L - 1 - p) : p;
                    float* dst = isctx ? OFC + (size_t)(b * CT + t) * D : F.out + (size_t)(b * T + t) * D;
                    if (half == 0) atomicAdd(dst + h * 128 + jcol, o);
                }
            }
            __syncthreads();
        }
    }
}
__device__ __forceinline__ void step_gdn_norm(int j) {
    const Frame F = make_frame();
    const int gw = F.bid * NWAVES + F.wave, NGW = F.G * NWAVES;
    const bf16* Z = (const bf16*)(F.ws + WS_Z); bf16* Y = (bf16*)(F.ws + WS_Y); const float* ng = INP(I_GNG) + j * 128;
    for (int row = gw; row < M; row += NGW) {
        const float* src = row < ML ? F.out + (size_t)row * D : (const float*)(F.ws + WS_OFC) + (size_t)(row - ML) * D;
        const f32x4* s4 = (const f32x4*)(src + 16 * F.lane);
        float v[16]; float ss = 0.f;
#pragma unroll
        for (int q = 0; q < 4; ++q) { const f32x4 x = s4[q]; v[4 * q] = x.x; v[4 * q + 1] = x.y; v[4 * q + 2] = x.z; v[4 * q + 3] = x.w; ss += (x.x * x.x + x.y * x.y) + (x.z * x.z + x.w * x.w); }
        ss += __shfl_xor(ss, 1); ss += __shfl_xor(ss, 2); ss += __shfl_xor(ss, 4);
        const float rstd = 1.0f / sqrtf(ss * (1.f / 128.f) + EPS);
        const u32x4* g4 = (const u32x4*)(Z + (size_t)row * 4096 + 3072 + 16 * F.lane);
        const int e0 = (16 * F.lane) & 127;
        u32x4 o[2];
#pragma unroll
        for (int q = 0; q < 2; ++q) { const u32x4 gz = g4[q]; unsigned w[4];
#pragma unroll
            for (int i = 0; i < 4; ++i) { const unsigned gg = gz[i]; const float g0 = bf2f(gg & 0xffffu), g1 = bf2f(gg >> 16); const int e = e0 + 8 * q + 2 * i;
                w[i] = pk2(v[8 * q + 2 * i] * rstd * ng[e] * silu_f(g0), v[8 * q + 2 * i + 1] * rstd * ng[e + 1] * silu_f(g1)); }
            o[q] = (u32x4){w[0], w[1], w[2], w[3]}; }
        u32x4* dst = (u32x4*)(Y + (size_t)row * D + 16 * F.lane); dst[0] = o[0]; dst[1] = o[1];
    }
}

__device__ __forceinline__ void step_sconv() {
    const Frame F = make_frame();
    const int gt = F.bid * NTHR + F.tid, NGT = F.G * NTHR;
    const bf16* Z = (const bf16*)(F.ws + WS_Z); bf16* Y = (bf16*)(F.ws + WS_Y); const float* cw = INP(I_SCONV);
    for (int idx = gt; idx < M * 128; idx += NGT) {
        const int row = idx >> 7, c0 = (idx & 127) * 8;
        int t, L, rbase; if (row < ML) { t = row & (T - 1); L = T; rbase = row - t; } else { const int r2 = row - ML; t = r2 & (CT - 1); L = CT; rbase = row - t; }
        float acc[8];
#pragma unroll
        for (int i = 0; i < 8; ++i) acc[i] = 0.f;
#pragma unroll
        for (int tap = 0; tap < 3; ++tap) { const int tt = t + tap - 1;
            if (tt >= 0 && tt < L) { const bf16* zr = Z + (size_t)(rbase + tt) * 3072; const u32x4 cg = *(const u32x4*)(zr + 1024 + c0), hv = *(const u32x4*)(zr + 2048 + c0);
                const f32x4 w0 = *(const f32x4*)(cw + tap * 1024 + c0), w1 = *(const f32x4*)(cw + tap * 1024 + c0 + 4); const float w[8] = {w0.x, w0.y, w0.z, w0.w, w1.x, w1.y, w1.z, w1.w};
#pragma unroll
                for (int i = 0; i < 4; ++i) { acc[2 * i] += w[2 * i] * bf2f(cg[i] & 0xffffu) * bf2f(hv[i] & 0xffffu); acc[2 * i + 1] += w[2 * i + 1] * bf2f(cg[i] >> 16) * bf2f(hv[i] >> 16); } } }
        const u32x4 bg = *(const u32x4*)(Z + (size_t)row * 3072 + c0); u32x4 o;
#pragma unroll
        for (int i = 0; i < 4; ++i) o[i] = pk2(bf2f(bg[i] & 0xffffu) * acc[2 * i], bf2f(bg[i] >> 16) * acc[2 * i + 1]);
        *(u32x4*)(Y + (size_t)row * D + c0) = o;
    }
}

__device__ __forceinline__ void step_rope() {
    const Frame F = make_frame();
    const int gw = F.bid * NWAVES + F.wave, NGW = F.G * NWAVES;
    bf16* Z = (bf16*)(F.ws + WS_Z); const f32x4* R = (const f32x4*)(F.ws + WS_ROPE);
    for (int row = gw; row < M; row += NGW) {
        u32x4* p = (u32x4*)(Z + (size_t)row * 3072 + 32 * F.lane);
        u32x4 v[4];
#pragma unroll
        for (int q = 0; q < 4; ++q) v[q] = p[q];
        const bool lat = row < ML; const float sc = F.lane < 32 ? QSCALE : 1.0f;
        const f32x4* tab = R + ((size_t)(row & (T - 1)) * 32 + 16 * (F.lane & 1)) / 2;
#pragma unroll
        for (int q = 0; q < 4; ++q) {
#pragma unroll
            for (int i = 0; i < 4; i += 2) {
                f32x4 cs = (f32x4){1.f, 0.f, 1.f, 0.f}; if (lat) cs = tab[(4 * q + i) / 2];
                { const unsigned w = v[q][i]; const float x0 = bf2f(w & 0xffffu), x1 = bf2f(w >> 16); v[q][i] = pk2((x0 * cs.x - x1 * cs.y) * sc, (x0 * cs.y + x1 * cs.x) * sc); }
                { const unsigned w = v[q][i + 1]; const float x0 = bf2f(w & 0xffffu), x1 = bf2f(w >> 16); v[q][i + 1] = pk2((x0 * cs.z - x1 * cs.w) * sc, (x0 * cs.w + x1 * cs.z) * sc); }
            }
        }
#pragma unroll
        for (int q = 0; q < 4; ++q) p[q] = v[q];
    }
    bf16* Vt = (bf16*)(F.ws + WS_H);
    LAS bf16* tl = (LAS bf16*)(F.lds + F.wave * 18432);
    for (int it = gw; it < NB * NH * (NKV / 64); it += NGW) {
        const int kt = it % (NKV / 64), bh = it / (NKV / 64), b = bh >> 3, h = bh & 7; const int kv0 = 64 * kt;
        const int srow = kv0 < CT ? ML + b * CT + kv0 : b * T + kv0 - CT;
#pragma unroll 4
        for (int i = 0; i < 16; ++i) { const int r = 4 * i + (F.lane >> 4), cc = (F.lane & 15) * 8;
            const u32x4 v = *(const u32x4*)(Z + (size_t)(srow + r) * 3072 + 2048 + h * 128 + cc);
#pragma unroll
            for (int q = 0; q < 4; ++q) { tl[(cc + 2 * q) * 72 + r] = (bf16)(v[q] & 0xffffu); tl[(cc + 2 * q + 1) * 72 + r] = (bf16)(v[q] >> 16); } }
        LDS_WAIT(); asm volatile("" ::: "memory");
#pragma unroll 4
        for (int i = 0; i < 16; ++i) { const int e = 8 * i + (F.lane >> 3), ch = F.lane & 7;
            const u32x4 v = *(const LAS u32x4*)(tl + e * 72 + ch * 8);
            *(u32x4*)(Vt + ((size_t)(bh * 128 + e)) * NKV + kv0 + ch * 8) = v; }
        LDS_WAIT(); asm volatile("" ::: "memory");
    }
}
__device__ __forceinline__ void step_attn() {
    const Frame F = make_frame();
    const bf16* Z = (const bf16*)(F.ws + WS_Z); const bf16* Vt = (const bf16*)(F.ws + WS_H); bf16* Y = (bf16*)(F.ws + WS_Y);
    LAS float* EX = (LAS float*)F.lds;
    const int r = F.lane & 31, hi = F.lane >> 5, qs = F.wave & 3, m = F.wave >> 2;
    float lmb;
    { const float* lam = INP(I_DLAM); const float t1 = lam[F.lane] * lam[64 + F.lane], t2 = lam[128 + F.lane] * lam[192 + F.lane]; lmb = expf(wave_sum(t1)) - expf(wave_sum(t2)) + LAMBDA_INIT; }
    const float* ng = INP(I_DNG);
    for (int u = F.bid; u < 1056; u += F.G) {
        int b, h, qrow0, nk;
        if (u < 1024) { b = u >> 9; h = (u >> 6) & 7; qrow0 = b * T + (u & 63) * 128; nk = NKV / 32; }
        else { const int v = u - 1024; b = v >> 4; h = (v >> 1) & 7; qrow0 = ML + b * CT + (v & 1) * 128; nk = CT / 32; }
        const int row0 = qrow0 + 32 * qs;
        bf16x8 qf[4];
#pragma unroll
        for (int d0 = 0; d0 < 4; ++d0) qf[d0] = *(const bf16x8*)(Z + (size_t)(row0 + r) * 3072 + h * 128 + m * 64 + d0 * 16 + hi * 8);
        const int kcol = 1024 + h * 128 + m * 64 + hi * 8;
        const bf16* vtb = Vt + (size_t)((b * 8 + h) * 128 + r) * NKV + 4 * hi;
        f32x16 o[4];
#pragma unroll
        for (int i = 0; i < 4; ++i)
#pragma unroll
            for (int q = 0; q < 16; ++q) o[i][q] = 0.f;
        float mref = 0.f, l = 0.f;
        for (int s = 0; s < nk; ++s) {
            const int kv0 = 32 * s; const int krow = kv0 < CT ? ML + b * CT + kv0 : b * T + kv0 - CT;
            const bf16* kp = Z + (size_t)(krow + r) * 3072 + kcol;
            bf16x8 kf[4];
#pragma unroll
            for (int d0 = 0; d0 < 4; ++d0) kf[d0] = *(const bf16x8*)(kp + d0 * 16);
            bf16x8 vf[4][2];
#pragma unroll
            for (int i = 0; i < 4; ++i)
#pragma unroll
                for (int s2 = 0; s2 < 2; ++s2) { const bf16* vp = vtb + (size_t)(32 * i) * NKV + kv0 + 16 * s2; const s16x4 lo = *(const s16x4*)vp, h8 = *(const s16x4*)(vp + 8);
                    vf[i][s2] = (bf16x8){lo[0], lo[1], lo[2], lo[3], h8[0], h8[1], h8[2], h8[3]}; }
            f32x16 S;
#pragma unroll
            for (int q = 0; q < 16; ++q) S[q] = 0.f;
#pragma unroll
            for (int d0 = 0; d0 < 4; ++d0) S = __builtin_amdgcn_mfma_f32_32x32x16_bf16(kf[d0], qf[d0], S, 0, 0, 0);
            float mx = S[0];
#pragma unroll
            for (int q = 1; q < 16; ++q) mx = fmaxf(mx, S[q]);
            mx = fmaxf(mx, __shfl_xor(mx, 32));
            if (s == 0) mref = mx;
            else if (__any(mx > mref)) { const float mn = fmaxf(mref, mx); const float al = __builtin_amdgcn_exp2f(mref - mn); l *= al; mref = mn;
#pragma unroll
                for (int i = 0; i < 4; ++i)
#pragma unroll
                    for (int q = 0; q < 16; ++q) o[i][q] *= al; }
            float ps = 0.f;
#pragma unroll
            for (int q = 0; q < 16; ++q) { S[q] = __builtin_amdgcn_exp2f(S[q] - mref); ps += S[q]; }
            l += ps;
            bf16x8 pf[2];
#pragma unroll
            for (int s2 = 0; s2 < 2; ++s2) { u32x4 w; w.x = pk2(S[8 * s2], S[8 * s2 + 1]); w.y = pk2(S[8 * s2 + 2], S[8 * s2 + 3]); w.z = pk2(S[8 * s2 + 4], S[8 * s2 + 5]); w.w = pk2(S[8 * s2 + 6], S[8 * s2 + 7]); pf[s2] = __builtin_bit_cast(bf16x8, w); }
#pragma unroll
            for (int i = 0; i < 4; ++i)
#pragma unroll
                for (int s2 = 0; s2 < 2; ++s2) o[i] = __builtin_amdgcn_mfma_f32_32x32x16_bf16(vf[i][s2], pf[s2], o[i], 0, 0, 0);
        }
        l += __shfl_xor(l, 32);
        const float f = (m == 1 ? lmb : 1.0f) / l;
        LAS float* ex = EX + (size_t)m * 128 * 129 + (qs * 32 + r) * 129;
#pragma unroll
        for (int i = 0; i < 4; ++i)
#pragma unroll
            for (int q = 0; q < 16; ++q) ex[32 * i + crow(q, hi)] = o[i][q] * f;
        __syncthreads();
#pragma unroll 1
        for (int rr = 0; rr < 16; ++rr) { const int row = 16 * F.wave + rr;
            const float a0 = EX[row * 129 + F.lane] - EX[128 * 129 + row * 129 + F.lane], a1 = EX[row * 129 + 64 + F.lane] - EX[128 * 129 + row * 129 + 64 + F.lane];
            const float rstd = (1.0f - LAMBDA_INIT) / sqrtf(wave_sum(a0 * a0 + a1 * a1) * (1.f / 128.f) + EPS);
            bf16* yr = Y + (size_t)(qrow0 + row) * D + h * 128;
            yr[F.lane] = (bf16)(pk2(a0 * rstd * ng[F.lane], 0.f) & 0xffffu); yr[64 + F.lane] = (bf16)(pk2(a1 * rstd * ng[64 + F.lane], 0.f) & 0xffffu); }
        __syncthreads();
    }
}

enum { OP_PRO = 0, OP_N1, OP_GIN, OP_SCAN, OP_GNORM, OP_CONV, OP_ROPE, OP_ATTN, OP_GOUT, OP_N2, OP_UP, OP_DOWN, OP_FINAL };
constexpr int NSTEPS = 1 + 8 + 7 + 8 + 8 + 1;
__host__ __device__ __forceinline__ void decode_step(int step, int& op, int& layer) {
    if (step == 0) { op = OP_PRO; layer = 0; return; }
    int s = step - 1;
    for (int i = 0; i < DEPTH; ++i) {
        const int kind = i % 3, n = kind == 1 ? 7 : 8;
        if (s < n) { layer = i;
            if (s == 0) op = OP_N1; else if (s == 1) op = OP_GIN;
            else { const int tail = n - s;
                if (tail == 4) op = OP_GOUT; else if (tail == 3) op = OP_N2; else if (tail == 2) op = OP_UP; else if (tail == 1) op = OP_DOWN;
                else if (kind == 0) op = (s == 2 ? OP_SCAN : OP_GNORM); else if (kind == 1) op = OP_CONV; else op = (s == 2 ? OP_ROPE : OP_ATTN); }
            return; }
        s -= n;
    }
    op = OP_FINAL; layer = DEPTH;
}

#ifndef MK_SINGLE
#define MK_SINGLE 0
#endif

__global__ void __launch_bounds__(NTHR, 2) fwd_kernel(Args a) {
    unsigned char* ws = a.ws;
    for (int step = a.step_lo; step < a.step_hi; ++step) {
        int op, layer; decode_step(step, op, layer);
        op = __builtin_amdgcn_readfirstlane(op); layer = __builtin_amdgcn_readfirstlane(layer);
        const int kind = layer % 3, jj = layer / 3; const bool last = layer == DEPTH - 1;
        const int Mrows = last ? ML : M;
        __syncthreads();
        int G_ = gridDim.x, B_ = blockIdx.x; asm volatile("" : "+s"(G_), "+s"(B_));
        switch (op) {
        case OP_PRO:
#ifndef NO_PRO
            step_prologue();
#endif
            break;
        #ifndef NO_NORM
        case OP_N1: step_norm(layer, 0, M, kind == 0); break;
        case OP_N2: step_norm(layer, 1, Mrows, false); break;
#endif
#ifndef NO_GIN
        case OP_GIN: {
            const bf16* Bt = kind == 0 ? (const bf16*)(ws + WS_GINT) + (size_t)jj * GDN_NP * D : (kind == 1 ? (const bf16*)(ws + WS_SINT) : (const bf16*)(ws + WS_DINT));
            const int N = kind == 0 ? GDN_NP : 3 * D, ldc = kind == 0 ? 4096 : 3 * D;
            pg8::Gemm g{(const bf16*)(ws + WS_H), Bt, M, N, D}; pg8::StaticOrder S; S.init(M, N, G_, B_);
            pg8::EpiStore<0> E{(bf16*)(ws + WS_Z), ldc, (float*)(ws + WS_AB), kind == 0 ? 16 : -1};
            pg8::gemm_phase<pg8::EpiStore<0>, pg8::StaticOrder, true, true>((LAS unsigned char*)lds_raw, g, S, E);
        } break;
#endif
#ifndef NO_UP
        case OP_UP: {
            pg8::Gemm g{(const bf16*)(ws + WS_H), (const bf16*)(ws + WS_W1T) + (size_t)layer * D * FF, Mrows, FF, D}; pg8::StaticOrder S; S.init(Mrows, FF, G_, B_);
            pg8::EpiStore<1> E{(bf16*)(ws + WS_Z), FF, nullptr, -1};
            pg8::gemm_phase<pg8::EpiStore<1>, pg8::StaticOrder, true, true>((LAS unsigned char*)lds_raw, g, S, E);
        } break;
#endif
#ifndef NO_RES
        case OP_GOUT: case OP_DOWN: {
            const bool dn = op == OP_DOWN;
            const bf16* A = dn ? (const bf16*)(ws + WS_Z) : (const bf16*)(ws + WS_Y);
            const bf16* Bt = dn ? (const bf16*)(ws + WS_W2T) + (size_t)layer * D * FF
                                : (kind == 0 ? (const bf16*)(ws + WS_GOUTT) + (size_t)jj * D * D : (kind == 1 ? (const bf16*)(ws + WS_SOUTT) : (const bf16*)(ws + WS_DOUTT)));
            const int K = dn ? FF : D;
            pg8::Gemm g{A, Bt, Mrows, D, K}; pg8::StaticOrder S; S.init(Mrows, D, G_, B_);
            pg8::EpiResid E{(float*)(ws + WS_X), D, (const float*)(ws + WS_MOD) + (size_t)layer * 3 * NADA + (dn ? 5 : 2) * D, NADA};
            pg8::gemm_phase<pg8::EpiResid, pg8::StaticOrder, true, true>((LAS unsigned char*)lds_raw, g, S, E);
        } break;
#endif
        case OP_SCAN:
#ifndef NO_SCAN
            step_gdn_scan(jj);
#endif
            break;
        #ifndef NO_GNORM
        case OP_GNORM: step_gdn_norm(jj); break;
#endif
        #ifndef NO_CONV
        case OP_CONV: step_sconv(); break;
#endif
        case OP_ROPE:
#ifndef NO_ROPE
            step_rope();
#endif
            break;
        case OP_ATTN:
#ifndef NO_ATTN
            step_attn();
#endif
            break;
        default:
#ifndef NO_FINAL
            step_final();
#endif
            break;
        }
        if (step + 1 < a.step_hi) { if (a.coop) cg::this_grid().sync(); }
    }
}

extern "C" void kernel_launch(void* const* d_in, const int* in_sizes, int n_in, void* d_out, int out_size, void* d_ws, size_t ws_size, hipStream_t stream) {
    static int grid = 0;
    if (grid == 0) {
        if (n_in != 24 || out_size != ML * D || ws_size < WS_END) { fprintf(stderr, "kernel_launch: unexpected problem (n_in %d, out %d, ws %zu); nothing launched\n", n_in, out_size, ws_size); grid = -1; return; }
        int dev = 0, cus = 0, per_cu = 0;
        if (hipGetDevice(&dev) != hipSuccess || hipDeviceGetAttribute(&cus, hipDeviceAttributeMultiprocessorCount, dev) != hipSuccess) { grid = -1; return; }
        if (hipFuncSetAttribute((const void*)fwd_kernel, hipFuncAttributeMaxDynamicSharedMemorySize, LDS_BYTES) != hipSuccess) { fprintf(stderr, "kernel_launch: hipFuncSetAttribute failed\n"); grid = -1; return; }
        if (hipOccupancyMaxActiveBlocksPerMultiprocessor(&per_cu, (const void*)fwd_kernel, NTHR, LDS_BYTES) != hipSuccess || per_cu < 1) { fprintf(stderr, "kernel_launch: occupancy query says %d blocks per CU\n", per_cu); (void)hipGetLastError(); per_cu = 1; }
        grid = cus;
        fprintf(stderr, "kernel_launch: %d CUs, occupancy %d per CU, grid %d\n", cus, per_cu, grid);
    }
    if (grid < 0) return;
    (void)hipMemsetAsync((char*)d_ws + WS_CTL, 0, CTL_ZERO_BYTES, stream);
    Args a{};
    for (int i = 0; i < 24; ++i) a.in[i] = (const float*)d_in[i];
    a.out = (float*)d_out; a.ws = (unsigned char*)d_ws;
#if MK_SINGLE
    a.step_lo = 0; a.step_hi = NSTEPS; a.coop = 1;
    void* args[] = {&a};
    hipError_t e = hipLaunchCooperativeKernel((const void*)fwd_kernel, dim3(grid), dim3(NTHR), args, LDS_BYTES, stream);
    if (e != hipSuccess) fprintf(stderr, "cooperative launch failed: %s (grid %d)\n", hipGetErrorString(e), grid);
#else
    for (int s = 0; s < NSTEPS; ++s) { a.step_lo = s; a.step_hi = s + 1; a.coop = 0; hipLaunchKernelGGL(fwd_kernel, dim3(grid), dim3(NTHR), LDS_BYTES, stream, a); }
#endif
}
```

```cpp
#include <hip/hip_runtime.h>
#include <hip/hip_cooperative_groups.h>
#include <cstdio>
#include <cstdint>
namespace cg = cooperative_groups;
namespace pg8 {
#define PG8_LAS __attribute__((address_space(3)))
typedef unsigned short bf16_t;
typedef short bf16x8 __attribute__((ext_vector_type(8)));
typedef float f32x4 __attribute__((ext_vector_type(4)));
typedef unsigned u32x4 __attribute__((ext_vector_type(4)));
constexpr int BM = 256, BK = 64, HALF = 128, HTB = HALF * BK * 2  , STAGE_BYTES = 8 * HTB, NXCD = 8, WGM = 8;

__host__ __device__ __forceinline__ int lds_byte(int r, int c) { const int st = (r >> 4) * 2 + (c >> 5), rr = r & 15, cc = c & 31, ob = rr * 64 + cc * 2; return st * 1024 + (ob ^ (((ob >> 9) & 1) << 5)); }
__host__ __device__ __forceinline__ void stage_rc(int b, int& R, int& C) { const int st = b / 1024, sb = b % 1024, swz = sb ^ (((sb >> 9) & 1) << 5); R = (st >> 1) * 16 + swz / 64; C = (st & 1) * 32 + (swz % 64) / 2; }
__host__ __device__ __forceinline__ int perm32(int rho) { const int n = rho >> 4, i = rho & 15; return 8 * (i >> 2) + 4 * n + (i & 3); }

struct Unit { int pm, pn; };
struct Gemm { const bf16_t* A; const bf16_t* Bt; int M, N, K; };

struct StaticOrder {
    int nM, nN, nwg, G, c;
    __host__ __device__ void init(int M, int N, int G_, int c_) { nM = M / BM; nN = N / BM; nwg = nM * nN; G = G_; c = c_; }
    __host__ __device__ bool next(int i, Unit& u) const {
        const long L = (long)i * G + c; if (L >= nwg) return false;
        int wgid = (int)L; { const int q = nwg / NXCD, r = nwg % NXCD, xcd = wgid % NXCD, off = wgid / NXCD; wgid = (xcd < r ? xcd * (q + 1) : r * (q + 1) + (xcd - r) * q) + off; }
        const int nig = WGM * nN, gid = wgid / nig, fm = gid * WGM, gsz = (nM - fm) < WGM ? (nM - fm) : WGM;
        u.pm = fm + ((wgid % nig) % gsz); u.pn = (wgid % nig) / gsz; return true;
    }
    __device__ __forceinline__ void a_ready(const Unit&) const {}
    __device__ __forceinline__ void done(const Unit&) const {}
};

typedef float f32x2 __attribute__((ext_vector_type(2)));
typedef __bf16 bf16x2_t __attribute__((ext_vector_type(2)));
__device__ __forceinline__ unsigned cvt_pk_bf16(float lo, float hi) { f32x2 v = {lo, hi}; bf16x2_t b = __builtin_convertvector(v, bf16x2_t); return __builtin_bit_cast(unsigned, b); }

template <int ACT> struct EpiStore {
    static constexpr bool PERM = true, AFTER_DRAIN = false;
    bf16_t* O; int ldc; float* AB; int ab_tile;
    __device__ __forceinline__ void operator()(const f32x4 (&acc)[2][2][4][2], const Unit& u, int wr, int wc, int fr, int fq) const {
        const int row0 = u.pm * BM + wr * 64 + fr;
        if (u.pn == ab_tile) {
            if (wc == 0) {
#pragma unroll
                for (int ai = 0; ai < 2; ++ai)
#pragma unroll
                    for (int m = 0; m < 4; ++m) { float* p = AB + (size_t)(row0 + ai * HALF + m * 16) * 32 + 8 * fq; *(f32x4*)p = acc[ai][0][m][0]; *(f32x4*)(p + 4) = acc[ai][0][m][1]; }
            }
            return;
        }
        const int col0 = u.pn * BM + wc * 32 + 8 * fq;
#pragma unroll
        for (int ai = 0; ai < 2; ++ai)
#pragma unroll
            for (int m = 0; m < 4; ++m) { bf16_t* rowp = O + (size_t)(row0 + ai * HALF + m * 16) * ldc + col0;
#pragma unroll
                for (int bj = 0; bj < 2; ++bj) { f32x4 v0 = acc[ai][bj][m][0], v1 = acc[ai][bj][m][1];
                    if (ACT == 1) {
#pragma unroll
                        for (int i = 0; i < 4; ++i) { const float a = fmaxf(v0[i], 0.f), b = fmaxf(v1[i], 0.f); v0[i] = a * a; v1[i] = b * b; } }
                    u32x4 w; w.x = cvt_pk_bf16(v0[0], v0[1]); w.y = cvt_pk_bf16(v0[2], v0[3]); w.z = cvt_pk_bf16(v1[0], v1[1]); w.w = cvt_pk_bf16(v1[2], v1[3]);
                    *(u32x4*)(rowp + bj * HALF) = w; } }
    }
};
struct EpiResid {
    static constexpr bool PERM = false, AFTER_DRAIN = false;
    float* X; int ldc; const float* gate; int gstride;
    __device__ __forceinline__ void operator()(const f32x4 (&acc)[2][2][4][2], const Unit& u, int wr, int wc, int fr, int fq) const {
        const int row0 = u.pm * BM + wr * 64 + fr, col0 = u.pn * BM + wc * 32 + 4 * fq;
        const float* g = gate + (size_t)(u.pm < 32 ? 0 : (u.pm < 64 ? 1 : 2)) * gstride + col0;
        f32x4 gv[2][2];
#pragma unroll
        for (int bj = 0; bj < 2; ++bj)
#pragma unroll
            for (int n = 0; n < 2; ++n) gv[bj][n] = *(const f32x4*)(g + bj * HALF + n * 16);
#pragma unroll
        for (int ai = 0; ai < 2; ++ai)
#pragma unroll
            for (int m = 0; m < 4; ++m) { float* p = X + (size_t)(row0 + ai * HALF + m * 16) * ldc + col0;
#pragma unroll
                for (int bj = 0; bj < 2; ++bj)
#pragma unroll
                    for (int n = 0; n < 2; ++n) { float* q = p + bj * HALF + n * 16; *(f32x4*)q = *(const f32x4*)q + gv[bj][n] * acc[ai][bj][m][n]; }
                if (m & 1) asm volatile("" ::: "memory"); }
    }
};

template <class Epi, class Sched, bool ALIGN_EPI = false, bool SP2 = false>
__device__ __forceinline__ void gemm_phase(PG8_LAS unsigned char* lds, const Gemm g, const Sched& S, const Epi& E) {
    int tid_ = threadIdx.x; asm volatile("" : "+v"(tid_)); const int tid = tid_, wid = __builtin_amdgcn_readfirstlane(tid >> 6), lane = tid & 63, wr = wid >> 2, wc = wid & 3, fr = lane & 15, fq = lane >> 4;
    const int K = g.K, nt = K / BK;
    unsigned voffA[2], voffB[2];
#pragma unroll
    for (int i = 0; i < 2; ++i) { int R, C; stage_rc(tid * 16 + i * 8192, R, C); const int Rb = Epi::PERM ? ((R & ~31) + perm32(R & 31)) : R;
        voffA[i] = (unsigned)(R * K + C) * 2u; voffB[i] = (unsigned)(Rb * K + C) * 2u; }
    const size_t kstep = (size_t)(BK * 2);
    const size_t hstep = (size_t)HALF * K * 2;
    const size_t tstep = 2 * hstep;
    const unsigned ldsw = (unsigned)wid * 1024u;
    const int aoff = lds_byte(wr * 64 + fr, fq * 8), boff = lds_byte(wc * 32 + fr, fq * 8);
#define PG8_SA(b, h) (((b) * 2 + (h)) * HTB)
#define PG8_SB(b, h) ((4 + (b) * 2 + (h)) * HTB)
#define PG8_STAGE(bufoff, gbase, voff) do { _Pragma("unroll") for (int _i = 0; _i < 2; ++_i) \
        __builtin_amdgcn_global_load_lds((const unsigned*)((const char*)(gbase) + (voff)[_i]), (PG8_LAS unsigned*)(lds + (bufoff) + ldsw + _i * 8192), 16, 0, 0); } while (0)
#define PG8_LDA(dst, b, h) do { _Pragma("unroll") for (int m = 0; m < 4; ++m) _Pragma("unroll") for (int k = 0; k < 2; ++k) dst[m][k] = *(const PG8_LAS bf16x8*)(lds + PG8_SA(b, h) + aoff + m * 2048 + k * 1024); } while (0)
#define PG8_LDB(dst, b, h) do { _Pragma("unroll") for (int n = 0; n < 2; ++n) _Pragma("unroll") for (int k = 0; k < 2; ++k) dst[n][k] = *(const PG8_LAS bf16x8*)(lds + PG8_SB(b, h) + boff + n * 2048 + k * 1024); } while (0)
#define PG8_MMA(ai, bj, At, Bt) do { __builtin_amdgcn_s_setprio(1); _Pragma("unroll") for (int m = 0; m < 4; ++m) _Pragma("unroll") for (int n = 0; n < 2; ++n) _Pragma("unroll") for (int k = 0; k < 2; ++k) \
        acc[ai][bj][m][n] = __builtin_amdgcn_mfma_f32_16x16x32_bf16(Bt[n][k], At[m][k], acc[ai][bj][m][n], 0, 0, 0); __builtin_amdgcn_s_setprio(0); } while (0)
#define PG8_WAIT_V(n) asm volatile("s_waitcnt vmcnt(" #n ")" ::: "memory")
#define PG8_WAIT_L(n) asm volatile("s_waitcnt lgkmcnt(" #n ")" ::: "memory")
#define PG8_BAR __builtin_amdgcn_s_barrier()
#define PG8_SCHED __builtin_amdgcn_sched_barrier(0)
    Unit cur, nxt; int ui = 0;
    if (!S.next(0, cur)) return;
    f32x4 acc[2][2][4][2];
#pragma unroll
    for (int a = 0; a < 2; ++a)
#pragma unroll
        for (int b = 0; b < 2; ++b)
#pragma unroll
            for (int m = 0; m < 4; ++m)
#pragma unroll
                for (int n = 0; n < 2; ++n) acc[a][b][m][n] = (f32x4){0.f, 0.f, 0.f, 0.f};
    bf16x8 At[4][2], B0[2][2], B1[2][2];
    const char* cA = (const char*)g.A + (size_t)cur.pm * tstep; const char* cB = (const char*)g.Bt + (size_t)cur.pn * tstep;
    S.a_ready(cur);
    if constexpr (SP2) {
        PG8_STAGE(PG8_SB(0, 0), cB, voffB); PG8_STAGE(PG8_SB(0, 1), cB + hstep, voffB); PG8_STAGE(PG8_SA(0, 0), cA, voffA); PG8_STAGE(PG8_SA(0, 1), cA + hstep, voffA);
        if (wr == 1) PG8_BAR;
        PG8_WAIT_V(2); PG8_BAR;
        PG8_STAGE(PG8_SB(1, 0), cB + kstep, voffB); PG8_STAGE(PG8_SA(1, 0), cA + kstep, voffA); PG8_STAGE(PG8_SB(1, 1), cB + hstep + kstep, voffB);
        PG8_WAIT_V(6); PG8_BAR;
    } else {
        PG8_STAGE(PG8_SB(0, 0), cB, voffB); PG8_STAGE(PG8_SA(0, 0), cA, voffA); PG8_STAGE(PG8_SB(0, 1), cB + hstep, voffB); PG8_STAGE(PG8_SA(0, 1), cA + hstep, voffA);
        if (wr == 1) PG8_BAR;
        PG8_WAIT_V(4); PG8_BAR;
        PG8_STAGE(PG8_SB(1, 0), cB + kstep, voffB); PG8_STAGE(PG8_SA(1, 0), cA + kstep, voffA); PG8_STAGE(PG8_SB(1, 1), cB + hstep + kstep, voffB);
        PG8_WAIT_V(6); PG8_BAR;
    }
    for (;;) {
        const bool has_next = S.next(ui + 1, nxt);
        const char* nA = has_next ? (const char*)g.A + (size_t)nxt.pm * tstep : cA; const char* nB = has_next ? (const char*)g.Bt + (size_t)nxt.pn * tstep : cB;
        for (int t = 0; t < nt; t += 2) {
            const bool last = (t == nt - 2);
            const char* a1 = cA + (size_t)(t + 1) * kstep;
            const char* a2 = last ? nA : cA + (size_t)(t + 2) * kstep; const char* b2 = last ? nB : cB + (size_t)(t + 2) * kstep;
            const char* a3 = a2 + kstep; const char* b3 = b2 + kstep;
            if (last && has_next) S.a_ready(nxt);
            if constexpr (SP2) {
            PG8_LDB(B0, 0, 0); PG8_LDB(B1, 0, 1); PG8_SCHED; PG8_LDA(At, 0, 0); PG8_STAGE(PG8_SA(1, 1), a1 + hstep, voffA);
            PG8_WAIT_V(8); PG8_WAIT_L(0); PG8_BAR; PG8_MMA(0, 0, At, B0); PG8_MMA(0, 1, At, B1); PG8_BAR; PG8_SCHED;
            PG8_LDA(At, 0, 1); PG8_STAGE(PG8_SB(0, 0), b2, voffB); PG8_STAGE(PG8_SB(0, 1), b2 + hstep, voffB); PG8_STAGE(PG8_SA(0, 0), a2, voffA);
            PG8_WAIT_V(8); PG8_WAIT_L(0); PG8_BAR; PG8_MMA(1, 0, At, B0); PG8_MMA(1, 1, At, B1); PG8_BAR; PG8_SCHED;
            PG8_LDB(B0, 1, 0); PG8_LDB(B1, 1, 1); PG8_SCHED; PG8_LDA(At, 1, 0); PG8_STAGE(PG8_SA(0, 1), a2 + hstep, voffA);
            PG8_WAIT_V(8); PG8_WAIT_L(0); PG8_BAR; PG8_MMA(0, 0, At, B0); PG8_MMA(0, 1, At, B1); PG8_BAR; PG8_SCHED;
            PG8_LDA(At, 1, 1); PG8_STAGE(PG8_SB(1, 0), b3, voffB); PG8_STAGE(PG8_SB(1, 1), b3 + hstep, voffB); PG8_STAGE(PG8_SA(1, 0), a3, voffA);
            PG8_WAIT_V(8); PG8_WAIT_L(0); PG8_BAR; PG8_MMA(1, 0, At, B0); PG8_MMA(1, 1, At, B1); PG8_BAR; PG8_SCHED;
            } else {
            PG8_LDB(B0, 0, 0); PG8_SCHED; PG8_LDA(At, 0, 0); PG8_STAGE(PG8_SA(1, 1), a1 + hstep, voffA);
            PG8_WAIT_L(8); PG8_BAR; PG8_WAIT_L(0); PG8_MMA(0, 0, At, B0); PG8_BAR; PG8_SCHED;
            PG8_LDB(B1, 0, 1); PG8_STAGE(PG8_SB(0, 0), b2, voffB);
            PG8_BAR; PG8_WAIT_L(0); PG8_MMA(0, 1, At, B1); PG8_BAR;
            PG8_LDA(At, 0, 1); PG8_STAGE(PG8_SA(0, 0), a2, voffA);
            PG8_BAR; PG8_WAIT_L(0); PG8_MMA(1, 0, At, B0); PG8_BAR; PG8_SCHED;
            PG8_STAGE(PG8_SB(0, 1), b2 + hstep, voffB);
            PG8_WAIT_V(6); PG8_BAR; PG8_MMA(1, 1, At, B1); PG8_BAR;
            PG8_LDB(B0, 1, 0); PG8_SCHED; PG8_LDA(At, 1, 0); PG8_STAGE(PG8_SA(0, 1), a2 + hstep, voffA);
            PG8_WAIT_L(8); PG8_BAR; PG8_WAIT_L(0); PG8_MMA(0, 0, At, B0); PG8_BAR; PG8_SCHED;
            PG8_LDB(B1, 1, 1); PG8_STAGE(PG8_SB(1, 0), b3, voffB);
            PG8_BAR; PG8_WAIT_L(0); PG8_MMA(0, 1, At, B1); PG8_BAR;
            PG8_LDA(At, 1, 1); PG8_STAGE(PG8_SA(1, 0), a3, voffA);
            PG8_BAR; PG8_WAIT_L(0); PG8_MMA(1, 0, At, B0); PG8_BAR; PG8_SCHED;
            PG8_STAGE(PG8_SB(1, 1), b3 + hstep, voffB);
            PG8_WAIT_V(6); PG8_BAR; PG8_MMA(1, 1, At, B1); PG8_BAR;
            }
        }
        if constexpr (ALIGN_EPI) { if (wr == 0) PG8_BAR; }
        if constexpr (!Epi::AFTER_DRAIN) { E(acc, cur, wr, wc, fr, fq); S.done(cur); }
        if (!has_next) break;
#pragma unroll
        for (int a = 0; a < 2; ++a)
#pragma unroll
            for (int b = 0; b < 2; ++b)
#pragma unroll
                for (int m = 0; m < 4; ++m)
#pragma unroll
                    for (int n = 0; n < 2; ++n) acc[a][b][m][n] = (f32x4){0.f, 0.f, 0.f, 0.f};
        cur = nxt; cA = nA; cB = nB; ++ui;
        if constexpr (ALIGN_EPI) { if (wr == 1) PG8_BAR; }
    }
    PG8_WAIT_V(0);
    if constexpr (!ALIGN_EPI) { if (wr == 0) PG8_BAR; }
    PG8_BAR;
    if constexpr (Epi::AFTER_DRAIN) { E.fused(acc, cur, wr, wc, fr, fq, lds, wid, lane); S.done(cur); }
#undef PG8_SA
#undef PG8_SB
#undef PG8_STAGE
#undef PG8_LDA
#undef PG8_LDB
#undef PG8_MMA
#undef PG8_WAIT_V
#undef PG8_WAIT_L
#undef PG8_BAR
#undef PG8_SCHED
}
}

constexpr int D = 1024, NB = 2, T = 8192, CT = 256, DEPTH = 4, FF = 4096;
constexpr int ML = NB * T, MC = NB * CT, M = ML + MC;
constexpr int NADA = 6 * D;
constexpr int GDN_N = 4128, GDN_NP = 4352;
constexpr int NH = 8, HD = 128;
constexpr int NKV = CT + T;
constexpr float EPS = 1e-6f;
constexpr int NWAVES = 8, NTHR = 512;
constexpr float QSCALE = 0.125f * 1.4426950408889634f;
constexpr float LAMBDA_INIT = 0.47071302f;

constexpr size_t MiB = 1u << 20;
constexpr size_t WS_CTL = 0, CTL_ZERO_BYTES = 1 * MiB;
constexpr size_t WS_MOD = 1 * MiB;
constexpr size_t WS_ROPE = 2 * MiB;
constexpr size_t WS_AB = 4 * MiB;
constexpr size_t WS_OFC = 7 * MiB;
constexpr size_t WS_W1T = 10 * MiB, WS_W2T = 42 * MiB, WS_GINT = 74 * MiB, WS_GOUTT = 91 * MiB, WS_SINT = 95 * MiB, WS_SOUTT = 101 * MiB, WS_DINT = 103 * MiB, WS_DOUTT = 109 * MiB;
constexpr size_t WS_X = 112 * MiB;
constexpr size_t WS_H = 178 * MiB;
constexpr size_t WS_Y = 211 * MiB;
constexpr size_t WS_Z = 244 * MiB;
constexpr size_t WS_END = 376 * MiB;

constexpr int LDS_BYTES = 147456;

#define LAS __attribute__((address_space(3)))
typedef unsigned short bf16;
typedef unsigned u32x4 __attribute__((ext_vector_type(4)));
typedef unsigned u32x2 __attribute__((ext_vector_type(2)));
typedef float f32x4 __attribute__((ext_vector_type(4)));
typedef float f32x2 __attribute__((ext_vector_type(2)));
typedef float f32x16 __attribute__((ext_vector_type(16)));
typedef short bf16x8 __attribute__((ext_vector_type(8)));
typedef short s16x4 __attribute__((ext_vector_type(4)));
#define LDS_WAIT() asm volatile("s_waitcnt lgkmcnt(0)" ::: "memory")

__device__ __forceinline__ float bf2f(unsigned u) { return __uint_as_float(u << 16); }
__device__ __forceinline__ unsigned pk2(float lo, float hi) { return pg8::cvt_pk_bf16(lo, hi); }
__device__ __forceinline__ float wave_sum(float v) {
#pragma unroll
    for (int o = 1; o < 64; o <<= 1) v += __shfl_xor(v, o);
    return v;
}
__device__ __forceinline__ float silu_f(float x) { return x / (1.f + expf(-x)); }
__device__ __forceinline__ int crow(int r, int hi) { return (r & 3) + 8 * (r >> 2) + 4 * hi; }

struct Args { const float* in[24]; float* out; unsigned char* ws; int step_lo, step_hi, coop, pad; };
typedef const __attribute__((address_space(4))) Args* KArgs;
__device__ __forceinline__ KArgs kargs() { unsigned long long p = (unsigned long long)__builtin_amdgcn_kernarg_segment_ptr(); asm volatile("" : "+s"(p)); return (KArgs)p; }
#define INP(k) (kargs()->in[k])
extern __shared__ __attribute__((aligned(16))) unsigned char lds_raw[];
struct Frame { LAS unsigned char* lds; int tid, lane, wave, G, bid; float* out; unsigned char* ws; };
__device__ __forceinline__ Frame make_frame() {
    Frame F; F.lds = (LAS unsigned char*)lds_raw; F.tid = threadIdx.x; asm volatile("" : "+v"(F.tid)); F.lane = F.tid & 63; F.wave = __builtin_amdgcn_readfirstlane(F.tid >> 6); F.G = gridDim.x; F.bid = blockIdx.x; asm volatile("" : "+s"(F.G), "+s"(F.bid));
    KArgs a = kargs(); F.out = a->out; F.ws = a->ws; return F;
}
enum { I_X = 0, I_C, I_CTX, I_CCTX, I_N1G, I_N2G, I_ADAW, I_ADAB, I_W1, I_W2, I_GIN, I_GCONV, I_GALOG, I_GDT, I_GNG, I_GOUT, I_SIN, I_SCONV, I_SOUT, I_DIN, I_DLAM, I_DNG, I_DOUT, I_FG };

__device__ __forceinline__ void transpose_item(const float* W, int K, int ldw, bf16* WT, LAS float* scr, int item, int nblk, int lane) {
    const int kb = item / nblk, nb = item % nblk, k0 = 64 * kb, n0 = 32 * nb;
#pragma unroll 8
    for (int i = 0; i < 32; ++i) { const int kk = 2 * i + (lane >> 5); scr[kk * 33 + (lane & 31)] = W[(size_t)(k0 + kk) * ldw + n0 + (lane & 31)]; }
    LDS_WAIT(); asm volatile("" ::: "memory");
    const int c = lane & 7;
#pragma unroll
    for (int j = 0; j < 4; ++j) { const int n = (lane >> 3) + 8 * j; const LAS float* s = scr + (8 * c) * 33 + n;
        u32x4 o; o.x = pk2(s[0 * 33], s[1 * 33]); o.y = pk2(s[2 * 33], s[3 * 33]); o.z = pk2(s[4 * 33], s[5 * 33]); o.w = pk2(s[6 * 33], s[7 * 33]);
        *(u32x4*)(WT + (size_t)(n0 + n) * K + k0 + 8 * c) = o; }
    LDS_WAIT(); asm volatile("" ::: "memory");
}
__device__ __forceinline__ void get_mat(unsigned char* ws_, int idx, const float*& src, bf16*& dst, int& K, int& N, int& ld) {
    unsigned char* ws = ws_;
    if (idx < 4)       { src = INP(I_W1) + (size_t)idx * D * FF; dst = (bf16*)(ws + WS_W1T) + (size_t)idx * D * FF; K = D; N = FF; ld = FF; }
    else if (idx < 8)  { const int i = idx - 4; src = INP(I_W2) + (size_t)i * D * FF; dst = (bf16*)(ws + WS_W2T) + (size_t)i * D * FF; K = FF; N = D; ld = D; }
    else if (idx < 10) { const int j = idx - 8; src = INP(I_GIN) + (size_t)j * D * GDN_N; dst = (bf16*)(ws + WS_GINT) + (size_t)j * GDN_NP * D; K = D; N = GDN_N; ld = GDN_N; }
    else if (idx < 12) { const int j = idx - 10; src = INP(I_GOUT) + (size_t)j * D * D; dst = (bf16*)(ws + WS_GOUTT) + (size_t)j * D * D; K = D; N = D; ld = D; }
    else if (idx == 12) { src = INP(I_SIN); dst = (bf16*)(ws + WS_SINT); K = D; N = 3 * D; ld = 3 * D; }
    else if (idx == 13) { src = INP(I_SOUT); dst = (bf16*)(ws + WS_SOUTT); K = D; N = D; ld = D; }
    else if (idx == 14) { src = INP(I_DIN); dst = (bf16*)(ws + WS_DINT); K = D; N = 3 * D; ld = 3 * D; }
    else { src = INP(I_DOUT); dst = (bf16*)(ws + WS_DOUTT); K = D; N = D; ld = D; }
}
__device__ __forceinline__ void step_prologue() {
    const Frame F = make_frame();
    const int gw = F.bid * NWAVES + F.wave, NGW = F.G * NWAVES;
    const int gt = F.bid * NTHR + F.tid, NGT = F.G * NTHR;
    {
        LAS float* scr = (LAS float*)(F.lds + F.wave * 16384);
        for (int mi = 0; mi < 16; ++mi) {
            const float* src; bf16* dst; int K, N, ld; get_mat(F.ws, mi, src, dst, K, N, ld);
            const int nblk = N / 32, nitems = (K / 64) * nblk;
            for (int it = gw; it < nitems; it += NGW) transpose_item(src, K, ld, dst, scr, it, nblk, F.lane);
        }
        for (int j = 0; j < 2; ++j) { u32x4* z = (u32x4*)((bf16*)(F.ws + WS_GINT) + (size_t)j * GDN_NP * D + (size_t)GDN_N * D);
            for (int i = gt; i < (GDN_NP - GDN_N) * D / 8; i += NGT) z[i] = (u32x4){0u, 0u, 0u, 0u}; }
    }
    __syncthreads();
    {
        LAS float* sv = (LAS float*)F.lds;
        LAS float* red = sv + 3 * D;
        for (int i = F.tid; i < 3 * D; i += NTHR) { const int g = i / D, k = i % D; const float c = g < 2 ? INP(I_C)[g * D + k] : INP(I_CCTX)[k]; sv[i] = silu_f(c); }
        __syncthreads();
        float* MOD = (float*)(F.ws + WS_MOD);
        const int c = F.tid & 63, ks = F.tid >> 6;
        for (int it = F.bid; it < DEPTH * (NADA / 64); it += F.G) {
            const int li = it / (NADA / 64), n0 = (it % (NADA / 64)) * 64;
            const float* w = INP(I_ADAW) + (size_t)li * D * NADA + (size_t)(ks * 128) * NADA + n0 + c;
            float a0 = 0.f, a1 = 0.f, a2 = 0.f;
#pragma unroll 8
            for (int k = 0; k < 128; ++k) { const float wv = w[(size_t)k * NADA]; const int kk = ks * 128 + k; a0 += sv[kk] * wv; a1 += sv[D + kk] * wv; a2 += sv[2 * D + kk] * wv; }
            red[(ks * 3 + 0) * 64 + c] = a0; red[(ks * 3 + 1) * 64 + c] = a1; red[(ks * 3 + 2) * 64 + c] = a2;
            __syncthreads();
            if (F.tid < 192) { const int g = F.tid >> 6; float s = INP(I_ADAB)[li * NADA + n0 + c];
#pragma unroll
                for (int q = 0; q < 8; ++q) s += red[(q * 3 + g) * 64 + c];
                MOD[((size_t)li * 3 + g) * NADA + n0 + c] = s; }
            __syncthreads();
        }
    }
    {
        f32x4* X4 = (f32x4*)(F.ws + WS_X); const f32x4* x4 = (const f32x4*)INP(I_X); const f32x4* c4 = (const f32x4*)INP(I_CTX);
        for (int i = gt; i < M * (D / 4); i += NGT) X4[i] = i < ML * (D / 4) ? x4[i] : c4[i - ML * (D / 4)];
    }
    {
        f32x2* R = (f32x2*)(F.ws + WS_ROPE);
        for (int i = gt; i < T * 32; i += NGT) { const int t = i >> 5, p = i & 31, f = p & 15;
            const float inv = powf(10000.0f, -(float)f / 16.0f); const float pos = (float)(p < 16 ? (t >> 6) : (t & 63)); const float ang = pos * inv;
            R[i] = (f32x2){cosf(ang), sinf(ang)}; }
    }
}

__device__ __forceinline__ void step_norm(int layer, int which, int nrows, bool zero_of) {
    const Frame F = make_frame();
    const int gw = F.bid * NWAVES + F.wave, NGW = F.G * NWAVES;
    const float* X = (const float*)(F.ws + WS_X); bf16* H = (bf16*)(F.ws + WS_H);
    const float* ng = (which ? INP(I_N2G) : INP(I_N1G)) + layer * D;
    const float* MOD = (const float*)(F.ws + WS_MOD) + (size_t)layer * 3 * NADA + which * 3 * D;
    for (int row = gw; row < nrows; row += NGW) {
        const int grp = row < T ? 0 : (row < ML ? 1 : 2);
        const f32x4* xr = (const f32x4*)(X + (size_t)row * D) + F.lane;
        const f32x4* sh = (const f32x4*)(MOD + (size_t)grp * NADA) + F.lane; const f32x4* sc = (const f32x4*)(MOD + (size_t)grp * NADA + D) + F.lane; const f32x4* gg = (const f32x4*)ng + F.lane;
        f32x4 v[4]; float s = 0.f;
#pragma unroll
        for (int j = 0; j < 4; ++j) { v[j] = xr[64 * j]; s += (v[j].x * v[j].x + v[j].y * v[j].y) + (v[j].z * v[j].z + v[j].w * v[j].w); }
        const float rstd = 1.0f / sqrtf(wave_sum(s) * (1.f / D) + EPS);
        u32x2* o = (u32x2*)(H + (size_t)row * D) + F.lane;
#pragma unroll
        for (int j = 0; j < 4; ++j) { const f32x4 g4 = gg[64 * j], s4 = sc[64 * j], h4 = sh[64 * j]; const f32x4 y = (v[j] * rstd) * g4; const f32x4 h = y * (1.0f + s4) + h4;
            o[64 * j] = (u32x2){pk2(h.x, h.y), pk2(h.z, h.w)}; }
    }
    if (zero_of) {
        const int gt = F.bid * NTHR + F.tid, NGT = F.G * NTHR;
        f32x4* a = (f32x4*)F.out; for (int i = gt; i < ML * (D / 4); i += NGT) a[i] = (f32x4){0.f, 0.f, 0.f, 0.f};
        f32x4* b = (f32x4*)(F.ws + WS_OFC); for (int i = gt; i < MC * (D / 4); i += NGT) b[i] = (f32x4){0.f, 0.f, 0.f, 0.f};
    }
}
__device__ __forceinline__ void step_final() {
    const Frame F = make_frame();
    const int gw = F.bid * NWAVES + F.wave, NGW = F.G * NWAVES;
    const float* X = (const float*)(F.ws + WS_X);
    for (int row = gw; row < ML; row += NGW) {
        const f32x4* xr = (const f32x4*)(X + (size_t)row * D) + F.lane; const f32x4* gg = (const f32x4*)INP(I_FG) + F.lane;
        f32x4 v[4]; float s = 0.f;
#pragma unroll
        for (int j = 0; j < 4; ++j) { v[j] = xr[64 * j]; s += (v[j].x * v[j].x + v[j].y * v[j].y) + (v[j].z * v[j].z + v[j].w * v[j].w); }
        const float rstd = 1.0f / sqrtf(wave_sum(s) * (1.f / D) + EPS);
        f32x4* o = (f32x4*)(F.out + (size_t)row * D) + F.lane;
#pragma unroll
        for (int j = 0; j < 4; ++j) o[64 * j] = (v[j] * rstd) * gg[64 * j];
    }
}

__device__ __forceinline__ void step_gdn_scan(int j) {
    const Frame F = make_frame();
    LAS float* qs = (LAS float*)F.lds;
    LAS float* ks = qs + 64 * 128;
    LAS float* vs = ks + 64 * 128;
    LAS float* ga = vs + 64 * 128;
    LAS float* be = ga + 64;
    const bf16* Z = (const bf16*)(F.ws + WS_Z);
    const float* AB = (const float*)(F.ws + WS_AB);
    const float* cw = INP(I_GCONV) + (size_t)j * 3 * 3072;
    float* OFC = (float*)(F.ws + WS_OFC);
    for (int it = F.bid; it < 32; it += F.G) {
        const int b = it >> 4, h = (it >> 1) & 7, dir = it & 1;
        const float Aco = expf(INP(I_GALOG)[j * 16 + dir * 8 + h]); const float dtb = INP(I_GDT)[j * 16 + dir * 8 + h];
        float S[64];
#pragma unroll
        for (int i = 0; i < 64; ++i) S[i] = 0.f;
        const int jcol = F.tid >> 1, half = F.tid & 1;
        for (int n = 0; n < 132; ++n) {
            const bool isctx = n < 4; const int L = isctx ? CT : T; const int p0 = isctx ? 64 * n : 64 * (n - 4); const int rbase = isctx ? ML + b * CT : b * T;
            for (int idx = F.tid; idx < 64 * 384; idx += NTHR) {
                const int c = idx / 384, ch = idx % 384, part = ch >> 7, e = ch & 127;
                const int p = p0 + c; const int t = dir ? (L - 1 - p) : p; const int col = part * 1024 + h * 128 + e;
                float acc = 0.f;
#pragma unroll
                for (int tap = 0; tap < 3; ++tap) { const int tt = t + tap - 1; if (tt >= 0 && tt < L) acc += cw[tap * 3072 + col] * bf2f(Z[(size_t)(rbase + tt) * 4096 + col]); }
                acc = silu_f(acc);
                LAS float* dst = part == 0 ? qs : (part == 1 ? ks : vs); dst[c * 128 + e] = acc;
            }
            if (F.tid < 64) { const int p = p0 + F.tid; const int t = dir ? (L - 1 - p) : p; const size_t row = (size_t)(rbase + t);
                const float av = AB[row * 32 + dir * 8 + h], bv = AB[row * 32 + 16 + dir * 8 + h];
                const float x = av + dtb; const float sp = x > 20.f ? x : log1pf(expf(x));
                ga[F.tid] = expf(-Aco * sp); be[F.tid] = 1.f / (1.f + expf(-bv)); }
            __syncthreads();
#pragma unroll 1
            for (int rr = 0; rr < 8; ++rr) { const int c = F.wave * 8 + rr;
                const float q0 = qs[c * 128 + F.lane], q1 = qs[c * 128 + 64 + F.lane]; const float sq = 0.08838834764831845f / sqrtf(wave_sum(q0 * q0 + q1 * q1) + EPS);
                qs[c * 128 + F.lane] = q0 * sq; qs[c * 128 + 64 + F.lane] = q1 * sq;
                const float k0 = ks[c * 128 + F.lane], k1 = ks[c * 128 + 64 + F.lane]; const float sk = 1.0f / sqrtf(wave_sum(k0 * k0 + k1 * k1) + EPS);
                ks[c * 128 + F.lane] = k0 * sk; ks[c * 128 + 64 + F.lane] = k1 * sk; }
            __syncthreads();
            if (F.tid < 256) {
#pragma unroll 1
                for (int c = 0; c < 64; ++c) {
                    const float a = ga[c], bt = be[c];
                    const LAS f32x4* k4 = (const LAS f32x4*)(ks + c * 128 + 64 * half); const LAS f32x4* q4 = (const LAS f32x4*)(qs + c * 128 + 64 * half);
                    float dot = 0.f;
#pragma unroll
                    for (int i = 0; i < 16; ++i) { const f32x4 kv = k4[i]; dot += kv.x * S[4 * i] + kv.y * S[4 * i + 1] + kv.z * S[4 * i + 2] + kv.w * S[4 * i + 3]; }
                    dot += __shfl_xor(dot, 1);
                    const float tmp = bt * (vs[c * 128 + jcol] - a * dot);
                    float o = 0.f;
#pragma unroll
                    for (int i = 0; i < 16; ++i) { const f32x4 kv = k4[i]; const f32x4 qv = q4[i];
                        S[4 * i] = a * S[4 * i] + kv.x * tmp; S[4 * i + 1] = a * S[4 * i + 1] + kv.y * tmp; S[4 * i + 2] = a * S[4 * i + 2] + kv.z * tmp; S[4 * i + 3] = a * S[4 * i + 3] + kv.w * tmp;
                        o += qv.x * S[4 * i] + qv.y * S[4 * i + 1] + qv.z * S[4 * i + 2] + qv.w * S[4 * i + 3]; }
                    o += __shfl_xor(o, 1);
                    const int p = p0 + c; const int t = dir ? (L - 1 - p) : p;
                    float* dst = isctx ? OFC + (size_t)(b * CT + t) * D : F.out + (size_t)(b * T + t) * D;
                    if (half == 0) atomicAdd(dst + h * 128 + jcol, o);
                }
            }
            __syncthreads();
        }
    }
}
__device__ __forceinline__ void step_gdn_norm(int j) {
    const Frame F = make_frame();
    const int gw = F.bid * NWAVES + F.wave, NGW = F.G * NWAVES;
    const bf16* Z = (const bf16*)(F.ws + WS_Z); bf16* Y = (bf16*)(F.ws + WS_Y); const float* ng = INP(I_GNG) + j * 128;
    for (int row = gw; row < M; row += NGW) {
        const float* src = row < ML ? F.out + (size_t)row * D : (const float*)(F.ws + WS_OFC) + (size_t)(row - ML) * D;
        const f32x4* s4 = (const f32x4*)(src + 16 * F.lane);
        float v[16]; float ss = 0.f;
#pragma unroll
        for (int q = 0; q < 4; ++q) { const f32x4 x = s4[q]; v[4 * q] = x.x; v[4 * q + 1] = x.y; v[4 * q + 2] = x.z; v[4 * q + 3] = x.w; ss += (x.x * x.x + x.y * x.y) + (x.z * x.z + x.w * x.w); }
        ss += __shfl_xor(ss, 1); ss += __shfl_xor(ss, 2); ss += __shfl_xor(ss, 4);
        const float rstd = 1.0f / sqrtf(ss * (1.f / 128.f) + EPS);
        const u32x4* g4 = (const u32x4*)(Z + (size_t)row * 4096 + 3072 + 16 * F.lane);
        const int e0 = (16 * F.lane) & 127;
        u32x4 o[2];
#pragma unroll
        for (int q = 0; q < 2; ++q) { const u32x4 gz = g4[q]; unsigned w[4];
#pragma unroll
            for (int i = 0; i < 4; ++i) { const unsigned gg = gz[i]; const float g0 = bf2f(gg & 0xffffu), g1 = bf2f(gg >> 16); const int e = e0 + 8 * q + 2 * i;
                w[i] = pk2(v[8 * q + 2 * i] * rstd * ng[e] * silu_f(g0), v[8 * q + 2 * i + 1] * rstd * ng[e + 1] * silu_f(g1)); }
            o[q] = (u32x4){w[0], w[1], w[2], w[3]}; }
        u32x4* dst = (u32x4*)(Y + (size_t)row * D + 16 * F.lane); dst[0] = o[0]; dst[1] = o[1];
    }
}

__device__ __forceinline__ void step_sconv() {
    const Frame F = make_frame();
    const int gt = F.bid * NTHR + F.tid, NGT = F.G * NTHR;
    const bf16* Z = (const bf16*)(F.ws + WS_Z); bf16* Y = (bf16*)(F.ws + WS_Y); const float* cw = INP(I_SCONV);
    for (int idx = gt; idx < M * 128; idx += NGT) {
        const int row = idx >> 7, c0 = (idx & 127) * 8;
        int t, L, rbase; if (row < ML) { t = row & (T - 1); L = T; rbase = row - t; } else { const int r2 = row - ML; t = r2 & (CT - 1); L = CT; rbase = row - t; }
        float acc[8];
#pragma unroll
        for (int i = 0; i < 8; ++i) acc[i] = 0.f;
#pragma unroll
        for (int tap = 0; tap < 3; ++tap) { const int tt = t + tap - 1;
            if (tt >= 0 && tt < L) { const bf16* zr = Z + (size_t)(rbase + tt) * 3072; const u32x4 cg = *(const u32x4*)(zr + 1024 + c0), hv = *(const u32x4*)(zr + 2048 + c0);
                const f32x4 w0 = *(const f32x4*)(cw + tap * 1024 + c0), w1 = *(const f32x4*)(cw + tap * 1024 + c0 + 4); const float w[8] = {w0.x, w0.y, w0.z, w0.w, w1.x, w1.y, w1.z, w1.w};
#pragma unroll
                for (int i = 0; i < 4; ++i) { acc[2 * i] += w[2 * i] * bf2f(cg[i] & 0xffffu) * bf2f(hv[i] & 0xffffu); acc[2 * i + 1] += w[2 * i + 1] * bf2f(cg[i] >> 16) * bf2f(hv[i] >> 16); } } }
        const u32x4 bg = *(const u32x4*)(Z + (size_t)row * 3072 + c0); u32x4 o;
#pragma unroll
        for (int i = 0; i < 4; ++i) o[i] = pk2(bf2f(bg[i] & 0xffffu) * acc[2 * i], bf2f(bg[i] >> 16) * acc[2 * i + 1]);
        *(u32x4*)(Y + (size_t)row * D + c0) = o;
    }
}

__device__ __forceinline__ void step_rope() {
    const Frame F = make_frame();
    const int gw = F.bid * NWAVES + F.wave, NGW = F.G * NWAVES;
    bf16* Z = (bf16*)(F.ws + WS_Z); const f32x4* R = (const f32x4*)(F.ws + WS_ROPE);
    for (int row = gw; row < M; row += NGW) {
        u32x4* p = (u32x4*)(Z + (size_t)row * 3072 + 32 * F.lane);
        u32x4 v[4];
#pragma unroll
        for (int q = 0; q < 4; ++q) v[q] = p[q];
        const bool lat = row < ML; const float sc = F.lane < 32 ? QSCALE : 1.0f;
        const f32x4* tab = R + ((size_t)(row & (T - 1)) * 32 + 16 * (F.lane & 1)) / 2;
#pragma unroll
        for (int q = 0; q < 4; ++q) {
#pragma unroll
            for (int i = 0; i < 4; i += 2) {
                f32x4 cs = (f32x4){1.f, 0.f, 1.f, 0.f}; if (lat) cs = tab[(4 * q + i) / 2];
                { const unsigned w = v[q][i]; const float x0 = bf2f(w & 0xffffu), x1 = bf2f(w >> 16); v[q][i] = pk2((x0 * cs.x - x1 * cs.y) * sc, (x0 * cs.y + x1 * cs.x) * sc); }
                { const unsigned w = v[q][i + 1]; const float x0 = bf2f(w & 0xffffu), x1 = bf2f(w >> 16); v[q][i + 1] = pk2((x0 * cs.z - x1 * cs.w) * sc, (x0 * cs.w + x1 * cs.z) * sc); }
            }
        }
#pragma unroll
        for (int q = 0; q < 4; ++q) p[q] = v[q];
    }
    bf16* Vt = (bf16*)(F.ws + WS_H);
    LAS bf16* tl = (LAS bf16*)(F.lds + F.wave * 18432);
    for (int it = gw; it < NB * NH * (NKV / 64); it += NGW) {
        const int kt = it % (NKV / 64), bh = it / (NKV / 64), b = bh >> 3, h = bh & 7; const int kv0 = 64 * kt;
        const int srow = kv0 < CT ? ML + b * CT + kv0 : b * T + kv0 - CT;
#pragma unroll 4
        for (int i = 0; i < 16; ++i) { const int r = 4 * i + (F.lane >> 4), cc = (F.lane & 15) * 8;
            const u32x4 v = *(const u32x4*)(Z + (size_t)(srow + r) * 3072 + 2048 + h * 128 + cc);
#pragma unroll
            for (int q = 0; q < 4; ++q) { tl[(cc + 2 * q) * 72 + r] = (bf16)(v[q] & 0xffffu); tl[(cc + 2 * q + 1) * 72 + r] = (bf16)(v[q] >> 16); } }
        LDS_WAIT(); asm volatile("" ::: "memory");
#pragma unroll 4
        for (int i = 0; i < 16; ++i) { const int e = 8 * i + (F.lane >> 3), ch = F.lane & 7;
            const u32x4 v = *(const LAS u32x4*)(tl + e * 72 + ch * 8);
            *(u32x4*)(Vt + ((size_t)(bh * 128 + e)) * NKV + kv0 + ch * 8) = v; }
        LDS_WAIT(); asm volatile("" ::: "memory");
    }
}
__device__ __forceinline__ void step_attn() {
    const Frame F = make_frame();
    const bf16* Z = (const bf16*)(F.ws + WS_Z); const bf16* Vt = (const bf16*)(F.ws + WS_H); bf16* Y = (bf16*)(F.ws + WS_Y);
    LAS float* EX = (LAS float*)F.lds;
    const int r = F.lane & 31, hi = F.lane >> 5, qs = F.wave & 3, m = F.wave >> 2;
    float lmb;
    { const float* lam = INP(I_DLAM); const float t1 = lam[F.lane] * lam[64 + F.lane], t2 = lam[128 + F.lane] * lam[192 + F.lane]; lmb = expf(wave_sum(t1)) - expf(wave_sum(t2)) + LAMBDA_INIT; }
    const float* ng = INP(I_DNG);
    for (int u = F.bid; u < 1056; u += F.G) {
        int b, h, qrow0, nk;
        if (u < 1024) { b = u >> 9; h = (u >> 6) & 7; qrow0 = b * T + (u & 63) * 128; nk = NKV / 32; }
        else { const int v = u - 1024; b = v >> 4; h = (v >> 1) & 7; qrow0 = ML + b * CT + (v & 1) * 128; nk = CT / 32; }
        const int row0 = qrow0 + 32 * qs;
        bf16x8 qf[4];
#pragma unroll
        for (int d0 = 0; d0 < 4; ++d0) qf[d0] = *(const bf16x8*)(Z + (size_t)(row0 + r) * 3072 + h * 128 + m * 64 + d0 * 16 + hi * 8);
        const int kcol = 1024 + h * 128 + m * 64 + hi * 8;
        const bf16* vtb = Vt + (size_t)((b * 8 + h) * 128 + r) * NKV + 4 * hi;
        f32x16 o[4];
#pragma unroll
        for (int i = 0; i < 4; ++i)
#pragma unroll
            for (int q = 0; q < 16; ++q) o[i][q] = 0.f;
        float mref = 0.f, l = 0.f;
        for (int s = 0; s < nk; ++s) {
            const int kv0 = 32 * s; const int krow = kv0 < CT ? ML + b * CT + kv0 : b * T + kv0 - CT;
            const bf16* kp = Z + (size_t)(krow + r) * 3072 + kcol;
            bf16x8 kf[4];
#pragma unroll
            for (int d0 = 0; d0 < 4; ++d0) kf[d0] = *(const bf16x8*)(kp + d0 * 16);
            bf16x8 vf[4][2];
#pragma unroll
            for (int i = 0; i < 4; ++i)
#pragma unroll
                for (int s2 = 0; s2 < 2; ++s2) { const bf16* vp = vtb + (size_t)(32 * i) * NKV + kv0 + 16 * s2; const s16x4 lo = *(const s16x4*)vp, h8 = *(const s16x4*)(vp + 8);
                    vf[i][s2] = (bf16x8){lo[0], lo[1], lo[2], lo[3], h8[0], h8[1], h8[2], h8[3]}; }
            f32x16 S;
#pragma unroll
            for (int q = 0; q < 16; ++q) S[q] = 0.f;
#pragma unroll
            for (int d0 = 0; d0 < 4; ++d0) S = __builtin_amdgcn_mfma_f32_32x32x16_bf16(kf[d0], qf[d0], S, 0, 0, 0);
            float mx = S[0];
#pragma unroll
            for (int q = 1; q < 16; ++q) mx = fmaxf(mx, S[q]);
            mx = fmaxf(mx, __shfl_xor(mx, 32));
            if (s == 0) mref = mx;
            else if (__any(mx > mref)) { const float mn = fmaxf(mref, mx); const float al = __builtin_amdgcn_exp2f(mref - mn); l *= al; mref = mn;
#pragma unroll
                for (int i = 0; i < 4; ++i)
#pragma unroll
                    for (int q = 0; q < 16; ++q) o[i][q] *= al; }
            float ps = 0.f;
#pragma unroll
            for (int q = 0; q < 16; ++q) { S[q] = __builtin_amdgcn_exp2f(S[q] - mref); ps += S[q]; }
            l += ps;
            bf16x8 pf[2];
#pragma unroll
            for (int s2 = 0; s2 < 2; ++s2) { u32x4 w; w.x = pk2(S[8 * s2], S[8 * s2 + 1]); w.y = pk2(S[8 * s2 + 2], S[8 * s2 + 3]); w.z = pk2(S[8 * s2 + 4], S[8 * s2 + 5]); w.w = pk2(S[8 * s2 + 6], S[8 * s2 + 7]); pf[s2] = __builtin_bit_cast(bf16x8, w); }
#pragma unroll
            for (int i = 0; i < 4; ++i)
#pragma unroll
                for (int s2 = 0; s2 < 2; ++s2) o[i] = __builtin_amdgcn_mfma_f32_32x32x16_bf16(vf[i][s2], pf[s2], o[i], 0, 0, 0);
        }
        l += __shfl_xor(l, 32);
        const float f = (m == 1 ? lmb : 1.0f) / l;
        LAS float* ex = EX + (size_t)m * 128 * 129 + (qs * 32 + r) * 129;
#pragma unroll
        for (int i = 0; i < 4; ++i)
#pragma unroll
            for (int q = 0; q < 16; ++q) ex[32 * i + crow(q, hi)] = o[i][q] * f;
        __syncthreads();
#pragma unroll 1
        for (int rr = 0; rr < 16; ++rr) { const int row = 16 * F.wave + rr;
            const float a0 = EX[row * 129 + F.lane] - EX[128 * 129 + row * 129 + F.lane], a1 = EX[row * 129 + 64 + F.lane] - EX[128 * 129 + row * 129 + 64 + F.lane];
            const float rstd = (1.0f - LAMBDA_INIT) / sqrtf(wave_sum(a0 * a0 + a1 * a1) * (1.f / 128.f) + EPS);
            bf16* yr = Y + (size_t)(qrow0 + row) * D + h * 128;
            yr[F.lane] = (bf16)(pk2(a0 * rstd * ng[F.lane], 0.f) & 0xffffu); yr[64 + F.lane] = (bf16)(pk2(a1 * rstd * ng[64 + F.lane], 0.f) & 0xffffu); }
        __syncthreads();
    }
}

enum { OP_PRO = 0, OP_N1, OP_GIN, OP_SCAN, OP_GNORM, OP_CONV, OP_ROPE, OP_ATTN, OP_GOUT, OP_N2, OP_UP, OP_DOWN, OP_FINAL };
constexpr int NSTEPS = 1 + 8 + 7 + 8 + 8 + 1;
__host__ __device__ __forceinline__ void decode_step(int step, int& op, int& layer) {
    if (step == 0) { op = OP_PRO; layer = 0; return; }
    int s = step - 1;
    for (int i = 0; i < DEPTH; ++i) {
        const int kind = i % 3, n = kind == 1 ? 7 : 8;
        if (s < n) { layer = i;
            if (s == 0) op = OP_N1; else if (s == 1) op = OP_GIN;
            else { const int tail = n - s;
                if (tail == 4) op = OP_GOUT; else if (tail == 3) op = OP_N2; else if (tail == 2) op = OP_UP; else if (tail == 1) op = OP_DOWN;
                else if (kind == 0) op = (s == 2 ? OP_SCAN : OP_GNORM); else if (kind == 1) op = OP_CONV; else op = (s == 2 ? OP_ROPE : OP_ATTN); }
            return; }
        s -= n;
    }
    op = OP_FINAL; layer = DEPTH;
}

#ifndef MK_SINGLE
#define MK_SINGLE 1
#endif

__global__ void __launch_bounds__(NTHR, 2) fwd_kernel(Args a) {
    unsigned char* ws = a.ws;
    for (int step = a.step_lo; step < a.step_hi; ++step) {
        int op, layer; decode_step(step, op, layer);
        op = __builtin_amdgcn_readfirstlane(op); layer = __builtin_amdgcn_readfirstlane(layer);
        const int kind = layer % 3, jj = layer / 3; const bool last = layer == DEPTH - 1;
        const int Mrows = last ? ML : M;
        __syncthreads();
        int G_ = gridDim.x, B_ = blockIdx.x; asm volatile("" : "+s"(G_), "+s"(B_));
        switch (op) {
        case OP_PRO:
#ifndef NO_PRO
            step_prologue();
#endif
            break;
        #ifndef NO_NORM
        case OP_N1: step_norm(layer, 0, M, kind == 0); break;
        case OP_N2: step_norm(layer, 1, Mrows, false); break;
#endif
#ifndef NO_GIN
        case OP_GIN: {
            const bf16* Bt = kind == 0 ? (const bf16*)(ws + WS_GINT) + (size_t)jj * GDN_NP * D : (kind == 1 ? (const bf16*)(ws + WS_SINT) : (const bf16*)(ws + WS_DINT));
            const int N = kind == 0 ? GDN_NP : 3 * D, ldc = kind == 0 ? 4096 : 3 * D;
            pg8::Gemm g{(const bf16*)(ws + WS_H), Bt, M, N, D}; pg8::StaticOrder S; S.init(M, N, G_, B_);
            pg8::EpiStore<0> E{(bf16*)(ws + WS_Z), ldc, (float*)(ws + WS_AB), kind == 0 ? 16 : -1};
            pg8::gemm_phase<pg8::EpiStore<0>, pg8::StaticOrder, true, true>((LAS unsigned char*)lds_raw, g, S, E);
        } break;
#endif
#ifndef NO_UP
        case OP_UP: {
            pg8::Gemm g{(const bf16*)(ws + WS_H), (const bf16*)(ws + WS_W1T) + (size_t)layer * D * FF, Mrows, FF, D}; pg8::StaticOrder S; S.init(Mrows, FF, G_, B_);
            pg8::EpiStore<1> E{(bf16*)(ws + WS_Z), FF, nullptr, -1};
            pg8::gemm_phase<pg8::EpiStore<1>, pg8::StaticOrder, true, true>((LAS unsigned char*)lds_raw, g, S, E);
        } break;
#endif
#ifndef NO_RES
        case OP_GOUT: case OP_DOWN: {
            const bool dn = op == OP_DOWN;
            const bf16* A = dn ? (const bf16*)(ws + WS_Z) : (const bf16*)(ws + WS_Y);
            const bf16* Bt = dn ? (const bf16*)(ws + WS_W2T) + (size_t)layer * D * FF
                                : (kind == 0 ? (const bf16*)(ws + WS_GOUTT) + (size_t)jj * D * D : (kind == 1 ? (const bf16*)(ws + WS_SOUTT) : (const bf16*)(ws + WS_DOUTT)));
            const int K = dn ? FF : D;
            pg8::Gemm g{A, Bt, Mrows, D, K}; pg8::StaticOrder S; S.init(Mrows, D, G_, B_);
            pg8::EpiResid E{(float*)(ws + WS_X), D, (const float*)(ws + WS_MOD) + (size_t)layer * 3 * NADA + (dn ? 5 : 2) * D, NADA};
            pg8::gemm_phase<pg8::EpiResid, pg8::StaticOrder, true, true>((LAS unsigned char*)lds_raw, g, S, E);
        } break;
#endif
        case OP_SCAN:
#ifndef NO_SCAN
            step_gdn_scan(jj);
#endif
            break;
        #ifndef NO_GNORM
        case OP_GNORM: step_gdn_norm(jj); break;
#endif
        #ifndef NO_CONV
        case OP_CONV: step_sconv(); break;
#endif
        case OP_ROPE:
#ifndef NO_ROPE
            step_rope();
#endif
            break;
        case OP_ATTN:
#ifndef NO_ATTN
            step_attn();
#endif
            break;
        default:
#ifndef NO_FINAL
            step_final();
#endif
            break;
        }
        if (step + 1 < a.step_hi) { if (a.coop) cg::this_grid().sync(); }
    }
}

extern "C" void kernel_launch(void* const* d_in, const int* in_sizes, int n_in, void* d_out, int out_size, void* d_ws, size_t ws_size, hipStream_t stream) {
    static int grid = 0;
    if (grid == 0) {
        if (n_in != 24 || out_size != ML * D || ws_size < WS_END) { fprintf(stderr, "kernel_launch: unexpected problem (n_in %d, out %d, ws %zu); nothing launched\n", n_in, out_size, ws_size); grid = -1; return; }
        int dev = 0, cus = 0, per_cu = 0;
        if (hipGetDevice(&dev) != hipSuccess || hipDeviceGetAttribute(&cus, hipDeviceAttributeMultiprocessorCount, dev) != hipSuccess) { grid = -1; return; }
        if (hipFuncSetAttribute((const void*)fwd_kernel, hipFuncAttributeMaxDynamicSharedMemorySize, LDS_BYTES) != hipSuccess) { fprintf(stderr, "kernel_launch: hipFuncSetAttribute failed\n"); grid = -1; return; }
        if (hipOccupancyMaxActiveBlocksPerMultiprocessor(&per_cu, (const void*)fwd_kernel, NTHR, LDS_BYTES) != hipSuccess || per_cu < 1) { fprintf(stderr, "kernel_launch: occupancy query says %d blocks per CU\n", per_cu); (void)hipGetLastError(); per_cu = 1; }
        grid = cus;
        fprintf(stderr, "kernel_launch: %d CUs, occupancy %d per CU, grid %d\n", cus, per_cu, grid);
    }
    if (grid < 0) return;
    (void)hipMemsetAsync((char*)d_ws + WS_CTL, 0, CTL_ZERO_BYTES, stream);
    Args a{};
    for (int i = 0; i < 24; ++i) a.in[i] = (const float*)d_in[i];
    a.out = (float*)d_out; a.ws = (unsigned char*)d_ws;
#if MK_SINGLE
    a.step_lo = 0; a.step_hi = NSTEPS; a.coop = 1;
    void* args[] = {&a};
    hipError_t e = hipLaunchCooperativeKernel((const void*)fwd_kernel, dim3(grid), dim3(NTHR), args, LDS_BYTES, stream);
    if (e != hipSuccess) fprintf(stderr, "cooperative launch failed: %s (grid %d)\n", hipGetErrorString(e), grid);
#else
    for (int s = 0; s < NSTEPS; ++s) { a.step_lo = s; a.step_hi = s + 1; a.coop = 0; hipLaunchKernelGGL(fwd_kernel, dim3(grid), dim3(NTHR), LDS_BYTES, stream, a); }
#endif
}
```

```cpp
#include <hip/hip_runtime.h>
#include <hip/hip_cooperative_groups.h>
#include <cstdio>
#include <cstdint>
namespace cg = cooperative_groups;
namespace pg8 {
#define PG8_LAS __attribute__((address_space(3)))
typedef unsigned short bf16_t;
typedef short bf16x8 __attribute__((ext_vector_type(8)));
typedef float f32x4 __attribute__((ext_vector_type(4)));
typedef unsigned u32x4 __attribute__((ext_vector_type(4)));
constexpr int BM = 256, BK = 64, HALF = 128, HTB = HALF * BK * 2  , STAGE_BYTES = 8 * HTB, NXCD = 8, WGM = 8;

__host__ __device__ __forceinline__ int lds_byte(int r, int c) { const int st = (r >> 4) * 2 + (c >> 5), rr = r & 15, cc = c & 31, ob = rr * 64 + cc * 2; return st * 1024 + (ob ^ (((ob >> 9) & 1) << 5)); }
__host__ __device__ __forceinline__ void stage_rc(int b, int& R, int& C) { const int st = b / 1024, sb = b % 1024, swz = sb ^ (((sb >> 9) & 1) << 5); R = (st >> 1) * 16 + swz / 64; C = (st & 1) * 32 + (swz % 64) / 2; }
__host__ __device__ __forceinline__ int perm32(int rho) { const int n = rho >> 4, i = rho & 15; return 8 * (i >> 2) + 4 * n + (i & 3); }

struct Unit { int pm, pn; };
struct Gemm { const bf16_t* A; const bf16_t* Bt; int M, N, K; };

struct StaticOrder {
    int nM, nN, nwg, G, c;
    __host__ __device__ void init(int M, int N, int G_, int c_) { nM = M / BM; nN = N / BM; nwg = nM * nN; G = G_; c = c_; }
    __host__ __device__ bool next(int i, Unit& u) const {
        const long L = (long)i * G + c; if (L >= nwg) return false;
        int wgid = (int)L; { const int q = nwg / NXCD, r = nwg % NXCD, xcd = wgid % NXCD, off = wgid / NXCD; wgid = (xcd < r ? xcd * (q + 1) : r * (q + 1) + (xcd - r) * q) + off; }
        const int nig = WGM * nN, gid = wgid / nig, fm = gid * WGM, gsz = (nM - fm) < WGM ? (nM - fm) : WGM;
        u.pm = fm + ((wgid % nig) % gsz); u.pn = (wgid % nig) / gsz; return true;
    }
    __device__ __forceinline__ void a_ready(const Unit&) const {}
    __device__ __forceinline__ void done(const Unit&) const {}
};

typedef float f32x2 __attribute__((ext_vector_type(2)));
typedef __bf16 bf16x2_t __attribute__((ext_vector_type(2)));
__device__ __forceinline__ unsigned cvt_pk_bf16(float lo, float hi) { f32x2 v = {lo, hi}; bf16x2_t b = __builtin_convertvector(v, bf16x2_t); return __builtin_bit_cast(unsigned, b); }

template <int ACT> struct EpiStore {
    static constexpr bool PERM = true, AFTER_DRAIN = false;
    bf16_t* O; int ldc; float* AB; int ab_tile; bf16_t* halo;
    __device__ __forceinline__ void operator()(const f32x4 (&acc)[2][2][4][2], const Unit& u, int wr, int wc, int fr, int fq) const {
        const int row0 = u.pm * BM + wr * 64 + fr;
        if (u.pn == ab_tile) {
            if (wc == 0) {
#pragma unroll
                for (int ai = 0; ai < 2; ++ai)
#pragma unroll
                    for (int m = 0; m < 4; ++m) { float* p = AB + (size_t)(row0 + ai * HALF + m * 16) * 32 + 8 * fq; *(f32x4*)p = acc[ai][0][m][0]; *(f32x4*)(p + 4) = acc[ai][0][m][1]; }
            }
            return;
        }
        const int col0 = u.pn * BM + wc * 32 + 8 * fq;
#pragma unroll
        for (int ai = 0; ai < 2; ++ai)
#pragma unroll
            for (int m = 0; m < 4; ++m) { bf16_t* rowp = O + (size_t)(row0 + ai * HALF + m * 16) * ldc + col0;
#pragma unroll
                for (int bj = 0; bj < 2; ++bj) { f32x4 v0 = acc[ai][bj][m][0], v1 = acc[ai][bj][m][1];
                    if (ACT == 1) {
#pragma unroll
                        for (int i = 0; i < 4; ++i) { const float a = fmaxf(v0[i], 0.f), b = fmaxf(v1[i], 0.f); v0[i] = a * a; v1[i] = b * b; } }
                    u32x4 w; w.x = cvt_pk_bf16(v0[0], v0[1]); w.y = cvt_pk_bf16(v0[2], v0[3]); w.z = cvt_pk_bf16(v1[0], v1[1]); w.w = cvt_pk_bf16(v1[2], v1[3]);
                    *(u32x4*)(rowp + bj * HALF) = w;
                    if (halo && u.pn < 12 && ((m == 0 && fr == 0) || (m == 3 && fr == 15))) { const int row = row0 + ai * HALF + m * 16;
                        *(u32x4*)(halo + ((size_t)(row >> 6) * 2 + (m == 3 ? 1 : 0)) * 3072 + col0 + bj * HALF) = w; } } }
    }
};
struct EpiResid {
    static constexpr bool PERM = false, AFTER_DRAIN = false;
    float* X; int ldc; const float* gate; int gstride;
    __device__ __forceinline__ void operator()(const f32x4 (&acc)[2][2][4][2], const Unit& u, int wr, int wc, int fr, int fq) const {
        const int row0 = u.pm * BM + wr * 64 + fr, col0 = u.pn * BM + wc * 32 + 4 * fq;
        const float* g = gate + (size_t)(u.pm < 32 ? 0 : (u.pm < 64 ? 1 : 2)) * gstride + col0;
        f32x4 gv[2][2];
#pragma unroll
        for (int bj = 0; bj < 2; ++bj)
#pragma unroll
            for (int n = 0; n < 2; ++n) gv[bj][n] = *(const f32x4*)(g + bj * HALF + n * 16);
#pragma unroll
        for (int ai = 0; ai < 2; ++ai)
#pragma unroll
            for (int m = 0; m < 4; ++m) { float* p = X + (size_t)(row0 + ai * HALF + m * 16) * ldc + col0;
#pragma unroll
                for (int bj = 0; bj < 2; ++bj)
#pragma unroll
                    for (int n = 0; n < 2; ++n) { float* q = p + bj * HALF + n * 16; *(f32x4*)q = *(const f32x4*)q + gv[bj][n] * acc[ai][bj][m][n]; }
                if (m & 1) asm volatile("" ::: "memory"); }
    }
};

template <class Epi, class Sched, bool ALIGN_EPI = false, bool SP2 = false>
__device__ __forceinline__ void gemm_phase(PG8_LAS unsigned char* lds, const Gemm g, const Sched& S, const Epi& E) {
    int tid_ = threadIdx.x; asm volatile("" : "+v"(tid_)); const int tid = tid_, wid = __builtin_amdgcn_readfirstlane(tid >> 6), lane = tid & 63, wr = wid >> 2, wc = wid & 3, fr = lane & 15, fq = lane >> 4;
    const int K = g.K, nt = K / BK;
    unsigned voffA[2], voffB[2];
#pragma unroll
    for (int i = 0; i < 2; ++i) { int R, C; stage_rc(tid * 16 + i * 8192, R, C); const int Rb = Epi::PERM ? ((R & ~31) + perm32(R & 31)) : R;
        voffA[i] = (unsigned)(R * K + C) * 2u; voffB[i] = (unsigned)(Rb * K + C) * 2u; }
    const size_t kstep = (size_t)(BK * 2);
    const size_t hstep = (size_t)HALF * K * 2;
    const size_t tstep = 2 * hstep;
    const unsigned ldsw = (unsigned)wid * 1024u;
    const int aoff = lds_byte(wr * 64 + fr, fq * 8), boff = lds_byte(wc * 32 + fr, fq * 8);
#define PG8_SA(b, h) (((b) * 2 + (h)) * HTB)
#define PG8_SB(b, h) ((4 + (b) * 2 + (h)) * HTB)
#define PG8_STAGE(bufoff, gbase, voff) do { _Pragma("unroll") for (int _i = 0; _i < 2; ++_i) \
        __builtin_amdgcn_global_load_lds((const unsigned*)((const char*)(gbase) + (voff)[_i]), (PG8_LAS unsigned*)(lds + (bufoff) + ldsw + _i * 8192), 16, 0, 0); } while (0)
#define PG8_LDA(dst, b, h) do { _Pragma("unroll") for (int m = 0; m < 4; ++m) _Pragma("unroll") for (int k = 0; k < 2; ++k) dst[m][k] = *(const PG8_LAS bf16x8*)(lds + PG8_SA(b, h) + aoff + m * 2048 + k * 1024); } while (0)
#define PG8_LDB(dst, b, h) do { _Pragma("unroll") for (int n = 0; n < 2; ++n) _Pragma("unroll") for (int k = 0; k < 2; ++k) dst[n][k] = *(const PG8_LAS bf16x8*)(lds + PG8_SB(b, h) + boff + n * 2048 + k * 1024); } while (0)
#define PG8_MMA(ai, bj, At, Bt) do { __builtin_amdgcn_s_setprio(1); _Pragma("unroll") for (int m = 0; m < 4; ++m) _Pragma("unroll") for (int n = 0; n < 2; ++n) _Pragma("unroll") for (int k = 0; k < 2; ++k) \
        acc[ai][bj][m][n] = __builtin_amdgcn_mfma_f32_16x16x32_bf16(Bt[n][k], At[m][k], acc[ai][bj][m][n], 0, 0, 0); __builtin_amdgcn_s_setprio(0); } while (0)
#define PG8_WAIT_V(n) asm volatile("s_waitcnt vmcnt(" #n ")" ::: "memory")
#define PG8_WAIT_L(n) asm volatile("s_waitcnt lgkmcnt(" #n ")" ::: "memory")
#define PG8_BAR __builtin_amdgcn_s_barrier()
#define PG8_SCHED __builtin_amdgcn_sched_barrier(0)
    Unit cur, nxt; int ui = 0;
    if (!S.next(0, cur)) return;
    f32x4 acc[2][2][4][2];
#pragma unroll
    for (int a = 0; a < 2; ++a)
#pragma unroll
        for (int b = 0; b < 2; ++b)
#pragma unroll
            for (int m = 0; m < 4; ++m)
#pragma unroll
                for (int n = 0; n < 2; ++n) acc[a][b][m][n] = (f32x4){0.f, 0.f, 0.f, 0.f};
    bf16x8 At[4][2], B0[2][2], B1[2][2];
    const char* cA = (const char*)g.A + (size_t)cur.pm * tstep; const char* cB = (const char*)g.Bt + (size_t)cur.pn * tstep;
    S.a_ready(cur);
    if constexpr (SP2) {
        PG8_STAGE(PG8_SB(0, 0), cB, voffB); PG8_STAGE(PG8_SB(0, 1), cB + hstep, voffB); PG8_STAGE(PG8_SA(0, 0), cA, voffA); PG8_STAGE(PG8_SA(0, 1), cA + hstep, voffA);
        if (wr == 1) PG8_BAR;
        PG8_WAIT_V(2); PG8_BAR;
        PG8_STAGE(PG8_SB(1, 0), cB + kstep, voffB); PG8_STAGE(PG8_SA(1, 0), cA + kstep, voffA); PG8_STAGE(PG8_SB(1, 1), cB + hstep + kstep, voffB);
        PG8_WAIT_V(6); PG8_BAR;
    } else {
        PG8_STAGE(PG8_SB(0, 0), cB, voffB); PG8_STAGE(PG8_SA(0, 0), cA, voffA); PG8_STAGE(PG8_SB(0, 1), cB + hstep, voffB); PG8_STAGE(PG8_SA(0, 1), cA + hstep, voffA);
        if (wr == 1) PG8_BAR;
        PG8_WAIT_V(4); PG8_BAR;
        PG8_STAGE(PG8_SB(1, 0), cB + kstep, voffB); PG8_STAGE(PG8_SA(1, 0), cA + kstep, voffA); PG8_STAGE(PG8_SB(1, 1), cB + hstep + kstep, voffB);
        PG8_WAIT_V(6); PG8_BAR;
    }
    for (;;) {
        const bool has_next = S.next(ui + 1, nxt);
        const char* nA = has_next ? (const char*)g.A + (size_t)nxt.pm * tstep : cA; const char* nB = has_next ? (const char*)g.Bt + (size_t)nxt.pn * tstep : cB;
        for (int t = 0; t < nt; t += 2) {
            const bool last = (t == nt - 2);
            const char* a1 = cA + (size_t)(t + 1) * kstep;
            const char* a2 = last ? nA : cA + (size_t)(t + 2) * kstep; const char* b2 = last ? nB : cB + (size_t)(t + 2) * kstep;
            const char* a3 = a2 + kstep; const char* b3 = b2 + kstep;
            if (last && has_next) S.a_ready(nxt);
            if constexpr (SP2) {
            PG8_LDB(B0, 0, 0); PG8_LDB(B1, 0, 1); PG8_SCHED; PG8_LDA(At, 0, 0); PG8_STAGE(PG8_SA(1, 1), a1 + hstep, voffA);
            PG8_WAIT_V(8); PG8_WAIT_L(0); PG8_BAR; PG8_MMA(0, 0, At, B0); PG8_MMA(0, 1, At, B1); PG8_BAR; PG8_SCHED;
            PG8_LDA(At, 0, 1); PG8_STAGE(PG8_SB(0, 0), b2, voffB); PG8_STAGE(PG8_SB(0, 1), b2 + hstep, voffB); PG8_STAGE(PG8_SA(0, 0), a2, voffA);
            PG8_WAIT_V(8); PG8_WAIT_L(0); PG8_BAR; PG8_MMA(1, 0, At, B0); PG8_MMA(1, 1, At, B1); PG8_BAR; PG8_SCHED;
            PG8_LDB(B0, 1, 0); PG8_LDB(B1, 1, 1); PG8_SCHED; PG8_LDA(At, 1, 0); PG8_STAGE(PG8_SA(0, 1), a2 + hstep, voffA);
            PG8_WAIT_V(8); PG8_WAIT_L(0); PG8_BAR; PG8_MMA(0, 0, At, B0); PG8_MMA(0, 1, At, B1); PG8_BAR; PG8_SCHED;
            PG8_LDA(At, 1, 1); PG8_STAGE(PG8_SB(1, 0), b3, voffB); PG8_STAGE(PG8_SB(1, 1), b3 + hstep, voffB); PG8_STAGE(PG8_SA(1, 0), a3, voffA);
            PG8_WAIT_V(8); PG8_WAIT_L(0); PG8_BAR; PG8_MMA(1, 0, At, B0); PG8_MMA(1, 1, At, B1); PG8_BAR; PG8_SCHED;
            } else {
            PG8_LDB(B0, 0, 0); PG8_SCHED; PG8_LDA(At, 0, 0); PG8_STAGE(PG8_SA(1, 1), a1 + hstep, voffA);
            PG8_WAIT_L(8); PG8_BAR; PG8_WAIT_L(0); PG8_MMA(0, 0, At, B0); PG8_BAR; PG8_SCHED;
            PG8_LDB(B1, 0, 1); PG8_STAGE(PG8_SB(0, 0), b2, voffB);
            PG8_BAR; PG8_WAIT_L(0); PG8_MMA(0, 1, At, B1); PG8_BAR;
            PG8_LDA(At, 0, 1); PG8_STAGE(PG8_SA(0, 0), a2, voffA);
            PG8_BAR; PG8_WAIT_L(0); PG8_MMA(1, 0, At, B0); PG8_BAR; PG8_SCHED;
            PG8_STAGE(PG8_SB(0, 1), b2 + hstep, voffB);
            PG8_WAIT_V(6); PG8_BAR; PG8_MMA(1, 1, At, B1); PG8_BAR;
            PG8_LDB(B0, 1, 0); PG8_SCHED; PG8_LDA(At, 1, 0); PG8_STAGE(PG8_SA(0, 1), a2 + hstep, voffA);
            PG8_WAIT_L(8); PG8_BAR; PG8_WAIT_L(0); PG8_MMA(0, 0, At, B0); PG8_BAR; PG8_SCHED;
            PG8_LDB(B1, 1, 1); PG8_STAGE(PG8_SB(1, 0), b3, voffB);
            PG8_BAR; PG8_WAIT_L(0); PG8_MMA(0, 1, At, B1); PG8_BAR;
            PG8_LDA(At, 1, 1); PG8_STAGE(PG8_SA(1, 0), a3, voffA);
            PG8_BAR; PG8_WAIT_L(0); PG8_MMA(1, 0, At, B0); PG8_BAR; PG8_SCHED;
            PG8_STAGE(PG8_SB(1, 1), b3 + hstep, voffB);
            PG8_WAIT_V(6); PG8_BAR; PG8_MMA(1, 1, At, B1); PG8_BAR;
            }
        }
        if constexpr (ALIGN_EPI) { if (wr == 0) PG8_BAR; }
        if constexpr (!Epi::AFTER_DRAIN) { E(acc, cur, wr, wc, fr, fq); S.done(cur); }
        if (!has_next) break;
#pragma unroll
        for (int a = 0; a < 2; ++a)
#pragma unroll
            for (int b = 0; b < 2; ++b)
#pragma unroll
                for (int m = 0; m < 4; ++m)
#pragma unroll
                    for (int n = 0; n < 2; ++n) acc[a][b][m][n] = (f32x4){0.f, 0.f, 0.f, 0.f};
        cur = nxt; cA = nA; cB = nB; ++ui;
        if constexpr (ALIGN_EPI) { if (wr == 1) PG8_BAR; }
    }
    PG8_WAIT_V(0);
    if constexpr (!ALIGN_EPI) { if (wr == 0) PG8_BAR; }
    PG8_BAR;
    if constexpr (Epi::AFTER_DRAIN) { E.fused(acc, cur, wr, wc, fr, fq, lds, wid, lane); S.done(cur); }
#undef PG8_SA
#undef PG8_SB
#undef PG8_STAGE
#undef PG8_LDA
#undef PG8_LDB
#undef PG8_MMA
#undef PG8_WAIT_V
#undef PG8_WAIT_L
#undef PG8_BAR
#undef PG8_SCHED
}
}

constexpr int D = 1024, NB = 2, T = 8192, CT = 256, DEPTH = 4, FF = 4096;
constexpr int ML = NB * T, MC = NB * CT, M = ML + MC;
constexpr int NADA = 6 * D;
constexpr int GDN_N = 4128, GDN_NP = 4352;
constexpr int NH = 8, HD = 128;
constexpr int NKV = CT + T;
constexpr float EPS = 1e-6f;
constexpr int NWAVES = 8, NTHR = 512;
constexpr float QSCALE = 0.125f * 1.4426950408889634f;
constexpr float LAMBDA_INIT = 0.47071302f;

constexpr size_t MiB = 1u << 20;
constexpr size_t WS_CTL = 0, CTL_ZERO_BYTES = 1 * MiB;
constexpr size_t WS_MOD = 1 * MiB;
constexpr size_t WS_ROPE = 2 * MiB;
constexpr size_t WS_AB = 4 * MiB;
constexpr size_t WS_OFC = 7 * MiB;
constexpr size_t WS_W1T = 10 * MiB, WS_W2T = 42 * MiB, WS_GINT = 74 * MiB, WS_GOUTT = 91 * MiB, WS_SINT = 95 * MiB, WS_SOUTT = 101 * MiB, WS_DINT = 103 * MiB, WS_DOUTT = 109 * MiB;
constexpr size_t WS_X = 112 * MiB;
constexpr size_t WS_H = 178 * MiB;
constexpr size_t WS_Y = 211 * MiB;
constexpr size_t WS_Z = 244 * MiB;
constexpr size_t WS_HALO = 376 * MiB;
constexpr size_t WS_END = 380 * MiB;
constexpr size_t WS_PD = WS_H;

constexpr int LDS_BYTES = 147456;

#define LAS __attribute__((address_space(3)))
typedef unsigned short bf16;
typedef unsigned u32x4 __attribute__((ext_vector_type(4)));
typedef unsigned u32x2 __attribute__((ext_vector_type(2)));
typedef float f32x4 __attribute__((ext_vector_type(4)));
typedef float f32x2 __attribute__((ext_vector_type(2)));
typedef float f32x16 __attribute__((ext_vector_type(16)));
typedef short bf16x8 __attribute__((ext_vector_type(8)));
typedef short s16x4 __attribute__((ext_vector_type(4)));
#define LDS_WAIT() asm volatile("s_waitcnt lgkmcnt(0)" ::: "memory")

__device__ __forceinline__ float bf2f(unsigned u) { return __uint_as_float(u << 16); }
__device__ __forceinline__ unsigned pk2(float lo, float hi) { return pg8::cvt_pk_bf16(lo, hi); }
__device__ __forceinline__ float wave_sum(float v) {
#pragma unroll
    for (int o = 1; o < 64; o <<= 1) v += __shfl_xor(v, o);
    return v;
}
__device__ __forceinline__ float silu_f(float x) { return x / (1.f + expf(-x)); }
__device__ __forceinline__ int crow(int r, int hi) { return (r & 3) + 8 * (r >> 2) + 4 * hi; }

struct Args { const float* in[24]; float* out; unsigned char* ws; int step_lo, step_hi, coop, pad; };
typedef const __attribute__((address_space(4))) Args* KArgs;
__device__ __forceinline__ KArgs kargs() { unsigned long long p = (unsigned long long)__builtin_amdgcn_kernarg_segment_ptr(); asm volatile("" : "+s"(p)); return (KArgs)p; }
#define INP(k) (kargs()->in[k])
extern __shared__ __attribute__((aligned(16))) unsigned char lds_raw[];
struct Frame { LAS unsigned char* lds; int tid, lane, wave, G, bid; float* out; unsigned char* ws; };
__device__ __forceinline__ Frame make_frame() {
    Frame F; F.lds = (LAS unsigned char*)lds_raw; F.tid = threadIdx.x; asm volatile("" : "+v"(F.tid)); F.lane = F.tid & 63; F.wave = __builtin_amdgcn_readfirstlane(F.tid >> 6); F.G = gridDim.x; F.bid = blockIdx.x; asm volatile("" : "+s"(F.G), "+s"(F.bid));
    KArgs a = kargs(); F.out = a->out; F.ws = a->ws; return F;
}
enum { I_X = 0, I_C, I_CTX, I_CCTX, I_N1G, I_N2G, I_ADAW, I_ADAB, I_W1, I_W2, I_GIN, I_GCONV, I_GALOG, I_GDT, I_GNG, I_GOUT, I_SIN, I_SCONV, I_SOUT, I_DIN, I_DLAM, I_DNG, I_DOUT, I_FG };

__device__ __forceinline__ void transpose_item(const float* W, int K, int ldw, bf16* WT, LAS float* scr, int item, int nblk, int lane) {
    const int kb = item / nblk, nb = item % nblk, k0 = 64 * kb, n0 = 32 * nb;
#pragma unroll 8
    for (int i = 0; i < 32; ++i) { const int kk = 2 * i + (lane >> 5); scr[kk * 33 + (lane & 31)] = W[(size_t)(k0 + kk) * ldw + n0 + (lane & 31)]; }
    LDS_WAIT(); asm volatile("" ::: "memory");
    const int c = lane & 7;
#pragma unroll
    for (int j = 0; j < 4; ++j) { const int n = (lane >> 3) + 8 * j; const LAS float* s = scr + (8 * c) * 33 + n;
        u32x4 o; o.x = pk2(s[0 * 33], s[1 * 33]); o.y = pk2(s[2 * 33], s[3 * 33]); o.z = pk2(s[4 * 33], s[5 * 33]); o.w = pk2(s[6 * 33], s[7 * 33]);
        *(u32x4*)(WT + (size_t)(n0 + n) * K + k0 + 8 * c) = o; }
    LDS_WAIT(); asm volatile("" ::: "memory");
}
__device__ __forceinline__ void get_mat(unsigned char* ws_, int idx, const float*& src, bf16*& dst, int& K, int& N, int& ld) {
    unsigned char* ws = ws_;
    if (idx < 4)       { src = INP(I_W1) + (size_t)idx * D * FF; dst = (bf16*)(ws + WS_W1T) + (size_t)idx * D * FF; K = D; N = FF; ld = FF; }
    else if (idx < 8)  { const int i = idx - 4; src = INP(I_W2) + (size_t)i * D * FF; dst = (bf16*)(ws + WS_W2T) + (size_t)i * D * FF; K = FF; N = D; ld = D; }
    else if (idx < 10) { const int j = idx - 8; src = INP(I_GIN) + (size_t)j * D * GDN_N; dst = (bf16*)(ws + WS_GINT) + (size_t)j * GDN_NP * D; K = D; N = GDN_N; ld = GDN_N; }
    else if (idx < 12) { const int j = idx - 10; src = INP(I_GOUT) + (size_t)j * D * D; dst = (bf16*)(ws + WS_GOUTT) + (size_t)j * D * D; K = D; N = D; ld = D; }
    else if (idx == 12) { src = INP(I_SIN); dst = (bf16*)(ws + WS_SINT); K = D; N = 3 * D; ld = 3 * D; }
    else if (idx == 13) { src = INP(I_SOUT); dst = (bf16*)(ws + WS_SOUTT); K = D; N = D; ld = D; }
    else if (idx == 14) { src = INP(I_DIN); dst = (bf16*)(ws + WS_DINT); K = D; N = 3 * D; ld = 3 * D; }
    else { src = INP(I_DOUT); dst = (bf16*)(ws + WS_DOUTT); K = D; N = D; ld = D; }
}
__device__ __forceinline__ void step_prologue() {
    const Frame F = make_frame();
    const int gw = F.bid * NWAVES + F.wave, NGW = F.G * NWAVES;
    const int gt = F.bid * NTHR + F.tid, NGT = F.G * NTHR;
    {
        LAS float* scr = (LAS float*)(F.lds + F.wave * 16384);
        for (int mi = 0; mi < 16; ++mi) {
            const float* src; bf16* dst; int K, N, ld; get_mat(F.ws, mi, src, dst, K, N, ld);
            const int nblk = N / 32, nitems = (K / 64) * nblk;
            for (int it = gw; it < nitems; it += NGW) transpose_item(src, K, ld, dst, scr, it, nblk, F.lane);
        }
        for (int j = 0; j < 2; ++j) { u32x4* z = (u32x4*)((bf16*)(F.ws + WS_GINT) + (size_t)j * GDN_NP * D + (size_t)GDN_N * D);
            for (int i = gt; i < (GDN_NP - GDN_N) * D / 8; i += NGT) z[i] = (u32x4){0u, 0u, 0u, 0u}; }
    }
    __syncthreads();
    {
        LAS float* sv = (LAS float*)F.lds;
        LAS float* red = sv + 3 * D;
        for (int i = F.tid; i < 3 * D; i += NTHR) { const int g = i / D, k = i % D; const float c = g < 2 ? INP(I_C)[g * D + k] : INP(I_CCTX)[k]; sv[i] = silu_f(c); }
        __syncthreads();
        float* MOD = (float*)(F.ws + WS_MOD);
        const int c = F.tid & 63, ks = F.tid >> 6;
        for (int it = F.bid; it < DEPTH * (NADA / 64); it += F.G) {
            const int li = it / (NADA / 64), n0 = (it % (NADA / 64)) * 64;
            const float* w = INP(I_ADAW) + (size_t)li * D * NADA + (size_t)(ks * 128) * NADA + n0 + c;
            float a0 = 0.f, a1 = 0.f, a2 = 0.f;
#pragma unroll 8
            for (int k = 0; k < 128; ++k) { const float wv = w[(size_t)k * NADA]; const int kk = ks * 128 + k; a0 += sv[kk] * wv; a1 += sv[D + kk] * wv; a2 += sv[2 * D + kk] * wv; }
            red[(ks * 3 + 0) * 64 + c] = a0; red[(ks * 3 + 1) * 64 + c] = a1; red[(ks * 3 + 2) * 64 + c] = a2;
            __syncthreads();
            if (F.tid < 192) { const int g = F.tid >> 6; float s = INP(I_ADAB)[li * NADA + n0 + c];
#pragma unroll
                for (int q = 0; q < 8; ++q) s += red[(q * 3 + g) * 64 + c];
                MOD[((size_t)li * 3 + g) * NADA + n0 + c] = s; }
            __syncthreads();
        }
    }
    {
        f32x4* X4 = (f32x4*)(F.ws + WS_X); const f32x4* x4 = (const f32x4*)INP(I_X); const f32x4* c4 = (const f32x4*)INP(I_CTX);
        for (int i = gt; i < M * (D / 4); i += NGT) X4[i] = i < ML * (D / 4) ? x4[i] : c4[i - ML * (D / 4)];
    }
    {
        f32x2* R = (f32x2*)(F.ws + WS_ROPE);
        for (int i = gt; i < T * 32; i += NGT) { const int t = i >> 5, p = i & 31, f = p & 15;
            const float inv = powf(10000.0f, -(float)f / 16.0f); const float pos = (float)(p < 16 ? (t >> 6) : (t & 63)); const float ang = pos * inv;
            R[i] = (f32x2){cosf(ang), sinf(ang)}; }
    }
}

__device__ __forceinline__ void step_norm(int layer, int which, int nrows, bool zero_of) {
    const Frame F = make_frame();
    const int gw = F.bid * NWAVES + F.wave, NGW = F.G * NWAVES;
    const float* X = (const float*)(F.ws + WS_X); bf16* H = (bf16*)(F.ws + WS_H);
    const float* ng = (which ? INP(I_N2G) : INP(I_N1G)) + layer * D;
    const float* MOD = (const float*)(F.ws + WS_MOD) + (size_t)layer * 3 * NADA + which * 3 * D;
    for (int row = gw; row < nrows; row += NGW) {
        const int grp = row < T ? 0 : (row < ML ? 1 : 2);
        const f32x4* xr = (const f32x4*)(X + (size_t)row * D) + F.lane;
        const f32x4* sh = (const f32x4*)(MOD + (size_t)grp * NADA) + F.lane; const f32x4* sc = (const f32x4*)(MOD + (size_t)grp * NADA + D) + F.lane; const f32x4* gg = (const f32x4*)ng + F.lane;
        f32x4 v[4]; float s = 0.f;
#pragma unroll
        for (int j = 0; j < 4; ++j) { v[j] = xr[64 * j]; s += (v[j].x * v[j].x + v[j].y * v[j].y) + (v[j].z * v[j].z + v[j].w * v[j].w); }
        const float rstd = 1.0f / sqrtf(wave_sum(s) * (1.f / D) + EPS);
        u32x2* o = (u32x2*)(H + (size_t)row * D) + F.lane;
#pragma unroll
        for (int j = 0; j < 4; ++j) { const f32x4 g4 = gg[64 * j], s4 = sc[64 * j], h4 = sh[64 * j]; const f32x4 y = (v[j] * rstd) * g4; const f32x4 h = y * (1.0f + s4) + h4;
            o[64 * j] = (u32x2){pk2(h.x, h.y), pk2(h.z, h.w)}; }
    }
    if (zero_of) {
        const int gt = F.bid * NTHR + F.tid, NGT = F.G * NTHR;
        f32x4* a = (f32x4*)F.out; for (int i = gt; i < ML * (D / 4); i += NGT) a[i] = (f32x4){0.f, 0.f, 0.f, 0.f};
        f32x4* b = (f32x4*)(F.ws + WS_OFC); for (int i = gt; i < MC * (D / 4); i += NGT) b[i] = (f32x4){0.f, 0.f, 0.f, 0.f};
    }
}
__device__ __forceinline__ void step_final() {
    const Frame F = make_frame();
    const int gw = F.bid * NWAVES + F.wave, NGW = F.G * NWAVES;
    const float* X = (const float*)(F.ws + WS_X);
    for (int row = gw; row < ML; row += NGW) {
        const f32x4* xr = (const f32x4*)(X + (size_t)row * D) + F.lane; const f32x4* gg = (const f32x4*)INP(I_FG) + F.lane;
        f32x4 v[4]; float s = 0.f;
#pragma unroll
        for (int j = 0; j < 4; ++j) { v[j] = xr[64 * j]; s += (v[j].x * v[j].x + v[j].y * v[j].y) + (v[j].z * v[j].z + v[j].w * v[j].w); }
        const float rstd = 1.0f / sqrtf(wave_sum(s) * (1.f / D) + EPS);
        f32x4* o = (f32x4*)(F.out + (size_t)row * D) + F.lane;
#pragma unroll
        for (int j = 0; j < 4; ++j) o[64 * j] = (v[j] * rstd) * gg[64 * j];
    }
}

__device__ __forceinline__ void step_gdn_scan(int j) {
    const Frame F = make_frame();
    LAS float* qs = (LAS float*)F.lds;
    LAS float* ks = qs + 64 * 128;
    LAS float* vs = ks + 64 * 128;
    LAS float* ga = vs + 64 * 128;
    LAS float* be = ga + 64;
    const bf16* Z = (const bf16*)(F.ws + WS_Z);
    const float* AB = (const float*)(F.ws + WS_AB);
    const float* cw = INP(I_GCONV) + (size_t)j * 3 * 3072;
    float* OFC = (float*)(F.ws + WS_OFC);
    for (int it = F.bid; it < 32; it += F.G) {
        const int b = it >> 4, h = (it >> 1) & 7, dir = it & 1;
        const float Aco = expf(INP(I_GALOG)[j * 16 + dir * 8 + h]); const float dtb = INP(I_GDT)[j * 16 + dir * 8 + h];
        float S[64];
#pragma unroll
        for (int i = 0; i < 64; ++i) S[i] = 0.f;
        const int jcol = F.tid >> 1, half = F.tid & 1;
        for (int n = 0; n < 132; ++n) {
            const bool isctx = n < 4; const int L = isctx ? CT : T; const int p0 = isctx ? 64 * n : 64 * (n - 4); const int rbase = isctx ? ML + b * CT : b * T;
            for (int idx = F.tid; idx < 64 * 384; idx += NTHR) {
                const int c = idx / 384, ch = idx % 384, part = ch >> 7, e = ch & 127;
                const int p = p0 + c; const int t = dir ? (L - 1 - p) : p; const int col = part * 1024 + h * 128 + e;
                float acc = 0.f;
#pragma unroll
                for (int tap = 0; tap < 3; ++tap) { const int tt = t + tap - 1; if (tt >= 0 && tt < L) acc += cw[tap * 3072 + col] * bf2f(Z[(size_t)(rbase + tt) * 4096 + col]); }
                acc = silu_f(acc);
                LAS float* dst = part == 0 ? qs : (part == 1 ? ks : vs); dst[c * 128 + e] = acc;
            }
            if (F.tid < 64) { const int p = p0 + F.tid; const int t = dir ? (L - 1 - p) : p; const size_t row = (size_t)(rbase + t);
                const float av = AB[row * 32 + dir * 8 + h], bv = AB[row * 32 + 16 + dir * 8 + h];
                const float x = av + dtb; const float sp = x > 20.f ? x : log1pf(expf(x));
                ga[F.tid] = expf(-Aco * sp); be[F.tid] = 1.f / (1.f + expf(-bv)); }
            __syncthreads();
#pragma unroll 1
            for (int rr = 0; rr < 8; ++rr) { const int c = F.wave * 8 + rr;
                const float q0 = qs[c * 128 + F.lane], q1 = qs[c * 128 + 64 + F.lane]; const float sq = 0.08838834764831845f / sqrtf(wave_sum(q0 * q0 + q1 * q1) + EPS);
                qs[c * 128 + F.lane] = q0 * sq; qs[c * 128 + 64 + F.lane] = q1 * sq;
                const float k0 = ks[c * 128 + F.lane], k1 = ks[c * 128 + 64 + F.lane]; const float sk = 1.0f / sqrtf(wave_sum(k0 * k0 + k1 * k1) + EPS);
                ks[c * 128 + F.lane] = k0 * sk; ks[c * 128 + 64 + F.lane] = k1 * sk; }
            __syncthreads();
            if (F.tid < 256) {
#pragma unroll 1
                for (int c = 0; c < 64; ++c) {
                    const float a = ga[c], bt = be[c];
                    const LAS f32x4* k4 = (const LAS f32x4*)(ks + c * 128 + 64 * half); const LAS f32x4* q4 = (const LAS f32x4*)(qs + c * 128 + 64 * half);
                    float dot = 0.f;
#pragma unroll
                    for (int i = 0; i < 16; ++i) { const f32x4 kv = k4[i]; dot += kv.x * S[4 * i] + kv.y * S[4 * i + 1] + kv.z * S[4 * i + 2] + kv.w * S[4 * i + 3]; }
                    dot += __shfl_xor(dot, 1);
                    const float tmp = bt * (vs[c * 128 + jcol] - a * dot);
                    float o = 0.f;
#pragma unroll
                    for (int i = 0; i < 16; ++i) { const f32x4 kv = k4[i]; const f32x4 qv = q4[i];
                        S[4 * i] = a * S[4 * i] + kv.x * tmp; S[4 * i + 1] = a * S[4 * i + 1] + kv.y * tmp; S[4 * i + 2] = a * S[4 * i + 2] + kv.z * tmp; S[4 * i + 3] = a * S[4 * i + 3] + kv.w * tmp;
                        o += qv.x * S[4 * i] + qv.y * S[4 * i + 1] + qv.z * S[4 * i + 2] + qv.w * S[4 * i + 3]; }
                    o += __shfl_xor(o, 1);
                    const int p = p0 + c; const int t = dir ? (L - 1 - p) : p;
                    float* dst = isctx ? OFC + (size_t)(b * CT + t) * D : F.out + (size_t)(b * T + t) * D;
                    if (half == 0) atomicAdd(dst + h * 128 + jcol, o);
                }
            }
            __syncthreads();
        }
    }
}
__device__ __forceinline__ void step_gdn_norm(int j) {
    const Frame F = make_frame();
    const int gw = F.bid * NWAVES + F.wave, NGW = F.G * NWAVES;
    const bf16* Z = (const bf16*)(F.ws + WS_Z); bf16* Y = (bf16*)(F.ws + WS_Y); const float* ng = INP(I_GNG) + j * 128;
    for (int row = gw; row < M; row += NGW) {
        const float* src = row < ML ? F.out + (size_t)row * D : (const float*)(F.ws + WS_OFC) + (size_t)(row - ML) * D;
        const f32x4* s4 = (const f32x4*)(src + 16 * F.lane);
        float v[16]; float ss = 0.f;
#pragma unroll
        for (int q = 0; q < 4; ++q) { const f32x4 x = s4[q]; v[4 * q] = x.x; v[4 * q + 1] = x.y; v[4 * q + 2] = x.z; v[4 * q + 3] = x.w; ss += (x.x * x.x + x.y * x.y) + (x.z * x.z + x.w * x.w); }
        ss += __shfl_xor(ss, 1); ss += __shfl_xor(ss, 2); ss += __shfl_xor(ss, 4);
        const float rstd = 1.0f / sqrtf(ss * (1.f / 128.f) + EPS);
        const u32x4* g4 = (const u32x4*)(Z + (size_t)row * 4096 + 3072 + 16 * F.lane);
        const int e0 = (16 * F.lane) & 127;
        u32x4 o[2];
#pragma unroll
        for (int q = 0; q < 2; ++q) { const u32x4 gz = g4[q]; unsigned w[4];
#pragma unroll
            for (int i = 0; i < 4; ++i) { const unsigned gg = gz[i]; const float g0 = bf2f(gg & 0xffffu), g1 = bf2f(gg >> 16); const int e = e0 + 8 * q + 2 * i;
                w[i] = pk2(v[8 * q + 2 * i] * rstd * ng[e] * silu_f(g0), v[8 * q + 2 * i + 1] * rstd * ng[e + 1] * silu_f(g1)); }
            o[q] = (u32x4){w[0], w[1], w[2], w[3]}; }
        u32x4* dst = (u32x4*)(Y + (size_t)row * D + 16 * F.lane); dst[0] = o[0]; dst[1] = o[1];
    }
}

__device__ __forceinline__ void step_sconv() {
    const Frame F = make_frame();
    const int gt = F.bid * NTHR + F.tid, NGT = F.G * NTHR;
    const bf16* Z = (const bf16*)(F.ws + WS_Z); bf16* Y = (bf16*)(F.ws + WS_Y); const float* cw = INP(I_SCONV);
    for (int idx = gt; idx < M * 128; idx += NGT) {
        const int row = idx >> 7, c0 = (idx & 127) * 8;
        int t, L, rbase; if (row < ML) { t = row & (T - 1); L = T; rbase = row - t; } else { const int r2 = row - ML; t = r2 & (CT - 1); L = CT; rbase = row - t; }
        float acc[8];
#pragma unroll
        for (int i = 0; i < 8; ++i) acc[i] = 0.f;
#pragma unroll
        for (int tap = 0; tap < 3; ++tap) { const int tt = t + tap - 1;
            if (tt >= 0 && tt < L) { const bf16* zr = Z + (size_t)(rbase + tt) * 3072; const u32x4 cg = *(const u32x4*)(zr + 1024 + c0), hv = *(const u32x4*)(zr + 2048 + c0);
                const f32x4 w0 = *(const f32x4*)(cw + tap * 1024 + c0), w1 = *(const f32x4*)(cw + tap * 1024 + c0 + 4); const float w[8] = {w0.x, w0.y, w0.z, w0.w, w1.x, w1.y, w1.z, w1.w};
#pragma unroll
                for (int i = 0; i < 4; ++i) { acc[2 * i] += w[2 * i] * bf2f(cg[i] & 0xffffu) * bf2f(hv[i] & 0xffffu); acc[2 * i + 1] += w[2 * i + 1] * bf2f(cg[i] >> 16) * bf2f(hv[i] >> 16); } } }
        const u32x4 bg = *(const u32x4*)(Z + (size_t)row * 3072 + c0); u32x4 o;
#pragma unroll
        for (int i = 0; i < 4; ++i) o[i] = pk2(bf2f(bg[i] & 0xffffu) * acc[2 * i], bf2f(bg[i] >> 16) * acc[2 * i + 1]);
        *(u32x4*)(Y + (size_t)row * D + c0) = o;
    }
}

__device__ __forceinline__ void step_rope() {
    const Frame F = make_frame();
    const int gw = F.bid * NWAVES + F.wave, NGW = F.G * NWAVES;
    bf16* Z = (bf16*)(F.ws + WS_Z); const f32x4* R = (const f32x4*)(F.ws + WS_ROPE);
    for (int row = gw; row < M; row += NGW) {
        u32x4* p = (u32x4*)(Z + (size_t)row * 3072 + 32 * F.lane);
        u32x4 v[4];
#pragma unroll
        for (int q = 0; q < 4; ++q) v[q] = p[q];
        const bool lat = row < ML; const float sc = F.lane < 32 ? QSCALE : 1.0f;
        const f32x4* tab = R + ((size_t)(row & (T - 1)) * 32 + 16 * (F.lane & 1)) / 2;
#pragma unroll
        for (int q = 0; q < 4; ++q) {
#pragma unroll
            for (int i = 0; i < 4; i += 2) {
                f32x4 cs = (f32x4){1.f, 0.f, 1.f, 0.f}; if (lat) cs = tab[(4 * q + i) / 2];
                { const unsigned w = v[q][i]; const float x0 = bf2f(w & 0xffffu), x1 = bf2f(w >> 16); v[q][i] = pk2((x0 * cs.x - x1 * cs.y) * sc, (x0 * cs.y + x1 * cs.x) * sc); }
                { const unsigned w = v[q][i + 1]; const float x0 = bf2f(w & 0xffffu), x1 = bf2f(w >> 16); v[q][i + 1] = pk2((x0 * cs.z - x1 * cs.w) * sc, (x0 * cs.w + x1 * cs.z) * sc); }
            }
        }
#pragma unroll
        for (int q = 0; q < 4; ++q) p[q] = v[q];
    }
    bf16* Vt = (bf16*)(F.ws + WS_H);
    LAS bf16* tl = (LAS bf16*)(F.lds + F.wave * 18432);
    for (int it = gw; it < NB * NH * (NKV / 64); it += NGW) {
        const int kt = it % (NKV / 64), bh = it / (NKV / 64), b = bh >> 3, h = bh & 7; const int kv0 = 64 * kt;
        const int srow = kv0 < CT ? ML + b * CT + kv0 : b * T + kv0 - CT;
#pragma unroll 4
        for (int i = 0; i < 16; ++i) { const int r = 4 * i + (F.lane >> 4), cc = (F.lane & 15) * 8;
            const u32x4 v = *(const u32x4*)(Z + (size_t)(srow + r) * 3072 + 2048 + h * 128 + cc);
#pragma unroll
            for (int q = 0; q < 4; ++q) { tl[(cc + 2 * q) * 72 + r] = (bf16)(v[q] & 0xffffu); tl[(cc + 2 * q + 1) * 72 + r] = (bf16)(v[q] >> 16); } }
        LDS_WAIT(); asm volatile("" ::: "memory");
#pragma unroll 4
        for (int i = 0; i < 16; ++i) { const int e = 8 * i + (F.lane >> 3), ch = F.lane & 7;
            const u32x4 v = *(const LAS u32x4*)(tl + e * 72 + ch * 8);
            *(u32x4*)(Vt + ((size_t)(bh * 128 + e)) * NKV + kv0 + ch * 8) = v; }
        LDS_WAIT(); asm volatile("" ::: "memory");
    }
}
__device__ __forceinline__ void step_attn() {
    const Frame F = make_frame();
    const bf16* Z = (const bf16*)(F.ws + WS_Z); const bf16* Vt = (const bf16*)(F.ws + WS_H); bf16* Y = (bf16*)(F.ws + WS_Y);
    LAS float* EX = (LAS float*)F.lds;
    const int r = F.lane & 31, hi = F.lane >> 5, qs = F.wave & 3, m = F.wave >> 2;
    float lmb;
    { const float* lam = INP(I_DLAM); const float t1 = lam[F.lane] * lam[64 + F.lane], t2 = lam[128 + F.lane] * lam[192 + F.lane]; lmb = expf(wave_sum(t1)) - expf(wave_sum(t2)) + LAMBDA_INIT; }
    const float* ng = INP(I_DNG);
    for (int u = F.bid; u < 1056; u += F.G) {
        int b, h, qrow0, nk;
        if (u < 1024) { b = u >> 9; h = (u >> 6) & 7; qrow0 = b * T + (u & 63) * 128; nk = NKV / 32; }
        else { const int v = u - 1024; b = v >> 4; h = (v >> 1) & 7; qrow0 = ML + b * CT + (v & 1) * 128; nk = CT / 32; }
        const int row0 = qrow0 + 32 * qs;
        bf16x8 qf[4];
#pragma unroll
        for (int d0 = 0; d0 < 4; ++d0) qf[d0] = *(const bf16x8*)(Z + (size_t)(row0 + r) * 3072 + h * 128 + m * 64 + d0 * 16 + hi * 8);
        const int kcol = 1024 + h * 128 + m * 64 + hi * 8;
        const bf16* vtb = Vt + (size_t)((b * 8 + h) * 128 + r) * NKV + 4 * hi;
        f32x16 o[4];
#pragma unroll
        for (int i = 0; i < 4; ++i)
#pragma unroll
            for (int q = 0; q < 16; ++q) o[i][q] = 0.f;
        float mref = 0.f, l = 0.f;
        for (int s = 0; s < nk; ++s) {
            const int kv0 = 32 * s; const int krow = kv0 < CT ? ML + b * CT + kv0 : b * T + kv0 - CT;
            const bf16* kp = Z + (size_t)(krow + r) * 3072 + kcol;
            bf16x8 kf[4];
#pragma unroll
            for (int d0 = 0; d0 < 4; ++d0) kf[d0] = *(const bf16x8*)(kp + d0 * 16);
            bf16x8 vf[4][2];
#pragma unroll
            for (int i = 0; i < 4; ++i)
#pragma unroll
                for (int s2 = 0; s2 < 2; ++s2) { const bf16* vp = vtb + (size_t)(32 * i) * NKV + kv0 + 16 * s2; const s16x4 lo = *(const s16x4*)vp, h8 = *(const s16x4*)(vp + 8);
                    vf[i][s2] = (bf16x8){lo[0], lo[1], lo[2], lo[3], h8[0], h8[1], h8[2], h8[3]}; }
            f32x16 S;
#pragma unroll
            for (int q = 0; q < 16; ++q) S[q] = 0.f;
#pragma unroll
            for (int d0 = 0; d0 < 4; ++d0) S = __builtin_amdgcn_mfma_f32_32x32x16_bf16(kf[d0], qf[d0], S, 0, 0, 0);
            float mx = S[0];
#pragma unroll
            for (int q = 1; q < 16; ++q) mx = fmaxf(mx, S[q]);
            mx = fmaxf(mx, __shfl_xor(mx, 32));
            if (s == 0) mref = mx;
            else if (__any(mx > mref)) { const float mn = fmaxf(mref, mx); const float al = __builtin_amdgcn_exp2f(mref - mn); l *= al; mref = mn;
#pragma unroll
                for (int i = 0; i < 4; ++i)
#pragma unroll
                    for (int q = 0; q < 16; ++q) o[i][q] *= al; }
            float ps = 0.f;
#pragma unroll
            for (int q = 0; q < 16; ++q) { S[q] = __builtin_amdgcn_exp2f(S[q] - mref); ps += S[q]; }
            l += ps;
            bf16x8 pf[2];
#pragma unroll
            for (int s2 = 0; s2 < 2; ++s2) { u32x4 w; w.x = pk2(S[8 * s2], S[8 * s2 + 1]); w.y = pk2(S[8 * s2 + 2], S[8 * s2 + 3]); w.z = pk2(S[8 * s2 + 4], S[8 * s2 + 5]); w.w = pk2(S[8 * s2 + 6], S[8 * s2 + 7]); pf[s2] = __builtin_bit_cast(bf16x8, w); }
#pragma unroll
            for (int i = 0; i < 4; ++i)
#pragma unroll
                for (int s2 = 0; s2 < 2; ++s2) o[i] = __builtin_amdgcn_mfma_f32_32x32x16_bf16(vf[i][s2], pf[s2], o[i], 0, 0, 0);
        }
        l += __shfl_xor(l, 32);
        const float f = (m == 1 ? lmb : 1.0f) / l;
        LAS float* ex = EX + (size_t)m * 128 * 129 + (qs * 32 + r) * 129;
#pragma unroll
        for (int i = 0; i < 4; ++i)
#pragma unroll
            for (int q = 0; q < 16; ++q) ex[32 * i + crow(q, hi)] = o[i][q] * f;
        __syncthreads();
#pragma unroll 1
        for (int rr = 0; rr < 16; ++rr) { const int row = 16 * F.wave + rr;
            const float a0 = EX[row * 129 + F.lane] - EX[128 * 129 + row * 129 + F.lane], a1 = EX[row * 129 + 64 + F.lane] - EX[128 * 129 + row * 129 + 64 + F.lane];
            const float rstd = (1.0f - LAMBDA_INIT) / sqrtf(wave_sum(a0 * a0 + a1 * a1) * (1.f / 128.f) + EPS);
            bf16* yr = Y + (size_t)(qrow0 + row) * D + h * 128;
            yr[F.lane] = (bf16)(pk2(a0 * rstd * ng[F.lane], 0.f) & 0xffffu); yr[64 + F.lane] = (bf16)(pk2(a1 * rstd * ng[64 + F.lane], 0.f) & 0xffffu); }
        __syncthreads();
    }
}

constexpr int PD_BYTES = 12800, PD_ATT = 6144, PD_EG = 12288, PD_EW = 12544;
__device__ __forceinline__ unsigned off_a(unsigned row, unsigned ch) { return 2048u * (row >> 3) + 512u * (ch >> 2) + 64u * (row & 7) + 16u * ((ch & 3) ^ ((row >> 2) & 3)); }
__device__ __forceinline__ int frag_off(int c, int s) {
    const int slot = (c >> 5) == (s >> 5) ? ((c >> 5) ? 2 : 0) : 1, s2 = (s & 31) >> 4, hh = ((s & 15) >> 2) & 1, jj = ((s & 15) >> 3) * 4 + (s & 3), r = c & 31;
    return slot * 2048 + s2 * 1024 + (hh * 32 + r) * 16 + jj * 2;
}
__device__ __forceinline__ void step_gdn_prep(int j) {
    const Frame F = make_frame();
    LAS float* STG = (LAS float*)F.lds;
    LAS float* KK = (LAS float*)F.lds;
    LAS float* QK = KK + 64 * 65;
    LAS float* LP = (LAS float*)(F.lds + 33280);
    LAS unsigned char* OUT = F.lds + 66048;
    LAS unsigned char* QI = F.lds + 99328; LAS unsigned char* KI = F.lds + 115712;
    LAS float* SM = (LAS float*)(F.lds + 132096);
    bf16* Z = (bf16*)(F.ws + WS_Z); const float* AB = (const float*)(F.ws + WS_AB); const bf16* HALO = (const bf16*)(F.ws + WS_HALO); unsigned char* PD = F.ws + WS_PD;
    const float* cw = INP(I_GCONV) + (size_t)j * 3 * 3072;
    const int r = F.lane & 31, hi = F.lane >> 5;
    for (int it = F.bid; it < NB * NH * 132; it += F.G) {
        const int n = it % 132, bh = it / 132, b = bh >> 3, h = bh & 7;
        const bool isctx = n < 4; const int L = isctx ? CT : T; const int t0 = isctx ? 64 * n : 64 * (n - 4); const int row0 = (isctx ? ML + b * CT : b * T) + t0;
        for (int idx = F.tid; idx < 3072; idx += NTHR) {
            const int c = idx / 48, g8 = idx % 48, part = g8 >> 4, e0 = (g8 & 15) * 8; const int col = part * 1024 + h * 128 + e0; const int t = t0 + c;
            const u32x4 zero = (u32x4){0u, 0u, 0u, 0u};
            const u32x4 z0 = *(const u32x4*)(Z + (size_t)(row0 + c) * 4096 + col);
            u32x4 zm = zero, zp = zero;
            if (t > 0) zm = c == 0 ? *(const u32x4*)(HALO + ((size_t)((row0 >> 6) - 1) * 2 + 1) * 3072 + col) : *(const u32x4*)(Z + (size_t)(row0 + c - 1) * 4096 + col);
            if (t < L - 1) zp = c == 63 ? *(const u32x4*)(HALO + ((size_t)((row0 >> 6) + 1) * 2) * 3072 + col) : *(const u32x4*)(Z + (size_t)(row0 + c + 1) * 4096 + col);
            const float* wp = cw + col;
            float o[8];
#pragma unroll
            for (int q = 0; q < 2; ++q) { const f32x4 w0 = *(const f32x4*)(wp + 4 * q), w1 = *(const f32x4*)(wp + 3072 + 4 * q), w2 = *(const f32x4*)(wp + 6144 + 4 * q);
#pragma unroll
                for (int i = 0; i < 2; ++i) { const unsigned a = zm[2 * q + i], bq = z0[2 * q + i], cq = zp[2 * q + i];
                    o[4 * q + 2 * i] = silu_f(w0[2 * i] * bf2f(a & 0xffffu) + w1[2 * i] * bf2f(bq & 0xffffu) + w2[2 * i] * bf2f(cq & 0xffffu));
                    o[4 * q + 2 * i + 1] = silu_f(w0[2 * i + 1] * bf2f(a >> 16) + w1[2 * i + 1] * bf2f(bq >> 16) + w2[2 * i + 1] * bf2f(cq >> 16)); } }
            LAS f32x4* dst = (LAS f32x4*)(STG + c * 388 + part * 128 + e0); dst[0] = (f32x4){o[0], o[1], o[2], o[3]}; dst[1] = (f32x4){o[4], o[5], o[6], o[7]};
        }
        if (F.wave < 2) {
            const int d = F.wave, c = F.lane; const size_t row = (size_t)(row0 + c);
            const float Aco = expf(INP(I_GALOG)[j * 16 + d * 8 + h]), dtb = INP(I_GDT)[j * 16 + d * 8 + h];
            const float x = AB[row * 32 + d * 8 + h] + dtb, bb = AB[row * 32 + 16 + d * 8 + h];
            const float sp = x > 20.f ? x : log1pf(expf(x));
            float s = -Aco * sp;
#pragma unroll
            for (int o = 1; o < 64; o <<= 1) { const float up = __shfl_up(s, o), dn = __shfl_down(s, o); if (d ? (c + o < 64) : (c >= o)) s += d ? dn : up; }
            SM[d * 64 + c] = 1.f / (1.f + expf(-bb)); SM[128 + d * 64 + c] = s;
        }
        __syncthreads();
#pragma unroll 1
        for (int rr = 0; rr < 8; ++rr) { const int c = F.wave * 8 + rr; const LAS float* sr = STG + c * 388;
            const float q0 = sr[F.lane], q1 = sr[64 + F.lane]; const float sq = 0.08838834764831845f / sqrtf(wave_sum(q0 * q0 + q1 * q1) + EPS);
            const float k0 = sr[128 + F.lane], k1 = sr[192 + F.lane]; const float sk = 1.0f / sqrtf(wave_sum(k0 * k0 + k1 * k1) + EPS);
            const unsigned o0 = off_a(c, F.lane >> 3) + 2 * (F.lane & 7), o1 = off_a(c, 8 + (F.lane >> 3)) + 2 * (F.lane & 7);
            *(LAS bf16*)(QI + o0) = (bf16)(pk2(q0 * sq, 0.f) & 0xffffu); *(LAS bf16*)(QI + o1) = (bf16)(pk2(q1 * sq, 0.f) & 0xffffu);
            *(LAS bf16*)(KI + o0) = (bf16)(pk2(k0 * sk, 0.f) & 0xffffu); *(LAS bf16*)(KI + o1) = (bf16)(pk2(k1 * sk, 0.f) & 0xffffu);
            bf16* vd = Z + (size_t)(row0 + c) * 4096 + 2048 + h * 128;
            vd[F.lane] = (bf16)(pk2(sr[256 + F.lane], 0.f) & 0xffffu); vd[64 + F.lane] = (bf16)(pk2(sr[320 + F.lane], 0.f) & 0xffffu); }
        __syncthreads();
        { const int prod = F.wave >> 2, mt = (F.wave >> 1) & 1, nt = F.wave & 1; LAS unsigned char* AI = prod ? QI : KI;
            f32x16 acc;
#pragma unroll
            for (int i = 0; i < 16; ++i) acc[i] = 0.f;
#pragma unroll
            for (int ks = 0; ks < 8; ++ks) { const bf16x8 a = *(const LAS bf16x8*)(AI + off_a(32 * mt + r, 2 * ks + hi)), bq = *(const LAS bf16x8*)(KI + off_a(32 * nt + r, 2 * ks + hi));
                acc = __builtin_amdgcn_mfma_f32_32x32x16_bf16(a, bq, acc, 0, 0, 0); }
            LAS float* dst = prod ? QK : KK;
#pragma unroll
            for (int i = 0; i < 16; ++i) dst[(32 * mt + crow(i, hi)) * 65 + 32 * nt + r] = acc[i]; }
        __syncthreads();
        for (int idx = F.tid; idx < 8192; idx += NTHR) { const int d = idx >> 12, p = (idx >> 6) & 63, ps = idx & 63; float val = 0.f;
            if (ps < p) { const int c = d ? 63 - p : p, s = d ? 63 - ps : ps; val = SM[d * 64 + c] * KK[c * 65 + s] * expf(SM[128 + d * 64 + c] - SM[128 + d * 64 + s]); }
            LP[idx] = val; }
        for (int idx = F.tid; idx < 8192; idx += NTHR) { const int d = idx >> 12, c = (idx >> 6) & 63, s = idx & 63;
            const bool zero_blk = d ? (c >= 32 && s < 32) : (c < 32 && s >= 32);
            if (!zero_blk) { const bool m = d ? (s >= c) : (s <= c); const float val = m ? QK[c * 65 + s] * expf(SM[128 + d * 64 + c] - SM[128 + d * 64 + s]) : 0.f;
                *(LAS bf16*)(OUT + d * PD_BYTES + PD_ATT + frag_off(c, s)) = (bf16)(pk2(val, 0.f) & 0xffffu); } }
        if (F.tid < 128) { const int d = F.tid >> 6, c = F.tid & 63; const float gl = SM[128 + d * 64 + (d ? 0 : 63)], gcv = SM[128 + d * 64 + c];
            *(LAS float*)(OUT + d * PD_BYTES + PD_EG + 4 * c) = expf(gcv); *(LAS float*)(OUT + d * PD_BYTES + PD_EW + 4 * c) = expf(gl - gcv); }
        __syncthreads();
#ifndef NO_INV
        if (F.wave < 2) {
            const int d = F.wave, jc = F.lane; const LAS f32x4* L4 = (const LAS f32x4*)(LP + d * 4096);
            float Tc[64];
#pragma unroll
            for (int p = 0; p < 64; ++p) { float acc = (p == jc) ? 1.f : 0.f;
#pragma unroll
                for (int q4 = 0; q4 < (p + 3) / 4; ++q4) { const f32x4 l = L4[p * 16 + q4];
                    if (4 * q4 < p) acc -= l.x * Tc[4 * q4]; if (4 * q4 + 1 < p) acc -= l.y * Tc[4 * q4 + 1]; if (4 * q4 + 2 < p) acc -= l.z * Tc[4 * q4 + 2]; if (4 * q4 + 3 < p) acc -= l.w * Tc[4 * q4 + 3]; }
                Tc[p] = acc; asm volatile("" ::: "memory"); }
            const int s = d ? 63 - jc : jc; const float bj = SM[d * 64 + s];
#pragma unroll
            for (int p = 0; p < 64; ++p) { const int c = d ? 63 - p : p; const bool zero_blk = d ? (c >= 32 && s < 32) : (c < 32 && s >= 32);
                *(LAS bf16*)(OUT + (zero_blk ? 2 * PD_BYTES : d * PD_BYTES + frag_off(c, s))) = (bf16)(pk2(Tc[p] * bj, 0.f) & 0xffffu); }
        }
#endif
        __syncthreads();
        for (int idx = F.tid; idx < 1600; idx += NTHR) { const int d = idx / 800, pc = idx % 800;
            *(u32x4*)(PD + ((size_t)(((d * 2 + b) * 8 + h) * 132 + n)) * PD_BYTES + pc * 16) = *(const LAS u32x4*)(OUT + d * PD_BYTES + pc * 16); }
        for (int idx = F.tid; idx < 2048; idx += NTHR) { const int img = idx >> 10, pn = idx & 1023;
            *(u32x4*)((unsigned char*)(Z + (size_t)(row0 + (pn >> 4)) * 4096 + img * 1024 + h * 128) + (pn & 15) * 16) = *(const LAS u32x4*)((img ? KI : QI) + pn * 16); }
        __syncthreads();
    }
}

#define PACK8(x, b) __builtin_bit_cast(bf16x8, (u32x4){pk2((x)[(b)], (x)[(b) + 1]), pk2((x)[(b) + 2], (x)[(b) + 3]), pk2((x)[(b) + 4], (x)[(b) + 5]), pk2((x)[(b) + 6], (x)[(b) + 7])})
#define MFMA32(a, b, c) __builtin_amdgcn_mfma_f32_32x32x16_bf16((a), (b), (c), 0, 0, 0)
typedef short v4i16_t __attribute__((ext_vector_type(4)));
__device__ __forceinline__ void step_gdn_scan2() {
    const Frame F = make_frame();
    constexpr int BUF = 61952, B_K = 0, B_Q = 16384, B_V = 32768, B_PD = 49152;
    const bf16* Z = (const bf16*)(F.ws + WS_Z); const unsigned char* PD = F.ws + WS_PD;
    const int r = F.lane & 31, hi = F.lane >> 5;
    for (int it = F.bid; it < 32; it += F.G) {
        const int b = it >> 4, h = (it >> 1) & 7, dir = it & 1;
        const unsigned char* pdb = PD + (size_t)(((dir * 2 + b) * 8 + h) * 132) * PD_BYTES;
#define CHUNK_OF(sp) (dir ? ((sp) < 4 ? 3 - (sp) : 135 - (sp)) : (sp))
#define ROW0_OF(n) ((n) < 4 ? ML + b * CT + 64 * (n) : b * T + 64 * ((n) - 4))
        if (F.wave >= 4) {
            const int lt = F.tid - 256;
            u32x4 rg[16];
#define LOAD_CHUNK(sp) do { const int n_ = CHUNK_OF(sp); const int row0_ = ROW0_OF(n_); \
                _Pragma("unroll") for (int i = 0; i < 4; ++i) { const int pn = lt + 256 * i; const unsigned char* src = (const unsigned char*)(Z + (size_t)(row0_ + (pn >> 4)) * 4096 + h * 128) + (pn & 15) * 16; \
                    rg[i] = *(const u32x4*)(src + 2048); rg[4 + i] = *(const u32x4*)src; rg[8 + i] = *(const u32x4*)(src + 4096); \
                    rg[12 + i] = pn < 800 ? *(const u32x4*)(pdb + (size_t)n_ * PD_BYTES + pn * 16) : (u32x4){0u, 0u, 0u, 0u}; } } while (0)
#define WRITE_CHUNK(bufb) do { LAS unsigned char* base_ = F.lds + (bufb); \
                _Pragma("unroll") for (int i = 0; i < 4; ++i) { const int pn = lt + 256 * i; *(LAS u32x4*)(base_ + B_K + pn * 16) = rg[i]; *(LAS u32x4*)(base_ + B_Q + pn * 16) = rg[4 + i]; \
                    *(LAS u32x4*)(base_ + B_V + pn * 16) = rg[8 + i]; if (pn < 800) *(LAS u32x4*)(base_ + B_PD + pn * 16) = rg[12 + i]; } } while (0)
            LOAD_CHUNK(0); WRITE_CHUNK(0); LOAD_CHUNK(1);
            __syncthreads();
            for (int sp = 0; sp < 132; ++sp) {
                if (sp + 1 < 132) WRITE_CHUNK(((sp + 1) & 1) * BUF);
                if (sp + 2 < 132) LOAD_CHUNK(sp + 2);
                __syncthreads();
            }
#undef LOAD_CHUNK
#undef WRITE_CHUNK
        } else {
            const int w = F.wave;
            f32x16 S[4];
#pragma unroll
            for (int kt = 0; kt < 4; ++kt)
#pragma unroll
                for (int i = 0; i < 16; ++i) S[kt][i] = 0.f;
            const int x = (r >> 2) & 3; const int rowb = 2048 * (r >> 3) + 64 * (r & 7);
            int oa[2], ob[2];
#pragma unroll
            for (int s2 = 0; s2 < 2; ++s2) { oa[s2] = rowb + 16 * ((2 * s2) ^ x) + 8 * hi; ob[s2] = rowb + 16 * ((2 * s2 + 1) ^ x) + 8 * hi; }
            const int blk = (F.lane >> 4) & 1, q = (F.lane & 15) >> 2, p = F.lane & 3, cb = 2 * blk + (p >> 1);
            int trb[2];
#pragma unroll
            for (int t = 0; t < 2; ++t) trb[t] = 64 * (4 * hi + q) + 8 * (p & 1) + 16 * (cb ^ ((2 * t + hi) & 3)) + 2048 * t;
            const int vb = 4 * hi * 256 + (32 * w + r) * 2;
            __syncthreads();
            for (int sp = 0; sp < 132; ++sp) {
                const int n = CHUNK_OF(sp); const int row0 = ROW0_OF(n);
                LAS unsigned char* B = F.lds + (sp & 1) * BUF;
                LAS unsigned char* KI = B + B_K; LAS unsigned char* QI = B + B_Q; LAS unsigned char* VI = B + B_V; LAS unsigned char* PR = B + B_PD;
                bf16x8 Sb[4][2];
#pragma unroll
                for (int kt = 0; kt < 4; ++kt) { Sb[kt][0] = PACK8(S[kt], 0); Sb[kt][1] = PACK8(S[kt], 8); }
                f32x16 KS[2];
#pragma unroll
                for (int mt = 0; mt < 2; ++mt) {
#pragma unroll
                    for (int i = 0; i < 16; ++i) KS[mt][i] = 0.f;
#pragma unroll
                    for (int kt = 0; kt < 4; ++kt)
#pragma unroll
                        for (int s2 = 0; s2 < 2; ++s2) {
                            const s16x4 k0 = *(const LAS s16x4*)(KI + 8192 * mt + 512 * kt + oa[s2]), k1 = *(const LAS s16x4*)(KI + 8192 * mt + 512 * kt + ob[s2]);
                            KS[mt] = MFMA32(((bf16x8){k0[0], k0[1], k0[2], k0[3], k1[0], k1[1], k1[2], k1[3]}), Sb[kt][s2], KS[mt]); }
                    asm volatile("" ::: "memory");
                }
                bf16x8 Rb[2][2];
#pragma unroll
                for (int mt = 0; mt < 2; ++mt) { f32x16 R;
#pragma unroll
                    for (int g = 0; g < 4; ++g) { const f32x4 e4 = *(const LAS f32x4*)(PR + PD_EG + 4 * (32 * mt + 8 * g + 4 * hi));
#pragma unroll
                        for (int i = 0; i < 4; ++i) { const float v = bf2f(*(const LAS bf16*)(VI + vb + (32 * mt + 8 * g + i) * 256)); R[4 * g + i] = v - e4[i] * KS[mt][4 * g + i]; } }
                    Rb[mt][0] = PACK8(R, 0); Rb[mt][1] = PACK8(R, 8); }
                f32x16 vn[2], o[2];
#pragma unroll
                for (int i = 0; i < 16; ++i) { vn[0][i] = 0.f; vn[1][i] = 0.f; }
#define TFR(base, slot, s2) (*(const LAS bf16x8*)(PR + (base) + (slot) * 2048 + (s2) * 1024 + F.lane * 16))
                vn[0] = MFMA32(TFR(0, 0, 0), Rb[0][0], vn[0]); vn[0] = MFMA32(TFR(0, 0, 1), Rb[0][1], vn[0]);
                vn[1] = MFMA32(TFR(0, 2, 0), Rb[1][0], vn[1]); vn[1] = MFMA32(TFR(0, 2, 1), Rb[1][1], vn[1]);
                if (dir) { vn[0] = MFMA32(TFR(0, 1, 0), Rb[1][0], vn[0]); vn[0] = MFMA32(TFR(0, 1, 1), Rb[1][1], vn[0]); }
                else     { vn[1] = MFMA32(TFR(0, 1, 0), Rb[0][0], vn[1]); vn[1] = MFMA32(TFR(0, 1, 1), Rb[0][1], vn[1]); }
                asm volatile("" ::: "memory");
                f32x16 QS[2];
#pragma unroll
                for (int mt = 0; mt < 2; ++mt) {
#pragma unroll
                    for (int i = 0; i < 16; ++i) QS[mt][i] = 0.f;
#pragma unroll
                    for (int kt = 0; kt < 4; ++kt)
#pragma unroll
                        for (int s2 = 0; s2 < 2; ++s2) {
                            const s16x4 q0 = *(const LAS s16x4*)(QI + 8192 * mt + 512 * kt + oa[s2]), q1 = *(const LAS s16x4*)(QI + 8192 * mt + 512 * kt + ob[s2]);
                            QS[mt] = MFMA32(((bf16x8){q0[0], q0[1], q0[2], q0[3], q1[0], q1[1], q1[2], q1[3]}), Sb[kt][s2], QS[mt]); }
                    asm volatile("" ::: "memory");
                }
                bf16x8 Vb[2][2], Wb[2][2];
#pragma unroll
                for (int mt = 0; mt < 2; ++mt) { f32x16 W;
#pragma unroll
                    for (int g = 0; g < 4; ++g) { const f32x4 e4 = *(const LAS f32x4*)(PR + PD_EG + 4 * (32 * mt + 8 * g + 4 * hi)), w4 = *(const LAS f32x4*)(PR + PD_EW + 4 * (32 * mt + 8 * g + 4 * hi));
#pragma unroll
                        for (int i = 0; i < 4; ++i) { o[mt][4 * g + i] = e4[i] * QS[mt][4 * g + i]; W[4 * g + i] = w4[i] * vn[mt][4 * g + i]; } }
                    Vb[mt][0] = PACK8(vn[mt], 0); Vb[mt][1] = PACK8(vn[mt], 8); Wb[mt][0] = PACK8(W, 0); Wb[mt][1] = PACK8(W, 8); }
                o[0] = MFMA32(TFR(PD_ATT, 0, 0), Vb[0][0], o[0]); o[0] = MFMA32(TFR(PD_ATT, 0, 1), Vb[0][1], o[0]);
                o[1] = MFMA32(TFR(PD_ATT, 2, 0), Vb[1][0], o[1]); o[1] = MFMA32(TFR(PD_ATT, 2, 1), Vb[1][1], o[1]);
                if (dir) { o[0] = MFMA32(TFR(PD_ATT, 1, 0), Vb[1][0], o[0]); o[0] = MFMA32(TFR(PD_ATT, 1, 1), Vb[1][1], o[0]); }
                else     { o[1] = MFMA32(TFR(PD_ATT, 1, 0), Vb[0][0], o[1]); o[1] = MFMA32(TFR(PD_ATT, 1, 1), Vb[0][1], o[1]); }
#undef TFR
                asm volatile("" ::: "memory");
                const float cd = *(const LAS float*)(PR + PD_EG + 4 * (dir ? 0 : 63));
#pragma unroll
                for (int kt = 0; kt < 4; ++kt) {
#pragma unroll
                    for (int i = 0; i < 16; ++i) S[kt][i] *= cd;
#pragma unroll
                    for (int mt = 0; mt < 2; ++mt)
#pragma unroll
                        for (int s2 = 0; s2 < 2; ++s2) {
                            const s16x4 a0 = __builtin_bit_cast(s16x4, __builtin_amdgcn_ds_read_tr16_b64_v4i16((LAS v4i16_t*)(KI + 8192 * mt + 4096 * s2 + 512 * kt + trb[0])));
                            const s16x4 a1 = __builtin_bit_cast(s16x4, __builtin_amdgcn_ds_read_tr16_b64_v4i16((LAS v4i16_t*)(KI + 8192 * mt + 4096 * s2 + 512 * kt + trb[1])));
                            S[kt] = MFMA32(((bf16x8){a0[0], a0[1], a0[2], a0[3], a1[0], a1[1], a1[2], a1[3]}), Wb[mt][s2], S[kt]); }
                    asm volatile("" ::: "memory");
                }
                { bf16* ob_ = n < 4 ? (bf16*)(F.ws + WS_OFC) + ((size_t)dir * MC + (row0 - ML)) * D : (bf16*)F.out + ((size_t)dir * ML + row0) * D;
                    bf16* oc = ob_ + h * 128 + 32 * w + r;
#pragma unroll
                    for (int mt = 0; mt < 2; ++mt)
#pragma unroll
                        for (int i = 0; i < 16; ++i) oc[(size_t)(32 * mt + crow(i, hi)) * D] = (bf16)(pk2(o[mt][i], 0.f) & 0xffffu); }
                __syncthreads();
            }
        }
#undef CHUNK_OF
#undef ROW0_OF
    }
}
__device__ __forceinline__ void step_gdn_norm2(int j) {
    const Frame F = make_frame();
    const int gw = F.bid * NWAVES + F.wave, NGW = F.G * NWAVES;
    const bf16* Z = (const bf16*)(F.ws + WS_Z); bf16* Y = (bf16*)(F.ws + WS_Y); const float* ng = INP(I_GNG) + j * 128;
    for (int row = gw; row < M; row += NGW) {
        const bf16* of = row < ML ? (const bf16*)F.out + (size_t)row * D : (const bf16*)(F.ws + WS_OFC) + (size_t)(row - ML) * D;
        const bf16* ob = row < ML ? of + (size_t)ML * D : of + (size_t)MC * D;
        const u32x4* f4 = (const u32x4*)(of + 16 * F.lane); const u32x4* b4 = (const u32x4*)(ob + 16 * F.lane);
        float v[16]; float ss = 0.f;
#pragma unroll
        for (int q = 0; q < 2; ++q) { const u32x4 a = f4[q], bq = b4[q];
#pragma unroll
            for (int i = 0; i < 4; ++i) { const float x0 = bf2f(a[i] & 0xffffu) + bf2f(bq[i] & 0xffffu), x1 = bf2f(a[i] >> 16) + bf2f(bq[i] >> 16); v[8 * q + 2 * i] = x0; v[8 * q + 2 * i + 1] = x1; ss += x0 * x0 + x1 * x1; } }
        ss += __shfl_xor(ss, 1); ss += __shfl_xor(ss, 2); ss += __shfl_xor(ss, 4);
        const float rstd = 1.0f / sqrtf(ss * (1.f / 128.f) + EPS);
        const u32x4* g4 = (const u32x4*)(Z + (size_t)row * 4096 + 3072 + 16 * F.lane);
        const int e0 = (16 * F.lane) & 127;
        u32x4 o[2];
#pragma unroll
        for (int q = 0; q < 2; ++q) { const u32x4 gz = g4[q]; unsigned wv[4];
#pragma unroll
            for (int i = 0; i < 4; ++i) { const unsigned gg = gz[i]; const float g0 = bf2f(gg & 0xffffu), g1 = bf2f(gg >> 16); const int e = e0 + 8 * q + 2 * i;
                wv[i] = pk2(v[8 * q + 2 * i] * rstd * ng[e] * silu_f(g0), v[8 * q + 2 * i + 1] * rstd * ng[e + 1] * silu_f(g1)); }
            o[q] = (u32x4){wv[0], wv[1], wv[2], wv[3]}; }
        u32x4* dst = (u32x4*)(Y + (size_t)row * D + 16 * F.lane); dst[0] = o[0]; dst[1] = o[1];
    }
}

#ifndef MK_SINGLE
#define MK_SINGLE 1
#endif
constexpr int NSTEPS = 1 + 9 + 7 + 8 + 9 + 1;
template <int ACT> __device__ __forceinline__ void gemm_store(const bf16* A, const bf16* Bt, int Mrows, int N, int K, bf16* O, int ldc, float* AB, int ab_tile, bf16* halo) {
    int G_ = gridDim.x, B_ = blockIdx.x; asm volatile("" : "+s"(G_), "+s"(B_));
    pg8::Gemm g{A, Bt, Mrows, N, K}; pg8::StaticOrder S; S.init(Mrows, N, G_, B_);
    pg8::EpiStore<ACT> E{O, ldc, AB, ab_tile, halo};
    pg8::gemm_phase<pg8::EpiStore<ACT>, pg8::StaticOrder, true, true>((LAS unsigned char*)lds_raw, g, S, E);
}
__device__ __forceinline__ void gemm_resid(const bf16* A, const bf16* Bt, int Mrows, int K, float* X, const float* gate) {
    int G_ = gridDim.x, B_ = blockIdx.x; asm volatile("" : "+s"(G_), "+s"(B_));
    pg8::Gemm g{A, Bt, Mrows, D, K}; pg8::StaticOrder S; S.init(Mrows, D, G_, B_);
    pg8::EpiResid E{X, D, gate, NADA};
    pg8::gemm_phase<pg8::EpiResid, pg8::StaticOrder, true, true>((LAS unsigned char*)lds_raw, g, S, E);
}
__global__ void __launch_bounds__(NTHR, 2) fwd_kernel(Args a) {
    unsigned char* ws = a.ws;
    const int lo = a.step_lo, hi = a.step_hi; const bool coop = a.coop != 0;
#define PHASE(k, body) do { if (lo <= (k) && (k) < hi) { __syncthreads(); body; if ((k) + 1 < hi && coop) cg::this_grid().sync(); } } while (0)
#define WB(off) ((bf16*)(ws + (off)))
#define MODP(layer, which) ((const float*)(ws + WS_MOD) + (size_t)(layer) * 3 * NADA + (which) * D)
#define TAIL(k0, layer, WoutT, Mrows) \
    PHASE((k0), gemm_resid(WB(WS_Y), (WoutT), (Mrows), D, (float*)(ws + WS_X), MODP(layer, 2))); \
    PHASE((k0) + 1, step_norm((layer), 1, (Mrows), false)); \
    PHASE((k0) + 2, gemm_store<1>(WB(WS_H), WB(WS_W1T) + (size_t)(layer) * D * FF, (Mrows), FF, D, WB(WS_Z), FF, nullptr, -1, nullptr)); \
    PHASE((k0) + 3, gemm_resid(WB(WS_Z), WB(WS_W2T) + (size_t)(layer) * D * FF, (Mrows), FF, (float*)(ws + WS_X), MODP(layer, 5)))
#define LAYER_GDN(k0, layer, jj, Mrows) \
    PHASE((k0), step_norm((layer), 0, M, false)); \
    PHASE((k0) + 1, gemm_store<0>(WB(WS_H), WB(WS_GINT) + (size_t)(jj) * GDN_NP * D, M, GDN_NP, D, WB(WS_Z), 4096, (float*)(ws + WS_AB), 16, WB(WS_HALO))); \
    PHASE((k0) + 2, step_gdn_prep(jj)); \
    PHASE((k0) + 3, step_gdn_scan2()); \
    PHASE((k0) + 4, step_gdn_norm2(jj)); \
    TAIL((k0) + 5, layer, WB(WS_GOUTT) + (size_t)(jj) * D * D, Mrows)
    PHASE(0, step_prologue());
    LAYER_GDN(1, 0, 0, M);
    PHASE(10, step_norm(1, 0, M, false));
    PHASE(11, gemm_store<0>(WB(WS_H), WB(WS_SINT), M, 3 * D, D, WB(WS_Z), 3 * D, nullptr, -1, nullptr));
    PHASE(12, step_sconv());
    TAIL(13, 1, WB(WS_SOUTT), M);
    PHASE(17, step_norm(2, 0, M, false));
    PHASE(18, gemm_store<0>(WB(WS_H), WB(WS_DINT), M, 3 * D, D, WB(WS_Z), 3 * D, nullptr, -1, nullptr));
    PHASE(19, step_rope());
    PHASE(20, step_attn());
    TAIL(21, 2, WB(WS_DOUTT), M);
    LAYER_GDN(25, 3, 1, ML);
    PHASE(34, step_final());
}

extern "C" void kernel_launch(void* const* d_in, const int* in_sizes, int n_in, void* d_out, int out_size, void* d_ws, size_t ws_size, hipStream_t stream) {
    static int grid = 0;
    if (grid == 0) {
        if (n_in != 24 || out_size != ML * D || ws_size < WS_END) { fprintf(stderr, "kernel_launch: unexpected problem (n_in %d, out %d, ws %zu); nothing launched\n", n_in, out_size, ws_size); grid = -1; return; }
        int dev = 0, cus = 0, per_cu = 0;
        if (hipGetDevice(&dev) != hipSuccess || hipDeviceGetAttribute(&cus, hipDeviceAttributeMultiprocessorCount, dev) != hipSuccess) { grid = -1; return; }
        if (hipFuncSetAttribute((const void*)fwd_kernel, hipFuncAttributeMaxDynamicSharedMemorySize, LDS_BYTES) != hipSuccess) { fprintf(stderr, "kernel_launch: hipFuncSetAttribute failed\n"); grid = -1; return; }
        if (hipOccupancyMaxActiveBlocksPerMultiprocessor(&per_cu, (const void*)fwd_kernel, NTHR, LDS_BYTES) != hipSuccess || per_cu < 1) { fprintf(stderr, "kernel_launch: occupancy query says %d blocks per CU\n", per_cu); (void)hipGetLastError(); per_cu = 1; }
        grid = cus;
        fprintf(stderr, "kernel_launch: %d CUs, occupancy %d per CU, grid %d\n", cus, per_cu, grid);
    }
    if (grid < 0) return;
    (void)hipMemsetAsync((char*)d_ws + WS_CTL, 0, CTL_ZERO_BYTES, stream);
    Args a{};
    for (int i = 0; i < 24; ++i) a.in[i] = (const float*)d_in[i];
    a.out = (float*)d_out; a.ws = (unsigned char*)d_ws;
#if MK_SINGLE
    a.step_lo = 0; a.step_hi = NSTEPS; a.coop = 1;
    void* args[] = {&a};
    hipError_t e = hipLaunchCooperativeKernel((const void*)fwd_kernel, dim3(grid), dim3(NTHR), args, LDS_BYTES, stream);
    if (e != hipSuccess) fprintf(stderr, "cooperative launch failed: %s (grid %d)\n", hipGetErrorString(e), grid);
#else
    for (int s = 0; s < NSTEPS; ++s) { a.step_lo = s; a.step_hi = s + 1; a.coop = 0; hipLaunchKernelGGL(fwd_kernel, dim3(grid), dim3(NTHR), LDS_BYTES, stream, a); }
#endif
}
```

```cpp
#include <hip/hip_runtime.h>
#include <hip/hip_cooperative_groups.h>
#include <cstdio>
#include <cstdint>
namespace cg = cooperative_groups;
namespace pg8 {
#define PG8_LAS __attribute__((address_space(3)))
typedef unsigned short bf16_t;
typedef short bf16x8 __attribute__((ext_vector_type(8)));
typedef float f32x4 __attribute__((ext_vector_type(4)));
typedef unsigned u32x4 __attribute__((ext_vector_type(4)));
constexpr int BM = 256, BK = 64, HALF = 128, HTB = HALF * BK * 2  , STAGE_BYTES = 8 * HTB, NXCD = 8, WGM = 8;

__host__ __device__ __forceinline__ int lds_byte(int r, int c) { const int st = (r >> 4) * 2 + (c >> 5), rr = r & 15, cc = c & 31, ob = rr * 64 + cc * 2; return st * 1024 + (ob ^ (((ob >> 9) & 1) << 5)); }
__host__ __device__ __forceinline__ void stage_rc(int b, int& R, int& C) { const int st = b / 1024, sb = b % 1024, swz = sb ^ (((sb >> 9) & 1) << 5); R = (st >> 1) * 16 + swz / 64; C = (st & 1) * 32 + (swz % 64) / 2; }
__host__ __device__ __forceinline__ int perm32(int rho) { const int n = rho >> 4, i = rho & 15; return 8 * (i >> 2) + 4 * n + (i & 3); }

struct Unit { int pm, pn; };
struct Gemm { const bf16_t* A; const bf16_t* Bt; int M, N, K; };

struct StaticOrder {
    int nM, nN, nwg, G, c;
    __host__ __device__ void init(int M, int N, int G_, int c_) { nM = M / BM; nN = N / BM; nwg = nM * nN; G = G_; c = c_; }
    __host__ __device__ bool next(int i, Unit& u) const {
        const long L = (long)i * G + c; if (L >= nwg) return false;
        int wgid = (int)L; { const int q = nwg / NXCD, r = nwg % NXCD, xcd = wgid % NXCD, off = wgid / NXCD; wgid = (xcd < r ? xcd * (q + 1) : r * (q + 1) + (xcd - r) * q) + off; }
        const int nig = WGM * nN, gid = wgid / nig, fm = gid * WGM, gsz = (nM - fm) < WGM ? (nM - fm) : WGM;
        u.pm = fm + ((wgid % nig) % gsz); u.pn = (wgid % nig) / gsz; return true;
    }
    __device__ __forceinline__ void a_ready(const Unit&) const {}
    __device__ __forceinline__ void done(const Unit&) const {}
};

typedef float f32x2 __attribute__((ext_vector_type(2)));
typedef __bf16 bf16x2_t __attribute__((ext_vector_type(2)));
__device__ __forceinline__ unsigned cvt_pk_bf16(float lo, float hi) { f32x2 v = {lo, hi}; bf16x2_t b = __builtin_convertvector(v, bf16x2_t); return __builtin_bit_cast(unsigned, b); }

template <int ACT> struct EpiStore {
    static constexpr bool PERM = true, AFTER_DRAIN = false;
    bf16_t* O; int ldc; float* AB; int ab_tile; bf16_t* halo;
    __device__ __forceinline__ void operator()(const f32x4 (&acc)[2][2][4][2], const Unit& u, int wr, int wc, int fr, int fq) const {
        const int row0 = u.pm * BM + wr * 64 + fr;
        if (u.pn == ab_tile) {
            if (wc == 0) {
#pragma unroll
                for (int ai = 0; ai < 2; ++ai)
#pragma unroll
                    for (int m = 0; m < 4; ++m) { float* p = AB + (size_t)(row0 + ai * HALF + m * 16) * 32 + 8 * fq; *(f32x4*)p = acc[ai][0][m][0]; *(f32x4*)(p + 4) = acc[ai][0][m][1]; }
            }
            return;
        }
        const int col0 = u.pn * BM + wc * 32 + 8 * fq;
#pragma unroll
        for (int ai = 0; ai < 2; ++ai)
#pragma unroll
            for (int m = 0; m < 4; ++m) { bf16_t* rowp = O + (size_t)(row0 + ai * HALF + m * 16) * ldc + col0;
#pragma unroll
                for (int bj = 0; bj < 2; ++bj) { f32x4 v0 = acc[ai][bj][m][0], v1 = acc[ai][bj][m][1];
                    if (ACT == 1) {
#pragma unroll
                        for (int i = 0; i < 4; ++i) { const float a = fmaxf(v0[i], 0.f), b = fmaxf(v1[i], 0.f); v0[i] = a * a; v1[i] = b * b; } }
                    u32x4 w; w.x = cvt_pk_bf16(v0[0], v0[1]); w.y = cvt_pk_bf16(v0[2], v0[3]); w.z = cvt_pk_bf16(v1[0], v1[1]); w.w = cvt_pk_bf16(v1[2], v1[3]);
                    *(u32x4*)(rowp + bj * HALF) = w;
                    if (halo && u.pn < 12 && ((m == 0 && fr == 0) || (m == 3 && fr == 15))) { const int row = row0 + ai * HALF + m * 16;
                        *(u32x4*)(halo + ((size_t)(row >> 6) * 2 + (m == 3 ? 1 : 0)) * 3072 + col0 + bj * HALF) = w; } } }
    }
};
struct EpiResid {
    static constexpr bool PERM = false, AFTER_DRAIN = false;
    float* X; int ldc; const float* gate; int gstride;
    __device__ __forceinline__ void operator()(const f32x4 (&acc)[2][2][4][2], const Unit& u, int wr, int wc, int fr, int fq) const {
        const int row0 = u.pm * BM + wr * 64 + fr, col0 = u.pn * BM + wc * 32 + 4 * fq;
        const float* g = gate + (size_t)(u.pm < 32 ? 0 : (u.pm < 64 ? 1 : 2)) * gstride + col0;
        f32x4 gv[2][2];
#pragma unroll
        for (int bj = 0; bj < 2; ++bj)
#pragma unroll
            for (int n = 0; n < 2; ++n) gv[bj][n] = *(const f32x4*)(g + bj * HALF + n * 16);
#pragma unroll
        for (int ai = 0; ai < 2; ++ai)
#pragma unroll
            for (int m = 0; m < 4; ++m) { float* p = X + (size_t)(row0 + ai * HALF + m * 16) * ldc + col0;
#pragma unroll
                for (int bj = 0; bj < 2; ++bj)
#pragma unroll
                    for (int n = 0; n < 2; ++n) { float* q = p + bj * HALF + n * 16; *(f32x4*)q = *(const f32x4*)q + gv[bj][n] * acc[ai][bj][m][n]; }
                if (m & 1) asm volatile("" ::: "memory"); }
    }
};

template <class Epi, class Sched, bool ALIGN_EPI = false, bool SP2 = false>
__device__ __forceinline__ void gemm_phase(PG8_LAS unsigned char* lds, const Gemm g, const Sched& S, const Epi& E) {
    int tid_ = threadIdx.x; asm volatile("" : "+v"(tid_)); const int tid = tid_, wid = __builtin_amdgcn_readfirstlane(tid >> 6), lane = tid & 63, wr = wid >> 2, wc = wid & 3, fr = lane & 15, fq = lane >> 4;
    const int K = g.K, nt = K / BK;
    unsigned voffA[2], voffB[2];
#pragma unroll
    for (int i = 0; i < 2; ++i) { int R, C; stage_rc(tid * 16 + i * 8192, R, C); const int Rb = Epi::PERM ? ((R & ~31) + perm32(R & 31)) : R;
        voffA[i] = (unsigned)(R * K + C) * 2u; voffB[i] = (unsigned)(Rb * K + C) * 2u; }
    const size_t kstep = (size_t)(BK * 2);
    const size_t hstep = (size_t)HALF * K * 2;
    const size_t tstep = 2 * hstep;
    const unsigned ldsw = (unsigned)wid * 1024u;
    const int aoff = lds_byte(wr * 64 + fr, fq * 8), boff = lds_byte(wc * 32 + fr, fq * 8);
#define PG8_SA(b, h) (((b) * 2 + (h)) * HTB)
#define PG8_SB(b, h) ((4 + (b) * 2 + (h)) * HTB)
#define PG8_STAGE(bufoff, gbase, voff) do { _Pragma("unroll") for (int _i = 0; _i < 2; ++_i) \
        __builtin_amdgcn_global_load_lds((const unsigned*)((const char*)(gbase) + (voff)[_i]), (PG8_LAS unsigned*)(lds + (bufoff) + ldsw + _i * 8192), 16, 0, 0); } while (0)
#define PG8_LDA(dst, b, h) do { _Pragma("unroll") for (int m = 0; m < 4; ++m) _Pragma("unroll") for (int k = 0; k < 2; ++k) dst[m][k] = *(const PG8_LAS bf16x8*)(lds + PG8_SA(b, h) + aoff + m * 2048 + k * 1024); } while (0)
#define PG8_LDB(dst, b, h) do { _Pragma("unroll") for (int n = 0; n < 2; ++n) _Pragma("unroll") for (int k = 0; k < 2; ++k) dst[n][k] = *(const PG8_LAS bf16x8*)(lds + PG8_SB(b, h) + boff + n * 2048 + k * 1024); } while (0)
#define PG8_MMA(ai, bj, At, Bt) do { __builtin_amdgcn_s_setprio(1); _Pragma("unroll") for (int m = 0; m < 4; ++m) _Pragma("unroll") for (int n = 0; n < 2; ++n) _Pragma("unroll") for (int k = 0; k < 2; ++k) \
        acc[ai][bj][m][n] = __builtin_amdgcn_mfma_f32_16x16x32_bf16(Bt[n][k], At[m][k], acc[ai][bj][m][n], 0, 0, 0); __builtin_amdgcn_s_setprio(0); } while (0)
#define PG8_WAIT_V(n) asm volatile("s_waitcnt vmcnt(" #n ")" ::: "memory")
#define PG8_WAIT_L(n) asm volatile("s_waitcnt lgkmcnt(" #n ")" ::: "memory")
#define PG8_BAR __builtin_amdgcn_s_barrier()
#define PG8_SCHED __builtin_amdgcn_sched_barrier(0)
    Unit cur, nxt; int ui = 0;
    if (!S.next(0, cur)) return;
    f32x4 acc[2][2][4][2];
#pragma unroll
    for (int a = 0; a < 2; ++a)
#pragma unroll
        for (int b = 0; b < 2; ++b)
#pragma unroll
            for (int m = 0; m < 4; ++m)
#pragma unroll
                for (int n = 0; n < 2; ++n) acc[a][b][m][n] = (f32x4){0.f, 0.f, 0.f, 0.f};
    bf16x8 At[4][2], B0[2][2], B1[2][2];
    const char* cA = (const char*)g.A + (size_t)cur.pm * tstep; const char* cB = (const char*)g.Bt + (size_t)cur.pn * tstep;
    S.a_ready(cur);
    if constexpr (SP2) {
        PG8_STAGE(PG8_SB(0, 0), cB, voffB); PG8_STAGE(PG8_SB(0, 1), cB + hstep, voffB); PG8_STAGE(PG8_SA(0, 0), cA, voffA); PG8_STAGE(PG8_SA(0, 1), cA + hstep, voffA);
        if (wr == 1) PG8_BAR;
        PG8_WAIT_V(2); PG8_BAR;
        PG8_STAGE(PG8_SB(1, 0), cB + kstep, voffB); PG8_STAGE(PG8_SA(1, 0), cA + kstep, voffA); PG8_STAGE(PG8_SB(1, 1), cB + hstep + kstep, voffB);
        PG8_WAIT_V(6); PG8_BAR;
    } else {
        PG8_STAGE(PG8_SB(0, 0), cB, voffB); PG8_STAGE(PG8_SA(0, 0), cA, voffA); PG8_STAGE(PG8_SB(0, 1), cB + hstep, voffB); PG8_STAGE(PG8_SA(0, 1), cA + hstep, voffA);
        if (wr == 1) PG8_BAR;
        PG8_WAIT_V(4); PG8_BAR;
        PG8_STAGE(PG8_SB(1, 0), cB + kstep, voffB); PG8_STAGE(PG8_SA(1, 0), cA + kstep, voffA); PG8_STAGE(PG8_SB(1, 1), cB + hstep + kstep, voffB);
        PG8_WAIT_V(6); PG8_BAR;
    }
    for (;;) {
        const bool has_next = S.next(ui + 1, nxt);
        const char* nA = has_next ? (const char*)g.A + (size_t)nxt.pm * tstep : cA; const char* nB = has_next ? (const char*)g.Bt + (size_t)nxt.pn * tstep : cB;
        for (int t = 0; t < nt; t += 2) {
            const bool last = (t == nt - 2);
            const char* a1 = cA + (size_t)(t + 1) * kstep;
            const char* a2 = last ? nA : cA + (size_t)(t + 2) * kstep; const char* b2 = last ? nB : cB + (size_t)(t + 2) * kstep;
            const char* a3 = a2 + kstep; const char* b3 = b2 + kstep;
            if (last && has_next) S.a_ready(nxt);
            if constexpr (SP2) {
            PG8_LDB(B0, 0, 0); PG8_LDB(B1, 0, 1); PG8_SCHED; PG8_LDA(At, 0, 0); PG8_STAGE(PG8_SA(1, 1), a1 + hstep, voffA);
            PG8_WAIT_V(8); PG8_WAIT_L(0); PG8_BAR; PG8_MMA(0, 0, At, B0); PG8_MMA(0, 1, At, B1); PG8_BAR; PG8_SCHED;
            PG8_LDA(At, 0, 1); PG8_STAGE(PG8_SB(0, 0), b2, voffB); PG8_STAGE(PG8_SB(0, 1), b2 + hstep, voffB); PG8_STAGE(PG8_SA(0, 0), a2, voffA);
            PG8_WAIT_V(8); PG8_WAIT_L(0); PG8_BAR; PG8_MMA(1, 0, At, B0); PG8_MMA(1, 1, At, B1); PG8_BAR; PG8_SCHED;
            PG8_LDB(B0, 1, 0); PG8_LDB(B1, 1, 1); PG8_SCHED; PG8_LDA(At, 1, 0); PG8_STAGE(PG8_SA(0, 1), a2 + hstep, voffA);
            PG8_WAIT_V(8); PG8_WAIT_L(0); PG8_BAR; PG8_MMA(0, 0, At, B0); PG8_MMA(0, 1, At, B1); PG8_BAR; PG8_SCHED;
            PG8_LDA(At, 1, 1); PG8_STAGE(PG8_SB(1, 0), b3, voffB); PG8_STAGE(PG8_SB(1, 1), b3 + hstep, voffB); PG8_STAGE(PG8_SA(1, 0), a3, voffA);
            PG8_WAIT_V(8); PG8_WAIT_L(0); PG8_BAR; PG8_MMA(1, 0, At, B0); PG8_MMA(1, 1, At, B1); PG8_BAR; PG8_SCHED;
            } else {
            PG8_LDB(B0, 0, 0); PG8_SCHED; PG8_LDA(At, 0, 0); PG8_STAGE(PG8_SA(1, 1), a1 + hstep, voffA);
            PG8_WAIT_L(8); PG8_BAR; PG8_WAIT_L(0); PG8_MMA(0, 0, At, B0); PG8_BAR; PG8_SCHED;
            PG8_LDB(B1, 0, 1); PG8_STAGE(PG8_SB(0, 0), b2, voffB);
            PG8_BAR; PG8_WAIT_L(0); PG8_MMA(0, 1, At, B1); PG8_BAR;
            PG8_LDA(At, 0, 1); PG8_STAGE(PG8_SA(0, 0), a2, voffA);
            PG8_BAR; PG8_WAIT_L(0); PG8_MMA(1, 0, At, B0); PG8_BAR; PG8_SCHED;
            PG8_STAGE(PG8_SB(0, 1), b2 + hstep, voffB);
            PG8_WAIT_V(6); PG8_BAR; PG8_MMA(1, 1, At, B1); PG8_BAR;
            PG8_LDB(B0, 1, 0); PG8_SCHED; PG8_LDA(At, 1, 0); PG8_STAGE(PG8_SA(0, 1), a2 + hstep, voffA);
            PG8_WAIT_L(8); PG8_BAR; PG8_WAIT_L(0); PG8_MMA(0, 0, At, B0); PG8_BAR; PG8_SCHED;
            PG8_LDB(B1, 1, 1); PG8_STAGE(PG8_SB(1, 0), b3, voffB);
            PG8_BAR; PG8_WAIT_L(0); PG8_MMA(0, 1, At, B1); PG8_BAR;
            PG8_LDA(At, 1, 1); PG8_STAGE(PG8_SA(1, 0), a3, voffA);
            PG8_BAR; PG8_WAIT_L(0); PG8_MMA(1, 0, At, B0); PG8_BAR; PG8_SCHED;
            PG8_STAGE(PG8_SB(1, 1), b3 + hstep, voffB);
            PG8_WAIT_V(6); PG8_BAR; PG8_MMA(1, 1, At, B1); PG8_BAR;
            }
        }
        if constexpr (ALIGN_EPI) { if (wr == 0) PG8_BAR; }
        if constexpr (!Epi::AFTER_DRAIN) { E(acc, cur, wr, wc, fr, fq); S.done(cur); }
        if (!has_next) break;
#pragma unroll
        for (int a = 0; a < 2; ++a)
#pragma unroll
            for (int b = 0; b < 2; ++b)
#pragma unroll
                for (int m = 0; m < 4; ++m)
#pragma unroll
                    for (int n = 0; n < 2; ++n) acc[a][b][m][n] = (f32x4){0.f, 0.f, 0.f, 0.f};
        cur = nxt; cA = nA; cB = nB; ++ui;
        if constexpr (ALIGN_EPI) { if (wr == 1) PG8_BAR; }
    }
    PG8_WAIT_V(0);
    if constexpr (!ALIGN_EPI) { if (wr == 0) PG8_BAR; }
    PG8_BAR;
    if constexpr (Epi::AFTER_DRAIN) { E.fused(acc, cur, wr, wc, fr, fq, lds, wid, lane); S.done(cur); }
#undef PG8_SA
#undef PG8_SB
#undef PG8_STAGE
#undef PG8_LDA
#undef PG8_LDB
#undef PG8_MMA
#undef PG8_WAIT_V
#undef PG8_WAIT_L
#undef PG8_BAR
#undef PG8_SCHED
}
}

constexpr int D = 1024, NB = 2, T = 8192, CT = 256, DEPTH = 4, FF = 4096;
constexpr int ML = NB * T, MC = NB * CT, M = ML + MC;
constexpr int NADA = 6 * D;
constexpr int GDN_N = 4128, GDN_NP = 4352;
constexpr int NH = 8, HD = 128;
constexpr int NKV = CT + T;
constexpr float EPS = 1e-6f;
constexpr int NWAVES = 8, NTHR = 512;
constexpr float QSCALE = 0.125f * 1.4426950408889634f;
constexpr float LAMBDA_INIT = 0.47071302f;

constexpr size_t MiB = 1u << 20;
constexpr size_t WS_CTL = 0, CTL_ZERO_BYTES = 1 * MiB;
constexpr size_t WS_MOD = 1 * MiB;
constexpr size_t WS_ROPE = 2 * MiB;
constexpr size_t WS_AB = 4 * MiB;
constexpr size_t WS_OFC = 7 * MiB;
constexpr size_t WS_W1T = 10 * MiB, WS_W2T = 42 * MiB, WS_GINT = 74 * MiB, WS_GOUTT = 91 * MiB, WS_SINT = 95 * MiB, WS_SOUTT = 101 * MiB, WS_DINT = 103 * MiB, WS_DOUTT = 109 * MiB;
constexpr size_t WS_X = 112 * MiB;
constexpr size_t WS_H = 178 * MiB;
constexpr size_t WS_Y = 211 * MiB;
constexpr size_t WS_Z = 244 * MiB;
constexpr size_t WS_HALO = 376 * MiB;
constexpr size_t WS_END = 380 * MiB;
constexpr size_t WS_PD = WS_H;

constexpr int LDS_BYTES = 149504;

#define LAS __attribute__((address_space(3)))
typedef unsigned short bf16;
typedef unsigned u32x4 __attribute__((ext_vector_type(4)));
typedef unsigned u32x2 __attribute__((ext_vector_type(2)));
typedef float f32x4 __attribute__((ext_vector_type(4)));
typedef float f32x2 __attribute__((ext_vector_type(2)));
typedef float f32x16 __attribute__((ext_vector_type(16)));
typedef short bf16x8 __attribute__((ext_vector_type(8)));
typedef short s16x4 __attribute__((ext_vector_type(4)));
#define LDS_WAIT() asm volatile("s_waitcnt lgkmcnt(0)" ::: "memory")

__device__ __forceinline__ float bf2f(unsigned u) { return __uint_as_float(u << 16); }
__device__ __forceinline__ unsigned pk2(float lo, float hi) { return pg8::cvt_pk_bf16(lo, hi); }
__device__ __forceinline__ float wave_sum(float v) {
#pragma unroll
    for (int o = 1; o < 64; o <<= 1) v += __shfl_xor(v, o);
    return v;
}
__device__ __forceinline__ float silu_f(float x) { return x / (1.f + expf(-x)); }
__device__ __forceinline__ int crow(int r, int hi) { return (r & 3) + 8 * (r >> 2) + 4 * hi; }

struct Args { const float* in[24]; float* out; unsigned char* ws; int step_lo, step_hi, coop, pad; };
typedef const __attribute__((address_space(4))) Args* KArgs;
__device__ __forceinline__ KArgs kargs() { unsigned long long p = (unsigned long long)__builtin_amdgcn_kernarg_segment_ptr(); asm volatile("" : "+s"(p)); return (KArgs)p; }
#define INP(k) (kargs()->in[k])
extern __shared__ __attribute__((aligned(16))) unsigned char lds_raw[];
struct Frame { LAS unsigned char* lds; int tid, lane, wave, G, bid; float* out; unsigned char* ws; };
__device__ __forceinline__ Frame make_frame() {
    Frame F; F.lds = (LAS unsigned char*)lds_raw; F.tid = threadIdx.x; asm volatile("" : "+v"(F.tid)); F.lane = F.tid & 63; F.wave = __builtin_amdgcn_readfirstlane(F.tid >> 6); F.G = gridDim.x; F.bid = blockIdx.x; asm volatile("" : "+s"(F.G), "+s"(F.bid));
    KArgs a = kargs(); F.out = a->out; F.ws = a->ws; return F;
}
enum { I_X = 0, I_C, I_CTX, I_CCTX, I_N1G, I_N2G, I_ADAW, I_ADAB, I_W1, I_W2, I_GIN, I_GCONV, I_GALOG, I_GDT, I_GNG, I_GOUT, I_SIN, I_SCONV, I_SOUT, I_DIN, I_DLAM, I_DNG, I_DOUT, I_FG };

__device__ __forceinline__ void transpose_item(const float* W, int K, int ldw, bf16* WT, LAS float* scr, int item, int nblk, int lane) {
    const int kb = item / nblk, nb = item % nblk, k0 = 64 * kb, n0 = 32 * nb;
#pragma unroll 8
    for (int i = 0; i < 32; ++i) { const int kk = 2 * i + (lane >> 5); scr[kk * 33 + (lane & 31)] = W[(size_t)(k0 + kk) * ldw + n0 + (lane & 31)]; }
    LDS_WAIT(); asm volatile("" ::: "memory");
    const int c = lane & 7;
#pragma unroll
    for (int j = 0; j < 4; ++j) { const int n = (lane >> 3) + 8 * j; const LAS float* s = scr + (8 * c) * 33 + n;
        u32x4 o; o.x = pk2(s[0 * 33], s[1 * 33]); o.y = pk2(s[2 * 33], s[3 * 33]); o.z = pk2(s[4 * 33], s[5 * 33]); o.w = pk2(s[6 * 33], s[7 * 33]);
        *(u32x4*)(WT + (size_t)(n0 + n) * K + k0 + 8 * c) = o; }
    LDS_WAIT(); asm volatile("" ::: "memory");
}
__device__ __forceinline__ void get_mat(unsigned char* ws_, int idx, const float*& src, bf16*& dst, int& K, int& N, int& ld) {
    unsigned char* ws = ws_;
    if (idx < 4)       { src = INP(I_W1) + (size_t)idx * D * FF; dst = (bf16*)(ws + WS_W1T) + (size_t)idx * D * FF; K = D; N = FF; ld = FF; }
    else if (idx < 8)  { const int i = idx - 4; src = INP(I_W2) + (size_t)i * D * FF; dst = (bf16*)(ws + WS_W2T) + (size_t)i * D * FF; K = FF; N = D; ld = D; }
    else if (idx < 10) { const int j = idx - 8; src = INP(I_GIN) + (size_t)j * D * GDN_N; dst = (bf16*)(ws + WS_GINT) + (size_t)j * GDN_NP * D; K = D; N = GDN_N; ld = GDN_N; }
    else if (idx < 12) { const int j = idx - 10; src = INP(I_GOUT) + (size_t)j * D * D; dst = (bf16*)(ws + WS_GOUTT) + (size_t)j * D * D; K = D; N = D; ld = D; }
    else if (idx == 12) { src = INP(I_SIN); dst = (bf16*)(ws + WS_SINT); K = D; N = 3 * D; ld = 3 * D; }
    else if (idx == 13) { src = INP(I_SOUT); dst = (bf16*)(ws + WS_SOUTT); K = D; N = D; ld = D; }
    else if (idx == 14) { src = INP(I_DIN); dst = (bf16*)(ws + WS_DINT); K = D; N = 3 * D; ld = 3 * D; }
    else { src = INP(I_DOUT); dst = (bf16*)(ws + WS_DOUTT); K = D; N = D; ld = D; }
}
__device__ __forceinline__ void step_prologue() {
    const Frame F = make_frame();
    const int gw = F.bid * NWAVES + F.wave, NGW = F.G * NWAVES;
    const int gt = F.bid * NTHR + F.tid, NGT = F.G * NTHR;
    {
        LAS float* scr = (LAS float*)(F.lds + F.wave * 16384);
        for (int mi = 0; mi < 16; ++mi) {
            const float* src; bf16* dst; int K, N, ld; get_mat(F.ws, mi, src, dst, K, N, ld);
            const int nblk = N / 32, nitems = (K / 64) * nblk;
            for (int it = gw; it < nitems; it += NGW) transpose_item(src, K, ld, dst, scr, it, nblk, F.lane);
        }
        for (int j = 0; j < 2; ++j) { u32x4* z = (u32x4*)((bf16*)(F.ws + WS_GINT) + (size_t)j * GDN_NP * D + (size_t)GDN_N * D);
            for (int i = gt; i < (GDN_NP - GDN_N) * D / 8; i += NGT) z[i] = (u32x4){0u, 0u, 0u, 0u}; }
    }
    __syncthreads();
    {
        LAS float* sv = (LAS float*)F.lds;
        LAS float* red = sv + 3 * D;
        for (int i = F.tid; i < 3 * D; i += NTHR) { const int g = i / D, k = i % D; const float c = g < 2 ? INP(I_C)[g * D + k] : INP(I_CCTX)[k]; sv[i] = silu_f(c); }
        __syncthreads();
        float* MOD = (float*)(F.ws + WS_MOD);
        const int c = F.tid & 63, ks = F.tid >> 6;
        for (int it = F.bid; it < DEPTH * (NADA / 64); it += F.G) {
            const int li = it / (NADA / 64), n0 = (it % (NADA / 64)) * 64;
            const float* w = INP(I_ADAW) + (size_t)li * D * NADA + (size_t)(ks * 128) * NADA + n0 + c;
            float a0 = 0.f, a1 = 0.f, a2 = 0.f;
#pragma unroll 8
            for (int k = 0; k < 128; ++k) { const float wv = w[(size_t)k * NADA]; const int kk = ks * 128 + k; a0 += sv[kk] * wv; a1 += sv[D + kk] * wv; a2 += sv[2 * D + kk] * wv; }
            red[(ks * 3 + 0) * 64 + c] = a0; red[(ks * 3 + 1) * 64 + c] = a1; red[(ks * 3 + 2) * 64 + c] = a2;
            __syncthreads();
            if (F.tid < 192) { const int g = F.tid >> 6; float s = INP(I_ADAB)[li * NADA + n0 + c];
#pragma unroll
                for (int q = 0; q < 8; ++q) s += red[(q * 3 + g) * 64 + c];
                MOD[((size_t)li * 3 + g) * NADA + n0 + c] = s; }
            __syncthreads();
        }
    }
    {
        f32x4* X4 = (f32x4*)(F.ws + WS_X); const f32x4* x4 = (const f32x4*)INP(I_X); const f32x4* c4 = (const f32x4*)INP(I_CTX);
        for (int i = gt; i < M * (D / 4); i += NGT) X4[i] = i < ML * (D / 4) ? x4[i] : c4[i - ML * (D / 4)];
    }
    {
        f32x2* R = (f32x2*)(F.ws + WS_ROPE);
        for (int i = gt; i < T * 32; i += NGT) { const int t = i >> 5, p = i & 31, f = p & 15;
            const float inv = powf(10000.0f, -(float)f / 16.0f); const float pos = (float)(p < 16 ? (t >> 6) : (t & 63)); const float ang = pos * inv;
            R[i] = (f32x2){cosf(ang), sinf(ang)}; }
    }
}

__device__ __forceinline__ void step_norm(int layer, int which, int nrows, bool zero_of) {
    const Frame F = make_frame();
    const int gw = F.bid * NWAVES + F.wave, NGW = F.G * NWAVES;
    const float* X = (const float*)(F.ws + WS_X); bf16* H = (bf16*)(F.ws + WS_H);
    const float* ng = (which ? INP(I_N2G) : INP(I_N1G)) + layer * D;
    const float* MOD = (const float*)(F.ws + WS_MOD) + (size_t)layer * 3 * NADA + which * 3 * D;
    for (int row = gw; row < nrows; row += NGW) {
        const int grp = row < T ? 0 : (row < ML ? 1 : 2);
        const f32x4* xr = (const f32x4*)(X + (size_t)row * D) + F.lane;
        const f32x4* sh = (const f32x4*)(MOD + (size_t)grp * NADA) + F.lane; const f32x4* sc = (const f32x4*)(MOD + (size_t)grp * NADA + D) + F.lane; const f32x4* gg = (const f32x4*)ng + F.lane;
        f32x4 v[4]; float s = 0.f;
#pragma unroll
        for (int j = 0; j < 4; ++j) { v[j] = xr[64 * j]; s += (v[j].x * v[j].x + v[j].y * v[j].y) + (v[j].z * v[j].z + v[j].w * v[j].w); }
        const float rstd = 1.0f / sqrtf(wave_sum(s) * (1.f / D) + EPS);
        u32x2* o = (u32x2*)(H + (size_t)row * D) + F.lane;
#pragma unroll
        for (int j = 0; j < 4; ++j) { const f32x4 g4 = gg[64 * j], s4 = sc[64 * j], h4 = sh[64 * j]; const f32x4 y = (v[j] * rstd) * g4; const f32x4 h = y * (1.0f + s4) + h4;
            o[64 * j] = (u32x2){pk2(h.x, h.y), pk2(h.z, h.w)}; }
    }
    if (zero_of) {
        const int gt = F.bid * NTHR + F.tid, NGT = F.G * NTHR;
        f32x4* a = (f32x4*)F.out; for (int i = gt; i < ML * (D / 4); i += NGT) a[i] = (f32x4){0.f, 0.f, 0.f, 0.f};
        f32x4* b = (f32x4*)(F.ws + WS_OFC); for (int i = gt; i < MC * (D / 4); i += NGT) b[i] = (f32x4){0.f, 0.f, 0.f, 0.f};
    }
}
__device__ __forceinline__ void step_final() {
    const Frame F = make_frame();
    const int gw = F.bid * NWAVES + F.wave, NGW = F.G * NWAVES;
    const float* X = (const float*)(F.ws + WS_X);
    for (int row = gw; row < ML; row += NGW) {
        const f32x4* xr = (const f32x4*)(X + (size_t)row * D) + F.lane; const f32x4* gg = (const f32x4*)INP(I_FG) + F.lane;
        f32x4 v[4]; float s = 0.f;
#pragma unroll
        for (int j = 0; j < 4; ++j) { v[j] = xr[64 * j]; s += (v[j].x * v[j].x + v[j].y * v[j].y) + (v[j].z * v[j].z + v[j].w * v[j].w); }
        const float rstd = 1.0f / sqrtf(wave_sum(s) * (1.f / D) + EPS);
        f32x4* o = (f32x4*)(F.out + (size_t)row * D) + F.lane;
#pragma unroll
        for (int j = 0; j < 4; ++j) o[64 * j] = (v[j] * rstd) * gg[64 * j];
    }
}

__device__ __forceinline__ void step_gdn_scan(int j) {
    const Frame F = make_frame();
    LAS float* qs = (LAS float*)F.lds;
    LAS float* ks = qs + 64 * 128;
    LAS float* vs = ks + 64 * 128;
    LAS float* ga = vs + 64 * 128;
    LAS float* be = ga + 64;
    const bf16* Z = (const bf16*)(F.ws + WS_Z);
    const float* AB = (const float*)(F.ws + WS_AB);
    const float* cw = INP(I_GCONV) + (size_t)j * 3 * 3072;
    float* OFC = (float*)(F.ws + WS_OFC);
    for (int it = F.bid; it < 32; it += F.G) {
        const int b = it >> 4, h = (it >> 1) & 7, dir = it & 1;
        const float Aco = expf(INP(I_GALOG)[j * 16 + dir * 8 + h]); const float dtb = INP(I_GDT)[j * 16 + dir * 8 + h];
        float S[64];
#pragma unroll
        for (int i = 0; i < 64; ++i) S[i] = 0.f;
        const int jcol = F.tid >> 1, half = F.tid & 1;
        for (int n = 0; n < 132; ++n) {
            const bool isctx = n < 4; const int L = isctx ? CT : T; const int p0 = isctx ? 64 * n : 64 * (n - 4); const int rbase = isctx ? ML + b * CT : b * T;
            for (int idx = F.tid; idx < 64 * 384; idx += NTHR) {
                const int c = idx / 384, ch = idx % 384, part = ch >> 7, e = ch & 127;
                const int p = p0 + c; const int t = dir ? (L - 1 - p) : p; const int col = part * 1024 + h * 128 + e;
                float acc = 0.f;
#pragma unroll
                for (int tap = 0; tap < 3; ++tap) { const int tt = t + tap - 1; if (tt >= 0 && tt < L) acc += cw[tap * 3072 + col] * bf2f(Z[(size_t)(rbase + tt) * 4096 + col]); }
                acc = silu_f(acc);
                LAS float* dst = part == 0 ? qs : (part == 1 ? ks : vs); dst[c * 128 + e] = acc;
            }
            if (F.tid < 64) { const int p = p0 + F.tid; const int t = dir ? (L - 1 - p) : p; const size_t row = (size_t)(rbase + t);
                const float av = AB[row * 32 + dir * 8 + h], bv = AB[row * 32 + 16 + dir * 8 + h];
                const float x = av + dtb; const float sp = x > 20.f ? x : log1pf(expf(x));
                ga[F.tid] = expf(-Aco * sp); be[F.tid] = 1.f / (1.f + expf(-bv)); }
            __syncthreads();
#pragma unroll 1
            for (int rr = 0; rr < 8; ++rr) { const int c = F.wave * 8 + rr;
                const float q0 = qs[c * 128 + F.lane], q1 = qs[c * 128 + 64 + F.lane]; const float sq = 0.08838834764831845f / sqrtf(wave_sum(q0 * q0 + q1 * q1) + EPS);
                qs[c * 128 + F.lane] = q0 * sq; qs[c * 128 + 64 + F.lane] = q1 * sq;
                const float k0 = ks[c * 128 + F.lane], k1 = ks[c * 128 + 64 + F.lane]; const float sk = 1.0f / sqrtf(wave_sum(k0 * k0 + k1 * k1) + EPS);
                ks[c * 128 + F.lane] = k0 * sk; ks[c * 128 + 64 + F.lane] = k1 * sk; }
            __syncthreads();
            if (F.tid < 256) {
#pragma unroll 1
                for (int c = 0; c < 64; ++c) {
                    const float a = ga[c], bt = be[c];
                    const LAS f32x4* k4 = (const LAS f32x4*)(ks + c * 128 + 64 * half); const LAS f32x4* q4 = (const LAS f32x4*)(qs + c * 128 + 64 * half);
                    float dot = 0.f;
#pragma unroll
                    for (int i = 0; i < 16; ++i) { const f32x4 kv = k4[i]; dot += kv.x * S[4 * i] + kv.y * S[4 * i + 1] + kv.z * S[4 * i + 2] + kv.w * S[4 * i + 3]; }
                    dot += __shfl_xor(dot, 1);
                    const float tmp = bt * (vs[c * 128 + jcol] - a * dot);
                    float o = 0.f;
#pragma unroll
                    for (int i = 0; i < 16; ++i) { const f32x4 kv = k4[i]; const f32x4 qv = q4[i];
                        S[4 * i] = a * S[4 * i] + kv.x * tmp; S[4 * i + 1] = a * S[4 * i + 1] + kv.y * tmp; S[4 * i + 2] = a * S[4 * i + 2] + kv.z * tmp; S[4 * i + 3] = a * S[4 * i + 3] + kv.w * tmp;
                        o += qv.x * S[4 * i] + qv.y * S[4 * i + 1] + qv.z * S[4 * i + 2] + qv.w * S[4 * i + 3]; }
                    o += __shfl_xor(o, 1);
                    const int p = p0 + c; const int t = dir ? (L - 1 - p) : p;
                    float* dst = isctx ? OFC + (size_t)(b * CT + t) * D : F.out + (size_t)(b * T + t) * D;
                    if (half == 0) atomicAdd(dst + h * 128 + jcol, o);
                }
            }
            __syncthreads();
        }
    }
}
__device__ __forceinline__ void step_gdn_norm(int j) {
    const Frame F = make_frame();
    const int gw = F.bid * NWAVES + F.wave, NGW = F.G * NWAVES;
    const bf16* Z = (const bf16*)(F.ws + WS_Z); bf16* Y = (bf16*)(F.ws + WS_Y); const float* ng = INP(I_GNG) + j * 128;
    for (int row = gw; row < M; row += NGW) {
        const float* src = row < ML ? F.out + (size_t)row * D : (const float*)(F.ws + WS_OFC) + (size_t)(row - ML) * D;
        const f32x4* s4 = (const f32x4*)(src + 16 * F.lane);
        float v[16]; float ss = 0.f;
#pragma unroll
        for (int q = 0; q < 4; ++q) { const f32x4 x = s4[q]; v[4 * q] = x.x; v[4 * q + 1] = x.y; v[4 * q + 2] = x.z; v[4 * q + 3] = x.w; ss += (x.x * x.x + x.y * x.y) + (x.z * x.z + x.w * x.w); }
        ss += __shfl_xor(ss, 1); ss += __shfl_xor(ss, 2); ss += __shfl_xor(ss, 4);
        const float rstd = 1.0f / sqrtf(ss * (1.f / 128.f) + EPS);
        const u32x4* g4 = (const u32x4*)(Z + (size_t)row * 4096 + 3072 + 16 * F.lane);
        const int e0 = (16 * F.lane) & 127;
        u32x4 o[2];
#pragma unroll
        for (int q = 0; q < 2; ++q) { const u32x4 gz = g4[q]; unsigned w[4];
#pragma unroll
            for (int i = 0; i < 4; ++i) { const unsigned gg = gz[i]; const float g0 = bf2f(gg & 0xffffu), g1 = bf2f(gg >> 16); const int e = e0 + 8 * q + 2 * i;
                w[i] = pk2(v[8 * q + 2 * i] * rstd * ng[e] * silu_f(g0), v[8 * q + 2 * i + 1] * rstd * ng[e + 1] * silu_f(g1)); }
            o[q] = (u32x4){w[0], w[1], w[2], w[3]}; }
        u32x4* dst = (u32x4*)(Y + (size_t)row * D + 16 * F.lane); dst[0] = o[0]; dst[1] = o[1];
    }
}

__device__ __forceinline__ void step_sconv() {
    const Frame F = make_frame();
    const int gt = F.bid * NTHR + F.tid, NGT = F.G * NTHR;
    const bf16* Z = (const bf16*)(F.ws + WS_Z); bf16* Y = (bf16*)(F.ws + WS_Y); const float* cw = INP(I_SCONV);
    for (int idx = gt; idx < M * 128; idx += NGT) {
        const int row = idx >> 7, c0 = (idx & 127) * 8;
        int t, L, rbase; if (row < ML) { t = row & (T - 1); L = T; rbase = row - t; } else { const int r2 = row - ML; t = r2 & (CT - 1); L = CT; rbase = row - t; }
        float acc[8];
#pragma unroll
        for (int i = 0; i < 8; ++i) acc[i] = 0.f;
#pragma unroll
        for (int tap = 0; tap < 3; ++tap) { const int tt = t + tap - 1;
            if (tt >= 0 && tt < L) { const bf16* zr = Z + (size_t)(rbase + tt) * 3072; const u32x4 cg = *(const u32x4*)(zr + 1024 + c0), hv = *(const u32x4*)(zr + 2048 + c0);
                const f32x4 w0 = *(const f32x4*)(cw + tap * 1024 + c0), w1 = *(const f32x4*)(cw + tap * 1024 + c0 + 4); const float w[8] = {w0.x, w0.y, w0.z, w0.w, w1.x, w1.y, w1.z, w1.w};
#pragma unroll
                for (int i = 0; i < 4; ++i) { acc[2 * i] += w[2 * i] * bf2f(cg[i] & 0xffffu) * bf2f(hv[i] & 0xffffu); acc[2 * i + 1] += w[2 * i + 1] * bf2f(cg[i] >> 16) * bf2f(hv[i] >> 16); } } }
        const u32x4 bg = *(const u32x4*)(Z + (size_t)row * 3072 + c0); u32x4 o;
#pragma unroll
        for (int i = 0; i < 4; ++i) o[i] = pk2(bf2f(bg[i] & 0xffffu) * acc[2 * i], bf2f(bg[i] >> 16) * acc[2 * i + 1]);
        *(u32x4*)(Y + (size_t)row * D + c0) = o;
    }
}

__device__ __forceinline__ void step_rope() {
    const Frame F = make_frame();
    const int gw = F.bid * NWAVES + F.wave, NGW = F.G * NWAVES;
    bf16* Z = (bf16*)(F.ws + WS_Z); const f32x4* R = (const f32x4*)(F.ws + WS_ROPE);
    for (int row = gw; row < M; row += NGW) {
        u32x4* p = (u32x4*)(Z + (size_t)row * 3072 + 32 * F.lane);
        u32x4 v[4];
#pragma unroll
        for (int q = 0; q < 4; ++q) v[q] = p[q];
        const bool lat = row < ML; const float sc = F.lane < 32 ? QSCALE : 1.0f;
        const f32x4* tab = R + ((size_t)(row & (T - 1)) * 32 + 16 * (F.lane & 1)) / 2;
#pragma unroll
        for (int q = 0; q < 4; ++q) {
#pragma unroll
            for (int i = 0; i < 4; i += 2) {
                f32x4 cs = (f32x4){1.f, 0.f, 1.f, 0.f}; if (lat) cs = tab[(4 * q + i) / 2];
                { const unsigned w = v[q][i]; const float x0 = bf2f(w & 0xffffu), x1 = bf2f(w >> 16); v[q][i] = pk2((x0 * cs.x - x1 * cs.y) * sc, (x0 * cs.y + x1 * cs.x) * sc); }
                { const unsigned w = v[q][i + 1]; const float x0 = bf2f(w & 0xffffu), x1 = bf2f(w >> 16); v[q][i + 1] = pk2((x0 * cs.z - x1 * cs.w) * sc, (x0 * cs.w + x1 * cs.z) * sc); }
            }
        }
#pragma unroll
        for (int q = 0; q < 4; ++q) p[q] = v[q];
    }
    bf16* Vt = (bf16*)(F.ws + WS_H);
    LAS bf16* tl = (LAS bf16*)(F.lds + F.wave * 18432);
    for (int it = gw; it < NB * NH * (NKV / 64); it += NGW) {
        const int kt = it % (NKV / 64), bh = it / (NKV / 64), b = bh >> 3, h = bh & 7; const int kv0 = 64 * kt;
        const int srow = kv0 < CT ? ML + b * CT + kv0 : b * T + kv0 - CT;
#pragma unroll 4
        for (int i = 0; i < 16; ++i) { const int r = 4 * i + (F.lane >> 4), cc = (F.lane & 15) * 8;
            const u32x4 v = *(const u32x4*)(Z + (size_t)(srow + r) * 3072 + 2048 + h * 128 + cc);
#pragma unroll
            for (int q = 0; q < 4; ++q) { tl[(cc + 2 * q) * 72 + r] = (bf16)(v[q] & 0xffffu); tl[(cc + 2 * q + 1) * 72 + r] = (bf16)(v[q] >> 16); } }
        LDS_WAIT(); asm volatile("" ::: "memory");
#pragma unroll 4
        for (int i = 0; i < 16; ++i) { const int e = 8 * i + (F.lane >> 3), ch = F.lane & 7;
            const u32x4 v = *(const LAS u32x4*)(tl + e * 72 + ch * 8);
            *(u32x4*)(Vt + ((size_t)(bh * 128 + e)) * NKV + kv0 + ch * 8) = v; }
        LDS_WAIT(); asm volatile("" ::: "memory");
    }
}
__device__ __forceinline__ void step_attn() {
    const Frame F = make_frame();
    const bf16* Z = (const bf16*)(F.ws + WS_Z); const bf16* Vt = (const bf16*)(F.ws + WS_H); bf16* Y = (bf16*)(F.ws + WS_Y);
    LAS float* EX = (LAS float*)F.lds;
    const int r = F.lane & 31, hi = F.lane >> 5, qs = F.wave & 3, m = F.wave >> 2;
    float lmb;
    { const float* lam = INP(I_DLAM); const float t1 = lam[F.lane] * lam[64 + F.lane], t2 = lam[128 + F.lane] * lam[192 + F.lane]; lmb = expf(wave_sum(t1)) - expf(wave_sum(t2)) + LAMBDA_INIT; }
    const float* ng = INP(I_DNG);
    for (int u = F.bid; u < 1056; u += F.G) {
        int b, h, qrow0, nk;
        if (u < 1024) { b = u >> 9; h = (u >> 6) & 7; qrow0 = b * T + (u & 63) * 128; nk = NKV / 32; }
        else { const int v = u - 1024; b = v >> 4; h = (v >> 1) & 7; qrow0 = ML + b * CT + (v & 1) * 128; nk = CT / 32; }
        const int row0 = qrow0 + 32 * qs;
        bf16x8 qf[4];
#pragma unroll
        for (int d0 = 0; d0 < 4; ++d0) qf[d0] = *(const bf16x8*)(Z + (size_t)(row0 + r) * 3072 + h * 128 + m * 64 + d0 * 16 + hi * 8);
        const int kcol = 1024 + h * 128 + m * 64 + hi * 8;
        const bf16* vtb = Vt + (size_t)((b * 8 + h) * 128 + r) * NKV + 4 * hi;
        f32x16 o[4];
#pragma unroll
        for (int i = 0; i < 4; ++i)
#pragma unroll
            for (int q = 0; q < 16; ++q) o[i][q] = 0.f;
        float mref = 0.f, l = 0.f;
        for (int s = 0; s < nk; ++s) {
            const int kv0 = 32 * s; const int krow = kv0 < CT ? ML + b * CT + kv0 : b * T + kv0 - CT;
            const bf16* kp = Z + (size_t)(krow + r) * 3072 + kcol;
            bf16x8 kf[4];
#pragma unroll
            for (int d0 = 0; d0 < 4; ++d0) kf[d0] = *(const bf16x8*)(kp + d0 * 16);
            bf16x8 vf[4][2];
#pragma unroll
            for (int i = 0; i < 4; ++i)
#pragma unroll
                for (int s2 = 0; s2 < 2; ++s2) { const bf16* vp = vtb + (size_t)(32 * i) * NKV + kv0 + 16 * s2; const s16x4 lo = *(const s16x4*)vp, h8 = *(const s16x4*)(vp + 8);
                    vf[i][s2] = (bf16x8){lo[0], lo[1], lo[2], lo[3], h8[0], h8[1], h8[2], h8[3]}; }
            f32x16 S;
#pragma unroll
            for (int q = 0; q < 16; ++q) S[q] = 0.f;
#pragma unroll
            for (int d0 = 0; d0 < 4; ++d0) S = __builtin_amdgcn_mfma_f32_32x32x16_bf16(kf[d0], qf[d0], S, 0, 0, 0);
            float mx = S[0];
#pragma unroll
            for (int q = 1; q < 16; ++q) mx = fmaxf(mx, S[q]);
            mx = fmaxf(mx, __shfl_xor(mx, 32));
            if (s == 0) mref = mx;
            else if (__any(mx > mref)) { const float mn = fmaxf(mref, mx); const float al = __builtin_amdgcn_exp2f(mref - mn); l *= al; mref = mn;
#pragma unroll
                for (int i = 0; i < 4; ++i)
#pragma unroll
                    for (int q = 0; q < 16; ++q) o[i][q] *= al; }
            float ps = 0.f;
#pragma unroll
            for (int q = 0; q < 16; ++q) { S[q] = __builtin_amdgcn_exp2f(S[q] - mref); ps += S[q]; }
            l += ps;
            bf16x8 pf[2];
#pragma unroll
            for (int s2 = 0; s2 < 2; ++s2) { u32x4 w; w.x = pk2(S[8 * s2], S[8 * s2 + 1]); w.y = pk2(S[8 * s2 + 2], S[8 * s2 + 3]); w.z = pk2(S[8 * s2 + 4], S[8 * s2 + 5]); w.w = pk2(S[8 * s2 + 6], S[8 * s2 + 7]); pf[s2] = __builtin_bit_cast(bf16x8, w); }
#pragma unroll
            for (int i = 0; i < 4; ++i)
#pragma unroll
                for (int s2 = 0; s2 < 2; ++s2) o[i] = __builtin_amdgcn_mfma_f32_32x32x16_bf16(vf[i][s2], pf[s2], o[i], 0, 0, 0);
        }
        l += __shfl_xor(l, 32);
        const float f = (m == 1 ? lmb : 1.0f) / l;
        LAS float* ex = EX + (size_t)m * 128 * 129 + (qs * 32 + r) * 129;
#pragma unroll
        for (int i = 0; i < 4; ++i)
#pragma unroll
            for (int q = 0; q < 16; ++q) ex[32 * i + crow(q, hi)] = o[i][q] * f;
        __syncthreads();
#pragma unroll 1
        for (int rr = 0; rr < 16; ++rr) { const int row = 16 * F.wave + rr;
            const float a0 = EX[row * 129 + F.lane] - EX[128 * 129 + row * 129 + F.lane], a1 = EX[row * 129 + 64 + F.lane] - EX[128 * 129 + row * 129 + 64 + F.lane];
            const float rstd = (1.0f - LAMBDA_INIT) / sqrtf(wave_sum(a0 * a0 + a1 * a1) * (1.f / 128.f) + EPS);
            bf16* yr = Y + (size_t)(qrow0 + row) * D + h * 128;
            yr[F.lane] = (bf16)(pk2(a0 * rstd * ng[F.lane], 0.f) & 0xffffu); yr[64 + F.lane] = (bf16)(pk2(a1 * rstd * ng[64 + F.lane], 0.f) & 0xffffu); }
        __syncthreads();
    }
}

constexpr int PD_BYTES = 12800, PD_ATT = 6144, PD_EG = 12288, PD_EW = 12544;
__device__ __forceinline__ unsigned off_a(unsigned row, unsigned ch) { return 2048u * (row >> 3) + 512u * (ch >> 2) + 64u * (row & 7) + 16u * ((ch & 3) ^ ((row >> 2) & 3)); }
__device__ __forceinline__ int frag_off(int c, int s) {
    const int slot = (c >> 5) == (s >> 5) ? ((c >> 5) ? 2 : 0) : 1, s2 = (s & 31) >> 4, hh = ((s & 15) >> 2) & 1, jj = ((s & 15) >> 3) * 4 + (s & 3), r = c & 31;
    return slot * 2048 + s2 * 1024 + (hh * 32 + r) * 16 + jj * 2;
}
__device__ __forceinline__ void step_gdn_prep(int j) {
    const Frame F = make_frame();
    LAS float* STG = (LAS float*)F.lds;
    LAS float* KK = (LAS float*)F.lds;
    LAS float* QK = KK + 64 * 65;
    LAS float* LP = (LAS float*)(F.lds + 33280);
    LAS unsigned char* OUT = F.lds + 66048;
    LAS unsigned char* QI = F.lds + 99328; LAS unsigned char* KI = F.lds + 115712;
    LAS float* SM = (LAS float*)(F.lds + 132096);
    bf16* Z = (bf16*)(F.ws + WS_Z); const float* AB = (const float*)(F.ws + WS_AB); const bf16* HALO = (const bf16*)(F.ws + WS_HALO); unsigned char* PD = F.ws + WS_PD;
    const float* cw = INP(I_GCONV) + (size_t)j * 3 * 3072;
    const int r = F.lane & 31, hi = F.lane >> 5;
    for (int it = F.bid; it < NB * NH * 132; it += F.G) {
        const int n = it % 132, bh = it / 132, b = bh >> 3, h = bh & 7;
        const bool isctx = n < 4; const int L = isctx ? CT : T; const int t0 = isctx ? 64 * n : 64 * (n - 4); const int row0 = (isctx ? ML + b * CT : b * T) + t0;
        for (int idx = F.tid; idx < 3072; idx += NTHR) {
            const int c = idx / 48, g8 = idx % 48, part = g8 >> 4, e0 = (g8 & 15) * 8; const int col = part * 1024 + h * 128 + e0; const int t = t0 + c;
            const u32x4 zero = (u32x4){0u, 0u, 0u, 0u};
            const u32x4 z0 = *(const u32x4*)(Z + (size_t)(row0 + c) * 4096 + col);
            u32x4 zm = zero, zp = zero;
            if (t > 0) zm = c == 0 ? *(const u32x4*)(HALO + ((size_t)((row0 >> 6) - 1) * 2 + 1) * 3072 + col) : *(const u32x4*)(Z + (size_t)(row0 + c - 1) * 4096 + col);
            if (t < L - 1) zp = c == 63 ? *(const u32x4*)(HALO + ((size_t)((row0 >> 6) + 1) * 2) * 3072 + col) : *(const u32x4*)(Z + (size_t)(row0 + c + 1) * 4096 + col);
            const float* wp = cw + col;
            float o[8];
#pragma unroll
            for (int q = 0; q < 2; ++q) { const f32x4 w0 = *(const f32x4*)(wp + 4 * q), w1 = *(const f32x4*)(wp + 3072 + 4 * q), w2 = *(const f32x4*)(wp + 6144 + 4 * q);
#pragma unroll
                for (int i = 0; i < 2; ++i) { const unsigned a = zm[2 * q + i], bq = z0[2 * q + i], cq = zp[2 * q + i];
                    o[4 * q + 2 * i] = silu_f(w0[2 * i] * bf2f(a & 0xffffu) + w1[2 * i] * bf2f(bq & 0xffffu) + w2[2 * i] * bf2f(cq & 0xffffu));
                    o[4 * q + 2 * i + 1] = silu_f(w0[2 * i + 1] * bf2f(a >> 16) + w1[2 * i + 1] * bf2f(bq >> 16) + w2[2 * i + 1] * bf2f(cq >> 16)); } }
            LAS f32x4* dst = (LAS f32x4*)(STG + c * 388 + part * 128 + e0); dst[0] = (f32x4){o[0], o[1], o[2], o[3]}; dst[1] = (f32x4){o[4], o[5], o[6], o[7]};
        }
        if (F.wave < 2) {
            const int d = F.wave, c = F.lane; const size_t row = (size_t)(row0 + c);
            const float Aco = expf(INP(I_GALOG)[j * 16 + d * 8 + h]), dtb = INP(I_GDT)[j * 16 + d * 8 + h];
            const float x = AB[row * 32 + d * 8 + h] + dtb, bb = AB[row * 32 + 16 + d * 8 + h];
            const float sp = x > 20.f ? x : log1pf(expf(x));
            float s = -Aco * sp;
#pragma unroll
            for (int o = 1; o < 64; o <<= 1) { const float up = __shfl_up(s, o), dn = __shfl_down(s, o); if (d ? (c + o < 64) : (c >= o)) s += d ? dn : up; }
            SM[d * 64 + c] = 1.f / (1.f + expf(-bb)); SM[128 + d * 64 + c] = s;
        }
        __syncthreads();
#pragma unroll 1
        for (int rr = 0; rr < 8; ++rr) { const int c = F.wave * 8 + rr; const LAS float* sr = STG + c * 388;
            const float q0 = sr[F.lane], q1 = sr[64 + F.lane]; const float sq = 0.08838834764831845f / sqrtf(wave_sum(q0 * q0 + q1 * q1) + EPS);
            const float k0 = sr[128 + F.lane], k1 = sr[192 + F.lane]; const float sk = 1.0f / sqrtf(wave_sum(k0 * k0 + k1 * k1) + EPS);
            const unsigned o0 = off_a(c, F.lane >> 3) + 2 * (F.lane & 7), o1 = off_a(c, 8 + (F.lane >> 3)) + 2 * (F.lane & 7);
            *(LAS bf16*)(QI + o0) = (bf16)(pk2(q0 * sq, 0.f) & 0xffffu); *(LAS bf16*)(QI + o1) = (bf16)(pk2(q1 * sq, 0.f) & 0xffffu);
            *(LAS bf16*)(KI + o0) = (bf16)(pk2(k0 * sk, 0.f) & 0xffffu); *(LAS bf16*)(KI + o1) = (bf16)(pk2(k1 * sk, 0.f) & 0xffffu);
            bf16* vd = Z + (size_t)(row0 + c) * 4096 + 2048 + h * 128;
            vd[F.lane] = (bf16)(pk2(sr[256 + F.lane], 0.f) & 0xffffu); vd[64 + F.lane] = (bf16)(pk2(sr[320 + F.lane], 0.f) & 0xffffu); }
        __syncthreads();
        { const int prod = F.wave >> 2, mt = (F.wave >> 1) & 1, nt = F.wave & 1; LAS unsigned char* AI = prod ? QI : KI;
            f32x16 acc;
#pragma unroll
            for (int i = 0; i < 16; ++i) acc[i] = 0.f;
#pragma unroll
            for (int ks = 0; ks < 8; ++ks) { const bf16x8 a = *(const LAS bf16x8*)(AI + off_a(32 * mt + r, 2 * ks + hi)), bq = *(const LAS bf16x8*)(KI + off_a(32 * nt + r, 2 * ks + hi));
                acc = __builtin_amdgcn_mfma_f32_32x32x16_bf16(a, bq, acc, 0, 0, 0); }
            LAS float* dst = prod ? QK : KK;
#pragma unroll
            for (int i = 0; i < 16; ++i) dst[(32 * mt + crow(i, hi)) * 65 + 32 * nt + r] = acc[i]; }
        __syncthreads();
        for (int idx = F.tid; idx < 8192; idx += NTHR) { const int d = idx >> 12, p = (idx >> 6) & 63, ps = idx & 63; float val = 0.f;
            if (ps < p) { const int c = d ? 63 - p : p, s = d ? 63 - ps : ps; val = SM[d * 64 + c] * KK[c * 65 + s] * expf(SM[128 + d * 64 + c] - SM[128 + d * 64 + s]); }
            LP[idx] = val; }
        for (int idx = F.tid; idx < 8192; idx += NTHR) { const int d = idx >> 12, c = (idx >> 6) & 63, s = idx & 63;
            const bool zero_blk = d ? (c >= 32 && s < 32) : (c < 32 && s >= 32);
            if (!zero_blk) { const bool m = d ? (s >= c) : (s <= c); const float val = m ? QK[c * 65 + s] * expf(SM[128 + d * 64 + c] - SM[128 + d * 64 + s]) : 0.f;
                *(LAS bf16*)(OUT + d * PD_BYTES + PD_ATT + frag_off(c, s)) = (bf16)(pk2(val, 0.f) & 0xffffu); } }
        if (F.tid < 128) { const int d = F.tid >> 6, c = F.tid & 63; const float gl = SM[128 + d * 64 + (d ? 0 : 63)], gcv = SM[128 + d * 64 + c];
            *(LAS float*)(OUT + d * PD_BYTES + PD_EG + 4 * c) = expf(gcv); *(LAS float*)(OUT + d * PD_BYTES + PD_EW + 4 * c) = expf(gl - gcv); }
        __syncthreads();
#ifndef NO_INV
        if (F.wave < 2) {
            const int d = F.wave, jc = F.lane; const LAS f32x4* L4 = (const LAS f32x4*)(LP + d * 4096);
            float Tc[64];
#pragma unroll
            for (int p = 0; p < 64; ++p) { float acc = (p == jc) ? 1.f : 0.f;
#pragma unroll
                for (int q4 = 0; q4 < (p + 3) / 4; ++q4) { const f32x4 l = L4[p * 16 + q4];
                    if (4 * q4 < p) acc -= l.x * Tc[4 * q4]; if (4 * q4 + 1 < p) acc -= l.y * Tc[4 * q4 + 1]; if (4 * q4 + 2 < p) acc -= l.z * Tc[4 * q4 + 2]; if (4 * q4 + 3 < p) acc -= l.w * Tc[4 * q4 + 3]; }
                Tc[p] = acc; asm volatile("" ::: "memory"); }
            const int s = d ? 63 - jc : jc; const float bj = SM[d * 64 + s];
#pragma unroll
            for (int p = 0; p < 64; ++p) { const int c = d ? 63 - p : p; const bool zero_blk = d ? (c >= 32 && s < 32) : (c < 32 && s >= 32);
                *(LAS bf16*)(OUT + (zero_blk ? 2 * PD_BYTES : d * PD_BYTES + frag_off(c, s))) = (bf16)(pk2(Tc[p] * bj, 0.f) & 0xffffu); }
        }
#endif
        __syncthreads();
        for (int idx = F.tid; idx < 1600; idx += NTHR) { const int d = idx / 800, pc = idx % 800;
            *(u32x4*)(PD + ((size_t)(((d * 2 + b) * 8 + h) * 132 + n)) * PD_BYTES + pc * 16) = *(const LAS u32x4*)(OUT + d * PD_BYTES + pc * 16); }
        for (int idx = F.tid; idx < 2048; idx += NTHR) { const int img = idx >> 10, pn = idx & 1023;
            *(u32x4*)((unsigned char*)(Z + (size_t)(row0 + (pn >> 4)) * 4096 + img * 1024 + h * 128) + (pn & 15) * 16) = *(const LAS u32x4*)((img ? KI : QI) + pn * 16); }
        __syncthreads();
    }
}

#define PACK8(x, b) __builtin_bit_cast(bf16x8, (u32x4){pk2((x)[(b)], (x)[(b) + 1]), pk2((x)[(b) + 2], (x)[(b) + 3]), pk2((x)[(b) + 4], (x)[(b) + 5]), pk2((x)[(b) + 6], (x)[(b) + 7])})
#define MFMA32(a, b, c) __builtin_amdgcn_mfma_f32_32x32x16_bf16((a), (b), (c), 0, 0, 0)
typedef short v4i16_t __attribute__((ext_vector_type(4)));
__device__ __forceinline__ void step_gdn_scan2() {
    const Frame F = make_frame();
    constexpr int BUF = 61952, B_K = 0, B_Q = 16384, B_V = 32768, B_PD = 49152;
    const bf16* Z = (const bf16*)(F.ws + WS_Z); const unsigned char* PD = F.ws + WS_PD;
    const int r = F.lane & 31, hi = F.lane >> 5;
    for (int it = F.bid; it < 32; it += F.G) {
        const int b = it >> 4, h = (it >> 1) & 7, dir = it & 1;
        const unsigned char* pdb = PD + (size_t)(((dir * 2 + b) * 8 + h) * 132) * PD_BYTES;
#define CHUNK_OF(sp) (dir ? ((sp) < 4 ? 3 - (sp) : 135 - (sp)) : (sp))
#define ROW0_OF(n) ((n) < 4 ? ML + b * CT + 64 * (n) : b * T + 64 * ((n) - 4))
        if (F.wave >= 4) {
            const int lt = F.tid - 256;
            u32x4 rg[16];
#define LOAD_CHUNK(sp) do { const int n_ = CHUNK_OF(sp); const int row0_ = ROW0_OF(n_); \
                _Pragma("unroll") for (int i = 0; i < 4; ++i) { const int pn = lt + 256 * i; const unsigned char* src = (const unsigned char*)(Z + (size_t)(row0_ + (pn >> 4)) * 4096 + h * 128) + (pn & 15) * 16; \
                    rg[i] = *(const u32x4*)(src + 2048); rg[4 + i] = *(const u32x4*)src; rg[8 + i] = *(const u32x4*)(src + 4096); \
                    rg[12 + i] = pn < 800 ? *(const u32x4*)(pdb + (size_t)n_ * PD_BYTES + pn * 16) : (u32x4){0u, 0u, 0u, 0u}; } } while (0)
#define WRITE_CHUNK(bufb) do { LAS unsigned char* base_ = F.lds + (bufb); \
                _Pragma("unroll") for (int i = 0; i < 4; ++i) { const int pn = lt + 256 * i; *(LAS u32x4*)(base_ + B_K + pn * 16) = rg[i]; *(LAS u32x4*)(base_ + B_Q + pn * 16) = rg[4 + i]; \
                    *(LAS u32x4*)(base_ + B_V + pn * 16) = rg[8 + i]; if (pn < 800) *(LAS u32x4*)(base_ + B_PD + pn * 16) = rg[12 + i]; } } while (0)
            LOAD_CHUNK(0); WRITE_CHUNK(0); LOAD_CHUNK(1);
            __syncthreads();
            for (int sp = 0; sp < 132; ++sp) {
                if (sp + 1 < 132) WRITE_CHUNK(((sp + 1) & 1) * BUF);
                if (sp + 2 < 132) LOAD_CHUNK(sp + 2);
                __syncthreads();
            }
#undef LOAD_CHUNK
#undef WRITE_CHUNK
        } else {
            const int w = F.wave;
            f32x16 S[4];
#pragma unroll
            for (int kt = 0; kt < 4; ++kt)
#pragma unroll
                for (int i = 0; i < 16; ++i) S[kt][i] = 0.f;
            const int x = (r >> 2) & 3; const int rowb = 2048 * (r >> 3) + 64 * (r & 7);
            int oa[2], ob[2];
#pragma unroll
            for (int s2 = 0; s2 < 2; ++s2) { oa[s2] = rowb + 16 * ((2 * s2) ^ x) + 8 * hi; ob[s2] = rowb + 16 * ((2 * s2 + 1) ^ x) + 8 * hi; }
            const int blk = (F.lane >> 4) & 1, q = (F.lane & 15) >> 2, p = F.lane & 3, cb = 2 * blk + (p >> 1);
            int trb[2];
#pragma unroll
            for (int t = 0; t < 2; ++t) trb[t] = 64 * (4 * hi + q) + 8 * (p & 1) + 16 * (cb ^ ((2 * t + hi) & 3)) + 2048 * t;
            const int vb = 4 * hi * 256 + (32 * w + r) * 2;
            __syncthreads();
            for (int sp = 0; sp < 132; ++sp) {
                const int n = CHUNK_OF(sp); const int row0 = ROW0_OF(n);
                LAS unsigned char* B = F.lds + (sp & 1) * BUF;
                LAS unsigned char* KI = B + B_K; LAS unsigned char* QI = B + B_Q; LAS unsigned char* VI = B + B_V; LAS unsigned char* PR = B + B_PD;
                bf16x8 Sb[4][2];
#pragma unroll
                for (int kt = 0; kt < 4; ++kt) { Sb[kt][0] = PACK8(S[kt], 0); Sb[kt][1] = PACK8(S[kt], 8); }
                f32x16 KS[2];
#pragma unroll
                for (int mt = 0; mt < 2; ++mt) {
#pragma unroll
                    for (int i = 0; i < 16; ++i) KS[mt][i] = 0.f;
#pragma unroll
                    for (int kt = 0; kt < 4; ++kt)
#pragma unroll
                        for (int s2 = 0; s2 < 2; ++s2) {
                            const s16x4 k0 = *(const LAS s16x4*)(KI + 8192 * mt + 512 * kt + oa[s2]), k1 = *(const LAS s16x4*)(KI + 8192 * mt + 512 * kt + ob[s2]);
                            KS[mt] = MFMA32(((bf16x8){k0[0], k0[1], k0[2], k0[3], k1[0], k1[1], k1[2], k1[3]}), Sb[kt][s2], KS[mt]); }
                    asm volatile("" ::: "memory");
                }
                bf16x8 Rb[2][2];
#pragma unroll
                for (int mt = 0; mt < 2; ++mt) { f32x16 R;
#pragma unroll
                    for (int g = 0; g < 4; ++g) { const f32x4 e4 = *(const LAS f32x4*)(PR + PD_EG + 4 * (32 * mt + 8 * g + 4 * hi));
#pragma unroll
                        for (int i = 0; i < 4; ++i) { const float v = bf2f(*(const LAS bf16*)(VI + vb + (32 * mt + 8 * g + i) * 256)); R[4 * g + i] = v - e4[i] * KS[mt][4 * g + i]; } }
                    Rb[mt][0] = PACK8(R, 0); Rb[mt][1] = PACK8(R, 8); }
                f32x16 vn[2], o[2];
#pragma unroll
                for (int i = 0; i < 16; ++i) { vn[0][i] = 0.f; vn[1][i] = 0.f; }
#define TFR(base, slot, s2) (*(const LAS bf16x8*)(PR + (base) + (slot) * 2048 + (s2) * 1024 + F.lane * 16))
                vn[0] = MFMA32(TFR(0, 0, 0), Rb[0][0], vn[0]); vn[0] = MFMA32(TFR(0, 0, 1), Rb[0][1], vn[0]);
                vn[1] = MFMA32(TFR(0, 2, 0), Rb[1][0], vn[1]); vn[1] = MFMA32(TFR(0, 2, 1), Rb[1][1], vn[1]);
                if (dir) { vn[0] = MFMA32(TFR(0, 1, 0), Rb[1][0], vn[0]); vn[0] = MFMA32(TFR(0, 1, 1), Rb[1][1], vn[0]); }
                else     { vn[1] = MFMA32(TFR(0, 1, 0), Rb[0][0], vn[1]); vn[1] = MFMA32(TFR(0, 1, 1), Rb[0][1], vn[1]); }
                asm volatile("" ::: "memory");
                f32x16 QS[2];
#pragma unroll
                for (int mt = 0; mt < 2; ++mt) {
#pragma unroll
                    for (int i = 0; i < 16; ++i) QS[mt][i] = 0.f;
#pragma unroll
                    for (int kt = 0; kt < 4; ++kt)
#pragma unroll
                        for (int s2 = 0; s2 < 2; ++s2) {
                            const s16x4 q0 = *(const LAS s16x4*)(QI + 8192 * mt + 512 * kt + oa[s2]), q1 = *(const LAS s16x4*)(QI + 8192 * mt + 512 * kt + ob[s2]);
                            QS[mt] = MFMA32(((bf16x8){q0[0], q0[1], q0[2], q0[3], q1[0], q1[1], q1[2], q1[3]}), Sb[kt][s2], QS[mt]); }
                    asm volatile("" ::: "memory");
                }
                bf16x8 Vb[2][2], Wb[2][2];
#pragma unroll
                for (int mt = 0; mt < 2; ++mt) { f32x16 W;
#pragma unroll
                    for (int g = 0; g < 4; ++g) { const f32x4 e4 = *(const LAS f32x4*)(PR + PD_EG + 4 * (32 * mt + 8 * g + 4 * hi)), w4 = *(const LAS f32x4*)(PR + PD_EW + 4 * (32 * mt + 8 * g + 4 * hi));
#pragma unroll
                        for (int i = 0; i < 4; ++i) { o[mt][4 * g + i] = e4[i] * QS[mt][4 * g + i]; W[4 * g + i] = w4[i] * vn[mt][4 * g + i]; } }
                    Vb[mt][0] = PACK8(vn[mt], 0); Vb[mt][1] = PACK8(vn[mt], 8); Wb[mt][0] = PACK8(W, 0); Wb[mt][1] = PACK8(W, 8); }
                o[0] = MFMA32(TFR(PD_ATT, 0, 0), Vb[0][0], o[0]); o[0] = MFMA32(TFR(PD_ATT, 0, 1), Vb[0][1], o[0]);
                o[1] = MFMA32(TFR(PD_ATT, 2, 0), Vb[1][0], o[1]); o[1] = MFMA32(TFR(PD_ATT, 2, 1), Vb[1][1], o[1]);
                if (dir) { o[0] = MFMA32(TFR(PD_ATT, 1, 0), Vb[1][0], o[0]); o[0] = MFMA32(TFR(PD_ATT, 1, 1), Vb[1][1], o[0]); }
                else     { o[1] = MFMA32(TFR(PD_ATT, 1, 0), Vb[0][0], o[1]); o[1] = MFMA32(TFR(PD_ATT, 1, 1), Vb[0][1], o[1]); }
#undef TFR
                asm volatile("" ::: "memory");
                const float cd = *(const LAS float*)(PR + PD_EG + 4 * (dir ? 0 : 63));
#pragma unroll
                for (int kt = 0; kt < 4; ++kt) {
#pragma unroll
                    for (int i = 0; i < 16; ++i) S[kt][i] *= cd;
#pragma unroll
                    for (int mt = 0; mt < 2; ++mt)
#pragma unroll
                        for (int s2 = 0; s2 < 2; ++s2) {
                            const s16x4 a0 = __builtin_bit_cast(s16x4, __builtin_amdgcn_ds_read_tr16_b64_v4i16((LAS v4i16_t*)(KI + 8192 * mt + 4096 * s2 + 512 * kt + trb[0])));
                            const s16x4 a1 = __builtin_bit_cast(s16x4, __builtin_amdgcn_ds_read_tr16_b64_v4i16((LAS v4i16_t*)(KI + 8192 * mt + 4096 * s2 + 512 * kt + trb[1])));
                            S[kt] = MFMA32(((bf16x8){a0[0], a0[1], a0[2], a0[3], a1[0], a1[1], a1[2], a1[3]}), Wb[mt][s2], S[kt]); }
                    asm volatile("" ::: "memory");
                }
                { bf16* ob_ = n < 4 ? (bf16*)(F.ws + WS_OFC) + ((size_t)dir * MC + (row0 - ML)) * D : (bf16*)F.out + ((size_t)dir * ML + row0) * D;
                    bf16* oc = ob_ + h * 128 + 32 * w + r;
#pragma unroll
                    for (int mt = 0; mt < 2; ++mt)
#pragma unroll
                        for (int i = 0; i < 16; ++i) oc[(size_t)(32 * mt + crow(i, hi)) * D] = (bf16)(pk2(o[mt][i], 0.f) & 0xffffu); }
                __syncthreads();
            }
        }
#undef CHUNK_OF
#undef ROW0_OF
    }
}
__device__ __forceinline__ void step_gdn_norm2(int j) {
    const Frame F = make_frame();
    const int gw = F.bid * NWAVES + F.wave, NGW = F.G * NWAVES;
    const bf16* Z = (const bf16*)(F.ws + WS_Z); bf16* Y = (bf16*)(F.ws + WS_Y); const float* ng = INP(I_GNG) + j * 128;
    for (int row = gw; row < M; row += NGW) {
        const bf16* of = row < ML ? (const bf16*)F.out + (size_t)row * D : (const bf16*)(F.ws + WS_OFC) + (size_t)(row - ML) * D;
        const bf16* ob = row < ML ? of + (size_t)ML * D : of + (size_t)MC * D;
        const u32x4* f4 = (const u32x4*)(of + 16 * F.lane); const u32x4* b4 = (const u32x4*)(ob + 16 * F.lane);
        float v[16]; float ss = 0.f;
#pragma unroll
        for (int q = 0; q < 2; ++q) { const u32x4 a = f4[q], bq = b4[q];
#pragma unroll
            for (int i = 0; i < 4; ++i) { const float x0 = bf2f(a[i] & 0xffffu) + bf2f(bq[i] & 0xffffu), x1 = bf2f(a[i] >> 16) + bf2f(bq[i] >> 16); v[8 * q + 2 * i] = x0; v[8 * q + 2 * i + 1] = x1; ss += x0 * x0 + x1 * x1; } }
        ss += __shfl_xor(ss, 1); ss += __shfl_xor(ss, 2); ss += __shfl_xor(ss, 4);
        const float rstd = 1.0f / sqrtf(ss * (1.f / 128.f) + EPS);
        const u32x4* g4 = (const u32x4*)(Z + (size_t)row * 4096 + 3072 + 16 * F.lane);
        const int e0 = (16 * F.lane) & 127;
        u32x4 o[2];
#pragma unroll
        for (int q = 0; q < 2; ++q) { const u32x4 gz = g4[q]; unsigned wv[4];
#pragma unroll
            for (int i = 0; i < 4; ++i) { const unsigned gg = gz[i]; const float g0 = bf2f(gg & 0xffffu), g1 = bf2f(gg >> 16); const int e = e0 + 8 * q + 2 * i;
                wv[i] = pk2(v[8 * q + 2 * i] * rstd * ng[e] * silu_f(g0), v[8 * q + 2 * i + 1] * rstd * ng[e + 1] * silu_f(g1)); }
            o[q] = (u32x4){wv[0], wv[1], wv[2], wv[3]}; }
        u32x4* dst = (u32x4*)(Y + (size_t)row * D + 16 * F.lane); dst[0] = o[0]; dst[1] = o[1];
    }
}

#define XB_TMO      128
#define XB_XCNT(j)  (256  + 64 * (j))
#define XB_XSUB(j)  (1280 + 64 * (j))
#define XB_XGEN(j)  (2304 + 64 * (j))
#define XB_TOP      3328
#define XB_TOPGEN   3392
#define XCD_BAR_WORDS 3456
#define XB_SPIN_CAP (1u << 18)

__device__ __forceinline__ unsigned xb_ld(unsigned* p)              { return __hip_atomic_load(p, __ATOMIC_RELAXED, __HIP_MEMORY_SCOPE_AGENT); }
__device__ __forceinline__ unsigned xb_add(unsigned* p, unsigned v) { return __hip_atomic_fetch_add(p, v, __ATOMIC_RELAXED, __HIP_MEMORY_SCOPE_AGENT); }
__device__ __forceinline__ unsigned xb_xcc_id() { return (unsigned)__builtin_amdgcn_s_getreg((3 << 11) | 20) & 0xFu; }
#define XB_SPIN(cond, bar) do { unsigned _sp = 0; while (cond) { __builtin_amdgcn_s_sleep(1); \
    if ((++_sp & 255u) == 0u) { if (xb_ld(&(bar)[XB_TMO])) break; if (_sp > XB_SPIN_CAP) { atomicAdd(&(bar)[XB_TMO], 1u); break; } } } } while (0)

struct XcdBarrier {
    unsigned* bar; unsigned x;
    volatile LAS unsigned* st;
};

__device__ __forceinline__ XcdBarrier xcd_barrier_post(unsigned* bar, volatile LAS unsigned* st) {
    XcdBarrier b; b.bar = bar; b.x = xb_xcc_id(); b.st = st;
    if (threadIdx.x == 0) (void)xb_add(&bar[XB_XCNT(b.x)], 1u);
    return b;
}
__device__ __forceinline__ void xcd_barrier_complete(unsigned* bar, unsigned x, unsigned& nloc, unsigned& nx) {
    const unsigned G = gridDim.x * gridDim.y * gridDim.z;
    unsigned sum, cnt, mine, sp = 0u;
    for (;;) {
        sum = 0u; cnt = 0u; mine = 0u;
#pragma unroll
        for (unsigned j = 0; j < 16; ++j) { const unsigned c = xb_ld(&bar[XB_XCNT(j)]); sum += c; cnt += (c > 0u) ? 1u : 0u; mine = (j == x) ? c : mine; }
        if (sum == G) break;
        __builtin_amdgcn_s_sleep(1);
        if ((++sp & 255u) == 0u) { if (xb_ld(&bar[XB_TMO])) break; if (sp > XB_SPIN_CAP) { atomicAdd(&bar[XB_TMO], 1u); break; } }
    }
    nloc = mine > 0u ? mine : 1u; nx = cnt > 0u ? cnt : 1u;
}

__device__ __forceinline__ void xcd_barrier(const XcdBarrier& b) {
    asm volatile("s_waitcnt vmcnt(0)" ::: "memory");
    __syncthreads();
    if (threadIdx.x == 0) {
        unsigned* bar = b.bar;
        __builtin_amdgcn_s_waitcnt(0);
        unsigned nloc = b.st[0], nx = b.st[1];
        if (nloc == 0u) { xcd_barrier_complete(bar, b.x, nloc, nx); b.st[0] = nloc; b.st[1] = nx; }
        const unsigned old = xb_add(&bar[XB_XSUB(b.x)], 1u);
        const unsigned gen = old / nloc;
        if (old + 1u == (gen + 1u) * nloc) {
            __builtin_amdgcn_fence(__ATOMIC_RELEASE, "agent");
            asm volatile("s_waitcnt vmcnt(0)" ::: "memory");
            const unsigned og = xb_add(&bar[XB_TOP], 1u);
            const unsigned tg = og / nx;
            if (og + 1u == (tg + 1u) * nx) xb_add(&bar[XB_TOPGEN], 1u);
            else XB_SPIN(xb_ld(&bar[XB_TOPGEN]) == tg, bar);
            __builtin_amdgcn_fence(__ATOMIC_ACQUIRE, "agent");
            xb_add(&bar[XB_XGEN(b.x)], 1u);
            asm volatile("s_waitcnt vmcnt(0)" ::: "memory");
        } else {
            XB_SPIN(xb_ld(&bar[XB_XGEN(b.x)]) == gen, bar);
            __builtin_amdgcn_fence(__ATOMIC_ACQUIRE, "agent");
            asm volatile("s_waitcnt vmcnt(0)" ::: "memory");
        }
    }
    __syncthreads();
}

#ifndef MK_SINGLE
#define MK_SINGLE 1
#endif
constexpr int NSTEPS = 1 + 9 + 7 + 8 + 9 + 1;
template <int ACT> __device__ __forceinline__ void gemm_store(const bf16* A, const bf16* Bt, int Mrows, int N, int K, bf16* O, int ldc, float* AB, int ab_tile, bf16* halo) {
    int G_ = gridDim.x, B_ = blockIdx.x; asm volatile("" : "+s"(G_), "+s"(B_));
    pg8::Gemm g{A, Bt, Mrows, N, K}; pg8::StaticOrder S; S.init(Mrows, N, G_, B_);
    pg8::EpiStore<ACT> E{O, ldc, AB, ab_tile, halo};
    pg8::gemm_phase<pg8::EpiStore<ACT>, pg8::StaticOrder, true, true>((LAS unsigned char*)lds_raw, g, S, E);
}
__device__ __forceinline__ void gemm_resid(const bf16* A, const bf16* Bt, int Mrows, int K, float* X, const float* gate) {
    int G_ = gridDim.x, B_ = blockIdx.x; asm volatile("" : "+s"(G_), "+s"(B_));
    pg8::Gemm g{A, Bt, Mrows, D, K}; pg8::StaticOrder S; S.init(Mrows, D, G_, B_);
    pg8::EpiResid E{X, D, gate, NADA};
    pg8::gemm_phase<pg8::EpiResid, pg8::StaticOrder, true, true>((LAS unsigned char*)lds_raw, g, S, E);
}
__global__ void __launch_bounds__(NTHR, 2) fwd_kernel(Args a) {
    unsigned char* ws = a.ws;
    const int lo = a.step_lo, hi = a.step_hi; const bool coop = a.coop != 0;
    volatile LAS unsigned* bst = (volatile LAS unsigned*)((LAS unsigned char*)lds_raw + LDS_BYTES - 64);
    if (threadIdx.x < 2) bst[threadIdx.x] = 0u;
    __syncthreads();
    XcdBarrier bar; bar.bar = (unsigned*)(ws + WS_CTL) + 4096; bar.x = 0; bar.st = bst;
    if (coop) bar = xcd_barrier_post((unsigned*)(ws + WS_CTL) + 4096, bst);
#define PHASE(k, body) do { if (lo <= (k) && (k) < hi) { __syncthreads(); body; if ((k) + 1 < hi && coop) { if ((k) == 0) cg::this_grid().sync(); else xcd_barrier(bar); } } } while (0)
#define WB(off) ((bf16*)(ws + (off)))
#define MODP(layer, which) ((const float*)(ws + WS_MOD) + (size_t)(layer) * 3 * NADA + (which) * D)
#define TAIL(k0, layer, WoutT, Mrows) \
    PHASE((k0), gemm_resid(WB(WS_Y), (WoutT), (Mrows), D, (float*)(ws + WS_X), MODP(layer, 2))); \
    PHASE((k0) + 1, step_norm((layer), 1, (Mrows), false)); \
    PHASE((k0) + 2, gemm_store<1>(WB(WS_H), WB(WS_W1T) + (size_t)(layer) * D * FF, (Mrows), FF, D, WB(WS_Z), FF, nullptr, -1, nullptr)); \
    PHASE((k0) + 3, gemm_resid(WB(WS_Z), WB(WS_W2T) + (size_t)(layer) * D * FF, (Mrows), FF, (float*)(ws + WS_X), MODP(layer, 5)))
#define LAYER_GDN(k0, layer, jj, Mrows) \
    PHASE((k0), step_norm((layer), 0, M, false)); \
    PHASE((k0) + 1, gemm_store<0>(WB(WS_H), WB(WS_GINT) + (size_t)(jj) * GDN_NP * D, M, GDN_NP, D, WB(WS_Z), 4096, (float*)(ws + WS_AB), 16, WB(WS_HALO))); \
    PHASE((k0) + 2, step_gdn_prep(jj)); \
    PHASE((k0) + 3, step_gdn_scan2()); \
    PHASE((k0) + 4, step_gdn_norm2(jj)); \
    TAIL((k0) + 5, layer, WB(WS_GOUTT) + (size_t)(jj) * D * D, Mrows)
    PHASE(0, step_prologue());
    LAYER_GDN(1, 0, 0, M);
    PHASE(10, step_norm(1, 0, M, false));
    PHASE(11, gemm_store<0>(WB(WS_H), WB(WS_SINT), M, 3 * D, D, WB(WS_Z), 3 * D, nullptr, -1, nullptr));
    PHASE(12, step_sconv());
    TAIL(13, 1, WB(WS_SOUTT), M);
    PHASE(17, step_norm(2, 0, M, false));
    PHASE(18, gemm_store<0>(WB(WS_H), WB(WS_DINT), M, 3 * D, D, WB(WS_Z), 3 * D, nullptr, -1, nullptr));
    PHASE(19, step_rope());
    PHASE(20, step_attn());
    TAIL(21, 2, WB(WS_DOUTT), M);
    LAYER_GDN(25, 3, 1, ML);
    PHASE(34, step_final());
}

extern "C" void kernel_launch(void* const* d_in, const int* in_sizes, int n_in, void* d_out, int out_size, void* d_ws, size_t ws_size, hipStream_t stream) {
    static int grid = 0;
    if (grid == 0) {
        if (n_in != 24 || out_size != ML * D || ws_size < WS_END) { fprintf(stderr, "kernel_launch: unexpected problem (n_in %d, out %d, ws %zu); nothing launched\n", n_in, out_size, ws_size); grid = -1; return; }
        int dev = 0, cus = 0, per_cu = 0;
        if (hipGetDevice(&dev) != hipSuccess || hipDeviceGetAttribute(&cus, hipDeviceAttributeMultiprocessorCount, dev) != hipSuccess) { grid = -1; return; }
        if (hipFuncSetAttribute((const void*)fwd_kernel, hipFuncAttributeMaxDynamicSharedMemorySize, LDS_BYTES) != hipSuccess) { fprintf(stderr, "kernel_launch: hipFuncSetAttribute failed\n"); grid = -1; return; }
        if (hipOccupancyMaxActiveBlocksPerMultiprocessor(&per_cu, (const void*)fwd_kernel, NTHR, LDS_BYTES) != hipSuccess || per_cu < 1) { fprintf(stderr, "kernel_launch: occupancy query says %d blocks per CU\n", per_cu); (void)hipGetLastError(); per_cu = 1; }
        grid = cus;
        fprintf(stderr, "kernel_launch: %d CUs, occupancy %d per CU, grid %d\n", cus, per_cu, grid);
    }
    if (grid < 0) return;
    (void)hipMemsetAsync((char*)d_ws + WS_CTL, 0, CTL_ZERO_BYTES, stream);
    Args a{};
    for (int i = 0; i < 24; ++i) a.in[i] = (const float*)d_in[i];
    a.out = (float*)d_out; a.ws = (unsigned char*)d_ws;
#if MK_SINGLE
    a.step_lo = 0; a.step_hi = NSTEPS; a.coop = 1;
    void* args[] = {&a};
    hipError_t e = hipLaunchCooperativeKernel((const void*)fwd_kernel, dim3(grid), dim3(NTHR), args, LDS_BYTES, stream);
    if (e != hipSuccess) fprintf(stderr, "cooperative launch failed: %s (grid %d)\n", hipGetErrorString(e), grid);
#else
    for (int s = 0; s < NSTEPS; ++s) { a.step_lo = s; a.step_hi = s + 1; a.coop = 0; hipLaunchKernelGGL(fwd_kernel, dim3(grid), dim3(NTHR), LDS_BYTES, stream, a); }
#endif
}
```

```cpp
#include <hip/hip_runtime.h>
#include <hip/hip_cooperative_groups.h>
#include <cstdio>
#include <cstdint>
namespace cg = cooperative_groups;
namespace pg8 {
#define PG8_LAS __attribute__((address_space(3)))
typedef unsigned short bf16_t;
typedef short bf16x8 __attribute__((ext_vector_type(8)));
typedef float f32x4 __attribute__((ext_vector_type(4)));
typedef unsigned u32x4 __attribute__((ext_vector_type(4)));
constexpr int BM = 256, BK = 64, HALF = 128, HTB = HALF * BK * 2  , STAGE_BYTES = 8 * HTB, NXCD = 8, WGM = 8;

__host__ __device__ __forceinline__ int lds_byte(int r, int c) { const int st = (r >> 4) * 2 + (c >> 5), rr = r & 15, cc = c & 31, ob = rr * 64 + cc * 2; return st * 1024 + (ob ^ (((ob >> 9) & 1) << 5)); }
__host__ __device__ __forceinline__ void stage_rc(int b, int& R, int& C) { const int st = b / 1024, sb = b % 1024, swz = sb ^ (((sb >> 9) & 1) << 5); R = (st >> 1) * 16 + swz / 64; C = (st & 1) * 32 + (swz % 64) / 2; }
__host__ __device__ __forceinline__ int perm32(int rho) { const int n = rho >> 4, i = rho & 15; return 8 * (i >> 2) + 4 * n + (i & 3); }

struct Unit { int pm, pn; };
struct Gemm { const bf16_t* A; const bf16_t* Bt; int M, N, K; };

struct StaticOrder {
    int nM, nN, nwg, G, c;
    __host__ __device__ void init(int M, int N, int G_, int c_) { nM = M / BM; nN = N / BM; nwg = nM * nN; G = G_; c = c_; }
    __host__ __device__ bool next(int i, Unit& u) const {
        const long L = (long)i * G + c; if (L >= nwg) return false;
        int wgid = (int)L; { const int q = nwg / NXCD, r = nwg % NXCD, xcd = wgid % NXCD, off = wgid / NXCD; wgid = (xcd < r ? xcd * (q + 1) : r * (q + 1) + (xcd - r) * q) + off; }
        const int nig = WGM * nN, gid = wgid / nig, fm = gid * WGM, gsz = (nM - fm) < WGM ? (nM - fm) : WGM;
        u.pm = fm + ((wgid % nig) % gsz); u.pn = (wgid % nig) / gsz; return true;
    }
    __device__ __forceinline__ void a_ready(const Unit&) const {}
    __device__ __forceinline__ void done(const Unit&) const {}
};

typedef float f32x2 __attribute__((ext_vector_type(2)));
typedef __bf16 bf16x2_t __attribute__((ext_vector_type(2)));
__device__ __forceinline__ unsigned cvt_pk_bf16(float lo, float hi) { f32x2 v = {lo, hi}; bf16x2_t b = __builtin_convertvector(v, bf16x2_t); return __builtin_bit_cast(unsigned, b); }

template <int ACT> struct EpiStore {
    static constexpr bool PERM = true, AFTER_DRAIN = false;
    bf16_t* O; int ldc; float* AB; int ab_tile; bf16_t* halo;
    __device__ __forceinline__ void operator()(const f32x4 (&acc)[2][2][4][2], const Unit& u, int wr, int wc, int fr, int fq) const {
        const int row0 = u.pm * BM + wr * 64 + fr;
        if (u.pn == ab_tile) {
            if (wc == 0) {
#pragma unroll
                for (int ai = 0; ai < 2; ++ai)
#pragma unroll
                    for (int m = 0; m < 4; ++m) { float* p = AB + (size_t)(row0 + ai * HALF + m * 16) * 32 + 8 * fq; *(f32x4*)p = acc[ai][0][m][0]; *(f32x4*)(p + 4) = acc[ai][0][m][1]; }
            }
            return;
        }
        const int col0 = u.pn * BM + wc * 32 + 8 * fq;
#pragma unroll
        for (int ai = 0; ai < 2; ++ai)
#pragma unroll
            for (int m = 0; m < 4; ++m) { bf16_t* rowp = O + (size_t)(row0 + ai * HALF + m * 16) * ldc + col0;
#pragma unroll
                for (int bj = 0; bj < 2; ++bj) { f32x4 v0 = acc[ai][bj][m][0], v1 = acc[ai][bj][m][1];
                    if (ACT == 1) {
#pragma unroll
                        for (int i = 0; i < 4; ++i) { const float a = fmaxf(v0[i], 0.f), b = fmaxf(v1[i], 0.f); v0[i] = a * a; v1[i] = b * b; } }
                    u32x4 w; w.x = cvt_pk_bf16(v0[0], v0[1]); w.y = cvt_pk_bf16(v0[2], v0[3]); w.z = cvt_pk_bf16(v1[0], v1[1]); w.w = cvt_pk_bf16(v1[2], v1[3]);
                    *(u32x4*)(rowp + bj * HALF) = w;
                    if (halo && u.pn < 12 && ((m == 0 && fr == 0) || (m == 3 && fr == 15))) { const int row = row0 + ai * HALF + m * 16;
                        *(u32x4*)(halo + ((size_t)(row >> 6) * 2 + (m == 3 ? 1 : 0)) * 3072 + col0 + bj * HALF) = w; } } }
    }
};
struct EpiResid {
    static constexpr bool PERM = false, AFTER_DRAIN = false;
    float* X; int ldc; const float* gate; int gstride;
    __device__ __forceinline__ void operator()(const f32x4 (&acc)[2][2][4][2], const Unit& u, int wr, int wc, int fr, int fq) const {
        const int row0 = u.pm * BM + wr * 64 + fr, col0 = u.pn * BM + wc * 32 + 4 * fq;
        const float* g = gate + (size_t)(u.pm < 32 ? 0 : (u.pm < 64 ? 1 : 2)) * gstride + col0;
        f32x4 gv[2][2];
#pragma unroll
        for (int bj = 0; bj < 2; ++bj)
#pragma unroll
            for (int n = 0; n < 2; ++n) gv[bj][n] = *(const f32x4*)(g + bj * HALF + n * 16);
#pragma unroll
        for (int ai = 0; ai < 2; ++ai)
#pragma unroll
            for (int m = 0; m < 4; ++m) { float* p = X + (size_t)(row0 + ai * HALF + m * 16) * ldc + col0;
#pragma unroll
                for (int bj = 0; bj < 2; ++bj)
#pragma unroll
                    for (int n = 0; n < 2; ++n) { float* q = p + bj * HALF + n * 16; *(f32x4*)q = *(const f32x4*)q + gv[bj][n] * acc[ai][bj][m][n]; }
                if (m & 1) asm volatile("" ::: "memory"); }
    }
};

template <class Epi, class Sched, bool ALIGN_EPI = false, bool SP2 = false>
__device__ __forceinline__ void gemm_phase(PG8_LAS unsigned char* lds, const Gemm g, const Sched& S, const Epi& E) {
    int tid_ = threadIdx.x; asm volatile("" : "+v"(tid_)); const int tid = tid_, wid = __builtin_amdgcn_readfirstlane(tid >> 6), lane = tid & 63, wr = wid >> 2, wc = wid & 3, fr = lane & 15, fq = lane >> 4;
    const int K = g.K, nt = K / BK;
    unsigned voffA[2], voffB[2];
#pragma unroll
    for (int i = 0; i < 2; ++i) { int R, C; stage_rc(tid * 16 + i * 8192, R, C); const int Rb = Epi::PERM ? ((R & ~31) + perm32(R & 31)) : R;
        voffA[i] = (unsigned)(R * K + C) * 2u; voffB[i] = (unsigned)(Rb * K + C) * 2u; }
    const size_t kstep = (size_t)(BK * 2);
    const size_t hstep = (size_t)HALF * K * 2;
    const size_t tstep = 2 * hstep;
    const unsigned ldsw = (unsigned)wid * 1024u;
    const int aoff = lds_byte(wr * 64 + fr, fq * 8), boff = lds_byte(wc * 32 + fr, fq * 8);
#define PG8_SA(b, h) (((b) * 2 + (h)) * HTB)
#define PG8_SB(b, h) ((4 + (b) * 2 + (h)) * HTB)
#define PG8_STAGE(bufoff, gbase, voff) do { _Pragma("unroll") for (int _i = 0; _i < 2; ++_i) \
        __builtin_amdgcn_global_load_lds((const unsigned*)((const char*)(gbase) + (voff)[_i]), (PG8_LAS unsigned*)(lds + (bufoff) + ldsw + _i * 8192), 16, 0, 0); } while (0)
#define PG8_LDA(dst, b, h) do { _Pragma("unroll") for (int m = 0; m < 4; ++m) _Pragma("unroll") for (int k = 0; k < 2; ++k) dst[m][k] = *(const PG8_LAS bf16x8*)(lds + PG8_SA(b, h) + aoff + m * 2048 + k * 1024); } while (0)
#define PG8_LDB(dst, b, h) do { _Pragma("unroll") for (int n = 0; n < 2; ++n) _Pragma("unroll") for (int k = 0; k < 2; ++k) dst[n][k] = *(const PG8_LAS bf16x8*)(lds + PG8_SB(b, h) + boff + n * 2048 + k * 1024); } while (0)
#define PG8_MMA(ai, bj, At, Bt) do { __builtin_amdgcn_s_setprio(1); _Pragma("unroll") for (int m = 0; m < 4; ++m) _Pragma("unroll") for (int n = 0; n < 2; ++n) _Pragma("unroll") for (int k = 0; k < 2; ++k) \
        acc[ai][bj][m][n] = __builtin_amdgcn_mfma_f32_16x16x32_bf16(Bt[n][k], At[m][k], acc[ai][bj][m][n], 0, 0, 0); __builtin_amdgcn_s_setprio(0); } while (0)
#define PG8_WAIT_V(n) asm volatile("s_waitcnt vmcnt(" #n ")" ::: "memory")
#define PG8_WAIT_L(n) asm volatile("s_waitcnt lgkmcnt(" #n ")" ::: "memory")
#define PG8_BAR __builtin_amdgcn_s_barrier()
#define PG8_SCHED __builtin_amdgcn_sched_barrier(0)
    Unit cur, nxt; int ui = 0;
    if (!S.next(0, cur)) return;
    f32x4 acc[2][2][4][2];
#pragma unroll
    for (int a = 0; a < 2; ++a)
#pragma unroll
        for (int b = 0; b < 2; ++b)
#pragma unroll
            for (int m = 0; m < 4; ++m)
#pragma unroll
                for (int n = 0; n < 2; ++n) acc[a][b][m][n] = (f32x4){0.f, 0.f, 0.f, 0.f};
    bf16x8 At[4][2], B0[2][2], B1[2][2];
    const char* cA = (const char*)g.A + (size_t)cur.pm * tstep; const char* cB = (const char*)g.Bt + (size_t)cur.pn * tstep;
    S.a_ready(cur);
    if constexpr (SP2) {
        PG8_STAGE(PG8_SB(0, 0), cB, voffB); PG8_STAGE(PG8_SB(0, 1), cB + hstep, voffB); PG8_STAGE(PG8_SA(0, 0), cA, voffA); PG8_STAGE(PG8_SA(0, 1), cA + hstep, voffA);
        if (wr == 1) PG8_BAR;
        PG8_WAIT_V(2); PG8_BAR;
        PG8_STAGE(PG8_SB(1, 0), cB + kstep, voffB); PG8_STAGE(PG8_SA(1, 0), cA + kstep, voffA); PG8_STAGE(PG8_SB(1, 1), cB + hstep + kstep, voffB);
        PG8_WAIT_V(6); PG8_BAR;
    } else {
        PG8_STAGE(PG8_SB(0, 0), cB, voffB); PG8_STAGE(PG8_SA(0, 0), cA, voffA); PG8_STAGE(PG8_SB(0, 1), cB + hstep, voffB); PG8_STAGE(PG8_SA(0, 1), cA + hstep, voffA);
        if (wr == 1) PG8_BAR;
        PG8_WAIT_V(4); PG8_BAR;
        PG8_STAGE(PG8_SB(1, 0), cB + kstep, voffB); PG8_STAGE(PG8_SA(1, 0), cA + kstep, voffA); PG8_STAGE(PG8_SB(1, 1), cB + hstep + kstep, voffB);
        PG8_WAIT_V(6); PG8_BAR;
    }
    for (;;) {
        const bool has_next = S.next(ui + 1, nxt);
        const char* nA = has_next ? (const char*)g.A + (size_t)nxt.pm * tstep : cA; const char* nB = has_next ? (const char*)g.Bt + (size_t)nxt.pn * tstep : cB;
        for (int t = 0; t < nt; t += 2) {
            const bool last = (t == nt - 2);
            const char* a1 = cA + (size_t)(t + 1) * kstep;
            const char* a2 = last ? nA : cA + (size_t)(t + 2) * kstep; const char* b2 = last ? nB : cB + (size_t)(t + 2) * kstep;
            const char* a3 = a2 + kstep; const char* b3 = b2 + kstep;
            if (last && has_next) S.a_ready(nxt);
            if constexpr (SP2) {
            PG8_LDB(B0, 0, 0); PG8_LDB(B1, 0, 1); PG8_SCHED; PG8_LDA(At, 0, 0); PG8_STAGE(PG8_SA(1, 1), a1 + hstep, voffA);
            PG8_WAIT_V(8); PG8_WAIT_L(0); PG8_BAR; PG8_MMA(0, 0, At, B0); PG8_MMA(0, 1, At, B1); PG8_BAR; PG8_SCHED;
            PG8_LDA(At, 0, 1); PG8_STAGE(PG8_SB(0, 0), b2, voffB); PG8_STAGE(PG8_SB(0, 1), b2 + hstep, voffB); PG8_STAGE(PG8_SA(0, 0), a2, voffA);
            PG8_WAIT_V(8); PG8_WAIT_L(0); PG8_BAR; PG8_MMA(1, 0, At, B0); PG8_MMA(1, 1, At, B1); PG8_BAR; PG8_SCHED;
            PG8_LDB(B0, 1, 0); PG8_LDB(B1, 1, 1); PG8_SCHED; PG8_LDA(At, 1, 0); PG8_STAGE(PG8_SA(0, 1), a2 + hstep, voffA);
            PG8_WAIT_V(8); PG8_WAIT_L(0); PG8_BAR; PG8_MMA(0, 0, At, B0); PG8_MMA(0, 1, At, B1); PG8_BAR; PG8_SCHED;
            PG8_LDA(At, 1, 1); PG8_STAGE(PG8_SB(1, 0), b3, voffB); PG8_STAGE(PG8_SB(1, 1), b3 + hstep, voffB); PG8_STAGE(PG8_SA(1, 0), a3, voffA);
            PG8_WAIT_V(8); PG8_WAIT_L(0); PG8_BAR; PG8_MMA(1, 0, At, B0); PG8_MMA(1, 1, At, B1); PG8_BAR; PG8_SCHED;
            } else {
            PG8_LDB(B0, 0, 0); PG8_SCHED; PG8_LDA(At, 0, 0); PG8_STAGE(PG8_SA(1, 1), a1 + hstep, voffA);
            PG8_WAIT_L(8); PG8_BAR; PG8_WAIT_L(0); PG8_MMA(0, 0, At, B0); PG8_BAR; PG8_SCHED;
            PG8_LDB(B1, 0, 1); PG8_STAGE(PG8_SB(0, 0), b2, voffB);
            PG8_BAR; PG8_WAIT_L(0); PG8_MMA(0, 1, At, B1); PG8_BAR;
            PG8_LDA(At, 0, 1); PG8_STAGE(PG8_SA(0, 0), a2, voffA);
            PG8_BAR; PG8_WAIT_L(0); PG8_MMA(1, 0, At, B0); PG8_BAR; PG8_SCHED;
            PG8_STAGE(PG8_SB(0, 1), b2 + hstep, voffB);
            PG8_WAIT_V(6); PG8_BAR; PG8_MMA(1, 1, At, B1); PG8_BAR;
            PG8_LDB(B0, 1, 0); PG8_SCHED; PG8_LDA(At, 1, 0); PG8_STAGE(PG8_SA(0, 1), a2 + hstep, voffA);
            PG8_WAIT_L(8); PG8_BAR; PG8_WAIT_L(0); PG8_MMA(0, 0, At, B0); PG8_BAR; PG8_SCHED;
            PG8_LDB(B1, 1, 1); PG8_STAGE(PG8_SB(1, 0), b3, voffB);
            PG8_BAR; PG8_WAIT_L(0); PG8_MMA(0, 1, At, B1); PG8_BAR;
            PG8_LDA(At, 1, 1); PG8_STAGE(PG8_SA(1, 0), a3, voffA);
            PG8_BAR; PG8_WAIT_L(0); PG8_MMA(1, 0, At, B0); PG8_BAR; PG8_SCHED;
            PG8_STAGE(PG8_SB(1, 1), b3 + hstep, voffB);
            PG8_WAIT_V(6); PG8_BAR; PG8_MMA(1, 1, At, B1); PG8_BAR;
            }
        }
        if constexpr (ALIGN_EPI) { if (wr == 0) PG8_BAR; }
        if constexpr (!Epi::AFTER_DRAIN) { E(acc, cur, wr, wc, fr, fq); S.done(cur); }
        if (!has_next) break;
#pragma unroll
        for (int a = 0; a < 2; ++a)
#pragma unroll
            for (int b = 0; b < 2; ++b)
#pragma unroll
                for (int m = 0; m < 4; ++m)
#pragma unroll
                    for (int n = 0; n < 2; ++n) acc[a][b][m][n] = (f32x4){0.f, 0.f, 0.f, 0.f};
        cur = nxt; cA = nA; cB = nB; ++ui;
        if constexpr (ALIGN_EPI) { if (wr == 1) PG8_BAR; }
    }
    PG8_WAIT_V(0);
    if constexpr (!ALIGN_EPI) { if (wr == 0) PG8_BAR; }
    PG8_BAR;
    if constexpr (Epi::AFTER_DRAIN) { E.fused(acc, cur, wr, wc, fr, fq, lds, wid, lane); S.done(cur); }
#undef PG8_SA
#undef PG8_SB
#undef PG8_STAGE
#undef PG8_LDA
#undef PG8_LDB
#undef PG8_MMA
#undef PG8_WAIT_V
#undef PG8_WAIT_L
#undef PG8_BAR
#undef PG8_SCHED
}
}

constexpr int D = 1024, NB = 2, T = 8192, CT = 256, DEPTH = 4, FF = 4096;
constexpr int ML = NB * T, MC = NB * CT, M = ML + MC;
constexpr int NADA = 6 * D;
constexpr int GDN_N = 4128, GDN_NP = 4352;
constexpr int NH = 8, HD = 128;
constexpr int NKV = CT + T;
constexpr float EPS = 1e-6f;
constexpr int NWAVES = 8, NTHR = 512;
constexpr float QSCALE = 0.125f * 1.4426950408889634f;
constexpr float LAMBDA_INIT = 0.47071302f;

constexpr size_t MiB = 1u << 20;
constexpr size_t WS_CTL = 0, CTL_ZERO_BYTES = 1 * MiB;
constexpr size_t WS_MOD = 1 * MiB;
constexpr size_t WS_ROPE = 2 * MiB;
constexpr size_t WS_AB = 4 * MiB;
constexpr size_t WS_OFC = 7 * MiB;
constexpr size_t WS_W1T = 10 * MiB, WS_W2T = 42 * MiB, WS_GINT = 74 * MiB, WS_GOUTT = 91 * MiB, WS_SINT = 95 * MiB, WS_SOUTT = 101 * MiB, WS_DINT = 103 * MiB, WS_DOUTT = 109 * MiB;
constexpr size_t WS_X = 112 * MiB;
constexpr size_t WS_H = 178 * MiB;
constexpr size_t WS_Y = 211 * MiB;
constexpr size_t WS_Z = 244 * MiB;
constexpr size_t WS_HALO = 376 * MiB;
constexpr size_t WS_END = 380 * MiB;
constexpr size_t WS_PD = WS_H;

constexpr int LDS_BYTES = 149504;

#define LAS __attribute__((address_space(3)))
typedef unsigned short bf16;
typedef unsigned u32x4 __attribute__((ext_vector_type(4)));
typedef unsigned u32x2 __attribute__((ext_vector_type(2)));
typedef float f32x4 __attribute__((ext_vector_type(4)));
typedef float f32x2 __attribute__((ext_vector_type(2)));
typedef float f32x16 __attribute__((ext_vector_type(16)));
typedef short bf16x8 __attribute__((ext_vector_type(8)));
typedef short s16x4 __attribute__((ext_vector_type(4)));
#define LDS_WAIT() asm volatile("s_waitcnt lgkmcnt(0)" ::: "memory")

__device__ __forceinline__ float bf2f(unsigned u) { return __uint_as_float(u << 16); }
__device__ __forceinline__ unsigned pk2(float lo, float hi) { return pg8::cvt_pk_bf16(lo, hi); }
__device__ __forceinline__ float wave_sum(float v) {
#pragma unroll
    for (int o = 1; o < 64; o <<= 1) v += __shfl_xor(v, o);
    return v;
}
__device__ __forceinline__ float silu_f(float x) { return x / (1.f + expf(-x)); }
__device__ __forceinline__ int crow(int r, int hi) { return (r & 3) + 8 * (r >> 2) + 4 * hi; }

struct Args { const float* in[24]; float* out; unsigned char* ws; int step_lo, step_hi, coop, pad; };
typedef const __attribute__((address_space(4))) Args* KArgs;
__device__ __forceinline__ KArgs kargs() { unsigned long long p = (unsigned long long)__builtin_amdgcn_kernarg_segment_ptr(); asm volatile("" : "+s"(p)); return (KArgs)p; }
#define INP(k) (kargs()->in[k])
extern __shared__ __attribute__((aligned(16))) unsigned char lds_raw[];
struct Frame { LAS unsigned char* lds; int tid, lane, wave, G, bid; float* out; unsigned char* ws; };
__device__ __forceinline__ Frame make_frame() {
    Frame F; F.lds = (LAS unsigned char*)lds_raw; F.tid = threadIdx.x; asm volatile("" : "+v"(F.tid)); F.lane = F.tid & 63; F.wave = __builtin_amdgcn_readfirstlane(F.tid >> 6); F.G = gridDim.x; F.bid = blockIdx.x; asm volatile("" : "+s"(F.G), "+s"(F.bid));
    KArgs a = kargs(); F.out = a->out; F.ws = a->ws; return F;
}
enum { I_X = 0, I_C, I_CTX, I_CCTX, I_N1G, I_N2G, I_ADAW, I_ADAB, I_W1, I_W2, I_GIN, I_GCONV, I_GALOG, I_GDT, I_GNG, I_GOUT, I_SIN, I_SCONV, I_SOUT, I_DIN, I_DLAM, I_DNG, I_DOUT, I_FG };

__device__ __forceinline__ void transpose_item(const float* W, int K, int ldw, bf16* WT, LAS float* scr, int item, int nblk, int lane) {
    const int kb = item / nblk, nb = item % nblk, k0 = 64 * kb, n0 = 32 * nb;
#pragma unroll 8
    for (int i = 0; i < 32; ++i) { const int kk = 2 * i + (lane >> 5); scr[kk * 33 + (lane & 31)] = W[(size_t)(k0 + kk) * ldw + n0 + (lane & 31)]; }
    LDS_WAIT(); asm volatile("" ::: "memory");
    const int c = lane & 7;
#pragma unroll
    for (int j = 0; j < 4; ++j) { const int n = (lane >> 3) + 8 * j; const LAS float* s = scr + (8 * c) * 33 + n;
        u32x4 o; o.x = pk2(s[0 * 33], s[1 * 33]); o.y = pk2(s[2 * 33], s[3 * 33]); o.z = pk2(s[4 * 33], s[5 * 33]); o.w = pk2(s[6 * 33], s[7 * 33]);
        *(u32x4*)(WT + (size_t)(n0 + n) * K + k0 + 8 * c) = o; }
    LDS_WAIT(); asm volatile("" ::: "memory");
}
__device__ __forceinline__ void get_mat(unsigned char* ws_, int idx, const float*& src, bf16*& dst, int& K, int& N, int& ld) {
    unsigned char* ws = ws_;
    if (idx < 4)       { src = INP(I_W1) + (size_t)idx * D * FF; dst = (bf16*)(ws + WS_W1T) + (size_t)idx * D * FF; K = D; N = FF; ld = FF; }
    else if (idx < 8)  { const int i = idx - 4; src = INP(I_W2) + (size_t)i * D * FF; dst = (bf16*)(ws + WS_W2T) + (size_t)i * D * FF; K = FF; N = D; ld = D; }
    else if (idx < 10) { const int j = idx - 8; src = INP(I_GIN) + (size_t)j * D * GDN_N; dst = (bf16*)(ws + WS_GINT) + (size_t)j * GDN_NP * D; K = D; N = GDN_N; ld = GDN_N; }
    else if (idx < 12) { const int j = idx - 10; src = INP(I_GOUT) + (size_t)j * D * D; dst = (bf16*)(ws + WS_GOUTT) + (size_t)j * D * D; K = D; N = D; ld = D; }
    else if (idx == 12) { src = INP(I_SIN); dst = (bf16*)(ws + WS_SINT); K = D; N = 3 * D; ld = 3 * D; }
    else if (idx == 13) { src = INP(I_SOUT); dst = (bf16*)(ws + WS_SOUTT); K = D; N = D; ld = D; }
    else if (idx == 14) { src = INP(I_DIN); dst = (bf16*)(ws + WS_DINT); K = D; N = 3 * D; ld = 3 * D; }
    else { src = INP(I_DOUT); dst = (bf16*)(ws + WS_DOUTT); K = D; N = D; ld = D; }
}
__device__ __forceinline__ void step_prologue() {
    const Frame F = make_frame();
    const int gw = F.bid * NWAVES + F.wave, NGW = F.G * NWAVES;
    const int gt = F.bid * NTHR + F.tid, NGT = F.G * NTHR;
    {
        LAS float* scr = (LAS float*)(F.lds + F.wave * 16384);
        for (int mi = 0; mi < 16; ++mi) {
            const float* src; bf16* dst; int K, N, ld; get_mat(F.ws, mi, src, dst, K, N, ld);
            const int nblk = N / 32, nitems = (K / 64) * nblk;
            for (int it = gw; it < nitems; it += NGW) transpose_item(src, K, ld, dst, scr, it, nblk, F.lane);
        }
        for (int j = 0; j < 2; ++j) { u32x4* z = (u32x4*)((bf16*)(F.ws + WS_GINT) + (size_t)j * GDN_NP * D + (size_t)GDN_N * D);
            for (int i = gt; i < (GDN_NP - GDN_N) * D / 8; i += NGT) z[i] = (u32x4){0u, 0u, 0u, 0u}; }
    }
    __syncthreads();
    {
        LAS float* sv = (LAS float*)F.lds;
        LAS float* red = sv + 3 * D;
        for (int i = F.tid; i < 3 * D; i += NTHR) { const int g = i / D, k = i % D; const float c = g < 2 ? INP(I_C)[g * D + k] : INP(I_CCTX)[k]; sv[i] = silu_f(c); }
        __syncthreads();
        float* MOD = (float*)(F.ws + WS_MOD);
        const int c = F.tid & 63, ks = F.tid >> 6;
        for (int it = F.bid; it < DEPTH * (NADA / 64); it += F.G) {
            const int li = it / (NADA / 64), n0 = (it % (NADA / 64)) * 64;
            const float* w = INP(I_ADAW) + (size_t)li * D * NADA + (size_t)(ks * 128) * NADA + n0 + c;
            float a0 = 0.f, a1 = 0.f, a2 = 0.f;
#pragma unroll 8
            for (int k = 0; k < 128; ++k) { const float wv = w[(size_t)k * NADA]; const int kk = ks * 128 + k; a0 += sv[kk] * wv; a1 += sv[D + kk] * wv; a2 += sv[2 * D + kk] * wv; }
            red[(ks * 3 + 0) * 64 + c] = a0; red[(ks * 3 + 1) * 64 + c] = a1; red[(ks * 3 + 2) * 64 + c] = a2;
            __syncthreads();
            if (F.tid < 192) { const int g = F.tid >> 6; float s = INP(I_ADAB)[li * NADA + n0 + c];
#pragma unroll
                for (int q = 0; q < 8; ++q) s += red[(q * 3 + g) * 64 + c];
                MOD[((size_t)li * 3 + g) * NADA + n0 + c] = s; }
            __syncthreads();
        }
    }
    {
        f32x4* X4 = (f32x4*)(F.ws + WS_X); const f32x4* x4 = (const f32x4*)INP(I_X); const f32x4* c4 = (const f32x4*)INP(I_CTX);
        for (int i = gt; i < M * (D / 4); i += NGT) X4[i] = i < ML * (D / 4) ? x4[i] : c4[i - ML * (D / 4)];
    }
    {
        f32x2* R = (f32x2*)(F.ws + WS_ROPE);
        for (int i = gt; i < T * 32; i += NGT) { const int t = i >> 5, p = i & 31, f = p & 15;
            const float inv = powf(10000.0f, -(float)f / 16.0f); const float pos = (float)(p < 16 ? (t >> 6) : (t & 63)); const float ang = pos * inv;
            R[i] = (f32x2){cosf(ang), sinf(ang)}; }
    }
}

__device__ __forceinline__ void step_norm(int layer, int which, int nrows, bool zero_of) {
    const Frame F = make_frame();
    const int gw = F.bid * NWAVES + F.wave, NGW = F.G * NWAVES;
    const float* X = (const float*)(F.ws + WS_X); bf16* H = (bf16*)(F.ws + WS_H);
    const float* ng = (which ? INP(I_N2G) : INP(I_N1G)) + layer * D;
    const float* MOD = (const float*)(F.ws + WS_MOD) + (size_t)layer * 3 * NADA + which * 3 * D;
    for (int row = gw; row < nrows; row += NGW) {
        const int grp = row < T ? 0 : (row < ML ? 1 : 2);
        const f32x4* xr = (const f32x4*)(X + (size_t)row * D) + F.lane;
        const f32x4* sh = (const f32x4*)(MOD + (size_t)grp * NADA) + F.lane; const f32x4* sc = (const f32x4*)(MOD + (size_t)grp * NADA + D) + F.lane; const f32x4* gg = (const f32x4*)ng + F.lane;
        f32x4 v[4]; float s = 0.f;
#pragma unroll
        for (int j = 0; j < 4; ++j) { v[j] = xr[64 * j]; s += (v[j].x * v[j].x + v[j].y * v[j].y) + (v[j].z * v[j].z + v[j].w * v[j].w); }
        const float rstd = 1.0f / sqrtf(wave_sum(s) * (1.f / D) + EPS);
        u32x2* o = (u32x2*)(H + (size_t)row * D) + F.lane;
#pragma unroll
        for (int j = 0; j < 4; ++j) { const f32x4 g4 = gg[64 * j], s4 = sc[64 * j], h4 = sh[64 * j]; const f32x4 y = (v[j] * rstd) * g4; const f32x4 h = y * (1.0f + s4) + h4;
            o[64 * j] = (u32x2){pk2(h.x, h.y), pk2(h.z, h.w)}; }
    }
    if (zero_of) {
        const int gt = F.bid * NTHR + F.tid, NGT = F.G * NTHR;
        f32x4* a = (f32x4*)F.out; for (int i = gt; i < ML * (D / 4); i += NGT) a[i] = (f32x4){0.f, 0.f, 0.f, 0.f};
        f32x4* b = (f32x4*)(F.ws + WS_OFC); for (int i = gt; i < MC * (D / 4); i += NGT) b[i] = (f32x4){0.f, 0.f, 0.f, 0.f};
    }
}
__device__ __forceinline__ void step_final() {
    const Frame F = make_frame();
    const int gw = F.bid * NWAVES + F.wave, NGW = F.G * NWAVES;
    const float* X = (const float*)(F.ws + WS_X);
    for (int row = gw; row < ML; row += NGW) {
        const f32x4* xr = (const f32x4*)(X + (size_t)row * D) + F.lane; const f32x4* gg = (const f32x4*)INP(I_FG) + F.lane;
        f32x4 v[4]; float s = 0.f;
#pragma unroll
        for (int j = 0; j < 4; ++j) { v[j] = xr[64 * j]; s += (v[j].x * v[j].x + v[j].y * v[j].y) + (v[j].z * v[j].z + v[j].w * v[j].w); }
        const float rstd = 1.0f / sqrtf(wave_sum(s) * (1.f / D) + EPS);
        f32x4* o = (f32x4*)(F.out + (size_t)row * D) + F.lane;
#pragma unroll
        for (int j = 0; j < 4; ++j) o[64 * j] = (v[j] * rstd) * gg[64 * j];
    }
}

__device__ __forceinline__ void step_gdn_scan(int j) {
    const Frame F = make_frame();
    LAS float* qs = (LAS float*)F.lds;
    LAS float* ks = qs + 64 * 128;
    LAS float* vs = ks + 64 * 128;
    LAS float* ga = vs + 64 * 128;
    LAS float* be = ga + 64;
    const bf16* Z = (const bf16*)(F.ws + WS_Z);
    const float* AB = (const float*)(F.ws + WS_AB);
    const float* cw = INP(I_GCONV) + (size_t)j * 3 * 3072;
    float* OFC = (float*)(F.ws + WS_OFC);
    for (int it = F.bid; it < 32; it += F.G) {
        const int b = it >> 4, h = (it >> 1) & 7, dir = it & 1;
        const float Aco = expf(INP(I_GALOG)[j * 16 + dir * 8 + h]); const float dtb = INP(I_GDT)[j * 16 + dir * 8 + h];
        float S[64];
#pragma unroll
        for (int i = 0; i < 64; ++i) S[i] = 0.f;
        const int jcol = F.tid >> 1, half = F.tid & 1;
        for (int n = 0; n < 132; ++n) {
            const bool isctx = n < 4; const int L = isctx ? CT : T; const int p0 = isctx ? 64 * n : 64 * (n - 4); const int rbase = isctx ? ML + b * CT : b * T;
            for (int idx = F.tid; idx < 64 * 384; idx += NTHR) {
                const int c = idx / 384, ch = idx % 384, part = ch >> 7, e = ch & 127;
                const int p = p0 + c; const int t = dir ? (L - 1 - p) : p; const int col = part * 1024 + h * 128 + e;
                float acc = 0.f;
#pragma unroll
                for (int tap = 0; tap < 3; ++tap) { const int tt = t + tap - 1; if (tt >= 0 && tt < L) acc += cw[tap * 3072 + col] * bf2f(Z[(size_t)(rbase + tt) * 4096 + col]); }
                acc = silu_f(acc);
                LAS float* dst = part == 0 ? qs : (part == 1 ? ks : vs); dst[c * 128 + e] = acc;
            }
            if (F.tid < 64) { const int p = p0 + F.tid; const int t = dir ? (L - 1 - p) : p; const size_t row = (size_t)(rbase + t);
                const float av = AB[row * 32 + dir * 8 + h], bv = AB[row * 32 + 16 + dir * 8 + h];
                const float x = av + dtb; const float sp = x > 20.f ? x : log1pf(expf(x));
                ga[F.tid] = expf(-Aco * sp); be[F.tid] = 1.f / (1.f + expf(-bv)); }
            __syncthreads();
#pragma unroll 1
            for (int rr = 0; rr < 8; ++rr) { const int c = F.wave * 8 + rr;
                const float q0 = qs[c * 128 + F.lane], q1 = qs[c * 128 + 64 + F.lane]; const float sq = 0.08838834764831845f / sqrtf(wave_sum(q0 * q0 + q1 * q1) + EPS);
                qs[c * 128 + F.lane] = q0 * sq; qs[c * 128 + 64 + F.lane] = q1 * sq;
                const float k0 = ks[c * 128 + F.lane], k1 = ks[c * 128 + 64 + F.lane]; const float sk = 1.0f / sqrtf(wave_sum(k0 * k0 + k1 * k1) + EPS);
                ks[c * 128 + F.lane] = k0 * sk; ks[c * 128 + 64 + F.lane] = k1 * sk; }
            __syncthreads();
            if (F.tid < 256) {
#pragma unroll 1
                for (int c = 0; c < 64; ++c) {
                    const float a = ga[c], bt = be[c];
                    const LAS f32x4* k4 = (const LAS f32x4*)(ks + c * 128 + 64 * half); const LAS f32x4* q4 = (const LAS f32x4*)(qs + c * 128 + 64 * half);
                    float dot = 0.f;
#pragma unroll
                    for (int i = 0; i < 16; ++i) { const f32x4 kv = k4[i]; dot += kv.x * S[4 * i] + kv.y * S[4 * i + 1] + kv.z * S[4 * i + 2] + kv.w * S[4 * i + 3]; }
                    dot += __shfl_xor(dot, 1);
                    const float tmp = bt * (vs[c * 128 + jcol] - a * dot);
                    float o = 0.f;
#pragma unroll
                    for (int i = 0; i < 16; ++i) { const f32x4 kv = k4[i]; const f32x4 qv = q4[i];
                        S[4 * i] = a * S[4 * i] + kv.x * tmp; S[4 * i + 1] = a * S[4 * i + 1] + kv.y * tmp; S[4 * i + 2] = a * S[4 * i + 2] + kv.z * tmp; S[4 * i + 3] = a * S[4 * i + 3] + kv.w * tmp;
                        o += qv.x * S[4 * i] + qv.y * S[4 * i + 1] + qv.z * S[4 * i + 2] + qv.w * S[4 * i + 3]; }
                    o += __shfl_xor(o, 1);
                    const int p = p0 + c; const int t = dir ? (L - 1 - p) : p;
                    float* dst = isctx ? OFC + (size_t)(b * CT + t) * D : F.out + (size_t)(b * T + t) * D;
                    if (half == 0) atomicAdd(dst + h * 128 + jcol, o);
                }
            }
            __syncthreads();
        }
    }
}
__device__ __forceinline__ void step_gdn_norm(int j) {
    const Frame F = make_frame();
    const int gw = F.bid * NWAVES + F.wave, NGW = F.G * NWAVES;
    const bf16* Z = (const bf16*)(F.ws + WS_Z); bf16* Y = (bf16*)(F.ws + WS_Y); const float* ng = INP(I_GNG) + j * 128;
    for (int row = gw; row < M; row += NGW) {
        const float* src = row < ML ? F.out + (size_t)row * D : (const float*)(F.ws + WS_OFC) + (size_t)(row - ML) * D;
        const f32x4* s4 = (const f32x4*)(src + 16 * F.lane);
        float v[16]; float ss = 0.f;
#pragma unroll
        for (int q = 0; q < 4; ++q) { const f32x4 x = s4[q]; v[4 * q] = x.x; v[4 * q + 1] = x.y; v[4 * q + 2] = x.z; v[4 * q + 3] = x.w; ss += (x.x * x.x + x.y * x.y) + (x.z * x.z + x.w * x.w); }
        ss += __shfl_xor(ss, 1); ss += __shfl_xor(ss, 2); ss += __shfl_xor(ss, 4);
        const float rstd = 1.0f / sqrtf(ss * (1.f / 128.f) + EPS);
        const u32x4* g4 = (const u32x4*)(Z + (size_t)row * 4096 + 3072 + 16 * F.lane);
        const int e0 = (16 * F.lane) & 127;
        u32x4 o[2];
#pragma unroll
        for (int q = 0; q < 2; ++q) { const u32x4 gz = g4[q]; unsigned w[4];
#pragma unroll
            for (int i = 0; i < 4; ++i) { const unsigned gg = gz[i]; const float g0 = bf2f(gg & 0xffffu), g1 = bf2f(gg >> 16); const int e = e0 + 8 * q + 2 * i;
                w[i] = pk2(v[8 * q + 2 * i] * rstd * ng[e] * silu_f(g0), v[8 * q + 2 * i + 1] * rstd * ng[e + 1] * silu_f(g1)); }
            o[q] = (u32x4){w[0], w[1], w[2], w[3]}; }
        u32x4* dst = (u32x4*)(Y + (size_t)row * D + 16 * F.lane); dst[0] = o[0]; dst[1] = o[1];
    }
}

__device__ __forceinline__ void step_sconv() {
    const Frame F = make_frame();
    const int gt = F.bid * NTHR + F.tid, NGT = F.G * NTHR;
    const bf16* Z = (const bf16*)(F.ws + WS_Z); bf16* Y = (bf16*)(F.ws + WS_Y); const float* cw = INP(I_SCONV);
    for (int idx = gt; idx < M * 128; idx += NGT) {
        const int row = idx >> 7, c0 = (idx & 127) * 8;
        int t, L, rbase; if (row < ML) { t = row & (T - 1); L = T; rbase = row - t; } else { const int r2 = row - ML; t = r2 & (CT - 1); L = CT; rbase = row - t; }
        float acc[8];
#pragma unroll
        for (int i = 0; i < 8; ++i) acc[i] = 0.f;
#pragma unroll
        for (int tap = 0; tap < 3; ++tap) { const int tt = t + tap - 1;
            if (tt >= 0 && tt < L) { const bf16* zr = Z + (size_t)(rbase + tt) * 3072; const u32x4 cg = *(const u32x4*)(zr + 1024 + c0), hv = *(const u32x4*)(zr + 2048 + c0);
                const f32x4 w0 = *(const f32x4*)(cw + tap * 1024 + c0), w1 = *(const f32x4*)(cw + tap * 1024 + c0 + 4); const float w[8] = {w0.x, w0.y, w0.z, w0.w, w1.x, w1.y, w1.z, w1.w};
#pragma unroll
                for (int i = 0; i < 4; ++i) { acc[2 * i] += w[2 * i] * bf2f(cg[i] & 0xffffu) * bf2f(hv[i] & 0xffffu); acc[2 * i + 1] += w[2 * i + 1] * bf2f(cg[i] >> 16) * bf2f(hv[i] >> 16); } } }
        const u32x4 bg = *(const u32x4*)(Z + (size_t)row * 3072 + c0); u32x4 o;
#pragma unroll
        for (int i = 0; i < 4; ++i) o[i] = pk2(bf2f(bg[i] & 0xffffu) * acc[2 * i], bf2f(bg[i] >> 16) * acc[2 * i + 1]);
        *(u32x4*)(Y + (size_t)row * D + c0) = o;
    }
}

__device__ __forceinline__ void step_rope() {
    const Frame F = make_frame();
    const int gw = F.bid * NWAVES + F.wave, NGW = F.G * NWAVES;
    bf16* Z = (bf16*)(F.ws + WS_Z); const f32x4* R = (const f32x4*)(F.ws + WS_ROPE);
    for (int row = gw; row < M; row += NGW) {
        u32x4* p = (u32x4*)(Z + (size_t)row * 3072 + 32 * F.lane);
        u32x4 v[4];
#pragma unroll
        for (int q = 0; q < 4; ++q) v[q] = p[q];
        const bool lat = row < ML; const float sc = F.lane < 32 ? QSCALE : 1.0f;
        const f32x4* tab = R + ((size_t)(row & (T - 1)) * 32 + 16 * (F.lane & 1)) / 2;
#pragma unroll
        for (int q = 0; q < 4; ++q) {
#pragma unroll
            for (int i = 0; i < 4; i += 2) {
                f32x4 cs = (f32x4){1.f, 0.f, 1.f, 0.f}; if (lat) cs = tab[(4 * q + i) / 2];
                { const unsigned w = v[q][i]; const float x0 = bf2f(w & 0xffffu), x1 = bf2f(w >> 16); v[q][i] = pk2((x0 * cs.x - x1 * cs.y) * sc, (x0 * cs.y + x1 * cs.x) * sc); }
                { const unsigned w = v[q][i + 1]; const float x0 = bf2f(w & 0xffffu), x1 = bf2f(w >> 16); v[q][i + 1] = pk2((x0 * cs.z - x1 * cs.w) * sc, (x0 * cs.w + x1 * cs.z) * sc); }
            }
        }
#pragma unroll
        for (int q = 0; q < 4; ++q) p[q] = v[q];
    }
    bf16* Vt = (bf16*)(F.ws + WS_H);
    LAS bf16* tl = (LAS bf16*)(F.lds + F.wave * 18432);
    for (int it = gw; it < NB * NH * (NKV / 64); it += NGW) {
        const int kt = it % (NKV / 64), bh = it / (NKV / 64), b = bh >> 3, h = bh & 7; const int kv0 = 64 * kt;
        const int srow = kv0 < CT ? ML + b * CT + kv0 : b * T + kv0 - CT;
#pragma unroll 4
        for (int i = 0; i < 16; ++i) { const int r = 4 * i + (F.lane >> 4), cc = (F.lane & 15) * 8;
            const u32x4 v = *(const u32x4*)(Z + (size_t)(srow + r) * 3072 + 2048 + h * 128 + cc);
#pragma unroll
            for (int q = 0; q < 4; ++q) { tl[(cc + 2 * q) * 72 + r] = (bf16)(v[q] & 0xffffu); tl[(cc + 2 * q + 1) * 72 + r] = (bf16)(v[q] >> 16); } }
        LDS_WAIT(); asm volatile("" ::: "memory");
#pragma unroll 4
        for (int i = 0; i < 16; ++i) { const int e = 8 * i + (F.lane >> 3), ch = F.lane & 7;
            const u32x4 v = *(const LAS u32x4*)(tl + e * 72 + ch * 8);
            *(u32x4*)(Vt + ((size_t)(bh * 128 + e)) * NKV + kv0 + ch * 8) = v; }
        LDS_WAIT(); asm volatile("" ::: "memory");
    }
}
__device__ __forceinline__ void step_attn() {
    const Frame F = make_frame();
    const bf16* Z = (const bf16*)(F.ws + WS_Z); const bf16* Vt = (const bf16*)(F.ws + WS_H); bf16* Y = (bf16*)(F.ws + WS_Y);
    LAS float* EX = (LAS float*)F.lds;
    const int r = F.lane & 31, hi = F.lane >> 5, qs = F.wave & 3, m = F.wave >> 2;
    float lmb;
    { const float* lam = INP(I_DLAM); const float t1 = lam[F.lane] * lam[64 + F.lane], t2 = lam[128 + F.lane] * lam[192 + F.lane]; lmb = expf(wave_sum(t1)) - expf(wave_sum(t2)) + LAMBDA_INIT; }
    const float* ng = INP(I_DNG);
    for (int u = F.bid; u < 1056; u += F.G) {
        int b, h, qrow0, nk;
        if (u < 1024) { b = u >> 9; h = (u >> 6) & 7; qrow0 = b * T + (u & 63) * 128; nk = NKV / 32; }
        else { const int v = u - 1024; b = v >> 4; h = (v >> 1) & 7; qrow0 = ML + b * CT + (v & 1) * 128; nk = CT / 32; }
        const int row0 = qrow0 + 32 * qs;
        bf16x8 qf[4];
#pragma unroll
        for (int d0 = 0; d0 < 4; ++d0) qf[d0] = *(const bf16x8*)(Z + (size_t)(row0 + r) * 3072 + h * 128 + m * 64 + d0 * 16 + hi * 8);
        const int kcol = 1024 + h * 128 + m * 64 + hi * 8;
        const bf16* vtb = Vt + (size_t)((b * 8 + h) * 128 + r) * NKV + 4 * hi;
        f32x16 o[4];
#pragma unroll
        for (int i = 0; i < 4; ++i)
#pragma unroll
            for (int q = 0; q < 16; ++q) o[i][q] = 0.f;
        float mref = 0.f, l = 0.f;
        for (int s = 0; s < nk; ++s) {
            const int kv0 = 32 * s; const int krow = kv0 < CT ? ML + b * CT + kv0 : b * T + kv0 - CT;
            const bf16* kp = Z + (size_t)(krow + r) * 3072 + kcol;
            bf16x8 kf[4];
#pragma unroll
            for (int d0 = 0; d0 < 4; ++d0) kf[d0] = *(const bf16x8*)(kp + d0 * 16);
            bf16x8 vf[4][2];
#pragma unroll
            for (int i = 0; i < 4; ++i)
#pragma unroll
                for (int s2 = 0; s2 < 2; ++s2) { const bf16* vp = vtb + (size_t)(32 * i) * NKV + kv0 + 16 * s2; const s16x4 lo = *(const s16x4*)vp, h8 = *(const s16x4*)(vp + 8);
                    vf[i][s2] = (bf16x8){lo[0], lo[1], lo[2], lo[3], h8[0], h8[1], h8[2], h8[3]}; }
            f32x16 S;
#pragma unroll
            for (int q = 0; q < 16; ++q) S[q] = 0.f;
#pragma unroll
            for (int d0 = 0; d0 < 4; ++d0) S = __builtin_amdgcn_mfma_f32_32x32x16_bf16(kf[d0], qf[d0], S, 0, 0, 0);
            float mx = S[0];
#pragma unroll
            for (int q = 1; q < 16; ++q) mx = fmaxf(mx, S[q]);
            mx = fmaxf(mx, __shfl_xor(mx, 32));
            if (s == 0) mref = mx;
            else if (__any(mx > mref)) { const float mn = fmaxf(mref, mx); const float al = __builtin_amdgcn_exp2f(mref - mn); l *= al; mref = mn;
#pragma unroll
                for (int i = 0; i < 4; ++i)
#pragma unroll
                    for (int q = 0; q < 16; ++q) o[i][q] *= al; }
            float ps = 0.f;
#pragma unroll
            for (int q = 0; q < 16; ++q) { S[q] = __builtin_amdgcn_exp2f(S[q] - mref); ps += S[q]; }
            l += ps;
            bf16x8 pf[2];
#pragma unroll
            for (int s2 = 0; s2 < 2; ++s2) { u32x4 w; w.x = pk2(S[8 * s2], S[8 * s2 + 1]); w.y = pk2(S[8 * s2 + 2], S[8 * s2 + 3]); w.z = pk2(S[8 * s2 + 4], S[8 * s2 + 5]); w.w = pk2(S[8 * s2 + 6], S[8 * s2 + 7]); pf[s2] = __builtin_bit_cast(bf16x8, w); }
#pragma unroll
            for (int i = 0; i < 4; ++i)
#pragma unroll
                for (int s2 = 0; s2 < 2; ++s2) o[i] = __builtin_amdgcn_mfma_f32_32x32x16_bf16(vf[i][s2], pf[s2], o[i], 0, 0, 0);
        }
        l += __shfl_xor(l, 32);
        const float f = (m == 1 ? lmb : 1.0f) / l;
        LAS float* ex = EX + (size_t)m * 128 * 129 + (qs * 32 + r) * 129;
#pragma unroll
        for (int i = 0; i < 4; ++i)
#pragma unroll
            for (int q = 0; q < 16; ++q) ex[32 * i + crow(q, hi)] = o[i][q] * f;
        __syncthreads();
#pragma unroll 1
        for (int rr = 0; rr < 16; ++rr) { const int row = 16 * F.wave + rr;
            const float a0 = EX[row * 129 + F.lane] - EX[128 * 129 + row * 129 + F.lane], a1 = EX[row * 129 + 64 + F.lane] - EX[128 * 129 + row * 129 + 64 + F.lane];
            const float rstd = (1.0f - LAMBDA_INIT) / sqrtf(wave_sum(a0 * a0 + a1 * a1) * (1.f / 128.f) + EPS);
            bf16* yr = Y + (size_t)(qrow0 + row) * D + h * 128;
            yr[F.lane] = (bf16)(pk2(a0 * rstd * ng[F.lane], 0.f) & 0xffffu); yr[64 + F.lane] = (bf16)(pk2(a1 * rstd * ng[64 + F.lane], 0.f) & 0xffffu); }
        __syncthreads();
    }
}

constexpr int PD_BYTES = 12800, PD_ATT = 6144, PD_EG = 12288, PD_EW = 12544;
__device__ __forceinline__ unsigned off_a(unsigned row, unsigned ch) { return 2048u * (row >> 3) + 512u * (ch >> 2) + 64u * (row & 7) + 16u * ((ch & 3) ^ ((row >> 2) & 3)); }
__device__ __forceinline__ int frag_off(int c, int s) {
    const int slot = (c >> 5) == (s >> 5) ? ((c >> 5) ? 2 : 0) : 1, s2 = (s & 31) >> 4, hh = ((s & 15) >> 2) & 1, jj = ((s & 15) >> 3) * 4 + (s & 3), r = c & 31;
    return slot * 2048 + s2 * 1024 + (hh * 32 + r) * 16 + jj * 2;
}
__device__ __forceinline__ void step_gdn_prep(int j) {
    const Frame F = make_frame();
    LAS float* STG = (LAS float*)F.lds;
    LAS float* KK = (LAS float*)F.lds;
    LAS float* QK = KK + 64 * 65;
    LAS float* LP = (LAS float*)(F.lds + 33280);
    LAS unsigned char* OUT = F.lds + 66048;
    LAS unsigned char* QI = F.lds + 99328; LAS unsigned char* KI = F.lds + 115712;
    LAS float* SM = (LAS float*)(F.lds + 132096);
    bf16* Z = (bf16*)(F.ws + WS_Z); const float* AB = (const float*)(F.ws + WS_AB); const bf16* HALO = (const bf16*)(F.ws + WS_HALO); unsigned char* PD = F.ws + WS_PD;
    const float* cw = INP(I_GCONV) + (size_t)j * 3 * 3072;
    const int r = F.lane & 31, hi = F.lane >> 5;
    for (int it = F.bid; it < NB * NH * 132; it += F.G) {
        const int n = it % 132, bh = it / 132, b = bh >> 3, h = bh & 7;
        const bool isctx = n < 4; const int L = isctx ? CT : T; const int t0 = isctx ? 64 * n : 64 * (n - 4); const int row0 = (isctx ? ML + b * CT : b * T) + t0;
        for (int idx = F.tid; idx < 3072; idx += NTHR) {
            const int c = idx / 48, g8 = idx % 48, part = g8 >> 4, e0 = (g8 & 15) * 8; const int col = part * 1024 + h * 128 + e0; const int t = t0 + c;
            const u32x4 zero = (u32x4){0u, 0u, 0u, 0u};
            const u32x4 z0 = *(const u32x4*)(Z + (size_t)(row0 + c) * 4096 + col);
            u32x4 zm = zero, zp = zero;
            if (t > 0) zm = c == 0 ? *(const u32x4*)(HALO + ((size_t)((row0 >> 6) - 1) * 2 + 1) * 3072 + col) : *(const u32x4*)(Z + (size_t)(row0 + c - 1) * 4096 + col);
            if (t < L - 1) zp = c == 63 ? *(const u32x4*)(HALO + ((size_t)((row0 >> 6) + 1) * 2) * 3072 + col) : *(const u32x4*)(Z + (size_t)(row0 + c + 1) * 4096 + col);
            const float* wp = cw + col;
            float o[8];
#pragma unroll
            for (int q = 0; q < 2; ++q) { const f32x4 w0 = *(const f32x4*)(wp + 4 * q), w1 = *(const f32x4*)(wp + 3072 + 4 * q), w2 = *(const f32x4*)(wp + 6144 + 4 * q);
#pragma unroll
                for (int i = 0; i < 2; ++i) { const unsigned a = zm[2 * q + i], bq = z0[2 * q + i], cq = zp[2 * q + i];
                    o[4 * q + 2 * i] = silu_f(w0[2 * i] * bf2f(a & 0xffffu) + w1[2 * i] * bf2f(bq & 0xffffu) + w2[2 * i] * bf2f(cq & 0xffffu));
                    o[4 * q + 2 * i + 1] = silu_f(w0[2 * i + 1] * bf2f(a >> 16) + w1[2 * i + 1] * bf2f(bq >> 16) + w2[2 * i + 1] * bf2f(cq >> 16)); } }
            LAS f32x4* dst = (LAS f32x4*)(STG + c * 388 + part * 128 + e0); dst[0] = (f32x4){o[0], o[1], o[2], o[3]}; dst[1] = (f32x4){o[4], o[5], o[6], o[7]};
        }
        if (F.wave < 2) {
            const int d = F.wave, c = F.lane; const size_t row = (size_t)(row0 + c);
            const float Aco = expf(INP(I_GALOG)[j * 16 + d * 8 + h]), dtb = INP(I_GDT)[j * 16 + d * 8 + h];
            const float x = AB[row * 32 + d * 8 + h] + dtb, bb = AB[row * 32 + 16 + d * 8 + h];
            const float sp = x > 20.f ? x : log1pf(expf(x));
            float s = -Aco * sp;
#pragma unroll
            for (int o = 1; o < 64; o <<= 1) { const float up = __shfl_up(s, o), dn = __shfl_down(s, o); if (d ? (c + o < 64) : (c >= o)) s += d ? dn : up; }
            SM[d * 64 + c] = 1.f / (1.f + expf(-bb)); SM[128 + d * 64 + c] = s;
        }
        __syncthreads();
#pragma unroll 1
        for (int rr = 0; rr < 8; ++rr) { const int c = F.wave * 8 + rr; const LAS float* sr = STG + c * 388;
            const float q0 = sr[F.lane], q1 = sr[64 + F.lane]; const float sq = 0.08838834764831845f / sqrtf(wave_sum(q0 * q0 + q1 * q1) + EPS);
            const float k0 = sr[128 + F.lane], k1 = sr[192 + F.lane]; const float sk = 1.0f / sqrtf(wave_sum(k0 * k0 + k1 * k1) + EPS);
            const unsigned o0 = off_a(c, F.lane >> 3) + 2 * (F.lane & 7), o1 = off_a(c, 8 + (F.lane >> 3)) + 2 * (F.lane & 7);
            *(LAS bf16*)(QI + o0) = (bf16)(pk2(q0 * sq, 0.f) & 0xffffu); *(LAS bf16*)(QI + o1) = (bf16)(pk2(q1 * sq, 0.f) & 0xffffu);
            *(LAS bf16*)(KI + o0) = (bf16)(pk2(k0 * sk, 0.f) & 0xffffu); *(LAS bf16*)(KI + o1) = (bf16)(pk2(k1 * sk, 0.f) & 0xffffu);
            bf16* vd = Z + (size_t)(row0 + c) * 4096 + 2048 + h * 128;
            vd[F.lane] = (bf16)(pk2(sr[256 + F.lane], 0.f) & 0xffffu); vd[64 + F.lane] = (bf16)(pk2(sr[320 + F.lane], 0.f) & 0xffffu); }
        __syncthreads();
        { const int prod = F.wave >> 2, mt = (F.wave >> 1) & 1, nt = F.wave & 1; LAS unsigned char* AI = prod ? QI : KI;
            f32x16 acc;
#pragma unroll
            for (int i = 0; i < 16; ++i) acc[i] = 0.f;
#pragma unroll
            for (int ks = 0; ks < 8; ++ks) { const bf16x8 a = *(const LAS bf16x8*)(AI + off_a(32 * mt + r, 2 * ks + hi)), bq = *(const LAS bf16x8*)(KI + off_a(32 * nt + r, 2 * ks + hi));
                acc = __builtin_amdgcn_mfma_f32_32x32x16_bf16(a, bq, acc, 0, 0, 0); }
            LAS float* dst = prod ? QK : KK;
#pragma unroll
            for (int i = 0; i < 16; ++i) dst[(32 * mt + crow(i, hi)) * 65 + 32 * nt + r] = acc[i]; }
        __syncthreads();
        for (int idx = F.tid; idx < 8192; idx += NTHR) { const int d = idx >> 12, p = (idx >> 6) & 63, ps = idx & 63; float val = 0.f;
            if (ps < p) { const int c = d ? 63 - p : p, s = d ? 63 - ps : ps; val = SM[d * 64 + c] * KK[c * 65 + s] * expf(SM[128 + d * 64 + c] - SM[128 + d * 64 + s]); }
            LP[idx] = val; }
        for (int idx = F.tid; idx < 8192; idx += NTHR) { const int d = idx >> 12, c = (idx >> 6) & 63, s = idx & 63;
            const bool zero_blk = d ? (c >= 32 && s < 32) : (c < 32 && s >= 32);
            if (!zero_blk) { const bool m = d ? (s >= c) : (s <= c); const float val = m ? QK[c * 65 + s] * expf(SM[128 + d * 64 + c] - SM[128 + d * 64 + s]) : 0.f;
                *(LAS bf16*)(OUT + d * PD_BYTES + PD_ATT + frag_off(c, s)) = (bf16)(pk2(val, 0.f) & 0xffffu); } }
        if (F.tid < 128) { const int d = F.tid >> 6, c = F.tid & 63; const float gl = SM[128 + d * 64 + (d ? 0 : 63)], gcv = SM[128 + d * 64 + c];
            *(LAS float*)(OUT + d * PD_BYTES + PD_EG + 4 * c) = expf(gcv); *(LAS float*)(OUT + d * PD_BYTES + PD_EW + 4 * c) = expf(gl - gcv); }
        __syncthreads();
#ifndef NO_INV
        if (F.wave < 2) {
            const int d = F.wave, jc = F.lane; const LAS f32x4* L4 = (const LAS f32x4*)(LP + d * 4096);
            float Tc[64];
#pragma unroll
            for (int p = 0; p < 64; ++p) { float acc = (p == jc) ? 1.f : 0.f;
#pragma unroll
                for (int q4 = 0; q4 < (p + 3) / 4; ++q4) { const f32x4 l = L4[p * 16 + q4];
                    if (4 * q4 < p) acc -= l.x * Tc[4 * q4]; if (4 * q4 + 1 < p) acc -= l.y * Tc[4 * q4 + 1]; if (4 * q4 + 2 < p) acc -= l.z * Tc[4 * q4 + 2]; if (4 * q4 + 3 < p) acc -= l.w * Tc[4 * q4 + 3]; }
                Tc[p] = acc; asm volatile("" ::: "memory"); }
            const int s = d ? 63 - jc : jc; const float bj = SM[d * 64 + s];
#pragma unroll
            for (int p = 0; p < 64; ++p) { const int c = d ? 63 - p : p; const bool zero_blk = d ? (c >= 32 && s < 32) : (c < 32 && s >= 32);
                *(LAS bf16*)(OUT + (zero_blk ? 2 * PD_BYTES : d * PD_BYTES + frag_off(c, s))) = (bf16)(pk2(Tc[p] * bj, 0.f) & 0xffffu); }
        }
#endif
        __syncthreads();
        for (int idx = F.tid; idx < 1600; idx += NTHR) { const int d = idx / 800, pc = idx % 800;
            *(u32x4*)(PD + ((size_t)(((d * 2 + b) * 8 + h) * 132 + n)) * PD_BYTES + pc * 16) = *(const LAS u32x4*)(OUT + d * PD_BYTES + pc * 16); }
        for (int idx = F.tid; idx < 2048; idx += NTHR) { const int img = idx >> 10, pn = idx & 1023;
            *(u32x4*)((unsigned char*)(Z + (size_t)(row0 + (pn >> 4)) * 4096 + img * 1024 + h * 128) + (pn & 15) * 16) = *(const LAS u32x4*)((img ? KI : QI) + pn * 16); }
        __syncthreads();
    }
}

#define PACK8(x, b) __builtin_bit_cast(bf16x8, (u32x4){pk2((x)[(b)], (x)[(b) + 1]), pk2((x)[(b) + 2], (x)[(b) + 3]), pk2((x)[(b) + 4], (x)[(b) + 5]), pk2((x)[(b) + 6], (x)[(b) + 7])})
#define MFMA32(a, b, c) __builtin_amdgcn_mfma_f32_32x32x16_bf16((a), (b), (c), 0, 0, 0)
typedef short v4i16_t __attribute__((ext_vector_type(4)));
__device__ __forceinline__ void step_gdn_scan2() {
    const Frame F = make_frame();
    constexpr int BUF = 61952, B_K = 0, B_Q = 16384, B_V = 32768, B_PD = 49152;
    const bf16* Z = (const bf16*)(F.ws + WS_Z); const unsigned char* PD = F.ws + WS_PD;
    const int r = F.lane & 31, hi = F.lane >> 5;
    for (int it = F.bid; it < 32; it += F.G) {
        const int b = it >> 4, h = (it >> 1) & 7, dir = it & 1;
        const unsigned char* pdb = PD + (size_t)(((dir * 2 + b) * 8 + h) * 132) * PD_BYTES;
#define CHUNK_OF(sp) (dir ? ((sp) < 4 ? 3 - (sp) : 135 - (sp)) : (sp))
#define ROW0_OF(n) ((n) < 4 ? ML + b * CT + 64 * (n) : b * T + 64 * ((n) - 4))
        if (F.wave >= 4) {
            const int lt = F.tid - 256;
            u32x4 rg[16];
#define LOAD_CHUNK(sp) do { const int n_ = CHUNK_OF(sp); const int row0_ = ROW0_OF(n_); \
                _Pragma("unroll") for (int i = 0; i < 4; ++i) { const int pn = lt + 256 * i; const unsigned char* src = (const unsigned char*)(Z + (size_t)(row0_ + (pn >> 4)) * 4096 + h * 128) + (pn & 15) * 16; \
                    rg[i] = *(const u32x4*)(src + 2048); rg[4 + i] = *(const u32x4*)src; rg[8 + i] = *(const u32x4*)(src + 4096); \
                    rg[12 + i] = pn < 800 ? *(const u32x4*)(pdb + (size_t)n_ * PD_BYTES + pn * 16) : (u32x4){0u, 0u, 0u, 0u}; } } while (0)
#define WRITE_CHUNK(bufb) do { LAS unsigned char* base_ = F.lds + (bufb); \
                _Pragma("unroll") for (int i = 0; i < 4; ++i) { const int pn = lt + 256 * i; *(LAS u32x4*)(base_ + B_K + pn * 16) = rg[i]; *(LAS u32x4*)(base_ + B_Q + pn * 16) = rg[4 + i]; \
                    *(LAS u32x4*)(base_ + B_V + pn * 16) = rg[8 + i]; if (pn < 800) *(LAS u32x4*)(base_ + B_PD + pn * 16) = rg[12 + i]; } } while (0)
            LOAD_CHUNK(0); WRITE_CHUNK(0); LOAD_CHUNK(1);
            __syncthreads();
            for (int sp = 0; sp < 132; ++sp) {
                if (sp + 1 < 132) WRITE_CHUNK(((sp + 1) & 1) * BUF);
                if (sp + 2 < 132) LOAD_CHUNK(sp + 2);
                __syncthreads();
            }
#undef LOAD_CHUNK
#undef WRITE_CHUNK
        } else {
            const int w = F.wave;
            f32x16 S[4];
#pragma unroll
            for (int kt = 0; kt < 4; ++kt)
#pragma unroll
                for (int i = 0; i < 16; ++i) S[kt][i] = 0.f;
            const int x = (r >> 2) & 3; const int rowb = 2048 * (r >> 3) + 64 * (r & 7);
            int oa[2], ob[2];
#pragma unroll
            for (int s2 = 0; s2 < 2; ++s2) { oa[s2] = rowb + 16 * ((2 * s2) ^ x) + 8 * hi; ob[s2] = rowb + 16 * ((2 * s2 + 1) ^ x) + 8 * hi; }
            const int blk = (F.lane >> 4) & 1, q = (F.lane & 15) >> 2, p = F.lane & 3, cb = 2 * blk + (p >> 1);
            int trb[2];
#pragma unroll
            for (int t = 0; t < 2; ++t) trb[t] = 64 * (4 * hi + q) + 8 * (p & 1) + 16 * (cb ^ ((2 * t + hi) & 3)) + 2048 * t;
            const int vb = 4 * hi * 256 + (32 * w + r) * 2;
            __syncthreads();
            for (int sp = 0; sp < 132; ++sp) {
                const int n = CHUNK_OF(sp); const int row0 = ROW0_OF(n);
                LAS unsigned char* B = F.lds + (sp & 1) * BUF;
                LAS unsigned char* KI = B + B_K; LAS unsigned char* QI = B + B_Q; LAS unsigned char* VI = B + B_V; LAS unsigned char* PR = B + B_PD;
                bf16x8 Sb[4][2];
#pragma unroll
                for (int kt = 0; kt < 4; ++kt) { Sb[kt][0] = PACK8(S[kt], 0); Sb[kt][1] = PACK8(S[kt], 8); }
                f32x16 KS[2];
#pragma unroll
                for (int mt = 0; mt < 2; ++mt) {
#pragma unroll
                    for (int i = 0; i < 16; ++i) KS[mt][i] = 0.f;
#pragma unroll
                    for (int kt = 0; kt < 4; ++kt)
#pragma unroll
                        for (int s2 = 0; s2 < 2; ++s2) {
                            const s16x4 k0 = *(const LAS s16x4*)(KI + 8192 * mt + 512 * kt + oa[s2]), k1 = *(const LAS s16x4*)(KI + 8192 * mt + 512 * kt + ob[s2]);
                            KS[mt] = MFMA32(((bf16x8){k0[0], k0[1], k0[2], k0[3], k1[0], k1[1], k1[2], k1[3]}), Sb[kt][s2], KS[mt]); }
                    asm volatile("" ::: "memory");
                }
                bf16x8 Rb[2][2];
#pragma unroll
                for (int mt = 0; mt < 2; ++mt) { f32x16 R;
#pragma unroll
                    for (int g = 0; g < 4; ++g) { const f32x4 e4 = *(const LAS f32x4*)(PR + PD_EG + 4 * (32 * mt + 8 * g + 4 * hi));
#pragma unroll
                        for (int i = 0; i < 4; ++i) { const float v = bf2f(*(const LAS bf16*)(VI + vb + (32 * mt + 8 * g + i) * 256)); R[4 * g + i] = v - e4[i] * KS[mt][4 * g + i]; } }
                    Rb[mt][0] = PACK8(R, 0); Rb[mt][1] = PACK8(R, 8); }
                f32x16 vn[2], o[2];
#pragma unroll
                for (int i = 0; i < 16; ++i) { vn[0][i] = 0.f; vn[1][i] = 0.f; }
#define TFR(base, slot, s2) (*(const LAS bf16x8*)(PR + (base) + (slot) * 2048 + (s2) * 1024 + F.lane * 16))
                vn[0] = MFMA32(TFR(0, 0, 0), Rb[0][0], vn[0]); vn[0] = MFMA32(TFR(0, 0, 1), Rb[0][1], vn[0]);
                vn[1] = MFMA32(TFR(0, 2, 0), Rb[1][0], vn[1]); vn[1] = MFMA32(TFR(0, 2, 1), Rb[1][1], vn[1]);
                if (dir) { vn[0] = MFMA32(TFR(0, 1, 0), Rb[1][0], vn[0]); vn[0] = MFMA32(TFR(0, 1, 1), Rb[1][1], vn[0]); }
                else     { vn[1] = MFMA32(TFR(0, 1, 0), Rb[0][0], vn[1]); vn[1] = MFMA32(TFR(0, 1, 1), Rb[0][1], vn[1]); }
                asm volatile("" ::: "memory");
                f32x16 QS[2];
#pragma unroll
                for (int mt = 0; mt < 2; ++mt) {
#pragma unroll
                    for (int i = 0; i < 16; ++i) QS[mt][i] = 0.f;
#pragma unroll
                    for (int kt = 0; kt < 4; ++kt)
#pragma unroll
                        for (int s2 = 0; s2 < 2; ++s2) {
                            const s16x4 q0 = *(const LAS s16x4*)(QI + 8192 * mt + 512 * kt + oa[s2]), q1 = *(const LAS s16x4*)(QI + 8192 * mt + 512 * kt + ob[s2]);
                            QS[mt] = MFMA32(((bf16x8){q0[0], q0[1], q0[2], q0[3], q1[0], q1[1], q1[2], q1[3]}), Sb[kt][s2], QS[mt]); }
                    asm volatile("" ::: "memory");
                }
                bf16x8 Vb[2][2], Wb[2][2];
#pragma unroll
                for (int mt = 0; mt < 2; ++mt) { f32x16 W;
#pragma unroll
                    for (int g = 0; g < 4; ++g) { const f32x4 e4 = *(const LAS f32x4*)(PR + PD_EG + 4 * (32 * mt + 8 * g + 4 * hi)), w4 = *(const LAS f32x4*)(PR + PD_EW + 4 * (32 * mt + 8 * g + 4 * hi));
#pragma unroll
                        for (int i = 0; i < 4; ++i) { o[mt][4 * g + i] = e4[i] * QS[mt][4 * g + i]; W[4 * g + i] = w4[i] * vn[mt][4 * g + i]; } }
                    Vb[mt][0] = PACK8(vn[mt], 0); Vb[mt][1] = PACK8(vn[mt], 8); Wb[mt][0] = PACK8(W, 0); Wb[mt][1] = PACK8(W, 8); }
                o[0] = MFMA32(TFR(PD_ATT, 0, 0), Vb[0][0], o[0]); o[0] = MFMA32(TFR(PD_ATT, 0, 1), Vb[0][1], o[0]);
                o[1] = MFMA32(TFR(PD_ATT, 2, 0), Vb[1][0], o[1]); o[1] = MFMA32(TFR(PD_ATT, 2, 1), Vb[1][1], o[1]);
                if (dir) { o[0] = MFMA32(TFR(PD_ATT, 1, 0), Vb[1][0], o[0]); o[0] = MFMA32(TFR(PD_ATT, 1, 1), Vb[1][1], o[0]); }
                else     { o[1] = MFMA32(TFR(PD_ATT, 1, 0), Vb[0][0], o[1]); o[1] = MFMA32(TFR(PD_ATT, 1, 1), Vb[0][1], o[1]); }
#undef TFR
                asm volatile("" ::: "memory");
                const float cd = *(const LAS float*)(PR + PD_EG + 4 * (dir ? 0 : 63));
#pragma unroll
                for (int kt = 0; kt < 4; ++kt) {
#pragma unroll
                    for (int i = 0; i < 16; ++i) S[kt][i] *= cd;
#pragma unroll
                    for (int mt = 0; mt < 2; ++mt)
#pragma unroll
                        for (int s2 = 0; s2 < 2; ++s2) {
                            const s16x4 a0 = __builtin_bit_cast(s16x4, __builtin_amdgcn_ds_read_tr16_b64_v4i16((LAS v4i16_t*)(KI + 8192 * mt + 4096 * s2 + 512 * kt + trb[0])));
                            const s16x4 a1 = __builtin_bit_cast(s16x4, __builtin_amdgcn_ds_read_tr16_b64_v4i16((LAS v4i16_t*)(KI + 8192 * mt + 4096 * s2 + 512 * kt + trb[1])));
                            S[kt] = MFMA32(((bf16x8){a0[0], a0[1], a0[2], a0[3], a1[0], a1[1], a1[2], a1[3]}), Wb[mt][s2], S[kt]); }
                    asm volatile("" ::: "memory");
                }
                { bf16* ob_ = n < 4 ? (bf16*)(F.ws + WS_OFC) + ((size_t)dir * MC + (row0 - ML)) * D : (bf16*)F.out + ((size_t)dir * ML + row0) * D;
                    bf16* oc = ob_ + h * 128 + 32 * w + r;
#pragma unroll
                    for (int mt = 0; mt < 2; ++mt)
#pragma unroll
                        for (int i = 0; i < 16; ++i) oc[(size_t)(32 * mt + crow(i, hi)) * D] = (bf16)(pk2(o[mt][i], 0.f) & 0xffffu); }
                __syncthreads();
            }
        }
#undef CHUNK_OF
#undef ROW0_OF
    }
}
__device__ __forceinline__ void step_gdn_norm2(int j) {
    const Frame F = make_frame();
    const int gw = F.bid * NWAVES + F.wave, NGW = F.G * NWAVES;
    const bf16* Z = (const bf16*)(F.ws + WS_Z); bf16* Y = (bf16*)(F.ws + WS_Y); const float* ng = INP(I_GNG) + j * 128;
    for (int row = gw; row < M; row += NGW) {
        const bf16* of = row < ML ? (const bf16*)F.out + (size_t)row * D : (const bf16*)(F.ws + WS_OFC) + (size_t)(row - ML) * D;
        const bf16* ob = row < ML ? of + (size_t)ML * D : of + (size_t)MC * D;
        const u32x4* f4 = (const u32x4*)(of + 16 * F.lane); const u32x4* b4 = (const u32x4*)(ob + 16 * F.lane);
        float v[16]; float ss = 0.f;
#pragma unroll
        for (int q = 0; q < 2; ++q) { const u32x4 a = f4[q], bq = b4[q];
#pragma unroll
            for (int i = 0; i < 4; ++i) { const float x0 = bf2f(a[i] & 0xffffu) + bf2f(bq[i] & 0xffffu), x1 = bf2f(a[i] >> 16) + bf2f(bq[i] >> 16); v[8 * q + 2 * i] = x0; v[8 * q + 2 * i + 1] = x1; ss += x0 * x0 + x1 * x1; } }
        ss += __shfl_xor(ss, 1); ss += __shfl_xor(ss, 2); ss += __shfl_xor(ss, 4);
        const float rstd = 1.0f / sqrtf(ss * (1.f / 128.f) + EPS);
        const u32x4* g4 = (const u32x4*)(Z + (size_t)row * 4096 + 3072 + 16 * F.lane);
        const int e0 = (16 * F.lane) & 127;
        u32x4 o[2];
#pragma unroll
        for (int q = 0; q < 2; ++q) { const u32x4 gz = g4[q]; unsigned wv[4];
#pragma unroll
            for (int i = 0; i < 4; ++i) { const unsigned gg = gz[i]; const float g0 = bf2f(gg & 0xffffu), g1 = bf2f(gg >> 16); const int e = e0 + 8 * q + 2 * i;
                wv[i] = pk2(v[8 * q + 2 * i] * rstd * ng[e] * silu_f(g0), v[8 * q + 2 * i + 1] * rstd * ng[e + 1] * silu_f(g1)); }
            o[q] = (u32x4){wv[0], wv[1], wv[2], wv[3]}; }
        u32x4* dst = (u32x4*)(Y + (size_t)row * D + 16 * F.lane); dst[0] = o[0]; dst[1] = o[1];
    }
}

__device__ __forceinline__ void step_rope2() {
    const Frame F = make_frame();
    const int gw = F.bid * NWAVES + F.wave, NGW = F.G * NWAVES;
    bf16* Z = (bf16*)(F.ws + WS_Z); const f32x4* R = (const f32x4*)(F.ws + WS_ROPE);
    for (int row = gw; row < M; row += NGW) {
        u32x4* p = (u32x4*)(Z + (size_t)row * 3072 + 32 * F.lane);
        u32x4 v[4];
#pragma unroll
        for (int q = 0; q < 4; ++q) v[q] = p[q];
        const bool lat = row < ML; const float sc = F.lane < 32 ? QSCALE : 1.0f;
        const f32x4* tab = R + ((size_t)(row & (T - 1)) * 32 + 16 * (F.lane & 1)) / 2;
#pragma unroll
        for (int q = 0; q < 4; ++q) {
#pragma unroll
            for (int i = 0; i < 4; i += 2) {
                f32x4 cs = (f32x4){1.f, 0.f, 1.f, 0.f}; if (lat) cs = tab[(4 * q + i) / 2];
                { const unsigned w = v[q][i]; const float x0 = bf2f(w & 0xffffu), x1 = bf2f(w >> 16); v[q][i] = pk2((x0 * cs.x - x1 * cs.y) * sc, (x0 * cs.y + x1 * cs.x) * sc); }
                { const unsigned w = v[q][i + 1]; const float x0 = bf2f(w & 0xffffu), x1 = bf2f(w >> 16); v[q][i + 1] = pk2((x0 * cs.z - x1 * cs.w) * sc, (x0 * cs.w + x1 * cs.z) * sc); }
            }
        }
#pragma unroll
        for (int q = 0; q < 4; ++q) p[q] = v[q];
    }
}
__device__ __forceinline__ void step_attn2() {
    const Frame F = make_frame();
    const bf16* Z = (const bf16*)(F.ws + WS_Z); bf16* Y = (bf16*)(F.ws + WS_Y);
    LAS float* EX = (LAS float*)F.lds;
    const int r = F.lane & 31, hi = F.lane >> 5, qs = F.wave & 3, m = F.wave >> 2;
    float lmb;
    { const float* lam = INP(I_DLAM); const float t1 = lam[F.lane] * lam[64 + F.lane], t2 = lam[128 + F.lane] * lam[192 + F.lane]; lmb = expf(wave_sum(t1)) - expf(wave_sum(t2)) + LAMBDA_INIT; }
    const float* ng = INP(I_DNG);
    const int kro = 2048 * (r >> 3) + 64 * (r & 7); const int xk = (r >> 2) & 3;
    int koff[4];
#pragma unroll
    for (int d0 = 0; d0 < 4; ++d0) koff[d0] = kro + 512 * (2 * m + (d0 >> 1)) + 16 * (((2 * d0 + hi) & 3) ^ xk);
    const int blk = (F.lane >> 4) & 1, q4 = (F.lane & 15) >> 2, p4 = F.lane & 3, cb = 2 * blk + (p4 >> 1);
    int trb[2];
#pragma unroll
    for (int t = 0; t < 2; ++t) trb[t] = 64 * (4 * hi + q4) + 8 * (p4 & 1) + 16 * (cb ^ ((2 * t + hi) & 3)) + 2048 * t;
    int srow[4], sdst[4], scol[4];
#pragma unroll
    for (int i = 0; i < 4; ++i) { const int p = F.tid + 512 * i, img = p >> 10, pn = p & 1023; srow[i] = pn >> 4; scol[i] = 1024 + img * 1024 + (pn & 15) * 8; sdst[i] = img * 16384 + (int)off_a(pn >> 4, pn & 15); }
    const int xcd = F.bid & 7, cux = F.bid >> 3;
    for (int ui = 0; ui < 5; ++ui) {
        int b, h, qrow0, nt;
        if (F.G == 256) {
            h = xcd;
            if (ui < 4) { b = ui >> 1; qrow0 = b * T + (cux + 32 * (ui & 1)) * 128; nt = NKV / 64; }
            else { if (cux >= 4) break; b = cux >> 1; qrow0 = ML + b * CT + (cux & 1) * 128; nt = CT / 64; }
        } else {
            const int u = F.bid + ui * F.G; if (ui >= 5 || u >= 1056) break;
            if (u < 1024) { b = u >> 9; h = (u >> 6) & 7; qrow0 = b * T + (u & 63) * 128; nt = NKV / 64; }
            else { const int v = u - 1024; b = v >> 4; h = (v >> 1) & 7; qrow0 = ML + b * CT + (v & 1) * 128; nt = CT / 64; }
        }
        const int row0 = qrow0 + 32 * qs;
        bf16x8 qf[4];
#pragma unroll
        for (int d0 = 0; d0 < 4; ++d0) qf[d0] = *(const bf16x8*)(Z + (size_t)(row0 + r) * 3072 + h * 128 + m * 64 + d0 * 16 + hi * 8);
        const bf16* kvb = Z + h * 128;
#define KVROW(t) ((t) < CT / 64 ? ML + b * CT + 64 * (t) : b * T + 64 * (t) - CT)
        u32x4 rg[4];
#define LOAD_TILE(t) do { const int kr_ = KVROW(t); _Pragma("unroll") for (int i = 0; i < 4; ++i) rg[i] = *(const u32x4*)(kvb + (size_t)(kr_ + srow[i]) * 3072 + scol[i]); } while (0)
#define WRITE_TILE(bufb) do { _Pragma("unroll") for (int i = 0; i < 4; ++i) *(LAS u32x4*)(F.lds + (bufb) + sdst[i]) = rg[i]; } while (0)
        LOAD_TILE(0); WRITE_TILE(0); if (nt > 1) LOAD_TILE(1);
        f32x16 o[4];
#pragma unroll
        for (int i = 0; i < 4; ++i)
#pragma unroll
            for (int q = 0; q < 16; ++q) o[i][q] = 0.f;
        float mref = 0.f, l = 0.f;
        __syncthreads();
        for (int t = 0; t < nt; ++t) {
            if (t + 1 < nt) WRITE_TILE(((t + 1) & 1) * 32768);
            if (t + 2 < nt) LOAD_TILE(t + 2);
            LAS unsigned char* KI = F.lds + (t & 1) * 32768; LAS unsigned char* VI = KI + 16384;
            f32x16 p0, p1;
#pragma unroll
            for (int q = 0; q < 16; ++q) { p0[q] = 0.f; p1[q] = 0.f; }
#pragma unroll
            for (int d0 = 0; d0 < 4; ++d0) { const bf16x8 k0 = *(const LAS bf16x8*)(KI + koff[d0]), k1 = *(const LAS bf16x8*)(KI + 8192 + koff[d0]);
                p0 = MFMA32(k0, qf[d0], p0); p1 = MFMA32(k1, qf[d0], p1); }
            float mx = fmaxf(p0[0], p1[0]);
#pragma unroll
            for (int q = 1; q < 16; ++q) mx = fmaxf(mx, fmaxf(p0[q], p1[q]));
            mx = fmaxf(mx, __shfl_xor(mx, 32));
            if (t == 0) mref = mx;
            else if (__any(mx > mref)) { const float mn = fmaxf(mref, mx); const float al = __builtin_amdgcn_exp2f(mref - mn); l *= al; mref = mn;
#pragma unroll
                for (int i = 0; i < 4; ++i)
#pragma unroll
                    for (int q = 0; q < 16; ++q) o[i][q] *= al; }
            float ps = 0.f;
#pragma unroll
            for (int q = 0; q < 16; ++q) { p0[q] = __builtin_amdgcn_exp2f(p0[q] - mref); p1[q] = __builtin_amdgcn_exp2f(p1[q] - mref); ps += p0[q] + p1[q]; }
            l += ps;
            bf16x8 pf[2][2];
            pf[0][0] = PACK8(p0, 0); pf[0][1] = PACK8(p0, 8); pf[1][0] = PACK8(p1, 0); pf[1][1] = PACK8(p1, 8);
#pragma unroll
            for (int i = 0; i < 4; ++i) {
#pragma unroll
                for (int kh = 0; kh < 2; ++kh)
#pragma unroll
                    for (int s2 = 0; s2 < 2; ++s2) {
                        const s16x4 a0 = __builtin_bit_cast(s16x4, __builtin_amdgcn_ds_read_tr16_b64_v4i16((LAS v4i16_t*)(VI + 8192 * kh + 4096 * s2 + 512 * i + trb[0])));
                        const s16x4 a1 = __builtin_bit_cast(s16x4, __builtin_amdgcn_ds_read_tr16_b64_v4i16((LAS v4i16_t*)(VI + 8192 * kh + 4096 * s2 + 512 * i + trb[1])));
                        o[i] = MFMA32(((bf16x8){a0[0], a0[1], a0[2], a0[3], a1[0], a1[1], a1[2], a1[3]}), pf[kh][s2], o[i]); }
            }
            __syncthreads();
        }
#undef LOAD_TILE
#undef WRITE_TILE
#undef KVROW
        l += __shfl_xor(l, 32);
        const float f = (m == 1 ? lmb : 1.0f) / l;
        LAS float* ex = EX + (size_t)m * 128 * 129 + (qs * 32 + r) * 129;
#pragma unroll
        for (int i = 0; i < 4; ++i)
#pragma unroll
            for (int q = 0; q < 16; ++q) ex[32 * i + crow(q, hi)] = o[i][q] * f;
        __syncthreads();
#pragma unroll 1
        for (int rr = 0; rr < 16; ++rr) { const int row = 16 * F.wave + rr;
            const float a0 = EX[row * 129 + F.lane] - EX[128 * 129 + row * 129 + F.lane], a1 = EX[row * 129 + 64 + F.lane] - EX[128 * 129 + row * 129 + 64 + F.lane];
            const float rstd = (1.0f - LAMBDA_INIT) / sqrtf(wave_sum(a0 * a0 + a1 * a1) * (1.f / 128.f) + EPS);
            bf16* yr = Y + (size_t)(qrow0 + row) * D + h * 128;
            yr[F.lane] = (bf16)(pk2(a0 * rstd * ng[F.lane], 0.f) & 0xffffu); yr[64 + F.lane] = (bf16)(pk2(a1 * rstd * ng[64 + F.lane], 0.f) & 0xffffu); }
        __syncthreads();
    }
}

#define XB_TMO      128
#define XB_XCNT(j)  (256  + 64 * (j))
#define XB_XSUB(j)  (1280 + 64 * (j))
#define XB_XGEN(j)  (2304 + 64 * (j))
#define XB_TOP      3328
#define XB_TOPGEN   3392
#define XCD_BAR_WORDS 3456
#define XB_SPIN_CAP (1u << 18)

__device__ __forceinline__ unsigned xb_ld(unsigned* p)              { return __hip_atomic_load(p, __ATOMIC_RELAXED, __HIP_MEMORY_SCOPE_AGENT); }
__device__ __forceinline__ unsigned xb_add(unsigned* p, unsigned v) { return __hip_atomic_fetch_add(p, v, __ATOMIC_RELAXED, __HIP_MEMORY_SCOPE_AGENT); }
__device__ __forceinline__ unsigned xb_xcc_id() { return (unsigned)__builtin_amdgcn_s_getreg((3 << 11) | 20) & 0xFu; }
#define XB_SPIN(cond, bar) do { unsigned _sp = 0; while (cond) { __builtin_amdgcn_s_sleep(1); \
    if ((++_sp & 255u) == 0u) { if (xb_ld(&(bar)[XB_TMO])) break; if (_sp > XB_SPIN_CAP) { atomicAdd(&(bar)[XB_TMO], 1u); break; } } } } while (0)

struct XcdBarrier {
    unsigned* bar; unsigned x;
    volatile LAS unsigned* st;
};

__device__ __forceinline__ XcdBarrier xcd_barrier_post(unsigned* bar, volatile LAS unsigned* st) {
    XcdBarrier b; b.bar = bar; b.x = xb_xcc_id(); b.st = st;
    if (threadIdx.x == 0) (void)xb_add(&bar[XB_XCNT(b.x)], 1u);
    return b;
}
__device__ __forceinline__ void xcd_barrier_complete(unsigned* bar, unsigned x, unsigned& nloc, unsigned& nx) {
    const unsigned G = gridDim.x * gridDim.y * gridDim.z;
    unsigned sum, cnt, mine, sp = 0u;
    for (;;) {
        sum = 0u; cnt = 0u; mine = 0u;
#pragma unroll
        for (unsigned j = 0; j < 16; ++j) { const unsigned c = xb_ld(&bar[XB_XCNT(j)]); sum += c; cnt += (c > 0u) ? 1u : 0u; mine = (j == x) ? c : mine; }
        if (sum == G) break;
        __builtin_amdgcn_s_sleep(1);
        if ((++sp & 255u) == 0u) { if (xb_ld(&bar[XB_TMO])) break; if (sp > XB_SPIN_CAP) { atomicAdd(&bar[XB_TMO], 1u); break; } }
    }
    nloc = mine > 0u ? mine : 1u; nx = cnt > 0u ? cnt : 1u;
}

__device__ __forceinline__ void xcd_barrier(const XcdBarrier& b) {
    asm volatile("s_waitcnt vmcnt(0)" ::: "memory");
    __syncthreads();
    if (threadIdx.x == 0) {
        unsigned* bar = b.bar;
        __builtin_amdgcn_s_waitcnt(0);
        unsigned nloc = b.st[0], nx = b.st[1];
        if (nloc == 0u) { xcd_barrier_complete(bar, b.x, nloc, nx); b.st[0] = nloc; b.st[1] = nx; }
        const unsigned old = xb_add(&bar[XB_XSUB(b.x)], 1u);
        const unsigned gen = old / nloc;
        if (old + 1u == (gen + 1u) * nloc) {
            __builtin_amdgcn_fence(__ATOMIC_RELEASE, "agent");
            asm volatile("s_waitcnt vmcnt(0)" ::: "memory");
            const unsigned og = xb_add(&bar[XB_TOP], 1u);
            const unsigned tg = og / nx;
            if (og + 1u == (tg + 1u) * nx) xb_add(&bar[XB_TOPGEN], 1u);
            else XB_SPIN(xb_ld(&bar[XB_TOPGEN]) == tg, bar);
            __builtin_amdgcn_fence(__ATOMIC_ACQUIRE, "agent");
            xb_add(&bar[XB_XGEN(b.x)], 1u);
            asm volatile("s_waitcnt vmcnt(0)" ::: "memory");
        } else {
            XB_SPIN(xb_ld(&bar[XB_XGEN(b.x)]) == gen, bar);
            __builtin_amdgcn_fence(__ATOMIC_ACQUIRE, "agent");
            asm volatile("s_waitcnt vmcnt(0)" ::: "memory");
        }
    }
    __syncthreads();
}

#ifndef MK_SINGLE
#define MK_SINGLE 1
#endif
constexpr int NSTEPS = 1 + 9 + 7 + 8 + 9 + 1;
template <int ACT> __device__ __forceinline__ void gemm_store(const bf16* A, const bf16* Bt, int Mrows, int N, int K, bf16* O, int ldc, float* AB, int ab_tile, bf16* halo) {
    int G_ = gridDim.x, B_ = blockIdx.x; asm volatile("" : "+s"(G_), "+s"(B_));
    pg8::Gemm g{A, Bt, Mrows, N, K}; pg8::StaticOrder S; S.init(Mrows, N, G_, B_);
    pg8::EpiStore<ACT> E{O, ldc, AB, ab_tile, halo};
    pg8::gemm_phase<pg8::EpiStore<ACT>, pg8::StaticOrder, true, true>((LAS unsigned char*)lds_raw, g, S, E);
}
__device__ __forceinline__ void gemm_resid(const bf16* A, const bf16* Bt, int Mrows, int K, float* X, const float* gate) {
    int G_ = gridDim.x, B_ = blockIdx.x; asm volatile("" : "+s"(G_), "+s"(B_));
    pg8::Gemm g{A, Bt, Mrows, D, K}; pg8::StaticOrder S; S.init(Mrows, D, G_, B_);
    pg8::EpiResid E{X, D, gate, NADA};
    pg8::gemm_phase<pg8::EpiResid, pg8::StaticOrder, true, true>((LAS unsigned char*)lds_raw, g, S, E);
}
__global__ void __launch_bounds__(NTHR, 2) fwd_kernel(Args a) {
    unsigned char* ws = a.ws;
    const int lo = a.step_lo, hi = a.step_hi; const bool coop = a.coop != 0;
    volatile LAS unsigned* bst = (volatile LAS unsigned*)((LAS unsigned char*)lds_raw + LDS_BYTES - 64);
    if (threadIdx.x < 2) bst[threadIdx.x] = 0u;
    __syncthreads();
    XcdBarrier bar; bar.bar = (unsigned*)(ws + WS_CTL) + 4096; bar.x = 0; bar.st = bst;
    if (coop) bar = xcd_barrier_post((unsigned*)(ws + WS_CTL) + 4096, bst);
#define PHASE(k, body) do { if (lo <= (k) && (k) < hi) { __syncthreads(); body; if ((k) + 1 < hi && coop) { if ((k) == 0) cg::this_grid().sync(); else xcd_barrier(bar); } } } while (0)
#define WB(off) ((bf16*)(ws + (off)))
#define MODP(layer, which) ((const float*)(ws + WS_MOD) + (size_t)(layer) * 3 * NADA + (which) * D)
#define TAIL(k0, layer, WoutT, Mrows) \
    PHASE((k0), gemm_resid(WB(WS_Y), (WoutT), (Mrows), D, (float*)(ws + WS_X), MODP(layer, 2))); \
    PHASE((k0) + 1, step_norm((layer), 1, (Mrows), false)); \
    PHASE((k0) + 2, gemm_store<1>(WB(WS_H), WB(WS_W1T) + (size_t)(layer) * D * FF, (Mrows), FF, D, WB(WS_Z), FF, nullptr, -1, nullptr)); \
    PHASE((k0) + 3, gemm_resid(WB(WS_Z), WB(WS_W2T) + (size_t)(layer) * D * FF, (Mrows), FF, (float*)(ws + WS_X), MODP(layer, 5)))
#define LAYER_GDN(k0, layer, jj, Mrows) \
    PHASE((k0), step_norm((layer), 0, M, false)); \
    PHASE((k0) + 1, gemm_store<0>(WB(WS_H), WB(WS_GINT) + (size_t)(jj) * GDN_NP * D, M, GDN_NP, D, WB(WS_Z), 4096, (float*)(ws + WS_AB), 16, WB(WS_HALO))); \
    PHASE((k0) + 2, step_gdn_prep(jj)); \
    PHASE((k0) + 3, step_gdn_scan2()); \
    PHASE((k0) + 4, step_gdn_norm2(jj)); \
    TAIL((k0) + 5, layer, WB(WS_GOUTT) + (size_t)(jj) * D * D, Mrows)
    PHASE(0, step_prologue());
    LAYER_GDN(1, 0, 0, M);
    PHASE(10, step_norm(1, 0, M, false));
    PHASE(11, gemm_store<0>(WB(WS_H), WB(WS_SINT), M, 3 * D, D, WB(WS_Z), 3 * D, nullptr, -1, nullptr));
    PHASE(12, step_sconv());
    TAIL(13, 1, WB(WS_SOUTT), M);
    PHASE(17, step_norm(2, 0, M, false));
    PHASE(18, gemm_store<0>(WB(WS_H), WB(WS_DINT), M, 3 * D, D, WB(WS_Z), 3 * D, nullptr, -1, nullptr));
    PHASE(19, step_rope2());
    PHASE(20, step_attn2());
    TAIL(21, 2, WB(WS_DOUTT), M);
    LAYER_GDN(25, 3, 1, ML);
    PHASE(34, step_final());
}

extern "C" void kernel_launch(void* const* d_in, const int* in_sizes, int n_in, void* d_out, int out_size, void* d_ws, size_t ws_size, hipStream_t stream) {
    static int grid = 0;
    if (grid == 0) {
        if (n_in != 24 || out_size != ML * D || ws_size < WS_END) { fprintf(stderr, "kernel_launch: unexpected problem (n_in %d, out %d, ws %zu); nothing launched\n", n_in, out_size, ws_size); grid = -1; return; }
        int dev = 0, cus = 0, per_cu = 0;
        if (hipGetDevice(&dev) != hipSuccess || hipDeviceGetAttribute(&cus, hipDeviceAttributeMultiprocessorCount, dev) != hipSuccess) { grid = -1; return; }
        if (hipFuncSetAttribute((const void*)fwd_kernel, hipFuncAttributeMaxDynamicSharedMemorySize, LDS_BYTES) != hipSuccess) { fprintf(stderr, "kernel_launch: hipFuncSetAttribute failed\n"); grid = -1; return; }
        if (hipOccupancyMaxActiveBlocksPerMultiprocessor(&per_cu, (const void*)fwd_kernel, NTHR, LDS_BYTES) != hipSuccess || per_cu < 1) { fprintf(stderr, "kernel_launch: occupancy query says %d blocks per CU\n", per_cu); (void)hipGetLastError(); per_cu = 1; }
        grid = cus;
        fprintf(stderr, "kernel_launch: %d CUs, occupancy %d per CU, grid %d\n", cus, per_cu, grid);
    }
    if (grid < 0) return;
    (void)hipMemsetAsync((char*)d_ws + WS_CTL, 0, CTL_ZERO_BYTES, stream);
    Args a{};
    for (int i = 0; i < 24; ++i) a.in[i] = (const float*)d_in[i];
    a.out = (float*)d_out; a.ws = (unsigned char*)d_ws;
#if MK_SINGLE
    a.step_lo = 0; a.step_hi = NSTEPS; a.coop = 1;
    void* args[] = {&a};
    hipError_t e = hipLaunchCooperativeKernel((const void*)fwd_kernel, dim3(grid), dim3(NTHR), args, LDS_BYTES, stream);
    if (e != hipSuccess) fprintf(stderr, "cooperative launch failed: %s (grid %d)\n", hipGetErrorString(e), grid);
#else
    for (int s = 0; s < NSTEPS; ++s) { a.step_lo = s; a.step_hi = s + 1; a.coop = 0; hipLaunchKernelGGL(fwd_kernel, dim3(grid), dim3(NTHR), LDS_BYTES, stream, a); }
#endif
}
```

```cpp
#include <hip/hip_runtime.h>
#include <hip/hip_cooperative_groups.h>
#include <cstdio>
#include <cstdint>
namespace cg = cooperative_groups;
namespace pg8 {
#define PG8_LAS __attribute__((address_space(3)))
typedef unsigned short bf16_t;
typedef short bf16x8 __attribute__((ext_vector_type(8)));
typedef float f32x4 __attribute__((ext_vector_type(4)));
typedef unsigned u32x4 __attribute__((ext_vector_type(4)));
constexpr int BM = 256, BK = 64, HALF = 128, HTB = HALF * BK * 2  , STAGE_BYTES = 8 * HTB, NXCD = 8, WGM = 8;

__host__ __device__ __forceinline__ int lds_byte(int r, int c) { const int st = (r >> 4) * 2 + (c >> 5), rr = r & 15, cc = c & 31, ob = rr * 64 + cc * 2; return st * 1024 + (ob ^ (((ob >> 9) & 1) << 5)); }
__host__ __device__ __forceinline__ void stage_rc(int b, int& R, int& C) { const int st = b / 1024, sb = b % 1024, swz = sb ^ (((sb >> 9) & 1) << 5); R = (st >> 1) * 16 + swz / 64; C = (st & 1) * 32 + (swz % 64) / 2; }
__host__ __device__ __forceinline__ int perm32(int rho) { const int n = rho >> 4, i = rho & 15; return 8 * (i >> 2) + 4 * n + (i & 3); }

struct Unit { int pm, pn; };
struct Gemm { const bf16_t* A; const bf16_t* Bt; int M, N, K, lda, ldb; };

struct StaticOrder {
    int nM, nN, nwg, G, c;
    __host__ __device__ void init(int M, int N, int G_, int c_) { nM = M / BM; nN = N / BM; nwg = nM * nN; G = G_; c = c_; }
    __host__ __device__ bool next(int i, Unit& u) const {
        const long L = (long)i * G + c; if (L >= nwg) return false;
        int wgid = (int)L; { const int q = nwg / NXCD, r = nwg % NXCD, xcd = wgid % NXCD, off = wgid / NXCD; wgid = (xcd < r ? xcd * (q + 1) : r * (q + 1) + (xcd - r) * q) + off; }
        const int nig = WGM * nN, gid = wgid / nig, fm = gid * WGM, gsz = (nM - fm) < WGM ? (nM - fm) : WGM;
        u.pm = fm + ((wgid % nig) % gsz); u.pn = (wgid % nig) / gsz; return true;
    }
    __device__ __forceinline__ void a_ready(const Unit&) const {}
    __device__ __forceinline__ void done(const Unit&) const {}
};

typedef float f32x2 __attribute__((ext_vector_type(2)));
typedef __bf16 bf16x2_t __attribute__((ext_vector_type(2)));
__device__ __forceinline__ unsigned cvt_pk_bf16(float lo, float hi) { f32x2 v = {lo, hi}; bf16x2_t b = __builtin_convertvector(v, bf16x2_t); return __builtin_bit_cast(unsigned, b); }

template <int ACT> struct EpiStore {
    static constexpr bool PERM = true, AFTER_DRAIN = false;
    bf16_t* O; int ldc; float* AB; int ab_tile; bf16_t* halo;
    __device__ __forceinline__ void operator()(const f32x4 (&acc)[2][2][4][2], const Unit& u, int wr, int wc, int fr, int fq) const {
        const int row0 = u.pm * BM + wr * 64 + fr;
        if (u.pn == ab_tile) {
            if (wc == 0) {
#pragma unroll
                for (int ai = 0; ai < 2; ++ai)
#pragma unroll
                    for (int m = 0; m < 4; ++m) { float* p = AB + (size_t)(row0 + ai * HALF + m * 16) * 32 + 8 * fq; *(f32x4*)p = acc[ai][0][m][0]; *(f32x4*)(p + 4) = acc[ai][0][m][1]; }
            }
            return;
        }
        const int col0 = u.pn * BM + wc * 32 + 8 * fq;
#pragma unroll
        for (int ai = 0; ai < 2; ++ai)
#pragma unroll
            for (int m = 0; m < 4; ++m) { bf16_t* rowp = O + (size_t)(row0 + ai * HALF + m * 16) * ldc + col0;
#pragma unroll
                for (int bj = 0; bj < 2; ++bj) { f32x4 v0 = acc[ai][bj][m][0], v1 = acc[ai][bj][m][1];
                    if (ACT == 1) {
#pragma unroll
                        for (int i = 0; i < 4; ++i) { const float a = fmaxf(v0[i], 0.f), b = fmaxf(v1[i], 0.f); v0[i] = a * a; v1[i] = b * b; } }
                    u32x4 w; w.x = cvt_pk_bf16(v0[0], v0[1]); w.y = cvt_pk_bf16(v0[2], v0[3]); w.z = cvt_pk_bf16(v1[0], v1[1]); w.w = cvt_pk_bf16(v1[2], v1[3]);
                    *(u32x4*)(rowp + bj * HALF) = w;
                    if (halo && u.pn < 12 && ((m == 0 && fr == 0) || (m == 3 && fr == 15))) { const int row = row0 + ai * HALF + m * 16;
                        *(u32x4*)(halo + ((size_t)(row >> 6) * 2 + (m == 3 ? 1 : 0)) * 3072 + col0 + bj * HALF) = w; } } }
    }
};
struct EpiResid {
    static constexpr bool PERM = false, AFTER_DRAIN = false;
    float* X; int ldc; const float* gate; int gstride;
    __device__ __forceinline__ void operator()(const f32x4 (&acc)[2][2][4][2], const Unit& u, int wr, int wc, int fr, int fq) const {
        const int row0 = u.pm * BM + wr * 64 + fr, col0 = u.pn * BM + wc * 32 + 4 * fq;
        const float* g = gate + (size_t)(u.pm < 32 ? 0 : (u.pm < 64 ? 1 : 2)) * gstride + col0;
        f32x4 gv[2][2];
#pragma unroll
        for (int bj = 0; bj < 2; ++bj)
#pragma unroll
            for (int n = 0; n < 2; ++n) gv[bj][n] = *(const f32x4*)(g + bj * HALF + n * 16);
#pragma unroll
        for (int ai = 0; ai < 2; ++ai)
#pragma unroll
            for (int m = 0; m < 4; ++m) { float* p = X + (size_t)(row0 + ai * HALF + m * 16) * ldc + col0;
#pragma unroll
                for (int bj = 0; bj < 2; ++bj)
#pragma unroll
                    for (int n = 0; n < 2; ++n) { float* q = p + bj * HALF + n * 16; *(f32x4*)q = *(const f32x4*)q + gv[bj][n] * acc[ai][bj][m][n]; }
                if (m & 1) asm volatile("" ::: "memory"); }
    }
};

template <class Epi, class Sched, bool ALIGN_EPI = false, bool SP2 = false>
__device__ __forceinline__ void gemm_phase(PG8_LAS unsigned char* lds, const Gemm g, const Sched& S, const Epi& E) {
    int tid_ = threadIdx.x; asm volatile("" : "+v"(tid_)); const int tid = tid_, wid = __builtin_amdgcn_readfirstlane(tid >> 6), lane = tid & 63, wr = wid >> 2, wc = wid & 3, fr = lane & 15, fq = lane >> 4;
    const int K = g.K, nt = K / BK;
    unsigned voffA[2], voffB[2];
#pragma unroll
    for (int i = 0; i < 2; ++i) { int R, C; stage_rc(tid * 16 + i * 8192, R, C); const int Rb = Epi::PERM ? ((R & ~31) + perm32(R & 31)) : R;
        voffA[i] = (unsigned)(R * g.lda + C) * 2u; voffB[i] = (unsigned)(Rb * g.ldb + C) * 2u; }
    const size_t kstep = (size_t)(BK * 2);
    const int lda = g.lda, ldb = g.ldb;
    const size_t hstepA = (size_t)HALF * lda * 2, hstepB = (size_t)HALF * ldb * 2;
    const size_t tstepA = 2 * hstepA, tstepB = 2 * hstepB;
    const unsigned ldsw = (unsigned)wid * 1024u;
    const int aoff = lds_byte(wr * 64 + fr, fq * 8), boff = lds_byte(wc * 32 + fr, fq * 8);
#define PG8_SA(b, h) (((b) * 2 + (h)) * HTB)
#define PG8_SB(b, h) ((4 + (b) * 2 + (h)) * HTB)
#define PG8_STAGE(bufoff, gbase, voff) do { _Pragma("unroll") for (int _i = 0; _i < 2; ++_i) \
        __builtin_amdgcn_global_load_lds((const unsigned*)((const char*)(gbase) + (voff)[_i]), (PG8_LAS unsigned*)(lds + (bufoff) + ldsw + _i * 8192), 16, 0, 0); } while (0)
#define PG8_LDA(dst, b, h) do { _Pragma("unroll") for (int m = 0; m < 4; ++m) _Pragma("unroll") for (int k = 0; k < 2; ++k) dst[m][k] = *(const PG8_LAS bf16x8*)(lds + PG8_SA(b, h) + aoff + m * 2048 + k * 1024); } while (0)
#define PG8_LDB(dst, b, h) do { _Pragma("unroll") for (int n = 0; n < 2; ++n) _Pragma("unroll") for (int k = 0; k < 2; ++k) dst[n][k] = *(const PG8_LAS bf16x8*)(lds + PG8_SB(b, h) + boff + n * 2048 + k * 1024); } while (0)
#define PG8_MMA(ai, bj, At, Bt) do { __builtin_amdgcn_s_setprio(1); _Pragma("unroll") for (int m = 0; m < 4; ++m) _Pragma("unroll") for (int n = 0; n < 2; ++n) _Pragma("unroll") for (int k = 0; k < 2; ++k) \
        acc[ai][bj][m][n] = __builtin_amdgcn_mfma_f32_16x16x32_bf16(Bt[n][k], At[m][k], acc[ai][bj][m][n], 0, 0, 0); __builtin_amdgcn_s_setprio(0); } while (0)
#define PG8_WAIT_V(n) asm volatile("s_waitcnt vmcnt(" #n ")" ::: "memory")
#define PG8_WAIT_L(n) asm volatile("s_waitcnt lgkmcnt(" #n ")" ::: "memory")
#define PG8_BAR __builtin_amdgcn_s_barrier()
#define PG8_SCHED __builtin_amdgcn_sched_barrier(0)
    Unit cur, nxt; int ui = 0;
    if (!S.next(0, cur)) return;
    f32x4 acc[2][2][4][2];
#pragma unroll
    for (int a = 0; a < 2; ++a)
#pragma unroll
        for (int b = 0; b < 2; ++b)
#pragma unroll
            for (int m = 0; m < 4; ++m)
#pragma unroll
                for (int n = 0; n < 2; ++n) acc[a][b][m][n] = (f32x4){0.f, 0.f, 0.f, 0.f};
    bf16x8 At[4][2], B0[2][2], B1[2][2];
    const char* cA = (const char*)g.A + (size_t)cur.pm * tstepA; const char* cB = (const char*)g.Bt + (size_t)cur.pn * tstepB;
    S.a_ready(cur);
    if constexpr (SP2) {
        PG8_STAGE(PG8_SB(0, 0), cB, voffB); PG8_STAGE(PG8_SB(0, 1), cB + hstepB, voffB); PG8_STAGE(PG8_SA(0, 0), cA, voffA); PG8_STAGE(PG8_SA(0, 1), cA + hstepA, voffA);
        if (wr == 1) PG8_BAR;
        PG8_WAIT_V(2); PG8_BAR;
        PG8_STAGE(PG8_SB(1, 0), cB + kstep, voffB); PG8_STAGE(PG8_SA(1, 0), cA + kstep, voffA); PG8_STAGE(PG8_SB(1, 1), cB + hstepB + kstep, voffB);
        PG8_WAIT_V(6); PG8_BAR;
    } else {
        PG8_STAGE(PG8_SB(0, 0), cB, voffB); PG8_STAGE(PG8_SA(0, 0), cA, voffA); PG8_STAGE(PG8_SB(0, 1), cB + hstepB, voffB); PG8_STAGE(PG8_SA(0, 1), cA + hstepA, voffA);
        if (wr == 1) PG8_BAR;
        PG8_WAIT_V(4); PG8_BAR;
        PG8_STAGE(PG8_SB(1, 0), cB + kstep, voffB); PG8_STAGE(PG8_SA(1, 0), cA + kstep, voffA); PG8_STAGE(PG8_SB(1, 1), cB + hstepB + kstep, voffB);
        PG8_WAIT_V(6); PG8_BAR;
    }
    for (;;) {
        const bool has_next = S.next(ui + 1, nxt);
        const char* nA = has_next ? (const char*)g.A + (size_t)nxt.pm * tstepA : cA; const char* nB = has_next ? (const char*)g.Bt + (size_t)nxt.pn * tstepB : cB;
        for (int t = 0; t < nt; t += 2) {
            const bool last = (t == nt - 2);
            const char* a1 = cA + (size_t)(t + 1) * kstep;
            const char* a2 = last ? nA : cA + (size_t)(t + 2) * kstep; const char* b2 = last ? nB : cB + (size_t)(t + 2) * kstep;
            const char* a3 = a2 + kstep; const char* b3 = b2 + kstep;
            if (last && has_next) S.a_ready(nxt);
            if constexpr (SP2) {
            PG8_LDB(B0, 0, 0); PG8_LDB(B1, 0, 1); PG8_SCHED; PG8_LDA(At, 0, 0); PG8_STAGE(PG8_SA(1, 1), a1 + hstepA, voffA);
            PG8_WAIT_V(8); PG8_WAIT_L(0); PG8_BAR; PG8_MMA(0, 0, At, B0); PG8_MMA(0, 1, At, B1); PG8_BAR; PG8_SCHED;
            PG8_LDA(At, 0, 1); PG8_STAGE(PG8_SB(0, 0), b2, voffB); PG8_STAGE(PG8_SB(0, 1), b2 + hstepB, voffB); PG8_STAGE(PG8_SA(0, 0), a2, voffA);
            PG8_WAIT_V(8); PG8_WAIT_L(0); PG8_BAR; PG8_MMA(1, 0, At, B0); PG8_MMA(1, 1, At, B1); PG8_BAR; PG8_SCHED;
            PG8_LDB(B0, 1, 0); PG8_LDB(B1, 1, 1); PG8_SCHED; PG8_LDA(At, 1, 0); PG8_STAGE(PG8_SA(0, 1), a2 + hstepA, voffA);
            PG8_WAIT_V(8); PG8_WAIT_L(0); PG8_BAR; PG8_MMA(0, 0, At, B0); PG8_MMA(0, 1, At, B1); PG8_BAR; PG8_SCHED;
            PG8_LDA(At, 1, 1); PG8_STAGE(PG8_SB(1, 0), b3, voffB); PG8_STAGE(PG8_SB(1, 1), b3 + hstepB, voffB); PG8_STAGE(PG8_SA(1, 0), a3, voffA);
            PG8_WAIT_V(8); PG8_WAIT_L(0); PG8_BAR; PG8_MMA(1, 0, At, B0); PG8_MMA(1, 1, At, B1); PG8_BAR; PG8_SCHED;
            } else {
            PG8_LDB(B0, 0, 0); PG8_SCHED; PG8_LDA(At, 0, 0); PG8_STAGE(PG8_SA(1, 1), a1 + hstepA, voffA);
            PG8_WAIT_L(8); PG8_BAR; PG8_WAIT_L(0); PG8_MMA(0, 0, At, B0); PG8_BAR; PG8_SCHED;
            PG8_LDB(B1, 0, 1); PG8_STAGE(PG8_SB(0, 0), b2, voffB);
            PG8_BAR; PG8_WAIT_L(0); PG8_MMA(0, 1, At, B1); PG8_BAR;
            PG8_LDA(At, 0, 1); PG8_STAGE(PG8_SA(0, 0), a2, voffA);
            PG8_BAR; PG8_WAIT_L(0); PG8_MMA(1, 0, At, B0); PG8_BAR; PG8_SCHED;
            PG8_STAGE(PG8_SB(0, 1), b2 + hstepB, voffB);
            PG8_WAIT_V(6); PG8_BAR; PG8_MMA(1, 1, At, B1); PG8_BAR;
            PG8_LDB(B0, 1, 0); PG8_SCHED; PG8_LDA(At, 1, 0); PG8_STAGE(PG8_SA(0, 1), a2 + hstepA, voffA);
            PG8_WAIT_L(8); PG8_BAR; PG8_WAIT_L(0); PG8_MMA(0, 0, At, B0); PG8_BAR; PG8_SCHED;
            PG8_LDB(B1, 1, 1); PG8_STAGE(PG8_SB(1, 0), b3, voffB);
            PG8_BAR; PG8_WAIT_L(0); PG8_MMA(0, 1, At, B1); PG8_BAR;
            PG8_LDA(At, 1, 1); PG8_STAGE(PG8_SA(1, 0), a3, voffA);
            PG8_BAR; PG8_WAIT_L(0); PG8_MMA(1, 0, At, B0); PG8_BAR; PG8_SCHED;
            PG8_STAGE(PG8_SB(1, 1), b3 + hstepB, voffB);
            PG8_WAIT_V(6); PG8_BAR; PG8_MMA(1, 1, At, B1); PG8_BAR;
            }
        }
        if constexpr (ALIGN_EPI) { if (wr == 0) PG8_BAR; }
        if constexpr (!Epi::AFTER_DRAIN) { E(acc, cur, wr, wc, fr, fq); S.done(cur); }
        if (!has_next) break;
#pragma unroll
        for (int a = 0; a < 2; ++a)
#pragma unroll
            for (int b = 0; b < 2; ++b)
#pragma unroll
                for (int m = 0; m < 4; ++m)
#pragma unroll
                    for (int n = 0; n < 2; ++n) acc[a][b][m][n] = (f32x4){0.f, 0.f, 0.f, 0.f};
        cur = nxt; cA = nA; cB = nB; ++ui;
        if constexpr (ALIGN_EPI) { if (wr == 1) PG8_BAR; }
    }
    PG8_WAIT_V(0);
    if constexpr (!ALIGN_EPI) { if (wr == 0) PG8_BAR; }
    PG8_BAR;
    if constexpr (Epi::AFTER_DRAIN) { E.fused(acc, cur, wr, wc, fr, fq, lds, wid, lane); S.done(cur); }
#undef PG8_SA
#undef PG8_SB
#undef PG8_STAGE
#undef PG8_LDA
#undef PG8_LDB
#undef PG8_MMA
#undef PG8_WAIT_V
#undef PG8_WAIT_L
#undef PG8_BAR
#undef PG8_SCHED
}
}

constexpr int D = 1024, NB = 2, T = 8192, CT = 256, DEPTH = 4, FF = 4096;
constexpr int ML = NB * T, MC = NB * CT, M = ML + MC;
constexpr int NADA = 6 * D;
constexpr int GDN_N = 4128, GDN_NP = 4352;
constexpr int NH = 8, HD = 128;
constexpr int NKV = CT + T;
constexpr float EPS = 1e-6f;
constexpr int NWAVES = 8, NTHR = 512;
constexpr float QSCALE = 0.125f * 1.4426950408889634f;
constexpr float LAMBDA_INIT = 0.47071302f;

constexpr size_t MiB = 1u << 20;
constexpr size_t WS_CTL = 0, CTL_ZERO_BYTES = 1 * MiB;
constexpr size_t WS_MOD = 1 * MiB;
constexpr size_t WS_ROPE = 2 * MiB;
constexpr size_t WS_AB = 4 * MiB;
constexpr size_t WS_OFC = 7 * MiB;
constexpr size_t WS_W1T = 10 * MiB, WS_W2T = 42 * MiB, WS_GINT = 74 * MiB, WS_GOUTT = 91 * MiB, WS_SINT = 95 * MiB, WS_SOUTT = 101 * MiB, WS_DINT = 103 * MiB, WS_DOUTT = 109 * MiB;
constexpr size_t WS_X = 112 * MiB;
constexpr size_t WS_H = 178 * MiB;
constexpr size_t WS_Y = 211 * MiB;
constexpr size_t WS_Z = 244 * MiB;
constexpr size_t WS_HALO = 376 * MiB;
constexpr size_t WS_END = 380 * MiB;
constexpr size_t WS_PD = WS_H;

constexpr int LDS_BYTES = 149504;

#define LAS __attribute__((address_space(3)))
typedef unsigned short bf16;
typedef unsigned u32x4 __attribute__((ext_vector_type(4)));
typedef unsigned u32x2 __attribute__((ext_vector_type(2)));
typedef float f32x4 __attribute__((ext_vector_type(4)));
typedef float f32x2 __attribute__((ext_vector_type(2)));
typedef float f32x16 __attribute__((ext_vector_type(16)));
typedef short bf16x8 __attribute__((ext_vector_type(8)));
typedef short s16x4 __attribute__((ext_vector_type(4)));
#define LDS_WAIT() asm volatile("s_waitcnt lgkmcnt(0)" ::: "memory")

__device__ __forceinline__ float bf2f(unsigned u) { return __uint_as_float(u << 16); }
__device__ __forceinline__ unsigned pk2(float lo, float hi) { return pg8::cvt_pk_bf16(lo, hi); }
__device__ __forceinline__ float wave_sum(float v) {
#pragma unroll
    for (int o = 1; o < 64; o <<= 1) v += __shfl_xor(v, o);
    return v;
}
__device__ __forceinline__ float silu_f(float x) { return x / (1.f + expf(-x)); }
__device__ __forceinline__ float silu_fast(float x) { return x * __builtin_amdgcn_rcpf(1.f + __builtin_amdgcn_exp2f(-1.4426950408889634f * x)); }
__device__ __forceinline__ int crow(int r, int hi) { return (r & 3) + 8 * (r >> 2) + 4 * hi; }

struct Args { const float* in[24]; float* out; unsigned char* ws; int step_lo, step_hi, coop, pad; };
typedef const __attribute__((address_space(4))) Args* KArgs;
__device__ __forceinline__ KArgs kargs() { unsigned long long p = (unsigned long long)__builtin_amdgcn_kernarg_segment_ptr(); asm volatile("" : "+s"(p)); return (KArgs)p; }
#define INP(k) (kargs()->in[k])
extern __shared__ __attribute__((aligned(16))) unsigned char lds_raw[];
struct Frame { LAS unsigned char* lds; int tid, lane, wave, G, bid; float* out; unsigned char* ws; };
__device__ __forceinline__ Frame make_frame() {
    Frame F; F.lds = (LAS unsigned char*)lds_raw; F.tid = threadIdx.x; asm volatile("" : "+v"(F.tid)); F.lane = F.tid & 63; F.wave = __builtin_amdgcn_readfirstlane(F.tid >> 6); F.G = gridDim.x; F.bid = blockIdx.x; asm volatile("" : "+s"(F.G), "+s"(F.bid));
    KArgs a = kargs(); F.out = a->out; F.ws = a->ws; return F;
}
enum { I_X = 0, I_C, I_CTX, I_CCTX, I_N1G, I_N2G, I_ADAW, I_ADAB, I_W1, I_W2, I_GIN, I_GCONV, I_GALOG, I_GDT, I_GNG, I_GOUT, I_SIN, I_SCONV, I_SOUT, I_DIN, I_DLAM, I_DNG, I_DOUT, I_FG };

__device__ __forceinline__ void transpose_item(const float* W, int K, int ldw, bf16* WT, LAS float* scr, int item, int nblk, int lane) {
    const int kb = item / nblk, nb = item % nblk, k0 = 64 * kb, n0 = 32 * nb;
#pragma unroll 8
    for (int i = 0; i < 32; ++i) { const int kk = 2 * i + (lane >> 5); scr[kk * 33 + (lane & 31)] = W[(size_t)(k0 + kk) * ldw + n0 + (lane & 31)]; }
    LDS_WAIT(); asm volatile("" ::: "memory");
    const int c = lane & 7;
#pragma unroll
    for (int j = 0; j < 4; ++j) { const int n = (lane >> 3) + 8 * j; const LAS float* s = scr + (8 * c) * 33 + n;
        u32x4 o; o.x = pk2(s[0 * 33], s[1 * 33]); o.y = pk2(s[2 * 33], s[3 * 33]); o.z = pk2(s[4 * 33], s[5 * 33]); o.w = pk2(s[6 * 33], s[7 * 33]);
        *(u32x4*)(WT + (size_t)(n0 + n) * K + k0 + 8 * c) = o; }
    LDS_WAIT(); asm volatile("" ::: "memory");
}
__device__ __forceinline__ void get_mat(unsigned char* ws_, int idx, const float*& src, bf16*& dst, int& K, int& N, int& ld) {
    unsigned char* ws = ws_;
    if (idx < 4)       { src = INP(I_W1) + (size_t)idx * D * FF; dst = (bf16*)(ws + WS_W1T) + (size_t)idx * D * FF; K = D; N = FF; ld = FF; }
    else if (idx < 8)  { const int i = idx - 4; src = INP(I_W2) + (size_t)i * D * FF; dst = (bf16*)(ws + WS_W2T) + (size_t)i * D * FF; K = FF; N = D; ld = D; }
    else if (idx < 10) { const int j = idx - 8; src = INP(I_GIN) + (size_t)j * D * GDN_N; dst = (bf16*)(ws + WS_GINT) + (size_t)j * GDN_NP * D; K = D; N = GDN_N; ld = GDN_N; }
    else if (idx < 12) { const int j = idx - 10; src = INP(I_GOUT) + (size_t)j * D * D; dst = (bf16*)(ws + WS_GOUTT) + (size_t)j * D * D; K = D; N = D; ld = D; }
    else if (idx == 12) { src = INP(I_SIN); dst = (bf16*)(ws + WS_SINT); K = D; N = 3 * D; ld = 3 * D; }
    else if (idx == 13) { src = INP(I_SOUT); dst = (bf16*)(ws + WS_SOUTT); K = D; N = D; ld = D; }
    else if (idx == 14) { src = INP(I_DIN); dst = (bf16*)(ws + WS_DINT); K = D; N = 3 * D; ld = 3 * D; }
    else { src = INP(I_DOUT); dst = (bf16*)(ws + WS_DOUTT); K = D; N = D; ld = D; }
}
__device__ __forceinline__ void convert_weights(unsigned char* ws, unsigned mask, int gw, int NGW, int gt, int NGT, LAS unsigned char* lds, int wave, int lane) {
    LAS float* scr = (LAS float*)(lds + wave * 16384);
    for (int mi = 0; mi < 16; ++mi) {
        if (!((mask >> mi) & 1u)) continue;
        const float* src; bf16* dst; int K, N, ld; get_mat(ws, mi, src, dst, K, N, ld);
        const int nblk = N / 32, nitems = (K / 64) * nblk;
        for (int it = gw; it < nitems; it += NGW) transpose_item(src, K, ld, dst, scr, it, nblk, lane);
        if (mi == 8 || mi == 9) { u32x4* z = (u32x4*)((bf16*)(ws + WS_GINT) + (size_t)(mi - 8) * GDN_NP * D + (size_t)GDN_N * D);
            for (int i = gt; i < (GDN_NP - GDN_N) * D / 8; i += NGT) z[i] = (u32x4){0u, 0u, 0u, 0u}; }
    }
}
__device__ __forceinline__ void step_prologue() {
    const Frame F = make_frame();
    const int gw = F.bid * NWAVES + F.wave, NGW = F.G * NWAVES;
    const int gt = F.bid * NTHR + F.tid, NGT = F.G * NTHR;
    convert_weights(F.ws, (1u << 0) | (1u << 4) | (1u << 8) | (1u << 10), gw, NGW, gt, NGT, F.lds, F.wave, F.lane);
    __syncthreads();
    {
        LAS float* sv = (LAS float*)F.lds;
        LAS float* red = sv + 3 * D;
        for (int i = F.tid; i < 3 * D; i += NTHR) { const int g = i / D, k = i % D; const float c = g < 2 ? INP(I_C)[g * D + k] : INP(I_CCTX)[k]; sv[i] = silu_f(c); }
        __syncthreads();
        float* MOD = (float*)(F.ws + WS_MOD);
        const int c = F.tid & 63, ks = F.tid >> 6;
        for (int it = F.bid; it < DEPTH * (NADA / 64); it += F.G) {
            const int li = it / (NADA / 64), n0 = (it % (NADA / 64)) * 64;
            const float* w = INP(I_ADAW) + (size_t)li * D * NADA + (size_t)(ks * 128) * NADA + n0 + c;
            float a0 = 0.f, a1 = 0.f, a2 = 0.f;
#pragma unroll 8
            for (int k = 0; k < 128; ++k) { const float wv = w[(size_t)k * NADA]; const int kk = ks * 128 + k; a0 += sv[kk] * wv; a1 += sv[D + kk] * wv; a2 += sv[2 * D + kk] * wv; }
            red[(ks * 3 + 0) * 64 + c] = a0; red[(ks * 3 + 1) * 64 + c] = a1; red[(ks * 3 + 2) * 64 + c] = a2;
            __syncthreads();
            if (F.tid < 192) { const int g = F.tid >> 6; float s = INP(I_ADAB)[li * NADA + n0 + c];
#pragma unroll
                for (int q = 0; q < 8; ++q) s += red[(q * 3 + g) * 64 + c];
                MOD[((size_t)li * 3 + g) * NADA + n0 + c] = s; }
            __syncthreads();
        }
    }
    {
        f32x4* X4 = (f32x4*)(F.ws + WS_X); const f32x4* x4 = (const f32x4*)INP(I_X); const f32x4* c4 = (const f32x4*)INP(I_CTX);
        for (int i = gt; i < M * (D / 4); i += NGT) X4[i] = i < ML * (D / 4) ? x4[i] : c4[i - ML * (D / 4)];
    }
    {
        f32x2* R = (f32x2*)(F.ws + WS_ROPE);
        for (int i = gt; i < T * 32; i += NGT) { const int t = i >> 5, p = i & 31, f = p & 15;
            const float inv = powf(10000.0f, -(float)f / 16.0f); const float pos = (float)(p < 16 ? (t >> 6) : (t & 63)); const float ang = pos * inv;
            R[i] = (f32x2){cosf(ang), sinf(ang)}; }
    }
}

__device__ __forceinline__ void step_norm(int layer, int which, int nrows, bool zero_of) {
    const Frame F = make_frame();
    const int gw = F.bid * NWAVES + F.wave, NGW = F.G * NWAVES;
    const float* X = (const float*)(F.ws + WS_X); bf16* H = (bf16*)(F.ws + WS_H);
    const float* ng = (which ? INP(I_N2G) : INP(I_N1G)) + layer * D;
    const float* MOD = (const float*)(F.ws + WS_MOD) + (size_t)layer * 3 * NADA + which * 3 * D;
    for (int row = gw; row < nrows; row += NGW) {
        const int grp = row < T ? 0 : (row < ML ? 1 : 2);
        const f32x4* xr = (const f32x4*)(X + (size_t)row * D) + F.lane;
        const f32x4* sh = (const f32x4*)(MOD + (size_t)grp * NADA) + F.lane; const f32x4* sc = (const f32x4*)(MOD + (size_t)grp * NADA + D) + F.lane; const f32x4* gg = (const f32x4*)ng + F.lane;
        f32x4 v[4]; float s = 0.f;
#pragma unroll
        for (int j = 0; j < 4; ++j) { v[j] = xr[64 * j]; s += (v[j].x * v[j].x + v[j].y * v[j].y) + (v[j].z * v[j].z + v[j].w * v[j].w); }
        const float rstd = 1.0f / sqrtf(wave_sum(s) * (1.f / D) + EPS);
        u32x2* o = (u32x2*)(H + (size_t)row * D) + F.lane;
#pragma unroll
        for (int j = 0; j < 4; ++j) { const f32x4 g4 = gg[64 * j], s4 = sc[64 * j], h4 = sh[64 * j]; const f32x4 y = (v[j] * rstd) * g4; const f32x4 h = y * (1.0f + s4) + h4;
            o[64 * j] = (u32x2){pk2(h.x, h.y), pk2(h.z, h.w)}; }
    }
    if (zero_of) {
        const int gt = F.bid * NTHR + F.tid, NGT = F.G * NTHR;
        f32x4* a = (f32x4*)F.out; for (int i = gt; i < ML * (D / 4); i += NGT) a[i] = (f32x4){0.f, 0.f, 0.f, 0.f};
        f32x4* b = (f32x4*)(F.ws + WS_OFC); for (int i = gt; i < MC * (D / 4); i += NGT) b[i] = (f32x4){0.f, 0.f, 0.f, 0.f};
    }
}
__device__ __forceinline__ void step_final() {
    const Frame F = make_frame();
    const int gw = F.bid * NWAVES + F.wave, NGW = F.G * NWAVES;
    const float* X = (const float*)(F.ws + WS_X);
    for (int row = gw; row < ML; row += NGW) {
        const f32x4* xr = (const f32x4*)(X + (size_t)row * D) + F.lane; const f32x4* gg = (const f32x4*)INP(I_FG) + F.lane;
        f32x4 v[4]; float s = 0.f;
#pragma unroll
        for (int j = 0; j < 4; ++j) { v[j] = xr[64 * j]; s += (v[j].x * v[j].x + v[j].y * v[j].y) + (v[j].z * v[j].z + v[j].w * v[j].w); }
        const float rstd = 1.0f / sqrtf(wave_sum(s) * (1.f / D) + EPS);
        f32x4* o = (f32x4*)(F.out + (size_t)row * D) + F.lane;
#pragma unroll
        for (int j = 0; j < 4; ++j) o[64 * j] = (v[j] * rstd) * gg[64 * j];
    }
}

__device__ __forceinline__ void step_gdn_scan(int j) {
    const Frame F = make_frame();
    LAS float* qs = (LAS float*)F.lds;
    LAS float* ks = qs + 64 * 128;
    LAS float* vs = ks + 64 * 128;
    LAS float* ga = vs + 64 * 128;
    LAS float* be = ga + 64;
    const bf16* Z = (const bf16*)(F.ws + WS_Z);
    const float* AB = (const float*)(F.ws + WS_AB);
    const float* cw = INP(I_GCONV) + (size_t)j * 3 * 3072;
    float* OFC = (float*)(F.ws + WS_OFC);
    for (int it = F.bid; it < 32; it += F.G) {
        const int b = it >> 4, h = (it >> 1) & 7, dir = it & 1;
        const float Aco = expf(INP(I_GALOG)[j * 16 + dir * 8 + h]); const float dtb = INP(I_GDT)[j * 16 + dir * 8 + h];
        float S[64];
#pragma unroll
        for (int i = 0; i < 64; ++i) S[i] = 0.f;
        const int jcol = F.tid >> 1, half = F.tid & 1;
        for (int n = 0; n < 132; ++n) {
            const bool isctx = n < 4; const int L = isctx ? CT : T; const int p0 = isctx ? 64 * n : 64 * (n - 4); const int rbase = isctx ? ML + b * CT : b * T;
            for (int idx = F.tid; idx < 64 * 384; idx += NTHR) {
                const int c = idx / 384, ch = idx % 384, part = ch >> 7, e = ch & 127;
                const int p = p0 + c; const int t = dir ? (L - 1 - p) : p; const int col = part * 1024 + h * 128 + e;
                float acc = 0.f;
#pragma unroll
                for (int tap = 0; tap < 3; ++tap) { const int tt = t + tap - 1; if (tt >= 0 && tt < L) acc += cw[tap * 3072 + col] * bf2f(Z[(size_t)(rbase + tt) * 4096 + col]); }
                acc = silu_f(acc);
                LAS float* dst = part == 0 ? qs : (part == 1 ? ks : vs); dst[c * 128 + e] = acc;
            }
            if (F.tid < 64) { const int p = p0 + F.tid; const int t = dir ? (L - 1 - p) : p; const size_t row = (size_t)(rbase + t);
                const float av = AB[row * 32 + dir * 8 + h], bv = AB[row * 32 + 16 + dir * 8 + h];
                const float x = av + dtb; const float sp = x > 20.f ? x : log1pf(expf(x));
                ga[F.tid] = expf(-Aco * sp); be[F.tid] = 1.f / (1.f + expf(-bv)); }
            __syncthreads();
#pragma unroll 1
            for (int rr = 0; rr < 8; ++rr) { const int c = F.wave * 8 + rr;
                const float q0 = qs[c * 128 + F.lane], q1 = qs[c * 128 + 64 + F.lane]; const float sq = 0.08838834764831845f / sqrtf(wave_sum(q0 * q0 + q1 * q1) + EPS);
                qs[c * 128 + F.lane] = q0 * sq; qs[c * 128 + 64 + F.lane] = q1 * sq;
                const float k0 = ks[c * 128 + F.lane], k1 = ks[c * 128 + 64 + F.lane]; const float sk = 1.0f / sqrtf(wave_sum(k0 * k0 + k1 * k1) + EPS);
                ks[c * 128 + F.lane] = k0 * sk; ks[c * 128 + 64 + F.lane] = k1 * sk; }
            __syncthreads();
            if (F.tid < 256) {
#pragma unroll 1
                for (int c = 0; c < 64; ++c) {
                    const float a = ga[c], bt = be[c];
                    const LAS f32x4* k4 = (const LAS f32x4*)(ks + c * 128 + 64 * half); const LAS f32x4* q4 = (const LAS f32x4*)(qs + c * 128 + 64 * half);
                    float dot = 0.f;
#pragma unroll
                    for (int i = 0; i < 16; ++i) { const f32x4 kv = k4[i]; dot += kv.x * S[4 * i] + kv.y * S[4 * i + 1] + kv.z * S[4 * i + 2] + kv.w * S[4 * i + 3]; }
                    dot += __shfl_xor(dot, 1);
                    const float tmp = bt * (vs[c * 128 + jcol] - a * dot);
                    float o = 0.f;
#pragma unroll
                    for (int i = 0; i < 16; ++i) { const f32x4 kv = k4[i]; const f32x4 qv = q4[i];
                        S[4 * i] = a * S[4 * i] + kv.x * tmp; S[4 * i + 1] = a * S[4 * i + 1] + kv.y * tmp; S[4 * i + 2] = a * S[4 * i + 2] + kv.z * tmp; S[4 * i + 3] = a * S[4 * i + 3] + kv.w * tmp;
                        o += qv.x * S[4 * i] + qv.y * S[4 * i + 1] + qv.z * S[4 * i + 2] + qv.w * S[4 * i + 3]; }
                    o += __shfl_xor(o, 1);
                    const int p = p0 + c; const int t = dir ? (L - 1 - p) : p;
                    float* dst = isctx ? OFC + (size_t)(b * CT + t) * D : F.out + (size_t)(b * T + t) * D;
                    if (half == 0) atomicAdd(dst + h * 128 + jcol, o);
                }
            }
            __syncthreads();
        }
    }
}
__device__ __forceinline__ void step_gdn_norm(int j) {
    const Frame F = make_frame();
    const int gw = F.bid * NWAVES + F.wave, NGW = F.G * NWAVES;
    const bf16* Z = (const bf16*)(F.ws + WS_Z); bf16* Y = (bf16*)(F.ws + WS_Y); const float* ng = INP(I_GNG) + j * 128;
    for (int row = gw; row < M; row += NGW) {
        const float* src = row < ML ? F.out + (size_t)row * D : (const float*)(F.ws + WS_OFC) + (size_t)(row - ML) * D;
        const f32x4* s4 = (const f32x4*)(src + 16 * F.lane);
        float v[16]; float ss = 0.f;
#pragma unroll
        for (int q = 0; q < 4; ++q) { const f32x4 x = s4[q]; v[4 * q] = x.x; v[4 * q + 1] = x.y; v[4 * q + 2] = x.z; v[4 * q + 3] = x.w; ss += (x.x * x.x + x.y * x.y) + (x.z * x.z + x.w * x.w); }
        ss += __shfl_xor(ss, 1); ss += __shfl_xor(ss, 2); ss += __shfl_xor(ss, 4);
        const float rstd = 1.0f / sqrtf(ss * (1.f / 128.f) + EPS);
        const u32x4* g4 = (const u32x4*)(Z + (size_t)row * 4096 + 3072 + 16 * F.lane);
        const int e0 = (16 * F.lane) & 127;
        u32x4 o[2];
#pragma unroll
        for (int q = 0; q < 2; ++q) { const u32x4 gz = g4[q]; unsigned w[4];
#pragma unroll
            for (int i = 0; i < 4; ++i) { const unsigned gg = gz[i]; const float g0 = bf2f(gg & 0xffffu), g1 = bf2f(gg >> 16); const int e = e0 + 8 * q + 2 * i;
                w[i] = pk2(v[8 * q + 2 * i] * rstd * ng[e] * silu_f(g0), v[8 * q + 2 * i + 1] * rstd * ng[e + 1] * silu_f(g1)); }
            o[q] = (u32x4){w[0], w[1], w[2], w[3]}; }
        u32x4* dst = (u32x4*)(Y + (size_t)row * D + 16 * F.lane); dst[0] = o[0]; dst[1] = o[1];
    }
}

__device__ __forceinline__ void step_sconv() {
    const Frame F = make_frame();
    const int gt = F.bid * NTHR + F.tid, NGT = F.G * NTHR;
    const bf16* Z = (const bf16*)(F.ws + WS_Z); bf16* Y = (bf16*)(F.ws + WS_Y); const float* cw = INP(I_SCONV);
    for (int idx = gt; idx < M * 128; idx += NGT) {
        const int row = idx >> 7, c0 = (idx & 127) * 8;
        int t, L, rbase; if (row < ML) { t = row & (T - 1); L = T; rbase = row - t; } else { const int r2 = row - ML; t = r2 & (CT - 1); L = CT; rbase = row - t; }
        float acc[8];
#pragma unroll
        for (int i = 0; i < 8; ++i) acc[i] = 0.f;
#pragma unroll
        for (int tap = 0; tap < 3; ++tap) { const int tt = t + tap - 1;
            if (tt >= 0 && tt < L) { const bf16* zr = Z + (size_t)(rbase + tt) * 3072; const u32x4 cg = *(const u32x4*)(zr + 1024 + c0), hv = *(const u32x4*)(zr + 2048 + c0);
                const f32x4 w0 = *(const f32x4*)(cw + tap * 1024 + c0), w1 = *(const f32x4*)(cw + tap * 1024 + c0 + 4); const float w[8] = {w0.x, w0.y, w0.z, w0.w, w1.x, w1.y, w1.z, w1.w};
#pragma unroll
                for (int i = 0; i < 4; ++i) { acc[2 * i] += w[2 * i] * bf2f(cg[i] & 0xffffu) * bf2f(hv[i] & 0xffffu); acc[2 * i + 1] += w[2 * i + 1] * bf2f(cg[i] >> 16) * bf2f(hv[i] >> 16); } } }
        const u32x4 bg = *(const u32x4*)(Z + (size_t)row * 3072 + c0); u32x4 o;
#pragma unroll
        for (int i = 0; i < 4; ++i) o[i] = pk2(bf2f(bg[i] & 0xffffu) * acc[2 * i], bf2f(bg[i] >> 16) * acc[2 * i + 1]);
        *(u32x4*)(Y + (size_t)row * D + c0) = o;
    }
}

__device__ __forceinline__ void step_rope() {
    const Frame F = make_frame();
    const int gw = F.bid * NWAVES + F.wave, NGW = F.G * NWAVES;
    bf16* Z = (bf16*)(F.ws + WS_Z); const f32x4* R = (const f32x4*)(F.ws + WS_ROPE);
    for (int row = gw; row < M; row += NGW) {
        u32x4* p = (u32x4*)(Z + (size_t)row * 3072 + 32 * F.lane);
        u32x4 v[4];
#pragma unroll
        for (int q = 0; q < 4; ++q) v[q] = p[q];
        const bool lat = row < ML; const float sc = F.lane < 32 ? QSCALE : 1.0f;
        const f32x4* tab = R + ((size_t)(row & (T - 1)) * 32 + 16 * (F.lane & 1)) / 2;
#pragma unroll
        for (int q = 0; q < 4; ++q) {
#pragma unroll
            for (int i = 0; i < 4; i += 2) {
                f32x4 cs = (f32x4){1.f, 0.f, 1.f, 0.f}; if (lat) cs = tab[(4 * q + i) / 2];
                { const unsigned w = v[q][i]; const float x0 = bf2f(w & 0xffffu), x1 = bf2f(w >> 16); v[q][i] = pk2((x0 * cs.x - x1 * cs.y) * sc, (x0 * cs.y + x1 * cs.x) * sc); }
                { const unsigned w = v[q][i + 1]; const float x0 = bf2f(w & 0xffffu), x1 = bf2f(w >> 16); v[q][i + 1] = pk2((x0 * cs.z - x1 * cs.w) * sc, (x0 * cs.w + x1 * cs.z) * sc); }
            }
        }
#pragma unroll
        for (int q = 0; q < 4; ++q) p[q] = v[q];
    }
    bf16* Vt = (bf16*)(F.ws + WS_H);
    LAS bf16* tl = (LAS bf16*)(F.lds + F.wave * 18432);
    for (int it = gw; it < NB * NH * (NKV / 64); it += NGW) {
        const int kt = it % (NKV / 64), bh = it / (NKV / 64), b = bh >> 3, h = bh & 7; const int kv0 = 64 * kt;
        const int srow = kv0 < CT ? ML + b * CT + kv0 : b * T + kv0 - CT;
#pragma unroll 4
        for (int i = 0; i < 16; ++i) { const int r = 4 * i + (F.lane >> 4), cc = (F.lane & 15) * 8;
            const u32x4 v = *(const u32x4*)(Z + (size_t)(srow + r) * 3072 + 2048 + h * 128 + cc);
#pragma unroll
            for (int q = 0; q < 4; ++q) { tl[(cc + 2 * q) * 72 + r] = (bf16)(v[q] & 0xffffu); tl[(cc + 2 * q + 1) * 72 + r] = (bf16)(v[q] >> 16); } }
        LDS_WAIT(); asm volatile("" ::: "memory");
#pragma unroll 4
        for (int i = 0; i < 16; ++i) { const int e = 8 * i + (F.lane >> 3), ch = F.lane & 7;
            const u32x4 v = *(const LAS u32x4*)(tl + e * 72 + ch * 8);
            *(u32x4*)(Vt + ((size_t)(bh * 128 + e)) * NKV + kv0 + ch * 8) = v; }
        LDS_WAIT(); asm volatile("" ::: "memory");
    }
}
__device__ __forceinline__ void step_attn() {
    const Frame F = make_frame();
    const bf16* Z = (const bf16*)(F.ws + WS_Z); const bf16* Vt = (const bf16*)(F.ws + WS_H); bf16* Y = (bf16*)(F.ws + WS_Y);
    LAS float* EX = (LAS float*)F.lds;
    const int r = F.lane & 31, hi = F.lane >> 5, qs = F.wave & 3, m = F.wave >> 2;
    float lmb;
    { const float* lam = INP(I_DLAM); const float t1 = lam[F.lane] * lam[64 + F.lane], t2 = lam[128 + F.lane] * lam[192 + F.lane]; lmb = expf(wave_sum(t1)) - expf(wave_sum(t2)) + LAMBDA_INIT; }
    const float* ng = INP(I_DNG);
    for (int u = F.bid; u < 1056; u += F.G) {
        int b, h, qrow0, nk;
        if (u < 1024) { b = u >> 9; h = (u >> 6) & 7; qrow0 = b * T + (u & 63) * 128; nk = NKV / 32; }
        else { const int v = u - 1024; b = v >> 4; h = (v >> 1) & 7; qrow0 = ML + b * CT + (v & 1) * 128; nk = CT / 32; }
        const int row0 = qrow0 + 32 * qs;
        bf16x8 qf[4];
#pragma unroll
        for (int d0 = 0; d0 < 4; ++d0) qf[d0] = *(const bf16x8*)(Z + (size_t)(row0 + r) * 3072 + h * 128 + m * 64 + d0 * 16 + hi * 8);
        const int kcol = 1024 + h * 128 + m * 64 + hi * 8;
        const bf16* vtb = Vt + (size_t)((b * 8 + h) * 128 + r) * NKV + 4 * hi;
        f32x16 o[4];
#pragma unroll
        for (int i = 0; i < 4; ++i)
#pragma unroll
            for (int q = 0; q < 16; ++q) o[i][q] = 0.f;
        float mref = 0.f, l = 0.f;
        for (int s = 0; s < nk; ++s) {
            const int kv0 = 32 * s; const int krow = kv0 < CT ? ML + b * CT + kv0 : b * T + kv0 - CT;
            const bf16* kp = Z + (size_t)(krow + r) * 3072 + kcol;
            bf16x8 kf[4];
#pragma unroll
            for (int d0 = 0; d0 < 4; ++d0) kf[d0] = *(const bf16x8*)(kp + d0 * 16);
            bf16x8 vf[4][2];
#pragma unroll
            for (int i = 0; i < 4; ++i)
#pragma unroll
                for (int s2 = 0; s2 < 2; ++s2) { const bf16* vp = vtb + (size_t)(32 * i) * NKV + kv0 + 16 * s2; const s16x4 lo = *(const s16x4*)vp, h8 = *(const s16x4*)(vp + 8);
                    vf[i][s2] = (bf16x8){lo[0], lo[1], lo[2], lo[3], h8[0], h8[1], h8[2], h8[3]}; }
            f32x16 S;
#pragma unroll
            for (int q = 0; q < 16; ++q) S[q] = 0.f;
#pragma unroll
            for (int d0 = 0; d0 < 4; ++d0) S = __builtin_amdgcn_mfma_f32_32x32x16_bf16(kf[d0], qf[d0], S, 0, 0, 0);
            float mx = S[0];
#pragma unroll
            for (int q = 1; q < 16; ++q) mx = fmaxf(mx, S[q]);
            mx = fmaxf(mx, __shfl_xor(mx, 32));
            if (s == 0) mref = mx;
            else if (__any(mx > mref)) { const float mn = fmaxf(mref, mx); const float al = __builtin_amdgcn_exp2f(mref - mn); l *= al; mref = mn;
#pragma unroll
                for (int i = 0; i < 4; ++i)
#pragma unroll
                    for (int q = 0; q < 16; ++q) o[i][q] *= al; }
            float ps = 0.f;
#pragma unroll
            for (int q = 0; q < 16; ++q) { S[q] = __builtin_amdgcn_exp2f(S[q] - mref); ps += S[q]; }
            l += ps;
            bf16x8 pf[2];
#pragma unroll
            for (int s2 = 0; s2 < 2; ++s2) { u32x4 w; w.x = pk2(S[8 * s2], S[8 * s2 + 1]); w.y = pk2(S[8 * s2 + 2], S[8 * s2 + 3]); w.z = pk2(S[8 * s2 + 4], S[8 * s2 + 5]); w.w = pk2(S[8 * s2 + 6], S[8 * s2 + 7]); pf[s2] = __builtin_bit_cast(bf16x8, w); }
#pragma unroll
            for (int i = 0; i < 4; ++i)
#pragma unroll
                for (int s2 = 0; s2 < 2; ++s2) o[i] = __builtin_amdgcn_mfma_f32_32x32x16_bf16(vf[i][s2], pf[s2], o[i], 0, 0, 0);
        }
        l += __shfl_xor(l, 32);
        const float f = (m == 1 ? lmb : 1.0f) / l;
        LAS float* ex = EX + (size_t)m * 128 * 129 + (qs * 32 + r) * 129;
#pragma unroll
        for (int i = 0; i < 4; ++i)
#pragma unroll
            for (int q = 0; q < 16; ++q) ex[32 * i + crow(q, hi)] = o[i][q] * f;
        __syncthreads();
#pragma unroll 1
        for (int rr = 0; rr < 16; ++rr) { const int row = 16 * F.wave + rr;
            const float a0 = EX[row * 129 + F.lane] - EX[128 * 129 + row * 129 + F.lane], a1 = EX[row * 129 + 64 + F.lane] - EX[128 * 129 + row * 129 + 64 + F.lane];
            const float rstd = (1.0f - LAMBDA_INIT) / sqrtf(wave_sum(a0 * a0 + a1 * a1) * (1.f / 128.f) + EPS);
            bf16* yr = Y + (size_t)(qrow0 + row) * D + h * 128;
            yr[F.lane] = (bf16)(pk2(a0 * rstd * ng[F.lane], 0.f) & 0xffffu); yr[64 + F.lane] = (bf16)(pk2(a1 * rstd * ng[64 + F.lane], 0.f) & 0xffffu); }
        __syncthreads();
    }
}

constexpr int PD_BYTES = 12800, PD_ATT = 6144, PD_EG = 12288, PD_EW = 12544;
__device__ __forceinline__ unsigned off_a(unsigned row, unsigned ch) { return 2048u * (row >> 3) + 512u * (ch >> 2) + 64u * (row & 7) + 16u * ((ch & 3) ^ ((row >> 2) & 3)); }
__device__ __forceinline__ int frag_off(int c, int s) {
    const int slot = (c >> 5) == (s >> 5) ? ((c >> 5) ? 2 : 0) : 1, s2 = (s & 31) >> 4, hh = ((s & 15) >> 2) & 1, jj = ((s & 15) >> 3) * 4 + (s & 3), r = c & 31;
    return slot * 2048 + s2 * 1024 + (hh * 32 + r) * 16 + jj * 2;
}
__device__ __forceinline__ void step_gdn_prep(int j, bool dry = false, int skip = 0) {
    const Frame F = make_frame();
    LAS float* STG = (LAS float*)F.lds;
    LAS float* KK = (LAS float*)F.lds;
    LAS float* QK = KK + 64 * 68;
    LAS float* LP = (LAS float*)(F.lds + 34816);
    LAS float* TS = (LAS float*)(F.lds + 67584);
    LAS unsigned char* QI = F.lds + 102400; LAS unsigned char* KI = F.lds + 118784;
    LAS float* SM = (LAS float*)(F.lds + 135168);
    bf16* Z = (bf16*)(F.ws + WS_Z); const float* AB = (const float*)(F.ws + WS_AB); const bf16* HALO = (const bf16*)(F.ws + WS_HALO); unsigned char* PD = F.ws + WS_PD;
    const float* cw = INP(I_GCONV) + (size_t)j * 3 * 3072;
    const int r = F.lane & 31, hi = F.lane >> 5;
    for (int it = F.bid; it < NB * NH * 132; it += F.G) {
        const int n = it % 132, bh = it / 132, b = bh >> 3, h = bh & 7;
        const bool isctx = n < 4; const int L = isctx ? CT : T; const int t0 = isctx ? 64 * n : 64 * (n - 4); const int row0 = (isctx ? ML + b * CT : b * T) + t0;
        if (F.tid < 384) {
            const int g8 = F.tid % 48, rp = F.tid / 48, part = g8 >> 4, e0 = (g8 & 15) * 8; const int col = part * 1024 + h * 128 + e0;
            const float* wp = cw + col;
            f32x4 wt[3][2];
#pragma unroll
            for (int tap = 0; tap < 3; ++tap) { wt[tap][0] = *(const f32x4*)(wp + tap * 3072); wt[tap][1] = *(const f32x4*)(wp + tap * 3072 + 4); }
            u32x4 zr[10];
#pragma unroll
            for (int ri = 0; ri < 10; ++ri) { const int c = 8 * rp - 1 + ri; const int t = t0 + c;
                const bf16* src = c < 0 ? HALO + ((size_t)((row0 >> 6) - 1) * 2 + 1) * 3072 + col : (c > 63 ? HALO + ((size_t)((row0 >> 6) + 1) * 2) * 3072 + col : Z + (size_t)(row0 + c) * 4096 + col);
                const bool valid = t >= 0 && t < L;
                if (!valid) src = Z + (size_t)row0 * 4096 + col;
                zr[ri] = *(const u32x4*)src; if (!valid) zr[ri] = (u32x4){0u, 0u, 0u, 0u}; }
#pragma unroll
            for (int i = 0; i < 8; ++i) { float o[8];
#pragma unroll
                for (int q = 0; q < 4; ++q) { const unsigned a = zr[i][q], bq = zr[i + 1][q], cq = zr[i + 2][q];
                    o[2 * q] = silu_fast(wt[0][q >> 1][2 * (q & 1)] * bf2f(a & 0xffffu) + wt[1][q >> 1][2 * (q & 1)] * bf2f(bq & 0xffffu) + wt[2][q >> 1][2 * (q & 1)] * bf2f(cq & 0xffffu));
                    o[2 * q + 1] = silu_fast(wt[0][q >> 1][2 * (q & 1) + 1] * bf2f(a >> 16) + wt[1][q >> 1][2 * (q & 1) + 1] * bf2f(bq >> 16) + wt[2][q >> 1][2 * (q & 1) + 1] * bf2f(cq >> 16)); }
                LAS f32x4* dst = (LAS f32x4*)(STG + (8 * rp + i) * 388 + part * 128 + e0); dst[0] = (f32x4){o[0], o[1], o[2], o[3]}; dst[1] = (f32x4){o[4], o[5], o[6], o[7]}; }
        }
        if (F.wave >= 6) {
            const int d = F.wave - 6, c = F.lane; const size_t row = (size_t)(row0 + c);
            const float Aco = expf(INP(I_GALOG)[j * 16 + d * 8 + h]), dtb = INP(I_GDT)[j * 16 + d * 8 + h];
            const float x = AB[row * 32 + d * 8 + h] + dtb, bb = AB[row * 32 + 16 + d * 8 + h];
            const float sp = x > 20.f ? x : log1pf(expf(x));
            float s = -Aco * sp;
#pragma unroll
            for (int o = 1; o < 64; o <<= 1) { const float up = __shfl_up(s, o), dn = __shfl_down(s, o); if (d ? (c + o < 64) : (c >= o)) s += d ? dn : up; }
            SM[d * 64 + c] = 1.f / (1.f + expf(-bb)); SM[128 + d * 64 + c] = s;
        }
        __syncthreads();
        if (skip & 8) continue;
        { float qv[8][2], kv[8][2], sq[8], sk[8];
#pragma unroll
            for (int rr = 0; rr < 8; ++rr) { const LAS float* sr = STG + (F.wave * 8 + rr) * 388;
                qv[rr][0] = sr[F.lane]; qv[rr][1] = sr[64 + F.lane]; kv[rr][0] = sr[128 + F.lane]; kv[rr][1] = sr[192 + F.lane];
                sq[rr] = qv[rr][0] * qv[rr][0] + qv[rr][1] * qv[rr][1]; sk[rr] = kv[rr][0] * kv[rr][0] + kv[rr][1] * kv[rr][1]; }
#pragma unroll
            for (int o = 1; o < 64; o <<= 1) {
#pragma unroll
                for (int rr = 0; rr < 8; ++rr) { sq[rr] += __shfl_xor(sq[rr], o); sk[rr] += __shfl_xor(sk[rr], o); } }
#pragma unroll
            for (int rr = 0; rr < 8; ++rr) { const int c = F.wave * 8 + rr; const LAS float* sr = STG + c * 388;
                const float fq = 0.08838834764831845f / sqrtf(sq[rr] + EPS), fk = 1.0f / sqrtf(sk[rr] + EPS);
                const unsigned o0 = off_a(c, F.lane >> 3) + 2 * (F.lane & 7), o1 = off_a(c, 8 + (F.lane >> 3)) + 2 * (F.lane & 7);
                *(LAS bf16*)(QI + o0) = (bf16)(pk2(qv[rr][0] * fq, 0.f) & 0xffffu); *(LAS bf16*)(QI + o1) = (bf16)(pk2(qv[rr][1] * fq, 0.f) & 0xffffu);
                *(LAS bf16*)(KI + o0) = (bf16)(pk2(kv[rr][0] * fk, 0.f) & 0xffffu); *(LAS bf16*)(KI + o1) = (bf16)(pk2(kv[rr][1] * fk, 0.f) & 0xffffu);
                bf16* vd = Z + (size_t)(row0 + c) * 4096 + 2048 + h * 128;
                if (!dry) { vd[F.lane] = (bf16)(pk2(sr[256 + F.lane], 0.f) & 0xffffu); vd[64 + F.lane] = (bf16)(pk2(sr[320 + F.lane], 0.f) & 0xffffu); } } }
        __syncthreads();
        if (skip & 4) continue;
        { const int prod = F.wave >> 2, mt = (F.wave >> 1) & 1, nt = F.wave & 1; LAS unsigned char* AI = prod ? QI : KI;
            f32x16 acc;
#pragma unroll
            for (int i = 0; i < 16; ++i) acc[i] = 0.f;
#pragma unroll
            for (int ks = 0; ks < 8; ++ks) { const bf16x8 a = *(const LAS bf16x8*)(AI + off_a(32 * mt + r, 2 * ks + hi)), bq = *(const LAS bf16x8*)(KI + off_a(32 * nt + r, 2 * ks + hi));
                acc = __builtin_amdgcn_mfma_f32_32x32x16_bf16(a, bq, acc, 0, 0, 0); }
            LAS float* dst = prod ? QK : KK;
#pragma unroll
            for (int i = 0; i < 16; ++i) dst[(32 * mt + crow(i, hi)) * 68 + 32 * nt + r] = acc[i]; }
        __syncthreads();
        if (skip & 2) continue;
        for (int idx = F.tid; idx < 8192; idx += NTHR) { const int d = idx >> 12, p = (idx >> 6) & 63, ps = idx & 63; float val = 0.f;
            if (ps < p) { const int c = d ? 63 - p : p, s = d ? 63 - ps : ps; val = SM[d * 64 + c] * KK[c * 68 + s] * expf(SM[128 + d * 64 + c] - SM[128 + d * 64 + s]); }
            LP[idx] = val; }
        __syncthreads();
        unsigned char* rec = PD + ((size_t)((b * 8 + h) * 132 + n)) * PD_BYTES;
        constexpr size_t DSTRIDE = (size_t)16 * 132 * PD_BYTES;
        if (F.wave < 2) { if (!(skip & 1)) {
            const int d = F.wave, jc = F.lane;
            float Lr[64], Tc[64];
#pragma unroll
            for (int p = 1; p < 64; ++p) Lr[p] = LP[d * 4096 + p * 64 + F.lane];
#pragma unroll
            for (int p = 0; p < 64; ++p) { float acc[4]; acc[0] = (p == jc) ? 1.f : 0.f; acc[1] = 0.f; acc[2] = 0.f; acc[3] = 0.f;
#pragma unroll
                for (int sx = 0; sx < p; ++sx) { const float l = __int_as_float(__builtin_amdgcn_readlane(__float_as_int(Lr[p]), sx)); acc[sx & 3] -= l * Tc[sx]; }
                Tc[p] = (acc[0] + acc[1]) + (acc[2] + acc[3]); }
            const int s = d ? 63 - jc : jc;
#pragma unroll
            for (int p = 0; p < 64; ++p) TS[d * 4352 + (d ? 63 - p : p) * 68 + s] = Tc[p]; }
        } else {
            for (int q = F.tid - 128; q < 768; q += NTHR - 128) { const int d = q / 384, qq = q % 384, slot = qq >> 7, s2 = (qq >> 6) & 1, ln = qq & 63, hh = ln >> 5, rr = ln & 31;
                const int mtr = slot == 0 ? 0 : (slot == 2 ? 1 : (d ? 0 : 1)), mtc = slot == 0 ? 0 : (slot == 2 ? 1 : (d ? 1 : 0));
                const int c = 32 * mtr + rr, sa = 32 * mtc + 16 * s2 + 4 * hh; const float gcc = SM[128 + d * 64 + c];
                const f32x4 qa = *(const LAS f32x4*)(QK + c * 68 + sa), qb = *(const LAS f32x4*)(QK + c * 68 + sa + 8);
                const f32x4 ga = *(const LAS f32x4*)(SM + 128 + d * 64 + sa), gb = *(const LAS f32x4*)(SM + 128 + d * 64 + sa + 8);
                float v[8];
#pragma unroll
                for (int i = 0; i < 4; ++i) { const int s0 = sa + i, s1 = sa + 8 + i; const bool m0 = d ? (s0 >= c) : (s0 <= c), m1 = d ? (s1 >= c) : (s1 <= c);
                    v[i] = m0 ? qa[i] * expf(gcc - ga[i]) : 0.f; v[4 + i] = m1 ? qb[i] * expf(gcc - gb[i]) : 0.f; }
                if (!dry) *(u32x4*)(rec + d * DSTRIDE + PD_ATT + qq * 16) = (u32x4){pk2(v[0], v[1]), pk2(v[2], v[3]), pk2(v[4], v[5]), pk2(v[6], v[7])}; }
            if (F.tid >= 128 && F.tid < 256) { const int d = (F.tid - 128) >> 6, c = F.tid & 63; const float gl = SM[128 + d * 64 + (d ? 0 : 63)], gcv = SM[128 + d * 64 + c];
                if (!dry) { *(float*)(rec + d * DSTRIDE + PD_EG + 4 * c) = expf(gcv); *(float*)(rec + d * DSTRIDE + PD_EW + 4 * c) = expf(gl - gcv); } }
        }
        __syncthreads();
        for (int q = F.tid; q < 768; q += NTHR) { const int d = q / 384, qq = q % 384, slot = qq >> 7, s2 = (qq >> 6) & 1, ln = qq & 63, hh = ln >> 5, rr = ln & 31;
            const int mtr = slot == 0 ? 0 : (slot == 2 ? 1 : (d ? 0 : 1)), mtc = slot == 0 ? 0 : (slot == 2 ? 1 : (d ? 1 : 0));
            const int c = 32 * mtr + rr, sa = 32 * mtc + 16 * s2 + 4 * hh;
            const f32x4 ta = *(const LAS f32x4*)(TS + d * 4352 + c * 68 + sa), tb = *(const LAS f32x4*)(TS + d * 4352 + c * 68 + sa + 8);
            const f32x4 ba = *(const LAS f32x4*)(SM + d * 64 + sa), bb = *(const LAS f32x4*)(SM + d * 64 + sa + 8);
            if (!dry) *(u32x4*)(rec + d * DSTRIDE + qq * 16) = (u32x4){pk2(ta[0] * ba[0], ta[1] * ba[1]), pk2(ta[2] * ba[2], ta[3] * ba[3]), pk2(tb[0] * bb[0], tb[1] * bb[1]), pk2(tb[2] * bb[2], tb[3] * bb[3])}; }
        if (!dry) for (int idx = F.tid; idx < 2048; idx += NTHR) { const int img = idx >> 10, pn = idx & 1023;
            *(u32x4*)((unsigned char*)(Z + (size_t)(row0 + (pn >> 4)) * 4096 + img * 1024 + h * 128) + (pn & 15) * 16) = *(const LAS u32x4*)((img ? KI : QI) + pn * 16); }
        __syncthreads();
    }
}

#define PACK8(x, b) __builtin_bit_cast(bf16x8, (u32x4){pk2((x)[(b)], (x)[(b) + 1]), pk2((x)[(b) + 2], (x)[(b) + 3]), pk2((x)[(b) + 4], (x)[(b) + 5]), pk2((x)[(b) + 6], (x)[(b) + 7])})
#define MFMA32(a, b, c) __builtin_amdgcn_mfma_f32_32x32x16_bf16((a), (b), (c), 0, 0, 0)
typedef short v4i16_t __attribute__((ext_vector_type(4)));
__device__ __forceinline__ void step_convert_rest() {
    const Frame F = make_frame();
    if (F.bid >= 32 && F.G > 32)
        convert_weights(F.ws, 0xffffu & ~((1u << 0) | (1u << 4) | (1u << 8) | (1u << 10)), (F.bid - 32) * NWAVES + F.wave, (F.G - 32) * NWAVES, (F.bid - 32) * NTHR + F.tid, (F.G - 32) * NTHR, F.lds, F.wave, F.lane);
}
__device__ __forceinline__ void step_gdn_scan2() {
    const Frame F = make_frame();
    constexpr int BUF = 61952, B_K = 0, B_Q = 16384, B_V = 32768, B_PD = 49152;
    const bf16* Z = (const bf16*)(F.ws + WS_Z); const unsigned char* PD = F.ws + WS_PD;
    const int r = F.lane & 31, hi = F.lane >> 5;
    for (int it = F.bid; it < 32; it += F.G) {
        const int b = it >> 4, h = (it >> 1) & 7, dir = it & 1;
        const unsigned char* pdb = PD + (size_t)(((dir * 2 + b) * 8 + h) * 132) * PD_BYTES;
#define CHUNK_OF(sp) (dir ? ((sp) < 4 ? 3 - (sp) : 135 - (sp)) : (sp))
#define ROW0_OF(n) ((n) < 4 ? ML + b * CT + 64 * (n) : b * T + 64 * ((n) - 4))
        if (F.wave >= 4) {
            const int lt = F.tid - 256;
            u32x4 rg[16];
#define LOAD_CHUNK(sp) do { const int n_ = CHUNK_OF(sp); const int row0_ = ROW0_OF(n_); \
                _Pragma("unroll") for (int i = 0; i < 4; ++i) { const int pn = lt + 256 * i; const unsigned char* src = (const unsigned char*)(Z + (size_t)(row0_ + (pn >> 4)) * 4096 + h * 128) + (pn & 15) * 16; \
                    rg[i] = *(const u32x4*)(src + 2048); rg[4 + i] = *(const u32x4*)src; rg[8 + i] = *(const u32x4*)(src + 4096); \
                    rg[12 + i] = pn < 800 ? *(const u32x4*)(pdb + (size_t)n_ * PD_BYTES + pn * 16) : (u32x4){0u, 0u, 0u, 0u}; } } while (0)
#define WRITE_CHUNK(bufb) do { LAS unsigned char* base_ = F.lds + (bufb); \
                _Pragma("unroll") for (int i = 0; i < 4; ++i) { const int pn = lt + 256 * i; *(LAS u32x4*)(base_ + B_K + pn * 16) = rg[i]; *(LAS u32x4*)(base_ + B_Q + pn * 16) = rg[4 + i]; \
                    *(LAS u32x4*)(base_ + B_V + pn * 16) = rg[8 + i]; if (pn < 800) *(LAS u32x4*)(base_ + B_PD + pn * 16) = rg[12 + i]; } } while (0)
            LOAD_CHUNK(0); WRITE_CHUNK(0); LOAD_CHUNK(1);
            __syncthreads();
            for (int sp = 0; sp < 132; ++sp) {
                if (sp + 1 < 132) WRITE_CHUNK(((sp + 1) & 1) * BUF);
                if (sp + 2 < 132) LOAD_CHUNK(sp + 2);
                __syncthreads();
            }
#undef LOAD_CHUNK
#undef WRITE_CHUNK
        } else {
            const int w = F.wave;
            f32x16 S[4];
#pragma unroll
            for (int kt = 0; kt < 4; ++kt)
#pragma unroll
                for (int i = 0; i < 16; ++i) S[kt][i] = 0.f;
            const int x = (r >> 2) & 3; const int rowb = 2048 * (r >> 3) + 64 * (r & 7);
            int oa[2], ob[2];
#pragma unroll
            for (int s2 = 0; s2 < 2; ++s2) { oa[s2] = rowb + 16 * ((2 * s2) ^ x) + 8 * hi; ob[s2] = rowb + 16 * ((2 * s2 + 1) ^ x) + 8 * hi; }
            const int blk = (F.lane >> 4) & 1, q = (F.lane & 15) >> 2, p = F.lane & 3, cb = 2 * blk + (p >> 1);
            int trb[2];
#pragma unroll
            for (int t = 0; t < 2; ++t) trb[t] = 64 * (4 * hi + q) + 8 * (p & 1) + 16 * (cb ^ ((2 * t + hi) & 3)) + 2048 * t;
            const int vb = 4 * hi * 256 + (32 * w + r) * 2;
            __syncthreads();
            for (int sp = 0; sp < 132; ++sp) {
                const int n = CHUNK_OF(sp); const int row0 = ROW0_OF(n);
                LAS unsigned char* B = F.lds + (sp & 1) * BUF;
                LAS unsigned char* KI = B + B_K; LAS unsigned char* QI = B + B_Q; LAS unsigned char* VI = B + B_V; LAS unsigned char* PR = B + B_PD;
                bf16x8 Sb[4][2];
#pragma unroll
                for (int kt = 0; kt < 4; ++kt) { Sb[kt][0] = PACK8(S[kt], 0); Sb[kt][1] = PACK8(S[kt], 8); }
                f32x16 KS[2];
#pragma unroll
                for (int mt = 0; mt < 2; ++mt) {
#pragma unroll
                    for (int i = 0; i < 16; ++i) KS[mt][i] = 0.f;
#pragma unroll
                    for (int kt = 0; kt < 4; ++kt)
#pragma unroll
                        for (int s2 = 0; s2 < 2; ++s2) {
                            const s16x4 k0 = *(const LAS s16x4*)(KI + 8192 * mt + 512 * kt + oa[s2]), k1 = *(const LAS s16x4*)(KI + 8192 * mt + 512 * kt + ob[s2]);
                            KS[mt] = MFMA32(((bf16x8){k0[0], k0[1], k0[2], k0[3], k1[0], k1[1], k1[2], k1[3]}), Sb[kt][s2], KS[mt]); }
                    asm volatile("" ::: "memory");
                }
                bf16x8 Rb[2][2];
#pragma unroll
                for (int mt = 0; mt < 2; ++mt) { f32x16 R;
#pragma unroll
                    for (int g = 0; g < 4; ++g) { const f32x4 e4 = *(const LAS f32x4*)(PR + PD_EG + 4 * (32 * mt + 8 * g + 4 * hi));
#pragma unroll
                        for (int i = 0; i < 4; ++i) { const float v = bf2f(*(const LAS bf16*)(VI + vb + (32 * mt + 8 * g + i) * 256)); R[4 * g + i] = v - e4[i] * KS[mt][4 * g + i]; } }
                    Rb[mt][0] = PACK8(R, 0); Rb[mt][1] = PACK8(R, 8); }
                f32x16 vn[2], o[2];
#pragma unroll
                for (int i = 0; i < 16; ++i) { vn[0][i] = 0.f; vn[1][i] = 0.f; }
#define TFR(base, slot, s2) (*(const LAS bf16x8*)(PR + (base) + (slot) * 2048 + (s2) * 1024 + F.lane * 16))
                vn[0] = MFMA32(TFR(0, 0, 0), Rb[0][0], vn[0]); vn[0] = MFMA32(TFR(0, 0, 1), Rb[0][1], vn[0]);
                vn[1] = MFMA32(TFR(0, 2, 0), Rb[1][0], vn[1]); vn[1] = MFMA32(TFR(0, 2, 1), Rb[1][1], vn[1]);
                if (dir) { vn[0] = MFMA32(TFR(0, 1, 0), Rb[1][0], vn[0]); vn[0] = MFMA32(TFR(0, 1, 1), Rb[1][1], vn[0]); }
                else     { vn[1] = MFMA32(TFR(0, 1, 0), Rb[0][0], vn[1]); vn[1] = MFMA32(TFR(0, 1, 1), Rb[0][1], vn[1]); }
                asm volatile("" ::: "memory");
                f32x16 QS[2];
#pragma unroll
                for (int mt = 0; mt < 2; ++mt) {
#pragma unroll
                    for (int i = 0; i < 16; ++i) QS[mt][i] = 0.f;
#pragma unroll
                    for (int kt = 0; kt < 4; ++kt)
#pragma unroll
                        for (int s2 = 0; s2 < 2; ++s2) {
                            const s16x4 q0 = *(const LAS s16x4*)(QI + 8192 * mt + 512 * kt + oa[s2]), q1 = *(const LAS s16x4*)(QI + 8192 * mt + 512 * kt + ob[s2]);
                            QS[mt] = MFMA32(((bf16x8){q0[0], q0[1], q0[2], q0[3], q1[0], q1[1], q1[2], q1[3]}), Sb[kt][s2], QS[mt]); }
                    asm volatile("" ::: "memory");
                }
                bf16x8 Vb[2][2], Wb[2][2];
#pragma unroll
                for (int mt = 0; mt < 2; ++mt) { f32x16 W;
#pragma unroll
                    for (int g = 0; g < 4; ++g) { const f32x4 e4 = *(const LAS f32x4*)(PR + PD_EG + 4 * (32 * mt + 8 * g + 4 * hi)), w4 = *(const LAS f32x4*)(PR + PD_EW + 4 * (32 * mt + 8 * g + 4 * hi));
#pragma unroll
                        for (int i = 0; i < 4; ++i) { o[mt][4 * g + i] = e4[i] * QS[mt][4 * g + i]; W[4 * g + i] = w4[i] * vn[mt][4 * g + i]; } }
                    Vb[mt][0] = PACK8(vn[mt], 0); Vb[mt][1] = PACK8(vn[mt], 8); Wb[mt][0] = PACK8(W, 0); Wb[mt][1] = PACK8(W, 8); }
                o[0] = MFMA32(TFR(PD_ATT, 0, 0), Vb[0][0], o[0]); o[0] = MFMA32(TFR(PD_ATT, 0, 1), Vb[0][1], o[0]);
                o[1] = MFMA32(TFR(PD_ATT, 2, 0), Vb[1][0], o[1]); o[1] = MFMA32(TFR(PD_ATT, 2, 1), Vb[1][1], o[1]);
                if (dir) { o[0] = MFMA32(TFR(PD_ATT, 1, 0), Vb[1][0], o[0]); o[0] = MFMA32(TFR(PD_ATT, 1, 1), Vb[1][1], o[0]); }
                else     { o[1] = MFMA32(TFR(PD_ATT, 1, 0), Vb[0][0], o[1]); o[1] = MFMA32(TFR(PD_ATT, 1, 1), Vb[0][1], o[1]); }
#undef TFR
                asm volatile("" ::: "memory");
                const float cd = *(const LAS float*)(PR + PD_EG + 4 * (dir ? 0 : 63));
#pragma unroll
                for (int kt = 0; kt < 4; ++kt) {
#pragma unroll
                    for (int i = 0; i < 16; ++i) S[kt][i] *= cd;
#pragma unroll
                    for (int mt = 0; mt < 2; ++mt)
#pragma unroll
                        for (int s2 = 0; s2 < 2; ++s2) {
                            const s16x4 a0 = __builtin_bit_cast(s16x4, __builtin_amdgcn_ds_read_tr16_b64_v4i16((LAS v4i16_t*)(KI + 8192 * mt + 4096 * s2 + 512 * kt + trb[0])));
                            const s16x4 a1 = __builtin_bit_cast(s16x4, __builtin_amdgcn_ds_read_tr16_b64_v4i16((LAS v4i16_t*)(KI + 8192 * mt + 4096 * s2 + 512 * kt + trb[1])));
                            S[kt] = MFMA32(((bf16x8){a0[0], a0[1], a0[2], a0[3], a1[0], a1[1], a1[2], a1[3]}), Wb[mt][s2], S[kt]); }
                    asm volatile("" ::: "memory");
                }
                { bf16* ob_ = n < 4 ? (bf16*)(F.ws + WS_OFC) + ((size_t)dir * MC + (row0 - ML)) * D : (bf16*)F.out + ((size_t)dir * ML + row0) * D;
                    bf16* oc = ob_ + h * 128 + 32 * w + r;
#pragma unroll
                    for (int mt = 0; mt < 2; ++mt)
#pragma unroll
                        for (int i = 0; i < 16; ++i) oc[(size_t)(32 * mt + crow(i, hi)) * D] = (bf16)(pk2(o[mt][i], 0.f) & 0xffffu); }
                __syncthreads();
            }
        }
#undef CHUNK_OF
#undef ROW0_OF
    }
}
__device__ __forceinline__ void step_gdn_norm2(int j) {
    const Frame F = make_frame();
    const int gw = F.bid * NWAVES + F.wave, NGW = F.G * NWAVES;
    const bf16* Z = (const bf16*)(F.ws + WS_Z); bf16* Y = (bf16*)(F.ws + WS_Y); const float* ng = INP(I_GNG) + j * 128;
    for (int row = gw; row < M; row += NGW) {
        const bf16* of = row < ML ? (const bf16*)F.out + (size_t)row * D : (const bf16*)(F.ws + WS_OFC) + (size_t)(row - ML) * D;
        const bf16* ob = row < ML ? of + (size_t)ML * D : of + (size_t)MC * D;
        const u32x4* f4 = (const u32x4*)(of + 16 * F.lane); const u32x4* b4 = (const u32x4*)(ob + 16 * F.lane);
        float v[16]; float ss = 0.f;
#pragma unroll
        for (int q = 0; q < 2; ++q) { const u32x4 a = f4[q], bq = b4[q];
#pragma unroll
            for (int i = 0; i < 4; ++i) { const float x0 = bf2f(a[i] & 0xffffu) + bf2f(bq[i] & 0xffffu), x1 = bf2f(a[i] >> 16) + bf2f(bq[i] >> 16); v[8 * q + 2 * i] = x0; v[8 * q + 2 * i + 1] = x1; ss += x0 * x0 + x1 * x1; } }
        ss += __shfl_xor(ss, 1); ss += __shfl_xor(ss, 2); ss += __shfl_xor(ss, 4);
        const float rstd = 1.0f / sqrtf(ss * (1.f / 128.f) + EPS);
        const u32x4* g4 = (const u32x4*)(Z + (size_t)row * 4096 + 3072 + 16 * F.lane);
        const int e0 = (16 * F.lane) & 127;
        u32x4 o[2];
#pragma unroll
        for (int q = 0; q < 2; ++q) { const u32x4 gz = g4[q]; unsigned wv[4];
#pragma unroll
            for (int i = 0; i < 4; ++i) { const unsigned gg = gz[i]; const float g0 = bf2f(gg & 0xffffu), g1 = bf2f(gg >> 16); const int e = e0 + 8 * q + 2 * i;
                wv[i] = pk2(v[8 * q + 2 * i] * rstd * ng[e] * silu_f(g0), v[8 * q + 2 * i + 1] * rstd * ng[e + 1] * silu_f(g1)); }
            o[q] = (u32x4){wv[0], wv[1], wv[2], wv[3]}; }
        u32x4* dst = (u32x4*)(Y + (size_t)row * D + 16 * F.lane); dst[0] = o[0]; dst[1] = o[1];
    }
}

__device__ __forceinline__ void step_rope2() {
    const Frame F = make_frame();
    const int gw = F.bid * NWAVES + F.wave, NGW = F.G * NWAVES;
    bf16* Z = (bf16*)(F.ws + WS_Z); const f32x4* R = (const f32x4*)(F.ws + WS_ROPE);
    for (int row = gw; row < M; row += NGW) {
        u32x4* p = (u32x4*)(Z + (size_t)row * 3072 + 32 * F.lane);
        u32x4 v[4];
#pragma unroll
        for (int q = 0; q < 4; ++q) v[q] = p[q];
        const bool lat = row < ML; const float sc = F.lane < 32 ? QSCALE : 1.0f;
        const f32x4* tab = R + ((size_t)(row & (T - 1)) * 32 + 16 * (F.lane & 1)) / 2;
#pragma unroll
        for (int q = 0; q < 4; ++q) {
#pragma unroll
            for (int i = 0; i < 4; i += 2) {
                f32x4 cs = (f32x4){1.f, 0.f, 1.f, 0.f}; if (lat) cs = tab[(4 * q + i) / 2];
                { const unsigned w = v[q][i]; const float x0 = bf2f(w & 0xffffu), x1 = bf2f(w >> 16); v[q][i] = pk2((x0 * cs.x - x1 * cs.y) * sc, (x0 * cs.y + x1 * cs.x) * sc); }
                { const unsigned w = v[q][i + 1]; const float x0 = bf2f(w & 0xffffu), x1 = bf2f(w >> 16); v[q][i + 1] = pk2((x0 * cs.z - x1 * cs.w) * sc, (x0 * cs.w + x1 * cs.z) * sc); }
            }
        }
#pragma unroll
        for (int q = 0; q < 4; ++q) p[q] = v[q];
    }
}
__device__ __forceinline__ void step_attn2() {
    const Frame F = make_frame();
    const bf16* Z = (const bf16*)(F.ws + WS_Z); bf16* Y = (bf16*)(F.ws + WS_Y);
    LAS float* EX = (LAS float*)F.lds;
    const int r = F.lane & 31, hi = F.lane >> 5, qs = F.wave & 3, m = F.wave >> 2;
    float lmb;
    { const float* lam = INP(I_DLAM); const float t1 = lam[F.lane] * lam[64 + F.lane], t2 = lam[128 + F.lane] * lam[192 + F.lane]; lmb = expf(wave_sum(t1)) - expf(wave_sum(t2)) + LAMBDA_INIT; }
    const float* ng = INP(I_DNG);
    const int kro = 2048 * (r >> 3) + 64 * (r & 7); const int xk = (r >> 2) & 3;
    int koff[4];
#pragma unroll
    for (int d0 = 0; d0 < 4; ++d0) koff[d0] = kro + 512 * (2 * m + (d0 >> 1)) + 16 * (((2 * d0 + hi) & 3) ^ xk);
    const int blk = (F.lane >> 4) & 1, q4 = (F.lane & 15) >> 2, p4 = F.lane & 3, cb = 2 * blk + (p4 >> 1);
    int trb[2];
#pragma unroll
    for (int t = 0; t < 2; ++t) trb[t] = 64 * (4 * hi + q4) + 8 * (p4 & 1) + 16 * (cb ^ ((2 * t + hi) & 3)) + 2048 * t;
    int srow[4], sdst[4], scol[4];
#pragma unroll
    for (int i = 0; i < 4; ++i) { const int p = F.tid + 512 * i, img = p >> 10, pn = p & 1023; srow[i] = pn >> 4; scol[i] = 1024 + img * 1024 + (pn & 15) * 8; sdst[i] = img * 16384 + (int)off_a(pn >> 4, pn & 15); }
    const int xcd = F.bid & 7, cux = F.bid >> 3;
    for (int ui = 0; ui < 5; ++ui) {
        int b, h, qrow0, nt;
        if (F.G == 256) {
            h = xcd;
            if (ui < 4) { b = ui >> 1; qrow0 = b * T + (cux + 32 * (ui & 1)) * 128; nt = NKV / 64; }
            else { if (cux >= 4) break; b = cux >> 1; qrow0 = ML + b * CT + (cux & 1) * 128; nt = CT / 64; }
        } else {
            const int u = F.bid + ui * F.G; if (ui >= 5 || u >= 1056) break;
            if (u < 1024) { b = u >> 9; h = (u >> 6) & 7; qrow0 = b * T + (u & 63) * 128; nt = NKV / 64; }
            else { const int v = u - 1024; b = v >> 4; h = (v >> 1) & 7; qrow0 = ML + b * CT + (v & 1) * 128; nt = CT / 64; }
        }
        const int row0 = qrow0 + 32 * qs;
        bf16x8 qf[4];
#pragma unroll
        for (int d0 = 0; d0 < 4; ++d0) qf[d0] = *(const bf16x8*)(Z + (size_t)(row0 + r) * 3072 + h * 128 + m * 64 + d0 * 16 + hi * 8);
        const bf16* kvb = Z + h * 128;
#define KVROW(t) ((t) < CT / 64 ? ML + b * CT + 64 * (t) : b * T + 64 * (t) - CT)
        u32x4 rg[4];
#define LOAD_TILE(t) do { const int kr_ = KVROW(t); _Pragma("unroll") for (int i = 0; i < 4; ++i) rg[i] = *(const u32x4*)(kvb + (size_t)(kr_ + srow[i]) * 3072 + scol[i]); } while (0)
#define WRITE_TILE(bufb) do { _Pragma("unroll") for (int i = 0; i < 4; ++i) *(LAS u32x4*)(F.lds + (bufb) + sdst[i]) = rg[i]; } while (0)
        LOAD_TILE(0); WRITE_TILE(0); if (nt > 1) LOAD_TILE(1);
        f32x16 o[4];
#pragma unroll
        for (int i = 0; i < 4; ++i)
#pragma unroll
            for (int q = 0; q < 16; ++q) o[i][q] = 0.f;
        float mref = 0.f, l = 0.f;
        __syncthreads();
        for (int t = 0; t < nt; ++t) {
            if (t + 1 < nt) WRITE_TILE(((t + 1) & 1) * 32768);
            if (t + 2 < nt) LOAD_TILE(t + 2);
            LAS unsigned char* KI = F.lds + (t & 1) * 32768; LAS unsigned char* VI = KI + 16384;
            f32x16 p0, p1;
#pragma unroll
            for (int q = 0; q < 16; ++q) { p0[q] = 0.f; p1[q] = 0.f; }
#pragma unroll
            for (int d0 = 0; d0 < 4; ++d0) { const bf16x8 k0 = *(const LAS bf16x8*)(KI + koff[d0]), k1 = *(const LAS bf16x8*)(KI + 8192 + koff[d0]);
                p0 = MFMA32(k0, qf[d0], p0); p1 = MFMA32(k1, qf[d0], p1); }
            float mx = fmaxf(p0[0], p1[0]);
#pragma unroll
            for (int q = 1; q < 16; ++q) mx = fmaxf(mx, fmaxf(p0[q], p1[q]));
            mx = fmaxf(mx, __shfl_xor(mx, 32));
            if (t == 0) mref = mx;
            else if (__any(mx > mref)) { const float mn = fmaxf(mref, mx); const float al = __builtin_amdgcn_exp2f(mref - mn); l *= al; mref = mn;
#pragma unroll
                for (int i = 0; i < 4; ++i)
#pragma unroll
                    for (int q = 0; q < 16; ++q) o[i][q] *= al; }
            float ps = 0.f;
#pragma unroll
            for (int q = 0; q < 16; ++q) { p0[q] = __builtin_amdgcn_exp2f(p0[q] - mref); p1[q] = __builtin_amdgcn_exp2f(p1[q] - mref); ps += p0[q] + p1[q]; }
            l += ps;
            bf16x8 pf[2][2];
            pf[0][0] = PACK8(p0, 0); pf[0][1] = PACK8(p0, 8); pf[1][0] = PACK8(p1, 0); pf[1][1] = PACK8(p1, 8);
#pragma unroll
            for (int i = 0; i < 4; ++i) {
#pragma unroll
                for (int kh = 0; kh < 2; ++kh)
#pragma unroll
                    for (int s2 = 0; s2 < 2; ++s2) {
                        const s16x4 a0 = __builtin_bit_cast(s16x4, __builtin_amdgcn_ds_read_tr16_b64_v4i16((LAS v4i16_t*)(VI + 8192 * kh + 4096 * s2 + 512 * i + trb[0])));
                        const s16x4 a1 = __builtin_bit_cast(s16x4, __builtin_amdgcn_ds_read_tr16_b64_v4i16((LAS v4i16_t*)(VI + 8192 * kh + 4096 * s2 + 512 * i + trb[1])));
                        o[i] = MFMA32(((bf16x8){a0[0], a0[1], a0[2], a0[3], a1[0], a1[1], a1[2], a1[3]}), pf[kh][s2], o[i]); }
            }
            __syncthreads();
        }
#undef LOAD_TILE
#undef WRITE_TILE
#undef KVROW
        l += __shfl_xor(l, 32);
        const float f = (m == 1 ? lmb : 1.0f) / l;
        LAS float* ex = EX + (size_t)m * 128 * 129 + (qs * 32 + r) * 129;
#pragma unroll
        for (int i = 0; i < 4; ++i)
#pragma unroll
            for (int q = 0; q < 16; ++q) ex[32 * i + crow(q, hi)] = o[i][q] * f;
        __syncthreads();
#pragma unroll 1
        for (int rr = 0; rr < 16; ++rr) { const int row = 16 * F.wave + rr;
            const float a0 = EX[row * 129 + F.lane] - EX[128 * 129 + row * 129 + F.lane], a1 = EX[row * 129 + 64 + F.lane] - EX[128 * 129 + row * 129 + 64 + F.lane];
            const float rstd = (1.0f - LAMBDA_INIT) / sqrtf(wave_sum(a0 * a0 + a1 * a1) * (1.f / 128.f) + EPS);
            bf16* yr = Y + (size_t)(qrow0 + row) * D + h * 128;
            yr[F.lane] = (bf16)(pk2(a0 * rstd * ng[F.lane], 0.f) & 0xffffu); yr[64 + F.lane] = (bf16)(pk2(a1 * rstd * ng[64 + F.lane], 0.f) & 0xffffu); }
        __syncthreads();
    }
}

#define XB_TMO      128
#define XB_XCNT(j)  (256  + 64 * (j))
#define XB_XSUB(j)  (1280 + 64 * (j))
#define XB_XGEN(j)  (2304 + 64 * (j))
#define XB_TOP      3328
#define XB_TOPGEN   3392
#define XCD_BAR_WORDS 3456
#define XB_SPIN_CAP (1u << 18)

__device__ __forceinline__ unsigned xb_ld(unsigned* p)              { return __hip_atomic_load(p, __ATOMIC_RELAXED, __HIP_MEMORY_SCOPE_AGENT); }
__device__ __forceinline__ unsigned xb_add(unsigned* p, unsigned v) { return __hip_atomic_fetch_add(p, v, __ATOMIC_RELAXED, __HIP_MEMORY_SCOPE_AGENT); }
__device__ __forceinline__ unsigned xb_xcc_id() { return (unsigned)__builtin_amdgcn_s_getreg((3 << 11) | 20) & 0xFu; }
#define XB_SPIN(cond, bar) do { unsigned _sp = 0; while (cond) { __builtin_amdgcn_s_sleep(1); \
    if ((++_sp & 255u) == 0u) { if (xb_ld(&(bar)[XB_TMO])) break; if (_sp > XB_SPIN_CAP) { atomicAdd(&(bar)[XB_TMO], 1u); break; } } } } while (0)

struct XcdBarrier {
    unsigned* bar; unsigned x;
    volatile LAS unsigned* st;
};

__device__ __forceinline__ XcdBarrier xcd_barrier_post(unsigned* bar, volatile LAS unsigned* st) {
    XcdBarrier b; b.bar = bar; b.x = xb_xcc_id(); b.st = st;
    if (threadIdx.x == 0) (void)xb_add(&bar[XB_XCNT(b.x)], 1u);
    return b;
}
__device__ __forceinline__ void xcd_barrier_complete(unsigned* bar, unsigned x, unsigned& nloc, unsigned& nx) {
    const unsigned G = gridDim.x * gridDim.y * gridDim.z;
    unsigned sum, cnt, mine, sp = 0u;
    for (;;) {
        sum = 0u; cnt = 0u; mine = 0u;
#pragma unroll
        for (unsigned j = 0; j < 16; ++j) { const unsigned c = xb_ld(&bar[XB_XCNT(j)]); sum += c; cnt += (c > 0u) ? 1u : 0u; mine = (j == x) ? c : mine; }
        if (sum == G) break;
        __builtin_amdgcn_s_sleep(1);
        if ((++sp & 255u) == 0u) { if (xb_ld(&bar[XB_TMO])) break; if (sp > XB_SPIN_CAP) { atomicAdd(&bar[XB_TMO], 1u); break; } }
    }
    nloc = mine > 0u ? mine : 1u; nx = cnt > 0u ? cnt : 1u;
}

__device__ __forceinline__ void xcd_barrier(const XcdBarrier& b) {
    asm volatile("s_waitcnt vmcnt(0)" ::: "memory");
    __syncthreads();
    if (threadIdx.x == 0) {
        unsigned* bar = b.bar;
        __builtin_amdgcn_s_waitcnt(0);
        unsigned nloc = b.st[0], nx = b.st[1];
        if (nloc == 0u) { xcd_barrier_complete(bar, b.x, nloc, nx); b.st[0] = nloc; b.st[1] = nx; }
        const unsigned old = xb_add(&bar[XB_XSUB(b.x)], 1u);
        const unsigned gen = old / nloc;
        if (old + 1u == (gen + 1u) * nloc) {
            __builtin_amdgcn_fence(__ATOMIC_RELEASE, "agent");
            asm volatile("s_waitcnt vmcnt(0)" ::: "memory");
            const unsigned og = xb_add(&bar[XB_TOP], 1u);
            const unsigned tg = og / nx;
            if (og + 1u == (tg + 1u) * nx) xb_add(&bar[XB_TOPGEN], 1u);
            else XB_SPIN(xb_ld(&bar[XB_TOPGEN]) == tg, bar);
            __builtin_amdgcn_fence(__ATOMIC_ACQUIRE, "agent");
            xb_add(&bar[XB_XGEN(b.x)], 1u);
            asm volatile("s_waitcnt vmcnt(0)" ::: "memory");
        } else {
            XB_SPIN(xb_ld(&bar[XB_XGEN(b.x)]) == gen, bar);
            __builtin_amdgcn_fence(__ATOMIC_ACQUIRE, "agent");
            asm volatile("s_waitcnt vmcnt(0)" ::: "memory");
        }
    }
    __syncthreads();
}

#ifndef MK_SINGLE
#define MK_SINGLE 1
#endif
constexpr int NSTEPS = 1 + 9 + 7 + 8 + 9 + 1;
struct SEpiStore { bf16* O; int ldc; int act; bf16* halo;
    __device__ __forceinline__ void operator()(const float (&v8)[8], int m, int n0, int hi, int half) const {
#pragma unroll
        for (int g = 0; g < 2; ++g) { float v[4];
#pragma unroll
            for (int i = 0; i < 4; ++i) { v[i] = v8[4 * g + i]; if (act) { const float t = fmaxf(v[i], 0.f); v[i] = t * t; } }
            const u32x2 w = (u32x2){pk2(v[0], v[1]), pk2(v[2], v[3])}; const int n = n0 + 8 * (2 * half + g) + 4 * hi;
            *(u32x2*)(O + (size_t)m * ldc + n) = w;
            if (halo && n < 3072 && (((m & 63) == 0) || ((m & 63) == 63))) *(u32x2*)(halo + ((size_t)(m >> 6) * 2 + ((m & 63) ? 1 : 0)) * 3072 + n) = w; } } };
struct SEpiResid { float* X; const float* gate;
    __device__ __forceinline__ void operator()(const float (&v8)[8], int m, int n0, int hi, int half) const {
#pragma unroll
        for (int g = 0; g < 2; ++g) { const int n = n0 + 8 * (2 * half + g) + 4 * hi; float* p = X + (size_t)m * D + n; const f32x4 gv = *(const f32x4*)(gate + n);
            *(f32x4*)p = *(const f32x4*)p + gv * (f32x4){v8[4 * g], v8[4 * g + 1], v8[4 * g + 2], v8[4 * g + 3]}; } } };
struct SEpiAB { float* AB;
    __device__ __forceinline__ void operator()(const float (&v8)[8], int m, int n0, int hi, int half) const {
        if (n0 == 0) {
#pragma unroll
            for (int g = 0; g < 2; ++g) *(f32x4*)(AB + (size_t)m * 32 + 8 * (2 * half + g) + 4 * hi) = (f32x4){v8[4 * g], v8[4 * g + 1], v8[4 * g + 2], v8[4 * g + 3]}; } } };
template <class Epi> __device__ __forceinline__ void small_gemm(const bf16* A, const bf16* Bt, int row_lo, int nrows, int N, int K, const Epi& E) {
    int tid = threadIdx.x; asm volatile("" : "+v"(tid));
    const int lane = tid & 63, wave = __builtin_amdgcn_readfirstlane(tid >> 6), r = lane & 31, hi = lane >> 5;
    int G_ = gridDim.x, B_ = blockIdx.x; asm volatile("" : "+s"(G_), "+s"(B_));
    LAS float* red = (LAS float*)lds_raw;
    const int tn = N / 64, items = (nrows / 64) * tn, kw = K / 8;
    for (int it = B_; it < items; it += G_) {
        const int mi = it / tn, ni = it % tn;
        const bf16* ap = A + (size_t)(row_lo + 64 * mi + r) * K + wave * kw + 8 * hi;
        const bf16* bp = Bt + (size_t)(64 * ni + r) * K + wave * kw + 8 * hi;
        f32x16 acc[2][2];
#pragma unroll
        for (int x = 0; x < 2; ++x)
#pragma unroll
            for (int y = 0; y < 2; ++y)
#pragma unroll
                for (int i = 0; i < 16; ++i) acc[x][y][i] = 0.f;
#pragma unroll 8
        for (int k = 0; k < kw; k += 16) {
            const bf16x8 a0 = *(const bf16x8*)(ap + k), a1 = *(const bf16x8*)(ap + (size_t)32 * K + k), b0 = *(const bf16x8*)(bp + k), b1 = *(const bf16x8*)(bp + (size_t)32 * K + k);
            acc[0][0] = __builtin_amdgcn_mfma_f32_32x32x16_bf16(b0, a0, acc[0][0], 0, 0, 0); acc[0][1] = __builtin_amdgcn_mfma_f32_32x32x16_bf16(b0, a1, acc[0][1], 0, 0, 0);
            acc[1][0] = __builtin_amdgcn_mfma_f32_32x32x16_bf16(b1, a0, acc[1][0], 0, 0, 0); acc[1][1] = __builtin_amdgcn_mfma_f32_32x32x16_bf16(b1, a1, acc[1][1], 0, 0, 0);
        }
#pragma unroll
        for (int x = 0; x < 2; ++x)
#pragma unroll
            for (int y = 0; y < 2; ++y)
#pragma unroll
                for (int i = 0; i < 16; ++i) red[((wave * 4 + x * 2 + y) * 16 + i) * 64 + lane] = acc[x][y][i];
        __syncthreads();
        { const int tile = wave >> 1, half = wave & 1; float v8[8];
#pragma unroll
            for (int i = 0; i < 8; ++i) { float s = 0.f;
#pragma unroll
                for (int w = 0; w < 8; ++w) s += red[((w * 4 + tile) * 16 + 8 * half + i) * 64 + lane];
                v8[i] = s; }
            E(v8, row_lo + 64 * mi + 32 * (tile & 1) + r, 64 * ni + 32 * (tile >> 1), hi, half); }
        __syncthreads();
    }
}
template <int ACT> __device__ __forceinline__ void gemm_store(const bf16* A, const bf16* Bt, bool ctx, int N, int K, bf16* O, int ldc, bf16* halo) {
    { int G_ = gridDim.x, B_ = blockIdx.x; asm volatile("" : "+s"(G_), "+s"(B_));
      pg8::Gemm g{A, Bt, ML, N, K, K, K}; pg8::StaticOrder S; S.init(ML, N, G_, B_);
      pg8::EpiStore<ACT> E{O, ldc, nullptr, -1, halo};
      pg8::gemm_phase<pg8::EpiStore<ACT>, pg8::StaticOrder, true, true>((LAS unsigned char*)lds_raw, g, S, E); }
    if (ctx) { SEpiStore E2{O, ldc, ACT, halo}; small_gemm(A, Bt, ML, MC, N, K, E2); }
}
__device__ __forceinline__ void gemm_resid(const bf16* A, const bf16* Bt, bool ctx, int K, float* X, const float* gate) {
    { int G_ = gridDim.x, B_ = blockIdx.x; asm volatile("" : "+s"(G_), "+s"(B_));
      pg8::Gemm g{A, Bt, ML, D, K, K, K}; pg8::StaticOrder S; S.init(ML, D, G_, B_);
      pg8::EpiResid E{X, D, gate, NADA};
      pg8::gemm_phase<pg8::EpiResid, pg8::StaticOrder, true, true>((LAS unsigned char*)lds_raw, g, S, E); }
    if (ctx) { SEpiResid E2{X, gate + 2 * NADA}; small_gemm(A, Bt, ML, MC, D, K, E2); }
}
__global__ void __launch_bounds__(NTHR, 2) fwd_kernel(Args a) {
    unsigned char* ws = a.ws;
    const int lo = a.step_lo, hi = a.step_hi; const bool coop = a.coop != 0;
    volatile LAS unsigned* bst = (volatile LAS unsigned*)((LAS unsigned char*)lds_raw + LDS_BYTES - 64);
    if (threadIdx.x < 2) bst[threadIdx.x] = 0u;
    __syncthreads();
    XcdBarrier bar; bar.bar = (unsigned*)(ws + WS_CTL) + 4096; bar.x = 0; bar.st = bst;
    if (coop) bar = xcd_barrier_post((unsigned*)(ws + WS_CTL) + 4096, bst);
#ifndef REP_SET
#define REP_SET 0
#endif
#define REP_OF(k) ((REP_SET == 1 && ((k) == 8 || (k) == 15 || (k) == 23 || (k) == 32)) || (REP_SET == 2 && ((k) == 4 || (k) == 28)) || (REP_SET == 3 && ((k) == 2 || (k) == 11 || (k) == 18 || (k) == 26)) || \
    (REP_SET == 4 && ((k) == 1 || (k) == 7 || (k) == 10 || (k) == 14 || (k) == 17 || (k) == 22 || (k) == 25 || (k) == 31)) || (REP_SET == 5 && (k) == 0) || (REP_SET == 6 && (k) == 20) || (REP_SET == 7 && ((k) == 5 || (k) == 29 || (k) == 12 || (k) == 34)))
#define PHASE(k, body) do { if (lo <= (k) && (k) < hi) { __syncthreads(); body; if (REP_OF(k)) { __syncthreads(); body; } if ((k) + 1 < hi && coop) { if ((k) == 0) cg::this_grid().sync(); else xcd_barrier(bar); } } } while (0)
#define WB(off) ((bf16*)(ws + (off)))
#define MODP(layer, which) ((const float*)(ws + WS_MOD) + (size_t)(layer) * 3 * NADA + (which) * D)
#define TAIL(k0, layer, WoutT, Mrows) \
    PHASE((k0), gemm_resid(WB(WS_Y), (WoutT), (Mrows) == M, D, (float*)(ws + WS_X), MODP(layer, 2))); \
    PHASE((k0) + 1, step_norm((layer), 1, (Mrows), false)); \
    PHASE((k0) + 2, gemm_store<1>(WB(WS_H), WB(WS_W1T) + (size_t)(layer) * D * FF, (Mrows) == M, FF, D, WB(WS_Z), FF, nullptr)); \
    PHASE((k0) + 3, gemm_resid(WB(WS_Z), WB(WS_W2T) + (size_t)(layer) * D * FF, (Mrows) == M, FF, (float*)(ws + WS_X), MODP(layer, 5)))
#define LAYER_GDN(k0, layer, jj, Mrows, conv) \
    PHASE((k0), step_norm((layer), 0, M, false)); \
    PHASE((k0) + 1, { gemm_store<0>(WB(WS_H), WB(WS_GINT) + (size_t)(jj) * GDN_NP * D, true, 4096, D, WB(WS_Z), 4096, WB(WS_HALO)); \
        SEpiAB E3{(float*)(ws + WS_AB)}; small_gemm(WB(WS_H), WB(WS_GINT) + (size_t)(jj) * GDN_NP * D + (size_t)4096 * D, 0, M, 64, D, E3); }); \
    PHASE((k0) + 2, { if (REP_SET >= 8) { step_gdn_prep(jj, a.coop != 0, a.pad); __syncthreads(); } step_gdn_prep(jj); }); \
    PHASE((k0) + 3, { if (conv) step_convert_rest(); step_gdn_scan2(); }); \
    PHASE((k0) + 4, step_gdn_norm2(jj)); \
    TAIL((k0) + 5, layer, WB(WS_GOUTT) + (size_t)(jj) * D * D, Mrows)
    PHASE(0, step_prologue());
    LAYER_GDN(1, 0, 0, M, true);
    PHASE(10, step_norm(1, 0, M, false));
    PHASE(11, gemm_store<0>(WB(WS_H), WB(WS_SINT), true, 3 * D, D, WB(WS_Z), 3 * D, nullptr));
    PHASE(12, step_sconv());
    TAIL(13, 1, WB(WS_SOUTT), M);
    PHASE(17, step_norm(2, 0, M, false));
    PHASE(18, gemm_store<0>(WB(WS_H), WB(WS_DINT), true, 3 * D, D, WB(WS_Z), 3 * D, nullptr));
    PHASE(19, step_rope2());
    PHASE(20, step_attn2());
    TAIL(21, 2, WB(WS_DOUTT), M);
    LAYER_GDN(25, 3, 1, ML, false);
    PHASE(34, step_final());
}

extern "C" void kernel_launch(void* const* d_in, const int* in_sizes, int n_in, void* d_out, int out_size, void* d_ws, size_t ws_size, hipStream_t stream) {
    static int grid = 0;
    if (grid == 0) {
        if (n_in != 24 || out_size != ML * D || ws_size < WS_END) { fprintf(stderr, "kernel_launch: unexpected problem (n_in %d, out %d, ws %zu); nothing launched\n", n_in, out_size, ws_size); grid = -1; return; }
        int dev = 0, cus = 0, per_cu = 0;
        if (hipGetDevice(&dev) != hipSuccess || hipDeviceGetAttribute(&cus, hipDeviceAttributeMultiprocessorCount, dev) != hipSuccess) { grid = -1; return; }
        if (hipFuncSetAttribute((const void*)fwd_kernel, hipFuncAttributeMaxDynamicSharedMemorySize, LDS_BYTES) != hipSuccess) { fprintf(stderr, "kernel_launch: hipFuncSetAttribute failed\n"); grid = -1; return; }
        if (hipOccupancyMaxActiveBlocksPerMultiprocessor(&per_cu, (const void*)fwd_kernel, NTHR, LDS_BYTES) != hipSuccess || per_cu < 1) { fprintf(stderr, "kernel_launch: occupancy query says %d blocks per CU\n", per_cu); (void)hipGetLastError(); per_cu = 1; }
        grid = cus;
        fprintf(stderr, "kernel_launch: %d CUs, occupancy %d per CU, grid %d\n", cus, per_cu, grid);
    }
    if (grid < 0) return;
    (void)hipMemsetAsync((char*)d_ws + WS_CTL, 0, CTL_ZERO_BYTES, stream);
    Args a{};
    for (int i = 0; i < 24; ++i) a.in[i] = (const float*)d_in[i];
    a.out = (float*)d_out; a.ws = (unsigned char*)d_ws;
#if MK_SINGLE
    a.step_lo = 0; a.step_hi = NSTEPS; a.coop = 1;
#if REP_SET >= 8
    a.pad = REP_SET - 8;
#endif
    void* args[] = {&a};
    hipError_t e = hipLaunchCooperativeKernel((const void*)fwd_kernel, dim3(grid), dim3(NTHR), args, LDS_BYTES, stream);
    if (e != hipSuccess) fprintf(stderr, "cooperative launch failed: %s (grid %d)\n", hipGetErrorString(e), grid);
#else
    for (int s = 0; s < NSTEPS; ++s) { a.step_lo = s; a.step_hi = s + 1; a.coop = 0; hipLaunchKernelGGL(fwd_kernel, dim3(grid), dim3(NTHR), LDS_BYTES, stream, a); }
#endif
}
```

```cpp
#include <hip/hip_runtime.h>
#include <hip/hip_cooperative_groups.h>
#include <cstdio>
#include <cstdint>
namespace cg = cooperative_groups;
namespace pg8 {
#define PG8_LAS __attribute__((address_space(3)))
typedef unsigned short bf16_t;
typedef short bf16x8 __attribute__((ext_vector_type(8)));
typedef float f32x4 __attribute__((ext_vector_type(4)));
typedef unsigned u32x4 __attribute__((ext_vector_type(4)));
constexpr int BM = 256, BK = 64, HALF = 128, HTB = HALF * BK * 2  , STAGE_BYTES = 8 * HTB, NXCD = 8, WGM = 8;

__host__ __device__ __forceinline__ int lds_byte(int r, int c) { const int st = (r >> 4) * 2 + (c >> 5), rr = r & 15, cc = c & 31, ob = rr * 64 + cc * 2; return st * 1024 + (ob ^ (((ob >> 9) & 1) << 5)); }
__host__ __device__ __forceinline__ void stage_rc(int b, int& R, int& C) { const int st = b / 1024, sb = b % 1024, swz = sb ^ (((sb >> 9) & 1) << 5); R = (st >> 1) * 16 + swz / 64; C = (st & 1) * 32 + (swz % 64) / 2; }
__host__ __device__ __forceinline__ int perm32(int rho) { const int n = rho >> 4, i = rho & 15; return 8 * (i >> 2) + 4 * n + (i & 3); }

struct Unit { int pm, pn; };
struct Gemm { const bf16_t* A; const bf16_t* Bt; int M, N, K, lda, ldb; };

struct StaticOrder {
    int nM, nN, nwg, G, c;
    __host__ __device__ void init(int M, int N, int G_, int c_) { nM = M / BM; nN = N / BM; nwg = nM * nN; G = G_; c = c_; }
    __host__ __device__ bool next(int i, Unit& u) const {
        const long L = (long)i * G + c; if (L >= nwg) return false;
        int wgid = (int)L; { const int q = nwg / NXCD, r = nwg % NXCD, xcd = wgid % NXCD, off = wgid / NXCD; wgid = (xcd < r ? xcd * (q + 1) : r * (q + 1) + (xcd - r) * q) + off; }
        const int nig = WGM * nN, gid = wgid / nig, fm = gid * WGM, gsz = (nM - fm) < WGM ? (nM - fm) : WGM;
        u.pm = fm + ((wgid % nig) % gsz); u.pn = (wgid % nig) / gsz; return true;
    }
    __device__ __forceinline__ void a_ready(const Unit&) const {}
    __device__ __forceinline__ void done(const Unit&) const {}
};

typedef float f32x2 __attribute__((ext_vector_type(2)));
typedef __bf16 bf16x2_t __attribute__((ext_vector_type(2)));
__device__ __forceinline__ unsigned cvt_pk_bf16(float lo, float hi) { f32x2 v = {lo, hi}; bf16x2_t b = __builtin_convertvector(v, bf16x2_t); return __builtin_bit_cast(unsigned, b); }

template <int ACT> struct EpiStore {
    static constexpr bool PERM = true, AFTER_DRAIN = false;
    bf16_t* O; int ldc; float* AB; int ab_tile; bf16_t* halo;
    __device__ __forceinline__ void operator()(const f32x4 (&acc)[2][2][4][2], const Unit& u, int wr, int wc, int fr, int fq) const {
        const int row0 = u.pm * BM + wr * 64 + fr;
        if (u.pn == ab_tile) {
            if (wc == 0) {
#pragma unroll
                for (int ai = 0; ai < 2; ++ai)
#pragma unroll
                    for (int m = 0; m < 4; ++m) { float* p = AB + (size_t)(row0 + ai * HALF + m * 16) * 32 + 8 * fq; *(f32x4*)p = acc[ai][0][m][0]; *(f32x4*)(p + 4) = acc[ai][0][m][1]; }
            }
            return;
        }
        const int col0 = u.pn * BM + wc * 32 + 8 * fq;
#pragma unroll
        for (int ai = 0; ai < 2; ++ai)
#pragma unroll
            for (int m = 0; m < 4; ++m) { bf16_t* rowp = O + (size_t)(row0 + ai * HALF + m * 16) * ldc + col0;
#pragma unroll
                for (int bj = 0; bj < 2; ++bj) { f32x4 v0 = acc[ai][bj][m][0], v1 = acc[ai][bj][m][1];
                    if (ACT == 1) {
#pragma unroll
                        for (int i = 0; i < 4; ++i) { const float a = fmaxf(v0[i], 0.f), b = fmaxf(v1[i], 0.f); v0[i] = a * a; v1[i] = b * b; } }
                    u32x4 w; w.x = cvt_pk_bf16(v0[0], v0[1]); w.y = cvt_pk_bf16(v0[2], v0[3]); w.z = cvt_pk_bf16(v1[0], v1[1]); w.w = cvt_pk_bf16(v1[2], v1[3]);
                    *(u32x4*)(rowp + bj * HALF) = w;
                    if (halo && u.pn < 12 && ((m == 0 && fr == 0) || (m == 3 && fr == 15))) { const int row = row0 + ai * HALF + m * 16;
                        *(u32x4*)(halo + ((size_t)(row >> 6) * 2 + (m == 3 ? 1 : 0)) * 3072 + col0 + bj * HALF) = w; } } }
    }
};
struct EpiResid {
    static constexpr bool PERM = false, AFTER_DRAIN = false;
    float* X; int ldc; const float* gate; int gstride;
    __device__ __forceinline__ void operator()(const f32x4 (&acc)[2][2][4][2], const Unit& u, int wr, int wc, int fr, int fq) const {
        const int row0 = u.pm * BM + wr * 64 + fr, col0 = u.pn * BM + wc * 32 + 4 * fq;
        const float* g = gate + (size_t)(u.pm < 32 ? 0 : (u.pm < 64 ? 1 : 2)) * gstride + col0;
        f32x4 gv[2][2];
#pragma unroll
        for (int bj = 0; bj < 2; ++bj)
#pragma unroll
            for (int n = 0; n < 2; ++n) gv[bj][n] = *(const f32x4*)(g + bj * HALF + n * 16);
#pragma unroll
        for (int ai = 0; ai < 2; ++ai)
#pragma unroll
            for (int m = 0; m < 4; ++m) { float* p = X + (size_t)(row0 + ai * HALF + m * 16) * ldc + col0;
#pragma unroll
                for (int bj = 0; bj < 2; ++bj)
#pragma unroll
                    for (int n = 0; n < 2; ++n) { float* q = p + bj * HALF + n * 16; *(f32x4*)q = *(const f32x4*)q + gv[bj][n] * acc[ai][bj][m][n]; }
                if (m & 1) asm volatile("" ::: "memory"); }
    }
};

template <class Epi, class Sched, bool ALIGN_EPI = false, bool SP2 = false>
__device__ __forceinline__ void gemm_phase(PG8_LAS unsigned char* lds, const Gemm g, const Sched& S, const Epi& E) {
    int tid_ = threadIdx.x; asm volatile("" : "+v"(tid_)); const int tid = tid_, wid = __builtin_amdgcn_readfirstlane(tid >> 6), lane = tid & 63, wr = wid >> 2, wc = wid & 3, fr = lane & 15, fq = lane >> 4;
    const int K = g.K, nt = K / BK;
    unsigned voffA[2], voffB[2];
#pragma unroll
    for (int i = 0; i < 2; ++i) { int R, C; stage_rc(tid * 16 + i * 8192, R, C); const int Rb = Epi::PERM ? ((R & ~31) + perm32(R & 31)) : R;
        voffA[i] = (unsigned)(R * g.lda + C) * 2u; voffB[i] = (unsigned)(Rb * g.ldb + C) * 2u; }
    const size_t kstep = (size_t)(BK * 2);
    const int lda = g.lda, ldb = g.ldb;
    const size_t hstepA = (size_t)HALF * lda * 2, hstepB = (size_t)HALF * ldb * 2;
    const size_t tstepA = 2 * hstepA, tstepB = 2 * hstepB;
    const unsigned ldsw = (unsigned)wid * 1024u;
    const int aoff = lds_byte(wr * 64 + fr, fq * 8), boff = lds_byte(wc * 32 + fr, fq * 8);
#define PG8_SA(b, h) (((b) * 2 + (h)) * HTB)
#define PG8_SB(b, h) ((4 + (b) * 2 + (h)) * HTB)
#define PG8_STAGE(bufoff, gbase, voff) do { _Pragma("unroll") for (int _i = 0; _i < 2; ++_i) \
        __builtin_amdgcn_global_load_lds((const unsigned*)((const char*)(gbase) + (voff)[_i]), (PG8_LAS unsigned*)(lds + (bufoff) + ldsw + _i * 8192), 16, 0, 0); } while (0)
#define PG8_LDA(dst, b, h) do { _Pragma("unroll") for (int m = 0; m < 4; ++m) _Pragma("unroll") for (int k = 0; k < 2; ++k) dst[m][k] = *(const PG8_LAS bf16x8*)(lds + PG8_SA(b, h) + aoff + m * 2048 + k * 1024); } while (0)
#define PG8_LDB(dst, b, h) do { _Pragma("unroll") for (int n = 0; n < 2; ++n) _Pragma("unroll") for (int k = 0; k < 2; ++k) dst[n][k] = *(const PG8_LAS bf16x8*)(lds + PG8_SB(b, h) + boff + n * 2048 + k * 1024); } while (0)
#define PG8_MMA(ai, bj, At, Bt) do { __builtin_amdgcn_s_setprio(1); _Pragma("unroll") for (int m = 0; m < 4; ++m) _Pragma("unroll") for (int n = 0; n < 2; ++n) _Pragma("unroll") for (int k = 0; k < 2; ++k) \
        acc[ai][bj][m][n] = __builtin_amdgcn_mfma_f32_16x16x32_bf16(Bt[n][k], At[m][k], acc[ai][bj][m][n], 0, 0, 0); __builtin_amdgcn_s_setprio(0); } while (0)
#define PG8_WAIT_V(n) asm volatile("s_waitcnt vmcnt(" #n ")" ::: "memory")
#define PG8_WAIT_L(n) asm volatile("s_waitcnt lgkmcnt(" #n ")" ::: "memory")
#define PG8_BAR __builtin_amdgcn_s_barrier()
#define PG8_SCHED __builtin_amdgcn_sched_barrier(0)
    Unit cur, nxt; int ui = 0;
    if (!S.next(0, cur)) return;
    f32x4 acc[2][2][4][2];
#pragma unroll
    for (int a = 0; a < 2; ++a)
#pragma unroll
        for (int b = 0; b < 2; ++b)
#pragma unroll
            for (int m = 0; m < 4; ++m)
#pragma unroll
                for (int n = 0; n < 2; ++n) acc[a][b][m][n] = (f32x4){0.f, 0.f, 0.f, 0.f};
    bf16x8 At[4][2], B0[2][2], B1[2][2];
    const char* cA = (const char*)g.A + (size_t)cur.pm * tstepA; const char* cB = (const char*)g.Bt + (size_t)cur.pn * tstepB;
    S.a_ready(cur);
    if constexpr (SP2) {
        PG8_STAGE(PG8_SB(0, 0), cB, voffB); PG8_STAGE(PG8_SB(0, 1), cB + hstepB, voffB); PG8_STAGE(PG8_SA(0, 0), cA, voffA); PG8_STAGE(PG8_SA(0, 1), cA + hstepA, voffA);
        if (wr == 1) PG8_BAR;
        PG8_WAIT_V(2); PG8_BAR;
        PG8_STAGE(PG8_SB(1, 0), cB + kstep, voffB); PG8_STAGE(PG8_SA(1, 0), cA + kstep, voffA); PG8_STAGE(PG8_SB(1, 1), cB + hstepB + kstep, voffB);
        PG8_WAIT_V(6); PG8_BAR;
    } else {
        PG8_STAGE(PG8_SB(0, 0), cB, voffB); PG8_STAGE(PG8_SA(0, 0), cA, voffA); PG8_STAGE(PG8_SB(0, 1), cB + hstepB, voffB); PG8_STAGE(PG8_SA(0, 1), cA + hstepA, voffA);
        if (wr == 1) PG8_BAR;
        PG8_WAIT_V(4); PG8_BAR;
        PG8_STAGE(PG8_SB(1, 0), cB + kstep, voffB); PG8_STAGE(PG8_SA(1, 0), cA + kstep, voffA); PG8_STAGE(PG8_SB(1, 1), cB + hstepB + kstep, voffB);
        PG8_WAIT_V(6); PG8_BAR;
    }
    for (;;) {
        const bool has_next = S.next(ui + 1, nxt);
        const char* nA = has_next ? (const char*)g.A + (size_t)nxt.pm * tstepA : cA; const char* nB = has_next ? (const char*)g.Bt + (size_t)nxt.pn * tstepB : cB;
        for (int t = 0; t < nt; t += 2) {
            const bool last = (t == nt - 2);
            const char* a1 = cA + (size_t)(t + 1) * kstep;
            const char* a2 = last ? nA : cA + (size_t)(t + 2) * kstep; const char* b2 = last ? nB : cB + (size_t)(t + 2) * kstep;
            const char* a3 = a2 + kstep; const char* b3 = b2 + kstep;
            if (last && has_next) S.a_ready(nxt);
            if constexpr (SP2) {
            PG8_LDB(B0, 0, 0); PG8_LDB(B1, 0, 1); PG8_SCHED; PG8_LDA(At, 0, 0); PG8_STAGE(PG8_SA(1, 1), a1 + hstepA, voffA);
            PG8_WAIT_V(8); PG8_WAIT_L(0); PG8_BAR; PG8_MMA(0, 0, At, B0); PG8_MMA(0, 1, At, B1); PG8_BAR; PG8_SCHED;
            PG8_LDA(At, 0, 1); PG8_STAGE(PG8_SB(0, 0), b2, voffB); PG8_STAGE(PG8_SB(0, 1), b2 + hstepB, voffB); PG8_STAGE(PG8_SA(0, 0), a2, voffA);
            PG8_WAIT_V(8); PG8_WAIT_L(0); PG8_BAR; PG8_MMA(1, 0, At, B0); PG8_MMA(1, 1, At, B1); PG8_BAR; PG8_SCHED;
            PG8_LDB(B0, 1, 0); PG8_LDB(B1, 1, 1); PG8_SCHED; PG8_LDA(At, 1, 0); PG8_STAGE(PG8_SA(0, 1), a2 + hstepA, voffA);
            PG8_WAIT_V(8); PG8_WAIT_L(0); PG8_BAR; PG8_MMA(0, 0, At, B0); PG8_MMA(0, 1, At, B1); PG8_BAR; PG8_SCHED;
            PG8_LDA(At, 1, 1); PG8_STAGE(PG8_SB(1, 0), b3, voffB); PG8_STAGE(PG8_SB(1, 1), b3 + hstepB, voffB); PG8_STAGE(PG8_SA(1, 0), a3, voffA);
            PG8_WAIT_V(8); PG8_WAIT_L(0); PG8_BAR; PG8_MMA(1, 0, At, B0); PG8_MMA(1, 1, At, B1); PG8_BAR; PG8_SCHED;
            } else {
            PG8_LDB(B0, 0, 0); PG8_SCHED; PG8_LDA(At, 0, 0); PG8_STAGE(PG8_SA(1, 1), a1 + hstepA, voffA);
            PG8_WAIT_L(8); PG8_BAR; PG8_WAIT_L(0); PG8_MMA(0, 0, At, B0); PG8_BAR; PG8_SCHED;
            PG8_LDB(B1, 0, 1); PG8_STAGE(PG8_SB(0, 0), b2, voffB);
            PG8_BAR; PG8_WAIT_L(0); PG8_MMA(0, 1, At, B1); PG8_BAR;
            PG8_LDA(At, 0, 1); PG8_STAGE(PG8_SA(0, 0), a2, voffA);
            PG8_BAR; PG8_WAIT_L(0); PG8_MMA(1, 0, At, B0); PG8_BAR; PG8_SCHED;
            PG8_STAGE(PG8_SB(0, 1), b2 + hstepB, voffB);
            PG8_WAIT_V(6); PG8_BAR; PG8_MMA(1, 1, At, B1); PG8_BAR;
            PG8_LDB(B0, 1, 0); PG8_SCHED; PG8_LDA(At, 1, 0); PG8_STAGE(PG8_SA(0, 1), a2 + hstepA, voffA);
            PG8_WAIT_L(8); PG8_BAR; PG8_WAIT_L(0); PG8_MMA(0, 0, At, B0); PG8_BAR; PG8_SCHED;
            PG8_LDB(B1, 1, 1); PG8_STAGE(PG8_SB(1, 0), b3, voffB);
            PG8_BAR; PG8_WAIT_L(0); PG8_MMA(0, 1, At, B1); PG8_BAR;
            PG8_LDA(At, 1, 1); PG8_STAGE(PG8_SA(1, 0), a3, voffA);
            PG8_BAR; PG8_WAIT_L(0); PG8_MMA(1, 0, At, B0); PG8_BAR; PG8_SCHED;
            PG8_STAGE(PG8_SB(1, 1), b3 + hstepB, voffB);
            PG8_WAIT_V(6); PG8_BAR; PG8_MMA(1, 1, At, B1); PG8_BAR;
            }
        }
        if constexpr (ALIGN_EPI) { if (wr == 0) PG8_BAR; }
        if constexpr (!Epi::AFTER_DRAIN) { E(acc, cur, wr, wc, fr, fq); S.done(cur); }
        if (!has_next) break;
#pragma unroll
        for (int a = 0; a < 2; ++a)
#pragma unroll
            for (int b = 0; b < 2; ++b)
#pragma unroll
                for (int m = 0; m < 4; ++m)
#pragma unroll
                    for (int n = 0; n < 2; ++n) acc[a][b][m][n] = (f32x4){0.f, 0.f, 0.f, 0.f};
        cur = nxt; cA = nA; cB = nB; ++ui;
        if constexpr (ALIGN_EPI) { if (wr == 1) PG8_BAR; }
    }
    PG8_WAIT_V(0);
    if constexpr (!ALIGN_EPI) { if (wr == 0) PG8_BAR; }
    PG8_BAR;
    if constexpr (Epi::AFTER_DRAIN) { E.fused(acc, cur, wr, wc, fr, fq, lds, wid, lane); S.done(cur); }
#undef PG8_SA
#undef PG8_SB
#undef PG8_STAGE
#undef PG8_LDA
#undef PG8_LDB
#undef PG8_MMA
#undef PG8_WAIT_V
#undef PG8_WAIT_L
#undef PG8_BAR
#undef PG8_SCHED
}
}

constexpr int D = 1024, NB = 2, T = 8192, CT = 256, DEPTH = 4, FF = 4096;
constexpr int ML = NB * T, MC = NB * CT, M = ML + MC;
constexpr int NADA = 6 * D;
constexpr int GDN_N = 4128, GDN_NP = 4352;
constexpr int NH = 8, HD = 128;
constexpr int NKV = CT + T;
constexpr float EPS = 1e-6f;
constexpr int NWAVES = 8, NTHR = 512;
constexpr float QSCALE = 0.125f * 1.4426950408889634f;
constexpr float LAMBDA_INIT = 0.47071302f;

constexpr size_t MiB = 1u << 20;
constexpr size_t WS_CTL = 0, CTL_ZERO_BYTES = 1 * MiB;
constexpr size_t WS_MOD = 1 * MiB;
constexpr size_t WS_ROPE = 2 * MiB;
constexpr size_t WS_AB = 4 * MiB;
constexpr size_t WS_OFC = 7 * MiB;
constexpr size_t WS_W1T = 10 * MiB, WS_W2T = 42 * MiB, WS_GINT = 74 * MiB, WS_GOUTT = 91 * MiB, WS_SINT = 95 * MiB, WS_SOUTT = 101 * MiB, WS_DINT = 103 * MiB, WS_DOUTT = 109 * MiB;
constexpr size_t WS_X = 112 * MiB;
constexpr size_t WS_H = 178 * MiB;
constexpr size_t WS_Y = 211 * MiB;
constexpr size_t WS_Z = 244 * MiB;
constexpr size_t WS_HALO = 376 * MiB;
constexpr size_t WS_END = 380 * MiB;
constexpr size_t WS_PD = WS_H;

constexpr int LDS_BYTES = 149504;

#define LAS __attribute__((address_space(3)))
typedef unsigned short bf16;
typedef unsigned u32x4 __attribute__((ext_vector_type(4)));
typedef unsigned u32x2 __attribute__((ext_vector_type(2)));
typedef float f32x4 __attribute__((ext_vector_type(4)));
typedef float f32x2 __attribute__((ext_vector_type(2)));
typedef float f32x16 __attribute__((ext_vector_type(16)));
typedef short bf16x8 __attribute__((ext_vector_type(8)));
typedef short s16x4 __attribute__((ext_vector_type(4)));
#define LDS_WAIT() asm volatile("s_waitcnt lgkmcnt(0)" ::: "memory")

__device__ __forceinline__ float bf2f(unsigned u) { return __uint_as_float(u << 16); }
__device__ __forceinline__ unsigned pk2(float lo, float hi) { return pg8::cvt_pk_bf16(lo, hi); }
__device__ __forceinline__ float wave_sum(float v) {
#pragma unroll
    for (int o = 1; o < 64; o <<= 1) v += __shfl_xor(v, o);
    return v;
}
__device__ __forceinline__ float silu_f(float x) { return x / (1.f + expf(-x)); }
__device__ __forceinline__ float silu_fast(float x) { return x * __builtin_amdgcn_rcpf(1.f + __builtin_amdgcn_exp2f(-1.4426950408889634f * x)); }
__device__ __forceinline__ int crow(int r, int hi) { return (r & 3) + 8 * (r >> 2) + 4 * hi; }

struct Args { const float* in[24]; float* out; unsigned char* ws; int step_lo, step_hi, coop, pad; };
typedef const __attribute__((address_space(4))) Args* KArgs;
__device__ __forceinline__ KArgs kargs() { unsigned long long p = (unsigned long long)__builtin_amdgcn_kernarg_segment_ptr(); asm volatile("" : "+s"(p)); return (KArgs)p; }
#define INP(k) (kargs()->in[k])
extern __shared__ __attribute__((aligned(16))) unsigned char lds_raw[];
struct Frame { LAS unsigned char* lds; int tid, lane, wave, G, bid; float* out; unsigned char* ws; };
__device__ __forceinline__ Frame make_frame() {
    Frame F; F.lds = (LAS unsigned char*)lds_raw; F.tid = threadIdx.x; asm volatile("" : "+v"(F.tid)); F.lane = F.tid & 63; F.wave = __builtin_amdgcn_readfirstlane(F.tid >> 6); F.G = gridDim.x; F.bid = blockIdx.x; asm volatile("" : "+s"(F.G), "+s"(F.bid));
    KArgs a = kargs(); F.out = a->out; F.ws = a->ws; return F;
}
enum { I_X = 0, I_C, I_CTX, I_CCTX, I_N1G, I_N2G, I_ADAW, I_ADAB, I_W1, I_W2, I_GIN, I_GCONV, I_GALOG, I_GDT, I_GNG, I_GOUT, I_SIN, I_SCONV, I_SOUT, I_DIN, I_DLAM, I_DNG, I_DOUT, I_FG };

__device__ __forceinline__ void transpose_item(const float* W, int K, int ldw, bf16* WT, LAS float* scr, int item, int nblk, int lane) {
    const int kb = item / nblk, nb = item % nblk, k0 = 64 * kb, n0 = 32 * nb;
#pragma unroll 8
    for (int i = 0; i < 32; ++i) { const int kk = 2 * i + (lane >> 5); scr[kk * 33 + (lane & 31)] = W[(size_t)(k0 + kk) * ldw + n0 + (lane & 31)]; }
    LDS_WAIT(); asm volatile("" ::: "memory");
    const int c = lane & 7;
#pragma unroll
    for (int j = 0; j < 4; ++j) { const int n = (lane >> 3) + 8 * j; const LAS float* s = scr + (8 * c) * 33 + n;
        u32x4 o; o.x = pk2(s[0 * 33], s[1 * 33]); o.y = pk2(s[2 * 33], s[3 * 33]); o.z = pk2(s[4 * 33], s[5 * 33]); o.w = pk2(s[6 * 33], s[7 * 33]);
        *(u32x4*)(WT + (size_t)(n0 + n) * K + k0 + 8 * c) = o; }
    LDS_WAIT(); asm volatile("" ::: "memory");
}
__device__ __forceinline__ void get_mat(unsigned char* ws_, int idx, const float*& src, bf16*& dst, int& K, int& N, int& ld) {
    unsigned char* ws = ws_;
    if (idx < 4)       { src = INP(I_W1) + (size_t)idx * D * FF; dst = (bf16*)(ws + WS_W1T) + (size_t)idx * D * FF; K = D; N = FF; ld = FF; }
    else if (idx < 8)  { const int i = idx - 4; src = INP(I_W2) + (size_t)i * D * FF; dst = (bf16*)(ws + WS_W2T) + (size_t)i * D * FF; K = FF; N = D; ld = D; }
    else if (idx < 10) { const int j = idx - 8; src = INP(I_GIN) + (size_t)j * D * GDN_N; dst = (bf16*)(ws + WS_GINT) + (size_t)j * GDN_NP * D; K = D; N = GDN_N; ld = GDN_N; }
    else if (idx < 12) { const int j = idx - 10; src = INP(I_GOUT) + (size_t)j * D * D; dst = (bf16*)(ws + WS_GOUTT) + (size_t)j * D * D; K = D; N = D; ld = D; }
    else if (idx == 12) { src = INP(I_SIN); dst = (bf16*)(ws + WS_SINT); K = D; N = 3 * D; ld = 3 * D; }
    else if (idx == 13) { src = INP(I_SOUT); dst = (bf16*)(ws + WS_SOUTT); K = D; N = D; ld = D; }
    else if (idx == 14) { src = INP(I_DIN); dst = (bf16*)(ws + WS_DINT); K = D; N = 3 * D; ld = 3 * D; }
    else { src = INP(I_DOUT); dst = (bf16*)(ws + WS_DOUTT); K = D; N = D; ld = D; }
}
__device__ __forceinline__ void convert_weights(unsigned char* ws, unsigned mask, int gw, int NGW, int gt, int NGT, LAS unsigned char* lds, int wave, int lane) {
    LAS float* scr = (LAS float*)(lds + wave * 16384);
    for (int mi = 0; mi < 16; ++mi) {
        if (!((mask >> mi) & 1u)) continue;
        const float* src; bf16* dst; int K, N, ld; get_mat(ws, mi, src, dst, K, N, ld);
        const int nblk = N / 32, nitems = (K / 64) * nblk;
        for (int it = gw; it < nitems; it += NGW) transpose_item(src, K, ld, dst, scr, it, nblk, lane);
        if (mi == 8 || mi == 9) { u32x4* z = (u32x4*)((bf16*)(ws + WS_GINT) + (size_t)(mi - 8) * GDN_NP * D + (size_t)GDN_N * D);
            for (int i = gt; i < (GDN_NP - GDN_N) * D / 8; i += NGT) z[i] = (u32x4){0u, 0u, 0u, 0u}; }
    }
}
__device__ __forceinline__ void step_prologue() {
    const Frame F = make_frame();
    const int gw = F.bid * NWAVES + F.wave, NGW = F.G * NWAVES;
    const int gt = F.bid * NTHR + F.tid, NGT = F.G * NTHR;
    convert_weights(F.ws, (1u << 0) | (1u << 4) | (1u << 8) | (1u << 10), gw, NGW, gt, NGT, F.lds, F.wave, F.lane);
    __syncthreads();
    {
        LAS float* sv = (LAS float*)F.lds;
        LAS float* red = sv + 3 * D;
        for (int i = F.tid; i < 3 * D; i += NTHR) { const int g = i / D, k = i % D; const float c = g < 2 ? INP(I_C)[g * D + k] : INP(I_CCTX)[k]; sv[i] = silu_f(c); }
        __syncthreads();
        float* MOD = (float*)(F.ws + WS_MOD);
        const int c = F.tid & 63, ks = F.tid >> 6;
        for (int it = F.bid; it < DEPTH * (NADA / 64); it += F.G) {
            const int li = it / (NADA / 64), n0 = (it % (NADA / 64)) * 64;
            const float* w = INP(I_ADAW) + (size_t)li * D * NADA + (size_t)(ks * 128) * NADA + n0 + c;
            float a0 = 0.f, a1 = 0.f, a2 = 0.f;
#pragma unroll 8
            for (int k = 0; k < 128; ++k) { const float wv = w[(size_t)k * NADA]; const int kk = ks * 128 + k; a0 += sv[kk] * wv; a1 += sv[D + kk] * wv; a2 += sv[2 * D + kk] * wv; }
            red[(ks * 3 + 0) * 64 + c] = a0; red[(ks * 3 + 1) * 64 + c] = a1; red[(ks * 3 + 2) * 64 + c] = a2;
            __syncthreads();
            if (F.tid < 192) { const int g = F.tid >> 6; float s = INP(I_ADAB)[li * NADA + n0 + c];
#pragma unroll
                for (int q = 0; q < 8; ++q) s += red[(q * 3 + g) * 64 + c];
                MOD[((size_t)li * 3 + g) * NADA + n0 + c] = s; }
            __syncthreads();
        }
    }
    {
        f32x4* X4 = (f32x4*)(F.ws + WS_X); const f32x4* x4 = (const f32x4*)INP(I_X); const f32x4* c4 = (const f32x4*)INP(I_CTX);
        for (int i = gt; i < M * (D / 4); i += NGT) X4[i] = i < ML * (D / 4) ? x4[i] : c4[i - ML * (D / 4)];
    }
    {
        f32x2* R = (f32x2*)(F.ws + WS_ROPE);
        for (int i = gt; i < T * 32; i += NGT) { const int t = i >> 5, p = i & 31, f = p & 15;
            const float inv = powf(10000.0f, -(float)f / 16.0f); const float pos = (float)(p < 16 ? (t >> 6) : (t & 63)); const float ang = pos * inv;
            R[i] = (f32x2){cosf(ang), sinf(ang)}; }
    }
}

__device__ __forceinline__ void step_norm(int layer, int which, int nrows, bool zero_of) {
    const Frame F = make_frame();
    const int gw = F.bid * NWAVES + F.wave, NGW = F.G * NWAVES;
    const float* X = (const float*)(F.ws + WS_X); bf16* H = (bf16*)(F.ws + WS_H);
    const float* ng = (which ? INP(I_N2G) : INP(I_N1G)) + layer * D;
    const float* MOD = (const float*)(F.ws + WS_MOD) + (size_t)layer * 3 * NADA + which * 3 * D;
    for (int row = gw; row < nrows; row += NGW) {
        const int grp = row < T ? 0 : (row < ML ? 1 : 2);
        const f32x4* xr = (const f32x4*)(X + (size_t)row * D) + F.lane;
        const f32x4* sh = (const f32x4*)(MOD + (size_t)grp * NADA) + F.lane; const f32x4* sc = (const f32x4*)(MOD + (size_t)grp * NADA + D) + F.lane; const f32x4* gg = (const f32x4*)ng + F.lane;
        f32x4 v[4]; float s = 0.f;
#pragma unroll
        for (int j = 0; j < 4; ++j) { v[j] = xr[64 * j]; s += (v[j].x * v[j].x + v[j].y * v[j].y) + (v[j].z * v[j].z + v[j].w * v[j].w); }
        const float rstd = 1.0f / sqrtf(wave_sum(s) * (1.f / D) + EPS);
        u32x2* o = (u32x2*)(H + (size_t)row * D) + F.lane;
#pragma unroll
        for (int j = 0; j < 4; ++j) { const f32x4 g4 = gg[64 * j], s4 = sc[64 * j], h4 = sh[64 * j]; const f32x4 y = (v[j] * rstd) * g4; const f32x4 h = y * (1.0f + s4) + h4;
            o[64 * j] = (u32x2){pk2(h.x, h.y), pk2(h.z, h.w)}; }
    }
    if (zero_of) {
        const int gt = F.bid * NTHR + F.tid, NGT = F.G * NTHR;
        f32x4* a = (f32x4*)F.out; for (int i = gt; i < ML * (D / 4); i += NGT) a[i] = (f32x4){0.f, 0.f, 0.f, 0.f};
        f32x4* b = (f32x4*)(F.ws + WS_OFC); for (int i = gt; i < MC * (D / 4); i += NGT) b[i] = (f32x4){0.f, 0.f, 0.f, 0.f};
    }
}
__device__ __forceinline__ void step_final() {
    const Frame F = make_frame();
    const int gw = F.bid * NWAVES + F.wave, NGW = F.G * NWAVES;
    const float* X = (const float*)(F.ws + WS_X);
    for (int row = gw; row < ML; row += NGW) {
        const f32x4* xr = (const f32x4*)(X + (size_t)row * D) + F.lane; const f32x4* gg = (const f32x4*)INP(I_FG) + F.lane;
        f32x4 v[4]; float s = 0.f;
#pragma unroll
        for (int j = 0; j < 4; ++j) { v[j] = xr[64 * j]; s += (v[j].x * v[j].x + v[j].y * v[j].y) + (v[j].z * v[j].z + v[j].w * v[j].w); }
        const float rstd = 1.0f / sqrtf(wave_sum(s) * (1.f / D) + EPS);
        f32x4* o = (f32x4*)(F.out + (size_t)row * D) + F.lane;
#pragma unroll
        for (int j = 0; j < 4; ++j) o[64 * j] = (v[j] * rstd) * gg[64 * j];
    }
}

__device__ __forceinline__ void step_gdn_scan(int j) {
    const Frame F = make_frame();
    LAS float* qs = (LAS float*)F.lds;
    LAS float* ks = qs + 64 * 128;
    LAS float* vs = ks + 64 * 128;
    LAS float* ga = vs + 64 * 128;
    LAS float* be = ga + 64;
    const bf16* Z = (const bf16*)(F.ws + WS_Z);
    const float* AB = (const float*)(F.ws + WS_AB);
    const float* cw = INP(I_GCONV) + (size_t)j * 3 * 3072;
    float* OFC = (float*)(F.ws + WS_OFC);
    for (int it = F.bid; it < 32; it += F.G) {
        const int b = it >> 4, h = (it >> 1) & 7, dir = it & 1;
        const float Aco = expf(INP(I_GALOG)[j * 16 + dir * 8 + h]); const float dtb = INP(I_GDT)[j * 16 + dir * 8 + h];
        float S[64];
#pragma unroll
        for (int i = 0; i < 64; ++i) S[i] = 0.f;
        const int jcol = F.tid >> 1, half = F.tid & 1;
        for (int n = 0; n < 132; ++n) {
            const bool isctx = n < 4; const int L = isctx ? CT : T; const int p0 = isctx ? 64 * n : 64 * (n - 4); const int rbase = isctx ? ML + b * CT : b * T;
            for (int idx = F.tid; idx < 64 * 384; idx += NTHR) {
                const int c = idx / 384, ch = idx % 384, part = ch >> 7, e = ch & 127;
                const int p = p0 + c; const int t = dir ? (L - 1 - p) : p; const int col = part * 1024 + h * 128 + e;
                float acc = 0.f;
#pragma unroll
                for (int tap = 0; tap < 3; ++tap) { const int tt = t + tap - 1; if (tt >= 0 && tt < L) acc += cw[tap * 3072 + col] * bf2f(Z[(size_t)(rbase + tt) * 4096 + col]); }
                acc = silu_f(acc);
                LAS float* dst = part == 0 ? qs : (part == 1 ? ks : vs); dst[c * 128 + e] = acc;
            }
            if (F.tid < 64) { const int p = p0 + F.tid; const int t = dir ? (L - 1 - p) : p; const size_t row = (size_t)(rbase + t);
                const float av = AB[row * 32 + dir * 8 + h], bv = AB[row * 32 + 16 + dir * 8 + h];
                const float x = av + dtb; const float sp = x > 20.f ? x : log1pf(expf(x));
                ga[F.tid] = expf(-Aco * sp); be[F.tid] = 1.f / (1.f + expf(-bv)); }
            __syncthreads();
#pragma unroll 1
            for (int rr = 0; rr < 8; ++rr) { const int c = F.wave * 8 + rr;
                const float q0 = qs[c * 128 + F.lane], q1 = qs[c * 128 + 64 + F.lane]; const float sq = 0.08838834764831845f / sqrtf(wave_sum(q0 * q0 + q1 * q1) + EPS);
                qs[c * 128 + F.lane] = q0 * sq; qs[c * 128 + 64 + F.lane] = q1 * sq;
                const float k0 = ks[c * 128 + F.lane], k1 = ks[c * 128 + 64 + F.lane]; const float sk = 1.0f / sqrtf(wave_sum(k0 * k0 + k1 * k1) + EPS);
                ks[c * 128 + F.lane] = k0 * sk; ks[c * 128 + 64 + F.lane] = k1 * sk; }
            __syncthreads();
            if (F.tid < 256) {
#pragma unroll 1
                for (int c = 0; c < 64; ++c) {
                    const float a = ga[c], bt = be[c];
                    const LAS f32x4* k4 = (const LAS f32x4*)(ks + c * 128 + 64 * half); const LAS f32x4* q4 = (const LAS f32x4*)(qs + c * 128 + 64 * half);
                    float dot = 0.f;
#pragma unroll
                    for (int i = 0; i < 16; ++i) { const f32x4 kv = k4[i]; dot += kv.x * S[4 * i] + kv.y * S[4 * i + 1] + kv.z * S[4 * i + 2] + kv.w * S[4 * i + 3]; }
                    dot += __shfl_xor(dot, 1);
                    const float tmp = bt * (vs[c * 128 + jcol] - a * dot);
                    float o = 0.f;
#pragma unroll
                    for (int i = 0; i < 16; ++i) { const f32x4 kv = k4[i]; const f32x4 qv = q4[i];
                        S[4 * i] = a * S[4 * i] + kv.x * tmp; S[4 * i + 1] = a * S[4 * i + 1] + kv.y * tmp; S[4 * i + 2] = a * S[4 * i + 2] + kv.z * tmp; S[4 * i + 3] = a * S[4 * i + 3] + kv.w * tmp;
                        o += qv.x * S[4 * i] + qv.y * S[4 * i + 1] + qv.z * S[4 * i + 2] + qv.w * S[4 * i + 3]; }
                    o += __shfl_xor(o, 1);
                    const int p = p0 + c; const int t = dir ? (L - 1 - p) : p;
                    float* dst = isctx ? OFC + (size_t)(b * CT + t) * D : F.out + (size_t)(b * T + t) * D;
                    if (half == 0) atomicAdd(dst + h * 128 + jcol, o);
                }
            }
            __syncthreads();
        }
    }
}
__device__ __forceinline__ void step_gdn_norm(int j) {
    const Frame F = make_frame();
    const int gw = F.bid * NWAVES + F.wave, NGW = F.G * NWAVES;
    const bf16* Z = (const bf16*)(F.ws + WS_Z); bf16* Y = (bf16*)(F.ws + WS_Y); const float* ng = INP(I_GNG) + j * 128;
    for (int row = gw; row < M; row += NGW) {
        const float* src = row < ML ? F.out + (size_t)row * D : (const float*)(F.ws + WS_OFC) + (size_t)(row - ML) * D;
        const f32x4* s4 = (const f32x4*)(src + 16 * F.lane);
        float v[16]; float ss = 0.f;
#pragma unroll
        for (int q = 0; q < 4; ++q) { const f32x4 x = s4[q]; v[4 * q] = x.x; v[4 * q + 1] = x.y; v[4 * q + 2] = x.z; v[4 * q + 3] = x.w; ss += (x.x * x.x + x.y * x.y) + (x.z * x.z + x.w * x.w); }
        ss += __shfl_xor(ss, 1); ss += __shfl_xor(ss, 2); ss += __shfl_xor(ss, 4);
        const float rstd = 1.0f / sqrtf(ss * (1.f / 128.f) + EPS);
        const u32x4* g4 = (const u32x4*)(Z + (size_t)row * 4096 + 3072 + 16 * F.lane);
        const int e0 = (16 * F.lane) & 127;
        u32x4 o[2];
#pragma unroll
        for (int q = 0; q < 2; ++q) { const u32x4 gz = g4[q]; unsigned w[4];
#pragma unroll
            for (int i = 0; i < 4; ++i) { const unsigned gg = gz[i]; const float g0 = bf2f(gg & 0xffffu), g1 = bf2f(gg >> 16); const int e = e0 + 8 * q + 2 * i;
                w[i] = pk2(v[8 * q + 2 * i] * rstd * ng[e] * silu_f(g0), v[8 * q + 2 * i + 1] * rstd * ng[e + 1] * silu_f(g1)); }
            o[q] = (u32x4){w[0], w[1], w[2], w[3]}; }
        u32x4* dst = (u32x4*)(Y + (size_t)row * D + 16 * F.lane); dst[0] = o[0]; dst[1] = o[1];
    }
}

__device__ __forceinline__ void step_sconv() {
    const Frame F = make_frame();
    const int gt = F.bid * NTHR + F.tid, NGT = F.G * NTHR;
    const bf16* Z = (const bf16*)(F.ws + WS_Z); bf16* Y = (bf16*)(F.ws + WS_Y); const float* cw = INP(I_SCONV);
    for (int idx = gt; idx < M * 128; idx += NGT) {
        const int row = idx >> 7, c0 = (idx & 127) * 8;
        int t, L, rbase; if (row < ML) { t = row & (T - 1); L = T; rbase = row - t; } else { const int r2 = row - ML; t = r2 & (CT - 1); L = CT; rbase = row - t; }
        float acc[8];
#pragma unroll
        for (int i = 0; i < 8; ++i) acc[i] = 0.f;
#pragma unroll
        for (int tap = 0; tap < 3; ++tap) { const int tt = t + tap - 1;
            if (tt >= 0 && tt < L) { const bf16* zr = Z + (size_t)(rbase + tt) * 3072; const u32x4 cg = *(const u32x4*)(zr + 1024 + c0), hv = *(const u32x4*)(zr + 2048 + c0);
                const f32x4 w0 = *(const f32x4*)(cw + tap * 1024 + c0), w1 = *(const f32x4*)(cw + tap * 1024 + c0 + 4); const float w[8] = {w0.x, w0.y, w0.z, w0.w, w1.x, w1.y, w1.z, w1.w};
#pragma unroll
                for (int i = 0; i < 4; ++i) { acc[2 * i] += w[2 * i] * bf2f(cg[i] & 0xffffu) * bf2f(hv[i] & 0xffffu); acc[2 * i + 1] += w[2 * i + 1] * bf2f(cg[i] >> 16) * bf2f(hv[i] >> 16); } } }
        const u32x4 bg = *(const u32x4*)(Z + (size_t)row * 3072 + c0); u32x4 o;
#pragma unroll
        for (int i = 0; i < 4; ++i) o[i] = pk2(bf2f(bg[i] & 0xffffu) * acc[2 * i], bf2f(bg[i] >> 16) * acc[2 * i + 1]);
        *(u32x4*)(Y + (size_t)row * D + c0) = o;
    }
}

__device__ __forceinline__ void step_rope() {
    const Frame F = make_frame();
    const int gw = F.bid * NWAVES + F.wave, NGW = F.G * NWAVES;
    bf16* Z = (bf16*)(F.ws + WS_Z); const f32x4* R = (const f32x4*)(F.ws + WS_ROPE);
    for (int row = gw; row < M; row += NGW) {
        u32x4* p = (u32x4*)(Z + (size_t)row * 3072 + 32 * F.lane);
        u32x4 v[4];
#pragma unroll
        for (int q = 0; q < 4; ++q) v[q] = p[q];
        const bool lat = row < ML; const float sc = F.lane < 32 ? QSCALE : 1.0f;
        const f32x4* tab = R + ((size_t)(row & (T - 1)) * 32 + 16 * (F.lane & 1)) / 2;
#pragma unroll
        for (int q = 0; q < 4; ++q) {
#pragma unroll
            for (int i = 0; i < 4; i += 2) {
                f32x4 cs = (f32x4){1.f, 0.f, 1.f, 0.f}; if (lat) cs = tab[(4 * q + i) / 2];
                { const unsigned w = v[q][i]; const float x0 = bf2f(w & 0xffffu), x1 = bf2f(w >> 16); v[q][i] = pk2((x0 * cs.x - x1 * cs.y) * sc, (x0 * cs.y + x1 * cs.x) * sc); }
                { const unsigned w = v[q][i + 1]; const float x0 = bf2f(w & 0xffffu), x1 = bf2f(w >> 16); v[q][i + 1] = pk2((x0 * cs.z - x1 * cs.w) * sc, (x0 * cs.w + x1 * cs.z) * sc); }
            }
        }
#pragma unroll
        for (int q = 0; q < 4; ++q) p[q] = v[q];
    }
    bf16* Vt = (bf16*)(F.ws + WS_H);
    LAS bf16* tl = (LAS bf16*)(F.lds + F.wave * 18432);
    for (int it = gw; it < NB * NH * (NKV / 64); it += NGW) {
        const int kt = it % (NKV / 64), bh = it / (NKV / 64), b = bh >> 3, h = bh & 7; const int kv0 = 64 * kt;
        const int srow = kv0 < CT ? ML + b * CT + kv0 : b * T + kv0 - CT;
#pragma unroll 4
        for (int i = 0; i < 16; ++i) { const int r = 4 * i + (F.lane >> 4), cc = (F.lane & 15) * 8;
            const u32x4 v = *(const u32x4*)(Z + (size_t)(srow + r) * 3072 + 2048 + h * 128 + cc);
#pragma unroll
            for (int q = 0; q < 4; ++q) { tl[(cc + 2 * q) * 72 + r] = (bf16)(v[q] & 0xffffu); tl[(cc + 2 * q + 1) * 72 + r] = (bf16)(v[q] >> 16); } }
        LDS_WAIT(); asm volatile("" ::: "memory");
#pragma unroll 4
        for (int i = 0; i < 16; ++i) { const int e = 8 * i + (F.lane >> 3), ch = F.lane & 7;
            const u32x4 v = *(const LAS u32x4*)(tl + e * 72 + ch * 8);
            *(u32x4*)(Vt + ((size_t)(bh * 128 + e)) * NKV + kv0 + ch * 8) = v; }
        LDS_WAIT(); asm volatile("" ::: "memory");
    }
}
__device__ __forceinline__ void step_attn() {
    const Frame F = make_frame();
    const bf16* Z = (const bf16*)(F.ws + WS_Z); const bf16* Vt = (const bf16*)(F.ws + WS_H); bf16* Y = (bf16*)(F.ws + WS_Y);
    LAS float* EX = (LAS float*)F.lds;
    const int r = F.lane & 31, hi = F.lane >> 5, qs = F.wave & 3, m = F.wave >> 2;
    float lmb;
    { const float* lam = INP(I_DLAM); const float t1 = lam[F.lane] * lam[64 + F.lane], t2 = lam[128 + F.lane] * lam[192 + F.lane]; lmb = expf(wave_sum(t1)) - expf(wave_sum(t2)) + LAMBDA_INIT; }
    const float* ng = INP(I_DNG);
    for (int u = F.bid; u < 1056; u += F.G) {
        int b, h, qrow0, nk;
        if (u < 1024) { b = u >> 9; h = (u >> 6) & 7; qrow0 = b * T + (u & 63) * 128; nk = NKV / 32; }
        else { const int v = u - 1024; b = v >> 4; h = (v >> 1) & 7; qrow0 = ML + b * CT + (v & 1) * 128; nk = CT / 32; }
        const int row0 = qrow0 + 32 * qs;
        bf16x8 qf[4];
#pragma unroll
        for (int d0 = 0; d0 < 4; ++d0) qf[d0] = *(const bf16x8*)(Z + (size_t)(row0 + r) * 3072 + h * 128 + m * 64 + d0 * 16 + hi * 8);
        const int kcol = 1024 + h * 128 + m * 64 + hi * 8;
        const bf16* vtb = Vt + (size_t)((b * 8 + h) * 128 + r) * NKV + 4 * hi;
        f32x16 o[4];
#pragma unroll
        for (int i = 0; i < 4; ++i)
#pragma unroll
            for (int q = 0; q < 16; ++q) o[i][q] = 0.f;
        float mref = 0.f, l = 0.f;
        for (int s = 0; s < nk; ++s) {
            const int kv0 = 32 * s; const int krow = kv0 < CT ? ML + b * CT + kv0 : b * T + kv0 - CT;
            const bf16* kp = Z + (size_t)(krow + r) * 3072 + kcol;
            bf16x8 kf[4];
#pragma unroll
            for (int d0 = 0; d0 < 4; ++d0) kf[d0] = *(const bf16x8*)(kp + d0 * 16);
            bf16x8 vf[4][2];
#pragma unroll
            for (int i = 0; i < 4; ++i)
#pragma unroll
                for (int s2 = 0; s2 < 2; ++s2) { const bf16* vp = vtb + (size_t)(32 * i) * NKV + kv0 + 16 * s2; const s16x4 lo = *(const s16x4*)vp, h8 = *(const s16x4*)(vp + 8);
                    vf[i][s2] = (bf16x8){lo[0], lo[1], lo[2], lo[3], h8[0], h8[1], h8[2], h8[3]}; }
            f32x16 S;
#pragma unroll
            for (int q = 0; q < 16; ++q) S[q] = 0.f;
#pragma unroll
            for (int d0 = 0; d0 < 4; ++d0) S = __builtin_amdgcn_mfma_f32_32x32x16_bf16(kf[d0], qf[d0], S, 0, 0, 0);
            float mx = S[0];
#pragma unroll
            for (int q = 1; q < 16; ++q) mx = fmaxf(mx, S[q]);
            mx = fmaxf(mx, __shfl_xor(mx, 32));
            if (s == 0) mref = mx;
            else if (__any(mx > mref)) { const float mn = fmaxf(mref, mx); const float al = __builtin_amdgcn_exp2f(mref - mn); l *= al; mref = mn;
#pragma unroll
                for (int i = 0; i < 4; ++i)
#pragma unroll
                    for (int q = 0; q < 16; ++q) o[i][q] *= al; }
            float ps = 0.f;
#pragma unroll
            for (int q = 0; q < 16; ++q) { S[q] = __builtin_amdgcn_exp2f(S[q] - mref); ps += S[q]; }
            l += ps;
            bf16x8 pf[2];
#pragma unroll
            for (int s2 = 0; s2 < 2; ++s2) { u32x4 w; w.x = pk2(S[8 * s2], S[8 * s2 + 1]); w.y = pk2(S[8 * s2 + 2], S[8 * s2 + 3]); w.z = pk2(S[8 * s2 + 4], S[8 * s2 + 5]); w.w = pk2(S[8 * s2 + 6], S[8 * s2 + 7]); pf[s2] = __builtin_bit_cast(bf16x8, w); }
#pragma unroll
            for (int i = 0; i < 4; ++i)
#pragma unroll
                for (int s2 = 0; s2 < 2; ++s2) o[i] = __builtin_amdgcn_mfma_f32_32x32x16_bf16(vf[i][s2], pf[s2], o[i], 0, 0, 0);
        }
        l += __shfl_xor(l, 32);
        const float f = (m == 1 ? lmb : 1.0f) / l;
        LAS float* ex = EX + (size_t)m * 128 * 129 + (qs * 32 + r) * 129;
#pragma unroll
        for (int i = 0; i < 4; ++i)
#pragma unroll
            for (int q = 0; q < 16; ++q) ex[32 * i + crow(q, hi)] = o[i][q] * f;
        __syncthreads();
#pragma unroll 1
        for (int rr = 0; rr < 16; ++rr) { const int row = 16 * F.wave + rr;
            const float a0 = EX[row * 129 + F.lane] - EX[128 * 129 + row * 129 + F.lane], a1 = EX[row * 129 + 64 + F.lane] - EX[128 * 129 + row * 129 + 64 + F.lane];
            const float rstd = (1.0f - LAMBDA_INIT) / sqrtf(wave_sum(a0 * a0 + a1 * a1) * (1.f / 128.f) + EPS);
            bf16* yr = Y + (size_t)(qrow0 + row) * D + h * 128;
            yr[F.lane] = (bf16)(pk2(a0 * rstd * ng[F.lane], 0.f) & 0xffffu); yr[64 + F.lane] = (bf16)(pk2(a1 * rstd * ng[64 + F.lane], 0.f) & 0xffffu); }
        __syncthreads();
    }
}

constexpr int PD_BYTES = 12800, PD_ATT = 6144, PD_EG = 12288, PD_EW = 12544;
__device__ __forceinline__ unsigned off_a(unsigned row, unsigned ch) { return 2048u * (row >> 3) + 512u * (ch >> 2) + 64u * (row & 7) + 16u * ((ch & 3) ^ ((row >> 2) & 3)); }
__device__ __forceinline__ int frag_off(int c, int s) {
    const int slot = (c >> 5) == (s >> 5) ? ((c >> 5) ? 2 : 0) : 1, s2 = (s & 31) >> 4, hh = ((s & 15) >> 2) & 1, jj = ((s & 15) >> 3) * 4 + (s & 3), r = c & 31;
    return slot * 2048 + s2 * 1024 + (hh * 32 + r) * 16 + jj * 2;
}
__device__ __forceinline__ void step_gdn_prep(int j, bool dry = false, int skip = 0) {
    const Frame F = make_frame();
    LAS float* STG = (LAS float*)F.lds;
    LAS float* KK = (LAS float*)F.lds;
    LAS float* QK = KK + 64 * 68;
    LAS float* LP = (LAS float*)(F.lds + 34816);
    LAS float* TS = (LAS float*)(F.lds + 67584);
    LAS unsigned char* QI = F.lds + 102400; LAS unsigned char* KI = F.lds + 118784;
    LAS float* SM = (LAS float*)(F.lds + 135168);
    bf16* Z = (bf16*)(F.ws + WS_Z); const float* AB = (const float*)(F.ws + WS_AB); const bf16* HALO = (const bf16*)(F.ws + WS_HALO); unsigned char* PD = F.ws + WS_PD;
    const float* cw = INP(I_GCONV) + (size_t)j * 3 * 3072;
    const int r = F.lane & 31, hi = F.lane >> 5;
    for (int it = F.bid; it < NB * NH * 132; it += F.G) {
        const int n = it % 132, bh = it / 132, b = bh >> 3, h = bh & 7;
        const bool isctx = n < 4; const int L = isctx ? CT : T; const int t0 = isctx ? 64 * n : 64 * (n - 4); const int row0 = (isctx ? ML + b * CT : b * T) + t0;
        if (F.tid < 384) {
            const int g8 = F.tid % 48, rp = F.tid / 48, part = g8 >> 4, e0 = (g8 & 15) * 8; const int col = part * 1024 + h * 128 + e0;
            const float* wp = cw + col;
            f32x4 wt[3][2];
#pragma unroll
            for (int tap = 0; tap < 3; ++tap) { wt[tap][0] = *(const f32x4*)(wp + tap * 3072); wt[tap][1] = *(const f32x4*)(wp + tap * 3072 + 4); }
            u32x4 zr[10];
#pragma unroll
            for (int ri = 0; ri < 10; ++ri) { const int c = 8 * rp - 1 + ri; const int t = t0 + c;
                const bf16* src = c < 0 ? HALO + ((size_t)((row0 >> 6) - 1) * 2 + 1) * 3072 + col : (c > 63 ? HALO + ((size_t)((row0 >> 6) + 1) * 2) * 3072 + col : Z + (size_t)(row0 + c) * 4096 + col);
                const bool valid = t >= 0 && t < L;
                if (!valid) src = Z + (size_t)row0 * 4096 + col;
                zr[ri] = *(const u32x4*)src; if (!valid) zr[ri] = (u32x4){0u, 0u, 0u, 0u}; }
#pragma unroll
            for (int i = 0; i < 8; ++i) { float o[8];
#pragma unroll
                for (int q = 0; q < 4; ++q) { const unsigned a = zr[i][q], bq = zr[i + 1][q], cq = zr[i + 2][q];
                    o[2 * q] = silu_fast(wt[0][q >> 1][2 * (q & 1)] * bf2f(a & 0xffffu) + wt[1][q >> 1][2 * (q & 1)] * bf2f(bq & 0xffffu) + wt[2][q >> 1][2 * (q & 1)] * bf2f(cq & 0xffffu));
                    o[2 * q + 1] = silu_fast(wt[0][q >> 1][2 * (q & 1) + 1] * bf2f(a >> 16) + wt[1][q >> 1][2 * (q & 1) + 1] * bf2f(bq >> 16) + wt[2][q >> 1][2 * (q & 1) + 1] * bf2f(cq >> 16)); }
                LAS f32x4* dst = (LAS f32x4*)(STG + (8 * rp + i) * 388 + part * 128 + e0); dst[0] = (f32x4){o[0], o[1], o[2], o[3]}; dst[1] = (f32x4){o[4], o[5], o[6], o[7]}; }
        }
        if (F.wave >= 6) {
            const int d = F.wave - 6, c = F.lane; const size_t row = (size_t)(row0 + c);
            const float Aco = expf(INP(I_GALOG)[j * 16 + d * 8 + h]), dtb = INP(I_GDT)[j * 16 + d * 8 + h];
            const float x = AB[row * 32 + d * 8 + h] + dtb, bb = AB[row * 32 + 16 + d * 8 + h];
            const float sp = x > 20.f ? x : log1pf(expf(x));
            float s = -Aco * sp;
#pragma unroll
            for (int o = 1; o < 64; o <<= 1) { const float up = __shfl_up(s, o), dn = __shfl_down(s, o); if (d ? (c + o < 64) : (c >= o)) s += d ? dn : up; }
            SM[d * 64 + c] = 1.f / (1.f + expf(-bb)); SM[128 + d * 64 + c] = s;
        }
        __syncthreads();
        if (skip & 8) continue;
        { float qv[8][2], kv[8][2], sq[8], sk[8];
#pragma unroll
            for (int rr = 0; rr < 8; ++rr) { const LAS float* sr = STG + (F.wave * 8 + rr) * 388;
                qv[rr][0] = sr[F.lane]; qv[rr][1] = sr[64 + F.lane]; kv[rr][0] = sr[128 + F.lane]; kv[rr][1] = sr[192 + F.lane];
                sq[rr] = qv[rr][0] * qv[rr][0] + qv[rr][1] * qv[rr][1]; sk[rr] = kv[rr][0] * kv[rr][0] + kv[rr][1] * kv[rr][1]; }
#pragma unroll
            for (int o = 1; o < 64; o <<= 1) {
#pragma unroll
                for (int rr = 0; rr < 8; ++rr) { sq[rr] += __shfl_xor(sq[rr], o); sk[rr] += __shfl_xor(sk[rr], o); } }
#pragma unroll
            for (int rr = 0; rr < 8; ++rr) { const int c = F.wave * 8 + rr; const LAS float* sr = STG + c * 388;
                const float fq = 0.08838834764831845f / sqrtf(sq[rr] + EPS), fk = 1.0f / sqrtf(sk[rr] + EPS);
                const unsigned o0 = off_a(c, F.lane >> 3) + 2 * (F.lane & 7), o1 = off_a(c, 8 + (F.lane >> 3)) + 2 * (F.lane & 7);
                *(LAS bf16*)(QI + o0) = (bf16)(pk2(qv[rr][0] * fq, 0.f) & 0xffffu); *(LAS bf16*)(QI + o1) = (bf16)(pk2(qv[rr][1] * fq, 0.f) & 0xffffu);
                *(LAS bf16*)(KI + o0) = (bf16)(pk2(kv[rr][0] * fk, 0.f) & 0xffffu); *(LAS bf16*)(KI + o1) = (bf16)(pk2(kv[rr][1] * fk, 0.f) & 0xffffu);
                bf16* vd = Z + (size_t)(row0 + c) * 4096 + 2048 + h * 128;
                if (!dry) { vd[F.lane] = (bf16)(pk2(sr[256 + F.lane], 0.f) & 0xffffu); vd[64 + F.lane] = (bf16)(pk2(sr[320 + F.lane], 0.f) & 0xffffu); } } }
        __syncthreads();
        if (skip & 4) continue;
        { const int prod = F.wave >> 2, mt = (F.wave >> 1) & 1, nt = F.wave & 1; LAS unsigned char* AI = prod ? QI : KI;
            f32x16 acc;
#pragma unroll
            for (int i = 0; i < 16; ++i) acc[i] = 0.f;
#pragma unroll
            for (int ks = 0; ks < 8; ++ks) { const bf16x8 a = *(const LAS bf16x8*)(AI + off_a(32 * mt + r, 2 * ks + hi)), bq = *(const LAS bf16x8*)(KI + off_a(32 * nt + r, 2 * ks + hi));
                acc = __builtin_amdgcn_mfma_f32_32x32x16_bf16(a, bq, acc, 0, 0, 0); }
            LAS float* dst = prod ? QK : KK;
#pragma unroll
            for (int i = 0; i < 16; ++i) dst[(32 * mt + crow(i, hi)) * 68 + 32 * nt + r] = acc[i]; }
        __syncthreads();
        if (skip & 2) continue;
        for (int idx = F.tid; idx < 8192; idx += NTHR) { const int d = idx >> 12, p = (idx >> 6) & 63, ps = idx & 63; float val = 0.f;
            if (ps < p) { const int c = d ? 63 - p : p, s = d ? 63 - ps : ps; val = SM[d * 64 + c] * KK[c * 68 + s] * expf(SM[128 + d * 64 + c] - SM[128 + d * 64 + s]); }
            LP[idx] = val; }
        __syncthreads();
        unsigned char* rec = PD + ((size_t)((b * 8 + h) * 132 + n)) * PD_BYTES;
        constexpr size_t DSTRIDE = (size_t)16 * 132 * PD_BYTES;
        if (F.wave < 2) { if (!(skip & 1)) {
            const int d = F.wave, jc = F.lane;
            float Lr[64], Tc[64];
#pragma unroll
            for (int p = 1; p < 64; ++p) Lr[p] = LP[d * 4096 + p * 64 + F.lane];
#pragma unroll
            for (int p = 0; p < 64; ++p) { float acc[4]; acc[0] = (p == jc) ? 1.f : 0.f; acc[1] = 0.f; acc[2] = 0.f; acc[3] = 0.f;
#pragma unroll
                for (int sx = 0; sx < p; ++sx) { const float l = __int_as_float(__builtin_amdgcn_readlane(__float_as_int(Lr[p]), sx)); acc[sx & 3] -= l * Tc[sx]; }
                Tc[p] = (acc[0] + acc[1]) + (acc[2] + acc[3]); }
            const int s = d ? 63 - jc : jc;
#pragma unroll
            for (int p = 0; p < 64; ++p) TS[d * 4352 + (d ? 63 - p : p) * 68 + s] = Tc[p]; }
        } else {
            for (int q = F.tid - 128; q < 768; q += NTHR - 128) { const int d = q / 384, qq = q % 384, slot = qq >> 7, s2 = (qq >> 6) & 1, ln = qq & 63, hh = ln >> 5, rr = ln & 31;
                const int mtr = slot == 0 ? 0 : (slot == 2 ? 1 : (d ? 0 : 1)), mtc = slot == 0 ? 0 : (slot == 2 ? 1 : (d ? 1 : 0));
                const int c = 32 * mtr + rr, sa = 32 * mtc + 16 * s2 + 4 * hh; const float gcc = SM[128 + d * 64 + c];
                const f32x4 qa = *(const LAS f32x4*)(QK + c * 68 + sa), qb = *(const LAS f32x4*)(QK + c * 68 + sa + 8);
                const f32x4 ga = *(const LAS f32x4*)(SM + 128 + d * 64 + sa), gb = *(const LAS f32x4*)(SM + 128 + d * 64 + sa + 8);
                float v[8];
#pragma unroll
                for (int i = 0; i < 4; ++i) { const int s0 = sa + i, s1 = sa + 8 + i; const bool m0 = d ? (s0 >= c) : (s0 <= c), m1 = d ? (s1 >= c) : (s1 <= c);
                    v[i] = m0 ? qa[i] * expf(gcc - ga[i]) : 0.f; v[4 + i] = m1 ? qb[i] * expf(gcc - gb[i]) : 0.f; }
                if (!dry) *(u32x4*)(rec + d * DSTRIDE + PD_ATT + qq * 16) = (u32x4){pk2(v[0], v[1]), pk2(v[2], v[3]), pk2(v[4], v[5]), pk2(v[6], v[7])}; }
            if (F.tid >= 128 && F.tid < 256) { const int d = (F.tid - 128) >> 6, c = F.tid & 63; const float gl = SM[128 + d * 64 + (d ? 0 : 63)], gcv = SM[128 + d * 64 + c];
                if (!dry) { *(float*)(rec + d * DSTRIDE + PD_EG + 4 * c) = expf(gcv); *(float*)(rec + d * DSTRIDE + PD_EW + 4 * c) = expf(gl - gcv); } }
        }
        __syncthreads();
        for (int q = F.tid; q < 768; q += NTHR) { const int d = q / 384, qq = q % 384, slot = qq >> 7, s2 = (qq >> 6) & 1, ln = qq & 63, hh = ln >> 5, rr = ln & 31;
            const int mtr = slot == 0 ? 0 : (slot == 2 ? 1 : (d ? 0 : 1)), mtc = slot == 0 ? 0 : (slot == 2 ? 1 : (d ? 1 : 0));
            const int c = 32 * mtr + rr, sa = 32 * mtc + 16 * s2 + 4 * hh;
            const f32x4 ta = *(const LAS f32x4*)(TS + d * 4352 + c * 68 + sa), tb = *(const LAS f32x4*)(TS + d * 4352 + c * 68 + sa + 8);
            const f32x4 ba = *(const LAS f32x4*)(SM + d * 64 + sa), bb = *(const LAS f32x4*)(SM + d * 64 + sa + 8);
            if (!dry) *(u32x4*)(rec + d * DSTRIDE + qq * 16) = (u32x4){pk2(ta[0] * ba[0], ta[1] * ba[1]), pk2(ta[2] * ba[2], ta[3] * ba[3]), pk2(tb[0] * bb[0], tb[1] * bb[1]), pk2(tb[2] * bb[2], tb[3] * bb[3])}; }
        if (!dry) for (int idx = F.tid; idx < 2048; idx += NTHR) { const int img = idx >> 10, pn = idx & 1023;
            *(u32x4*)((unsigned char*)(Z + (size_t)(row0 + (pn >> 4)) * 4096 + img * 1024 + h * 128) + (pn & 15) * 16) = *(const LAS u32x4*)((img ? KI : QI) + pn * 16); }
        __syncthreads();
    }
}

#define PACK8(x, b) __builtin_bit_cast(bf16x8, (u32x4){pk2((x)[(b)], (x)[(b) + 1]), pk2((x)[(b) + 2], (x)[(b) + 3]), pk2((x)[(b) + 4], (x)[(b) + 5]), pk2((x)[(b) + 6], (x)[(b) + 7])})
#define MFMA32(a, b, c) __builtin_amdgcn_mfma_f32_32x32x16_bf16((a), (b), (c), 0, 0, 0)
typedef short v4i16_t __attribute__((ext_vector_type(4)));
__device__ __forceinline__ void step_convert_rest() {
    const Frame F = make_frame();
    if (F.bid >= 32 && F.G > 32)
        convert_weights(F.ws, 0xffffu & ~((1u << 0) | (1u << 4) | (1u << 8) | (1u << 10)), (F.bid - 32) * NWAVES + F.wave, (F.G - 32) * NWAVES, (F.bid - 32) * NTHR + F.tid, (F.G - 32) * NTHR, F.lds, F.wave, F.lane);
}
__device__ __forceinline__ void step_gdn_scan2() {
    const Frame F = make_frame();
    constexpr int BUF = 61952, B_K = 0, B_Q = 16384, B_V = 32768, B_PD = 49152;
    const bf16* Z = (const bf16*)(F.ws + WS_Z); const unsigned char* PD = F.ws + WS_PD;
    const int r = F.lane & 31, hi = F.lane >> 5;
    for (int it = F.bid; it < 32; it += F.G) {
        const int b = it >> 4, h = (it >> 1) & 7, dir = it & 1;
        const unsigned char* pdb = PD + (size_t)(((dir * 2 + b) * 8 + h) * 132) * PD_BYTES;
#define CHUNK_OF(sp) (dir ? ((sp) < 4 ? 3 - (sp) : 135 - (sp)) : (sp))
#define ROW0_OF(n) ((n) < 4 ? ML + b * CT + 64 * (n) : b * T + 64 * ((n) - 4))
        if (F.wave >= 4) {
            const int lt = F.tid - 256;
            u32x4 rg[16];
#define LOAD_CHUNK(sp) do { const int n_ = CHUNK_OF(sp); const int row0_ = ROW0_OF(n_); \
                _Pragma("unroll") for (int i = 0; i < 4; ++i) { const int pn = lt + 256 * i; const unsigned char* src = (const unsigned char*)(Z + (size_t)(row0_ + (pn >> 4)) * 4096 + h * 128) + (pn & 15) * 16; \
                    rg[i] = *(const u32x4*)(src + 2048); rg[4 + i] = *(const u32x4*)src; rg[8 + i] = *(const u32x4*)(src + 4096); \
                    rg[12 + i] = pn < 800 ? *(const u32x4*)(pdb + (size_t)n_ * PD_BYTES + pn * 16) : (u32x4){0u, 0u, 0u, 0u}; } } while (0)
#define WRITE_CHUNK(bufb) do { LAS unsigned char* base_ = F.lds + (bufb); \
                _Pragma("unroll") for (int i = 0; i < 4; ++i) { const int pn = lt + 256 * i; *(LAS u32x4*)(base_ + B_K + pn * 16) = rg[i]; *(LAS u32x4*)(base_ + B_Q + pn * 16) = rg[4 + i]; \
                    *(LAS u32x4*)(base_ + B_V + pn * 16) = rg[8 + i]; if (pn < 800) *(LAS u32x4*)(base_ + B_PD + pn * 16) = rg[12 + i]; } } while (0)
            LOAD_CHUNK(0); WRITE_CHUNK(0); LOAD_CHUNK(1);
            __syncthreads();
            for (int sp = 0; sp < 132; ++sp) {
                if (sp + 1 < 132) WRITE_CHUNK(((sp + 1) & 1) * BUF);
                if (sp + 2 < 132) LOAD_CHUNK(sp + 2);
                __syncthreads();
            }
#undef LOAD_CHUNK
#undef WRITE_CHUNK
        } else {
            const int w = F.wave;
            f32x16 S[4];
#pragma unroll
            for (int kt = 0; kt < 4; ++kt)
#pragma unroll
                for (int i = 0; i < 16; ++i) S[kt][i] = 0.f;
            const int x = (r >> 2) & 3; const int rowb = 2048 * (r >> 3) + 64 * (r & 7);
            int oa[2], ob[2];
#pragma unroll
            for (int s2 = 0; s2 < 2; ++s2) { oa[s2] = rowb + 16 * ((2 * s2) ^ x) + 8 * hi; ob[s2] = rowb + 16 * ((2 * s2 + 1) ^ x) + 8 * hi; }
            const int blk = (F.lane >> 4) & 1, q = (F.lane & 15) >> 2, p = F.lane & 3, cb = 2 * blk + (p >> 1);
            int trb[2];
#pragma unroll
            for (int t = 0; t < 2; ++t) trb[t] = 64 * (4 * hi + q) + 8 * (p & 1) + 16 * (cb ^ ((2 * t + hi) & 3)) + 2048 * t;
            const int vb = 4 * hi * 256 + (32 * w + r) * 2;
            __syncthreads();
            for (int sp = 0; sp < 132; ++sp) {
                const int n = CHUNK_OF(sp); const int row0 = ROW0_OF(n);
                LAS unsigned char* B = F.lds + (sp & 1) * BUF;
                LAS unsigned char* KI = B + B_K; LAS unsigned char* QI = B + B_Q; LAS unsigned char* VI = B + B_V; LAS unsigned char* PR = B + B_PD;
                bf16x8 Sb[4][2];
#pragma unroll
                for (int kt = 0; kt < 4; ++kt) { Sb[kt][0] = PACK8(S[kt], 0); Sb[kt][1] = PACK8(S[kt], 8); }
                f32x16 KS[2];
#pragma unroll
                for (int mt = 0; mt < 2; ++mt) {
#pragma unroll
                    for (int i = 0; i < 16; ++i) KS[mt][i] = 0.f;
#pragma unroll
                    for (int kt = 0; kt < 4; ++kt)
#pragma unroll
                        for (int s2 = 0; s2 < 2; ++s2) {
                            const s16x4 k0 = *(const LAS s16x4*)(KI + 8192 * mt + 512 * kt + oa[s2]), k1 = *(const LAS s16x4*)(KI + 8192 * mt + 512 * kt + ob[s2]);
                            KS[mt] = MFMA32(((bf16x8){k0[0], k0[1], k0[2], k0[3], k1[0], k1[1], k1[2], k1[3]}), Sb[kt][s2], KS[mt]); }
                    asm volatile("" ::: "memory");
                }
                bf16x8 Rb[2][2];
#pragma unroll
                for (int mt = 0; mt < 2; ++mt) { f32x16 R;
#pragma unroll
                    for (int g = 0; g < 4; ++g) { const f32x4 e4 = *(const LAS f32x4*)(PR + PD_EG + 4 * (32 * mt + 8 * g + 4 * hi));
#pragma unroll
                        for (int i = 0; i < 4; ++i) { const float v = bf2f(*(const LAS bf16*)(VI + vb + (32 * mt + 8 * g + i) * 256)); R[4 * g + i] = v - e4[i] * KS[mt][4 * g + i]; } }
                    Rb[mt][0] = PACK8(R, 0); Rb[mt][1] = PACK8(R, 8); }
                f32x16 vn[2], o[2];
#pragma unroll
                for (int i = 0; i < 16; ++i) { vn[0][i] = 0.f; vn[1][i] = 0.f; }
#define TFR(base, slot, s2) (*(const LAS bf16x8*)(PR + (base) + (slot) * 2048 + (s2) * 1024 + F.lane * 16))
                vn[0] = MFMA32(TFR(0, 0, 0), Rb[0][0], vn[0]); vn[0] = MFMA32(TFR(0, 0, 1), Rb[0][1], vn[0]);
                vn[1] = MFMA32(TFR(0, 2, 0), Rb[1][0], vn[1]); vn[1] = MFMA32(TFR(0, 2, 1), Rb[1][1], vn[1]);
                if (dir) { vn[0] = MFMA32(TFR(0, 1, 0), Rb[1][0], vn[0]); vn[0] = MFMA32(TFR(0, 1, 1), Rb[1][1], vn[0]); }
                else     { vn[1] = MFMA32(TFR(0, 1, 0), Rb[0][0], vn[1]); vn[1] = MFMA32(TFR(0, 1, 1), Rb[0][1], vn[1]); }
                asm volatile("" ::: "memory");
                f32x16 QS[2];
#pragma unroll
                for (int mt = 0; mt < 2; ++mt) {
#pragma unroll
                    for (int i = 0; i < 16; ++i) QS[mt][i] = 0.f;
#pragma unroll
                    for (int kt = 0; kt < 4; ++kt)
#pragma unroll
                        for (int s2 = 0; s2 < 2; ++s2) {
                            const s16x4 q0 = *(const LAS s16x4*)(QI + 8192 * mt + 512 * kt + oa[s2]), q1 = *(const LAS s16x4*)(QI + 8192 * mt + 512 * kt + ob[s2]);
                            QS[mt] = MFMA32(((bf16x8){q0[0], q0[1], q0[2], q0[3], q1[0], q1[1], q1[2], q1[3]}), Sb[kt][s2], QS[mt]); }
                    asm volatile("" ::: "memory");
                }
                bf16x8 Vb[2][2], Wb[2][2];
#pragma unroll
                for (int mt = 0; mt < 2; ++mt) { f32x16 W;
#pragma unroll
                    for (int g = 0; g < 4; ++g) { const f32x4 e4 = *(const LAS f32x4*)(PR + PD_EG + 4 * (32 * mt + 8 * g + 4 * hi)), w4 = *(const LAS f32x4*)(PR + PD_EW + 4 * (32 * mt + 8 * g + 4 * hi));
#pragma unroll
                        for (int i = 0; i < 4; ++i) { o[mt][4 * g + i] = e4[i] * QS[mt][4 * g + i]; W[4 * g + i] = w4[i] * vn[mt][4 * g + i]; } }
                    Vb[mt][0] = PACK8(vn[mt], 0); Vb[mt][1] = PACK8(vn[mt], 8); Wb[mt][0] = PACK8(W, 0); Wb[mt][1] = PACK8(W, 8); }
                o[0] = MFMA32(TFR(PD_ATT, 0, 0), Vb[0][0], o[0]); o[0] = MFMA32(TFR(PD_ATT, 0, 1), Vb[0][1], o[0]);
                o[1] = MFMA32(TFR(PD_ATT, 2, 0), Vb[1][0], o[1]); o[1] = MFMA32(TFR(PD_ATT, 2, 1), Vb[1][1], o[1]);
                if (dir) { o[0] = MFMA32(TFR(PD_ATT, 1, 0), Vb[1][0], o[0]); o[0] = MFMA32(TFR(PD_ATT, 1, 1), Vb[1][1], o[0]); }
                else     { o[1] = MFMA32(TFR(PD_ATT, 1, 0), Vb[0][0], o[1]); o[1] = MFMA32(TFR(PD_ATT, 1, 1), Vb[0][1], o[1]); }
#undef TFR
                asm volatile("" ::: "memory");
                const float cd = *(const LAS float*)(PR + PD_EG + 4 * (dir ? 0 : 63));
#pragma unroll
                for (int kt = 0; kt < 4; ++kt) {
#pragma unroll
                    for (int i = 0; i < 16; ++i) S[kt][i] *= cd;
#pragma unroll
                    for (int mt = 0; mt < 2; ++mt)
#pragma unroll
                        for (int s2 = 0; s2 < 2; ++s2) {
                            const s16x4 a0 = __builtin_bit_cast(s16x4, __builtin_amdgcn_ds_read_tr16_b64_v4i16((LAS v4i16_t*)(KI + 8192 * mt + 4096 * s2 + 512 * kt + trb[0])));
                            const s16x4 a1 = __builtin_bit_cast(s16x4, __builtin_amdgcn_ds_read_tr16_b64_v4i16((LAS v4i16_t*)(KI + 8192 * mt + 4096 * s2 + 512 * kt + trb[1])));
                            S[kt] = MFMA32(((bf16x8){a0[0], a0[1], a0[2], a0[3], a1[0], a1[1], a1[2], a1[3]}), Wb[mt][s2], S[kt]); }
                    asm volatile("" ::: "memory");
                }
                { bf16* ob_ = n < 4 ? (bf16*)(F.ws + WS_OFC) + ((size_t)dir * MC + (row0 - ML)) * D : (bf16*)F.out + ((size_t)dir * ML + row0) * D;
                    bf16* oc = ob_ + h * 128 + 32 * w + r;
#pragma unroll
                    for (int mt = 0; mt < 2; ++mt)
#pragma unroll
                        for (int i = 0; i < 16; ++i) oc[(size_t)(32 * mt + crow(i, hi)) * D] = (bf16)(pk2(o[mt][i], 0.f) & 0xffffu); }
                __syncthreads();
            }
        }
#undef CHUNK_OF
#undef ROW0_OF
    }
}
__device__ __forceinline__ void step_gdn_norm2(int j) {
    const Frame F = make_frame();
    const int gw = F.bid * NWAVES + F.wave, NGW = F.G * NWAVES;
    const bf16* Z = (const bf16*)(F.ws + WS_Z); bf16* Y = (bf16*)(F.ws + WS_Y); const float* ng = INP(I_GNG) + j * 128;
    for (int row = gw; row < M; row += NGW) {
        const bf16* of = row < ML ? (const bf16*)F.out + (size_t)row * D : (const bf16*)(F.ws + WS_OFC) + (size_t)(row - ML) * D;
        const bf16* ob = row < ML ? of + (size_t)ML * D : of + (size_t)MC * D;
        const u32x4* f4 = (const u32x4*)(of + 16 * F.lane); const u32x4* b4 = (const u32x4*)(ob + 16 * F.lane);
        float v[16]; float ss = 0.f;
#pragma unroll
        for (int q = 0; q < 2; ++q) { const u32x4 a = f4[q], bq = b4[q];
#pragma unroll
            for (int i = 0; i < 4; ++i) { const float x0 = bf2f(a[i] & 0xffffu) + bf2f(bq[i] & 0xffffu), x1 = bf2f(a[i] >> 16) + bf2f(bq[i] >> 16); v[8 * q + 2 * i] = x0; v[8 * q + 2 * i + 1] = x1; ss += x0 * x0 + x1 * x1; } }
        ss += __shfl_xor(ss, 1); ss += __shfl_xor(ss, 2); ss += __shfl_xor(ss, 4);
        const float rstd = 1.0f / sqrtf(ss * (1.f / 128.f) + EPS);
        const u32x4* g4 = (const u32x4*)(Z + (size_t)row * 4096 + 3072 + 16 * F.lane);
        const int e0 = (16 * F.lane) & 127;
        u32x4 o[2];
#pragma unroll
        for (int q = 0; q < 2; ++q) { const u32x4 gz = g4[q]; unsigned wv[4];
#pragma unroll
            for (int i = 0; i < 4; ++i) { const unsigned gg = gz[i]; const float g0 = bf2f(gg & 0xffffu), g1 = bf2f(gg >> 16); const int e = e0 + 8 * q + 2 * i;
                wv[i] = pk2(v[8 * q + 2 * i] * rstd * ng[e] * silu_f(g0), v[8 * q + 2 * i + 1] * rstd * ng[e + 1] * silu_f(g1)); }
            o[q] = (u32x4){wv[0], wv[1], wv[2], wv[3]}; }
        u32x4* dst = (u32x4*)(Y + (size_t)row * D + 16 * F.lane); dst[0] = o[0]; dst[1] = o[1];
    }
}

__device__ __forceinline__ void step_rope2() {
    const Frame F = make_frame();
    const int gw = F.bid * NWAVES + F.wave, NGW = F.G * NWAVES;
    bf16* Z = (bf16*)(F.ws + WS_Z); const f32x4* R = (const f32x4*)(F.ws + WS_ROPE);
    for (int row = gw; row < M; row += NGW) {
        u32x4* p = (u32x4*)(Z + (size_t)row * 3072 + 32 * F.lane);
        u32x4 v[4];
#pragma unroll
        for (int q = 0; q < 4; ++q) v[q] = p[q];
        const bool lat = row < ML; const float sc = F.lane < 32 ? QSCALE : 1.0f;
        const f32x4* tab = R + ((size_t)(row & (T - 1)) * 32 + 16 * (F.lane & 1)) / 2;
#pragma unroll
        for (int q = 0; q < 4; ++q) {
#pragma unroll
            for (int i = 0; i < 4; i += 2) {
                f32x4 cs = (f32x4){1.f, 0.f, 1.f, 0.f}; if (lat) cs = tab[(4 * q + i) / 2];
                { const unsigned w = v[q][i]; const float x0 = bf2f(w & 0xffffu), x1 = bf2f(w >> 16); v[q][i] = pk2((x0 * cs.x - x1 * cs.y) * sc, (x0 * cs.y + x1 * cs.x) * sc); }
                { const unsigned w = v[q][i + 1]; const float x0 = bf2f(w & 0xffffu), x1 = bf2f(w >> 16); v[q][i + 1] = pk2((x0 * cs.z - x1 * cs.w) * sc, (x0 * cs.w + x1 * cs.z) * sc); }
            }
        }
#pragma unroll
        for (int q = 0; q < 4; ++q) p[q] = v[q];
    }
}
#define ATT_THR 4.0f
__device__ __forceinline__ void att_softmax(f32x16& p0, f32x16& p1, float& m_reg, float& l, float& alpha, bf16x8 (&pf)[2][2]) {
    float mx = fmaxf(p0[0], p1[0]);
#pragma unroll
    for (int q = 1; q < 16; ++q) mx = fmaxf(mx, fmaxf(p0[q], p1[q]));
    mx = fmaxf(mx, __shfl_xor(mx, 32));
    const float mn = (mx - m_reg > ATT_THR) ? mx : m_reg; alpha = __builtin_amdgcn_exp2f(m_reg - mn); m_reg = mn;
    float ps = 0.f;
#pragma unroll
    for (int q = 0; q < 16; ++q) { p0[q] = __builtin_amdgcn_exp2f(p0[q] - m_reg); p1[q] = __builtin_amdgcn_exp2f(p1[q] - m_reg); ps += p0[q] + p1[q]; }
    l = l * alpha + ps;
    pf[0][0] = PACK8(p0, 0); pf[0][1] = PACK8(p0, 8); pf[1][0] = PACK8(p1, 0); pf[1][1] = PACK8(p1, 8);
}
__device__ __forceinline__ void step_attn2() {
    const Frame F = make_frame();
    const bf16* Z = (const bf16*)(F.ws + WS_Z); bf16* Y = (bf16*)(F.ws + WS_Y);
    LAS float* EX = (LAS float*)F.lds;
    constexpr int KB0 = 0, VB0 = 65536;
    const int r = F.lane & 31, hi = F.lane >> 5, qs = F.wave & 3, m = F.wave >> 2;
    float lmb;
    { const float* lam = INP(I_DLAM); const float t1 = lam[F.lane] * lam[64 + F.lane], t2 = lam[128 + F.lane] * lam[192 + F.lane]; lmb = expf(wave_sum(t1)) - expf(wave_sum(t2)) + LAMBDA_INIT; }
    const float* ng = INP(I_DNG);
    const int kro = 2048 * (r >> 3) + 64 * (r & 7); const int xk = (r >> 2) & 3;
    int koff[2];
#pragma unroll
    for (int d0 = 0; d0 < 2; ++d0) koff[d0] = kro + 1024 * m + 16 * (((2 * d0 + hi) & 3) ^ xk);
    const int blk = (F.lane >> 4) & 1, q4 = (F.lane & 15) >> 2, p4 = F.lane & 3, cb = 2 * blk + (p4 >> 1);
    int trb[2];
#pragma unroll
    for (int t = 0; t < 2; ++t) trb[t] = 64 * (4 * hi + q4) + 8 * (p4 & 1) + 16 * (cb ^ ((2 * t + hi) & 3)) + 2048 * t;
    const int drow = 8 * F.wave + ((F.lane & 31) >> 2);
    const unsigned goff = (unsigned)(drow * 6144 + 16 * (4 * (F.lane >> 5) + ((F.lane & 3) ^ ((drow >> 2) & 3))));
    const unsigned ldsw = (unsigned)F.wave * 2048u;
    const int xcd = F.bid & 7, cux = F.bid >> 3;
    for (int ui = 0; ui < 5; ++ui) {
        int b, h, qrow0, nt;
        if (F.G == 256) {
            h = xcd;
            if (ui < 4) { b = ui >> 1; qrow0 = b * T + (cux + 32 * (ui & 1)) * 128; nt = NKV / 64; }
            else { if (cux >= 4) break; b = cux >> 1; qrow0 = ML + b * CT + (cux & 1) * 128; nt = CT / 64; }
        } else {
            const int u = F.bid + ui * F.G; if (u >= 1056) break;
            if (u < 1024) { b = u >> 9; h = (u >> 6) & 7; qrow0 = b * T + (u & 63) * 128; nt = NKV / 64; }
            else { const int v = u - 1024; b = v >> 4; h = (v >> 1) & 7; qrow0 = ML + b * CT + (v & 1) * 128; nt = CT / 64; }
        }
        const int row0 = qrow0 + 32 * qs;
        bf16x8 qf[4];
#pragma unroll
        for (int d0 = 0; d0 < 4; ++d0) qf[d0] = *(const bf16x8*)(Z + (size_t)(row0 + r) * 3072 + h * 128 + m * 64 + d0 * 16 + hi * 8);
        asm volatile("" : "+v"(qf[0]), "+v"(qf[1]), "+v"(qf[2]), "+v"(qf[3]));
        asm volatile("s_waitcnt vmcnt(0)" ::: "memory");
        const char* kgb = (const char*)(Z + 1024 + h * 128); const char* vgb = (const char*)(Z + 2048 + h * 128);
#define KVROW(t) ((t) < CT / 64 ? ML + b * CT + 64 * (t) : b * T + 64 * (t) - CT)
#define DMAK(t) do { const int t_ = (t) < nt ? (t) : nt - 1; const char* g_ = kgb + (size_t)KVROW(t_) * 6144 + goff; LAS unsigned char* d_ = F.lds + KB0 + ((t) & 3) * 16384 + ldsw; \
            __builtin_amdgcn_global_load_lds((const unsigned*)g_, (LAS unsigned*)d_, 16, 0, 0); __builtin_amdgcn_global_load_lds((const unsigned*)(g_ + 128), (LAS unsigned*)(d_ + 1024), 16, 0, 0); } while (0)
#define DMAV(t) do { const int t_ = (t) < nt ? (t) : nt - 1; const char* g_ = vgb + (size_t)KVROW(t_) * 6144 + goff; LAS unsigned char* d_ = F.lds + VB0 + ((t) & 3) * 16384 + ldsw; \
            __builtin_amdgcn_global_load_lds((const unsigned*)g_, (LAS unsigned*)d_, 16, 0, 0); __builtin_amdgcn_global_load_lds((const unsigned*)(g_ + 128), (LAS unsigned*)(d_ + 1024), 16, 0, 0); } while (0)
#define WAIT_BAR(N) do { asm volatile("s_waitcnt vmcnt(" #N ") lgkmcnt(0)" ::: "memory"); __builtin_amdgcn_s_barrier(); asm volatile("" ::: "memory"); } while (0)
#define QKT(P0, P1, t) do { LAS unsigned char* KI_ = F.lds + KB0 + ((t) & 3) * 16384; \
            _Pragma("unroll") for (int q_ = 0; q_ < 16; ++q_) { P0[q_] = 0.f; P1[q_] = 0.f; } \
            _Pragma("unroll") for (int d0 = 0; d0 < 4; ++d0) { const bf16x8 k0_ = *(const LAS bf16x8*)(KI_ + 512 * (d0 >> 1) + koff[d0 & 1]), k1_ = *(const LAS bf16x8*)(KI_ + 8192 + 512 * (d0 >> 1) + koff[d0 & 1]); \
                P0 = MFMA32(k0_, qf[d0], P0); P1 = MFMA32(k1_, qf[d0], P1); if (d0 & 1) asm volatile("" ::: "memory"); } } while (0)
#define PV1(t, PF, i) do { LAS unsigned char* VI_ = F.lds + VB0 + ((t) & 3) * 16384; \
            _Pragma("unroll") for (int kh = 0; kh < 2; ++kh) _Pragma("unroll") for (int s2 = 0; s2 < 2; ++s2) { \
                const s16x4 a0_ = __builtin_bit_cast(s16x4, __builtin_amdgcn_ds_read_tr16_b64_v4i16((LAS v4i16_t*)(VI_ + 8192 * kh + 4096 * s2 + 512 * (i) + trb[0]))); \
                const s16x4 a1_ = __builtin_bit_cast(s16x4, __builtin_amdgcn_ds_read_tr16_b64_v4i16((LAS v4i16_t*)(VI_ + 8192 * kh + 4096 * s2 + 512 * (i) + trb[1]))); \
                o[i] = MFMA32(((bf16x8){a0_[0], a0_[1], a0_[2], a0_[3], a1_[0], a1_[1], a1_[2], a1_[3]}), PF[kh][s2], o[i]); if (s2 == 1) asm volatile("" ::: "memory"); } } while (0)
#define PVT(t, PF) do { PV1(t, PF, 0); PV1(t, PF, 1); PV1(t, PF, 2); PV1(t, PF, 3); } while (0)
#define SM_MAX() do { float mx_ = fmaxf(c0[0], c1[0]); _Pragma("unroll") for (int q_ = 1; q_ < 16; ++q_) mx_ = fmaxf(mx_, fmaxf(c0[q_], c1[q_])); \
            mx_ = fmaxf(mx_, __shfl_xor(mx_, 32)); const float mn_ = (mx_ - mref > ATT_THR) ? mx_ : mref; al = __builtin_amdgcn_exp2f(mref - mn_); mref = mn_; ps = 0.f; } while (0)
#define SM_EXP(C, B, DST) do { _Pragma("unroll") for (int q_ = 0; q_ < 8; ++q_) { C[(B) + q_] = __builtin_amdgcn_exp2f(C[(B) + q_] - mref); ps += C[(B) + q_]; } DST = PACK8(C, B); } while (0)
#define RESC(al) do { if (__any((al) < 1.f)) { _Pragma("unroll") for (int i = 0; i < 4; ++i) _Pragma("unroll") for (int q_ = 0; q_ < 16; ++q_) o[i][q_] *= (al); } } while (0)
#define SBAR() __builtin_amdgcn_sched_barrier(0)
#define ATT_STEP(j, PFC, PFP) do { \
            WAIT_BAR(8); DMAK((j) + 3); DMAV((j) + 2); \
            SBAR(); QKT(c0, c1, j); SBAR(); \
            PV1((j) - 1, PFP, 0); SM_MAX(); SBAR(); \
            PV1((j) - 1, PFP, 1); SM_EXP(c0, 0, PFC[0][0]); SM_EXP(c0, 8, PFC[0][1]); SBAR(); \
            PV1((j) - 1, PFP, 2); SM_EXP(c1, 0, PFC[1][0]); SBAR(); \
            PV1((j) - 1, PFP, 3); SM_EXP(c1, 8, PFC[1][1]); l = l * al + ps; SBAR(); \
            RESC(al); } while (0)
        f32x16 o[4];
#pragma unroll
        for (int i = 0; i < 4; ++i)
#pragma unroll
            for (int q = 0; q < 16; ++q) o[i][q] = 0.f;
        float mref = -1e30f, l = 0.f, al = 1.f, ps = 0.f;
        f32x16 c0, c1; bf16x8 pfA[2][2], pfB[2][2];
        DMAK(0); DMAV(0); DMAK(1); DMAV(1); DMAK(2);
        WAIT_BAR(6); DMAK(3); DMAV(2);
        QKT(c0, c1, 0); SM_MAX(); SM_EXP(c0, 0, pfA[0][0]); SM_EXP(c0, 8, pfA[0][1]); SM_EXP(c1, 0, pfA[1][0]); SM_EXP(c1, 8, pfA[1][1]); l = l * al + ps;
        for (int j = 1; j + 1 < nt; j += 2) {
            ATT_STEP(j, pfB, pfA);
            ATT_STEP(j + 1, pfA, pfB);
        }
        ATT_STEP(nt - 1, pfB, pfA);
        WAIT_BAR(0);
        PVT(nt - 1, pfB);
        WAIT_BAR(0);
#undef DMAK
#undef DMAV
#undef WAIT_BAR
#undef QKT
#undef PVT
#undef PV1
#undef SM_MAX
#undef SM_EXP
#undef RESC
#undef SBAR
#undef ATT_STEP
#undef KVROW
        l += __shfl_xor(l, 32);
        const float f = (m == 1 ? lmb : 1.0f) / l;
        LAS float* ex = EX + (size_t)m * 128 * 129 + (qs * 32 + r) * 129;
#pragma unroll
        for (int i = 0; i < 4; ++i)
#pragma unroll
            for (int q = 0; q < 16; ++q) ex[32 * i + crow(q, hi)] = o[i][q] * f;
        __syncthreads();
#pragma unroll 1
        for (int rr = 0; rr < 16; ++rr) { const int row = 16 * F.wave + rr;
            const float a0 = EX[row * 129 + F.lane] - EX[128 * 129 + row * 129 + F.lane], a1 = EX[row * 129 + 64 + F.lane] - EX[128 * 129 + row * 129 + 64 + F.lane];
            const float rstd = (1.0f - LAMBDA_INIT) / sqrtf(wave_sum(a0 * a0 + a1 * a1) * (1.f / 128.f) + EPS);
            bf16* yr = Y + (size_t)(qrow0 + row) * D + h * 128;
            yr[F.lane] = (bf16)(pk2(a0 * rstd * ng[F.lane], 0.f) & 0xffffu); yr[64 + F.lane] = (bf16)(pk2(a1 * rstd * ng[64 + F.lane], 0.f) & 0xffffu); }
        __syncthreads();
    }
}

#define XB_TMO      128
#define XB_XCNT(j)  (256  + 64 * (j))
#define XB_XSUB(j)  (1280 + 64 * (j))
#define XB_XGEN(j)  (2304 + 64 * (j))
#define XB_TOP      3328
#define XB_TOPGEN   3392
#define XCD_BAR_WORDS 3456
#define XB_SPIN_CAP (1u << 18)

__device__ __forceinline__ unsigned xb_ld(unsigned* p)              { return __hip_atomic_load(p, __ATOMIC_RELAXED, __HIP_MEMORY_SCOPE_AGENT); }
__device__ __forceinline__ unsigned xb_add(unsigned* p, unsigned v) { return __hip_atomic_fetch_add(p, v, __ATOMIC_RELAXED, __HIP_MEMORY_SCOPE_AGENT); }
__device__ __forceinline__ unsigned xb_xcc_id() { return (unsigned)__builtin_amdgcn_s_getreg((3 << 11) | 20) & 0xFu; }
#define XB_SPIN(cond, bar) do { unsigned _sp = 0; while (cond) { __builtin_amdgcn_s_sleep(1); \
    if ((++_sp & 255u) == 0u) { if (xb_ld(&(bar)[XB_TMO])) break; if (_sp > XB_SPIN_CAP) { atomicAdd(&(bar)[XB_TMO], 1u); break; } } } } while (0)

struct XcdBarrier {
    unsigned* bar; unsigned x;
    volatile LAS unsigned* st;
};

__device__ __forceinline__ XcdBarrier xcd_barrier_post(unsigned* bar, volatile LAS unsigned* st) {
    XcdBarrier b; b.bar = bar; b.x = xb_xcc_id(); b.st = st;
    if (threadIdx.x == 0) (void)xb_add(&bar[XB_XCNT(b.x)], 1u);
    return b;
}
__device__ __forceinline__ void xcd_barrier_complete(unsigned* bar, unsigned x, unsigned& nloc, unsigned& nx) {
    const unsigned G = gridDim.x * gridDim.y * gridDim.z;
    unsigned sum, cnt, mine, sp = 0u;
    for (;;) {
        sum = 0u; cnt = 0u; mine = 0u;
#pragma unroll
        for (unsigned j = 0; j < 16; ++j) { const unsigned c = xb_ld(&bar[XB_XCNT(j)]); sum += c; cnt += (c > 0u) ? 1u : 0u; mine = (j == x) ? c : mine; }
        if (sum == G) break;
        __builtin_amdgcn_s_sleep(1);
        if ((++sp & 255u) == 0u) { if (xb_ld(&bar[XB_TMO])) break; if (sp > XB_SPIN_CAP) { atomicAdd(&bar[XB_TMO], 1u); break; } }
    }
    nloc = mine > 0u ? mine : 1u; nx = cnt > 0u ? cnt : 1u;
}

__device__ __forceinline__ void xcd_barrier(const XcdBarrier& b) {
    asm volatile("s_waitcnt vmcnt(0)" ::: "memory");
    __syncthreads();
    if (threadIdx.x == 0) {
        unsigned* bar = b.bar;
        __builtin_amdgcn_s_waitcnt(0);
        unsigned nloc = b.st[0], nx = b.st[1];
        if (nloc == 0u) { xcd_barrier_complete(bar, b.x, nloc, nx); b.st[0] = nloc; b.st[1] = nx; }
        const unsigned old = xb_add(&bar[XB_XSUB(b.x)], 1u);
        const unsigned gen = old / nloc;
        if (old + 1u == (gen + 1u) * nloc) {
            __builtin_amdgcn_fence(__ATOMIC_RELEASE, "agent");
            asm volatile("s_waitcnt vmcnt(0)" ::: "memory");
            const unsigned og = xb_add(&bar[XB_TOP], 1u);
            const unsigned tg = og / nx;
            if (og + 1u == (tg + 1u) * nx) xb_add(&bar[XB_TOPGEN], 1u);
            else XB_SPIN(xb_ld(&bar[XB_TOPGEN]) == tg, bar);
            __builtin_amdgcn_fence(__ATOMIC_ACQUIRE, "agent");
            xb_add(&bar[XB_XGEN(b.x)], 1u);
            asm volatile("s_waitcnt vmcnt(0)" ::: "memory");
        } else {
            XB_SPIN(xb_ld(&bar[XB_XGEN(b.x)]) == gen, bar);
            __builtin_amdgcn_fence(__ATOMIC_ACQUIRE, "agent");
            asm volatile("s_waitcnt vmcnt(0)" ::: "memory");
        }
    }
    __syncthreads();
}

#ifndef MK_SINGLE
#define MK_SINGLE 1
#endif
constexpr int NSTEPS = 1 + 9 + 7 + 8 + 9 + 1;
struct SEpiStore { bf16* O; int ldc; int act; bf16* halo;
    __device__ __forceinline__ void operator()(const float (&v8)[8], int m, int n0, int hi, int half) const {
#pragma unroll
        for (int g = 0; g < 2; ++g) { float v[4];
#pragma unroll
            for (int i = 0; i < 4; ++i) { v[i] = v8[4 * g + i]; if (act) { const float t = fmaxf(v[i], 0.f); v[i] = t * t; } }
            const u32x2 w = (u32x2){pk2(v[0], v[1]), pk2(v[2], v[3])}; const int n = n0 + 8 * (2 * half + g) + 4 * hi;
            *(u32x2*)(O + (size_t)m * ldc + n) = w;
            if (halo && n < 3072 && (((m & 63) == 0) || ((m & 63) == 63))) *(u32x2*)(halo + ((size_t)(m >> 6) * 2 + ((m & 63) ? 1 : 0)) * 3072 + n) = w; } } };
struct SEpiResid { float* X; const float* gate;
    __device__ __forceinline__ void operator()(const float (&v8)[8], int m, int n0, int hi, int half) const {
#pragma unroll
        for (int g = 0; g < 2; ++g) { const int n = n0 + 8 * (2 * half + g) + 4 * hi; float* p = X + (size_t)m * D + n; const f32x4 gv = *(const f32x4*)(gate + n);
            *(f32x4*)p = *(const f32x4*)p + gv * (f32x4){v8[4 * g], v8[4 * g + 1], v8[4 * g + 2], v8[4 * g + 3]}; } } };
struct SEpiAB { float* AB;
    __device__ __forceinline__ void operator()(const float (&v8)[8], int m, int n0, int hi, int half) const {
        if (n0 == 0) {
#pragma unroll
            for (int g = 0; g < 2; ++g) *(f32x4*)(AB + (size_t)m * 32 + 8 * (2 * half + g) + 4 * hi) = (f32x4){v8[4 * g], v8[4 * g + 1], v8[4 * g + 2], v8[4 * g + 3]}; } } };
template <class Epi> __device__ __forceinline__ void small_gemm(const bf16* A, const bf16* Bt, int row_lo, int nrows, int N, int K, const Epi& E) {
    int tid = threadIdx.x; asm volatile("" : "+v"(tid));
    const int lane = tid & 63, wave = __builtin_amdgcn_readfirstlane(tid >> 6), r = lane & 31, hi = lane >> 5;
    int G_ = gridDim.x, B_ = blockIdx.x; asm volatile("" : "+s"(G_), "+s"(B_));
    LAS float* red = (LAS float*)lds_raw;
    const int tn = N / 64, items = (nrows / 64) * tn, kw = K / 8;
    for (int it = B_; it < items; it += G_) {
        const int mi = it / tn, ni = it % tn;
        const bf16* ap = A + (size_t)(row_lo + 64 * mi + r) * K + wave * kw + 8 * hi;
        const bf16* bp = Bt + (size_t)(64 * ni + r) * K + wave * kw + 8 * hi;
        f32x16 acc[2][2];
#pragma unroll
        for (int x = 0; x < 2; ++x)
#pragma unroll
            for (int y = 0; y < 2; ++y)
#pragma unroll
                for (int i = 0; i < 16; ++i) acc[x][y][i] = 0.f;
#pragma unroll 8
        for (int k = 0; k < kw; k += 16) {
            const bf16x8 a0 = *(const bf16x8*)(ap + k), a1 = *(const bf16x8*)(ap + (size_t)32 * K + k), b0 = *(const bf16x8*)(bp + k), b1 = *(const bf16x8*)(bp + (size_t)32 * K + k);
            acc[0][0] = __builtin_amdgcn_mfma_f32_32x32x16_bf16(b0, a0, acc[0][0], 0, 0, 0); acc[0][1] = __builtin_amdgcn_mfma_f32_32x32x16_bf16(b0, a1, acc[0][1], 0, 0, 0);
            acc[1][0] = __builtin_amdgcn_mfma_f32_32x32x16_bf16(b1, a0, acc[1][0], 0, 0, 0); acc[1][1] = __builtin_amdgcn_mfma_f32_32x32x16_bf16(b1, a1, acc[1][1], 0, 0, 0);
        }
#pragma unroll
        for (int x = 0; x < 2; ++x)
#pragma unroll
            for (int y = 0; y < 2; ++y)
#pragma unroll
                for (int i = 0; i < 16; ++i) red[((wave * 4 + x * 2 + y) * 16 + i) * 64 + lane] = acc[x][y][i];
        __syncthreads();
        { const int tile = wave >> 1, half = wave & 1; float v8[8];
#pragma unroll
            for (int i = 0; i < 8; ++i) { float s = 0.f;
#pragma unroll
                for (int w = 0; w < 8; ++w) s += red[((w * 4 + tile) * 16 + 8 * half + i) * 64 + lane];
                v8[i] = s; }
            E(v8, row_lo + 64 * mi + 32 * (tile & 1) + r, 64 * ni + 32 * (tile >> 1), hi, half); }
        __syncthreads();
    }
}
template <int ACT> __device__ __forceinline__ void gemm_store(const bf16* A, const bf16* Bt, bool ctx, int N, int K, bf16* O, int ldc, bf16* halo) {
    { int G_ = gridDim.x, B_ = blockIdx.x; asm volatile("" : "+s"(G_), "+s"(B_));
      pg8::Gemm g{A, Bt, ML, N, K, K, K}; pg8::StaticOrder S; S.init(ML, N, G_, B_);
      pg8::EpiStore<ACT> E{O, ldc, nullptr, -1, halo};
      pg8::gemm_phase<pg8::EpiStore<ACT>, pg8::StaticOrder, true, true>((LAS unsigned char*)lds_raw, g, S, E); }
    if (ctx) { SEpiStore E2{O, ldc, ACT, halo}; small_gemm(A, Bt, ML, MC, N, K, E2); }
}
__device__ __forceinline__ void gemm_resid(const bf16* A, const bf16* Bt, bool ctx, int K, float* X, const float* gate) {
    { int G_ = gridDim.x, B_ = blockIdx.x; asm volatile("" : "+s"(G_), "+s"(B_));
      pg8::Gemm g{A, Bt, ML, D, K, K, K}; pg8::StaticOrder S; S.init(ML, D, G_, B_);
      pg8::EpiResid E{X, D, gate, NADA};
      pg8::gemm_phase<pg8::EpiResid, pg8::StaticOrder, true, true>((LAS unsigned char*)lds_raw, g, S, E); }
    if (ctx) { SEpiResid E2{X, gate + 2 * NADA}; small_gemm(A, Bt, ML, MC, D, K, E2); }
}
__global__ void __launch_bounds__(NTHR, 2) fwd_kernel(Args a) {
    unsigned char* ws = a.ws;
    const int lo = a.step_lo, hi = a.step_hi; const bool coop = a.coop != 0;
    volatile LAS unsigned* bst = (volatile LAS unsigned*)((LAS unsigned char*)lds_raw + LDS_BYTES - 64);
    if (threadIdx.x < 2) bst[threadIdx.x] = 0u;
    __syncthreads();
    XcdBarrier bar; bar.bar = (unsigned*)(ws + WS_CTL) + 4096; bar.x = 0; bar.st = bst;
    if (coop) bar = xcd_barrier_post((unsigned*)(ws + WS_CTL) + 4096, bst);
#ifndef REP_SET
#define REP_SET 0
#endif
#define REP_OF(k) ((REP_SET == 1 && ((k) == 8 || (k) == 15 || (k) == 23 || (k) == 32)) || (REP_SET == 2 && ((k) == 4 || (k) == 28)) || (REP_SET == 3 && ((k) == 2 || (k) == 11 || (k) == 18 || (k) == 26)) || \
    (REP_SET == 4 && ((k) == 1 || (k) == 7 || (k) == 10 || (k) == 14 || (k) == 17 || (k) == 22 || (k) == 25 || (k) == 31)) || (REP_SET == 5 && (k) == 0) || (REP_SET == 6 && (k) == 20) || (REP_SET == 7 && ((k) == 5 || (k) == 29 || (k) == 12 || (k) == 34)))
#define PHASE(k, body) do { if (lo <= (k) && (k) < hi) { __syncthreads(); body; if (REP_OF(k)) { __syncthreads(); body; } if ((k) + 1 < hi && coop) { if ((k) == 0) cg::this_grid().sync(); else xcd_barrier(bar); } } } while (0)
#define WB(off) ((bf16*)(ws + (off)))
#define MODP(layer, which) ((const float*)(ws + WS_MOD) + (size_t)(layer) * 3 * NADA + (which) * D)
#define TAIL(k0, layer, WoutT, Mrows) \
    PHASE((k0), gemm_resid(WB(WS_Y), (WoutT), (Mrows) == M, D, (float*)(ws + WS_X), MODP(layer, 2))); \
    PHASE((k0) + 1, step_norm((layer), 1, (Mrows), false)); \
    PHASE((k0) + 2, gemm_store<1>(WB(WS_H), WB(WS_W1T) + (size_t)(layer) * D * FF, (Mrows) == M, FF, D, WB(WS_Z), FF, nullptr)); \
    PHASE((k0) + 3, gemm_resid(WB(WS_Z), WB(WS_W2T) + (size_t)(layer) * D * FF, (Mrows) == M, FF, (float*)(ws + WS_X), MODP(layer, 5)))
#define LAYER_GDN(k0, layer, jj, Mrows, conv) \
    PHASE((k0), step_norm((layer), 0, M, false)); \
    PHASE((k0) + 1, { gemm_store<0>(WB(WS_H), WB(WS_GINT) + (size_t)(jj) * GDN_NP * D, true, 4096, D, WB(WS_Z), 4096, WB(WS_HALO)); \
        SEpiAB E3{(float*)(ws + WS_AB)}; small_gemm(WB(WS_H), WB(WS_GINT) + (size_t)(jj) * GDN_NP * D + (size_t)4096 * D, 0, M, 64, D, E3); }); \
    PHASE((k0) + 2, { if (REP_SET >= 8) { step_gdn_prep(jj, a.coop != 0, a.pad); __syncthreads(); } step_gdn_prep(jj); }); \
    PHASE((k0) + 3, { if (conv) step_convert_rest(); step_gdn_scan2(); }); \
    PHASE((k0) + 4, step_gdn_norm2(jj)); \
    TAIL((k0) + 5, layer, WB(WS_GOUTT) + (size_t)(jj) * D * D, Mrows)
    PHASE(0, step_prologue());
    LAYER_GDN(1, 0, 0, M, true);
    PHASE(10, step_norm(1, 0, M, false));
    PHASE(11, gemm_store<0>(WB(WS_H), WB(WS_SINT), true, 3 * D, D, WB(WS_Z), 3 * D, nullptr));
    PHASE(12, step_sconv());
    TAIL(13, 1, WB(WS_SOUTT), M);
    PHASE(17, step_norm(2, 0, M, false));
    PHASE(18, gemm_store<0>(WB(WS_H), WB(WS_DINT), true, 3 * D, D, WB(WS_Z), 3 * D, nullptr));
    PHASE(19, step_rope2());
    PHASE(20, step_attn2());
    TAIL(21, 2, WB(WS_DOUTT), M);
    LAYER_GDN(25, 3, 1, ML, false);
    PHASE(34, step_final());
}

extern "C" void kernel_launch(void* const* d_in, const int* in_sizes, int n_in, void* d_out, int out_size, void* d_ws, size_t ws_size, hipStream_t stream) {
    static int grid = 0;
    if (grid == 0) {
        if (n_in != 24 || out_size != ML * D || ws_size < WS_END) { fprintf(stderr, "kernel_launch: unexpected problem (n_in %d, out %d, ws %zu); nothing launched\n", n_in, out_size, ws_size); grid = -1; return; }
        int dev = 0, cus = 0, per_cu = 0;
        if (hipGetDevice(&dev) != hipSuccess || hipDeviceGetAttribute(&cus, hipDeviceAttributeMultiprocessorCount, dev) != hipSuccess) { grid = -1; return; }
        if (hipFuncSetAttribute((const void*)fwd_kernel, hipFuncAttributeMaxDynamicSharedMemorySize, LDS_BYTES) != hipSuccess) { fprintf(stderr, "kernel_launch: hipFuncSetAttribute failed\n"); grid = -1; return; }
        if (hipOccupancyMaxActiveBlocksPerMultiprocessor(&per_cu, (const void*)fwd_kernel, NTHR, LDS_BYTES) != hipSuccess || per_cu < 1) { fprintf(stderr, "kernel_launch: occupancy query says %d blocks per CU\n", per_cu); (void)hipGetLastError(); per_cu = 1; }
        grid = cus;
        fprintf(stderr, "kernel_launch: %d CUs, occupancy %d per CU, grid %d\n", cus, per_cu, grid);
    }
    if (grid < 0) return;
    (void)hipMemsetAsync((char*)d_ws + WS_CTL, 0, CTL_ZERO_BYTES, stream);
    Args a{};
    for (int i = 0; i < 24; ++i) a.in[i] = (const float*)d_in[i];
    a.out = (float*)d_out; a.ws = (unsigned char*)d_ws;
#if MK_SINGLE
    a.step_lo = 0; a.step_hi = NSTEPS; a.coop = 1;
#if REP_SET >= 8
    a.pad = REP_SET - 8;
#endif
    void* args[] = {&a};
    hipError_t e = hipLaunchCooperativeKernel((const void*)fwd_kernel, dim3(grid), dim3(NTHR), args, LDS_BYTES, stream);
    if (e != hipSuccess) fprintf(stderr, "cooperative launch failed: %s (grid %d)\n", hipGetErrorString(e), grid);
#else
    for (int s = 0; s < NSTEPS; ++s) { a.step_lo = s; a.step_hi = s + 1; a.coop = 0; hipLaunchKernelGGL(fwd_kernel, dim3(grid), dim3(NTHR), LDS_BYTES, stream, a); }
#endif
}
```

```cpp
#include <hip/hip_runtime.h>
#include <hip/hip_cooperative_groups.h>
#include <cstdio>
#include <cstdint>
namespace cg = cooperative_groups;
namespace pg8 {
#define PG8_LAS __attribute__((address_space(3)))
typedef unsigned short bf16_t;
typedef short bf16x8 __attribute__((ext_vector_type(8)));
typedef float f32x4 __attribute__((ext_vector_type(4)));
typedef unsigned u32x4 __attribute__((ext_vector_type(4)));
constexpr int BM = 256, BK = 64, HALF = 128, HTB = HALF * BK * 2  , STAGE_BYTES = 8 * HTB, NXCD = 8, WGM = 8;

__host__ __device__ __forceinline__ int lds_byte(int r, int c) { const int st = (r >> 4) * 2 + (c >> 5), rr = r & 15, cc = c & 31, ob = rr * 64 + cc * 2; return st * 1024 + (ob ^ (((ob >> 9) & 1) << 5)); }
__host__ __device__ __forceinline__ void stage_rc(int b, int& R, int& C) { const int st = b / 1024, sb = b % 1024, swz = sb ^ (((sb >> 9) & 1) << 5); R = (st >> 1) * 16 + swz / 64; C = (st & 1) * 32 + (swz % 64) / 2; }
__host__ __device__ __forceinline__ int perm32(int rho) { const int n = rho >> 4, i = rho & 15; return 8 * (i >> 2) + 4 * n + (i & 3); }

struct Unit { int pm, pn; };
struct Gemm { const bf16_t* A; const bf16_t* Bt; int M, N, K, lda, ldb; };

struct StaticOrder {
    int nM, nN, nwg, G, c;
    __host__ __device__ void init(int M, int N, int G_, int c_) { nM = M / BM; nN = N / BM; nwg = nM * nN; G = G_; c = c_; }
    __host__ __device__ bool next(int i, Unit& u) const {
        const long L = (long)i * G + c; if (L >= nwg) return false;
        int wgid = (int)L; { const int q = nwg / NXCD, r = nwg % NXCD, xcd = wgid % NXCD, off = wgid / NXCD; wgid = (xcd < r ? xcd * (q + 1) : r * (q + 1) + (xcd - r) * q) + off; }
        const int nig = WGM * nN, gid = wgid / nig, fm = gid * WGM, gsz = (nM - fm) < WGM ? (nM - fm) : WGM;
        u.pm = fm + ((wgid % nig) % gsz); u.pn = (wgid % nig) / gsz; return true;
    }
    __device__ __forceinline__ void a_ready(const Unit&) const {}
    __device__ __forceinline__ void done(const Unit&) const {}
};

typedef float f32x2 __attribute__((ext_vector_type(2)));
typedef __bf16 bf16x2_t __attribute__((ext_vector_type(2)));
__device__ __forceinline__ unsigned cvt_pk_bf16(float lo, float hi) { f32x2 v = {lo, hi}; bf16x2_t b = __builtin_convertvector(v, bf16x2_t); return __builtin_bit_cast(unsigned, b); }

template <int ACT> struct EpiStore {
    static constexpr bool PERM = true, AFTER_DRAIN = false;
    bf16_t* O; int ldc; float* AB; int ab_tile; bf16_t* halo;
    __device__ __forceinline__ void operator()(const f32x4 (&acc)[2][2][4][2], const Unit& u, int wr, int wc, int fr, int fq) const {
        const int row0 = u.pm * BM + wr * 64 + fr;
        if (u.pn == ab_tile) {
            if (wc == 0) {
#pragma unroll
                for (int ai = 0; ai < 2; ++ai)
#pragma unroll
                    for (int m = 0; m < 4; ++m) { float* p = AB + (size_t)(row0 + ai * HALF + m * 16) * 32 + 8 * fq; *(f32x4*)p = acc[ai][0][m][0]; *(f32x4*)(p + 4) = acc[ai][0][m][1]; }
            }
            return;
        }
        const int col0 = u.pn * BM + wc * 32 + 8 * fq;
#pragma unroll
        for (int ai = 0; ai < 2; ++ai)
#pragma unroll
            for (int m = 0; m < 4; ++m) { bf16_t* rowp = O + (size_t)(row0 + ai * HALF + m * 16) * ldc + col0;
#pragma unroll
                for (int bj = 0; bj < 2; ++bj) { f32x4 v0 = acc[ai][bj][m][0], v1 = acc[ai][bj][m][1];
                    if (ACT == 1) {
#pragma unroll
                        for (int i = 0; i < 4; ++i) { const float a = fmaxf(v0[i], 0.f), b = fmaxf(v1[i], 0.f); v0[i] = a * a; v1[i] = b * b; } }
                    u32x4 w; w.x = cvt_pk_bf16(v0[0], v0[1]); w.y = cvt_pk_bf16(v0[2], v0[3]); w.z = cvt_pk_bf16(v1[0], v1[1]); w.w = cvt_pk_bf16(v1[2], v1[3]);
                    *(u32x4*)(rowp + bj * HALF) = w;
                    if (halo && u.pn < 12 && ((m == 0 && fr == 0) || (m == 3 && fr == 15))) { const int row = row0 + ai * HALF + m * 16;
                        *(u32x4*)(halo + ((size_t)(row >> 6) * 2 + (m == 3 ? 1 : 0)) * 3072 + col0 + bj * HALF) = w; } } }
    }
};
struct EpiResid {
    static constexpr bool PERM = false, AFTER_DRAIN = false;
    float* X; int ldc; const float* gate; int gstride;
    __device__ __forceinline__ void operator()(const f32x4 (&acc)[2][2][4][2], const Unit& u, int wr, int wc, int fr, int fq) const {
        const int row0 = u.pm * BM + wr * 64 + fr, col0 = u.pn * BM + wc * 32 + 4 * fq;
        const float* g = gate + (size_t)(u.pm < 32 ? 0 : (u.pm < 64 ? 1 : 2)) * gstride + col0;
        f32x4 gv[2][2];
#pragma unroll
        for (int bj = 0; bj < 2; ++bj)
#pragma unroll
            for (int n = 0; n < 2; ++n) gv[bj][n] = *(const f32x4*)(g + bj * HALF + n * 16);
#pragma unroll
        for (int ai = 0; ai < 2; ++ai)
#pragma unroll
            for (int m = 0; m < 4; ++m) { float* p = X + (size_t)(row0 + ai * HALF + m * 16) * ldc + col0;
#pragma unroll
                for (int bj = 0; bj < 2; ++bj)
#pragma unroll
                    for (int n = 0; n < 2; ++n) { float* q = p + bj * HALF + n * 16; *(f32x4*)q = *(const f32x4*)q + gv[bj][n] * acc[ai][bj][m][n]; }
                if (m & 1) asm volatile("" ::: "memory"); }
    }
};

template <class Epi, class Sched, bool ALIGN_EPI = false, bool SP2 = false>
__device__ __forceinline__ void gemm_phase(PG8_LAS unsigned char* lds, const Gemm g, const Sched& S, const Epi& E) {
    int tid_ = threadIdx.x; asm volatile("" : "+v"(tid_)); const int tid = tid_, wid = __builtin_amdgcn_readfirstlane(tid >> 6), lane = tid & 63, wr = wid >> 2, wc = wid & 3, fr = lane & 15, fq = lane >> 4;
    const int K = g.K, nt = K / BK;
    unsigned voffA[2], voffB[2];
#pragma unroll
    for (int i = 0; i < 2; ++i) { int R, C; stage_rc(tid * 16 + i * 8192, R, C); const int Rb = Epi::PERM ? ((R & ~31) + perm32(R & 31)) : R;
        voffA[i] = (unsigned)(R * g.lda + C) * 2u; voffB[i] = (unsigned)(Rb * g.ldb + C) * 2u; }
    const size_t kstep = (size_t)(BK * 2);
    const int lda = g.lda, ldb = g.ldb;
    const size_t hstepA = (size_t)HALF * lda * 2, hstepB = (size_t)HALF * ldb * 2;
    const size_t tstepA = 2 * hstepA, tstepB = 2 * hstepB;
    const unsigned ldsw = (unsigned)wid * 1024u;
    const int aoff = lds_byte(wr * 64 + fr, fq * 8), boff = lds_byte(wc * 32 + fr, fq * 8);
#define PG8_SA(b, h) (((b) * 2 + (h)) * HTB)
#define PG8_SB(b, h) ((4 + (b) * 2 + (h)) * HTB)
#define PG8_STAGE(bufoff, gbase, voff) do { _Pragma("unroll") for (int _i = 0; _i < 2; ++_i) \
        __builtin_amdgcn_global_load_lds((const unsigned*)((const char*)(gbase) + (voff)[_i]), (PG8_LAS unsigned*)(lds + (bufoff) + ldsw + _i * 8192), 16, 0, 0); } while (0)
#define PG8_LDA(dst, b, h) do { _Pragma("unroll") for (int m = 0; m < 4; ++m) _Pragma("unroll") for (int k = 0; k < 2; ++k) dst[m][k] = *(const PG8_LAS bf16x8*)(lds + PG8_SA(b, h) + aoff + m * 2048 + k * 1024); } while (0)
#define PG8_LDB(dst, b, h) do { _Pragma("unroll") for (int n = 0; n < 2; ++n) _Pragma("unroll") for (int k = 0; k < 2; ++k) dst[n][k] = *(const PG8_LAS bf16x8*)(lds + PG8_SB(b, h) + boff + n * 2048 + k * 1024); } while (0)
#define PG8_MMA(ai, bj, At, Bt) do { __builtin_amdgcn_s_setprio(1); _Pragma("unroll") for (int m = 0; m < 4; ++m) _Pragma("unroll") for (int n = 0; n < 2; ++n) _Pragma("unroll") for (int k = 0; k < 2; ++k) \
        acc[ai][bj][m][n] = __builtin_amdgcn_mfma_f32_16x16x32_bf16(Bt[n][k], At[m][k], acc[ai][bj][m][n], 0, 0, 0); __builtin_amdgcn_s_setprio(0); } while (0)
#define PG8_WAIT_V(n) asm volatile("s_waitcnt vmcnt(" #n ")" ::: "memory")
#define PG8_WAIT_L(n) asm volatile("s_waitcnt lgkmcnt(" #n ")" ::: "memory")
#define PG8_BAR __builtin_amdgcn_s_barrier()
#define PG8_SCHED __builtin_amdgcn_sched_barrier(0)
    Unit cur, nxt; int ui = 0;
    if (!S.next(0, cur)) return;
    f32x4 acc[2][2][4][2];
#pragma unroll
    for (int a = 0; a < 2; ++a)
#pragma unroll
        for (int b = 0; b < 2; ++b)
#pragma unroll
            for (int m = 0; m < 4; ++m)
#pragma unroll
                for (int n = 0; n < 2; ++n) acc[a][b][m][n] = (f32x4){0.f, 0.f, 0.f, 0.f};
    bf16x8 At[4][2], B0[2][2], B1[2][2];
    const char* cA = (const char*)g.A + (size_t)cur.pm * tstepA; const char* cB = (const char*)g.Bt + (size_t)cur.pn * tstepB;
    S.a_ready(cur);
    if constexpr (SP2) {
        PG8_STAGE(PG8_SB(0, 0), cB, voffB); PG8_STAGE(PG8_SB(0, 1), cB + hstepB, voffB); PG8_STAGE(PG8_SA(0, 0), cA, voffA); PG8_STAGE(PG8_SA(0, 1), cA + hstepA, voffA);
        if (wr == 1) PG8_BAR;
        PG8_WAIT_V(2); PG8_BAR;
        PG8_STAGE(PG8_SB(1, 0), cB + kstep, voffB); PG8_STAGE(PG8_SA(1, 0), cA + kstep, voffA); PG8_STAGE(PG8_SB(1, 1), cB + hstepB + kstep, voffB);
        PG8_WAIT_V(6); PG8_BAR;
    } else {
        PG8_STAGE(PG8_SB(0, 0), cB, voffB); PG8_STAGE(PG8_SA(0, 0), cA, voffA); PG8_STAGE(PG8_SB(0, 1), cB + hstepB, voffB); PG8_STAGE(PG8_SA(0, 1), cA + hstepA, voffA);
        if (wr == 1) PG8_BAR;
        PG8_WAIT_V(4); PG8_BAR;
        PG8_STAGE(PG8_SB(1, 0), cB + kstep, voffB); PG8_STAGE(PG8_SA(1, 0), cA + kstep, voffA); PG8_STAGE(PG8_SB(1, 1), cB + hstepB + kstep, voffB);
        PG8_WAIT_V(6); PG8_BAR;
    }
    for (;;) {
        const bool has_next = S.next(ui + 1, nxt);
        const char* nA = has_next ? (const char*)g.A + (size_t)nxt.pm * tstepA : cA; const char* nB = has_next ? (const char*)g.Bt + (size_t)nxt.pn * tstepB : cB;
        for (int t = 0; t < nt; t += 2) {
            const bool last = (t == nt - 2);
            const char* a1 = cA + (size_t)(t + 1) * kstep;
            const char* a2 = last ? nA : cA + (size_t)(t + 2) * kstep; const char* b2 = last ? nB : cB + (size_t)(t + 2) * kstep;
            const char* a3 = a2 + kstep; const char* b3 = b2 + kstep;
            if (last && has_next) S.a_ready(nxt);
            if constexpr (SP2) {
            PG8_LDB(B0, 0, 0); PG8_LDB(B1, 0, 1); PG8_SCHED; PG8_LDA(At, 0, 0); PG8_STAGE(PG8_SA(1, 1), a1 + hstepA, voffA);
            PG8_WAIT_V(8); PG8_WAIT_L(0); PG8_BAR; PG8_MMA(0, 0, At, B0); PG8_MMA(0, 1, At, B1); PG8_BAR; PG8_SCHED;
            PG8_LDA(At, 0, 1); PG8_STAGE(PG8_SB(0, 0), b2, voffB); PG8_STAGE(PG8_SB(0, 1), b2 + hstepB, voffB); PG8_STAGE(PG8_SA(0, 0), a2, voffA);
            PG8_WAIT_V(8); PG8_WAIT_L(0); PG8_BAR; PG8_MMA(1, 0, At, B0); PG8_MMA(1, 1, At, B1); PG8_BAR; PG8_SCHED;
            PG8_LDB(B0, 1, 0); PG8_LDB(B1, 1, 1); PG8_SCHED; PG8_LDA(At, 1, 0); PG8_STAGE(PG8_SA(0, 1), a2 + hstepA, voffA);
            PG8_WAIT_V(8); PG8_WAIT_L(0); PG8_BAR; PG8_MMA(0, 0, At, B0); PG8_MMA(0, 1, At, B1); PG8_BAR; PG8_SCHED;
            PG8_LDA(At, 1, 1); PG8_STAGE(PG8_SB(1, 0), b3, voffB); PG8_STAGE(PG8_SB(1, 1), b3 + hstepB, voffB); PG8_STAGE(PG8_SA(1, 0), a3, voffA);
            PG8_WAIT_V(8); PG8_WAIT_L(0); PG8_BAR; PG8_MMA(1, 0, At, B0); PG8_MMA(1, 1, At, B1); PG8_BAR; PG8_SCHED;
            } else {
            PG8_LDB(B0, 0, 0); PG8_SCHED; PG8_LDA(At, 0, 0); PG8_STAGE(PG8_SA(1, 1), a1 + hstepA, voffA);
            PG8_WAIT_L(8); PG8_BAR; PG8_WAIT_L(0); PG8_MMA(0, 0, At, B0); PG8_BAR; PG8_SCHED;
            PG8_LDB(B1, 0, 1); PG8_STAGE(PG8_SB(0, 0), b2, voffB);
            PG8_BAR; PG8_WAIT_L(0); PG8_MMA(0, 1, At, B1); PG8_BAR;
            PG8_LDA(At, 0, 1); PG8_STAGE(PG8_SA(0, 0), a2, voffA);
            PG8_BAR; PG8_WAIT_L(0); PG8_MMA(1, 0, At, B0); PG8_BAR; PG8_SCHED;
            PG8_STAGE(PG8_SB(0, 1), b2 + hstepB, voffB);
            PG8_WAIT_V(6); PG8_BAR; PG8_MMA(1, 1, At, B1); PG8_BAR;
            PG8_LDB(B0, 1, 0); PG8_SCHED; PG8_LDA(At, 1, 0); PG8_STAGE(PG8_SA(0, 1), a2 + hstepA, voffA);
            PG8_WAIT_L(8); PG8_BAR; PG8_WAIT_L(0); PG8_MMA(0, 0, At, B0); PG8_BAR; PG8_SCHED;
            PG8_LDB(B1, 1, 1); PG8_STAGE(PG8_SB(1, 0), b3, voffB);
            PG8_BAR; PG8_WAIT_L(0); PG8_MMA(0, 1, At, B1); PG8_BAR;
            PG8_LDA(At, 1, 1); PG8_STAGE(PG8_SA(1, 0), a3, voffA);
            PG8_BAR; PG8_WAIT_L(0); PG8_MMA(1, 0, At, B0); PG8_BAR; PG8_SCHED;
            PG8_STAGE(PG8_SB(1, 1), b3 + hstepB, voffB);
            PG8_WAIT_V(6); PG8_BAR; PG8_MMA(1, 1, At, B1); PG8_BAR;
            }
        }
        if constexpr (ALIGN_EPI) { if (wr == 0) PG8_BAR; }
        if constexpr (!Epi::AFTER_DRAIN) { E(acc, cur, wr, wc, fr, fq); S.done(cur); }
        if (!has_next) break;
#pragma unroll
        for (int a = 0; a < 2; ++a)
#pragma unroll
            for (int b = 0; b < 2; ++b)
#pragma unroll
                for (int m = 0; m < 4; ++m)
#pragma unroll
                    for (int n = 0; n < 2; ++n) acc[a][b][m][n] = (f32x4){0.f, 0.f, 0.f, 0.f};
        cur = nxt; cA = nA; cB = nB; ++ui;
        if constexpr (ALIGN_EPI) { if (wr == 1) PG8_BAR; }
    }
    PG8_WAIT_V(0);
    if constexpr (!ALIGN_EPI) { if (wr == 0) PG8_BAR; }
    PG8_BAR;
    if constexpr (Epi::AFTER_DRAIN) { E.fused(acc, cur, wr, wc, fr, fq, lds, wid, lane); S.done(cur); }
#undef PG8_SA
#undef PG8_SB
#undef PG8_STAGE
#undef PG8_LDA
#undef PG8_LDB
#undef PG8_MMA
#undef PG8_WAIT_V
#undef PG8_WAIT_L
#undef PG8_BAR
#undef PG8_SCHED
}
}

constexpr int D = 1024, NB = 2, T = 8192, CT = 256, DEPTH = 4, FF = 4096;
constexpr int ML = NB * T, MC = NB * CT, M = ML + MC;
constexpr int NADA = 6 * D;
constexpr int GDN_N = 4128, GDN_NP = 4352;
constexpr int NH = 8, HD = 128;
constexpr int NKV = CT + T;
constexpr float EPS = 1e-6f;
constexpr int NWAVES = 8, NTHR = 512;
constexpr float QSCALE = 0.125f * 1.4426950408889634f;
constexpr float LAMBDA_INIT = 0.47071302f;

constexpr size_t MiB = 1u << 20;
constexpr size_t WS_CTL = 0, CTL_ZERO_BYTES = 1 * MiB;
constexpr size_t WS_MOD = 1 * MiB;
constexpr size_t WS_ROPE = 2 * MiB;
constexpr size_t WS_AB = 4 * MiB;
constexpr size_t WS_OFC = 7 * MiB;
constexpr size_t WS_W1T = 10 * MiB, WS_W2T = 42 * MiB, WS_GINT = 74 * MiB, WS_GOUTT = 91 * MiB, WS_SINT = 95 * MiB, WS_SOUTT = 101 * MiB, WS_DINT = 103 * MiB, WS_DOUTT = 109 * MiB;
constexpr size_t WS_X = 112 * MiB;
constexpr size_t WS_H = 178 * MiB;
constexpr size_t WS_Y = 211 * MiB;
constexpr size_t WS_Z = 244 * MiB;
constexpr size_t WS_HALO = 376 * MiB;
constexpr size_t WS_END = 380 * MiB;
constexpr size_t WS_PD = WS_H;

constexpr int LDS_BYTES = 149504;

#define LAS __attribute__((address_space(3)))
typedef unsigned short bf16;
typedef unsigned u32x4 __attribute__((ext_vector_type(4)));
typedef unsigned u32x2 __attribute__((ext_vector_type(2)));
typedef float f32x4 __attribute__((ext_vector_type(4)));
typedef float f32x2 __attribute__((ext_vector_type(2)));
typedef float f32x16 __attribute__((ext_vector_type(16)));
typedef short bf16x8 __attribute__((ext_vector_type(8)));
typedef short s16x4 __attribute__((ext_vector_type(4)));
#define LDS_WAIT() asm volatile("s_waitcnt lgkmcnt(0)" ::: "memory")

__device__ __forceinline__ float bf2f(unsigned u) { return __uint_as_float(u << 16); }
__device__ __forceinline__ unsigned pk2(float lo, float hi) { return pg8::cvt_pk_bf16(lo, hi); }
__device__ __forceinline__ float wave_sum(float v) {
#pragma unroll
    for (int o = 1; o < 64; o <<= 1) v += __shfl_xor(v, o);
    return v;
}
__device__ __forceinline__ float silu_f(float x) { return x / (1.f + expf(-x)); }
__device__ __forceinline__ float silu_fast(float x) { return x * __builtin_amdgcn_rcpf(1.f + __builtin_amdgcn_exp2f(-1.4426950408889634f * x)); }
__device__ __forceinline__ int crow(int r, int hi) { return (r & 3) + 8 * (r >> 2) + 4 * hi; }

struct Args { const float* in[24]; float* out; unsigned char* ws; int step_lo, step_hi, coop, pad; };
typedef const __attribute__((address_space(4))) Args* KArgs;
__device__ __forceinline__ KArgs kargs() { unsigned long long p = (unsigned long long)__builtin_amdgcn_kernarg_segment_ptr(); asm volatile("" : "+s"(p)); return (KArgs)p; }
#define INP(k) (kargs()->in[k])
extern __shared__ __attribute__((aligned(16))) unsigned char lds_raw[];
struct Frame { LAS unsigned char* lds; int tid, lane, wave, G, bid; float* out; unsigned char* ws; };
__device__ __forceinline__ Frame make_frame() {
    Frame F; F.lds = (LAS unsigned char*)lds_raw; F.tid = threadIdx.x; asm volatile("" : "+v"(F.tid)); F.lane = F.tid & 63; F.wave = __builtin_amdgcn_readfirstlane(F.tid >> 6); F.G = gridDim.x; F.bid = blockIdx.x; asm volatile("" : "+s"(F.G), "+s"(F.bid));
    KArgs a = kargs(); F.out = a->out; F.ws = a->ws; return F;
}
enum { I_X = 0, I_C, I_CTX, I_CCTX, I_N1G, I_N2G, I_ADAW, I_ADAB, I_W1, I_W2, I_GIN, I_GCONV, I_GALOG, I_GDT, I_GNG, I_GOUT, I_SIN, I_SCONV, I_SOUT, I_DIN, I_DLAM, I_DNG, I_DOUT, I_FG };

__device__ __forceinline__ void transpose_item(const float* W, int K, int ldw, bf16* WT, LAS float* scr, int item, int nblk, int lane) {
    const int kb = item / nblk, nb = item % nblk, k0 = 64 * kb, n0 = 32 * nb;
#pragma unroll 8
    for (int i = 0; i < 32; ++i) { const int kk = 2 * i + (lane >> 5); scr[kk * 33 + (lane & 31)] = W[(size_t)(k0 + kk) * ldw + n0 + (lane & 31)]; }
    LDS_WAIT(); asm volatile("" ::: "memory");
    const int c = lane & 7;
#pragma unroll
    for (int j = 0; j < 4; ++j) { const int n = (lane >> 3) + 8 * j; const LAS float* s = scr + (8 * c) * 33 + n;
        u32x4 o; o.x = pk2(s[0 * 33], s[1 * 33]); o.y = pk2(s[2 * 33], s[3 * 33]); o.z = pk2(s[4 * 33], s[5 * 33]); o.w = pk2(s[6 * 33], s[7 * 33]);
        *(u32x4*)(WT + (size_t)(n0 + n) * K + k0 + 8 * c) = o; }
    LDS_WAIT(); asm volatile("" ::: "memory");
}
__device__ __forceinline__ void get_mat(unsigned char* ws_, int idx, const float*& src, bf16*& dst, int& K, int& N, int& ld) {
    unsigned char* ws = ws_;
    if (idx < 4)       { src = INP(I_W1) + (size_t)idx * D * FF; dst = (bf16*)(ws + WS_W1T) + (size_t)idx * D * FF; K = D; N = FF; ld = FF; }
    else if (idx < 8)  { const int i = idx - 4; src = INP(I_W2) + (size_t)i * D * FF; dst = (bf16*)(ws + WS_W2T) + (size_t)i * D * FF; K = FF; N = D; ld = D; }
    else if (idx < 10) { const int j = idx - 8; src = INP(I_GIN) + (size_t)j * D * GDN_N; dst = (bf16*)(ws + WS_GINT) + (size_t)j * GDN_NP * D; K = D; N = GDN_N; ld = GDN_N; }
    else if (idx < 12) { const int j = idx - 10; src = INP(I_GOUT) + (size_t)j * D * D; dst = (bf16*)(ws + WS_GOUTT) + (size_t)j * D * D; K = D; N = D; ld = D; }
    else if (idx == 12) { src = INP(I_SIN); dst = (bf16*)(ws + WS_SINT); K = D; N = 3 * D; ld = 3 * D; }
    else if (idx == 13) { src = INP(I_SOUT); dst = (bf16*)(ws + WS_SOUTT); K = D; N = D; ld = D; }
    else if (idx == 14) { src = INP(I_DIN); dst = (bf16*)(ws + WS_DINT); K = D; N = 3 * D; ld = 3 * D; }
    else { src = INP(I_DOUT); dst = (bf16*)(ws + WS_DOUTT); K = D; N = D; ld = D; }
}
__device__ __forceinline__ void convert_weights(unsigned char* ws, unsigned mask, int gw, int NGW, int gt, int NGT, LAS unsigned char* lds, int wave, int lane) {
    LAS float* scr = (LAS float*)(lds + wave * 16384);
    for (int mi = 0; mi < 16; ++mi) {
        if (!((mask >> mi) & 1u)) continue;
        const float* src; bf16* dst; int K, N, ld; get_mat(ws, mi, src, dst, K, N, ld);
        const int nblk = N / 32, nitems = (K / 64) * nblk;
        for (int it = gw; it < nitems; it += NGW) transpose_item(src, K, ld, dst, scr, it, nblk, lane);
        if (mi == 8 || mi == 9) { u32x4* z = (u32x4*)((bf16*)(ws + WS_GINT) + (size_t)(mi - 8) * GDN_NP * D + (size_t)GDN_N * D);
            for (int i = gt; i < (GDN_NP - GDN_N) * D / 8; i += NGT) z[i] = (u32x4){0u, 0u, 0u, 0u}; }
    }
}
__device__ __forceinline__ void step_prologue() {
    const Frame F = make_frame();
    const int gw = F.bid * NWAVES + F.wave, NGW = F.G * NWAVES;
    const int gt = F.bid * NTHR + F.tid, NGT = F.G * NTHR;
    convert_weights(F.ws, (1u << 0) | (1u << 4) | (1u << 8) | (1u << 10), gw, NGW, gt, NGT, F.lds, F.wave, F.lane);
    __syncthreads();
    {
        LAS float* sv = (LAS float*)F.lds;
        LAS float* red = sv + 3 * D;
        for (int i = F.tid; i < 3 * D; i += NTHR) { const int g = i / D, k = i % D; const float c = g < 2 ? INP(I_C)[g * D + k] : INP(I_CCTX)[k]; sv[i] = silu_f(c); }
        __syncthreads();
        float* MOD = (float*)(F.ws + WS_MOD);
        const int c = F.tid & 63, ks = F.tid >> 6;
        for (int it = F.bid; it < DEPTH * (NADA / 64); it += F.G) {
            const int li = it / (NADA / 64), n0 = (it % (NADA / 64)) * 64;
            const float* w = INP(I_ADAW) + (size_t)li * D * NADA + (size_t)(ks * 128) * NADA + n0 + c;
            float a0 = 0.f, a1 = 0.f, a2 = 0.f;
#pragma unroll 8
            for (int k = 0; k < 128; ++k) { const float wv = w[(size_t)k * NADA]; const int kk = ks * 128 + k; a0 += sv[kk] * wv; a1 += sv[D + kk] * wv; a2 += sv[2 * D + kk] * wv; }
            red[(ks * 3 + 0) * 64 + c] = a0; red[(ks * 3 + 1) * 64 + c] = a1; red[(ks * 3 + 2) * 64 + c] = a2;
            __syncthreads();
            if (F.tid < 192) { const int g = F.tid >> 6; float s = INP(I_ADAB)[li * NADA + n0 + c];
#pragma unroll
                for (int q = 0; q < 8; ++q) s += red[(q * 3 + g) * 64 + c];
                MOD[((size_t)li * 3 + g) * NADA + n0 + c] = s; }
            __syncthreads();
        }
    }
    {
        f32x4* X4 = (f32x4*)(F.ws + WS_X); const f32x4* x4 = (const f32x4*)INP(I_X); const f32x4* c4 = (const f32x4*)INP(I_CTX);
        for (int i = gt; i < M * (D / 4); i += NGT) X4[i] = i < ML * (D / 4) ? x4[i] : c4[i - ML * (D / 4)];
    }
    {
        f32x2* R = (f32x2*)(F.ws + WS_ROPE);
        for (int i = gt; i < T * 32; i += NGT) { const int t = i >> 5, p = i & 31, f = p & 15;
            const float inv = powf(10000.0f, -(float)f / 16.0f); const float pos = (float)(p < 16 ? (t >> 6) : (t & 63)); const float ang = pos * inv;
            R[i] = (f32x2){cosf(ang), sinf(ang)}; }
    }
}

__device__ __forceinline__ void step_norm(int layer, int which, int nrows, bool zero_of) {
    const Frame F = make_frame();
    const int gw = F.bid * NWAVES + F.wave, NGW = F.G * NWAVES;
    const float* X = (const float*)(F.ws + WS_X); bf16* H = (bf16*)(F.ws + WS_H);
    const float* ng = (which ? INP(I_N2G) : INP(I_N1G)) + layer * D;
    const float* MOD = (const float*)(F.ws + WS_MOD) + (size_t)layer * 3 * NADA + which * 3 * D;
    for (int row = gw; row < nrows; row += NGW) {
        const int grp = row < T ? 0 : (row < ML ? 1 : 2);
        const f32x4* xr = (const f32x4*)(X + (size_t)row * D) + F.lane;
        const f32x4* sh = (const f32x4*)(MOD + (size_t)grp * NADA) + F.lane; const f32x4* sc = (const f32x4*)(MOD + (size_t)grp * NADA + D) + F.lane; const f32x4* gg = (const f32x4*)ng + F.lane;
        f32x4 v[4]; float s = 0.f;
#pragma unroll
        for (int j = 0; j < 4; ++j) { v[j] = xr[64 * j]; s += (v[j].x * v[j].x + v[j].y * v[j].y) + (v[j].z * v[j].z + v[j].w * v[j].w); }
        const float rstd = 1.0f / sqrtf(wave_sum(s) * (1.f / D) + EPS);
        u32x2* o = (u32x2*)(H + (size_t)row * D) + F.lane;
#pragma unroll
        for (int j = 0; j < 4; ++j) { const f32x4 g4 = gg[64 * j], s4 = sc[64 * j], h4 = sh[64 * j]; const f32x4 y = (v[j] * rstd) * g4; const f32x4 h = y * (1.0f + s4) + h4;
            o[64 * j] = (u32x2){pk2(h.x, h.y), pk2(h.z, h.w)}; }
    }
    if (zero_of) {
        const int gt = F.bid * NTHR + F.tid, NGT = F.G * NTHR;
        f32x4* a = (f32x4*)F.out; for (int i = gt; i < ML * (D / 4); i += NGT) a[i] = (f32x4){0.f, 0.f, 0.f, 0.f};
        f32x4* b = (f32x4*)(F.ws + WS_OFC); for (int i = gt; i < MC * (D / 4); i += NGT) b[i] = (f32x4){0.f, 0.f, 0.f, 0.f};
    }
}
__device__ __forceinline__ void step_final() {
    const Frame F = make_frame();
    const int gw = F.bid * NWAVES + F.wave, NGW = F.G * NWAVES;
    const float* X = (const float*)(F.ws + WS_X);
    for (int row = gw; row < ML; row += NGW) {
        const f32x4* xr = (const f32x4*)(X + (size_t)row * D) + F.lane; const f32x4* gg = (const f32x4*)INP(I_FG) + F.lane;
        f32x4 v[4]; float s = 0.f;
#pragma unroll
        for (int j = 0; j < 4; ++j) { v[j] = xr[64 * j]; s += (v[j].x * v[j].x + v[j].y * v[j].y) + (v[j].z * v[j].z + v[j].w * v[j].w); }
        const float rstd = 1.0f / sqrtf(wave_sum(s) * (1.f / D) + EPS);
        f32x4* o = (f32x4*)(F.out + (size_t)row * D) + F.lane;
#pragma unroll
        for (int j = 0; j < 4; ++j) o[64 * j] = (v[j] * rstd) * gg[64 * j];
    }
}

__device__ __forceinline__ void step_gdn_scan(int j) {
    const Frame F = make_frame();
    LAS float* qs = (LAS float*)F.lds;
    LAS float* ks = qs + 64 * 128;
    LAS float* vs = ks + 64 * 128;
    LAS float* ga = vs + 64 * 128;
    LAS float* be = ga + 64;
    const bf16* Z = (const bf16*)(F.ws + WS_Z);
    const float* AB = (const float*)(F.ws + WS_AB);
    const float* cw = INP(I_GCONV) + (size_t)j * 3 * 3072;
    float* OFC = (float*)(F.ws + WS_OFC);
    for (int it = F.bid; it < 32; it += F.G) {
        const int b = it >> 4, h = (it >> 1) & 7, dir = it & 1;
        const float Aco = expf(INP(I_GALOG)[j * 16 + dir * 8 + h]); const float dtb = INP(I_GDT)[j * 16 + dir * 8 + h];
        float S[64];
#pragma unroll
        for (int i = 0; i < 64; ++i) S[i] = 0.f;
        const int jcol = F.tid >> 1, half = F.tid & 1;
        for (int n = 0; n < 132; ++n) {
            const bool isctx = n < 4; const int L = isctx ? CT : T; const int p0 = isctx ? 64 * n : 64 * (n - 4); const int rbase = isctx ? ML + b * CT : b * T;
            for (int idx = F.tid; idx < 64 * 384; idx += NTHR) {
                const int c = idx / 384, ch = idx % 384, part = ch >> 7, e = ch & 127;
                const int p = p0 + c; const int t = dir ? (L - 1 - p) : p; const int col = part * 1024 + h * 128 + e;
                float acc = 0.f;
#pragma unroll
                for (int tap = 0; tap < 3; ++tap) { const int tt = t + tap - 1; if (tt >= 0 && tt < L) acc += cw[tap * 3072 + col] * bf2f(Z[(size_t)(rbase + tt) * 4096 + col]); }
                acc = silu_f(acc);
                LAS float* dst = part == 0 ? qs : (part == 1 ? ks : vs); dst[c * 128 + e] = acc;
            }
            if (F.tid < 64) { const int p = p0 + F.tid; const int t = dir ? (L - 1 - p) : p; const size_t row = (size_t)(rbase + t);
                const float av = AB[row * 32 + dir * 8 + h], bv = AB[row * 32 + 16 + dir * 8 + h];
                const float x = av + dtb; const float sp = x > 20.f ? x : log1pf(expf(x));
                ga[F.tid] = expf(-Aco * sp); be[F.tid] = 1.f / (1.f + expf(-bv)); }
            __syncthreads();
#pragma unroll 1
            for (int rr = 0; rr < 8; ++rr) { const int c = F.wave * 8 + rr;
                const float q0 = qs[c * 128 + F.lane], q1 = qs[c * 128 + 64 + F.lane]; const float sq = 0.08838834764831845f / sqrtf(wave_sum(q0 * q0 + q1 * q1) + EPS);
                qs[c * 128 + F.lane] = q0 * sq; qs[c * 128 + 64 + F.lane] = q1 * sq;
                const float k0 = ks[c * 128 + F.lane], k1 = ks[c * 128 + 64 + F.lane]; const float sk = 1.0f / sqrtf(wave_sum(k0 * k0 + k1 * k1) + EPS);
                ks[c * 128 + F.lane] = k0 * sk; ks[c * 128 + 64 + F.lane] = k1 * sk; }
            __syncthreads();
            if (F.tid < 256) {
#pragma unroll 1
                for (int c = 0; c < 64; ++c) {
                    const float a = ga[c], bt = be[c];
                    const LAS f32x4* k4 = (const LAS f32x4*)(ks + c * 128 + 64 * half); const LAS f32x4* q4 = (const LAS f32x4*)(qs + c * 128 + 64 * half);
                    float dot = 0.f;
#pragma unroll
                    for (int i = 0; i < 16; ++i) { const f32x4 kv = k4[i]; dot += kv.x * S[4 * i] + kv.y * S[4 * i + 1] + kv.z * S[4 * i + 2] + kv.w * S[4 * i + 3]; }
                    dot += __shfl_xor(dot, 1);
                    const float tmp = bt * (vs[c * 128 + jcol] - a * dot);
                    float o = 0.f;
#pragma unroll
                    for (int i = 0; i < 16; ++i) { const f32x4 kv = k4[i]; const f32x4 qv = q4[i];
                        S[4 * i] = a * S[4 * i] + kv.x * tmp; S[4 * i + 1] = a * S[4 * i + 1] + kv.y * tmp; S[4 * i + 2] = a * S[4 * i + 2] + kv.z * tmp; S[4 * i + 3] = a * S[4 * i + 3] + kv.w * tmp;
                        o += qv.x * S[4 * i] + qv.y * S[4 * i + 1] + qv.z * S[4 * i + 2] + qv.w * S[4 * i + 3]; }
                    o += __shfl_xor(o, 1);
                    const int p = p0 + c; const int t = dir ? (L - 1 - p) : p;
                    float* dst = isctx ? OFC + (size_t)(b * CT + t) * D : F.out + (size_t)(b * T + t) * D;
                    if (half == 0) atomicAdd(dst + h * 128 + jcol, o);
                }
            }
            __syncthreads();
        }
    }
}
__device__ __forceinline__ void step_gdn_norm(int j) {
    const Frame F = make_frame();
    const int gw = F.bid * NWAVES + F.wave, NGW = F.G * NWAVES;
    const bf16* Z = (const bf16*)(F.ws + WS_Z); bf16* Y = (bf16*)(F.ws + WS_Y); const float* ng = INP(I_GNG) + j * 128;
    for (int row = gw; row < M; row += NGW) {
        const float* src = row < ML ? F.out + (size_t)row * D : (const float*)(F.ws + WS_OFC) + (size_t)(row - ML) * D;
        const f32x4* s4 = (const f32x4*)(src + 16 * F.lane);
        float v[16]; float ss = 0.f;
#pragma unroll
        for (int q = 0; q < 4; ++q) { const f32x4 x = s4[q]; v[4 * q] = x.x; v[4 * q + 1] = x.y; v[4 * q + 2] = x.z; v[4 * q + 3] = x.w; ss += (x.x * x.x + x.y * x.y) + (x.z * x.z + x.w * x.w); }
        ss += __shfl_xor(ss, 1); ss += __shfl_xor(ss, 2); ss += __shfl_xor(ss, 4);
        const float rstd = 1.0f / sqrtf(ss * (1.f / 128.f) + EPS);
        const u32x4* g4 = (const u32x4*)(Z + (size_t)row * 4096 + 3072 + 16 * F.lane);
        const int e0 = (16 * F.lane) & 127;
        u32x4 o[2];
#pragma unroll
        for (int q = 0; q < 2; ++q) { const u32x4 gz = g4[q]; unsigned w[4];
#pragma unroll
            for (int i = 0; i < 4; ++i) { const unsigned gg = gz[i]; const float g0 = bf2f(gg & 0xffffu), g1 = bf2f(gg >> 16); const int e = e0 + 8 * q + 2 * i;
                w[i] = pk2(v[8 * q + 2 * i] * rstd * ng[e] * silu_f(g0), v[8 * q + 2 * i + 1] * rstd * ng[e + 1] * silu_f(g1)); }
            o[q] = (u32x4){w[0], w[1], w[2], w[3]}; }
        u32x4* dst = (u32x4*)(Y + (size_t)row * D + 16 * F.lane); dst[0] = o[0]; dst[1] = o[1];
    }
}

__device__ __forceinline__ void step_sconv() {
    const Frame F = make_frame();
    const int gt = F.bid * NTHR + F.tid, NGT = F.G * NTHR;
    const bf16* Z = (const bf16*)(F.ws + WS_Z); bf16* Y = (bf16*)(F.ws + WS_Y); const float* cw = INP(I_SCONV);
    for (int idx = gt; idx < M * 128; idx += NGT) {
        const int row = idx >> 7, c0 = (idx & 127) * 8;
        int t, L, rbase; if (row < ML) { t = row & (T - 1); L = T; rbase = row - t; } else { const int r2 = row - ML; t = r2 & (CT - 1); L = CT; rbase = row - t; }
        float acc[8];
#pragma unroll
        for (int i = 0; i < 8; ++i) acc[i] = 0.f;
#pragma unroll
        for (int tap = 0; tap < 3; ++tap) { const int tt = t + tap - 1;
            if (tt >= 0 && tt < L) { const bf16* zr = Z + (size_t)(rbase + tt) * 3072; const u32x4 cg = *(const u32x4*)(zr + 1024 + c0), hv = *(const u32x4*)(zr + 2048 + c0);
                const f32x4 w0 = *(const f32x4*)(cw + tap * 1024 + c0), w1 = *(const f32x4*)(cw + tap * 1024 + c0 + 4); const float w[8] = {w0.x, w0.y, w0.z, w0.w, w1.x, w1.y, w1.z, w1.w};
#pragma unroll
                for (int i = 0; i < 4; ++i) { acc[2 * i] += w[2 * i] * bf2f(cg[i] & 0xffffu) * bf2f(hv[i] & 0xffffu); acc[2 * i + 1] += w[2 * i + 1] * bf2f(cg[i] >> 16) * bf2f(hv[i] >> 16); } } }
        const u32x4 bg = *(const u32x4*)(Z + (size_t)row * 3072 + c0); u32x4 o;
#pragma unroll
        for (int i = 0; i < 4; ++i) o[i] = pk2(bf2f(bg[i] & 0xffffu) * acc[2 * i], bf2f(bg[i] >> 16) * acc[2 * i + 1]);
        *(u32x4*)(Y + (size_t)row * D + c0) = o;
    }
}

__device__ __forceinline__ void step_rope() {
    const Frame F = make_frame();
    const int gw = F.bid * NWAVES + F.wave, NGW = F.G * NWAVES;
    bf16* Z = (bf16*)(F.ws + WS_Z); const f32x4* R = (const f32x4*)(F.ws + WS_ROPE);
    for (int row = gw; row < M; row += NGW) {
        u32x4* p = (u32x4*)(Z + (size_t)row * 3072 + 32 * F.lane);
        u32x4 v[4];
#pragma unroll
        for (int q = 0; q < 4; ++q) v[q] = p[q];
        const bool lat = row < ML; const float sc = F.lane < 32 ? QSCALE : 1.0f;
        const f32x4* tab = R + ((size_t)(row & (T - 1)) * 32 + 16 * (F.lane & 1)) / 2;
#pragma unroll
        for (int q = 0; q < 4; ++q) {
#pragma unroll
            for (int i = 0; i < 4; i += 2) {
                f32x4 cs = (f32x4){1.f, 0.f, 1.f, 0.f}; if (lat) cs = tab[(4 * q + i) / 2];
                { const unsigned w = v[q][i]; const float x0 = bf2f(w & 0xffffu), x1 = bf2f(w >> 16); v[q][i] = pk2((x0 * cs.x - x1 * cs.y) * sc, (x0 * cs.y + x1 * cs.x) * sc); }
                { const unsigned w = v[q][i + 1]; const float x0 = bf2f(w & 0xffffu), x1 = bf2f(w >> 16); v[q][i + 1] = pk2((x0 * cs.z - x1 * cs.w) * sc, (x0 * cs.w + x1 * cs.z) * sc); }
            }
        }
#pragma unroll
        for (int q = 0; q < 4; ++q) p[q] = v[q];
    }
    bf16* Vt = (bf16*)(F.ws + WS_H);
    LAS bf16* tl = (LAS bf16*)(F.lds + F.wave * 18432);
    for (int it = gw; it < NB * NH * (NKV / 64); it += NGW) {
        const int kt = it % (NKV / 64), bh = it / (NKV / 64), b = bh >> 3, h = bh & 7; const int kv0 = 64 * kt;
        const int srow = kv0 < CT ? ML + b * CT + kv0 : b * T + kv0 - CT;
#pragma unroll 4
        for (int i = 0; i < 16; ++i) { const int r = 4 * i + (F.lane >> 4), cc = (F.lane & 15) * 8;
            const u32x4 v = *(const u32x4*)(Z + (size_t)(srow + r) * 3072 + 2048 + h * 128 + cc);
#pragma unroll
            for (int q = 0; q < 4; ++q) { tl[(cc + 2 * q) * 72 + r] = (bf16)(v[q] & 0xffffu); tl[(cc + 2 * q + 1) * 72 + r] = (bf16)(v[q] >> 16); } }
        LDS_WAIT(); asm volatile("" ::: "memory");
#pragma unroll 4
        for (int i = 0; i < 16; ++i) { const int e = 8 * i + (F.lane >> 3), ch = F.lane & 7;
            const u32x4 v = *(const LAS u32x4*)(tl + e * 72 + ch * 8);
            *(u32x4*)(Vt + ((size_t)(bh * 128 + e)) * NKV + kv0 + ch * 8) = v; }
        LDS_WAIT(); asm volatile("" ::: "memory");
    }
}
__device__ __forceinline__ void step_attn() {
    const Frame F = make_frame();
    const bf16* Z = (const bf16*)(F.ws + WS_Z); const bf16* Vt = (const bf16*)(F.ws + WS_H); bf16* Y = (bf16*)(F.ws + WS_Y);
    LAS float* EX = (LAS float*)F.lds;
    const int r = F.lane & 31, hi = F.lane >> 5, qs = F.wave & 3, m = F.wave >> 2;
    float lmb;
    { const float* lam = INP(I_DLAM); const float t1 = lam[F.lane] * lam[64 + F.lane], t2 = lam[128 + F.lane] * lam[192 + F.lane]; lmb = expf(wave_sum(t1)) - expf(wave_sum(t2)) + LAMBDA_INIT; }
    const float* ng = INP(I_DNG);
    for (int u = F.bid; u < 1056; u += F.G) {
        int b, h, qrow0, nk;
        if (u < 1024) { b = u >> 9; h = (u >> 6) & 7; qrow0 = b * T + (u & 63) * 128; nk = NKV / 32; }
        else { const int v = u - 1024; b = v >> 4; h = (v >> 1) & 7; qrow0 = ML + b * CT + (v & 1) * 128; nk = CT / 32; }
        const int row0 = qrow0 + 32 * qs;
        bf16x8 qf[4];
#pragma unroll
        for (int d0 = 0; d0 < 4; ++d0) qf[d0] = *(const bf16x8*)(Z + (size_t)(row0 + r) * 3072 + h * 128 + m * 64 + d0 * 16 + hi * 8);
        const int kcol = 1024 + h * 128 + m * 64 + hi * 8;
        const bf16* vtb = Vt + (size_t)((b * 8 + h) * 128 + r) * NKV + 4 * hi;
        f32x16 o[4];
#pragma unroll
        for (int i = 0; i < 4; ++i)
#pragma unroll
            for (int q = 0; q < 16; ++q) o[i][q] = 0.f;
        float mref = 0.f, l = 0.f;
        for (int s = 0; s < nk; ++s) {
            const int kv0 = 32 * s; const int krow = kv0 < CT ? ML + b * CT + kv0 : b * T + kv0 - CT;
            const bf16* kp = Z + (size_t)(krow + r) * 3072 + kcol;
            bf16x8 kf[4];
#pragma unroll
            for (int d0 = 0; d0 < 4; ++d0) kf[d0] = *(const bf16x8*)(kp + d0 * 16);
            bf16x8 vf[4][2];
#pragma unroll
            for (int i = 0; i < 4; ++i)
#pragma unroll
                for (int s2 = 0; s2 < 2; ++s2) { const bf16* vp = vtb + (size_t)(32 * i) * NKV + kv0 + 16 * s2; const s16x4 lo = *(const s16x4*)vp, h8 = *(const s16x4*)(vp + 8);
                    vf[i][s2] = (bf16x8){lo[0], lo[1], lo[2], lo[3], h8[0], h8[1], h8[2], h8[3]}; }
            f32x16 S;
#pragma unroll
            for (int q = 0; q < 16; ++q) S[q] = 0.f;
#pragma unroll
            for (int d0 = 0; d0 < 4; ++d0) S = __builtin_amdgcn_mfma_f32_32x32x16_bf16(kf[d0], qf[d0], S, 0, 0, 0);
            float mx = S[0];
#pragma unroll
            for (int q = 1; q < 16; ++q) mx = fmaxf(mx, S[q]);
            mx = fmaxf(mx, __shfl_xor(mx, 32));
            if (s == 0) mref = mx;
            else if (__any(mx > mref)) { const float mn = fmaxf(mref, mx); const float al = __builtin_amdgcn_exp2f(mref - mn); l *= al; mref = mn;
#pragma unroll
                for (int i = 0; i < 4; ++i)
#pragma unroll
                    for (int q = 0; q < 16; ++q) o[i][q] *= al; }
            float ps = 0.f;
#pragma unroll
            for (int q = 0; q < 16; ++q) { S[q] = __builtin_amdgcn_exp2f(S[q] - mref); ps += S[q]; }
            l += ps;
            bf16x8 pf[2];
#pragma unroll
            for (int s2 = 0; s2 < 2; ++s2) { u32x4 w; w.x = pk2(S[8 * s2], S[8 * s2 + 1]); w.y = pk2(S[8 * s2 + 2], S[8 * s2 + 3]); w.z = pk2(S[8 * s2 + 4], S[8 * s2 + 5]); w.w = pk2(S[8 * s2 + 6], S[8 * s2 + 7]); pf[s2] = __builtin_bit_cast(bf16x8, w); }
#pragma unroll
            for (int i = 0; i < 4; ++i)
#pragma unroll
                for (int s2 = 0; s2 < 2; ++s2) o[i] = __builtin_amdgcn_mfma_f32_32x32x16_bf16(vf[i][s2], pf[s2], o[i], 0, 0, 0);
        }
        l += __shfl_xor(l, 32);
        const float f = (m == 1 ? lmb : 1.0f) / l;
        LAS float* ex = EX + (size_t)m * 128 * 129 + (qs * 32 + r) * 129;
#pragma unroll
        for (int i = 0; i < 4; ++i)
#pragma unroll
            for (int q = 0; q < 16; ++q) ex[32 * i + crow(q, hi)] = o[i][q] * f;
        __syncthreads();
#pragma unroll 1
        for (int rr = 0; rr < 16; ++rr) { const int row = 16 * F.wave + rr;
            const float a0 = EX[row * 129 + F.lane] - EX[128 * 129 + row * 129 + F.lane], a1 = EX[row * 129 + 64 + F.lane] - EX[128 * 129 + row * 129 + 64 + F.lane];
            const float rstd = (1.0f - LAMBDA_INIT) / sqrtf(wave_sum(a0 * a0 + a1 * a1) * (1.f / 128.f) + EPS);
            bf16* yr = Y + (size_t)(qrow0 + row) * D + h * 128;
            yr[F.lane] = (bf16)(pk2(a0 * rstd * ng[F.lane], 0.f) & 0xffffu); yr[64 + F.lane] = (bf16)(pk2(a1 * rstd * ng[64 + F.lane], 0.f) & 0xffffu); }
        __syncthreads();
    }
}

constexpr int PD_BYTES = 12800, PD_ATT = 6144, PD_EG = 12288, PD_EW = 12544;
__device__ __forceinline__ unsigned off_a(unsigned row, unsigned ch) { return 2048u * (row >> 3) + 512u * (ch >> 2) + 64u * (row & 7) + 16u * ((ch & 3) ^ ((row >> 2) & 3)); }
__device__ __forceinline__ int frag_off(int c, int s) {
    const int slot = (c >> 5) == (s >> 5) ? ((c >> 5) ? 2 : 0) : 1, s2 = (s & 31) >> 4, hh = ((s & 15) >> 2) & 1, jj = ((s & 15) >> 3) * 4 + (s & 3), r = c & 31;
    return slot * 2048 + s2 * 1024 + (hh * 32 + r) * 16 + jj * 2;
}
__device__ __forceinline__ void step_gdn_prep(int j, bool overlap, unsigned* flags, bool dry = false, int skip = 0) {
    const Frame F = make_frame();
    LAS float* STG = (LAS float*)F.lds;
    LAS float* KK = (LAS float*)F.lds;
    LAS float* QK = KK + 64 * 68;
    LAS float* LP = (LAS float*)(F.lds + 34816);
    LAS float* TS = (LAS float*)(F.lds + 67584);
    LAS unsigned char* QI = F.lds + 102400; LAS unsigned char* KI = F.lds + 118784;
    LAS float* SM = (LAS float*)(F.lds + 135168);
    bf16* Z = (bf16*)(F.ws + WS_Z); const float* AB = (const float*)(F.ws + WS_AB); const bf16* HALO = (const bf16*)(F.ws + WS_HALO); unsigned char* PD = F.ws + WS_PD;
    const float* cw = INP(I_GCONV) + (size_t)j * 3 * 3072;
    const int r = F.lane & 31, hi = F.lane >> 5;
    const int first = overlap ? 32 : 0;
    for (int it = F.bid - first; it >= 0 && it < NB * NH * 132; it += F.G - first) {
        int n, bh;
        if (overlap) { bh = it & 15; const int pos = it >> 4;
            if (pos < 4) n = pos == 0 ? 0 : (pos == 1 ? 3 : (pos == 2 ? 1 : 2)); else { const int k = pos - 4; n = (k & 1) ? 131 - (k >> 1) : 4 + (k >> 1); } }
        else { n = it % 132; bh = it / 132; }
        const int b = bh >> 3, h = bh & 7;
        const bool isctx = n < 4; const int L = isctx ? CT : T; const int t0 = isctx ? 64 * n : 64 * (n - 4); const int row0 = (isctx ? ML + b * CT : b * T) + t0;
        if (F.tid < 384) {
            const int g8 = F.tid % 48, rp = F.tid / 48, part = g8 >> 4, e0 = (g8 & 15) * 8; const int col = part * 1024 + h * 128 + e0;
            const float* wp = cw + col;
            f32x4 wt[3][2];
#pragma unroll
            for (int tap = 0; tap < 3; ++tap) { wt[tap][0] = *(const f32x4*)(wp + tap * 3072); wt[tap][1] = *(const f32x4*)(wp + tap * 3072 + 4); }
            u32x4 zr[10];
#pragma unroll
            for (int ri = 0; ri < 10; ++ri) { const int c = 8 * rp - 1 + ri; const int t = t0 + c;
                const bf16* src = c < 0 ? HALO + ((size_t)((row0 >> 6) - 1) * 2 + 1) * 3072 + col : (c > 63 ? HALO + ((size_t)((row0 >> 6) + 1) * 2) * 3072 + col : Z + (size_t)(row0 + c) * 4096 + col);
                const bool valid = t >= 0 && t < L;
                if (!valid) src = Z + (size_t)row0 * 4096 + col;
                zr[ri] = *(const u32x4*)src; if (!valid) zr[ri] = (u32x4){0u, 0u, 0u, 0u}; }
#pragma unroll
            for (int i = 0; i < 8; ++i) { float o[8];
#pragma unroll
                for (int q = 0; q < 4; ++q) { const unsigned a = zr[i][q], bq = zr[i + 1][q], cq = zr[i + 2][q];
                    o[2 * q] = silu_fast(wt[0][q >> 1][2 * (q & 1)] * bf2f(a & 0xffffu) + wt[1][q >> 1][2 * (q & 1)] * bf2f(bq & 0xffffu) + wt[2][q >> 1][2 * (q & 1)] * bf2f(cq & 0xffffu));
                    o[2 * q + 1] = silu_fast(wt[0][q >> 1][2 * (q & 1) + 1] * bf2f(a >> 16) + wt[1][q >> 1][2 * (q & 1) + 1] * bf2f(bq >> 16) + wt[2][q >> 1][2 * (q & 1) + 1] * bf2f(cq >> 16)); }
                LAS f32x4* dst = (LAS f32x4*)(STG + (8 * rp + i) * 388 + part * 128 + e0); dst[0] = (f32x4){o[0], o[1], o[2], o[3]}; dst[1] = (f32x4){o[4], o[5], o[6], o[7]}; }
        }
        if (F.wave >= 6) {
            const int d = F.wave - 6, c = F.lane; const size_t row = (size_t)(row0 + c);
            const float Aco = expf(INP(I_GALOG)[j * 16 + d * 8 + h]), dtb = INP(I_GDT)[j * 16 + d * 8 + h];
            const float x = AB[row * 32 + d * 8 + h] + dtb, bb = AB[row * 32 + 16 + d * 8 + h];
            const float sp = x > 20.f ? x : log1pf(expf(x));
            float s = -Aco * sp;
#pragma unroll
            for (int o = 1; o < 64; o <<= 1) { const float up = __shfl_up(s, o), dn = __shfl_down(s, o); if (d ? (c + o < 64) : (c >= o)) s += d ? dn : up; }
            SM[d * 64 + c] = 1.f / (1.f + expf(-bb)); SM[128 + d * 64 + c] = s;
        }
        __syncthreads();
        if (skip & 8) continue;
        { float qv[8][2], kv[8][2], sq[8], sk[8];
#pragma unroll
            for (int rr = 0; rr < 8; ++rr) { const LAS float* sr = STG + (F.wave * 8 + rr) * 388;
                qv[rr][0] = sr[F.lane]; qv[rr][1] = sr[64 + F.lane]; kv[rr][0] = sr[128 + F.lane]; kv[rr][1] = sr[192 + F.lane];
                sq[rr] = qv[rr][0] * qv[rr][0] + qv[rr][1] * qv[rr][1]; sk[rr] = kv[rr][0] * kv[rr][0] + kv[rr][1] * kv[rr][1]; }
#pragma unroll
            for (int o = 1; o < 64; o <<= 1) {
#pragma unroll
                for (int rr = 0; rr < 8; ++rr) { sq[rr] += __shfl_xor(sq[rr], o); sk[rr] += __shfl_xor(sk[rr], o); } }
#pragma unroll
            for (int rr = 0; rr < 8; ++rr) { const int c = F.wave * 8 + rr; const LAS float* sr = STG + c * 388;
                const float fq = 0.08838834764831845f / sqrtf(sq[rr] + EPS), fk = 1.0f / sqrtf(sk[rr] + EPS);
                const unsigned o0 = off_a(c, F.lane >> 3) + 2 * (F.lane & 7), o1 = off_a(c, 8 + (F.lane >> 3)) + 2 * (F.lane & 7);
                *(LAS bf16*)(QI + o0) = (bf16)(pk2(qv[rr][0] * fq, 0.f) & 0xffffu); *(LAS bf16*)(QI + o1) = (bf16)(pk2(qv[rr][1] * fq, 0.f) & 0xffffu);
                *(LAS bf16*)(KI + o0) = (bf16)(pk2(kv[rr][0] * fk, 0.f) & 0xffffu); *(LAS bf16*)(KI + o1) = (bf16)(pk2(kv[rr][1] * fk, 0.f) & 0xffffu);
                bf16* vd = Z + (size_t)(row0 + c) * 4096 + 2048 + h * 128;
                if (!dry) { vd[F.lane] = (bf16)(pk2(sr[256 + F.lane], 0.f) & 0xffffu); vd[64 + F.lane] = (bf16)(pk2(sr[320 + F.lane], 0.f) & 0xffffu); } } }
        __syncthreads();
        if (skip & 4) continue;
        { const int prod = F.wave >> 2, mt = (F.wave >> 1) & 1, nt = F.wave & 1; LAS unsigned char* AI = prod ? QI : KI;
            f32x16 acc;
#pragma unroll
            for (int i = 0; i < 16; ++i) acc[i] = 0.f;
#pragma unroll
            for (int ks = 0; ks < 8; ++ks) { const bf16x8 a = *(const LAS bf16x8*)(AI + off_a(32 * mt + r, 2 * ks + hi)), bq = *(const LAS bf16x8*)(KI + off_a(32 * nt + r, 2 * ks + hi));
                acc = __builtin_amdgcn_mfma_f32_32x32x16_bf16(a, bq, acc, 0, 0, 0); }
            LAS float* dst = prod ? QK : KK;
#pragma unroll
            for (int i = 0; i < 16; ++i) dst[(32 * mt + crow(i, hi)) * 68 + 32 * nt + r] = acc[i]; }
        __syncthreads();
        if (skip & 2) continue;
        for (int idx = F.tid; idx < 8192; idx += NTHR) { const int d = idx >> 12, p = (idx >> 6) & 63, ps = idx & 63; float val = 0.f;
            if (ps < p) { const int c = d ? 63 - p : p, s = d ? 63 - ps : ps; val = SM[d * 64 + c] * KK[c * 68 + s] * expf(SM[128 + d * 64 + c] - SM[128 + d * 64 + s]); }
            LP[idx] = val; }
        __syncthreads();
        unsigned char* rec = PD + ((size_t)((b * 8 + h) * 132 + n)) * PD_BYTES;
        constexpr size_t DSTRIDE = (size_t)16 * 132 * PD_BYTES;
        if (F.wave < 2) { if (!(skip & 1)) {
            const int d = F.wave, jc = F.lane;
            float Lr[64], Tc[64];
#pragma unroll
            for (int p = 1; p < 64; ++p) Lr[p] = LP[d * 4096 + p * 64 + F.lane];
#pragma unroll
            for (int p = 0; p < 64; ++p) { float acc[4]; acc[0] = (p == jc) ? 1.f : 0.f; acc[1] = 0.f; acc[2] = 0.f; acc[3] = 0.f;
#pragma unroll
                for (int sx = 0; sx < p; ++sx) { const float l = __int_as_float(__builtin_amdgcn_readlane(__float_as_int(Lr[p]), sx)); acc[sx & 3] -= l * Tc[sx]; }
                Tc[p] = (acc[0] + acc[1]) + (acc[2] + acc[3]); }
            const int s = d ? 63 - jc : jc;
#pragma unroll
            for (int p = 0; p < 64; ++p) TS[d * 4352 + (d ? 63 - p : p) * 68 + s] = Tc[p]; }
        } else {
            for (int q = F.tid - 128; q < 768; q += NTHR - 128) { const int d = q / 384, qq = q % 384, slot = qq >> 7, s2 = (qq >> 6) & 1, ln = qq & 63, hh = ln >> 5, rr = ln & 31;
                const int mtr = slot == 0 ? 0 : (slot == 2 ? 1 : (d ? 0 : 1)), mtc = slot == 0 ? 0 : (slot == 2 ? 1 : (d ? 1 : 0));
                const int c = 32 * mtr + rr, sa = 32 * mtc + 16 * s2 + 4 * hh; const float gcc = SM[128 + d * 64 + c];
                const f32x4 qa = *(const LAS f32x4*)(QK + c * 68 + sa), qb = *(const LAS f32x4*)(QK + c * 68 + sa + 8);
                const f32x4 ga = *(const LAS f32x4*)(SM + 128 + d * 64 + sa), gb = *(const LAS f32x4*)(SM + 128 + d * 64 + sa + 8);
                float v[8];
#pragma unroll
                for (int i = 0; i < 4; ++i) { const int s0 = sa + i, s1 = sa + 8 + i; const bool m0 = d ? (s0 >= c) : (s0 <= c), m1 = d ? (s1 >= c) : (s1 <= c);
                    v[i] = m0 ? qa[i] * expf(gcc - ga[i]) : 0.f; v[4 + i] = m1 ? qb[i] * expf(gcc - gb[i]) : 0.f; }
                if (!dry) *(u32x4*)(rec + d * DSTRIDE + PD_ATT + qq * 16) = (u32x4){pk2(v[0], v[1]), pk2(v[2], v[3]), pk2(v[4], v[5]), pk2(v[6], v[7])}; }
            if (F.tid >= 128 && F.tid < 256) { const int d = (F.tid - 128) >> 6, c = F.tid & 63; const float gl = SM[128 + d * 64 + (d ? 0 : 63)], gcv = SM[128 + d * 64 + c];
                if (!dry) { *(float*)(rec + d * DSTRIDE + PD_EG + 4 * c) = expf(gcv); *(float*)(rec + d * DSTRIDE + PD_EW + 4 * c) = expf(gl - gcv); } }
        }
        __syncthreads();
        for (int q = F.tid; q < 768; q += NTHR) { const int d = q / 384, qq = q % 384, slot = qq >> 7, s2 = (qq >> 6) & 1, ln = qq & 63, hh = ln >> 5, rr = ln & 31;
            const int mtr = slot == 0 ? 0 : (slot == 2 ? 1 : (d ? 0 : 1)), mtc = slot == 0 ? 0 : (slot == 2 ? 1 : (d ? 1 : 0));
            const int c = 32 * mtr + rr, sa = 32 * mtc + 16 * s2 + 4 * hh;
            const f32x4 ta = *(const LAS f32x4*)(TS + d * 4352 + c * 68 + sa), tb = *(const LAS f32x4*)(TS + d * 4352 + c * 68 + sa + 8);
            const f32x4 ba = *(const LAS f32x4*)(SM + d * 64 + sa), bb = *(const LAS f32x4*)(SM + d * 64 + sa + 8);
            if (!dry) *(u32x4*)(rec + d * DSTRIDE + qq * 16) = (u32x4){pk2(ta[0] * ba[0], ta[1] * ba[1]), pk2(ta[2] * ba[2], ta[3] * ba[3]), pk2(tb[0] * bb[0], tb[1] * bb[1]), pk2(tb[2] * bb[2], tb[3] * bb[3])}; }
        if (!dry) for (int idx = F.tid; idx < 2048; idx += NTHR) { const int img = idx >> 10, pn = idx & 1023;
            *(u32x4*)((unsigned char*)(Z + (size_t)(row0 + (pn >> 4)) * 4096 + img * 1024 + h * 128) + (pn & 15) * 16) = *(const LAS u32x4*)((img ? KI : QI) + pn * 16); }
        if (overlap && !dry) {
            asm volatile("s_waitcnt vmcnt(0)" ::: "memory");
            __syncthreads();
            if (F.tid == 0) { __builtin_amdgcn_fence(__ATOMIC_RELEASE, "agent"); asm volatile("s_waitcnt vmcnt(0)" ::: "memory");
                __hip_atomic_store(flags + bh * 132 + n, 1u, __ATOMIC_RELAXED, __HIP_MEMORY_SCOPE_AGENT); }
        }
        __syncthreads();
    }
}

#define PACK8(x, b) __builtin_bit_cast(bf16x8, (u32x4){pk2((x)[(b)], (x)[(b) + 1]), pk2((x)[(b) + 2], (x)[(b) + 3]), pk2((x)[(b) + 4], (x)[(b) + 5]), pk2((x)[(b) + 6], (x)[(b) + 7])})
#define MFMA32(a, b, c) __builtin_amdgcn_mfma_f32_32x32x16_bf16((a), (b), (c), 0, 0, 0)
typedef short v4i16_t __attribute__((ext_vector_type(4)));
__device__ __forceinline__ void step_convert_rest() {
    const Frame F = make_frame();
    if (F.bid >= 32 && F.G > 32)
        convert_weights(F.ws, 0xffffu & ~((1u << 0) | (1u << 4) | (1u << 8) | (1u << 10)), (F.bid - 32) * NWAVES + F.wave, (F.G - 32) * NWAVES, (F.bid - 32) * NTHR + F.tid, (F.G - 32) * NTHR, F.lds, F.wave, F.lane);
}
__device__ __forceinline__ void step_gdn_scan2(const unsigned* flags, int mode = 0) {
    const Frame F = make_frame();
    constexpr int BUF = 61952, B_K = 0, B_Q = 16384, B_V = 32768, B_PD = 49152;
    const bf16* Z = (const bf16*)(F.ws + WS_Z); const unsigned char* PD = F.ws + WS_PD;
    const int r = F.lane & 31, hi = F.lane >> 5;
    for (int it = F.bid; it < 32; it += F.G) {
        const int b = it >> 4, h = (it >> 1) & 7, dir = it & 1;
        const unsigned char* pdb = PD + (size_t)(((dir * 2 + b) * 8 + h) * 132) * PD_BYTES;
#define CHUNK_OF(sp) (dir ? ((sp) < 4 ? 3 - (sp) : 135 - (sp)) : (sp))
#define ROW0_OF(n) ((n) < 4 ? ML + b * CT + 64 * (n) : b * T + 64 * ((n) - 4))
        if (F.wave >= 4) {
            const int lt = F.tid - 256;
            u32x4 rg[16];
#define LOAD_CHUNK(sp) do { const int n_ = CHUNK_OF(sp); const int row0_ = ROW0_OF(n_); \
                _Pragma("unroll") for (int i = 0; i < 4; ++i) { const int pn = lt + 256 * i; const unsigned char* src = (const unsigned char*)(Z + (size_t)(row0_ + (pn >> 4)) * 4096 + h * 128) + (pn & 15) * 16; \
                    rg[i] = *(const u32x4*)(src + 2048); rg[4 + i] = *(const u32x4*)src; rg[8 + i] = *(const u32x4*)(src + 4096); \
                    rg[12 + i] = pn < 800 ? *(const u32x4*)(pdb + (size_t)n_ * PD_BYTES + pn * 16) : (u32x4){0u, 0u, 0u, 0u}; } } while (0)
#define WRITE_CHUNK(bufb) do { LAS unsigned char* base_ = F.lds + (bufb); \
                _Pragma("unroll") for (int i = 0; i < 4; ++i) { const int pn = lt + 256 * i; *(LAS u32x4*)(base_ + B_K + pn * 16) = rg[i]; *(LAS u32x4*)(base_ + B_Q + pn * 16) = rg[4 + i]; \
                    *(LAS u32x4*)(base_ + B_V + pn * 16) = rg[8 + i]; if (pn < 800) *(LAS u32x4*)(base_ + B_PD + pn * 16) = rg[12 + i]; } } while (0)
#define WAIT_CHUNK(sp) do { if (flags && F.wave == 4) { const unsigned* f_ = flags + (b * 8 + h) * 132 + CHUNK_OF(sp); unsigned spins_ = 0; \
                    while (__hip_atomic_load(f_, __ATOMIC_RELAXED, __HIP_MEMORY_SCOPE_AGENT) == 0u) { __builtin_amdgcn_s_sleep(2); if (++spins_ > (1u << 24)) break; } \
                    __builtin_amdgcn_fence(__ATOMIC_ACQUIRE, "agent"); asm volatile("s_waitcnt vmcnt(0)" ::: "memory"); } } while (0)
            WAIT_CHUNK(0); WAIT_CHUNK(1);
            __syncthreads();
            LOAD_CHUNK(0); WRITE_CHUNK(0); WAIT_CHUNK(2); LOAD_CHUNK(1);
            __syncthreads();
            for (int sp = 0; sp < 132; ++sp) {
                if (sp + 1 < 132) WRITE_CHUNK(((sp + 1) & 1) * BUF);
                if (sp + 3 < 132) WAIT_CHUNK(sp + 3);
                if (sp + 2 < 132) LOAD_CHUNK(sp + 2);
                __syncthreads();
            }
#undef WAIT_CHUNK
#undef LOAD_CHUNK
#undef WRITE_CHUNK
        } else {
            const int w = F.wave;
            f32x16 S[4];
#pragma unroll
            for (int kt = 0; kt < 4; ++kt)
#pragma unroll
                for (int i = 0; i < 16; ++i) S[kt][i] = 0.f;
            const int x = (r >> 2) & 3; const int rowb = 2048 * (r >> 3) + 64 * (r & 7);
            int oa[2], ob[2];
#pragma unroll
            for (int s2 = 0; s2 < 2; ++s2) { oa[s2] = rowb + 16 * ((2 * s2) ^ x) + 8 * hi; ob[s2] = rowb + 16 * ((2 * s2 + 1) ^ x) + 8 * hi; }
            const int blk = (F.lane >> 4) & 1, q = (F.lane & 15) >> 2, p = F.lane & 3, cb = 2 * blk + (p >> 1);
            int trb[2];
#pragma unroll
            for (int t = 0; t < 2; ++t) trb[t] = 64 * (4 * hi + q) + 8 * (p & 1) + 16 * (cb ^ ((2 * t + hi) & 3)) + 2048 * t;
            const int vb = 4 * hi * 256 + (32 * w + r) * 2;
            __syncthreads();
            __syncthreads();
            for (int sp = 0; sp < 132; ++sp) {
                const int n = CHUNK_OF(sp); const int row0 = ROW0_OF(n);
                LAS unsigned char* B = F.lds + (sp & 1) * BUF;
                LAS unsigned char* KI = B + B_K; LAS unsigned char* QI = B + B_Q; LAS unsigned char* VI = B + B_V; LAS unsigned char* PR = B + B_PD;
                bf16x8 Sb[4][2];
#pragma unroll
                for (int kt = 0; kt < 4; ++kt) { Sb[kt][0] = PACK8(S[kt], 0); Sb[kt][1] = PACK8(S[kt], 8); }
                f32x16 KS[2];
#pragma unroll
                for (int i = 0; i < 16; ++i) { KS[0][i] = 0.f; KS[1][i] = 0.f; }
#pragma unroll
                for (int kt = 0; kt < 4; ++kt) {
#pragma unroll
                    for (int s2 = 0; s2 < 2; ++s2)
#pragma unroll
                        for (int mt = 0; mt < 2; ++mt) {
                            const s16x4 k0 = *(const LAS s16x4*)(KI + 8192 * mt + 512 * kt + oa[s2]), k1 = *(const LAS s16x4*)(KI + 8192 * mt + 512 * kt + ob[s2]);
                            KS[mt] = MFMA32(((bf16x8){k0[0], k0[1], k0[2], k0[3], k1[0], k1[1], k1[2], k1[3]}), Sb[kt][s2], KS[mt]); }
                    asm volatile("" ::: "memory");
                }
                bf16x8 Rb[2][2];
#pragma unroll
                for (int mt = 0; mt < 2; ++mt) { f32x16 R;
#pragma unroll
                    for (int g = 0; g < 4; ++g) { const f32x4 e4 = *(const LAS f32x4*)(PR + PD_EG + 4 * (32 * mt + 8 * g + 4 * hi));
#pragma unroll
                        for (int i = 0; i < 4; ++i) { const float v = bf2f(*(const LAS bf16*)(VI + vb + (32 * mt + 8 * g + i) * 256)); R[4 * g + i] = v - e4[i] * KS[mt][4 * g + i]; } }
                    Rb[mt][0] = PACK8(R, 0); Rb[mt][1] = PACK8(R, 8); }
                f32x16 vn[2], o[2];
#pragma unroll
                for (int i = 0; i < 16; ++i) { vn[0][i] = 0.f; vn[1][i] = 0.f; }
#define TFR(base, slot, s2) (*(const LAS bf16x8*)(PR + (base) + (slot) * 2048 + (s2) * 1024 + F.lane * 16))
                vn[0] = MFMA32(TFR(0, 0, 0), Rb[0][0], vn[0]); vn[0] = MFMA32(TFR(0, 0, 1), Rb[0][1], vn[0]);
                vn[1] = MFMA32(TFR(0, 2, 0), Rb[1][0], vn[1]); vn[1] = MFMA32(TFR(0, 2, 1), Rb[1][1], vn[1]);
                if (dir) { vn[0] = MFMA32(TFR(0, 1, 0), Rb[1][0], vn[0]); vn[0] = MFMA32(TFR(0, 1, 1), Rb[1][1], vn[0]); }
                else     { vn[1] = MFMA32(TFR(0, 1, 0), Rb[0][0], vn[1]); vn[1] = MFMA32(TFR(0, 1, 1), Rb[0][1], vn[1]); }
                asm volatile("" ::: "memory");
                f32x16 QS[2];
#pragma unroll
                for (int i = 0; i < 16; ++i) { QS[0][i] = 0.f; QS[1][i] = 0.f; }
                if (!(mode & 2))
#pragma unroll
                for (int kt = 0; kt < 4; ++kt) {
#pragma unroll
                    for (int s2 = 0; s2 < 2; ++s2)
#pragma unroll
                        for (int mt = 0; mt < 2; ++mt) {
                            const s16x4 q0 = *(const LAS s16x4*)(QI + 8192 * mt + 512 * kt + oa[s2]), q1 = *(const LAS s16x4*)(QI + 8192 * mt + 512 * kt + ob[s2]);
                            QS[mt] = MFMA32(((bf16x8){q0[0], q0[1], q0[2], q0[3], q1[0], q1[1], q1[2], q1[3]}), Sb[kt][s2], QS[mt]); }
                    asm volatile("" ::: "memory");
                }
                bf16x8 Vb[2][2], Wb[2][2];
#pragma unroll
                for (int mt = 0; mt < 2; ++mt) { f32x16 W;
#pragma unroll
                    for (int g = 0; g < 4; ++g) { const f32x4 e4 = *(const LAS f32x4*)(PR + PD_EG + 4 * (32 * mt + 8 * g + 4 * hi)), w4 = *(const LAS f32x4*)(PR + PD_EW + 4 * (32 * mt + 8 * g + 4 * hi));
#pragma unroll
                        for (int i = 0; i < 4; ++i) { o[mt][4 * g + i] = e4[i] * QS[mt][4 * g + i]; W[4 * g + i] = w4[i] * vn[mt][4 * g + i]; } }
                    Vb[mt][0] = PACK8(vn[mt], 0); Vb[mt][1] = PACK8(vn[mt], 8); Wb[mt][0] = PACK8(W, 0); Wb[mt][1] = PACK8(W, 8); }
                if (!(mode & 2)) {
                o[0] = MFMA32(TFR(PD_ATT, 0, 0), Vb[0][0], o[0]); o[0] = MFMA32(TFR(PD_ATT, 0, 1), Vb[0][1], o[0]);
                o[1] = MFMA32(TFR(PD_ATT, 2, 0), Vb[1][0], o[1]); o[1] = MFMA32(TFR(PD_ATT, 2, 1), Vb[1][1], o[1]);
                if (dir) { o[0] = MFMA32(TFR(PD_ATT, 1, 0), Vb[1][0], o[0]); o[0] = MFMA32(TFR(PD_ATT, 1, 1), Vb[1][1], o[0]); }
                else     { o[1] = MFMA32(TFR(PD_ATT, 1, 0), Vb[0][0], o[1]); o[1] = MFMA32(TFR(PD_ATT, 1, 1), Vb[0][1], o[1]); }
                }
#undef TFR
                asm volatile("" ::: "memory");
                const float cd = *(const LAS float*)(PR + PD_EG + 4 * (dir ? 0 : 63));
#pragma unroll
                for (int kt = 0; kt < 4; ++kt)
#pragma unroll
                    for (int i = 0; i < 16; ++i) S[kt][i] *= cd;
#pragma unroll
                for (int mt = 0; mt < 2; ++mt)
#pragma unroll
                    for (int s2 = 0; s2 < 2; ++s2) {
#pragma unroll
                        for (int kt = 0; kt < 4; ++kt) {
                            const s16x4 a0 = __builtin_bit_cast(s16x4, __builtin_amdgcn_ds_read_tr16_b64_v4i16((LAS v4i16_t*)(KI + 8192 * mt + 4096 * s2 + 512 * kt + trb[0])));
                            const s16x4 a1 = __builtin_bit_cast(s16x4, __builtin_amdgcn_ds_read_tr16_b64_v4i16((LAS v4i16_t*)(KI + 8192 * mt + 4096 * s2 + 512 * kt + trb[1])));
                            S[kt] = MFMA32(((bf16x8){a0[0], a0[1], a0[2], a0[3], a1[0], a1[1], a1[2], a1[3]}), Wb[mt][s2], S[kt]); }
                        asm volatile("" ::: "memory");
                    }
                if (!(mode & 1)) { bf16* ob_ = n < 4 ? (bf16*)(F.ws + WS_OFC) + ((size_t)dir * MC + (row0 - ML)) * D : (bf16*)F.out + ((size_t)dir * ML + row0) * D;
                    bf16* oc = ob_ + h * 128 + 32 * w + r;
#pragma unroll
                    for (int mt = 0; mt < 2; ++mt)
#pragma unroll
                        for (int i = 0; i < 16; ++i) oc[(size_t)(32 * mt + crow(i, hi)) * D] = (bf16)(pk2(o[mt][i], 0.f) & 0xffffu); }
                __syncthreads();
            }
        }
#undef CHUNK_OF
#undef ROW0_OF
    }
}
__device__ __forceinline__ void step_gdn_norm2(int j) {
    const Frame F = make_frame();
    const int gw = F.bid * NWAVES + F.wave, NGW = F.G * NWAVES;
    const bf16* Z = (const bf16*)(F.ws + WS_Z); bf16* Y = (bf16*)(F.ws + WS_Y); const float* ng = INP(I_GNG) + j * 128;
    for (int row = gw; row < M; row += NGW) {
        const bf16* of = row < ML ? (const bf16*)F.out + (size_t)row * D : (const bf16*)(F.ws + WS_OFC) + (size_t)(row - ML) * D;
        const bf16* ob = row < ML ? of + (size_t)ML * D : of + (size_t)MC * D;
        const u32x4* f4 = (const u32x4*)(of + 16 * F.lane); const u32x4* b4 = (const u32x4*)(ob + 16 * F.lane);
        float v[16]; float ss = 0.f;
#pragma unroll
        for (int q = 0; q < 2; ++q) { const u32x4 a = f4[q], bq = b4[q];
#pragma unroll
            for (int i = 0; i < 4; ++i) { const float x0 = bf2f(a[i] & 0xffffu) + bf2f(bq[i] & 0xffffu), x1 = bf2f(a[i] >> 16) + bf2f(bq[i] >> 16); v[8 * q + 2 * i] = x0; v[8 * q + 2 * i + 1] = x1; ss += x0 * x0 + x1 * x1; } }
        ss += __shfl_xor(ss, 1); ss += __shfl_xor(ss, 2); ss += __shfl_xor(ss, 4);
        const float rstd = 1.0f / sqrtf(ss * (1.f / 128.f) + EPS);
        const u32x4* g4 = (const u32x4*)(Z + (size_t)row * 4096 + 3072 + 16 * F.lane);
        const int e0 = (16 * F.lane) & 127;
        u32x4 o[2];
#pragma unroll
        for (int q = 0; q < 2; ++q) { const u32x4 gz = g4[q]; unsigned wv[4];
#pragma unroll
            for (int i = 0; i < 4; ++i) { const unsigned gg = gz[i]; const float g0 = bf2f(gg & 0xffffu), g1 = bf2f(gg >> 16); const int e = e0 + 8 * q + 2 * i;
                wv[i] = pk2(v[8 * q + 2 * i] * rstd * ng[e] * silu_f(g0), v[8 * q + 2 * i + 1] * rstd * ng[e + 1] * silu_f(g1)); }
            o[q] = (u32x4){wv[0], wv[1], wv[2], wv[3]}; }
        u32x4* dst = (u32x4*)(Y + (size_t)row * D + 16 * F.lane); dst[0] = o[0]; dst[1] = o[1];
    }
}

__device__ __forceinline__ void step_rope2() {
    const Frame F = make_frame();
    const int gw = F.bid * NWAVES + F.wave, NGW = F.G * NWAVES;
    bf16* Z = (bf16*)(F.ws + WS_Z); const f32x4* R = (const f32x4*)(F.ws + WS_ROPE);
    for (int row = gw; row < M; row += NGW) {
        u32x4* p = (u32x4*)(Z + (size_t)row * 3072 + 32 * F.lane);
        u32x4 v[4];
#pragma unroll
        for (int q = 0; q < 4; ++q) v[q] = p[q];
        const bool lat = row < ML; const float sc = F.lane < 32 ? QSCALE : 1.0f;
        const f32x4* tab = R + ((size_t)(row & (T - 1)) * 32 + 16 * (F.lane & 1)) / 2;
#pragma unroll
        for (int q = 0; q < 4; ++q) {
#pragma unroll
            for (int i = 0; i < 4; i += 2) {
                f32x4 cs = (f32x4){1.f, 0.f, 1.f, 0.f}; if (lat) cs = tab[(4 * q + i) / 2];
                { const unsigned w = v[q][i]; const float x0 = bf2f(w & 0xffffu), x1 = bf2f(w >> 16); v[q][i] = pk2((x0 * cs.x - x1 * cs.y) * sc, (x0 * cs.y + x1 * cs.x) * sc); }
                { const unsigned w = v[q][i + 1]; const float x0 = bf2f(w & 0xffffu), x1 = bf2f(w >> 16); v[q][i + 1] = pk2((x0 * cs.z - x1 * cs.w) * sc, (x0 * cs.w + x1 * cs.z) * sc); }
            }
        }
#pragma unroll
        for (int q = 0; q < 4; ++q) p[q] = v[q];
    }
}
#define ATT_THR 4.0f
__device__ __forceinline__ void att_softmax(f32x16& p0, f32x16& p1, float& m_reg, float& l, float& alpha, bf16x8 (&pf)[2][2]) {
    float mx = fmaxf(p0[0], p1[0]);
#pragma unroll
    for (int q = 1; q < 16; ++q) mx = fmaxf(mx, fmaxf(p0[q], p1[q]));
    mx = fmaxf(mx, __shfl_xor(mx, 32));
    const float mn = (mx - m_reg > ATT_THR) ? mx : m_reg; alpha = __builtin_amdgcn_exp2f(m_reg - mn); m_reg = mn;
    float ps = 0.f;
#pragma unroll
    for (int q = 0; q < 16; ++q) { p0[q] = __builtin_amdgcn_exp2f(p0[q] - m_reg); p1[q] = __builtin_amdgcn_exp2f(p1[q] - m_reg); ps += p0[q] + p1[q]; }
    l = l * alpha + ps;
    pf[0][0] = PACK8(p0, 0); pf[0][1] = PACK8(p0, 8); pf[1][0] = PACK8(p1, 0); pf[1][1] = PACK8(p1, 8);
}
__device__ __forceinline__ void step_attn2() {
    const Frame F = make_frame();
    const bf16* Z = (const bf16*)(F.ws + WS_Z); bf16* Y = (bf16*)(F.ws + WS_Y);
    LAS float* EX = (LAS float*)F.lds;
    constexpr int KB0 = 0, VB0 = 65536;
    const int r = F.lane & 31, hi = F.lane >> 5, qs = F.wave & 3, m = F.wave >> 2;
    float lmb;
    { const float* lam = INP(I_DLAM); const float t1 = lam[F.lane] * lam[64 + F.lane], t2 = lam[128 + F.lane] * lam[192 + F.lane]; lmb = expf(wave_sum(t1)) - expf(wave_sum(t2)) + LAMBDA_INIT; }
    const float* ng = INP(I_DNG);
    const int kro = 2048 * (r >> 3) + 64 * (r & 7); const int xk = (r >> 2) & 3;
    int koff[2];
#pragma unroll
    for (int d0 = 0; d0 < 2; ++d0) koff[d0] = kro + 1024 * m + 16 * (((2 * d0 + hi) & 3) ^ xk);
    const int blk = (F.lane >> 4) & 1, q4 = (F.lane & 15) >> 2, p4 = F.lane & 3, cb = 2 * blk + (p4 >> 1);
    int trb[2];
#pragma unroll
    for (int t = 0; t < 2; ++t) trb[t] = 64 * (4 * hi + q4) + 8 * (p4 & 1) + 16 * (cb ^ ((2 * t + hi) & 3)) + 2048 * t;
    const int drow = 8 * F.wave + ((F.lane & 31) >> 2);
    const unsigned goff = (unsigned)(drow * 6144 + 16 * (4 * (F.lane >> 5) + ((F.lane & 3) ^ ((drow >> 2) & 3))));
    const unsigned ldsw = (unsigned)F.wave * 2048u;
    const int xcd = F.bid & 7, cux = F.bid >> 3;
    for (int ui = 0; ui < 5; ++ui) {
        int b, h, qrow0, nt;
        if (F.G == 256) {
            h = xcd;
            if (ui < 4) { b = ui >> 1; qrow0 = b * T + (cux + 32 * (ui & 1)) * 128; nt = NKV / 64; }
            else { if (cux >= 4) break; b = cux >> 1; qrow0 = ML + b * CT + (cux & 1) * 128; nt = CT / 64; }
        } else {
            const int u = F.bid + ui * F.G; if (u >= 1056) break;
            if (u < 1024) { b = u >> 9; h = (u >> 6) & 7; qrow0 = b * T + (u & 63) * 128; nt = NKV / 64; }
            else { const int v = u - 1024; b = v >> 4; h = (v >> 1) & 7; qrow0 = ML + b * CT + (v & 1) * 128; nt = CT / 64; }
        }
        const int row0 = qrow0 + 32 * qs;
        bf16x8 qf[4];
#pragma unroll
        for (int d0 = 0; d0 < 4; ++d0) qf[d0] = *(const bf16x8*)(Z + (size_t)(row0 + r) * 3072 + h * 128 + m * 64 + d0 * 16 + hi * 8);
        asm volatile("" : "+v"(qf[0]), "+v"(qf[1]), "+v"(qf[2]), "+v"(qf[3]));
        asm volatile("s_waitcnt vmcnt(0)" ::: "memory");
        const char* kgb = (const char*)(Z + 1024 + h * 128); const char* vgb = (const char*)(Z + 2048 + h * 128);
#define KVROW(t) ((t) < CT / 64 ? ML + b * CT + 64 * (t) : b * T + 64 * (t) - CT)
#define DMAK(t) do { const int t_ = (t) < nt ? (t) : nt - 1; const char* g_ = kgb + (size_t)KVROW(t_) * 6144 + goff; LAS unsigned char* d_ = F.lds + KB0 + ((t) & 3) * 16384 + ldsw; \
            __builtin_amdgcn_global_load_lds((const unsigned*)g_, (LAS unsigned*)d_, 16, 0, 0); __builtin_amdgcn_global_load_lds((const unsigned*)(g_ + 128), (LAS unsigned*)(d_ + 1024), 16, 0, 0); } while (0)
#define DMAV(t) do { const int t_ = (t) < nt ? (t) : nt - 1; const char* g_ = vgb + (size_t)KVROW(t_) * 6144 + goff; LAS unsigned char* d_ = F.lds + VB0 + ((t) & 3) * 16384 + ldsw; \
            __builtin_amdgcn_global_load_lds((const unsigned*)g_, (LAS unsigned*)d_, 16, 0, 0); __builtin_amdgcn_global_load_lds((const unsigned*)(g_ + 128), (LAS unsigned*)(d_ + 1024), 16, 0, 0); } while (0)
#define WAIT_BAR(N) do { asm volatile("s_waitcnt vmcnt(" #N ") lgkmcnt(0)" ::: "memory"); __builtin_amdgcn_s_barrier(); asm volatile("" ::: "memory"); } while (0)
#define QKT(P0, P1, t) do { LAS unsigned char* KI_ = F.lds + KB0 + ((t) & 3) * 16384; \
            _Pragma("unroll") for (int q_ = 0; q_ < 16; ++q_) { P0[q_] = 0.f; P1[q_] = 0.f; } \
            _Pragma("unroll") for (int d0 = 0; d0 < 4; ++d0) { const bf16x8 k0_ = *(const LAS bf16x8*)(KI_ + 512 * (d0 >> 1) + koff[d0 & 1]), k1_ = *(const LAS bf16x8*)(KI_ + 8192 + 512 * (d0 >> 1) + koff[d0 & 1]); \
                P0 = MFMA32(k0_, qf[d0], P0); P1 = MFMA32(k1_, qf[d0], P1); if (d0 & 1) asm volatile("" ::: "memory"); } } while (0)
#define PV1(t, PF, i) do { LAS unsigned char* VI_ = F.lds + VB0 + ((t) & 3) * 16384; \
            _Pragma("unroll") for (int kh = 0; kh < 2; ++kh) _Pragma("unroll") for (int s2 = 0; s2 < 2; ++s2) { \
                const s16x4 a0_ = __builtin_bit_cast(s16x4, __builtin_amdgcn_ds_read_tr16_b64_v4i16((LAS v4i16_t*)(VI_ + 8192 * kh + 4096 * s2 + 512 * (i) + trb[0]))); \
                const s16x4 a1_ = __builtin_bit_cast(s16x4, __builtin_amdgcn_ds_read_tr16_b64_v4i16((LAS v4i16_t*)(VI_ + 8192 * kh + 4096 * s2 + 512 * (i) + trb[1]))); \
                o[i] = MFMA32(((bf16x8){a0_[0], a0_[1], a0_[2], a0_[3], a1_[0], a1_[1], a1_[2], a1_[3]}), PF[kh][s2], o[i]); if (s2 == 1) asm volatile("" ::: "memory"); } } while (0)
#define PVT(t, PF) do { PV1(t, PF, 0); PV1(t, PF, 1); PV1(t, PF, 2); PV1(t, PF, 3); } while (0)
#define SM_MAX() do { float mx_ = fmaxf(c0[0], c1[0]); _Pragma("unroll") for (int q_ = 1; q_ < 16; ++q_) mx_ = fmaxf(mx_, fmaxf(c0[q_], c1[q_])); \
            mx_ = fmaxf(mx_, __shfl_xor(mx_, 32)); const float mn_ = (mx_ - mref > ATT_THR) ? mx_ : mref; al = __builtin_amdgcn_exp2f(mref - mn_); mref = mn_; ps = 0.f; } while (0)
#define SM_EXP(C, B, DST) do { _Pragma("unroll") for (int q_ = 0; q_ < 8; ++q_) { C[(B) + q_] = __builtin_amdgcn_exp2f(C[(B) + q_] - mref); ps += C[(B) + q_]; } DST = PACK8(C, B); } while (0)
#define RESC(al) do { if (__any((al) < 1.f)) { _Pragma("unroll") for (int i = 0; i < 4; ++i) _Pragma("unroll") for (int q_ = 0; q_ < 16; ++q_) o[i][q_] *= (al); } } while (0)
#define SBAR() __builtin_amdgcn_sched_barrier(0)
#define ATT_STEP(j, PFC, PFP) do { \
            WAIT_BAR(8); DMAK((j) + 3); DMAV((j) + 2); \
            SBAR(); QKT(c0, c1, j); SBAR(); \
            PV1((j) - 1, PFP, 0); SM_MAX(); SBAR(); \
            PV1((j) - 1, PFP, 1); SM_EXP(c0, 0, PFC[0][0]); SM_EXP(c0, 8, PFC[0][1]); SBAR(); \
            PV1((j) - 1, PFP, 2); SM_EXP(c1, 0, PFC[1][0]); SBAR(); \
            PV1((j) - 1, PFP, 3); SM_EXP(c1, 8, PFC[1][1]); l = l * al + ps; SBAR(); \
            RESC(al); } while (0)
        f32x16 o[4];
#pragma unroll
        for (int i = 0; i < 4; ++i)
#pragma unroll
            for (int q = 0; q < 16; ++q) o[i][q] = 0.f;
        float mref = -1e30f, l = 0.f, al = 1.f, ps = 0.f;
        f32x16 c0, c1; bf16x8 pfA[2][2], pfB[2][2];
        DMAK(0); DMAV(0); DMAK(1); DMAV(1); DMAK(2);
        WAIT_BAR(6); DMAK(3); DMAV(2);
        QKT(c0, c1, 0); SM_MAX(); SM_EXP(c0, 0, pfA[0][0]); SM_EXP(c0, 8, pfA[0][1]); SM_EXP(c1, 0, pfA[1][0]); SM_EXP(c1, 8, pfA[1][1]); l = l * al + ps;
        for (int j = 1; j + 1 < nt; j += 2) {
            ATT_STEP(j, pfB, pfA);
            ATT_STEP(j + 1, pfA, pfB);
        }
        ATT_STEP(nt - 1, pfB, pfA);
        WAIT_BAR(0);
        PVT(nt - 1, pfB);
        WAIT_BAR(0);
#undef DMAK
#undef DMAV
#undef WAIT_BAR
#undef QKT
#undef PVT
#undef PV1
#undef SM_MAX
#undef SM_EXP
#undef RESC
#undef SBAR
#undef ATT_STEP
#undef KVROW
        l += __shfl_xor(l, 32);
        const float f = (m == 1 ? lmb : 1.0f) / l;
        LAS float* ex = EX + (size_t)m * 128 * 129 + (qs * 32 + r) * 129;
#pragma unroll
        for (int i = 0; i < 4; ++i)
#pragma unroll
            for (int q = 0; q < 16; ++q) ex[32 * i + crow(q, hi)] = o[i][q] * f;
        __syncthreads();
#pragma unroll 1
        for (int rr = 0; rr < 16; ++rr) { const int row = 16 * F.wave + rr;
            const float a0 = EX[row * 129 + F.lane] - EX[128 * 129 + row * 129 + F.lane], a1 = EX[row * 129 + 64 + F.lane] - EX[128 * 129 + row * 129 + 64 + F.lane];
            const float rstd = (1.0f - LAMBDA_INIT) / sqrtf(wave_sum(a0 * a0 + a1 * a1) * (1.f / 128.f) + EPS);
            bf16* yr = Y + (size_t)(qrow0 + row) * D + h * 128;
            yr[F.lane] = (bf16)(pk2(a0 * rstd * ng[F.lane], 0.f) & 0xffffu); yr[64 + F.lane] = (bf16)(pk2(a1 * rstd * ng[64 + F.lane], 0.f) & 0xffffu); }
        __syncthreads();
    }
}

#define XB_TMO      128
#define XB_XCNT(j)  (256  + 64 * (j))
#define XB_XSUB(j)  (1280 + 64 * (j))
#define XB_XGEN(j)  (2304 + 64 * (j))
#define XB_TOP      3328
#define XB_TOPGEN   3392
#define XCD_BAR_WORDS 3456
#define XB_SPIN_CAP (1u << 18)

__device__ __forceinline__ unsigned xb_ld(unsigned* p)              { return __hip_atomic_load(p, __ATOMIC_RELAXED, __HIP_MEMORY_SCOPE_AGENT); }
__device__ __forceinline__ unsigned xb_add(unsigned* p, unsigned v) { return __hip_atomic_fetch_add(p, v, __ATOMIC_RELAXED, __HIP_MEMORY_SCOPE_AGENT); }
__device__ __forceinline__ unsigned xb_xcc_id() { return (unsigned)__builtin_amdgcn_s_getreg((3 << 11) | 20) & 0xFu; }
#define XB_SPIN(cond, bar) do { unsigned _sp = 0; while (cond) { __builtin_amdgcn_s_sleep(1); \
    if ((++_sp & 255u) == 0u) { if (xb_ld(&(bar)[XB_TMO])) break; if (_sp > XB_SPIN_CAP) { atomicAdd(&(bar)[XB_TMO], 1u); break; } } } } while (0)

struct XcdBarrier {
    unsigned* bar; unsigned x;
    volatile LAS unsigned* st;
};

__device__ __forceinline__ XcdBarrier xcd_barrier_post(unsigned* bar, volatile LAS unsigned* st) {
    XcdBarrier b; b.bar = bar; b.x = xb_xcc_id(); b.st = st;
    if (threadIdx.x == 0) (void)xb_add(&bar[XB_XCNT(b.x)], 1u);
    return b;
}
__device__ __forceinline__ void xcd_barrier_complete(unsigned* bar, unsigned x, unsigned& nloc, unsigned& nx) {
    const unsigned G = gridDim.x * gridDim.y * gridDim.z;
    unsigned sum, cnt, mine, sp = 0u;
    for (;;) {
        sum = 0u; cnt = 0u; mine = 0u;
#pragma unroll
        for (unsigned j = 0; j < 16; ++j) { const unsigned c = xb_ld(&bar[XB_XCNT(j)]); sum += c; cnt += (c > 0u) ? 1u : 0u; mine = (j == x) ? c : mine; }
        if (sum == G) break;
        __builtin_amdgcn_s_sleep(1);
        if ((++sp & 255u) == 0u) { if (xb_ld(&bar[XB_TMO])) break; if (sp > XB_SPIN_CAP) { atomicAdd(&bar[XB_TMO], 1u); break; } }
    }
    nloc = mine > 0u ? mine : 1u; nx = cnt > 0u ? cnt : 1u;
}

__device__ __forceinline__ void xcd_barrier(const XcdBarrier& b) {
    asm volatile("s_waitcnt vmcnt(0)" ::: "memory");
    __syncthreads();
    if (threadIdx.x == 0) {
        unsigned* bar = b.bar;
        __builtin_amdgcn_s_waitcnt(0);
        unsigned nloc = b.st[0], nx = b.st[1];
        if (nloc == 0u) { xcd_barrier_complete(bar, b.x, nloc, nx); b.st[0] = nloc; b.st[1] = nx; }
        const unsigned old = xb_add(&bar[XB_XSUB(b.x)], 1u);
        const unsigned gen = old / nloc;
        if (old + 1u == (gen + 1u) * nloc) {
            __builtin_amdgcn_fence(__ATOMIC_RELEASE, "agent");
            asm volatile("s_waitcnt vmcnt(0)" ::: "memory");
            const unsigned og = xb_add(&bar[XB_TOP], 1u);
            const unsigned tg = og / nx;
            if (og + 1u == (tg + 1u) * nx) xb_add(&bar[XB_TOPGEN], 1u);
            else XB_SPIN(xb_ld(&bar[XB_TOPGEN]) == tg, bar);
            __builtin_amdgcn_fence(__ATOMIC_ACQUIRE, "agent");
            xb_add(&bar[XB_XGEN(b.x)], 1u);
            asm volatile("s_waitcnt vmcnt(0)" ::: "memory");
        } else {
            XB_SPIN(xb_ld(&bar[XB_XGEN(b.x)]) == gen, bar);
            __builtin_amdgcn_fence(__ATOMIC_ACQUIRE, "agent");
            asm volatile("s_waitcnt vmcnt(0)" ::: "memory");
        }
    }
    __syncthreads();
}

#ifndef MK_SINGLE
#define MK_SINGLE 1
#endif
constexpr int NSTEPS = 1 + 9 + 7 + 8 + 9 + 1;
struct SEpiStore { bf16* O; int ldc; int act; bf16* halo;
    __device__ __forceinline__ void operator()(const float (&v8)[8], int m, int n0, int hi, int half) const {
#pragma unroll
        for (int g = 0; g < 2; ++g) { float v[4];
#pragma unroll
            for (int i = 0; i < 4; ++i) { v[i] = v8[4 * g + i]; if (act) { const float t = fmaxf(v[i], 0.f); v[i] = t * t; } }
            const u32x2 w = (u32x2){pk2(v[0], v[1]), pk2(v[2], v[3])}; const int n = n0 + 8 * (2 * half + g) + 4 * hi;
            *(u32x2*)(O + (size_t)m * ldc + n) = w;
            if (halo && n < 3072 && (((m & 63) == 0) || ((m & 63) == 63))) *(u32x2*)(halo + ((size_t)(m >> 6) * 2 + ((m & 63) ? 1 : 0)) * 3072 + n) = w; } } };
struct SEpiResid { float* X; const float* gate;
    __device__ __forceinline__ void operator()(const float (&v8)[8], int m, int n0, int hi, int half) const {
#pragma unroll
        for (int g = 0; g < 2; ++g) { const int n = n0 + 8 * (2 * half + g) + 4 * hi; float* p = X + (size_t)m * D + n; const f32x4 gv = *(const f32x4*)(gate + n);
            *(f32x4*)p = *(const f32x4*)p + gv * (f32x4){v8[4 * g], v8[4 * g + 1], v8[4 * g + 2], v8[4 * g + 3]}; } } };
struct SEpiAB { float* AB;
    __device__ __forceinline__ void operator()(const float (&v8)[8], int m, int n0, int hi, int half) const {
        if (n0 == 0) {
#pragma unroll
            for (int g = 0; g < 2; ++g) *(f32x4*)(AB + (size_t)m * 32 + 8 * (2 * half + g) + 4 * hi) = (f32x4){v8[4 * g], v8[4 * g + 1], v8[4 * g + 2], v8[4 * g + 3]}; } } };
template <class Epi> __device__ __forceinline__ void small_gemm(const bf16* A, const bf16* Bt, int row_lo, int nrows, int N, int K, const Epi& E) {
    int tid = threadIdx.x; asm volatile("" : "+v"(tid));
    const int lane = tid & 63, wave = __builtin_amdgcn_readfirstlane(tid >> 6), r = lane & 31, hi = lane >> 5;
    int G_ = gridDim.x, B_ = blockIdx.x; asm volatile("" : "+s"(G_), "+s"(B_));
    LAS float* red = (LAS float*)lds_raw;
    const int tn = N / 64, items = (nrows / 64) * tn, kw = K / 8;
    for (int it = B_; it < items; it += G_) {
        const int mi = it / tn, ni = it % tn;
        const bf16* ap = A + (size_t)(row_lo + 64 * mi + r) * K + wave * kw + 8 * hi;
        const bf16* bp = Bt + (size_t)(64 * ni + r) * K + wave * kw + 8 * hi;
        f32x16 acc[2][2];
#pragma unroll
        for (int x = 0; x < 2; ++x)
#pragma unroll
            for (int y = 0; y < 2; ++y)
#pragma unroll
                for (int i = 0; i < 16; ++i) acc[x][y][i] = 0.f;
#pragma unroll 8
        for (int k = 0; k < kw; k += 16) {
            const bf16x8 a0 = *(const bf16x8*)(ap + k), a1 = *(const bf16x8*)(ap + (size_t)32 * K + k), b0 = *(const bf16x8*)(bp + k), b1 = *(const bf16x8*)(bp + (size_t)32 * K + k);
            acc[0][0] = __builtin_amdgcn_mfma_f32_32x32x16_bf16(b0, a0, acc[0][0], 0, 0, 0); acc[0][1] = __builtin_amdgcn_mfma_f32_32x32x16_bf16(b0, a1, acc[0][1], 0, 0, 0);
            acc[1][0] = __builtin_amdgcn_mfma_f32_32x32x16_bf16(b1, a0, acc[1][0], 0, 0, 0); acc[1][1] = __builtin_amdgcn_mfma_f32_32x32x16_bf16(b1, a1, acc[1][1], 0, 0, 0);
        }
#pragma unroll
        for (int x = 0; x < 2; ++x)
#pragma unroll
            for (int y = 0; y < 2; ++y)
#pragma unroll
                for (int i = 0; i < 16; ++i) red[((wave * 4 + x * 2 + y) * 16 + i) * 64 + lane] = acc[x][y][i];
        __syncthreads();
        { const int tile = wave >> 1, half = wave & 1; float v8[8];
#pragma unroll
            for (int i = 0; i < 8; ++i) { float s = 0.f;
#pragma unroll
                for (int w = 0; w < 8; ++w) s += red[((w * 4 + tile) * 16 + 8 * half + i) * 64 + lane];
                v8[i] = s; }
            E(v8, row_lo + 64 * mi + 32 * (tile & 1) + r, 64 * ni + 32 * (tile >> 1), hi, half); }
        __syncthreads();
    }
}
template <int ACT> __device__ __forceinline__ void gemm_store(const bf16* A, const bf16* Bt, bool ctx, int N, int K, bf16* O, int ldc, bf16* halo) {
    { int G_ = gridDim.x, B_ = blockIdx.x; asm volatile("" : "+s"(G_), "+s"(B_));
      pg8::Gemm g{A, Bt, ML, N, K, K, K}; pg8::StaticOrder S; S.init(ML, N, G_, B_);
      pg8::EpiStore<ACT> E{O, ldc, nullptr, -1, halo};
      pg8::gemm_phase<pg8::EpiStore<ACT>, pg8::StaticOrder, true, true>((LAS unsigned char*)lds_raw, g, S, E); }
    if (ctx) { SEpiStore E2{O, ldc, ACT, halo}; small_gemm(A, Bt, ML, MC, N, K, E2); }
}
__device__ __forceinline__ void gemm_resid(const bf16* A, const bf16* Bt, bool ctx, int K, float* X, const float* gate) {
    { int G_ = gridDim.x, B_ = blockIdx.x; asm volatile("" : "+s"(G_), "+s"(B_));
      pg8::Gemm g{A, Bt, ML, D, K, K, K}; pg8::StaticOrder S; S.init(ML, D, G_, B_);
      pg8::EpiResid E{X, D, gate, NADA};
      pg8::gemm_phase<pg8::EpiResid, pg8::StaticOrder, true, true>((LAS unsigned char*)lds_raw, g, S, E); }
    if (ctx) { SEpiResid E2{X, gate + 2 * NADA}; small_gemm(A, Bt, ML, MC, D, K, E2); }
}
__global__ void __launch_bounds__(NTHR, 2) fwd_kernel(Args a) {
    unsigned char* ws = a.ws;
    const int lo = a.step_lo, hi = a.step_hi; const bool coop = a.coop != 0;
    volatile LAS unsigned* bst = (volatile LAS unsigned*)((LAS unsigned char*)lds_raw + LDS_BYTES - 64);
    if (threadIdx.x < 2) bst[threadIdx.x] = 0u;
    __syncthreads();
    XcdBarrier bar; bar.bar = (unsigned*)(ws + WS_CTL) + 4096; bar.x = 0; bar.st = bst;
    if (coop) bar = xcd_barrier_post((unsigned*)(ws + WS_CTL) + 4096, bst);
#ifndef REP_SET
#define REP_SET 0
#endif
#define REP_OF(k) ((REP_SET == 1 && ((k) == 8 || (k) == 15 || (k) == 23 || (k) == 32)) || (REP_SET == 2 && ((k) == 4 || (k) == 28)) || (REP_SET == 3 && ((k) == 2 || (k) == 11 || (k) == 18 || (k) == 26)) || \
    (REP_SET == 4 && ((k) == 1 || (k) == 7 || (k) == 10 || (k) == 14 || (k) == 17 || (k) == 22 || (k) == 25 || (k) == 31)) || (REP_SET == 5 && (k) == 0) || (REP_SET == 6 && (k) == 20) || (REP_SET == 7 && ((k) == 5 || (k) == 29 || (k) == 12 || (k) == 34)))
#define PHASE(k, body) do { if (lo <= (k) && (k) < hi) { __syncthreads(); body; if (REP_OF(k)) { __syncthreads(); body; } if ((k) + 1 < hi && coop) { if ((k) == 0) cg::this_grid().sync(); else xcd_barrier(bar); } } } while (0)
#define WB(off) ((bf16*)(ws + (off)))
#define MODP(layer, which) ((const float*)(ws + WS_MOD) + (size_t)(layer) * 3 * NADA + (which) * D)
#define TAIL(k0, layer, WoutT, Mrows) \
    PHASE((k0), gemm_resid(WB(WS_Y), (WoutT), (Mrows) == M, D, (float*)(ws + WS_X), MODP(layer, 2))); \
    PHASE((k0) + 1, step_norm((layer), 1, (Mrows), false)); \
    PHASE((k0) + 2, gemm_store<1>(WB(WS_H), WB(WS_W1T) + (size_t)(layer) * D * FF, (Mrows) == M, FF, D, WB(WS_Z), FF, nullptr)); \
    PHASE((k0) + 3, gemm_resid(WB(WS_Z), WB(WS_W2T) + (size_t)(layer) * D * FF, (Mrows) == M, FF, (float*)(ws + WS_X), MODP(layer, 5)))
#define LAYER_GDN(k0, layer, jj, Mrows, conv) \
    PHASE((k0), step_norm((layer), 0, M, false)); \
    PHASE((k0) + 1, { gemm_store<0>(WB(WS_H), WB(WS_GINT) + (size_t)(jj) * GDN_NP * D, true, 4096, D, WB(WS_Z), 4096, WB(WS_HALO)); \
        SEpiAB E3{(float*)(ws + WS_AB)}; small_gemm(WB(WS_H), WB(WS_GINT) + (size_t)(jj) * GDN_NP * D + (size_t)4096 * D, 0, M, 64, D, E3); }); \
    if (lo <= (k0) + 2 && (k0) + 2 < hi && !(coop && gridDim.x == 256)) { __syncthreads(); step_gdn_prep(jj, false, nullptr); if ((k0) + 3 < hi && coop) xcd_barrier(bar); } \
    PHASE((k0) + 3, { unsigned* fl_ = (unsigned*)(ws + WS_CTL) + 16384 + (jj) * 4096; \
        if (coop && gridDim.x == 256) { step_gdn_scan2(fl_); step_gdn_prep(jj, true, fl_); } else step_gdn_scan2(nullptr); \
        if (conv) step_convert_rest(); }); \
    PHASE((k0) + 4, step_gdn_norm2(jj)); \
    TAIL((k0) + 5, layer, WB(WS_GOUTT) + (size_t)(jj) * D * D, Mrows)
    PHASE(0, step_prologue());
    LAYER_GDN(1, 0, 0, M, true);
    PHASE(10, step_norm(1, 0, M, false));
    PHASE(11, gemm_store<0>(WB(WS_H), WB(WS_SINT), true, 3 * D, D, WB(WS_Z), 3 * D, nullptr));
    PHASE(12, step_sconv());
    TAIL(13, 1, WB(WS_SOUTT), M);
    PHASE(17, step_norm(2, 0, M, false));
    PHASE(18, gemm_store<0>(WB(WS_H), WB(WS_DINT), true, 3 * D, D, WB(WS_Z), 3 * D, nullptr));
    PHASE(19, step_rope2());
    PHASE(20, step_attn2());
    TAIL(21, 2, WB(WS_DOUTT), M);
    LAYER_GDN(25, 3, 1, ML, false);
    PHASE(34, step_final());
}

extern "C" void kernel_launch(void* const* d_in, const int* in_sizes, int n_in, void* d_out, int out_size, void* d_ws, size_t ws_size, hipStream_t stream) {
    static int grid = 0;
    if (grid == 0) {
        if (n_in != 24 || out_size != ML * D || ws_size < WS_END) { fprintf(stderr, "kernel_launch: unexpected problem (n_in %d, out %d, ws %zu); nothing launched\n", n_in, out_size, ws_size); grid = -1; return; }
        int dev = 0, cus = 0, per_cu = 0;
        if (hipGetDevice(&dev) != hipSuccess || hipDeviceGetAttribute(&cus, hipDeviceAttributeMultiprocessorCount, dev) != hipSuccess) { grid = -1; return; }
        if (hipFuncSetAttribute((const void*)fwd_kernel, hipFuncAttributeMaxDynamicSharedMemorySize, LDS_BYTES) != hipSuccess) { fprintf(stderr, "kernel_launch: hipFuncSetAttribute failed\n"); grid = -1; return; }
        if (hipOccupancyMaxActiveBlocksPerMultiprocessor(&per_cu, (const void*)fwd_kernel, NTHR, LDS_BYTES) != hipSuccess || per_cu < 1) { fprintf(stderr, "kernel_launch: occupancy query says %d blocks per CU\n", per_cu); (void)hipGetLastError(); per_cu = 1; }
        grid = cus;
        fprintf(stderr, "kernel_launch: %d CUs, occupancy %d per CU, grid %d\n", cus, per_cu, grid);
    }
    if (grid < 0) return;
    (void)hipMemsetAsync((char*)d_ws + WS_CTL, 0, CTL_ZERO_BYTES, stream);
    Args a{};
    for (int i = 0; i < 24; ++i) a.in[i] = (const float*)d_in[i];
    a.out = (float*)d_out; a.ws = (unsigned char*)d_ws;
#if MK_SINGLE
    a.step_lo = 0; a.step_hi = NSTEPS; a.coop = 1;
#if REP_SET == 20
    a.pad = 1;
#elif REP_SET == 21
    a.pad = 3;
#elif REP_SET >= 8
    a.pad = REP_SET - 8;
#endif
    void* args[] = {&a};
    hipError_t e = hipLaunchCooperativeKernel((const void*)fwd_kernel, dim3(grid), dim3(NTHR), args, LDS_BYTES, stream);
    if (e != hipSuccess) fprintf(stderr, "cooperative launch failed: %s (grid %d)\n", hipGetErrorString(e), grid);
#else
    for (int s = 0; s < NSTEPS; ++s) { a.step_lo = s; a.step_hi = s + 1; a.coop = 0; hipLaunchKernelGGL(fwd_kernel, dim3(grid), dim3(NTHR), LDS_BYTES, stream, a); }
#endif
}
```

```cpp
#include <hip/hip_runtime.h>
#include <hip/hip_cooperative_groups.h>
#include <cstdio>
#include <cstdint>
namespace cg = cooperative_groups;
namespace pg8 {
#define PG8_LAS __attribute__((address_space(3)))
typedef unsigned short bf16_t;
typedef short bf16x8 __attribute__((ext_vector_type(8)));
typedef float f32x4 __attribute__((ext_vector_type(4)));
typedef unsigned u32x4 __attribute__((ext_vector_type(4)));
constexpr int BM = 256, BK = 64, HALF = 128, HTB = HALF * BK * 2  , STAGE_BYTES = 8 * HTB, NXCD = 8, WGM = 8;

__host__ __device__ __forceinline__ int lds_byte(int r, int c) { const int st = (r >> 4) * 2 + (c >> 5), rr = r & 15, cc = c & 31, ob = rr * 64 + cc * 2; return st * 1024 + (ob ^ (((ob >> 9) & 1) << 5)); }
__host__ __device__ __forceinline__ void stage_rc(int b, int& R, int& C) { const int st = b / 1024, sb = b % 1024, swz = sb ^ (((sb >> 9) & 1) << 5); R = (st >> 1) * 16 + swz / 64; C = (st & 1) * 32 + (swz % 64) / 2; }
__host__ __device__ __forceinline__ int perm32(int rho) { const int n = rho >> 4, i = rho & 15; return 8 * (i >> 2) + 4 * n + (i & 3); }

struct Unit { int pm, pn; };
struct Gemm { const bf16_t* A; const bf16_t* Bt; int M, N, K, lda, ldb; };

struct StaticOrder {
    int nM, nN, nwg, G, c;
    __host__ __device__ void init(int M, int N, int G_, int c_) { nM = M / BM; nN = N / BM; nwg = nM * nN; G = G_; c = c_; }
    __host__ __device__ bool next(int i, Unit& u) const {
        const long L = (long)i * G + c; if (L >= nwg) return false;
        int wgid = (int)L; { const int q = nwg / NXCD, r = nwg % NXCD, xcd = wgid % NXCD, off = wgid / NXCD; wgid = (xcd < r ? xcd * (q + 1) : r * (q + 1) + (xcd - r) * q) + off; }
        const int nig = WGM * nN, gid = wgid / nig, fm = gid * WGM, gsz = (nM - fm) < WGM ? (nM - fm) : WGM;
        u.pm = fm + ((wgid % nig) % gsz); u.pn = (wgid % nig) / gsz; return true;
    }
    __device__ __forceinline__ void a_ready(const Unit&) const {}
    __device__ __forceinline__ void done(const Unit&) const {}
};

typedef float f32x2 __attribute__((ext_vector_type(2)));
typedef __bf16 bf16x2_t __attribute__((ext_vector_type(2)));
__device__ __forceinline__ unsigned cvt_pk_bf16(float lo, float hi) { f32x2 v = {lo, hi}; bf16x2_t b = __builtin_convertvector(v, bf16x2_t); return __builtin_bit_cast(unsigned, b); }

template <int ACT> struct EpiStore {
    static constexpr bool PERM = true, AFTER_DRAIN = false;
    bf16_t* O; int ldc; float* AB; int ab_tile; bf16_t* halo;
    __device__ __forceinline__ void operator()(const f32x4 (&acc)[2][2][4][2], const Unit& u, int wr, int wc, int fr, int fq) const {
        const int row0 = u.pm * BM + wr * 64 + fr;
        if (u.pn == ab_tile) {
            if (wc == 0) {
#pragma unroll
                for (int ai = 0; ai < 2; ++ai)
#pragma unroll
                    for (int m = 0; m < 4; ++m) { float* p = AB + (size_t)(row0 + ai * HALF + m * 16) * 32 + 8 * fq; *(f32x4*)p = acc[ai][0][m][0]; *(f32x4*)(p + 4) = acc[ai][0][m][1]; }
            }
            return;
        }
        const int col0 = u.pn * BM + wc * 32 + 8 * fq;
#pragma unroll
        for (int ai = 0; ai < 2; ++ai)
#pragma unroll
            for (int m = 0; m < 4; ++m) { bf16_t* rowp = O + (size_t)(row0 + ai * HALF + m * 16) * ldc + col0;
#pragma unroll
                for (int bj = 0; bj < 2; ++bj) { f32x4 v0 = acc[ai][bj][m][0], v1 = acc[ai][bj][m][1];
                    if (ACT == 1) {
#pragma unroll
                        for (int i = 0; i < 4; ++i) { const float a = fmaxf(v0[i], 0.f), b = fmaxf(v1[i], 0.f); v0[i] = a * a; v1[i] = b * b; } }
                    u32x4 w; w.x = cvt_pk_bf16(v0[0], v0[1]); w.y = cvt_pk_bf16(v0[2], v0[3]); w.z = cvt_pk_bf16(v1[0], v1[1]); w.w = cvt_pk_bf16(v1[2], v1[3]);
                    *(u32x4*)(rowp + bj * HALF) = w;
                    if (halo && u.pn < 12 && ((m == 0 && fr == 0) || (m == 3 && fr == 15))) { const int row = row0 + ai * HALF + m * 16;
                        *(u32x4*)(halo + ((size_t)(row >> 6) * 2 + (m == 3 ? 1 : 0)) * 3072 + col0 + bj * HALF) = w; } } }
    }
};
struct EpiResid {
    static constexpr bool PERM = false, AFTER_DRAIN = false;
    float* X; int ldc; const float* gate; int gstride;
    __device__ __forceinline__ void operator()(const f32x4 (&acc)[2][2][4][2], const Unit& u, int wr, int wc, int fr, int fq) const {
        const int row0 = u.pm * BM + wr * 64 + fr, col0 = u.pn * BM + wc * 32 + 4 * fq;
        const float* g = gate + (size_t)(u.pm < 32 ? 0 : (u.pm < 64 ? 1 : 2)) * gstride + col0;
        f32x4 gv[2][2];
#pragma unroll
        for (int bj = 0; bj < 2; ++bj)
#pragma unroll
            for (int n = 0; n < 2; ++n) gv[bj][n] = *(const f32x4*)(g + bj * HALF + n * 16);
#pragma unroll
        for (int ai = 0; ai < 2; ++ai)
#pragma unroll
            for (int m = 0; m < 4; ++m) { float* p = X + (size_t)(row0 + ai * HALF + m * 16) * ldc + col0;
#pragma unroll
                for (int bj = 0; bj < 2; ++bj)
#pragma unroll
                    for (int n = 0; n < 2; ++n) { float* q = p + bj * HALF + n * 16; *(f32x4*)q = *(const f32x4*)q + gv[bj][n] * acc[ai][bj][m][n]; }
                if (m & 1) asm volatile("" ::: "memory"); }
    }
};

template <class Epi, class Sched, bool ALIGN_EPI = false, bool SP2 = false>
__device__ __forceinline__ void gemm_phase(PG8_LAS unsigned char* lds, const Gemm g, const Sched& S, const Epi& E) {
    int tid_ = threadIdx.x; asm volatile("" : "+v"(tid_)); const int tid = tid_, wid = __builtin_amdgcn_readfirstlane(tid >> 6), lane = tid & 63, wr = wid >> 2, wc = wid & 3, fr = lane & 15, fq = lane >> 4;
    const int K = g.K, nt = K / BK;
    unsigned voffA[2], voffB[2];
#pragma unroll
    for (int i = 0; i < 2; ++i) { int R, C; stage_rc(tid * 16 + i * 8192, R, C); const int Rb = Epi::PERM ? ((R & ~31) + perm32(R & 31)) : R;
        voffA[i] = (unsigned)(R * g.lda + C) * 2u; voffB[i] = (unsigned)(Rb * g.ldb + C) * 2u; }
    const size_t kstep = (size_t)(BK * 2);
    const int lda = g.lda, ldb = g.ldb;
    const size_t hstepA = (size_t)HALF * lda * 2, hstepB = (size_t)HALF * ldb * 2;
    const size_t tstepA = 2 * hstepA, tstepB = 2 * hstepB;
    const unsigned ldsw = (unsigned)wid * 1024u;
    const int aoff = lds_byte(wr * 64 + fr, fq * 8), boff = lds_byte(wc * 32 + fr, fq * 8);
#define PG8_SA(b, h) (((b) * 2 + (h)) * HTB)
#define PG8_SB(b, h) ((4 + (b) * 2 + (h)) * HTB)
#define PG8_STAGE(bufoff, gbase, voff) do { _Pragma("unroll") for (int _i = 0; _i < 2; ++_i) \
        __builtin_amdgcn_global_load_lds((const unsigned*)((const char*)(gbase) + (voff)[_i]), (PG8_LAS unsigned*)(lds + (bufoff) + ldsw + _i * 8192), 16, 0, 0); } while (0)
#define PG8_LDA(dst, b, h) do { _Pragma("unroll") for (int m = 0; m < 4; ++m) _Pragma("unroll") for (int k = 0; k < 2; ++k) dst[m][k] = *(const PG8_LAS bf16x8*)(lds + PG8_SA(b, h) + aoff + m * 2048 + k * 1024); } while (0)
#define PG8_LDB(dst, b, h) do { _Pragma("unroll") for (int n = 0; n < 2; ++n) _Pragma("unroll") for (int k = 0; k < 2; ++k) dst[n][k] = *(const PG8_LAS bf16x8*)(lds + PG8_SB(b, h) + boff + n * 2048 + k * 1024); } while (0)
#define PG8_MMA(ai, bj, At, Bt) do { __builtin_amdgcn_s_setprio(1); _Pragma("unroll") for (int m = 0; m < 4; ++m) _Pragma("unroll") for (int n = 0; n < 2; ++n) _Pragma("unroll") for (int k = 0; k < 2; ++k) \
        acc[ai][bj][m][n] = __builtin_amdgcn_mfma_f32_16x16x32_bf16(Bt[n][k], At[m][k], acc[ai][bj][m][n], 0, 0, 0); __builtin_amdgcn_s_setprio(0); } while (0)
#define PG8_WAIT_V(n) asm volatile("s_waitcnt vmcnt(" #n ")" ::: "memory")
#define PG8_WAIT_L(n) asm volatile("s_waitcnt lgkmcnt(" #n ")" ::: "memory")
#define PG8_BAR __builtin_amdgcn_s_barrier()
#define PG8_SCHED __builtin_amdgcn_sched_barrier(0)
    Unit cur, nxt; int ui = 0;
    if (!S.next(0, cur)) return;
    f32x4 acc[2][2][4][2];
#pragma unroll
    for (int a = 0; a < 2; ++a)
#pragma unroll
        for (int b = 0; b < 2; ++b)
#pragma unroll
            for (int m = 0; m < 4; ++m)
#pragma unroll
                for (int n = 0; n < 2; ++n) acc[a][b][m][n] = (f32x4){0.f, 0.f, 0.f, 0.f};
    bf16x8 At[4][2], B0[2][2], B1[2][2];
    const char* cA = (const char*)g.A + (size_t)cur.pm * tstepA; const char* cB = (const char*)g.Bt + (size_t)cur.pn * tstepB;
    S.a_ready(cur);
    if constexpr (SP2) {
        PG8_STAGE(PG8_SB(0, 0), cB, voffB); PG8_STAGE(PG8_SB(0, 1), cB + hstepB, voffB); PG8_STAGE(PG8_SA(0, 0), cA, voffA); PG8_STAGE(PG8_SA(0, 1), cA + hstepA, voffA);
        if (wr == 1) PG8_BAR;
        PG8_WAIT_V(2); PG8_BAR;
        PG8_STAGE(PG8_SB(1, 0), cB + kstep, voffB); PG8_STAGE(PG8_SA(1, 0), cA + kstep, voffA); PG8_STAGE(PG8_SB(1, 1), cB + hstepB + kstep, voffB);
        PG8_WAIT_V(6); PG8_BAR;
    } else {
        PG8_STAGE(PG8_SB(0, 0), cB, voffB); PG8_STAGE(PG8_SA(0, 0), cA, voffA); PG8_STAGE(PG8_SB(0, 1), cB + hstepB, voffB); PG8_STAGE(PG8_SA(0, 1), cA + hstepA, voffA);
        if (wr == 1) PG8_BAR;
        PG8_WAIT_V(4); PG8_BAR;
        PG8_STAGE(PG8_SB(1, 0), cB + kstep, voffB); PG8_STAGE(PG8_SA(1, 0), cA + kstep, voffA); PG8_STAGE(PG8_SB(1, 1), cB + hstepB + kstep, voffB);
        PG8_WAIT_V(6); PG8_BAR;
    }
    for (;;) {
        const bool has_next = S.next(ui + 1, nxt);
        const char* nA = has_next ? (const char*)g.A + (size_t)nxt.pm * tstepA : cA; const char* nB = has_next ? (const char*)g.Bt + (size_t)nxt.pn * tstepB : cB;
        for (int t = 0; t < nt; t += 2) {
            const bool last = (t == nt - 2);
            const char* a1 = cA + (size_t)(t + 1) * kstep;
            const char* a2 = last ? nA : cA + (size_t)(t + 2) * kstep; const char* b2 = last ? nB : cB + (size_t)(t + 2) * kstep;
            const char* a3 = a2 + kstep; const char* b3 = b2 + kstep;
            if (last && has_next) S.a_ready(nxt);
            if constexpr (SP2) {
            PG8_LDB(B0, 0, 0); PG8_LDB(B1, 0, 1); PG8_SCHED; PG8_LDA(At, 0, 0); PG8_STAGE(PG8_SA(1, 1), a1 + hstepA, voffA);
            PG8_WAIT_V(8); PG8_WAIT_L(0); PG8_BAR; PG8_MMA(0, 0, At, B0); PG8_MMA(0, 1, At, B1); PG8_BAR; PG8_SCHED;
            PG8_LDA(At, 0, 1); PG8_STAGE(PG8_SB(0, 0), b2, voffB); PG8_STAGE(PG8_SB(0, 1), b2 + hstepB, voffB); PG8_STAGE(PG8_SA(0, 0), a2, voffA);
            PG8_WAIT_V(8); PG8_WAIT_L(0); PG8_BAR; PG8_MMA(1, 0, At, B0); PG8_MMA(1, 1, At, B1); PG8_BAR; PG8_SCHED;
            PG8_LDB(B0, 1, 0); PG8_LDB(B1, 1, 1); PG8_SCHED; PG8_LDA(At, 1, 0); PG8_STAGE(PG8_SA(0, 1), a2 + hstepA, voffA);
            PG8_WAIT_V(8); PG8_WAIT_L(0); PG8_BAR; PG8_MMA(0, 0, At, B0); PG8_MMA(0, 1, At, B1); PG8_BAR; PG8_SCHED;
            PG8_LDA(At, 1, 1); PG8_STAGE(PG8_SB(1, 0), b3, voffB); PG8_STAGE(PG8_SB(1, 1), b3 + hstepB, voffB); PG8_STAGE(PG8_SA(1, 0), a3, voffA);
            PG8_WAIT_V(8); PG8_WAIT_L(0); PG8_BAR; PG8_MMA(1, 0, At, B0); PG8_MMA(1, 1, At, B1); PG8_BAR; PG8_SCHED;
            } else {
            PG8_LDB(B0, 0, 0); PG8_SCHED; PG8_LDA(At, 0, 0); PG8_STAGE(PG8_SA(1, 1), a1 + hstepA, voffA);
            PG8_WAIT_L(8); PG8_BAR; PG8_WAIT_L(0); PG8_MMA(0, 0, At, B0); PG8_BAR; PG8_SCHED;
            PG8_LDB(B1, 0, 1); PG8_STAGE(PG8_SB(0, 0), b2, voffB);
            PG8_BAR; PG8_WAIT_L(0); PG8_MMA(0, 1, At, B1); PG8_BAR;
            PG8_LDA(At, 0, 1); PG8_STAGE(PG8_SA(0, 0), a2, voffA);
            PG8_BAR; PG8_WAIT_L(0); PG8_MMA(1, 0, At, B0); PG8_BAR; PG8_SCHED;
            PG8_STAGE(PG8_SB(0, 1), b2 + hstepB, voffB);
            PG8_WAIT_V(6); PG8_BAR; PG8_MMA(1, 1, At, B1); PG8_BAR;
            PG8_LDB(B0, 1, 0); PG8_SCHED; PG8_LDA(At, 1, 0); PG8_STAGE(PG8_SA(0, 1), a2 + hstepA, voffA);
            PG8_WAIT_L(8); PG8_BAR; PG8_WAIT_L(0); PG8_MMA(0, 0, At, B0); PG8_BAR; PG8_SCHED;
            PG8_LDB(B1, 1, 1); PG8_STAGE(PG8_SB(1, 0), b3, voffB);
            PG8_BAR; PG8_WAIT_L(0); PG8_MMA(0, 1, At, B1); PG8_BAR;
            PG8_LDA(At, 1, 1); PG8_STAGE(PG8_SA(1, 0), a3, voffA);
            PG8_BAR; PG8_WAIT_L(0); PG8_MMA(1, 0, At, B0); PG8_BAR; PG8_SCHED;
            PG8_STAGE(PG8_SB(1, 1), b3 + hstepB, voffB);
            PG8_WAIT_V(6); PG8_BAR; PG8_MMA(1, 1, At, B1); PG8_BAR;
            }
        }
        if constexpr (ALIGN_EPI) { if (wr == 0) PG8_BAR; }
        if constexpr (!Epi::AFTER_DRAIN) { E(acc, cur, wr, wc, fr, fq); S.done(cur); }
        if (!has_next) break;
#pragma unroll
        for (int a = 0; a < 2; ++a)
#pragma unroll
            for (int b = 0; b < 2; ++b)
#pragma unroll
                for (int m = 0; m < 4; ++m)
#pragma unroll
                    for (int n = 0; n < 2; ++n) acc[a][b][m][n] = (f32x4){0.f, 0.f, 0.f, 0.f};
        cur = nxt; cA = nA; cB = nB; ++ui;
        if constexpr (ALIGN_EPI) { if (wr == 1) PG8_BAR; }
    }
    PG8_WAIT_V(0);
    if constexpr (!ALIGN_EPI) { if (wr == 0) PG8_BAR; }
    PG8_BAR;
    if constexpr (Epi::AFTER_DRAIN) { E.fused(acc, cur, wr, wc, fr, fq, lds, wid, lane); S.done(cur); }
#undef PG8_SA
#undef PG8_SB
#undef PG8_STAGE
#undef PG8_LDA
#undef PG8_LDB
#undef PG8_MMA
#undef PG8_WAIT_V
#undef PG8_WAIT_L
#undef PG8_BAR
#undef PG8_SCHED
}
}

constexpr int D = 1024, NB = 2, T = 8192, CT = 256, DEPTH = 4, FF = 4096;
constexpr int ML = NB * T, MC = NB * CT, M = ML + MC;
constexpr int NADA = 6 * D;
constexpr int GDN_N = 4128, GDN_NP = 4352;
constexpr int NH = 8, HD = 128;
constexpr int NKV = CT + T;
constexpr float EPS = 1e-6f;
constexpr int NWAVES = 8, NTHR = 512;
constexpr float QSCALE = 0.125f * 1.4426950408889634f;
constexpr float LAMBDA_INIT = 0.47071302f;

constexpr size_t MiB = 1u << 20;
constexpr size_t WS_CTL = 0, CTL_ZERO_BYTES = 1 * MiB;
constexpr size_t WS_MOD = 1 * MiB;
constexpr size_t WS_ROPE = 2 * MiB;
constexpr size_t WS_AB = 4 * MiB;
constexpr size_t WS_OFC = 7 * MiB;
constexpr size_t WS_W1T = 10 * MiB, WS_W2T = 42 * MiB, WS_GINT = 74 * MiB, WS_GOUTT = 91 * MiB, WS_SINT = 95 * MiB, WS_SOUTT = 101 * MiB, WS_DINT = 103 * MiB, WS_DOUTT = 109 * MiB;
constexpr size_t WS_X = 112 * MiB;
constexpr size_t WS_H = 178 * MiB;
constexpr size_t WS_Y = 211 * MiB;
constexpr size_t WS_Z = 244 * MiB;
constexpr size_t WS_HALO = 376 * MiB;
constexpr size_t WS_END = 380 * MiB;
constexpr size_t WS_PD = WS_H;

constexpr int LDS_BYTES = 149504;

#define LAS __attribute__((address_space(3)))
typedef unsigned short bf16;
typedef unsigned u32x4 __attribute__((ext_vector_type(4)));
typedef unsigned u32x2 __attribute__((ext_vector_type(2)));
typedef float f32x4 __attribute__((ext_vector_type(4)));
typedef float f32x2 __attribute__((ext_vector_type(2)));
typedef float f32x16 __attribute__((ext_vector_type(16)));
typedef short bf16x8 __attribute__((ext_vector_type(8)));
typedef short s16x4 __attribute__((ext_vector_type(4)));
#define LDS_WAIT() asm volatile("s_waitcnt lgkmcnt(0)" ::: "memory")

__device__ __forceinline__ float bf2f(unsigned u) { return __uint_as_float(u << 16); }
__device__ __forceinline__ unsigned pk2(float lo, float hi) { return pg8::cvt_pk_bf16(lo, hi); }
__device__ __forceinline__ float wave_sum(float v) {
#pragma unroll
    for (int o = 1; o < 64; o <<= 1) v += __shfl_xor(v, o);
    return v;
}
__device__ __forceinline__ float silu_f(float x) { return x / (1.f + expf(-x)); }
__device__ __forceinline__ float silu_fast(float x) { return x * __builtin_amdgcn_rcpf(1.f + __builtin_amdgcn_exp2f(-1.4426950408889634f * x)); }
__device__ __forceinline__ int crow(int r, int hi) { return (r & 3) + 8 * (r >> 2) + 4 * hi; }

struct Args { const float* in[24]; float* out; unsigned char* ws; int step_lo, step_hi, coop, pad; };
typedef const __attribute__((address_space(4))) Args* KArgs;
__device__ __forceinline__ KArgs kargs() { unsigned long long p = (unsigned long long)__builtin_amdgcn_kernarg_segment_ptr(); asm volatile("" : "+s"(p)); return (KArgs)p; }
#define INP(k) (kargs()->in[k])
extern __shared__ __attribute__((aligned(16))) unsigned char lds_raw[];
struct Frame { LAS unsigned char* lds; int tid, lane, wave, G, bid; float* out; unsigned char* ws; };
__device__ __forceinline__ Frame make_frame() {
    Frame F; F.lds = (LAS unsigned char*)lds_raw; F.tid = threadIdx.x; asm volatile("" : "+v"(F.tid)); F.lane = F.tid & 63; F.wave = __builtin_amdgcn_readfirstlane(F.tid >> 6); F.G = gridDim.x; F.bid = blockIdx.x; asm volatile("" : "+s"(F.G), "+s"(F.bid));
    KArgs a = kargs(); F.out = a->out; F.ws = a->ws; return F;
}
enum { I_X = 0, I_C, I_CTX, I_CCTX, I_N1G, I_N2G, I_ADAW, I_ADAB, I_W1, I_W2, I_GIN, I_GCONV, I_GALOG, I_GDT, I_GNG, I_GOUT, I_SIN, I_SCONV, I_SOUT, I_DIN, I_DLAM, I_DNG, I_DOUT, I_FG };

__device__ __forceinline__ void transpose_item(const float* W, int K, int ldw, bf16* WT, LAS float* scr, int item, int nblk, int lane) {
    const int kb = item / nblk, nb = item % nblk, k0 = 64 * kb, n0 = 32 * nb;
#pragma unroll 8
    for (int i = 0; i < 32; ++i) { const int kk = 2 * i + (lane >> 5); scr[kk * 33 + (lane & 31)] = W[(size_t)(k0 + kk) * ldw + n0 + (lane & 31)]; }
    LDS_WAIT(); asm volatile("" ::: "memory");
    const int c = lane & 7;
#pragma unroll
    for (int j = 0; j < 4; ++j) { const int n = (lane >> 3) + 8 * j; const LAS float* s = scr + (8 * c) * 33 + n;
        u32x4 o; o.x = pk2(s[0 * 33], s[1 * 33]); o.y = pk2(s[2 * 33], s[3 * 33]); o.z = pk2(s[4 * 33], s[5 * 33]); o.w = pk2(s[6 * 33], s[7 * 33]);
        *(u32x4*)(WT + (size_t)(n0 + n) * K + k0 + 8 * c) = o; }
    LDS_WAIT(); asm volatile("" ::: "memory");
}
__device__ __forceinline__ void get_mat(unsigned char* ws_, int idx, const float*& src, bf16*& dst, int& K, int& N, int& ld) {
    unsigned char* ws = ws_;
    if (idx < 4)       { src = INP(I_W1) + (size_t)idx * D * FF; dst = (bf16*)(ws + WS_W1T) + (size_t)idx * D * FF; K = D; N = FF; ld = FF; }
    else if (idx < 8)  { const int i = idx - 4; src = INP(I_W2) + (size_t)i * D * FF; dst = (bf16*)(ws + WS_W2T) + (size_t)i * D * FF; K = FF; N = D; ld = D; }
    else if (idx < 10) { const int j = idx - 8; src = INP(I_GIN) + (size_t)j * D * GDN_N; dst = (bf16*)(ws + WS_GINT) + (size_t)j * GDN_NP * D; K = D; N = GDN_N; ld = GDN_N; }
    else if (idx < 12) { const int j = idx - 10; src = INP(I_GOUT) + (size_t)j * D * D; dst = (bf16*)(ws + WS_GOUTT) + (size_t)j * D * D; K = D; N = D; ld = D; }
    else if (idx == 12) { src = INP(I_SIN); dst = (bf16*)(ws + WS_SINT); K = D; N = 3 * D; ld = 3 * D; }
    else if (idx == 13) { src = INP(I_SOUT); dst = (bf16*)(ws + WS_SOUTT); K = D; N = D; ld = D; }
    else if (idx == 14) { src = INP(I_DIN); dst = (bf16*)(ws + WS_DINT); K = D; N = 3 * D; ld = 3 * D; }
    else { src = INP(I_DOUT); dst = (bf16*)(ws + WS_DOUTT); K = D; N = D; ld = D; }
}
__device__ __forceinline__ void convert_weights(unsigned char* ws, unsigned mask, int gw, int NGW, int gt, int NGT, LAS unsigned char* lds, int wave, int lane) {
    LAS float* scr = (LAS float*)(lds + wave * 16384);
    for (int mi = 0; mi < 16; ++mi) {
        if (!((mask >> mi) & 1u)) continue;
        const float* src; bf16* dst; int K, N, ld; get_mat(ws, mi, src, dst, K, N, ld);
        const int nblk = N / 32, nitems = (K / 64) * nblk;
        for (int it = gw; it < nitems; it += NGW) transpose_item(src, K, ld, dst, scr, it, nblk, lane);
        if (mi == 8 || mi == 9) { u32x4* z = (u32x4*)((bf16*)(ws + WS_GINT) + (size_t)(mi - 8) * GDN_NP * D + (size_t)GDN_N * D);
            for (int i = gt; i < (GDN_NP - GDN_N) * D / 8; i += NGT) z[i] = (u32x4){0u, 0u, 0u, 0u}; }
    }
}
__device__ __forceinline__ void step_prologue() {
    const Frame F = make_frame();
    const int gw = F.bid * NWAVES + F.wave, NGW = F.G * NWAVES;
    const int gt = F.bid * NTHR + F.tid, NGT = F.G * NTHR;
    convert_weights(F.ws, (1u << 0) | (1u << 4) | (1u << 8) | (1u << 10), gw, NGW, gt, NGT, F.lds, F.wave, F.lane);
    __syncthreads();
    {
        LAS float* sv = (LAS float*)F.lds;
        LAS float* red = sv + 3 * D;
        for (int i = F.tid; i < 3 * D; i += NTHR) { const int g = i / D, k = i % D; const float c = g < 2 ? INP(I_C)[g * D + k] : INP(I_CCTX)[k]; sv[i] = silu_f(c); }
        __syncthreads();
        float* MOD = (float*)(F.ws + WS_MOD);
        const int c = F.tid & 63, ks = F.tid >> 6;
        for (int it = F.bid; it < DEPTH * (NADA / 64); it += F.G) {
            const int li = it / (NADA / 64), n0 = (it % (NADA / 64)) * 64;
            const float* w = INP(I_ADAW) + (size_t)li * D * NADA + (size_t)(ks * 128) * NADA + n0 + c;
            float a0 = 0.f, a1 = 0.f, a2 = 0.f;
#pragma unroll 8
            for (int k = 0; k < 128; ++k) { const float wv = w[(size_t)k * NADA]; const int kk = ks * 128 + k; a0 += sv[kk] * wv; a1 += sv[D + kk] * wv; a2 += sv[2 * D + kk] * wv; }
            red[(ks * 3 + 0) * 64 + c] = a0; red[(ks * 3 + 1) * 64 + c] = a1; red[(ks * 3 + 2) * 64 + c] = a2;
            __syncthreads();
            if (F.tid < 192) { const int g = F.tid >> 6; float s = INP(I_ADAB)[li * NADA + n0 + c];
#pragma unroll
                for (int q = 0; q < 8; ++q) s += red[(q * 3 + g) * 64 + c];
                MOD[((size_t)li * 3 + g) * NADA + n0 + c] = s; }
            __syncthreads();
        }
    }
    {
        f32x4* X4 = (f32x4*)(F.ws + WS_X); const f32x4* x4 = (const f32x4*)INP(I_X); const f32x4* c4 = (const f32x4*)INP(I_CTX);
        for (int i = gt; i < M * (D / 4); i += NGT) X4[i] = i < ML * (D / 4) ? x4[i] : c4[i - ML * (D / 4)];
    }
    {
        f32x2* R = (f32x2*)(F.ws + WS_ROPE);
        for (int i = gt; i < T * 32; i += NGT) { const int t = i >> 5, p = i & 31, f = p & 15;
            const float inv = powf(10000.0f, -(float)f / 16.0f); const float pos = (float)(p < 16 ? (t >> 6) : (t & 63)); const float ang = pos * inv;
            R[i] = (f32x2){cosf(ang), sinf(ang)}; }
    }
}

__device__ __forceinline__ void step_norm(int layer, int which, int nrows, bool zero_of) {
    const Frame F = make_frame();
    const int gw = F.bid * NWAVES + F.wave, NGW = F.G * NWAVES;
    const float* X = (const float*)(F.ws + WS_X); bf16* H = (bf16*)(F.ws + WS_H);
    const float* ng = (which ? INP(I_N2G) : INP(I_N1G)) + layer * D;
    const float* MOD = (const float*)(F.ws + WS_MOD) + (size_t)layer * 3 * NADA + which * 3 * D;
    for (int row = gw; row < nrows; row += NGW) {
        const int grp = row < T ? 0 : (row < ML ? 1 : 2);
        const f32x4* xr = (const f32x4*)(X + (size_t)row * D) + F.lane;
        const f32x4* sh = (const f32x4*)(MOD + (size_t)grp * NADA) + F.lane; const f32x4* sc = (const f32x4*)(MOD + (size_t)grp * NADA + D) + F.lane; const f32x4* gg = (const f32x4*)ng + F.lane;
        f32x4 v[4]; float s = 0.f;
#pragma unroll
        for (int j = 0; j < 4; ++j) { v[j] = xr[64 * j]; s += (v[j].x * v[j].x + v[j].y * v[j].y) + (v[j].z * v[j].z + v[j].w * v[j].w); }
        const float rstd = 1.0f / sqrtf(wave_sum(s) * (1.f / D) + EPS);
        u32x2* o = (u32x2*)(H + (size_t)row * D) + F.lane;
#pragma unroll
        for (int j = 0; j < 4; ++j) { const f32x4 g4 = gg[64 * j], s4 = sc[64 * j], h4 = sh[64 * j]; const f32x4 y = (v[j] * rstd) * g4; const f32x4 h = y * (1.0f + s4) + h4;
            o[64 * j] = (u32x2){pk2(h.x, h.y), pk2(h.z, h.w)}; }
    }
    if (zero_of) {
        const int gt = F.bid * NTHR + F.tid, NGT = F.G * NTHR;
        f32x4* a = (f32x4*)F.out; for (int i = gt; i < ML * (D / 4); i += NGT) a[i] = (f32x4){0.f, 0.f, 0.f, 0.f};
        f32x4* b = (f32x4*)(F.ws + WS_OFC); for (int i = gt; i < MC * (D / 4); i += NGT) b[i] = (f32x4){0.f, 0.f, 0.f, 0.f};
    }
}
__device__ __forceinline__ void step_final() {
    const Frame F = make_frame();
    const int gw = F.bid * NWAVES + F.wave, NGW = F.G * NWAVES;
    const float* X = (const float*)(F.ws + WS_X);
    for (int row = gw; row < ML; row += NGW) {
        const f32x4* xr = (const f32x4*)(X + (size_t)row * D) + F.lane; const f32x4* gg = (const f32x4*)INP(I_FG) + F.lane;
        f32x4 v[4]; float s = 0.f;
#pragma unroll
        for (int j = 0; j < 4; ++j) { v[j] = xr[64 * j]; s += (v[j].x * v[j].x + v[j].y * v[j].y) + (v[j].z * v[j].z + v[j].w * v[j].w); }
        const float rstd = 1.0f / sqrtf(wave_sum(s) * (1.f / D) + EPS);
        f32x4* o = (f32x4*)(F.out + (size_t)row * D) + F.lane;
#pragma unroll
        for (int j = 0; j < 4; ++j) o[64 * j] = (v[j] * rstd) * gg[64 * j];
    }
}

__device__ __forceinline__ void step_gdn_scan(int j) {
    const Frame F = make_frame();
    LAS float* qs = (LAS float*)F.lds;
    LAS float* ks = qs + 64 * 128;
    LAS float* vs = ks + 64 * 128;
    LAS float* ga = vs + 64 * 128;
    LAS float* be = ga + 64;
    const bf16* Z = (const bf16*)(F.ws + WS_Z);
    const float* AB = (const float*)(F.ws + WS_AB);
    const float* cw = INP(I_GCONV) + (size_t)j * 3 * 3072;
    float* OFC = (float*)(F.ws + WS_OFC);
    for (int it = F.bid; it < 32; it += F.G) {
        const int b = it >> 4, h = (it >> 1) & 7, dir = it & 1;
        const float Aco = expf(INP(I_GALOG)[j * 16 + dir * 8 + h]); const float dtb = INP(I_GDT)[j * 16 + dir * 8 + h];
        float S[64];
#pragma unroll
        for (int i = 0; i < 64; ++i) S[i] = 0.f;
        const int jcol = F.tid >> 1, half = F.tid & 1;
        for (int n = 0; n < 132; ++n) {
            const bool isctx = n < 4; const int L = isctx ? CT : T; const int p0 = isctx ? 64 * n : 64 * (n - 4); const int rbase = isctx ? ML + b * CT : b * T;
            for (int idx = F.tid; idx < 64 * 384; idx += NTHR) {
                const int c = idx / 384, ch = idx % 384, part = ch >> 7, e = ch & 127;
                const int p = p0 + c; const int t = dir ? (L - 1 - p) : p; const int col = part * 1024 + h * 128 + e;
                float acc = 0.f;
#pragma unroll
                for (int tap = 0; tap < 3; ++tap) { const int tt = t + tap - 1; if (tt >= 0 && tt < L) acc += cw[tap * 3072 + col] * bf2f(Z[(size_t)(rbase + tt) * 4096 + col]); }
                acc = silu_f(acc);
                LAS float* dst = part == 0 ? qs : (part == 1 ? ks : vs); dst[c * 128 + e] = acc;
            }
            if (F.tid < 64) { const int p = p0 + F.tid; const int t = dir ? (L - 1 - p) : p; const size_t row = (size_t)(rbase + t);
                const float av = AB[row * 32 + dir * 8 + h], bv = AB[row * 32 + 16 + dir * 8 + h];
                const float x = av + dtb; const float sp = x > 20.f ? x : log1pf(expf(x));
                ga[F.tid] = expf(-Aco * sp); be[F.tid] = 1.f / (1.f + expf(-bv)); }
            __syncthreads();
#pragma unroll 1
            for (int rr = 0; rr < 8; ++rr) { const int c = F.wave * 8 + rr;
                const float q0 = qs[c * 128 + F.lane], q1 = qs[c * 128 + 64 + F.lane]; const float sq = 0.08838834764831845f / sqrtf(wave_sum(q0 * q0 + q1 * q1) + EPS);
                qs[c * 128 + F.lane] = q0 * sq; qs[c * 128 + 64 + F.lane] = q1 * sq;
                const float k0 = ks[c * 128 + F.lane], k1 = ks[c * 128 + 64 + F.lane]; const float sk = 1.0f / sqrtf(wave_sum(k0 * k0 + k1 * k1) + EPS);
                ks[c * 128 + F.lane] = k0 * sk; ks[c * 128 + 64 + F.lane] = k1 * sk; }
            __syncthreads();
            if (F.tid < 256) {
#pragma unroll 1
                for (int c = 0; c < 64; ++c) {
                    const float a = ga[c], bt = be[c];
                    const LAS f32x4* k4 = (const LAS f32x4*)(ks + c * 128 + 64 * half); const LAS f32x4* q4 = (const LAS f32x4*)(qs + c * 128 + 64 * half);
                    float dot = 0.f;
#pragma unroll
                    for (int i = 0; i < 16; ++i) { const f32x4 kv = k4[i]; dot += kv.x * S[4 * i] + kv.y * S[4 * i + 1] + kv.z * S[4 * i + 2] + kv.w * S[4 * i + 3]; }
                    dot += __shfl_xor(dot, 1);
                    const float tmp = bt * (vs[c * 128 + jcol] - a * dot);
                    float o = 0.f;
#pragma unroll
                    for (int i = 0; i < 16; ++i) { const f32x4 kv = k4[i]; const f32x4 qv = q4[i];
                        S[4 * i] = a * S[4 * i] + kv.x * tmp; S[4 * i + 1] = a * S[4 * i + 1] + kv.y * tmp; S[4 * i + 2] = a * S[4 * i + 2] + kv.z * tmp; S[4 * i + 3] = a * S[4 * i + 3] + kv.w * tmp;
                        o += qv.x * S[4 * i] + qv.y * S[4 * i + 1] + qv.z * S[4 * i + 2] + qv.w * S[4 * i + 3]; }
                    o += __shfl_xor(o, 1);
                    const int p = p0 + c; const int t = dir ? (L - 1 - p) : p;
                    float* dst = isctx ? OFC + (size_t)(b * CT + t) * D : F.out + (size_t)(b * T + t) * D;
                    if (half == 0) atomicAdd(dst + h * 128 + jcol, o);
                }
            }
            __syncthreads();
        }
    }
}
__device__ __forceinline__ void step_gdn_norm(int j) {
    const Frame F = make_frame();
    const int gw = F.bid * NWAVES + F.wave, NGW = F.G * NWAVES;
    const bf16* Z = (const bf16*)(F.ws + WS_Z); bf16* Y = (bf16*)(F.ws + WS_Y); const float* ng = INP(I_GNG) + j * 128;
    for (int row = gw; row < M; row += NGW) {
        const float* src = row < ML ? F.out + (size_t)row * D : (const float*)(F.ws + WS_OFC) + (size_t)(row - ML) * D;
        const f32x4* s4 = (const f32x4*)(src + 16 * F.lane);
        float v[16]; float ss = 0.f;
#pragma unroll
        for (int q = 0; q < 4; ++q) { const f32x4 x = s4[q]; v[4 * q] = x.x; v[4 * q + 1] = x.y; v[4 * q + 2] = x.z; v[4 * q + 3] = x.w; ss += (x.x * x.x + x.y * x.y) + (x.z * x.z + x.w * x.w); }
        ss += __shfl_xor(ss, 1); ss += __shfl_xor(ss, 2); ss += __shfl_xor(ss, 4);
        const float rstd = 1.0f / sqrtf(ss * (1.f / 128.f) + EPS);
        const u32x4* g4 = (const u32x4*)(Z + (size_t)row * 4096 + 3072 + 16 * F.lane);
        const int e0 = (16 * F.lane) & 127;
        u32x4 o[2];
#pragma unroll
        for (int q = 0; q < 2; ++q) { const u32x4 gz = g4[q]; unsigned w[4];
#pragma unroll
            for (int i = 0; i < 4; ++i) { const unsigned gg = gz[i]; const float g0 = bf2f(gg & 0xffffu), g1 = bf2f(gg >> 16); const int e = e0 + 8 * q + 2 * i;
                w[i] = pk2(v[8 * q + 2 * i] * rstd * ng[e] * silu_f(g0), v[8 * q + 2 * i + 1] * rstd * ng[e + 1] * silu_f(g1)); }
            o[q] = (u32x4){w[0], w[1], w[2], w[3]}; }
        u32x4* dst = (u32x4*)(Y + (size_t)row * D + 16 * F.lane); dst[0] = o[0]; dst[1] = o[1];
    }
}

__device__ __forceinline__ void step_sconv() {
    const Frame F = make_frame();
    const int gt = F.bid * NTHR + F.tid, NGT = F.G * NTHR;
    const bf16* Z = (const bf16*)(F.ws + WS_Z); bf16* Y = (bf16*)(F.ws + WS_Y); const float* cw = INP(I_SCONV);
    for (int idx = gt; idx < M * 128; idx += NGT) {
        const int row = idx >> 7, c0 = (idx & 127) * 8;
        int t, L, rbase; if (row < ML) { t = row & (T - 1); L = T; rbase = row - t; } else { const int r2 = row - ML; t = r2 & (CT - 1); L = CT; rbase = row - t; }
        float acc[8];
#pragma unroll
        for (int i = 0; i < 8; ++i) acc[i] = 0.f;
#pragma unroll
        for (int tap = 0; tap < 3; ++tap) { const int tt = t + tap - 1;
            if (tt >= 0 && tt < L) { const bf16* zr = Z + (size_t)(rbase + tt) * 3072; const u32x4 cg = *(const u32x4*)(zr + 1024 + c0), hv = *(const u32x4*)(zr + 2048 + c0);
                const f32x4 w0 = *(const f32x4*)(cw + tap * 1024 + c0), w1 = *(const f32x4*)(cw + tap * 1024 + c0 + 4); const float w[8] = {w0.x, w0.y, w0.z, w0.w, w1.x, w1.y, w1.z, w1.w};
#pragma unroll
                for (int i = 0; i < 4; ++i) { acc[2 * i] += w[2 * i] * bf2f(cg[i] & 0xffffu) * bf2f(hv[i] & 0xffffu); acc[2 * i + 1] += w[2 * i + 1] * bf2f(cg[i] >> 16) * bf2f(hv[i] >> 16); } } }
        const u32x4 bg = *(const u32x4*)(Z + (size_t)row * 3072 + c0); u32x4 o;
#pragma unroll
        for (int i = 0; i < 4; ++i) o[i] = pk2(bf2f(bg[i] & 0xffffu) * acc[2 * i], bf2f(bg[i] >> 16) * acc[2 * i + 1]);
        *(u32x4*)(Y + (size_t)row * D + c0) = o;
    }
}

__device__ __forceinline__ void step_rope() {
    const Frame F = make_frame();
    const int gw = F.bid * NWAVES + F.wave, NGW = F.G * NWAVES;
    bf16* Z = (bf16*)(F.ws + WS_Z); const f32x4* R = (const f32x4*)(F.ws + WS_ROPE);
    for (int row = gw; row < M; row += NGW) {
        u32x4* p = (u32x4*)(Z + (size_t)row * 3072 + 32 * F.lane);
        u32x4 v[4];
#pragma unroll
        for (int q = 0; q < 4; ++q) v[q] = p[q];
        const bool lat = row < ML; const float sc = F.lane < 32 ? QSCALE : 1.0f;
        const f32x4* tab = R + ((size_t)(row & (T - 1)) * 32 + 16 * (F.lane & 1)) / 2;
#pragma unroll
        for (int q = 0; q < 4; ++q) {
#pragma unroll
            for (int i = 0; i < 4; i += 2) {
                f32x4 cs = (f32x4){1.f, 0.f, 1.f, 0.f}; if (lat) cs = tab[(4 * q + i) / 2];
                { const unsigned w = v[q][i]; const float x0 = bf2f(w & 0xffffu), x1 = bf2f(w >> 16); v[q][i] = pk2((x0 * cs.x - x1 * cs.y) * sc, (x0 * cs.y + x1 * cs.x) * sc); }
                { const unsigned w = v[q][i + 1]; const float x0 = bf2f(w & 0xffffu), x1 = bf2f(w >> 16); v[q][i + 1] = pk2((x0 * cs.z - x1 * cs.w) * sc, (x0 * cs.w + x1 * cs.z) * sc); }
            }
        }
#pragma unroll
        for (int q = 0; q < 4; ++q) p[q] = v[q];
    }
    bf16* Vt = (bf16*)(F.ws + WS_H);
    LAS bf16* tl = (LAS bf16*)(F.lds + F.wave * 18432);
    for (int it = gw; it < NB * NH * (NKV / 64); it += NGW) {
        const int kt = it % (NKV / 64), bh = it / (NKV / 64), b = bh >> 3, h = bh & 7; const int kv0 = 64 * kt;
        const int srow = kv0 < CT ? ML + b * CT + kv0 : b * T + kv0 - CT;
#pragma unroll 4
        for (int i = 0; i < 16; ++i) { const int r = 4 * i + (F.lane >> 4), cc = (F.lane & 15) * 8;
            const u32x4 v = *(const u32x4*)(Z + (size_t)(srow + r) * 3072 + 2048 + h * 128 + cc);
#pragma unroll
            for (int q = 0; q < 4; ++q) { tl[(cc + 2 * q) * 72 + r] = (bf16)(v[q] & 0xffffu); tl[(cc + 2 * q + 1) * 72 + r] = (bf16)(v[q] >> 16); } }
        LDS_WAIT(); asm volatile("" ::: "memory");
#pragma unroll 4
        for (int i = 0; i < 16; ++i) { const int e = 8 * i + (F.lane >> 3), ch = F.lane & 7;
            const u32x4 v = *(const LAS u32x4*)(tl + e * 72 + ch * 8);
            *(u32x4*)(Vt + ((size_t)(bh * 128 + e)) * NKV + kv0 + ch * 8) = v; }
        LDS_WAIT(); asm volatile("" ::: "memory");
    }
}
__device__ __forceinline__ void step_attn() {
    const Frame F = make_frame();
    const bf16* Z = (const bf16*)(F.ws + WS_Z); const bf16* Vt = (const bf16*)(F.ws + WS_H); bf16* Y = (bf16*)(F.ws + WS_Y);
    LAS float* EX = (LAS float*)F.lds;
    const int r = F.lane & 31, hi = F.lane >> 5, qs = F.wave & 3, m = F.wave >> 2;
    float lmb;
    { const float* lam = INP(I_DLAM); const float t1 = lam[F.lane] * lam[64 + F.lane], t2 = lam[128 + F.lane] * lam[192 + F.lane]; lmb = expf(wave_sum(t1)) - expf(wave_sum(t2)) + LAMBDA_INIT; }
    const float* ng = INP(I_DNG);
    for (int u = F.bid; u < 1056; u += F.G) {
        int b, h, qrow0, nk;
        if (u < 1024) { b = u >> 9; h = (u >> 6) & 7; qrow0 = b * T + (u & 63) * 128; nk = NKV / 32; }
        else { const int v = u - 1024; b = v >> 4; h = (v >> 1) & 7; qrow0 = ML + b * CT + (v & 1) * 128; nk = CT / 32; }
        const int row0 = qrow0 + 32 * qs;
        bf16x8 qf[4];
#pragma unroll
        for (int d0 = 0; d0 < 4; ++d0) qf[d0] = *(const bf16x8*)(Z + (size_t)(row0 + r) * 3072 + h * 128 + m * 64 + d0 * 16 + hi * 8);
        const int kcol = 1024 + h * 128 + m * 64 + hi * 8;
        const bf16* vtb = Vt + (size_t)((b * 8 + h) * 128 + r) * NKV + 4 * hi;
        f32x16 o[4];
#pragma unroll
        for (int i = 0; i < 4; ++i)
#pragma unroll
            for (int q = 0; q < 16; ++q) o[i][q] = 0.f;
        float mref = 0.f, l = 0.f;
        for (int s = 0; s < nk; ++s) {
            const int kv0 = 32 * s; const int krow = kv0 < CT ? ML + b * CT + kv0 : b * T + kv0 - CT;
            const bf16* kp = Z + (size_t)(krow + r) * 3072 + kcol;
            bf16x8 kf[4];
#pragma unroll
            for (int d0 = 0; d0 < 4; ++d0) kf[d0] = *(const bf16x8*)(kp + d0 * 16);
            bf16x8 vf[4][2];
#pragma unroll
            for (int i = 0; i < 4; ++i)
#pragma unroll
                for (int s2 = 0; s2 < 2; ++s2) { const bf16* vp = vtb + (size_t)(32 * i) * NKV + kv0 + 16 * s2; const s16x4 lo = *(const s16x4*)vp, h8 = *(const s16x4*)(vp + 8);
                    vf[i][s2] = (bf16x8){lo[0], lo[1], lo[2], lo[3], h8[0], h8[1], h8[2], h8[3]}; }
            f32x16 S;
#pragma unroll
            for (int q = 0; q < 16; ++q) S[q] = 0.f;
#pragma unroll
            for (int d0 = 0; d0 < 4; ++d0) S = __builtin_amdgcn_mfma_f32_32x32x16_bf16(kf[d0], qf[d0], S, 0, 0, 0);
            float mx = S[0];
#pragma unroll
            for (int q = 1; q < 16; ++q) mx = fmaxf(mx, S[q]);
            mx = fmaxf(mx, __shfl_xor(mx, 32));
            if (s == 0) mref = mx;
            else if (__any(mx > mref)) { const float mn = fmaxf(mref, mx); const float al = __builtin_amdgcn_exp2f(mref - mn); l *= al; mref = mn;
#pragma unroll
                for (int i = 0; i < 4; ++i)
#pragma unroll
                    for (int q = 0; q < 16; ++q) o[i][q] *= al; }
            float ps = 0.f;
#pragma unroll
            for (int q = 0; q < 16; ++q) { S[q] = __builtin_amdgcn_exp2f(S[q] - mref); ps += S[q]; }
            l += ps;
            bf16x8 pf[2];
#pragma unroll
            for (int s2 = 0; s2 < 2; ++s2) { u32x4 w; w.x = pk2(S[8 * s2], S[8 * s2 + 1]); w.y = pk2(S[8 * s2 + 2], S[8 * s2 + 3]); w.z = pk2(S[8 * s2 + 4], S[8 * s2 + 5]); w.w = pk2(S[8 * s2 + 6], S[8 * s2 + 7]); pf[s2] = __builtin_bit_cast(bf16x8, w); }
#pragma unroll
            for (int i = 0; i < 4; ++i)
#pragma unroll
                for (int s2 = 0; s2 < 2; ++s2) o[i] = __builtin_amdgcn_mfma_f32_32x32x16_bf16(vf[i][s2], pf[s2], o[i], 0, 0, 0);
        }
        l += __shfl_xor(l, 32);
        const float f = (m == 1 ? lmb : 1.0f) / l;
        LAS float* ex = EX + (size_t)m * 128 * 129 + (qs * 32 + r) * 129;
#pragma unroll
        for (int i = 0; i < 4; ++i)
#pragma unroll
            for (int q = 0; q < 16; ++q) ex[32 * i + crow(q, hi)] = o[i][q] * f;
        __syncthreads();
#pragma unroll 1
        for (int rr = 0; rr < 16; ++rr) { const int row = 16 * F.wave + rr;
            const float a0 = EX[row * 129 + F.lane] - EX[128 * 129 + row * 129 + F.lane], a1 = EX[row * 129 + 64 + F.lane] - EX[128 * 129 + row * 129 + 64 + F.lane];
            const float rstd = (1.0f - LAMBDA_INIT) / sqrtf(wave_sum(a0 * a0 + a1 * a1) * (1.f / 128.f) + EPS);
            bf16* yr = Y + (size_t)(qrow0 + row) * D + h * 128;
            yr[F.lane] = (bf16)(pk2(a0 * rstd * ng[F.lane], 0.f) & 0xffffu); yr[64 + F.lane] = (bf16)(pk2(a1 * rstd * ng[64 + F.lane], 0.f) & 0xffffu); }
        __syncthreads();
    }
}

#define PACK8(x, b) __builtin_bit_cast(bf16x8, (u32x4){pk2((x)[(b)], (x)[(b) + 1]), pk2((x)[(b) + 2], (x)[(b) + 3]), pk2((x)[(b) + 4], (x)[(b) + 5]), pk2((x)[(b) + 6], (x)[(b) + 7])})
#define MFMA32(a, b, c) __builtin_amdgcn_mfma_f32_32x32x16_bf16((a), (b), (c), 0, 0, 0)
constexpr int PD_BYTES = 12800, PD_ATT = 6144, PD_EG = 12288, PD_EW = 12544;
__device__ __forceinline__ unsigned off_a(unsigned row, unsigned ch) { return 2048u * (row >> 3) + 512u * (ch >> 2) + 64u * (row & 7) + 16u * ((ch & 3) ^ ((row >> 2) & 3)); }
__device__ __forceinline__ int frag_off(int c, int s) {
    const int slot = (c >> 5) == (s >> 5) ? ((c >> 5) ? 2 : 0) : 1, s2 = (s & 31) >> 4, hh = ((s & 15) >> 2) & 1, jj = ((s & 15) >> 3) * 4 + (s & 3), r = c & 31;
    return slot * 2048 + s2 * 1024 + (hh * 32 + r) * 16 + jj * 2;
}
__device__ __forceinline__ void step_gdn_prep(int j, bool overlap, unsigned* flags, bool dry = false, int skip = 0) {
    const Frame F = make_frame();
    LAS float* STG = (LAS float*)F.lds;
    LAS float* KK = (LAS float*)F.lds;
    LAS float* QK = KK + 64 * 68;
    LAS float* LP = (LAS float*)(F.lds + 34816);
    LAS float* TS = (LAS float*)(F.lds + 67584);
    LAS unsigned char* QI = F.lds + 102400; LAS unsigned char* KI = F.lds + 118784;
    LAS float* SM = (LAS float*)(F.lds + 135168);
    bf16* Z = (bf16*)(F.ws + WS_Z); const float* AB = (const float*)(F.ws + WS_AB); const bf16* HALO = (const bf16*)(F.ws + WS_HALO); unsigned char* PD = F.ws + WS_PD;
    const float* cw = INP(I_GCONV) + (size_t)j * 3 * 3072;
    const int r = F.lane & 31, hi = F.lane >> 5;
    const int first = overlap ? 32 : 0;
    for (int it = F.bid - first; it >= 0 && it < NB * NH * 132; it += F.G - first) {
        int n, bh;
        if (overlap) { bh = it & 15; const int pos = it >> 4;
            if (pos < 4) n = pos == 0 ? 0 : (pos == 1 ? 3 : (pos == 2 ? 1 : 2)); else { const int k = pos - 4; n = (k & 1) ? 131 - (k >> 1) : 4 + (k >> 1); } }
        else { n = it % 132; bh = it / 132; }
        const int b = bh >> 3, h = bh & 7;
        const bool isctx = n < 4; const int L = isctx ? CT : T; const int t0 = isctx ? 64 * n : 64 * (n - 4); const int row0 = (isctx ? ML + b * CT : b * T) + t0;
        if (F.tid < 384) {
            const int g8 = F.tid % 48, rp = F.tid / 48, part = g8 >> 4, e0 = (g8 & 15) * 8; const int col = part * 1024 + h * 128 + e0;
            const float* wp = cw + col;
            f32x4 wt[3][2];
#pragma unroll
            for (int tap = 0; tap < 3; ++tap) { wt[tap][0] = *(const f32x4*)(wp + tap * 3072); wt[tap][1] = *(const f32x4*)(wp + tap * 3072 + 4); }
            u32x4 zr[10];
#pragma unroll
            for (int ri = 0; ri < 10; ++ri) { const int c = 8 * rp - 1 + ri; const int t = t0 + c;
                const bf16* src = c < 0 ? HALO + ((size_t)((row0 >> 6) - 1) * 2 + 1) * 3072 + col : (c > 63 ? HALO + ((size_t)((row0 >> 6) + 1) * 2) * 3072 + col : Z + (size_t)(row0 + c) * 4096 + col);
                const bool valid = t >= 0 && t < L;
                if (!valid) src = Z + (size_t)row0 * 4096 + col;
                zr[ri] = *(const u32x4*)src; if (!valid) zr[ri] = (u32x4){0u, 0u, 0u, 0u}; }
#pragma unroll
            for (int i = 0; i < 8; ++i) { float o[8];
#pragma unroll
                for (int q = 0; q < 4; ++q) { const unsigned a = zr[i][q], bq = zr[i + 1][q], cq = zr[i + 2][q];
                    o[2 * q] = silu_fast(wt[0][q >> 1][2 * (q & 1)] * bf2f(a & 0xffffu) + wt[1][q >> 1][2 * (q & 1)] * bf2f(bq & 0xffffu) + wt[2][q >> 1][2 * (q & 1)] * bf2f(cq & 0xffffu));
                    o[2 * q + 1] = silu_fast(wt[0][q >> 1][2 * (q & 1) + 1] * bf2f(a >> 16) + wt[1][q >> 1][2 * (q & 1) + 1] * bf2f(bq >> 16) + wt[2][q >> 1][2 * (q & 1) + 1] * bf2f(cq >> 16)); }
                LAS f32x4* dst = (LAS f32x4*)(STG + (8 * rp + i) * 388 + part * 128 + e0); dst[0] = (f32x4){o[0], o[1], o[2], o[3]}; dst[1] = (f32x4){o[4], o[5], o[6], o[7]}; }
        }
        if (F.wave >= 6) {
            const int d = F.wave - 6, c = F.lane; const size_t row = (size_t)(row0 + c);
            const float Aco = expf(INP(I_GALOG)[j * 16 + d * 8 + h]), dtb = INP(I_GDT)[j * 16 + d * 8 + h];
            const float x = AB[row * 32 + d * 8 + h] + dtb, bb = AB[row * 32 + 16 + d * 8 + h];
            const float sp = x > 20.f ? x : log1pf(expf(x));
            float s = -Aco * sp;
#pragma unroll
            for (int o = 1; o < 64; o <<= 1) { const float up = __shfl_up(s, o), dn = __shfl_down(s, o); if (d ? (c + o < 64) : (c >= o)) s += d ? dn : up; }
            SM[d * 64 + c] = 1.f / (1.f + expf(-bb)); SM[128 + d * 64 + c] = s;
        }
        __syncthreads();
        if (skip & 8) continue;
        { float qv[8][2], kv[8][2], sq[8], sk[8];
#pragma unroll
            for (int rr = 0; rr < 8; ++rr) { const LAS float* sr = STG + (F.wave * 8 + rr) * 388;
                qv[rr][0] = sr[F.lane]; qv[rr][1] = sr[64 + F.lane]; kv[rr][0] = sr[128 + F.lane]; kv[rr][1] = sr[192 + F.lane];
                sq[rr] = qv[rr][0] * qv[rr][0] + qv[rr][1] * qv[rr][1]; sk[rr] = kv[rr][0] * kv[rr][0] + kv[rr][1] * kv[rr][1]; }
#pragma unroll
            for (int o = 1; o < 64; o <<= 1) {
#pragma unroll
                for (int rr = 0; rr < 8; ++rr) { sq[rr] += __shfl_xor(sq[rr], o); sk[rr] += __shfl_xor(sk[rr], o); } }
#pragma unroll
            for (int rr = 0; rr < 8; ++rr) { const int c = F.wave * 8 + rr; const LAS float* sr = STG + c * 388;
                const float fq = 0.08838834764831845f / sqrtf(sq[rr] + EPS), fk = 1.0f / sqrtf(sk[rr] + EPS);
                const unsigned o0 = off_a(c, F.lane >> 3) + 2 * (F.lane & 7), o1 = off_a(c, 8 + (F.lane >> 3)) + 2 * (F.lane & 7);
                *(LAS bf16*)(QI + o0) = (bf16)(pk2(qv[rr][0] * fq, 0.f) & 0xffffu); *(LAS bf16*)(QI + o1) = (bf16)(pk2(qv[rr][1] * fq, 0.f) & 0xffffu);
                *(LAS bf16*)(KI + o0) = (bf16)(pk2(kv[rr][0] * fk, 0.f) & 0xffffu); *(LAS bf16*)(KI + o1) = (bf16)(pk2(kv[rr][1] * fk, 0.f) & 0xffffu);
                bf16* vd = Z + (size_t)(row0 + c) * 4096 + 2048 + h * 128;
                if (!dry) { vd[F.lane] = (bf16)(pk2(sr[256 + F.lane], 0.f) & 0xffffu); vd[64 + F.lane] = (bf16)(pk2(sr[320 + F.lane], 0.f) & 0xffffu); } } }
        __syncthreads();
        if (skip & 4) continue;
        { const int prod = F.wave >> 2, mt = (F.wave >> 1) & 1, nt = F.wave & 1; LAS unsigned char* AI = prod ? QI : KI;
            f32x16 acc;
#pragma unroll
            for (int i = 0; i < 16; ++i) acc[i] = 0.f;
#pragma unroll
            for (int ks = 0; ks < 8; ++ks) { const bf16x8 a = *(const LAS bf16x8*)(AI + off_a(32 * mt + r, 2 * ks + hi)), bq = *(const LAS bf16x8*)(KI + off_a(32 * nt + r, 2 * ks + hi));
                acc = __builtin_amdgcn_mfma_f32_32x32x16_bf16(a, bq, acc, 0, 0, 0); }
            LAS float* dst = prod ? QK : KK;
#pragma unroll
            for (int i = 0; i < 16; ++i) dst[(32 * mt + crow(i, hi)) * 68 + 32 * nt + r] = acc[i]; }
        __syncthreads();
        if (skip & 2) continue;
        for (int idx = F.tid; idx < 8192; idx += NTHR) { const int d = idx >> 12, p = (idx >> 6) & 63, ps = idx & 63; float val = 0.f;
            if (ps < p) { const int c = d ? 63 - p : p, s = d ? 63 - ps : ps; val = SM[d * 64 + c] * KK[c * 68 + s] * expf(SM[128 + d * 64 + c] - SM[128 + d * 64 + s]); }
            LP[idx] = val; }
        __syncthreads();
        unsigned char* rec = PD + ((size_t)((b * 8 + h) * 132 + n)) * PD_BYTES;
        constexpr size_t DSTRIDE = (size_t)16 * 132 * PD_BYTES;
        float Tc[32];
#pragma unroll
        for (int p = 0; p < 32; ++p) Tc[p] = 0.f;
        if (F.wave < 4) { if (!(skip & 1)) {
            const int d = F.wave >> 1, blk = F.wave & 1, jj = F.lane & 31;
            float Lr[32];
#pragma unroll
            for (int p = 1; p < 32; ++p) Lr[p] = LP[d * 4096 + (32 * blk + p) * 64 + 32 * blk + jj];
#pragma unroll
            for (int p = 0; p < 32; ++p) { float acc[4]; acc[0] = (p == jj) ? 1.f : 0.f; acc[1] = 0.f; acc[2] = 0.f; acc[3] = 0.f;
#pragma unroll
                for (int sx = 0; sx < p; ++sx) { const float l = __int_as_float(__builtin_amdgcn_readlane(__float_as_int(Lr[p]), sx)); acc[sx & 3] -= l * Tc[sx]; }
                Tc[p] = (acc[0] + acc[1]) + (acc[2] + acc[3]); }
            if (F.lane < 32) { const int pc = 32 * blk + jj;
#pragma unroll
                for (int p = 0; p < 32; ++p) { const int pr = 32 * blk + p; TS[d * 4352 + (d ? 63 - pr : pr) * 68 + (d ? 63 - pc : pc)] = Tc[p]; } } }
        } else {
            for (int q = F.tid - 256; q < 768; q += NTHR - 256) { const int d = q / 384, qq = q % 384, slot = qq >> 7, s2 = (qq >> 6) & 1, ln = qq & 63, hh = ln >> 5, rr = ln & 31;
                const int mtr = slot == 0 ? 0 : (slot == 2 ? 1 : (d ? 0 : 1)), mtc = slot == 0 ? 0 : (slot == 2 ? 1 : (d ? 1 : 0));
                const int c = 32 * mtr + rr, sa = 32 * mtc + 16 * s2 + 4 * hh; const float gcc = SM[128 + d * 64 + c];
                const f32x4 qa = *(const LAS f32x4*)(QK + c * 68 + sa), qb = *(const LAS f32x4*)(QK + c * 68 + sa + 8);
                const f32x4 ga = *(const LAS f32x4*)(SM + 128 + d * 64 + sa), gb = *(const LAS f32x4*)(SM + 128 + d * 64 + sa + 8);
                float v[8];
#pragma unroll
                for (int i = 0; i < 4; ++i) { const int s0 = sa + i, s1 = sa + 8 + i; const bool m0 = d ? (s0 >= c) : (s0 <= c), m1 = d ? (s1 >= c) : (s1 <= c);
                    v[i] = m0 ? qa[i] * expf(gcc - ga[i]) : 0.f; v[4 + i] = m1 ? qb[i] * expf(gcc - gb[i]) : 0.f; }
                if (!dry) *(u32x4*)(rec + d * DSTRIDE + PD_ATT + qq * 16) = (u32x4){pk2(v[0], v[1]), pk2(v[2], v[3]), pk2(v[4], v[5]), pk2(v[6], v[7])}; }
            if (F.tid >= 256 && F.tid < 384) { const int d = (F.tid - 256) >> 6, c = F.tid & 63; const float gl = SM[128 + d * 64 + (d ? 0 : 63)], gcv = SM[128 + d * 64 + c];
                if (!dry) { *(float*)(rec + d * DSTRIDE + PD_EG + 4 * c) = expf(gcv); *(float*)(rec + d * DSTRIDE + PD_EW + 4 * c) = expf(gl - gcv); } }
        }
        __syncthreads();
        if ((F.wave == 0 || F.wave == 2) && !(skip & 1)) {
            const int d = F.wave >> 1;
            f32x16 Mx, R2;
#pragma unroll
            for (int i = 0; i < 16; ++i) { Mx[i] = 0.f; R2[i] = 0.f; }
#define INV_M(ks) do { const LAS f32x4* lp = (const LAS f32x4*)(LP + d * 4096 + (32 + r) * 64 + 16 * (ks) + 8 * hi); const f32x4 l0 = lp[0], l1 = lp[1]; \
                const bf16x8 A_ = __builtin_bit_cast(bf16x8, (u32x4){pk2(l0[0], l0[1]), pk2(l0[2], l0[3]), pk2(l1[0], l1[1]), pk2(l1[2], l1[3])}); \
                const bf16x8 B_ = __builtin_bit_cast(bf16x8, (u32x4){pk2(hi ? Tc[16 * (ks) + 8] : Tc[16 * (ks)], hi ? Tc[16 * (ks) + 9] : Tc[16 * (ks) + 1]), pk2(hi ? Tc[16 * (ks) + 10] : Tc[16 * (ks) + 2], hi ? Tc[16 * (ks) + 11] : Tc[16 * (ks) + 3]), \
                    pk2(hi ? Tc[16 * (ks) + 12] : Tc[16 * (ks) + 4], hi ? Tc[16 * (ks) + 13] : Tc[16 * (ks) + 5]), pk2(hi ? Tc[16 * (ks) + 14] : Tc[16 * (ks) + 6], hi ? Tc[16 * (ks) + 15] : Tc[16 * (ks) + 7])}); \
                Mx = MFMA32(A_, B_, Mx); } while (0)
            INV_M(0); INV_M(1);
#undef INV_M
#pragma unroll
            for (int ks = 0; ks < 2; ++ks) {
                const int cn = d ? 31 - r : 32 + r, ps0 = 32 + 16 * ks + 4 * hi;
                f32x4 ta, tb;
                if (d) { const f32x4 x0 = *(const LAS f32x4*)(TS + 4352 + cn * 68 + (60 - ps0)), x1 = *(const LAS f32x4*)(TS + 4352 + cn * 68 + (52 - ps0));
                    ta = (f32x4){x0[3], x0[2], x0[1], x0[0]}; tb = (f32x4){x1[3], x1[2], x1[1], x1[0]}; }
                else { ta = *(const LAS f32x4*)(TS + cn * 68 + ps0); tb = *(const LAS f32x4*)(TS + cn * 68 + ps0 + 8); }
                const bf16x8 A2 = __builtin_bit_cast(bf16x8, (u32x4){pk2(ta[0], ta[1]), pk2(ta[2], ta[3]), pk2(tb[0], tb[1]), pk2(tb[2], tb[3])});
                const bf16x8 B2 = ks == 0 ? PACK8(Mx, 0) : PACK8(Mx, 8);
                R2 = MFMA32(A2, B2, R2); }
#pragma unroll
            for (int i = 0; i < 16; ++i) { const int pr = 32 + crow(i, hi), pc = r; TS[d * 4352 + (d ? 63 - pr : pr) * 68 + (d ? 63 - pc : pc)] = -R2[i]; }
        }
        __syncthreads();
        for (int q = F.tid; q < 768; q += NTHR) { const int d = q / 384, qq = q % 384, slot = qq >> 7, s2 = (qq >> 6) & 1, ln = qq & 63, hh = ln >> 5, rr = ln & 31;
            const int mtr = slot == 0 ? 0 : (slot == 2 ? 1 : (d ? 0 : 1)), mtc = slot == 0 ? 0 : (slot == 2 ? 1 : (d ? 1 : 0));
            const int c = 32 * mtr + rr, sa = 32 * mtc + 16 * s2 + 4 * hh;
            const f32x4 ta = *(const LAS f32x4*)(TS + d * 4352 + c * 68 + sa), tb = *(const LAS f32x4*)(TS + d * 4352 + c * 68 + sa + 8);
            const f32x4 ba = *(const LAS f32x4*)(SM + d * 64 + sa), bb = *(const LAS f32x4*)(SM + d * 64 + sa + 8);
            if (!dry) *(u32x4*)(rec + d * DSTRIDE + qq * 16) = (u32x4){pk2(ta[0] * ba[0], ta[1] * ba[1]), pk2(ta[2] * ba[2], ta[3] * ba[3]), pk2(tb[0] * bb[0], tb[1] * bb[1]), pk2(tb[2] * bb[2], tb[3] * bb[3])}; }
        if (!dry) for (int idx = F.tid; idx < 2048; idx += NTHR) { const int img = idx >> 10, pn = idx & 1023;
            *(u32x4*)((unsigned char*)(Z + (size_t)(row0 + (pn >> 4)) * 4096 + img * 1024 + h * 128) + (pn & 15) * 16) = *(const LAS u32x4*)((img ? KI : QI) + pn * 16); }
        if (overlap && !dry) {
            asm volatile("s_waitcnt vmcnt(0)" ::: "memory");
            __syncthreads();
            if (F.tid == 0) { __builtin_amdgcn_fence(__ATOMIC_RELEASE, "agent"); asm volatile("s_waitcnt vmcnt(0)" ::: "memory");
                __hip_atomic_store(flags + bh * 132 + n, 1u, __ATOMIC_RELAXED, __HIP_MEMORY_SCOPE_AGENT); }
        }
        __syncthreads();
    }
}

typedef short v4i16_t __attribute__((ext_vector_type(4)));
__device__ __forceinline__ void step_convert_rest() {
    const Frame F = make_frame();
    if (F.bid >= 32 && F.G > 32)
        convert_weights(F.ws, 0xffffu & ~((1u << 0) | (1u << 4) | (1u << 8) | (1u << 10)), (F.bid - 32) * NWAVES + F.wave, (F.G - 32) * NWAVES, (F.bid - 32) * NTHR + F.tid, (F.G - 32) * NTHR, F.lds, F.wave, F.lane);
}
__device__ __forceinline__ void step_gdn_scan2(const unsigned* flags, int mode = 0) {
    const Frame F = make_frame();
    constexpr int BUF = 61952, B_K = 0, B_Q = 16384, B_V = 32768, B_PD = 49152;
    const bf16* Z = (const bf16*)(F.ws + WS_Z); const unsigned char* PD = F.ws + WS_PD;
    const int r = F.lane & 31, hi = F.lane >> 5;
    for (int it = F.bid; it < 32; it += F.G) {
        const int b = it >> 4, h = (it >> 1) & 7, dir = it & 1;
        const unsigned char* pdb = PD + (size_t)(((dir * 2 + b) * 8 + h) * 132) * PD_BYTES;
#define CHUNK_OF(sp) (dir ? ((sp) < 4 ? 3 - (sp) : 135 - (sp)) : (sp))
#define ROW0_OF(n) ((n) < 4 ? ML + b * CT + 64 * (n) : b * T + 64 * ((n) - 4))
        if (F.wave >= 4) {
            const int lt = F.tid - 256;
            u32x4 rg[16];
#define LOAD_CHUNK(sp) do { const int n_ = CHUNK_OF(sp); const int row0_ = ROW0_OF(n_); \
                _Pragma("unroll") for (int i = 0; i < 4; ++i) { const int pn = lt + 256 * i; const unsigned char* src = (const unsigned char*)(Z + (size_t)(row0_ + (pn >> 4)) * 4096 + h * 128) + (pn & 15) * 16; \
                    rg[i] = *(const u32x4*)(src + 2048); rg[4 + i] = *(const u32x4*)src; rg[8 + i] = *(const u32x4*)(src + 4096); \
                    rg[12 + i] = pn < 800 ? *(const u32x4*)(pdb + (size_t)n_ * PD_BYTES + pn * 16) : (u32x4){0u, 0u, 0u, 0u}; } } while (0)
#define WRITE_CHUNK(bufb) do { LAS unsigned char* base_ = F.lds + (bufb); \
                _Pragma("unroll") for (int i = 0; i < 4; ++i) { const int pn = lt + 256 * i; *(LAS u32x4*)(base_ + B_K + pn * 16) = rg[i]; *(LAS u32x4*)(base_ + B_Q + pn * 16) = rg[4 + i]; \
                    *(LAS u32x4*)(base_ + B_V + pn * 16) = rg[8 + i]; if (pn < 800) *(LAS u32x4*)(base_ + B_PD + pn * 16) = rg[12 + i]; } } while (0)
#define WAIT_CHUNK(sp) do { if (flags && F.wave == 4) { const unsigned* f_ = flags + (b * 8 + h) * 132 + CHUNK_OF(sp); unsigned spins_ = 0; \
                    while (__hip_atomic_load(f_, __ATOMIC_RELAXED, __HIP_MEMORY_SCOPE_AGENT) == 0u) { __builtin_amdgcn_s_sleep(2); if (++spins_ > (1u << 24)) break; } \
                    __builtin_amdgcn_fence(__ATOMIC_ACQUIRE, "agent"); asm volatile("s_waitcnt vmcnt(0)" ::: "memory"); } } while (0)
            WAIT_CHUNK(0); WAIT_CHUNK(1);
            __syncthreads();
            LOAD_CHUNK(0); WRITE_CHUNK(0); WAIT_CHUNK(2); LOAD_CHUNK(1);
            __syncthreads();
            for (int sp = 0; sp < 132; ++sp) {
                if (sp + 1 < 132) WRITE_CHUNK(((sp + 1) & 1) * BUF);
                if (sp + 3 < 132) WAIT_CHUNK(sp + 3);
                if (sp + 2 < 132) LOAD_CHUNK(sp + 2);
                __syncthreads();
            }
#undef WAIT_CHUNK
#undef LOAD_CHUNK
#undef WRITE_CHUNK
        } else {
            const int w = F.wave;
            f32x16 S[4];
#pragma unroll
            for (int kt = 0; kt < 4; ++kt)
#pragma unroll
                for (int i = 0; i < 16; ++i) S[kt][i] = 0.f;
            const int x = (r >> 2) & 3; const int rowb = 2048 * (r >> 3) + 64 * (r & 7);
            int oa[2], ob[2];
#pragma unroll
            for (int s2 = 0; s2 < 2; ++s2) { oa[s2] = rowb + 16 * ((2 * s2) ^ x) + 8 * hi; ob[s2] = rowb + 16 * ((2 * s2 + 1) ^ x) + 8 * hi; }
            const int blk = (F.lane >> 4) & 1, q = (F.lane & 15) >> 2, p = F.lane & 3, cb = 2 * blk + (p >> 1);
            int trb[2];
#pragma unroll
            for (int t = 0; t < 2; ++t) trb[t] = 64 * (4 * hi + q) + 8 * (p & 1) + 16 * (cb ^ ((2 * t + hi) & 3)) + 2048 * t;
            const int vb = 4 * hi * 256 + (32 * w + r) * 2;
            __syncthreads();
            __syncthreads();
            for (int sp = 0; sp < 132; ++sp) {
                const int n = CHUNK_OF(sp); const int row0 = ROW0_OF(n);
                LAS unsigned char* B = F.lds + (sp & 1) * BUF;
                LAS unsigned char* KI = B + B_K; LAS unsigned char* QI = B + B_Q; LAS unsigned char* VI = B + B_V; LAS unsigned char* PR = B + B_PD;
                bf16x8 Sb[4][2];
#pragma unroll
                for (int kt = 0; kt < 4; ++kt) { Sb[kt][0] = PACK8(S[kt], 0); Sb[kt][1] = PACK8(S[kt], 8); }
                f32x16 KS[2];
#pragma unroll
                for (int i = 0; i < 16; ++i) { KS[0][i] = 0.f; KS[1][i] = 0.f; }
#pragma unroll
                for (int kt = 0; kt < 4; ++kt) {
#pragma unroll
                    for (int s2 = 0; s2 < 2; ++s2)
#pragma unroll
                        for (int mt = 0; mt < 2; ++mt) {
                            const s16x4 k0 = *(const LAS s16x4*)(KI + 8192 * mt + 512 * kt + oa[s2]), k1 = *(const LAS s16x4*)(KI + 8192 * mt + 512 * kt + ob[s2]);
                            KS[mt] = MFMA32(((bf16x8){k0[0], k0[1], k0[2], k0[3], k1[0], k1[1], k1[2], k1[3]}), Sb[kt][s2], KS[mt]); }
                    asm volatile("" ::: "memory");
                }
                bf16x8 Rb[2][2];
#pragma unroll
                for (int mt = 0; mt < 2; ++mt) { f32x16 R;
#pragma unroll
                    for (int g = 0; g < 4; ++g) { const f32x4 e4 = *(const LAS f32x4*)(PR + PD_EG + 4 * (32 * mt + 8 * g + 4 * hi));
#pragma unroll
                        for (int i = 0; i < 4; ++i) { const float v = bf2f(*(const LAS bf16*)(VI + vb + (32 * mt + 8 * g + i) * 256)); R[4 * g + i] = v - e4[i] * KS[mt][4 * g + i]; } }
                    Rb[mt][0] = PACK8(R, 0); Rb[mt][1] = PACK8(R, 8); }
                f32x16 vn[2], o[2];
#pragma unroll
                for (int i = 0; i < 16; ++i) { vn[0][i] = 0.f; vn[1][i] = 0.f; }
#define TFR(base, slot, s2) (*(const LAS bf16x8*)(PR + (base) + (slot) * 2048 + (s2) * 1024 + F.lane * 16))
                vn[0] = MFMA32(TFR(0, 0, 0), Rb[0][0], vn[0]); vn[0] = MFMA32(TFR(0, 0, 1), Rb[0][1], vn[0]);
                vn[1] = MFMA32(TFR(0, 2, 0), Rb[1][0], vn[1]); vn[1] = MFMA32(TFR(0, 2, 1), Rb[1][1], vn[1]);
                if (dir) { vn[0] = MFMA32(TFR(0, 1, 0), Rb[1][0], vn[0]); vn[0] = MFMA32(TFR(0, 1, 1), Rb[1][1], vn[0]); }
                else     { vn[1] = MFMA32(TFR(0, 1, 0), Rb[0][0], vn[1]); vn[1] = MFMA32(TFR(0, 1, 1), Rb[0][1], vn[1]); }
                asm volatile("" ::: "memory");
                f32x16 QS[2];
#pragma unroll
                for (int i = 0; i < 16; ++i) { QS[0][i] = 0.f; QS[1][i] = 0.f; }
                if (!(mode & 2))
#pragma unroll
                for (int kt = 0; kt < 4; ++kt) {
#pragma unroll
                    for (int s2 = 0; s2 < 2; ++s2)
#pragma unroll
                        for (int mt = 0; mt < 2; ++mt) {
                            const s16x4 q0 = *(const LAS s16x4*)(QI + 8192 * mt + 512 * kt + oa[s2]), q1 = *(const LAS s16x4*)(QI + 8192 * mt + 512 * kt + ob[s2]);
                            QS[mt] = MFMA32(((bf16x8){q0[0], q0[1], q0[2], q0[3], q1[0], q1[1], q1[2], q1[3]}), Sb[kt][s2], QS[mt]); }
                    asm volatile("" ::: "memory");
                }
                bf16x8 Vb[2][2], Wb[2][2];
#pragma unroll
                for (int mt = 0; mt < 2; ++mt) { f32x16 W;
#pragma unroll
                    for (int g = 0; g < 4; ++g) { const f32x4 e4 = *(const LAS f32x4*)(PR + PD_EG + 4 * (32 * mt + 8 * g + 4 * hi)), w4 = *(const LAS f32x4*)(PR + PD_EW + 4 * (32 * mt + 8 * g + 4 * hi));
#pragma unroll
                        for (int i = 0; i < 4; ++i) { o[mt][4 * g + i] = e4[i] * QS[mt][4 * g + i]; W[4 * g + i] = w4[i] * vn[mt][4 * g + i]; } }
                    Vb[mt][0] = PACK8(vn[mt], 0); Vb[mt][1] = PACK8(vn[mt], 8); Wb[mt][0] = PACK8(W, 0); Wb[mt][1] = PACK8(W, 8); }
                if (!(mode & 2)) {
                o[0] = MFMA32(TFR(PD_ATT, 0, 0), Vb[0][0], o[0]); o[0] = MFMA32(TFR(PD_ATT, 0, 1), Vb[0][1], o[0]);
                o[1] = MFMA32(TFR(PD_ATT, 2, 0), Vb[1][0], o[1]); o[1] = MFMA32(TFR(PD_ATT, 2, 1), Vb[1][1], o[1]);
                if (dir) { o[0] = MFMA32(TFR(PD_ATT, 1, 0), Vb[1][0], o[0]); o[0] = MFMA32(TFR(PD_ATT, 1, 1), Vb[1][1], o[0]); }
                else     { o[1] = MFMA32(TFR(PD_ATT, 1, 0), Vb[0][0], o[1]); o[1] = MFMA32(TFR(PD_ATT, 1, 1), Vb[0][1], o[1]); }
                }
#undef TFR
                asm volatile("" ::: "memory");
                const float cd = *(const LAS float*)(PR + PD_EG + 4 * (dir ? 0 : 63));
#pragma unroll
                for (int kt = 0; kt < 4; ++kt)
#pragma unroll
                    for (int i = 0; i < 16; ++i) S[kt][i] *= cd;
#pragma unroll
                for (int mt = 0; mt < 2; ++mt)
#pragma unroll
                    for (int s2 = 0; s2 < 2; ++s2) {
#pragma unroll
                        for (int kt = 0; kt < 4; ++kt) {
                            const s16x4 a0 = __builtin_bit_cast(s16x4, __builtin_amdgcn_ds_read_tr16_b64_v4i16((LAS v4i16_t*)(KI + 8192 * mt + 4096 * s2 + 512 * kt + trb[0])));
                            const s16x4 a1 = __builtin_bit_cast(s16x4, __builtin_amdgcn_ds_read_tr16_b64_v4i16((LAS v4i16_t*)(KI + 8192 * mt + 4096 * s2 + 512 * kt + trb[1])));
                            S[kt] = MFMA32(((bf16x8){a0[0], a0[1], a0[2], a0[3], a1[0], a1[1], a1[2], a1[3]}), Wb[mt][s2], S[kt]); }
                        asm volatile("" ::: "memory");
                    }
                if (!(mode & 1)) { bf16* ob_ = n < 4 ? (bf16*)(F.ws + WS_OFC) + ((size_t)dir * MC + (row0 - ML)) * D : (bf16*)F.out + ((size_t)dir * ML + row0) * D;
                    bf16* oc = ob_ + h * 128 + 32 * w + r;
#pragma unroll
                    for (int mt = 0; mt < 2; ++mt)
#pragma unroll
                        for (int i = 0; i < 16; ++i) oc[(size_t)(32 * mt + crow(i, hi)) * D] = (bf16)(pk2(o[mt][i], 0.f) & 0xffffu); }
                __syncthreads();
            }
        }
#undef CHUNK_OF
#undef ROW0_OF
    }
}
__device__ __forceinline__ void step_gdn_norm2(int j) {
    const Frame F = make_frame();
    const int gw = F.bid * NWAVES + F.wave, NGW = F.G * NWAVES;
    const bf16* Z = (const bf16*)(F.ws + WS_Z); bf16* Y = (bf16*)(F.ws + WS_Y); const float* ng = INP(I_GNG) + j * 128;
    for (int row = gw; row < M; row += NGW) {
        const bf16* of = row < ML ? (const bf16*)F.out + (size_t)row * D : (const bf16*)(F.ws + WS_OFC) + (size_t)(row - ML) * D;
        const bf16* ob = row < ML ? of + (size_t)ML * D : of + (size_t)MC * D;
        const u32x4* f4 = (const u32x4*)(of + 16 * F.lane); const u32x4* b4 = (const u32x4*)(ob + 16 * F.lane);
        float v[16]; float ss = 0.f;
#pragma unroll
        for (int q = 0; q < 2; ++q) { const u32x4 a = f4[q], bq = b4[q];
#pragma unroll
            for (int i = 0; i < 4; ++i) { const float x0 = bf2f(a[i] & 0xffffu) + bf2f(bq[i] & 0xffffu), x1 = bf2f(a[i] >> 16) + bf2f(bq[i] >> 16); v[8 * q + 2 * i] = x0; v[8 * q + 2 * i + 1] = x1; ss += x0 * x0 + x1 * x1; } }
        ss += __shfl_xor(ss, 1); ss += __shfl_xor(ss, 2); ss += __shfl_xor(ss, 4);
        const float rstd = 1.0f / sqrtf(ss * (1.f / 128.f) + EPS);
        const u32x4* g4 = (const u32x4*)(Z + (size_t)row * 4096 + 3072 + 16 * F.lane);
        const int e0 = (16 * F.lane) & 127;
        u32x4 o[2];
#pragma unroll
        for (int q = 0; q < 2; ++q) { const u32x4 gz = g4[q]; unsigned wv[4];
#pragma unroll
            for (int i = 0; i < 4; ++i) { const unsigned gg = gz[i]; const float g0 = bf2f(gg & 0xffffu), g1 = bf2f(gg >> 16); const int e = e0 + 8 * q + 2 * i;
                wv[i] = pk2(v[8 * q + 2 * i] * rstd * ng[e] * silu_f(g0), v[8 * q + 2 * i + 1] * rstd * ng[e + 1] * silu_f(g1)); }
            o[q] = (u32x4){wv[0], wv[1], wv[2], wv[3]}; }
        u32x4* dst = (u32x4*)(Y + (size_t)row * D + 16 * F.lane); dst[0] = o[0]; dst[1] = o[1];
    }
}

__device__ __forceinline__ void step_rope2() {
    const Frame F = make_frame();
    const int gw = F.bid * NWAVES + F.wave, NGW = F.G * NWAVES;
    bf16* Z = (bf16*)(F.ws + WS_Z); const f32x4* R = (const f32x4*)(F.ws + WS_ROPE);
    for (int row = gw; row < M; row += NGW) {
        u32x4* p = (u32x4*)(Z + (size_t)row * 3072 + 32 * F.lane);
        u32x4 v[4];
#pragma unroll
        for (int q = 0; q < 4; ++q) v[q] = p[q];
        const bool lat = row < ML; const float sc = F.lane < 32 ? QSCALE : 1.0f;
        const f32x4* tab = R + ((size_t)(row & (T - 1)) * 32 + 16 * (F.lane & 1)) / 2;
#pragma unroll
        for (int q = 0; q < 4; ++q) {
#pragma unroll
            for (int i = 0; i < 4; i += 2) {
                f32x4 cs = (f32x4){1.f, 0.f, 1.f, 0.f}; if (lat) cs = tab[(4 * q + i) / 2];
                { const unsigned w = v[q][i]; const float x0 = bf2f(w & 0xffffu), x1 = bf2f(w >> 16); v[q][i] = pk2((x0 * cs.x - x1 * cs.y) * sc, (x0 * cs.y + x1 * cs.x) * sc); }
                { const unsigned w = v[q][i + 1]; const float x0 = bf2f(w & 0xffffu), x1 = bf2f(w >> 16); v[q][i + 1] = pk2((x0 * cs.z - x1 * cs.w) * sc, (x0 * cs.w + x1 * cs.z) * sc); }
            }
        }
#pragma unroll
        for (int q = 0; q < 4; ++q) p[q] = v[q];
    }
}
#define ATT_THR 4.0f
__device__ __forceinline__ void att_softmax(f32x16& p0, f32x16& p1, float& m_reg, float& l, float& alpha, bf16x8 (&pf)[2][2]) {
    float mx = fmaxf(p0[0], p1[0]);
#pragma unroll
    for (int q = 1; q < 16; ++q) mx = fmaxf(mx, fmaxf(p0[q], p1[q]));
    mx = fmaxf(mx, __shfl_xor(mx, 32));
    const float mn = (mx - m_reg > ATT_THR) ? mx : m_reg; alpha = __builtin_amdgcn_exp2f(m_reg - mn); m_reg = mn;
    float ps = 0.f;
#pragma unroll
    for (int q = 0; q < 16; ++q) { p0[q] = __builtin_amdgcn_exp2f(p0[q] - m_reg); p1[q] = __builtin_amdgcn_exp2f(p1[q] - m_reg); ps += p0[q] + p1[q]; }
    l = l * alpha + ps;
    pf[0][0] = PACK8(p0, 0); pf[0][1] = PACK8(p0, 8); pf[1][0] = PACK8(p1, 0); pf[1][1] = PACK8(p1, 8);
}
__device__ __forceinline__ void step_attn2() {
    const Frame F = make_frame();
    const bf16* Z = (const bf16*)(F.ws + WS_Z); bf16* Y = (bf16*)(F.ws + WS_Y);
    LAS float* EX = (LAS float*)F.lds;
    constexpr int KB0 = 0, VB0 = 65536;
    const int r = F.lane & 31, hi = F.lane >> 5, qs = F.wave & 3, m = F.wave >> 2;
    float lmb;
    { const float* lam = INP(I_DLAM); const float t1 = lam[F.lane] * lam[64 + F.lane], t2 = lam[128 + F.lane] * lam[192 + F.lane]; lmb = expf(wave_sum(t1)) - expf(wave_sum(t2)) + LAMBDA_INIT; }
    const float* ng = INP(I_DNG);
    const int kro = 2048 * (r >> 3) + 64 * (r & 7); const int xk = (r >> 2) & 3;
    int koff[2];
#pragma unroll
    for (int d0 = 0; d0 < 2; ++d0) koff[d0] = kro + 1024 * m + 16 * (((2 * d0 + hi) & 3) ^ xk);
    const int blk = (F.lane >> 4) & 1, q4 = (F.lane & 15) >> 2, p4 = F.lane & 3, cb = 2 * blk + (p4 >> 1);
    int trb[2];
#pragma unroll
    for (int t = 0; t < 2; ++t) trb[t] = 64 * (4 * hi + q4) + 8 * (p4 & 1) + 16 * (cb ^ ((2 * t + hi) & 3)) + 2048 * t;
    const int drow = 8 * F.wave + ((F.lane & 31) >> 2);
    const unsigned goff = (unsigned)(drow * 6144 + 16 * (4 * (F.lane >> 5) + ((F.lane & 3) ^ ((drow >> 2) & 3))));
    const unsigned ldsw = (unsigned)F.wave * 2048u;
    const int xcd = F.bid & 7, cux = F.bid >> 3;
    for (int ui = 0; ui < 5; ++ui) {
        int b, h, qrow0, nt;
        if (F.G == 256) {
            h = xcd;
            if (ui < 4) { b = ui >> 1; qrow0 = b * T + (cux + 32 * (ui & 1)) * 128; nt = NKV / 64; }
            else { if (cux >= 4) break; b = cux >> 1; qrow0 = ML + b * CT + (cux & 1) * 128; nt = CT / 64; }
        } else {
            const int u = F.bid + ui * F.G; if (u >= 1056) break;
            if (u < 1024) { b = u >> 9; h = (u >> 6) & 7; qrow0 = b * T + (u & 63) * 128; nt = NKV / 64; }
            else { const int v = u - 1024; b = v >> 4; h = (v >> 1) & 7; qrow0 = ML + b * CT + (v & 1) * 128; nt = CT / 64; }
        }
        const int row0 = qrow0 + 32 * qs;
        bf16x8 qf[4];
#pragma unroll
        for (int d0 = 0; d0 < 4; ++d0) qf[d0] = *(const bf16x8*)(Z + (size_t)(row0 + r) * 3072 + h * 128 + m * 64 + d0 * 16 + hi * 8);
        asm volatile("" : "+v"(qf[0]), "+v"(qf[1]), "+v"(qf[2]), "+v"(qf[3]));
        asm volatile("s_waitcnt vmcnt(0)" ::: "memory");
        const char* kgb = (const char*)(Z + 1024 + h * 128); const char* vgb = (const char*)(Z + 2048 + h * 128);
#define KVROW(t) ((t) < CT / 64 ? ML + b * CT + 64 * (t) : b * T + 64 * (t) - CT)
#define DMAK(t) do { const int t_ = (t) < nt ? (t) : nt - 1; const char* g_ = kgb + (size_t)KVROW(t_) * 6144 + goff; LAS unsigned char* d_ = F.lds + KB0 + ((t) & 3) * 16384 + ldsw; \
            __builtin_amdgcn_global_load_lds((const unsigned*)g_, (LAS unsigned*)d_, 16, 0, 0); __builtin_amdgcn_global_load_lds((const unsigned*)(g_ + 128), (LAS unsigned*)(d_ + 1024), 16, 0, 0); } while (0)
#define DMAV(t) do { const int t_ = (t) < nt ? (t) : nt - 1; const char* g_ = vgb + (size_t)KVROW(t_) * 6144 + goff; LAS unsigned char* d_ = F.lds + VB0 + ((t) & 3) * 16384 + ldsw; \
            __builtin_amdgcn_global_load_lds((const unsigned*)g_, (LAS unsigned*)d_, 16, 0, 0); __builtin_amdgcn_global_load_lds((const unsigned*)(g_ + 128), (LAS unsigned*)(d_ + 1024), 16, 0, 0); } while (0)
#define WAIT_BAR(N) do { asm volatile("s_waitcnt vmcnt(" #N ") lgkmcnt(0)" ::: "memory"); __builtin_amdgcn_s_barrier(); asm volatile("" ::: "memory"); } while (0)
#define QKT(P0, P1, t) do { LAS unsigned char* KI_ = F.lds + KB0 + ((t) & 3) * 16384; \
            _Pragma("unroll") for (int q_ = 0; q_ < 16; ++q_) { P0[q_] = 0.f; P1[q_] = 0.f; } \
            _Pragma("unroll") for (int d0 = 0; d0 < 4; ++d0) { const bf16x8 k0_ = *(const LAS bf16x8*)(KI_ + 512 * (d0 >> 1) + koff[d0 & 1]), k1_ = *(const LAS bf16x8*)(KI_ + 8192 + 512 * (d0 >> 1) + koff[d0 & 1]); \
                P0 = MFMA32(k0_, qf[d0], P0); P1 = MFMA32(k1_, qf[d0], P1); if (d0 & 1) asm volatile("" ::: "memory"); } } while (0)
#define PV1(t, PF, i) do { LAS unsigned char* VI_ = F.lds + VB0 + ((t) & 3) * 16384; \
            _Pragma("unroll") for (int kh = 0; kh < 2; ++kh) _Pragma("unroll") for (int s2 = 0; s2 < 2; ++s2) { \
                const s16x4 a0_ = __builtin_bit_cast(s16x4, __builtin_amdgcn_ds_read_tr16_b64_v4i16((LAS v4i16_t*)(VI_ + 8192 * kh + 4096 * s2 + 512 * (i) + trb[0]))); \
                const s16x4 a1_ = __builtin_bit_cast(s16x4, __builtin_amdgcn_ds_read_tr16_b64_v4i16((LAS v4i16_t*)(VI_ + 8192 * kh + 4096 * s2 + 512 * (i) + trb[1]))); \
                o[i] = MFMA32(((bf16x8){a0_[0], a0_[1], a0_[2], a0_[3], a1_[0], a1_[1], a1_[2], a1_[3]}), PF[kh][s2], o[i]); if (s2 == 1) asm volatile("" ::: "memory"); } } while (0)
#define PVT(t, PF) do { PV1(t, PF, 0); PV1(t, PF, 1); PV1(t, PF, 2); PV1(t, PF, 3); } while (0)
#define SM_MAX() do { float mx_ = fmaxf(c0[0], c1[0]); _Pragma("unroll") for (int q_ = 1; q_ < 16; ++q_) mx_ = fmaxf(mx_, fmaxf(c0[q_], c1[q_])); \
            mx_ = fmaxf(mx_, __shfl_xor(mx_, 32)); const float mn_ = (mx_ - mref > ATT_THR) ? mx_ : mref; al = __builtin_amdgcn_exp2f(mref - mn_); mref = mn_; ps = 0.f; } while (0)
#define SM_EXP(C, B, DST) do { _Pragma("unroll") for (int q_ = 0; q_ < 8; ++q_) { C[(B) + q_] = __builtin_amdgcn_exp2f(C[(B) + q_] - mref); ps += C[(B) + q_]; } DST = PACK8(C, B); } while (0)
#define RESC(al) do { if (__any((al) < 1.f)) { _Pragma("unroll") for (int i = 0; i < 4; ++i) _Pragma("unroll") for (int q_ = 0; q_ < 16; ++q_) o[i][q_] *= (al); } } while (0)
#define SBAR() __builtin_amdgcn_sched_barrier(0)
#define ATT_STEP(j, PFC, PFP) do { \
            WAIT_BAR(8); DMAK((j) + 3); DMAV((j) + 2); \
            SBAR(); QKT(c0, c1, j); SBAR(); \
            PV1((j) - 1, PFP, 0); SM_MAX(); SBAR(); \
            PV1((j) - 1, PFP, 1); SM_EXP(c0, 0, PFC[0][0]); SM_EXP(c0, 8, PFC[0][1]); SBAR(); \
            PV1((j) - 1, PFP, 2); SM_EXP(c1, 0, PFC[1][0]); SBAR(); \
            PV1((j) - 1, PFP, 3); SM_EXP(c1, 8, PFC[1][1]); l = l * al + ps; SBAR(); \
            RESC(al); } while (0)
        f32x16 o[4];
#pragma unroll
        for (int i = 0; i < 4; ++i)
#pragma unroll
            for (int q = 0; q < 16; ++q) o[i][q] = 0.f;
        float mref = -1e30f, l = 0.f, al = 1.f, ps = 0.f;
        f32x16 c0, c1; bf16x8 pfA[2][2], pfB[2][2];
        DMAK(0); DMAV(0); DMAK(1); DMAV(1); DMAK(2);
        WAIT_BAR(6); DMAK(3); DMAV(2);
        QKT(c0, c1, 0); SM_MAX(); SM_EXP(c0, 0, pfA[0][0]); SM_EXP(c0, 8, pfA[0][1]); SM_EXP(c1, 0, pfA[1][0]); SM_EXP(c1, 8, pfA[1][1]); l = l * al + ps;
        for (int j = 1; j + 1 < nt; j += 2) {
            ATT_STEP(j, pfB, pfA);
            ATT_STEP(j + 1, pfA, pfB);
        }
        ATT_STEP(nt - 1, pfB, pfA);
        WAIT_BAR(0);
        PVT(nt - 1, pfB);
        WAIT_BAR(0);
#undef DMAK
#undef DMAV
#undef WAIT_BAR
#undef QKT
#undef PVT
#undef PV1
#undef SM_MAX
#undef SM_EXP
#undef RESC
#undef SBAR
#undef ATT_STEP
#undef KVROW
        l += __shfl_xor(l, 32);
        const float f = (m == 1 ? lmb : 1.0f) / l;
        LAS float* ex = EX + (size_t)m * 128 * 129 + (qs * 32 + r) * 129;
#pragma unroll
        for (int i = 0; i < 4; ++i)
#pragma unroll
            for (int q = 0; q < 16; ++q) ex[32 * i + crow(q, hi)] = o[i][q] * f;
        __syncthreads();
#pragma unroll 1
        for (int rr = 0; rr < 16; ++rr) { const int row = 16 * F.wave + rr;
            const float a0 = EX[row * 129 + F.lane] - EX[128 * 129 + row * 129 + F.lane], a1 = EX[row * 129 + 64 + F.lane] - EX[128 * 129 + row * 129 + 64 + F.lane];
            const float rstd = (1.0f - LAMBDA_INIT) / sqrtf(wave_sum(a0 * a0 + a1 * a1) * (1.f / 128.f) + EPS);
            bf16* yr = Y + (size_t)(qrow0 + row) * D + h * 128;
            yr[F.lane] = (bf16)(pk2(a0 * rstd * ng[F.lane], 0.f) & 0xffffu); yr[64 + F.lane] = (bf16)(pk2(a1 * rstd * ng[64 + F.lane], 0.f) & 0xffffu); }
        __syncthreads();
    }
}

#define XB_TMO      128
#define XB_XCNT(j)  (256  + 64 * (j))
#define XB_XSUB(j)  (1280 + 64 * (j))
#define XB_XGEN(j)  (2304 + 64 * (j))
#define XB_TOP      3328
#define XB_TOPGEN   3392
#define XCD_BAR_WORDS 3456
#define XB_SPIN_CAP (1u << 18)

__device__ __forceinline__ unsigned xb_ld(unsigned* p)              { return __hip_atomic_load(p, __ATOMIC_RELAXED, __HIP_MEMORY_SCOPE_AGENT); }
__device__ __forceinline__ unsigned xb_add(unsigned* p, unsigned v) { return __hip_atomic_fetch_add(p, v, __ATOMIC_RELAXED, __HIP_MEMORY_SCOPE_AGENT); }
__device__ __forceinline__ unsigned xb_xcc_id() { return (unsigned)__builtin_amdgcn_s_getreg((3 << 11) | 20) & 0xFu; }
#define XB_SPIN(cond, bar) do { unsigned _sp = 0; while (cond) { __builtin_amdgcn_s_sleep(1); \
    if ((++_sp & 255u) == 0u) { if (xb_ld(&(bar)[XB_TMO])) break; if (_sp > XB_SPIN_CAP) { atomicAdd(&(bar)[XB_TMO], 1u); break; } } } } while (0)

struct XcdBarrier {
    unsigned* bar; unsigned x;
    volatile LAS unsigned* st;
};

__device__ __forceinline__ XcdBarrier xcd_barrier_post(unsigned* bar, volatile LAS unsigned* st) {
    XcdBarrier b; b.bar = bar; b.x = xb_xcc_id(); b.st = st;
    if (threadIdx.x == 0) (void)xb_add(&bar[XB_XCNT(b.x)], 1u);
    return b;
}
__device__ __forceinline__ void xcd_barrier_complete(unsigned* bar, unsigned x, unsigned& nloc, unsigned& nx) {
    const unsigned G = gridDim.x * gridDim.y * gridDim.z;
    unsigned sum, cnt, mine, sp = 0u;
    for (;;) {
        sum = 0u; cnt = 0u; mine = 0u;
#pragma unroll
        for (unsigned j = 0; j < 16; ++j) { const unsigned c = xb_ld(&bar[XB_XCNT(j)]); sum += c; cnt += (c > 0u) ? 1u : 0u; mine = (j == x) ? c : mine; }
        if (sum == G) break;
        __builtin_amdgcn_s_sleep(1);
        if ((++sp & 255u) == 0u) { if (xb_ld(&bar[XB_TMO])) break; if (sp > XB_SPIN_CAP) { atomicAdd(&bar[XB_TMO], 1u); break; } }
    }
    nloc = mine > 0u ? mine : 1u; nx = cnt > 0u ? cnt : 1u;
}

__device__ __forceinline__ void xcd_barrier(const XcdBarrier& b) {
    asm volatile("s_waitcnt vmcnt(0)" ::: "memory");
    __syncthreads();
    if (threadIdx.x == 0) {
        unsigned* bar = b.bar;
        __builtin_amdgcn_s_waitcnt(0);
        unsigned nloc = b.st[0], nx = b.st[1];
        if (nloc == 0u) { xcd_barrier_complete(bar, b.x, nloc, nx); b.st[0] = nloc; b.st[1] = nx; }
        const unsigned old = xb_add(&bar[XB_XSUB(b.x)], 1u);
        const unsigned gen = old / nloc;
        if (old + 1u == (gen + 1u) * nloc) {
            __builtin_amdgcn_fence(__ATOMIC_RELEASE, "agent");
            asm volatile("s_waitcnt vmcnt(0)" ::: "memory");
            const unsigned og = xb_add(&bar[XB_TOP], 1u);
            const unsigned tg = og / nx;
            if (og + 1u == (tg + 1u) * nx) xb_add(&bar[XB_TOPGEN], 1u);
            else XB_SPIN(xb_ld(&bar[XB_TOPGEN]) == tg, bar);
            __builtin_amdgcn_fence(__ATOMIC_ACQUIRE, "agent");
            xb_add(&bar[XB_XGEN(b.x)], 1u);
            asm volatile("s_waitcnt vmcnt(0)" ::: "memory");
        } else {
            XB_SPIN(xb_ld(&bar[XB_XGEN(b.x)]) == gen, bar);
            __builtin_amdgcn_fence(__ATOMIC_ACQUIRE, "agent");
            asm volatile("s_waitcnt vmcnt(0)" ::: "memory");
        }
    }
    __syncthreads();
}

#ifndef MK_SINGLE
#define MK_SINGLE 1
#endif
constexpr int NSTEPS = 1 + 9 + 7 + 8 + 9 + 1;
struct SEpiStore { bf16* O; int ldc; int act; bf16* halo;
    __device__ __forceinline__ void operator()(const float (&v8)[8], int m, int n0, int hi, int half) const {
#pragma unroll
        for (int g = 0; g < 2; ++g) { float v[4];
#pragma unroll
            for (int i = 0; i < 4; ++i) { v[i] = v8[4 * g + i]; if (act) { const float t = fmaxf(v[i], 0.f); v[i] = t * t; } }
            const u32x2 w = (u32x2){pk2(v[0], v[1]), pk2(v[2], v[3])}; const int n = n0 + 8 * (2 * half + g) + 4 * hi;
            *(u32x2*)(O + (size_t)m * ldc + n) = w;
            if (halo && n < 3072 && (((m & 63) == 0) || ((m & 63) == 63))) *(u32x2*)(halo + ((size_t)(m >> 6) * 2 + ((m & 63) ? 1 : 0)) * 3072 + n) = w; } } };
struct SEpiResid { float* X; const float* gate;
    __device__ __forceinline__ void operator()(const float (&v8)[8], int m, int n0, int hi, int half) const {
#pragma unroll
        for (int g = 0; g < 2; ++g) { const int n = n0 + 8 * (2 * half + g) + 4 * hi; float* p = X + (size_t)m * D + n; const f32x4 gv = *(const f32x4*)(gate + n);
            *(f32x4*)p = *(const f32x4*)p + gv * (f32x4){v8[4 * g], v8[4 * g + 1], v8[4 * g + 2], v8[4 * g + 3]}; } } };
struct SEpiAB { float* AB;
    __device__ __forceinline__ void operator()(const float (&v8)[8], int m, int n0, int hi, int half) const {
        if (n0 == 0) {
#pragma unroll
            for (int g = 0; g < 2; ++g) *(f32x4*)(AB + (size_t)m * 32 + 8 * (2 * half + g) + 4 * hi) = (f32x4){v8[4 * g], v8[4 * g + 1], v8[4 * g + 2], v8[4 * g + 3]}; } } };
template <class Epi> __device__ __forceinline__ void small_gemm(const bf16* A, const bf16* Bt, int row_lo, int nrows, int N, int K, const Epi& E) {
    int tid = threadIdx.x; asm volatile("" : "+v"(tid));
    const int lane = tid & 63, wave = __builtin_amdgcn_readfirstlane(tid >> 6), r = lane & 31, hi = lane >> 5;
    int G_ = gridDim.x, B_ = blockIdx.x; asm volatile("" : "+s"(G_), "+s"(B_));
    LAS float* red = (LAS float*)lds_raw;
    const int tn = N / 64, items = (nrows / 64) * tn, kw = K / 8;
    for (int it = B_; it < items; it += G_) {
        const int mi = it / tn, ni = it % tn;
        const bf16* ap = A + (size_t)(row_lo + 64 * mi + r) * K + wave * kw + 8 * hi;
        const bf16* bp = Bt + (size_t)(64 * ni + r) * K + wave * kw + 8 * hi;
        f32x16 acc[2][2];
#pragma unroll
        for (int x = 0; x < 2; ++x)
#pragma unroll
            for (int y = 0; y < 2; ++y)
#pragma unroll
                for (int i = 0; i < 16; ++i) acc[x][y][i] = 0.f;
#pragma unroll 8
        for (int k = 0; k < kw; k += 16) {
            const bf16x8 a0 = *(const bf16x8*)(ap + k), a1 = *(const bf16x8*)(ap + (size_t)32 * K + k), b0 = *(const bf16x8*)(bp + k), b1 = *(const bf16x8*)(bp + (size_t)32 * K + k);
            acc[0][0] = __builtin_amdgcn_mfma_f32_32x32x16_bf16(b0, a0, acc[0][0], 0, 0, 0); acc[0][1] = __builtin_amdgcn_mfma_f32_32x32x16_bf16(b0, a1, acc[0][1], 0, 0, 0);
            acc[1][0] = __builtin_amdgcn_mfma_f32_32x32x16_bf16(b1, a0, acc[1][0], 0, 0, 0); acc[1][1] = __builtin_amdgcn_mfma_f32_32x32x16_bf16(b1, a1, acc[1][1], 0, 0, 0);
        }
#pragma unroll
        for (int x = 0; x < 2; ++x)
#pragma unroll
            for (int y = 0; y < 2; ++y)
#pragma unroll
                for (int i = 0; i < 16; ++i) red[((wave * 4 + x * 2 + y) * 16 + i) * 64 + lane] = acc[x][y][i];
        __syncthreads();
        { const int tile = wave >> 1, half = wave & 1; float v8[8];
#pragma unroll
            for (int i = 0; i < 8; ++i) { float s = 0.f;
#pragma unroll
                for (int w = 0; w < 8; ++w) s += red[((w * 4 + tile) * 16 + 8 * half + i) * 64 + lane];
                v8[i] = s; }
            E(v8, row_lo + 64 * mi + 32 * (tile & 1) + r, 64 * ni + 32 * (tile >> 1), hi, half); }
        __syncthreads();
    }
}
template <int ACT> __device__ __forceinline__ void gemm_store(const bf16* A, const bf16* Bt, bool ctx, int N, int K, bf16* O, int ldc, bf16* halo) {
    { int G_ = gridDim.x, B_ = blockIdx.x; asm volatile("" : "+s"(G_), "+s"(B_));
      pg8::Gemm g{A, Bt, ML, N, K, K, K}; pg8::StaticOrder S; S.init(ML, N, G_, B_);
      pg8::EpiStore<ACT> E{O, ldc, nullptr, -1, halo};
      pg8::gemm_phase<pg8::EpiStore<ACT>, pg8::StaticOrder, true, true>((LAS unsigned char*)lds_raw, g, S, E); }
    if (ctx) { SEpiStore E2{O, ldc, ACT, halo}; small_gemm(A, Bt, ML, MC, N, K, E2); }
}
__device__ __forceinline__ void gemm_resid(const bf16* A, const bf16* Bt, bool ctx, int K, float* X, const float* gate) {
    { int G_ = gridDim.x, B_ = blockIdx.x; asm volatile("" : "+s"(G_), "+s"(B_));
      pg8::Gemm g{A, Bt, ML, D, K, K, K}; pg8::StaticOrder S; S.init(ML, D, G_, B_);
      pg8::EpiResid E{X, D, gate, NADA};
      pg8::gemm_phase<pg8::EpiResid, pg8::StaticOrder, true, true>((LAS unsigned char*)lds_raw, g, S, E); }
    if (ctx) { SEpiResid E2{X, gate + 2 * NADA}; small_gemm(A, Bt, ML, MC, D, K, E2); }
}
__global__ void __launch_bounds__(NTHR, 2) fwd_kernel(Args a) {
    unsigned char* ws = a.ws;
    const int lo = a.step_lo, hi = a.step_hi; const bool coop = a.coop != 0;
    volatile LAS unsigned* bst = (volatile LAS unsigned*)((LAS unsigned char*)lds_raw + LDS_BYTES - 64);
    if (threadIdx.x < 2) bst[threadIdx.x] = 0u;
    __syncthreads();
    XcdBarrier bar; bar.bar = (unsigned*)(ws + WS_CTL) + 4096; bar.x = 0; bar.st = bst;
    if (coop) bar = xcd_barrier_post((unsigned*)(ws + WS_CTL) + 4096, bst);
#ifndef REP_SET
#define REP_SET 0
#endif
#define REP_OF(k) ((REP_SET == 1 && ((k) == 8 || (k) == 15 || (k) == 23 || (k) == 32)) || (REP_SET == 2 && ((k) == 4 || (k) == 28)) || (REP_SET == 3 && ((k) == 2 || (k) == 11 || (k) == 18 || (k) == 26)) || \
    (REP_SET == 4 && ((k) == 1 || (k) == 7 || (k) == 10 || (k) == 14 || (k) == 17 || (k) == 22 || (k) == 25 || (k) == 31)) || (REP_SET == 5 && (k) == 0) || (REP_SET == 6 && (k) == 20) || (REP_SET == 7 && ((k) == 5 || (k) == 29 || (k) == 12 || (k) == 34)))
#define PHASE(k, body) do { if (lo <= (k) && (k) < hi) { __syncthreads(); body; if (REP_OF(k)) { __syncthreads(); body; } if ((k) + 1 < hi && coop) { if ((k) == 0) cg::this_grid().sync(); else xcd_barrier(bar); } } } while (0)
#define WB(off) ((bf16*)(ws + (off)))
#define MODP(layer, which) ((const float*)(ws + WS_MOD) + (size_t)(layer) * 3 * NADA + (which) * D)
#define TAIL(k0, layer, WoutT, Mrows) \
    PHASE((k0), gemm_resid(WB(WS_Y), (WoutT), (Mrows) == M, D, (float*)(ws + WS_X), MODP(layer, 2))); \
    PHASE((k0) + 1, step_norm((layer), 1, (Mrows), false)); \
    PHASE((k0) + 2, gemm_store<1>(WB(WS_H), WB(WS_W1T) + (size_t)(layer) * D * FF, (Mrows) == M, FF, D, WB(WS_Z), FF, nullptr)); \
    PHASE((k0) + 3, gemm_resid(WB(WS_Z), WB(WS_W2T) + (size_t)(layer) * D * FF, (Mrows) == M, FF, (float*)(ws + WS_X), MODP(layer, 5)))
#define LAYER_GDN(k0, layer, jj, Mrows, conv) \
    PHASE((k0), step_norm((layer), 0, M, false)); \
    PHASE((k0) + 1, { gemm_store<0>(WB(WS_H), WB(WS_GINT) + (size_t)(jj) * GDN_NP * D, true, 4096, D, WB(WS_Z), 4096, WB(WS_HALO)); \
        SEpiAB E3{(float*)(ws + WS_AB)}; small_gemm(WB(WS_H), WB(WS_GINT) + (size_t)(jj) * GDN_NP * D + (size_t)4096 * D, 0, M, 64, D, E3); }); \
    if (lo <= (k0) + 2 && (k0) + 2 < hi && !(coop && gridDim.x == 256)) { __syncthreads(); step_gdn_prep(jj, false, nullptr); if ((k0) + 3 < hi && coop) xcd_barrier(bar); } \
    PHASE((k0) + 3, { unsigned* fl_ = (unsigned*)(ws + WS_CTL) + 16384 + (jj) * 4096; \
        if (coop && gridDim.x == 256) { step_gdn_scan2(fl_); step_gdn_prep(jj, true, fl_); } else step_gdn_scan2(nullptr); \
        if (conv) step_convert_rest(); }); \
    PHASE((k0) + 4, step_gdn_norm2(jj)); \
    TAIL((k0) + 5, layer, WB(WS_GOUTT) + (size_t)(jj) * D * D, Mrows)
    PHASE(0, step_prologue());
    LAYER_GDN(1, 0, 0, M, true);
    PHASE(10, step_norm(1, 0, M, false));
    PHASE(11, gemm_store<0>(WB(WS_H), WB(WS_SINT), true, 3 * D, D, WB(WS_Z), 3 * D, nullptr));
    PHASE(12, step_sconv());
    TAIL(13, 1, WB(WS_SOUTT), M);
    PHASE(17, step_norm(2, 0, M, false));
    PHASE(18, gemm_store<0>(WB(WS_H), WB(WS_DINT), true, 3 * D, D, WB(WS_Z), 3 * D, nullptr));
    PHASE(19, step_rope2());
    PHASE(20, step_attn2());
    TAIL(21, 2, WB(WS_DOUTT), M);
    LAYER_GDN(25, 3, 1, ML, false);
    PHASE(34, step_final());
}

extern "C" void kernel_launch(void* const* d_in, const int* in_sizes, int n_in, void* d_out, int out_size, void* d_ws, size_t ws_size, hipStream_t stream) {
    static int grid = 0;
    if (grid == 0) {
        if (n_in != 24 || out_size != ML * D || ws_size < WS_END) { fprintf(stderr, "kernel_launch: unexpected problem (n_in %d, out %d, ws %zu); nothing launched\n", n_in, out_size, ws_size); grid = -1; return; }
        int dev = 0, cus = 0, per_cu = 0;
        if (hipGetDevice(&dev) != hipSuccess || hipDeviceGetAttribute(&cus, hipDeviceAttributeMultiprocessorCount, dev) != hipSuccess) { grid = -1; return; }
        if (hipFuncSetAttribute((const void*)fwd_kernel, hipFuncAttributeMaxDynamicSharedMemorySize, LDS_BYTES) != hipSuccess) { fprintf(stderr, "kernel_launch: hipFuncSetAttribute failed\n"); grid = -1; return; }
        if (hipOccupancyMaxActiveBlocksPerMultiprocessor(&per_cu, (const void*)fwd_kernel, NTHR, LDS_BYTES) != hipSuccess || per_cu < 1) { fprintf(stderr, "kernel_launch: occupancy query says %d blocks per CU\n", per_cu); (void)hipGetLastError(); per_cu = 1; }
        grid = cus;
        fprintf(stderr, "kernel_launch: %d CUs, occupancy %d per CU, grid %d\n", cus, per_cu, grid);
    }
    if (grid < 0) return;
    (void)hipMemsetAsync((char*)d_ws + WS_CTL, 0, CTL_ZERO_BYTES, stream);
    Args a{};
    for (int i = 0; i < 24; ++i) a.in[i] = (const float*)d_in[i];
    a.out = (float*)d_out; a.ws = (unsigned char*)d_ws;
#if MK_SINGLE
    a.step_lo = 0; a.step_hi = NSTEPS; a.coop = 1;
#if REP_SET == 20
    a.pad = 1;
#elif REP_SET == 21
    a.pad = 3;
#elif REP_SET >= 8
    a.pad = REP_SET - 8;
#endif
    void* args[] = {&a};
    hipError_t e = hipLaunchCooperativeKernel((const void*)fwd_kernel, dim3(grid), dim3(NTHR), args, LDS_BYTES, stream);
    if (e != hipSuccess) fprintf(stderr, "cooperative launch failed: %s (grid %d)\n", hipGetErrorString(e), grid);
#else
    for (int s = 0; s < NSTEPS; ++s) { a.step_lo = s; a.step_hi = s + 1; a.coop = 0; hipLaunchKernelGGL(fwd_kernel, dim3(grid), dim3(NTHR), LDS_BYTES, stream, a); }
#endif
}
```

```cpp
#include <hip/hip_runtime.h>
#include <hip/hip_cooperative_groups.h>
#include <cstdio>
#include <cstdint>
namespace cg = cooperative_groups;
namespace pg8 {
#define PG8_LAS __attribute__((address_space(3)))
typedef unsigned short bf16_t;
typedef short bf16x8 __attribute__((ext_vector_type(8)));
typedef float f32x4 __attribute__((ext_vector_type(4)));
typedef unsigned u32x4 __attribute__((ext_vector_type(4)));
constexpr int BM = 256, BK = 64, HALF = 128, HTB = HALF * BK * 2  , STAGE_BYTES = 8 * HTB, NXCD = 8, WGM = 8;

__host__ __device__ __forceinline__ int lds_byte(int r, int c) { const int st = (r >> 4) * 2 + (c >> 5), rr = r & 15, cc = c & 31, ob = rr * 64 + cc * 2; return st * 1024 + (ob ^ (((ob >> 9) & 1) << 5)); }
__host__ __device__ __forceinline__ void stage_rc(int b, int& R, int& C) { const int st = b / 1024, sb = b % 1024, swz = sb ^ (((sb >> 9) & 1) << 5); R = (st >> 1) * 16 + swz / 64; C = (st & 1) * 32 + (swz % 64) / 2; }
__host__ __device__ __forceinline__ int perm32(int rho) { const int n = rho >> 4, i = rho & 15; return 8 * (i >> 2) + 4 * n + (i & 3); }

struct Unit { int pm, pn; };
struct Gemm { const bf16_t* A; const bf16_t* Bt; int M, N, K, lda, ldb; };

struct StaticOrder {
    int nM, nN, nwg, G, c;
    __host__ __device__ void init(int M, int N, int G_, int c_) { nM = M / BM; nN = N / BM; nwg = nM * nN; G = G_; c = c_; }
    __host__ __device__ bool next(int i, Unit& u) const {
        const long L = (long)i * G + c; if (L >= nwg) return false;
        int wgid = (int)L; { const int q = nwg / NXCD, r = nwg % NXCD, xcd = wgid % NXCD, off = wgid / NXCD; wgid = (xcd < r ? xcd * (q + 1) : r * (q + 1) + (xcd - r) * q) + off; }
        const int nig = WGM * nN, gid = wgid / nig, fm = gid * WGM, gsz = (nM - fm) < WGM ? (nM - fm) : WGM;
        u.pm = fm + ((wgid % nig) % gsz); u.pn = (wgid % nig) / gsz; return true;
    }
    __device__ __forceinline__ void a_ready(const Unit&) const {}
    __device__ __forceinline__ void done(const Unit&) const {}
};

typedef float f32x2 __attribute__((ext_vector_type(2)));
typedef __bf16 bf16x2_t __attribute__((ext_vector_type(2)));
__device__ __forceinline__ unsigned cvt_pk_bf16(float lo, float hi) { f32x2 v = {lo, hi}; bf16x2_t b = __builtin_convertvector(v, bf16x2_t); return __builtin_bit_cast(unsigned, b); }

template <int ACT> struct EpiStore {
    static constexpr bool PERM = true, AFTER_DRAIN = false;
    bf16_t* O; int ldc; float* AB; int ab_tile; bf16_t* halo;
    __device__ __forceinline__ void operator()(const f32x4 (&acc)[2][2][4][2], const Unit& u, int wr, int wc, int fr, int fq) const {
        const int row0 = u.pm * BM + wr * 64 + fr;
        if (u.pn == ab_tile) {
            if (wc == 0) {
#pragma unroll
                for (int ai = 0; ai < 2; ++ai)
#pragma unroll
                    for (int m = 0; m < 4; ++m) { float* p = AB + (size_t)(row0 + ai * HALF + m * 16) * 32 + 8 * fq; *(f32x4*)p = acc[ai][0][m][0]; *(f32x4*)(p + 4) = acc[ai][0][m][1]; }
            }
            return;
        }
        const int col0 = u.pn * BM + wc * 32 + 8 * fq;
#pragma unroll
        for (int ai = 0; ai < 2; ++ai)
#pragma unroll
            for (int m = 0; m < 4; ++m) { bf16_t* rowp = O + (size_t)(row0 + ai * HALF + m * 16) * ldc + col0;
#pragma unroll
                for (int bj = 0; bj < 2; ++bj) { f32x4 v0 = acc[ai][bj][m][0], v1 = acc[ai][bj][m][1];
                    if (ACT == 1) {
#pragma unroll
                        for (int i = 0; i < 4; ++i) { const float a = fmaxf(v0[i], 0.f), b = fmaxf(v1[i], 0.f); v0[i] = a * a; v1[i] = b * b; } }
                    u32x4 w; w.x = cvt_pk_bf16(v0[0], v0[1]); w.y = cvt_pk_bf16(v0[2], v0[3]); w.z = cvt_pk_bf16(v1[0], v1[1]); w.w = cvt_pk_bf16(v1[2], v1[3]);
                    *(u32x4*)(rowp + bj * HALF) = w;
                    if (halo && u.pn < 12 && ((m == 0 && fr == 0) || (m == 3 && fr == 15))) { const int row = row0 + ai * HALF + m * 16;
                        *(u32x4*)(halo + ((size_t)(row >> 6) * 2 + (m == 3 ? 1 : 0)) * 3072 + col0 + bj * HALF) = w; } } }
    }
};
struct EpiResid {
    static constexpr bool PERM = false, AFTER_DRAIN = false;
    float* X; const float* Xin; int ldc; const float* gate; int gstride; int dry;
    __device__ __forceinline__ void operator()(const f32x4 (&acc)[2][2][4][2], const Unit& u, int wr, int wc, int fr, int fq) const {
        const int row0 = u.pm * BM + wr * 64 + fr, col0 = u.pn * BM + wc * 32 + 4 * fq;
        const float* g = gate + (size_t)(u.pm < 32 ? 0 : (u.pm < 64 ? 1 : 2)) * gstride + col0;
        f32x4 gv[2][2];
#pragma unroll
        for (int bj = 0; bj < 2; ++bj)
#pragma unroll
            for (int n = 0; n < 2; ++n) gv[bj][n] = *(const f32x4*)(g + bj * HALF + n * 16);
#pragma unroll
        for (int ai = 0; ai < 2; ++ai)
#pragma unroll
            for (int m = 0; m < 4; ++m) { const size_t off = (size_t)(row0 + ai * HALF + m * 16) * ldc + col0; float* p = X + off; const float* pi = Xin + off;
#pragma unroll
                for (int bj = 0; bj < 2; ++bj)
#pragma unroll
                    for (int n = 0; n < 2; ++n) { float* q = p + bj * HALF + n * 16; const f32x4 v_ = *(const f32x4*)(pi + bj * HALF + n * 16) + gv[bj][n] * acc[ai][bj][m][n]; if (!dry) *(f32x4*)q = v_; else asm volatile("" :: "v"(v_)); }
                if (m & 1) asm volatile("" ::: "memory"); }
    }
};

template <class Epi, class Sched, bool ALIGN_EPI = false, bool SP2 = false>
__device__ __forceinline__ void gemm_phase(PG8_LAS unsigned char* lds, const Gemm g, const Sched& S, const Epi& E) {
    int tid_ = threadIdx.x; asm volatile("" : "+v"(tid_)); const int tid = tid_, wid = __builtin_amdgcn_readfirstlane(tid >> 6), lane = tid & 63, wr = wid >> 2, wc = wid & 3, fr = lane & 15, fq = lane >> 4;
    const int K = g.K, nt = K / BK;
    unsigned voffA[2], voffB[2];
#pragma unroll
    for (int i = 0; i < 2; ++i) { int R, C; stage_rc(tid * 16 + i * 8192, R, C); const int Rb = Epi::PERM ? ((R & ~31) + perm32(R & 31)) : R;
        voffA[i] = (unsigned)(R * g.lda + C) * 2u; voffB[i] = (unsigned)(Rb * g.ldb + C) * 2u; }
    const size_t kstep = (size_t)(BK * 2);
    const int lda = g.lda, ldb = g.ldb;
    const size_t hstepA = (size_t)HALF * lda * 2, hstepB = (size_t)HALF * ldb * 2;
    const size_t tstepA = 2 * hstepA, tstepB = 2 * hstepB;
    const unsigned ldsw = (unsigned)wid * 1024u;
    const int aoff = lds_byte(wr * 64 + fr, fq * 8), boff = lds_byte(wc * 32 + fr, fq * 8);
#define PG8_SA(b, h) (((b) * 2 + (h)) * HTB)
#define PG8_SB(b, h) ((4 + (b) * 2 + (h)) * HTB)
#define PG8_STAGE(bufoff, gbase, voff) do { _Pragma("unroll") for (int _i = 0; _i < 2; ++_i) \
        __builtin_amdgcn_global_load_lds((const unsigned*)((const char*)(gbase) + (voff)[_i]), (PG8_LAS unsigned*)(lds + (bufoff) + ldsw + _i * 8192), 16, 0, 0); } while (0)
#define PG8_LDA(dst, b, h) do { _Pragma("unroll") for (int m = 0; m < 4; ++m) _Pragma("unroll") for (int k = 0; k < 2; ++k) dst[m][k] = *(const PG8_LAS bf16x8*)(lds + PG8_SA(b, h) + aoff + m * 2048 + k * 1024); } while (0)
#define PG8_LDB(dst, b, h) do { _Pragma("unroll") for (int n = 0; n < 2; ++n) _Pragma("unroll") for (int k = 0; k < 2; ++k) dst[n][k] = *(const PG8_LAS bf16x8*)(lds + PG8_SB(b, h) + boff + n * 2048 + k * 1024); } while (0)
#define PG8_MMA(ai, bj, At, Bt) do { __builtin_amdgcn_s_setprio(1); _Pragma("unroll") for (int m = 0; m < 4; ++m) _Pragma("unroll") for (int n = 0; n < 2; ++n) _Pragma("unroll") for (int k = 0; k < 2; ++k) \
        acc[ai][bj][m][n] = __builtin_amdgcn_mfma_f32_16x16x32_bf16(Bt[n][k], At[m][k], acc[ai][bj][m][n], 0, 0, 0); __builtin_amdgcn_s_setprio(0); } while (0)
#define PG8_WAIT_V(n) asm volatile("s_waitcnt vmcnt(" #n ")" ::: "memory")
#define PG8_WAIT_L(n) asm volatile("s_waitcnt lgkmcnt(" #n ")" ::: "memory")
#define PG8_BAR __builtin_amdgcn_s_barrier()
#define PG8_SCHED __builtin_amdgcn_sched_barrier(0)
    Unit cur, nxt; int ui = 0;
    if (!S.next(0, cur)) return;
    f32x4 acc[2][2][4][2];
#pragma unroll
    for (int a = 0; a < 2; ++a)
#pragma unroll
        for (int b = 0; b < 2; ++b)
#pragma unroll
            for (int m = 0; m < 4; ++m)
#pragma unroll
                for (int n = 0; n < 2; ++n) acc[a][b][m][n] = (f32x4){0.f, 0.f, 0.f, 0.f};
    bf16x8 At[4][2], B0[2][2], B1[2][2];
    const char* cA = (const char*)g.A + (size_t)cur.pm * tstepA; const char* cB = (const char*)g.Bt + (size_t)cur.pn * tstepB;
    S.a_ready(cur);
    if constexpr (SP2) {
        PG8_STAGE(PG8_SB(0, 0), cB, voffB); PG8_STAGE(PG8_SB(0, 1), cB + hstepB, voffB); PG8_STAGE(PG8_SA(0, 0), cA, voffA); PG8_STAGE(PG8_SA(0, 1), cA + hstepA, voffA);
        if (wr == 1) PG8_BAR;
        PG8_WAIT_V(2); PG8_BAR;
        PG8_STAGE(PG8_SB(1, 0), cB + kstep, voffB); PG8_STAGE(PG8_SA(1, 0), cA + kstep, voffA); PG8_STAGE(PG8_SB(1, 1), cB + hstepB + kstep, voffB);
        PG8_WAIT_V(6); PG8_BAR;
    } else {
        PG8_STAGE(PG8_SB(0, 0), cB, voffB); PG8_STAGE(PG8_SA(0, 0), cA, voffA); PG8_STAGE(PG8_SB(0, 1), cB + hstepB, voffB); PG8_STAGE(PG8_SA(0, 1), cA + hstepA, voffA);
        if (wr == 1) PG8_BAR;
        PG8_WAIT_V(4); PG8_BAR;
        PG8_STAGE(PG8_SB(1, 0), cB + kstep, voffB); PG8_STAGE(PG8_SA(1, 0), cA + kstep, voffA); PG8_STAGE(PG8_SB(1, 1), cB + hstepB + kstep, voffB);
        PG8_WAIT_V(6); PG8_BAR;
    }
    for (;;) {
        const bool has_next = S.next(ui + 1, nxt);
        const char* nA = has_next ? (const char*)g.A + (size_t)nxt.pm * tstepA : cA; const char* nB = has_next ? (const char*)g.Bt + (size_t)nxt.pn * tstepB : cB;
        for (int t = 0; t < nt; t += 2) {
            const bool last = (t == nt - 2);
            const char* a1 = cA + (size_t)(t + 1) * kstep;
            const char* a2 = last ? nA : cA + (size_t)(t + 2) * kstep; const char* b2 = last ? nB : cB + (size_t)(t + 2) * kstep;
            const char* a3 = a2 + kstep; const char* b3 = b2 + kstep;
            if (last && has_next) S.a_ready(nxt);
            if constexpr (SP2) {
            PG8_LDB(B0, 0, 0); PG8_LDB(B1, 0, 1); PG8_SCHED; PG8_LDA(At, 0, 0); PG8_STAGE(PG8_SA(1, 1), a1 + hstepA, voffA);
            PG8_WAIT_V(8); PG8_WAIT_L(0); PG8_BAR; PG8_MMA(0, 0, At, B0); PG8_MMA(0, 1, At, B1); PG8_BAR; PG8_SCHED;
            PG8_LDA(At, 0, 1); PG8_STAGE(PG8_SB(0, 0), b2, voffB); PG8_STAGE(PG8_SB(0, 1), b2 + hstepB, voffB); PG8_STAGE(PG8_SA(0, 0), a2, voffA);
            PG8_WAIT_V(8); PG8_WAIT_L(0); PG8_BAR; PG8_MMA(1, 0, At, B0); PG8_MMA(1, 1, At, B1); PG8_BAR; PG8_SCHED;
            PG8_LDB(B0, 1, 0); PG8_LDB(B1, 1, 1); PG8_SCHED; PG8_LDA(At, 1, 0); PG8_STAGE(PG8_SA(0, 1), a2 + hstepA, voffA);
            PG8_WAIT_V(8); PG8_WAIT_L(0); PG8_BAR; PG8_MMA(0, 0, At, B0); PG8_MMA(0, 1, At, B1); PG8_BAR; PG8_SCHED;
            PG8_LDA(At, 1, 1); PG8_STAGE(PG8_SB(1, 0), b3, voffB); PG8_STAGE(PG8_SB(1, 1), b3 + hstepB, voffB); PG8_STAGE(PG8_SA(1, 0), a3, voffA);
            PG8_WAIT_V(8); PG8_WAIT_L(0); PG8_BAR; PG8_MMA(1, 0, At, B0); PG8_MMA(1, 1, At, B1); PG8_BAR; PG8_SCHED;
            } else {
            PG8_LDB(B0, 0, 0); PG8_SCHED; PG8_LDA(At, 0, 0); PG8_STAGE(PG8_SA(1, 1), a1 + hstepA, voffA);
            PG8_WAIT_L(8); PG8_BAR; PG8_WAIT_L(0); PG8_MMA(0, 0, At, B0); PG8_BAR; PG8_SCHED;
            PG8_LDB(B1, 0, 1); PG8_STAGE(PG8_SB(0, 0), b2, voffB);
            PG8_BAR; PG8_WAIT_L(0); PG8_MMA(0, 1, At, B1); PG8_BAR;
            PG8_LDA(At, 0, 1); PG8_STAGE(PG8_SA(0, 0), a2, voffA);
            PG8_BAR; PG8_WAIT_L(0); PG8_MMA(1, 0, At, B0); PG8_BAR; PG8_SCHED;
            PG8_STAGE(PG8_SB(0, 1), b2 + hstepB, voffB);
            PG8_WAIT_V(6); PG8_BAR; PG8_MMA(1, 1, At, B1); PG8_BAR;
            PG8_LDB(B0, 1, 0); PG8_SCHED; PG8_LDA(At, 1, 0); PG8_STAGE(PG8_SA(0, 1), a2 + hstepA, voffA);
            PG8_WAIT_L(8); PG8_BAR; PG8_WAIT_L(0); PG8_MMA(0, 0, At, B0); PG8_BAR; PG8_SCHED;
            PG8_LDB(B1, 1, 1); PG8_STAGE(PG8_SB(1, 0), b3, voffB);
            PG8_BAR; PG8_WAIT_L(0); PG8_MMA(0, 1, At, B1); PG8_BAR;
            PG8_LDA(At, 1, 1); PG8_STAGE(PG8_SA(1, 0), a3, voffA);
            PG8_BAR; PG8_WAIT_L(0); PG8_MMA(1, 0, At, B0); PG8_BAR; PG8_SCHED;
            PG8_STAGE(PG8_SB(1, 1), b3 + hstepB, voffB);
            PG8_WAIT_V(6); PG8_BAR; PG8_MMA(1, 1, At, B1); PG8_BAR;
            }
        }
        if constexpr (ALIGN_EPI) { if (wr == 0) PG8_BAR; }
        if constexpr (!Epi::AFTER_DRAIN) { E(acc, cur, wr, wc, fr, fq); S.done(cur); }
        if (!has_next) break;
#pragma unroll
        for (int a = 0; a < 2; ++a)
#pragma unroll
            for (int b = 0; b < 2; ++b)
#pragma unroll
                for (int m = 0; m < 4; ++m)
#pragma unroll
                    for (int n = 0; n < 2; ++n) acc[a][b][m][n] = (f32x4){0.f, 0.f, 0.f, 0.f};
        cur = nxt; cA = nA; cB = nB; ++ui;
        if constexpr (ALIGN_EPI) { if (wr == 1) PG8_BAR; }
    }
    PG8_WAIT_V(0);
    if constexpr (!ALIGN_EPI) { if (wr == 0) PG8_BAR; }
    PG8_BAR;
    if constexpr (Epi::AFTER_DRAIN) { E.fused(acc, cur, wr, wc, fr, fq, lds, wid, lane); S.done(cur); }
#undef PG8_SA
#undef PG8_SB
#undef PG8_STAGE
#undef PG8_LDA
#undef PG8_LDB
#undef PG8_MMA
#undef PG8_WAIT_V
#undef PG8_WAIT_L
#undef PG8_BAR
#undef PG8_SCHED
}
}

constexpr int D = 1024, NB = 2, T = 8192, CT = 256, DEPTH = 4, FF = 4096;
constexpr int ML = NB * T, MC = NB * CT, M = ML + MC;
constexpr int NADA = 6 * D;
constexpr int GDN_N = 4128, GDN_NP = 4352;
constexpr int NH = 8, HD = 128;
constexpr int NKV = CT + T;
constexpr float EPS = 1e-6f;
constexpr int NWAVES = 8, NTHR = 512;
constexpr float QSCALE = 0.125f * 1.4426950408889634f;
constexpr float LAMBDA_INIT = 0.47071302f;

constexpr size_t MiB = 1u << 20;
constexpr size_t WS_CTL = 0, CTL_ZERO_BYTES = 1 * MiB;
constexpr size_t WS_MOD = 1 * MiB;
constexpr size_t WS_ROPE = 2 * MiB;
constexpr size_t WS_AB = 4 * MiB;
constexpr size_t WS_OFC = 7 * MiB;
constexpr size_t WS_W1T = 10 * MiB, WS_W2T = 42 * MiB, WS_GINT = 74 * MiB, WS_GOUTT = 91 * MiB, WS_SINT = 95 * MiB, WS_SOUTT = 101 * MiB, WS_DINT = 103 * MiB, WS_DOUTT = 109 * MiB;
constexpr size_t WS_X = 112 * MiB;
constexpr size_t WS_H = 178 * MiB;
constexpr size_t WS_Y = 211 * MiB;
constexpr size_t WS_Z = 244 * MiB;
constexpr size_t WS_HALO = 376 * MiB;
constexpr size_t WS_END = 380 * MiB;
constexpr size_t WS_PD = WS_H;

constexpr int LDS_BYTES = 149504;

#define LAS __attribute__((address_space(3)))
typedef unsigned short bf16;
typedef unsigned u32x4 __attribute__((ext_vector_type(4)));
typedef unsigned u32x2 __attribute__((ext_vector_type(2)));
typedef float f32x4 __attribute__((ext_vector_type(4)));
typedef float f32x2 __attribute__((ext_vector_type(2)));
typedef float f32x16 __attribute__((ext_vector_type(16)));
typedef short bf16x8 __attribute__((ext_vector_type(8)));
typedef short s16x4 __attribute__((ext_vector_type(4)));
#define LDS_WAIT() asm volatile("s_waitcnt lgkmcnt(0)" ::: "memory")

__device__ __forceinline__ float bf2f(unsigned u) { return __uint_as_float(u << 16); }
__device__ __forceinline__ unsigned pk2(float lo, float hi) { return pg8::cvt_pk_bf16(lo, hi); }
__device__ __forceinline__ float wave_sum(float v) {
#pragma unroll
    for (int o = 1; o < 64; o <<= 1) v += __shfl_xor(v, o);
    return v;
}
__device__ __forceinline__ float silu_f(float x) { return x / (1.f + expf(-x)); }
__device__ __forceinline__ float silu_fast(float x) { return x * __builtin_amdgcn_rcpf(1.f + __builtin_amdgcn_exp2f(-1.4426950408889634f * x)); }
__device__ __forceinline__ int crow(int r, int hi) { return (r & 3) + 8 * (r >> 2) + 4 * hi; }

struct Args { const float* in[24]; float* out; unsigned char* ws; int step_lo, step_hi, coop, pad; };
typedef const __attribute__((address_space(4))) Args* KArgs;
__device__ __forceinline__ KArgs kargs() { unsigned long long p = (unsigned long long)__builtin_amdgcn_kernarg_segment_ptr(); asm volatile("" : "+s"(p)); return (KArgs)p; }
#define INP(k) (kargs()->in[k])
extern __shared__ __attribute__((aligned(16))) unsigned char lds_raw[];
struct Frame { LAS unsigned char* lds; int tid, lane, wave, G, bid; float* out; unsigned char* ws; };
__device__ __forceinline__ Frame make_frame() {
    Frame F; F.lds = (LAS unsigned char*)lds_raw; F.tid = threadIdx.x; asm volatile("" : "+v"(F.tid)); F.lane = F.tid & 63; F.wave = __builtin_amdgcn_readfirstlane(F.tid >> 6); F.G = gridDim.x; F.bid = blockIdx.x; asm volatile("" : "+s"(F.G), "+s"(F.bid));
    KArgs a = kargs(); F.out = a->out; F.ws = a->ws; return F;
}
enum { I_X = 0, I_C, I_CTX, I_CCTX, I_N1G, I_N2G, I_ADAW, I_ADAB, I_W1, I_W2, I_GIN, I_GCONV, I_GALOG, I_GDT, I_GNG, I_GOUT, I_SIN, I_SCONV, I_SOUT, I_DIN, I_DLAM, I_DNG, I_DOUT, I_FG };

__device__ __forceinline__ void transpose_item(const float* W, int K, int ldw, bf16* WT, LAS float* scr, int item, int nblk, int lane) {
    const int kb = item / nblk, nb = item % nblk, k0 = 64 * kb, n0 = 32 * nb;
#pragma unroll 8
    for (int i = 0; i < 32; ++i) { const int kk = 2 * i + (lane >> 5); scr[kk * 33 + (lane & 31)] = W[(size_t)(k0 + kk) * ldw + n0 + (lane & 31)]; }
    LDS_WAIT(); asm volatile("" ::: "memory");
    const int c = lane & 7;
#pragma unroll
    for (int j = 0; j < 4; ++j) { const int n = (lane >> 3) + 8 * j; const LAS float* s = scr + (8 * c) * 33 + n;
        u32x4 o; o.x = pk2(s[0 * 33], s[1 * 33]); o.y = pk2(s[2 * 33], s[3 * 33]); o.z = pk2(s[4 * 33], s[5 * 33]); o.w = pk2(s[6 * 33], s[7 * 33]);
        *(u32x4*)(WT + (size_t)(n0 + n) * K + k0 + 8 * c) = o; }
    LDS_WAIT(); asm volatile("" ::: "memory");
}
__device__ __forceinline__ void get_mat(unsigned char* ws_, int idx, const float*& src, bf16*& dst, int& K, int& N, int& ld) {
    unsigned char* ws = ws_;
    if (idx < 4)       { src = INP(I_W1) + (size_t)idx * D * FF; dst = (bf16*)(ws + WS_W1T) + (size_t)idx * D * FF; K = D; N = FF; ld = FF; }
    else if (idx < 8)  { const int i = idx - 4; src = INP(I_W2) + (size_t)i * D * FF; dst = (bf16*)(ws + WS_W2T) + (size_t)i * D * FF; K = FF; N = D; ld = D; }
    else if (idx < 10) { const int j = idx - 8; src = INP(I_GIN) + (size_t)j * D * GDN_N; dst = (bf16*)(ws + WS_GINT) + (size_t)j * GDN_NP * D; K = D; N = GDN_N; ld = GDN_N; }
    else if (idx < 12) { const int j = idx - 10; src = INP(I_GOUT) + (size_t)j * D * D; dst = (bf16*)(ws + WS_GOUTT) + (size_t)j * D * D; K = D; N = D; ld = D; }
    else if (idx == 12) { src = INP(I_SIN); dst = (bf16*)(ws + WS_SINT); K = D; N = 3 * D; ld = 3 * D; }
    else if (idx == 13) { src = INP(I_SOUT); dst = (bf16*)(ws + WS_SOUTT); K = D; N = D; ld = D; }
    else if (idx == 14) { src = INP(I_DIN); dst = (bf16*)(ws + WS_DINT); K = D; N = 3 * D; ld = 3 * D; }
    else { src = INP(I_DOUT); dst = (bf16*)(ws + WS_DOUTT); K = D; N = D; ld = D; }
}
__device__ __forceinline__ void convert_weights(unsigned char* ws, unsigned mask, int gw, int NGW, int gt, int NGT, LAS unsigned char* lds, int wave, int lane) {
    LAS float* scr = (LAS float*)(lds + wave * 16384);
    for (int mi = 0; mi < 16; ++mi) {
        if (!((mask >> mi) & 1u)) continue;
        const float* src; bf16* dst; int K, N, ld; get_mat(ws, mi, src, dst, K, N, ld);
        const int nblk = N / 32, nitems = (K / 64) * nblk;
        for (int it = gw; it < nitems; it += NGW) transpose_item(src, K, ld, dst, scr, it, nblk, lane);
        if (mi == 8 || mi == 9) { u32x4* z = (u32x4*)((bf16*)(ws + WS_GINT) + (size_t)(mi - 8) * GDN_NP * D + (size_t)GDN_N * D);
            for (int i = gt; i < (GDN_NP - GDN_N) * D / 8; i += NGT) z[i] = (u32x4){0u, 0u, 0u, 0u}; }
    }
}
__device__ __forceinline__ void step_prologue() {
    const Frame F = make_frame();
    const int gw = F.bid * NWAVES + F.wave, NGW = F.G * NWAVES;
    const int gt = F.bid * NTHR + F.tid, NGT = F.G * NTHR;
    convert_weights(F.ws, (1u << 0) | (1u << 4) | (1u << 8) | (1u << 10), gw, NGW, gt, NGT, F.lds, F.wave, F.lane);
    __syncthreads();
    {
        LAS float* sv = (LAS float*)F.lds;
        LAS float* red = sv + 3 * D;
        for (int i = F.tid; i < 3 * D; i += NTHR) { const int g = i / D, k = i % D; const float c = g < 2 ? INP(I_C)[g * D + k] : INP(I_CCTX)[k]; sv[i] = silu_f(c); }
        __syncthreads();
        float* MOD = (float*)(F.ws + WS_MOD);
        const int c = F.tid & 63, ks = F.tid >> 6;
        for (int it = F.bid; it < DEPTH * (NADA / 64); it += F.G) {
            const int li = it / (NADA / 64), n0 = (it % (NADA / 64)) * 64;
            const float* w = INP(I_ADAW) + (size_t)li * D * NADA + (size_t)(ks * 128) * NADA + n0 + c;
            float a0 = 0.f, a1 = 0.f, a2 = 0.f;
#pragma unroll 8
            for (int k = 0; k < 128; ++k) { const float wv = w[(size_t)k * NADA]; const int kk = ks * 128 + k; a0 += sv[kk] * wv; a1 += sv[D + kk] * wv; a2 += sv[2 * D + kk] * wv; }
            red[(ks * 3 + 0) * 64 + c] = a0; red[(ks * 3 + 1) * 64 + c] = a1; red[(ks * 3 + 2) * 64 + c] = a2;
            __syncthreads();
            if (F.tid < 192) { const int g = F.tid >> 6; float s = INP(I_ADAB)[li * NADA + n0 + c];
#pragma unroll
                for (int q = 0; q < 8; ++q) s += red[(q * 3 + g) * 64 + c];
                MOD[((size_t)li * 3 + g) * NADA + n0 + c] = s; }
            __syncthreads();
        }
    }
    {
        f32x2* R = (f32x2*)(F.ws + WS_ROPE);
        for (int i = gt; i < T * 32; i += NGT) { const int t = i >> 5, p = i & 31, f = p & 15;
            const float inv = powf(10000.0f, -(float)f / 16.0f); const float pos = (float)(p < 16 ? (t >> 6) : (t & 63)); const float ang = pos * inv;
            R[i] = (f32x2){cosf(ang), sinf(ang)}; }
    }
}

__device__ __forceinline__ void step_norm(int layer, int which, int nrows, bool from_inputs) {
    const Frame F = make_frame();
    const int gw = F.bid * NWAVES + F.wave, NGW = F.G * NWAVES;
    const float* X = (const float*)(F.ws + WS_X); bf16* H = (bf16*)(F.ws + WS_H);
    const float* ng = (which ? INP(I_N2G) : INP(I_N1G)) + layer * D;
    const float* MOD = (const float*)(F.ws + WS_MOD) + (size_t)layer * 3 * NADA + which * 3 * D;
    for (int row = gw; row < nrows; row += NGW) {
        const int grp = row < T ? 0 : (row < ML ? 1 : 2);
        const float* xrow = from_inputs ? (row < ML ? INP(I_X) + (size_t)row * D : INP(I_CTX) + (size_t)(row - ML) * D) : X + (size_t)row * D;
        const f32x4* xr = (const f32x4*)xrow + F.lane;
        const f32x4* sh = (const f32x4*)(MOD + (size_t)grp * NADA) + F.lane; const f32x4* sc = (const f32x4*)(MOD + (size_t)grp * NADA + D) + F.lane; const f32x4* gg = (const f32x4*)ng + F.lane;
        f32x4 v[4]; float s = 0.f;
#pragma unroll
        for (int j = 0; j < 4; ++j) { v[j] = xr[64 * j]; s += (v[j].x * v[j].x + v[j].y * v[j].y) + (v[j].z * v[j].z + v[j].w * v[j].w); }
        const float rstd = 1.0f / sqrtf(wave_sum(s) * (1.f / D) + EPS);
        u32x2* o = (u32x2*)(H + (size_t)row * D) + F.lane;
#pragma unroll
        for (int j = 0; j < 4; ++j) { const f32x4 g4 = gg[64 * j], s4 = sc[64 * j], h4 = sh[64 * j]; const f32x4 y = (v[j] * rstd) * g4; const f32x4 h = y * (1.0f + s4) + h4;
            o[64 * j] = (u32x2){pk2(h.x, h.y), pk2(h.z, h.w)}; }
    }
}
__device__ __forceinline__ void step_final() {
    const Frame F = make_frame();
    const int gw = F.bid * NWAVES + F.wave, NGW = F.G * NWAVES;
    const float* X = (const float*)(F.ws + WS_X);
    for (int row = gw; row < ML; row += NGW) {
        const f32x4* xr = (const f32x4*)(X + (size_t)row * D) + F.lane; const f32x4* gg = (const f32x4*)INP(I_FG) + F.lane;
        f32x4 v[4]; float s = 0.f;
#pragma unroll
        for (int j = 0; j < 4; ++j) { v[j] = xr[64 * j]; s += (v[j].x * v[j].x + v[j].y * v[j].y) + (v[j].z * v[j].z + v[j].w * v[j].w); }
        const float rstd = 1.0f / sqrtf(wave_sum(s) * (1.f / D) + EPS);
        f32x4* o = (f32x4*)(F.out + (size_t)row * D) + F.lane;
#pragma unroll
        for (int j = 0; j < 4; ++j) o[64 * j] = (v[j] * rstd) * gg[64 * j];
    }
}

__device__ __forceinline__ void step_gdn_scan(int j) {
    const Frame F = make_frame();
    LAS float* qs = (LAS float*)F.lds;
    LAS float* ks = qs + 64 * 128;
    LAS float* vs = ks + 64 * 128;
    LAS float* ga = vs + 64 * 128;
    LAS float* be = ga + 64;
    const bf16* Z = (const bf16*)(F.ws + WS_Z);
    const float* AB = (const float*)(F.ws + WS_AB);
    const float* cw = INP(I_GCONV) + (size_t)j * 3 * 3072;
    float* OFC = (float*)(F.ws + WS_OFC);
    for (int it = F.bid; it < 32; it += F.G) {
        const int b = it >> 4, h = (it >> 1) & 7, dir = it & 1;
        const float Aco = expf(INP(I_GALOG)[j * 16 + dir * 8 + h]); const float dtb = INP(I_GDT)[j * 16 + dir * 8 + h];
        float S[64];
#pragma unroll
        for (int i = 0; i < 64; ++i) S[i] = 0.f;
        const int jcol = F.tid >> 1, half = F.tid & 1;
        for (int n = 0; n < 132; ++n) {
            const bool isctx = n < 4; const int L = isctx ? CT : T; const int p0 = isctx ? 64 * n : 64 * (n - 4); const int rbase = isctx ? ML + b * CT : b * T;
            for (int idx = F.tid; idx < 64 * 384; idx += NTHR) {
                const int c = idx / 384, ch = idx % 384, part = ch >> 7, e = ch & 127;
                const int p = p0 + c; const int t = dir ? (L - 1 - p) : p; const int col = part * 1024 + h * 128 + e;
                float acc = 0.f;
#pragma unroll
                for (int tap = 0; tap < 3; ++tap) { const int tt = t + tap - 1; if (tt >= 0 && tt < L) acc += cw[tap * 3072 + col] * bf2f(Z[(size_t)(rbase + tt) * 4096 + col]); }
                acc = silu_f(acc);
                LAS float* dst = part == 0 ? qs : (part == 1 ? ks : vs); dst[c * 128 + e] = acc;
            }
            if (F.tid < 64) { const int p = p0 + F.tid; const int t = dir ? (L - 1 - p) : p; const size_t row = (size_t)(rbase + t);
                const float av = AB[row * 32 + dir * 8 + h], bv = AB[row * 32 + 16 + dir * 8 + h];
                const float x = av + dtb; const float sp = x > 20.f ? x : log1pf(expf(x));
                ga[F.tid] = expf(-Aco * sp); be[F.tid] = 1.f / (1.f + expf(-bv)); }
            __syncthreads();
#pragma unroll 1
            for (int rr = 0; rr < 8; ++rr) { const int c = F.wave * 8 + rr;
                const float q0 = qs[c * 128 + F.lane], q1 = qs[c * 128 + 64 + F.lane]; const float sq = 0.08838834764831845f / sqrtf(wave_sum(q0 * q0 + q1 * q1) + EPS);
                qs[c * 128 + F.lane] = q0 * sq; qs[c * 128 + 64 + F.lane] = q1 * sq;
                const float k0 = ks[c * 128 + F.lane], k1 = ks[c * 128 + 64 + F.lane]; const float sk = 1.0f / sqrtf(wave_sum(k0 * k0 + k1 * k1) + EPS);
                ks[c * 128 + F.lane] = k0 * sk; ks[c * 128 + 64 + F.lane] = k1 * sk; }
            __syncthreads();
            if (F.tid < 256) {
#pragma unroll 1
                for (int c = 0; c < 64; ++c) {
                    const float a = ga[c], bt = be[c];
                    const LAS f32x4* k4 = (const LAS f32x4*)(ks + c * 128 + 64 * half); const LAS f32x4* q4 = (const LAS f32x4*)(qs + c * 128 + 64 * half);
                    float dot = 0.f;
#pragma unroll
                    for (int i = 0; i < 16; ++i) { const f32x4 kv = k4[i]; dot += kv.x * S[4 * i] + kv.y * S[4 * i + 1] + kv.z * S[4 * i + 2] + kv.w * S[4 * i + 3]; }
                    dot += __shfl_xor(dot, 1);
                    const float tmp = bt * (vs[c * 128 + jcol] - a * dot);
                    float o = 0.f;
#pragma unroll
                    for (int i = 0; i < 16; ++i) { const f32x4 kv = k4[i]; const f32x4 qv = q4[i];
                        S[4 * i] = a * S[4 * i] + kv.x * tmp; S[4 * i + 1] = a * S[4 * i + 1] + kv.y * tmp; S[4 * i + 2] = a * S[4 * i + 2] + kv.z * tmp; S[4 * i + 3] = a * S[4 * i + 3] + kv.w * tmp;
                        o += qv.x * S[4 * i] + qv.y * S[4 * i + 1] + qv.z * S[4 * i + 2] + qv.w * S[4 * i + 3]; }
                    o += __shfl_xor(o, 1);
                    const int p = p0 + c; const int t = dir ? (L - 1 - p) : p;
                    float* dst = isctx ? OFC + (size_t)(b * CT + t) * D : F.out + (size_t)(b * T + t) * D;
                    if (half == 0) atomicAdd(dst + h * 128 + jcol, o);
                }
            }
            __syncthreads();
        }
    }
}
__device__ __forceinline__ void step_gdn_norm(int j) {
    const Frame F = make_frame();
    const int gw = F.bid * NWAVES + F.wave, NGW = F.G * NWAVES;
    const bf16* Z = (const bf16*)(F.ws + WS_Z); bf16* Y = (bf16*)(F.ws + WS_Y); const float* ng = INP(I_GNG) + j * 128;
    for (int row = gw; row < M; row += NGW) {
        const float* src = row < ML ? F.out + (size_t)row * D : (const float*)(F.ws + WS_OFC) + (size_t)(row - ML) * D;
        const f32x4* s4 = (const f32x4*)(src + 16 * F.lane);
        float v[16]; float ss = 0.f;
#pragma unroll
        for (int q = 0; q < 4; ++q) { const f32x4 x = s4[q]; v[4 * q] = x.x; v[4 * q + 1] = x.y; v[4 * q + 2] = x.z; v[4 * q + 3] = x.w; ss += (x.x * x.x + x.y * x.y) + (x.z * x.z + x.w * x.w); }
        ss += __shfl_xor(ss, 1); ss += __shfl_xor(ss, 2); ss += __shfl_xor(ss, 4);
        const float rstd = 1.0f / sqrtf(ss * (1.f / 128.f) + EPS);
        const u32x4* g4 = (const u32x4*)(Z + (size_t)row * 4096 + 3072 + 16 * F.lane);
        const int e0 = (16 * F.lane) & 127;
        u32x4 o[2];
#pragma unroll
        for (int q = 0; q < 2; ++q) { const u32x4 gz = g4[q]; unsigned w[4];
#pragma unroll
            for (int i = 0; i < 4; ++i) { const unsigned gg = gz[i]; const float g0 = bf2f(gg & 0xffffu), g1 = bf2f(gg >> 16); const int e = e0 + 8 * q + 2 * i;
                w[i] = pk2(v[8 * q + 2 * i] * rstd * ng[e] * silu_f(g0), v[8 * q + 2 * i + 1] * rstd * ng[e + 1] * silu_f(g1)); }
            o[q] = (u32x4){w[0], w[1], w[2], w[3]}; }
        u32x4* dst = (u32x4*)(Y + (size_t)row * D + 16 * F.lane); dst[0] = o[0]; dst[1] = o[1];
    }
}

__device__ __forceinline__ void step_sconv() {
    const Frame F = make_frame();
    const int gt = F.bid * NTHR + F.tid, NGT = F.G * NTHR;
    const bf16* Z = (const bf16*)(F.ws + WS_Z); bf16* Y = (bf16*)(F.ws + WS_Y); const float* cw = INP(I_SCONV);
    for (int idx = gt; idx < M * 128; idx += NGT) {
        const int row = idx >> 7, c0 = (idx & 127) * 8;
        int t, L, rbase; if (row < ML) { t = row & (T - 1); L = T; rbase = row - t; } else { const int r2 = row - ML; t = r2 & (CT - 1); L = CT; rbase = row - t; }
        float acc[8];
#pragma unroll
        for (int i = 0; i < 8; ++i) acc[i] = 0.f;
#pragma unroll
        for (int tap = 0; tap < 3; ++tap) { const int tt = t + tap - 1;
            if (tt >= 0 && tt < L) { const bf16* zr = Z + (size_t)(rbase + tt) * 3072; const u32x4 cg = *(const u32x4*)(zr + 1024 + c0), hv = *(const u32x4*)(zr + 2048 + c0);
                const f32x4 w0 = *(const f32x4*)(cw + tap * 1024 + c0), w1 = *(const f32x4*)(cw + tap * 1024 + c0 + 4); const float w[8] = {w0.x, w0.y, w0.z, w0.w, w1.x, w1.y, w1.z, w1.w};
#pragma unroll
                for (int i = 0; i < 4; ++i) { acc[2 * i] += w[2 * i] * bf2f(cg[i] & 0xffffu) * bf2f(hv[i] & 0xffffu); acc[2 * i + 1] += w[2 * i + 1] * bf2f(cg[i] >> 16) * bf2f(hv[i] >> 16); } } }
        const u32x4 bg = *(const u32x4*)(Z + (size_t)row * 3072 + c0); u32x4 o;
#pragma unroll
        for (int i = 0; i < 4; ++i) o[i] = pk2(bf2f(bg[i] & 0xffffu) * acc[2 * i], bf2f(bg[i] >> 16) * acc[2 * i + 1]);
        *(u32x4*)(Y + (size_t)row * D + c0) = o;
    }
}

__device__ __forceinline__ void step_rope() {
    const Frame F = make_frame();
    const int gw = F.bid * NWAVES + F.wave, NGW = F.G * NWAVES;
    bf16* Z = (bf16*)(F.ws + WS_Z); const f32x4* R = (const f32x4*)(F.ws + WS_ROPE);
    for (int row = gw; row < M; row += NGW) {
        u32x4* p = (u32x4*)(Z + (size_t)row * 3072 + 32 * F.lane);
        u32x4 v[4];
#pragma unroll
        for (int q = 0; q < 4; ++q) v[q] = p[q];
        const bool lat = row < ML; const float sc = F.lane < 32 ? QSCALE : 1.0f;
        const f32x4* tab = R + ((size_t)(row & (T - 1)) * 32 + 16 * (F.lane & 1)) / 2;
#pragma unroll
        for (int q = 0; q < 4; ++q) {
#pragma unroll
            for (int i = 0; i < 4; i += 2) {
                f32x4 cs = (f32x4){1.f, 0.f, 1.f, 0.f}; if (lat) cs = tab[(4 * q + i) / 2];
                { const unsigned w = v[q][i]; const float x0 = bf2f(w & 0xffffu), x1 = bf2f(w >> 16); v[q][i] = pk2((x0 * cs.x - x1 * cs.y) * sc, (x0 * cs.y + x1 * cs.x) * sc); }
                { const unsigned w = v[q][i + 1]; const float x0 = bf2f(w & 0xffffu), x1 = bf2f(w >> 16); v[q][i + 1] = pk2((x0 * cs.z - x1 * cs.w) * sc, (x0 * cs.w + x1 * cs.z) * sc); }
            }
        }
#pragma unroll
        for (int q = 0; q < 4; ++q) p[q] = v[q];
    }
    bf16* Vt = (bf16*)(F.ws + WS_H);
    LAS bf16* tl = (LAS bf16*)(F.lds + F.wave * 18432);
    for (int it = gw; it < NB * NH * (NKV / 64); it += NGW) {
        const int kt = it % (NKV / 64), bh = it / (NKV / 64), b = bh >> 3, h = bh & 7; const int kv0 = 64 * kt;
        const int srow = kv0 < CT ? ML + b * CT + kv0 : b * T + kv0 - CT;
#pragma unroll 4
        for (int i = 0; i < 16; ++i) { const int r = 4 * i + (F.lane >> 4), cc = (F.lane & 15) * 8;
            const u32x4 v = *(const u32x4*)(Z + (size_t)(srow + r) * 3072 + 2048 + h * 128 + cc);
#pragma unroll
            for (int q = 0; q < 4; ++q) { tl[(cc + 2 * q) * 72 + r] = (bf16)(v[q] & 0xffffu); tl[(cc + 2 * q + 1) * 72 + r] = (bf16)(v[q] >> 16); } }
        LDS_WAIT(); asm volatile("" ::: "memory");
#pragma unroll 4
        for (int i = 0; i < 16; ++i) { const int e = 8 * i + (F.lane >> 3), ch = F.lane & 7;
            const u32x4 v = *(const LAS u32x4*)(tl + e * 72 + ch * 8);
            *(u32x4*)(Vt + ((size_t)(bh * 128 + e)) * NKV + kv0 + ch * 8) = v; }
        LDS_WAIT(); asm volatile("" ::: "memory");
    }
}
__device__ __forceinline__ void step_attn() {
    const Frame F = make_frame();
    const bf16* Z = (const bf16*)(F.ws + WS_Z); const bf16* Vt = (const bf16*)(F.ws + WS_H); bf16* Y = (bf16*)(F.ws + WS_Y);
    LAS float* EX = (LAS float*)F.lds;
    const int r = F.lane & 31, hi = F.lane >> 5, qs = F.wave & 3, m = F.wave >> 2;
    float lmb;
    { const float* lam = INP(I_DLAM); const float t1 = lam[F.lane] * lam[64 + F.lane], t2 = lam[128 + F.lane] * lam[192 + F.lane]; lmb = expf(wave_sum(t1)) - expf(wave_sum(t2)) + LAMBDA_INIT; }
    const float* ng = INP(I_DNG);
    for (int u = F.bid; u < 1056; u += F.G) {
        int b, h, qrow0, nk;
        if (u < 1024) { b = u >> 9; h = (u >> 6) & 7; qrow0 = b * T + (u & 63) * 128; nk = NKV / 32; }
        else { const int v = u - 1024; b = v >> 4; h = (v >> 1) & 7; qrow0 = ML + b * CT + (v & 1) * 128; nk = CT / 32; }
        const int row0 = qrow0 + 32 * qs;
        bf16x8 qf[4];
#pragma unroll
        for (int d0 = 0; d0 < 4; ++d0) qf[d0] = *(const bf16x8*)(Z + (size_t)(row0 + r) * 3072 + h * 128 + m * 64 + d0 * 16 + hi * 8);
        const int kcol = 1024 + h * 128 + m * 64 + hi * 8;
        const bf16* vtb = Vt + (size_t)((b * 8 + h) * 128 + r) * NKV + 4 * hi;
        f32x16 o[4];
#pragma unroll
        for (int i = 0; i < 4; ++i)
#pragma unroll
            for (int q = 0; q < 16; ++q) o[i][q] = 0.f;
        float mref = 0.f, l = 0.f;
        for (int s = 0; s < nk; ++s) {
            const int kv0 = 32 * s; const int krow = kv0 < CT ? ML + b * CT + kv0 : b * T + kv0 - CT;
            const bf16* kp = Z + (size_t)(krow + r) * 3072 + kcol;
            bf16x8 kf[4];
#pragma unroll
            for (int d0 = 0; d0 < 4; ++d0) kf[d0] = *(const bf16x8*)(kp + d0 * 16);
            bf16x8 vf[4][2];
#pragma unroll
            for (int i = 0; i < 4; ++i)
#pragma unroll
                for (int s2 = 0; s2 < 2; ++s2) { const bf16* vp = vtb + (size_t)(32 * i) * NKV + kv0 + 16 * s2; const s16x4 lo = *(const s16x4*)vp, h8 = *(const s16x4*)(vp + 8);
                    vf[i][s2] = (bf16x8){lo[0], lo[1], lo[2], lo[3], h8[0], h8[1], h8[2], h8[3]}; }
            f32x16 S;
#pragma unroll
            for (int q = 0; q < 16; ++q) S[q] = 0.f;
#pragma unroll
            for (int d0 = 0; d0 < 4; ++d0) S = __builtin_amdgcn_mfma_f32_32x32x16_bf16(kf[d0], qf[d0], S, 0, 0, 0);
            float mx = S[0];
#pragma unroll
            for (int q = 1; q < 16; ++q) mx = fmaxf(mx, S[q]);
            mx = fmaxf(mx, __shfl_xor(mx, 32));
            if (s == 0) mref = mx;
            else if (__any(mx > mref)) { const float mn = fmaxf(mref, mx); const float al = __builtin_amdgcn_exp2f(mref - mn); l *= al; mref = mn;
#pragma unroll
                for (int i = 0; i < 4; ++i)
#pragma unroll
                    for (int q = 0; q < 16; ++q) o[i][q] *= al; }
            float ps = 0.f;
#pragma unroll
            for (int q = 0; q < 16; ++q) { S[q] = __builtin_amdgcn_exp2f(S[q] - mref); ps += S[q]; }
            l += ps;
            bf16x8 pf[2];
#pragma unroll
            for (int s2 = 0; s2 < 2; ++s2) { u32x4 w; w.x = pk2(S[8 * s2], S[8 * s2 + 1]); w.y = pk2(S[8 * s2 + 2], S[8 * s2 + 3]); w.z = pk2(S[8 * s2 + 4], S[8 * s2 + 5]); w.w = pk2(S[8 * s2 + 6], S[8 * s2 + 7]); pf[s2] = __builtin_bit_cast(bf16x8, w); }
#pragma unroll
            for (int i = 0; i < 4; ++i)
#pragma unroll
                for (int s2 = 0; s2 < 2; ++s2) o[i] = __builtin_amdgcn_mfma_f32_32x32x16_bf16(vf[i][s2], pf[s2], o[i], 0, 0, 0);
        }
        l += __shfl_xor(l, 32);
        const float f = (m == 1 ? lmb : 1.0f) / l;
        LAS float* ex = EX + (size_t)m * 128 * 129 + (qs * 32 + r) * 129;
#pragma unroll
        for (int i = 0; i < 4; ++i)
#pragma unroll
            for (int q = 0; q < 16; ++q) ex[32 * i + crow(q, hi)] = o[i][q] * f;
        __syncthreads();
#pragma unroll 1
        for (int rr = 0; rr < 16; ++rr) { const int row = 16 * F.wave + rr;
            const float a0 = EX[row * 129 + F.lane] - EX[128 * 129 + row * 129 + F.lane], a1 = EX[row * 129 + 64 + F.lane] - EX[128 * 129 + row * 129 + 64 + F.lane];
            const float rstd = (1.0f - LAMBDA_INIT) / sqrtf(wave_sum(a0 * a0 + a1 * a1) * (1.f / 128.f) + EPS);
            bf16* yr = Y + (size_t)(qrow0 + row) * D + h * 128;
            yr[F.lane] = (bf16)(pk2(a0 * rstd * ng[F.lane], 0.f) & 0xffffu); yr[64 + F.lane] = (bf16)(pk2(a1 * rstd * ng[64 + F.lane], 0.f) & 0xffffu); }
        __syncthreads();
    }
}

#define PACK8(x, b) __builtin_bit_cast(bf16x8, (u32x4){pk2((x)[(b)], (x)[(b) + 1]), pk2((x)[(b) + 2], (x)[(b) + 3]), pk2((x)[(b) + 4], (x)[(b) + 5]), pk2((x)[(b) + 6], (x)[(b) + 7])})
#define MFMA32(a, b, c) __builtin_amdgcn_mfma_f32_32x32x16_bf16((a), (b), (c), 0, 0, 0)
constexpr int PD_BYTES = 12800, PD_ATT = 6144, PD_EG = 12288, PD_EW = 12544;
__device__ __forceinline__ unsigned off_a(unsigned row, unsigned ch) { return 2048u * (row >> 3) + 512u * (ch >> 2) + 64u * (row & 7) + 16u * ((ch & 3) ^ ((row >> 2) & 3)); }
__device__ __forceinline__ int frag_off(int c, int s) {
    const int slot = (c >> 5) == (s >> 5) ? ((c >> 5) ? 2 : 0) : 1, s2 = (s & 31) >> 4, hh = ((s & 15) >> 2) & 1, jj = ((s & 15) >> 3) * 4 + (s & 3), r = c & 31;
    return slot * 2048 + s2 * 1024 + (hh * 32 + r) * 16 + jj * 2;
}
__device__ __forceinline__ void step_gdn_prep(int j, bool overlap, unsigned* flags, bool dry = false, int skip = 0) {
    const Frame F = make_frame();
    LAS float* STG = (LAS float*)F.lds;
    LAS float* KK = (LAS float*)F.lds;
    LAS float* QK = KK + 64 * 68;
    LAS float* LP = (LAS float*)(F.lds + 34816);
    LAS float* TS = (LAS float*)(F.lds + 67584);
    LAS unsigned char* QI = F.lds + 102400; LAS unsigned char* KI = F.lds + 118784;
    LAS float* SM = (LAS float*)(F.lds + 135168);
    bf16* Z = (bf16*)(F.ws + WS_Z); const float* AB = (const float*)(F.ws + WS_AB); const bf16* HALO = (const bf16*)(F.ws + WS_HALO); unsigned char* PD = F.ws + WS_PD;
    const float* cw = INP(I_GCONV) + (size_t)j * 3 * 3072;
    const int r = F.lane & 31, hi = F.lane >> 5;
    const int first = overlap ? 32 : 0;
    for (int it = F.bid - first; it >= 0 && it < NB * NH * 132; it += F.G - first) {
        int n, bh;
        if (overlap) { bh = it & 15; const int pos = it >> 4;
            if (pos < 4) n = pos == 0 ? 0 : (pos == 1 ? 3 : (pos == 2 ? 1 : 2)); else { const int k = pos - 4; n = (k & 1) ? 131 - (k >> 1) : 4 + (k >> 1); } }
        else { n = it % 132; bh = it / 132; }
        const int b = bh >> 3, h = bh & 7;
        const bool isctx = n < 4; const int L = isctx ? CT : T; const int t0 = isctx ? 64 * n : 64 * (n - 4); const int row0 = (isctx ? ML + b * CT : b * T) + t0;
        if (F.tid < 384) {
            const int g8 = F.tid % 48, rp = F.tid / 48, part = g8 >> 4, e0 = (g8 & 15) * 8; const int col = part * 1024 + h * 128 + e0;
            const float* wp = cw + col;
            f32x4 wt[3][2];
#pragma unroll
            for (int tap = 0; tap < 3; ++tap) { wt[tap][0] = *(const f32x4*)(wp + tap * 3072); wt[tap][1] = *(const f32x4*)(wp + tap * 3072 + 4); }
            u32x4 zr[10];
#pragma unroll
            for (int ri = 0; ri < 10; ++ri) { const int c = 8 * rp - 1 + ri; const int t = t0 + c;
                const bf16* src = c < 0 ? HALO + ((size_t)((row0 >> 6) - 1) * 2 + 1) * 3072 + col : (c > 63 ? HALO + ((size_t)((row0 >> 6) + 1) * 2) * 3072 + col : Z + (size_t)(row0 + c) * 4096 + col);
                const bool valid = t >= 0 && t < L;
                if (!valid) src = Z + (size_t)row0 * 4096 + col;
                zr[ri] = *(const u32x4*)src; if (!valid) zr[ri] = (u32x4){0u, 0u, 0u, 0u}; }
#pragma unroll
            for (int i = 0; i < 8; ++i) { float o[8];
#pragma unroll
                for (int q = 0; q < 4; ++q) { const unsigned a = zr[i][q], bq = zr[i + 1][q], cq = zr[i + 2][q];
                    o[2 * q] = silu_fast(wt[0][q >> 1][2 * (q & 1)] * bf2f(a & 0xffffu) + wt[1][q >> 1][2 * (q & 1)] * bf2f(bq & 0xffffu) + wt[2][q >> 1][2 * (q & 1)] * bf2f(cq & 0xffffu));
                    o[2 * q + 1] = silu_fast(wt[0][q >> 1][2 * (q & 1) + 1] * bf2f(a >> 16) + wt[1][q >> 1][2 * (q & 1) + 1] * bf2f(bq >> 16) + wt[2][q >> 1][2 * (q & 1) + 1] * bf2f(cq >> 16)); }
                LAS f32x4* dst = (LAS f32x4*)(STG + (8 * rp + i) * 388 + part * 128 + e0); dst[0] = (f32x4){o[0], o[1], o[2], o[3]}; dst[1] = (f32x4){o[4], o[5], o[6], o[7]}; }
        }
        if (F.wave >= 6) {
            const int d = F.wave - 6, c = F.lane; const size_t row = (size_t)(row0 + c);
            const float Aco = expf(INP(I_GALOG)[j * 16 + d * 8 + h]), dtb = INP(I_GDT)[j * 16 + d * 8 + h];
            const float x = AB[row * 32 + d * 8 + h] + dtb, bb = AB[row * 32 + 16 + d * 8 + h];
            const float sp = x > 20.f ? x : log1pf(expf(x));
            float s = -Aco * sp;
#pragma unroll
            for (int o = 1; o < 64; o <<= 1) { const float up = __shfl_up(s, o), dn = __shfl_down(s, o); if (d ? (c + o < 64) : (c >= o)) s += d ? dn : up; }
            SM[d * 64 + c] = 1.f / (1.f + expf(-bb)); SM[128 + d * 64 + c] = s;
        }
        __syncthreads();
        if (skip & 8) continue;
        { float qv[8][2], kv[8][2], sq[8], sk[8];
#pragma unroll
            for (int rr = 0; rr < 8; ++rr) { const LAS float* sr = STG + (F.wave * 8 + rr) * 388;
                qv[rr][0] = sr[F.lane]; qv[rr][1] = sr[64 + F.lane]; kv[rr][0] = sr[128 + F.lane]; kv[rr][1] = sr[192 + F.lane];
                sq[rr] = qv[rr][0] * qv[rr][0] + qv[rr][1] * qv[rr][1]; sk[rr] = kv[rr][0] * kv[rr][0] + kv[rr][1] * kv[rr][1]; }
#pragma unroll
            for (int o = 1; o < 64; o <<= 1) {
#pragma unroll
                for (int rr = 0; rr < 8; ++rr) { sq[rr] += __shfl_xor(sq[rr], o); sk[rr] += __shfl_xor(sk[rr], o); } }
#pragma unroll
            for (int rr = 0; rr < 8; ++rr) { const int c = F.wave * 8 + rr; const LAS float* sr = STG + c * 388;
                const float fq = 0.08838834764831845f / sqrtf(sq[rr] + EPS), fk = 1.0f / sqrtf(sk[rr] + EPS);
                const unsigned o0 = off_a(c, F.lane >> 3) + 2 * (F.lane & 7), o1 = off_a(c, 8 + (F.lane >> 3)) + 2 * (F.lane & 7);
                *(LAS bf16*)(QI + o0) = (bf16)(pk2(qv[rr][0] * fq, 0.f) & 0xffffu); *(LAS bf16*)(QI + o1) = (bf16)(pk2(qv[rr][1] * fq, 0.f) & 0xffffu);
                *(LAS bf16*)(KI + o0) = (bf16)(pk2(kv[rr][0] * fk, 0.f) & 0xffffu); *(LAS bf16*)(KI + o1) = (bf16)(pk2(kv[rr][1] * fk, 0.f) & 0xffffu);
                bf16* vd = Z + (size_t)(row0 + c) * 4096 + 2048 + h * 128;
                if (!dry) { vd[F.lane] = (bf16)(pk2(sr[256 + F.lane], 0.f) & 0xffffu); vd[64 + F.lane] = (bf16)(pk2(sr[320 + F.lane], 0.f) & 0xffffu); } } }
        __syncthreads();
        if (skip & 4) continue;
        { const int prod = F.wave >> 2, mt = (F.wave >> 1) & 1, nt = F.wave & 1; LAS unsigned char* AI = prod ? QI : KI;
            f32x16 acc;
#pragma unroll
            for (int i = 0; i < 16; ++i) acc[i] = 0.f;
#pragma unroll
            for (int ks = 0; ks < 8; ++ks) { const bf16x8 a = *(const LAS bf16x8*)(AI + off_a(32 * mt + r, 2 * ks + hi)), bq = *(const LAS bf16x8*)(KI + off_a(32 * nt + r, 2 * ks + hi));
                acc = __builtin_amdgcn_mfma_f32_32x32x16_bf16(a, bq, acc, 0, 0, 0); }
            LAS float* dst = prod ? QK : KK;
#pragma unroll
            for (int i = 0; i < 16; ++i) dst[(32 * mt + crow(i, hi)) * 68 + 32 * nt + r] = acc[i]; }
        __syncthreads();
        if (skip & 2) continue;
        for (int idx = F.tid; idx < 8192; idx += NTHR) { const int d = idx >> 12, p = (idx >> 6) & 63, ps = idx & 63; float val = 0.f;
            if (ps < p) { const int c = d ? 63 - p : p, s = d ? 63 - ps : ps; val = SM[d * 64 + c] * KK[c * 68 + s] * expf(SM[128 + d * 64 + c] - SM[128 + d * 64 + s]); }
            LP[idx] = val; }
        __syncthreads();
        unsigned char* rec = PD + ((size_t)((b * 8 + h) * 132 + n)) * PD_BYTES;
        constexpr size_t DSTRIDE = (size_t)16 * 132 * PD_BYTES;
        float Tc[32];
#pragma unroll
        for (int p = 0; p < 32; ++p) Tc[p] = 0.f;
        if (F.wave < 4) { if (!(skip & 1)) {
            const int d = F.wave >> 1, blk = F.wave & 1, jj = F.lane & 31;
            float Lr[32];
#pragma unroll
            for (int p = 1; p < 32; ++p) Lr[p] = LP[d * 4096 + (32 * blk + p) * 64 + 32 * blk + jj];
#pragma unroll
            for (int p = 0; p < 32; ++p) { float acc[4]; acc[0] = (p == jj) ? 1.f : 0.f; acc[1] = 0.f; acc[2] = 0.f; acc[3] = 0.f;
#pragma unroll
                for (int sx = 0; sx < p; ++sx) { const float l = __int_as_float(__builtin_amdgcn_readlane(__float_as_int(Lr[p]), sx)); acc[sx & 3] -= l * Tc[sx]; }
                Tc[p] = (acc[0] + acc[1]) + (acc[2] + acc[3]); }
            if (F.lane < 32) { const int pc = 32 * blk + jj;
#pragma unroll
                for (int p = 0; p < 32; ++p) { const int pr = 32 * blk + p; TS[d * 4352 + (d ? 63 - pr : pr) * 68 + (d ? 63 - pc : pc)] = Tc[p]; } } }
        } else {
            for (int q = F.tid - 256; q < 768; q += NTHR - 256) { const int d = q / 384, qq = q % 384, slot = qq >> 7, s2 = (qq >> 6) & 1, ln = qq & 63, hh = ln >> 5, rr = ln & 31;
                const int mtr = slot == 0 ? 0 : (slot == 2 ? 1 : (d ? 0 : 1)), mtc = slot == 0 ? 0 : (slot == 2 ? 1 : (d ? 1 : 0));
                const int c = 32 * mtr + rr, sa = 32 * mtc + 16 * s2 + 4 * hh; const float gcc = SM[128 + d * 64 + c];
                const f32x4 qa = *(const LAS f32x4*)(QK + c * 68 + sa), qb = *(const LAS f32x4*)(QK + c * 68 + sa + 8);
                const f32x4 ga = *(const LAS f32x4*)(SM + 128 + d * 64 + sa), gb = *(const LAS f32x4*)(SM + 128 + d * 64 + sa + 8);
                float v[8];
#pragma unroll
                for (int i = 0; i < 4; ++i) { const int s0 = sa + i, s1 = sa + 8 + i; const bool m0 = d ? (s0 >= c) : (s0 <= c), m1 = d ? (s1 >= c) : (s1 <= c);
                    v[i] = m0 ? qa[i] * expf(gcc - ga[i]) : 0.f; v[4 + i] = m1 ? qb[i] * expf(gcc - gb[i]) : 0.f; }
                if (!dry) *(u32x4*)(rec + d * DSTRIDE + PD_ATT + qq * 16) = (u32x4){pk2(v[0], v[1]), pk2(v[2], v[3]), pk2(v[4], v[5]), pk2(v[6], v[7])}; }
            if (F.tid >= 256 && F.tid < 384) { const int d = (F.tid - 256) >> 6, c = F.tid & 63; const float gl = SM[128 + d * 64 + (d ? 0 : 63)], gcv = SM[128 + d * 64 + c];
                if (!dry) { *(float*)(rec + d * DSTRIDE + PD_EG + 4 * c) = expf(gcv); *(float*)(rec + d * DSTRIDE + PD_EW + 4 * c) = expf(gl - gcv); } }
        }
        __syncthreads();
        if ((F.wave == 0 || F.wave == 2) && !(skip & 1)) {
            const int d = F.wave >> 1;
            f32x16 Mx, R2;
#pragma unroll
            for (int i = 0; i < 16; ++i) { Mx[i] = 0.f; R2[i] = 0.f; }
#define INV_M(ks) do { const LAS f32x4* lp = (const LAS f32x4*)(LP + d * 4096 + (32 + r) * 64 + 16 * (ks) + 8 * hi); const f32x4 l0 = lp[0], l1 = lp[1]; \
                const bf16x8 A_ = __builtin_bit_cast(bf16x8, (u32x4){pk2(l0[0], l0[1]), pk2(l0[2], l0[3]), pk2(l1[0], l1[1]), pk2(l1[2], l1[3])}); \
                const bf16x8 B_ = __builtin_bit_cast(bf16x8, (u32x4){pk2(hi ? Tc[16 * (ks) + 8] : Tc[16 * (ks)], hi ? Tc[16 * (ks) + 9] : Tc[16 * (ks) + 1]), pk2(hi ? Tc[16 * (ks) + 10] : Tc[16 * (ks) + 2], hi ? Tc[16 * (ks) + 11] : Tc[16 * (ks) + 3]), \
                    pk2(hi ? Tc[16 * (ks) + 12] : Tc[16 * (ks) + 4], hi ? Tc[16 * (ks) + 13] : Tc[16 * (ks) + 5]), pk2(hi ? Tc[16 * (ks) + 14] : Tc[16 * (ks) + 6], hi ? Tc[16 * (ks) + 15] : Tc[16 * (ks) + 7])}); \
                Mx = MFMA32(A_, B_, Mx); } while (0)
            INV_M(0); INV_M(1);
#undef INV_M
#pragma unroll
            for (int ks = 0; ks < 2; ++ks) {
                const int cn = d ? 31 - r : 32 + r, ps0 = 32 + 16 * ks + 4 * hi;
                f32x4 ta, tb;
                if (d) { const f32x4 x0 = *(const LAS f32x4*)(TS + 4352 + cn * 68 + (60 - ps0)), x1 = *(const LAS f32x4*)(TS + 4352 + cn * 68 + (52 - ps0));
                    ta = (f32x4){x0[3], x0[2], x0[1], x0[0]}; tb = (f32x4){x1[3], x1[2], x1[1], x1[0]}; }
                else { ta = *(const LAS f32x4*)(TS + cn * 68 + ps0); tb = *(const LAS f32x4*)(TS + cn * 68 + ps0 + 8); }
                const bf16x8 A2 = __builtin_bit_cast(bf16x8, (u32x4){pk2(ta[0], ta[1]), pk2(ta[2], ta[3]), pk2(tb[0], tb[1]), pk2(tb[2], tb[3])});
                const bf16x8 B2 = ks == 0 ? PACK8(Mx, 0) : PACK8(Mx, 8);
                R2 = MFMA32(A2, B2, R2); }
#pragma unroll
            for (int i = 0; i < 16; ++i) { const int pr = 32 + crow(i, hi), pc = r; TS[d * 4352 + (d ? 63 - pr : pr) * 68 + (d ? 63 - pc : pc)] = -R2[i]; }
        }
        __syncthreads();
        for (int q = F.tid; q < 768; q += NTHR) { const int d = q / 384, qq = q % 384, slot = qq >> 7, s2 = (qq >> 6) & 1, ln = qq & 63, hh = ln >> 5, rr = ln & 31;
            const int mtr = slot == 0 ? 0 : (slot == 2 ? 1 : (d ? 0 : 1)), mtc = slot == 0 ? 0 : (slot == 2 ? 1 : (d ? 1 : 0));
            const int c = 32 * mtr + rr, sa = 32 * mtc + 16 * s2 + 4 * hh;
            const f32x4 ta = *(const LAS f32x4*)(TS + d * 4352 + c * 68 + sa), tb = *(const LAS f32x4*)(TS + d * 4352 + c * 68 + sa + 8);
            const f32x4 ba = *(const LAS f32x4*)(SM + d * 64 + sa), bb = *(const LAS f32x4*)(SM + d * 64 + sa + 8);
            if (!dry) *(u32x4*)(rec + d * DSTRIDE + qq * 16) = (u32x4){pk2(ta[0] * ba[0], ta[1] * ba[1]), pk2(ta[2] * ba[2], ta[3] * ba[3]), pk2(tb[0] * bb[0], tb[1] * bb[1]), pk2(tb[2] * bb[2], tb[3] * bb[3])}; }
        if (!dry) for (int idx = F.tid; idx < 2048; idx += NTHR) { const int img = idx >> 10, pn = idx & 1023;
            *(u32x4*)((unsigned char*)(Z + (size_t)(row0 + (pn >> 4)) * 4096 + img * 1024 + h * 128) + (pn & 15) * 16) = *(const LAS u32x4*)((img ? KI : QI) + pn * 16); }
        if (overlap && !dry) {
            asm volatile("s_waitcnt vmcnt(0)" ::: "memory");
            __syncthreads();
            if (F.tid == 0) { __builtin_amdgcn_fence(__ATOMIC_RELEASE, "agent"); asm volatile("s_waitcnt vmcnt(0)" ::: "memory");
                __hip_atomic_store(flags + bh * 132 + n, 1u, __ATOMIC_RELAXED, __HIP_MEMORY_SCOPE_AGENT); }
        }
        __syncthreads();
    }
}

typedef short v4i16_t __attribute__((ext_vector_type(4)));
__device__ __forceinline__ void step_convert_rest() {
    const Frame F = make_frame();
    if (F.bid >= 32 && F.G > 32)
        convert_weights(F.ws, 0xffffu & ~((1u << 0) | (1u << 4) | (1u << 8) | (1u << 10)), (F.bid - 32) * NWAVES + F.wave, (F.G - 32) * NWAVES, (F.bid - 32) * NTHR + F.tid, (F.G - 32) * NTHR, F.lds, F.wave, F.lane);
}
__device__ __forceinline__ void step_gdn_scan2(const unsigned* flags, int mode = 0) {
    const Frame F = make_frame();
    constexpr int BUF = 61952, B_K = 0, B_Q = 16384, B_V = 32768, B_PD = 49152;
    const bf16* Z = (const bf16*)(F.ws + WS_Z); const unsigned char* PD = F.ws + WS_PD;
    const int r = F.lane & 31, hi = F.lane >> 5;
    for (int it = F.bid; it < 32; it += F.G) {
        const int b = it >> 4, h = (it >> 1) & 7, dir = it & 1;
        const unsigned char* pdb = PD + (size_t)(((dir * 2 + b) * 8 + h) * 132) * PD_BYTES;
#define CHUNK_OF(sp) (dir ? ((sp) < 4 ? 3 - (sp) : 135 - (sp)) : (sp))
#define ROW0_OF(n) ((n) < 4 ? ML + b * CT + 64 * (n) : b * T + 64 * ((n) - 4))
        if (F.wave >= 4) {
            const int lt = F.tid - 256;
            u32x4 rg[16];
#define LOAD_CHUNK(sp) do { const int n_ = CHUNK_OF(sp); const int row0_ = ROW0_OF(n_); \
                _Pragma("unroll") for (int i = 0; i < 4; ++i) { const int pn = lt + 256 * i; const unsigned char* src = (const unsigned char*)(Z + (size_t)(row0_ + (pn >> 4)) * 4096 + h * 128) + (pn & 15) * 16; \
                    rg[i] = *(const u32x4*)(src + 2048); rg[4 + i] = *(const u32x4*)src; rg[8 + i] = *(const u32x4*)(src + 4096); \
                    rg[12 + i] = pn < 800 ? *(const u32x4*)(pdb + (size_t)n_ * PD_BYTES + pn * 16) : (u32x4){0u, 0u, 0u, 0u}; } } while (0)
#define WRITE_CHUNK(bufb) do { LAS unsigned char* base_ = F.lds + (bufb); \
                _Pragma("unroll") for (int i = 0; i < 4; ++i) { const int pn = lt + 256 * i; *(LAS u32x4*)(base_ + B_K + pn * 16) = rg[i]; *(LAS u32x4*)(base_ + B_Q + pn * 16) = rg[4 + i]; \
                    *(LAS u32x4*)(base_ + B_V + pn * 16) = rg[8 + i]; if (pn < 800) *(LAS u32x4*)(base_ + B_PD + pn * 16) = rg[12 + i]; } } while (0)
#define WAIT_CHUNK(sp) do { if (flags && F.wave == 4) { const unsigned* f_ = flags + (b * 8 + h) * 132 + CHUNK_OF(sp); unsigned spins_ = 0; \
                    while (__hip_atomic_load(f_, __ATOMIC_RELAXED, __HIP_MEMORY_SCOPE_AGENT) == 0u) { __builtin_amdgcn_s_sleep(2); if (++spins_ > (1u << 24)) break; } \
                    __builtin_amdgcn_fence(__ATOMIC_ACQUIRE, "agent"); asm volatile("s_waitcnt vmcnt(0)" ::: "memory"); } } while (0)
            WAIT_CHUNK(0); WAIT_CHUNK(1);
            __syncthreads();
            LOAD_CHUNK(0); WRITE_CHUNK(0); WAIT_CHUNK(2); LOAD_CHUNK(1);
            __syncthreads();
            for (int sp = 0; sp < 132; ++sp) {
                if (sp + 1 < 132) WRITE_CHUNK(((sp + 1) & 1) * BUF);
                if (sp + 3 < 132) WAIT_CHUNK(sp + 3);
                if (sp + 2 < 132) LOAD_CHUNK(sp + 2);
                __syncthreads();
            }
#undef WAIT_CHUNK
#undef LOAD_CHUNK
#undef WRITE_CHUNK
        } else {
            const int w = F.wave;
            f32x16 S[4];
#pragma unroll
            for (int kt = 0; kt < 4; ++kt)
#pragma unroll
                for (int i = 0; i < 16; ++i) S[kt][i] = 0.f;
            const int x = (r >> 2) & 3; const int rowb = 2048 * (r >> 3) + 64 * (r & 7);
            int oa[2], ob[2];
#pragma unroll
            for (int s2 = 0; s2 < 2; ++s2) { oa[s2] = rowb + 16 * ((2 * s2) ^ x) + 8 * hi; ob[s2] = rowb + 16 * ((2 * s2 + 1) ^ x) + 8 * hi; }
            const int blk = (F.lane >> 4) & 1, q = (F.lane & 15) >> 2, p = F.lane & 3, cb = 2 * blk + (p >> 1);
            int trb[2];
#pragma unroll
            for (int t = 0; t < 2; ++t) trb[t] = 64 * (4 * hi + q) + 8 * (p & 1) + 16 * (cb ^ ((2 * t + hi) & 3)) + 2048 * t;
            const int vb = 4 * hi * 256 + (32 * w + r) * 2;
            __syncthreads();
            __syncthreads();
            for (int sp = 0; sp < 132; ++sp) {
                const int n = CHUNK_OF(sp); const int row0 = ROW0_OF(n);
                LAS unsigned char* B = F.lds + (sp & 1) * BUF;
                LAS unsigned char* KI = B + B_K; LAS unsigned char* QI = B + B_Q; LAS unsigned char* VI = B + B_V; LAS unsigned char* PR = B + B_PD;
                bf16x8 Sb[4][2];
#pragma unroll
                for (int kt = 0; kt < 4; ++kt) { Sb[kt][0] = PACK8(S[kt], 0); Sb[kt][1] = PACK8(S[kt], 8); }
                f32x16 KS[2];
#pragma unroll
                for (int i = 0; i < 16; ++i) { KS[0][i] = 0.f; KS[1][i] = 0.f; }
#pragma unroll
                for (int kt = 0; kt < 4; ++kt) {
#pragma unroll
                    for (int s2 = 0; s2 < 2; ++s2)
#pragma unroll
                        for (int mt = 0; mt < 2; ++mt) {
                            const s16x4 k0 = *(const LAS s16x4*)(KI + 8192 * mt + 512 * kt + oa[s2]), k1 = *(const LAS s16x4*)(KI + 8192 * mt + 512 * kt + ob[s2]);
                            KS[mt] = MFMA32(((bf16x8){k0[0], k0[1], k0[2], k0[3], k1[0], k1[1], k1[2], k1[3]}), Sb[kt][s2], KS[mt]); }
                    asm volatile("" ::: "memory");
                }
                bf16x8 Rb[2][2];
#pragma unroll
                for (int mt = 0; mt < 2; ++mt) { f32x16 R;
#pragma unroll
                    for (int g = 0; g < 4; ++g) { const f32x4 e4 = *(const LAS f32x4*)(PR + PD_EG + 4 * (32 * mt + 8 * g + 4 * hi));
#pragma unroll
                        for (int i = 0; i < 4; ++i) { const float v = bf2f(*(const LAS bf16*)(VI + vb + (32 * mt + 8 * g + i) * 256)); R[4 * g + i] = v - e4[i] * KS[mt][4 * g + i]; } }
                    Rb[mt][0] = PACK8(R, 0); Rb[mt][1] = PACK8(R, 8); }
                f32x16 vn[2], o[2];
#pragma unroll
                for (int i = 0; i < 16; ++i) { vn[0][i] = 0.f; vn[1][i] = 0.f; }
#define TFR(base, slot, s2) (*(const LAS bf16x8*)(PR + (base) + (slot) * 2048 + (s2) * 1024 + F.lane * 16))
                vn[0] = MFMA32(TFR(0, 0, 0), Rb[0][0], vn[0]); vn[0] = MFMA32(TFR(0, 0, 1), Rb[0][1], vn[0]);
                vn[1] = MFMA32(TFR(0, 2, 0), Rb[1][0], vn[1]); vn[1] = MFMA32(TFR(0, 2, 1), Rb[1][1], vn[1]);
                if (dir) { vn[0] = MFMA32(TFR(0, 1, 0), Rb[1][0], vn[0]); vn[0] = MFMA32(TFR(0, 1, 1), Rb[1][1], vn[0]); }
                else     { vn[1] = MFMA32(TFR(0, 1, 0), Rb[0][0], vn[1]); vn[1] = MFMA32(TFR(0, 1, 1), Rb[0][1], vn[1]); }
                asm volatile("" ::: "memory");
                f32x16 QS[2];
#pragma unroll
                for (int i = 0; i < 16; ++i) { QS[0][i] = 0.f; QS[1][i] = 0.f; }
                if (!(mode & 2))
#pragma unroll
                for (int kt = 0; kt < 4; ++kt) {
#pragma unroll
                    for (int s2 = 0; s2 < 2; ++s2)
#pragma unroll
                        for (int mt = 0; mt < 2; ++mt) {
                            const s16x4 q0 = *(const LAS s16x4*)(QI + 8192 * mt + 512 * kt + oa[s2]), q1 = *(const LAS s16x4*)(QI + 8192 * mt + 512 * kt + ob[s2]);
                            QS[mt] = MFMA32(((bf16x8){q0[0], q0[1], q0[2], q0[3], q1[0], q1[1], q1[2], q1[3]}), Sb[kt][s2], QS[mt]); }
                    asm volatile("" ::: "memory");
                }
                bf16x8 Vb[2][2], Wb[2][2];
#pragma unroll
                for (int mt = 0; mt < 2; ++mt) { f32x16 W;
#pragma unroll
                    for (int g = 0; g < 4; ++g) { const f32x4 e4 = *(const LAS f32x4*)(PR + PD_EG + 4 * (32 * mt + 8 * g + 4 * hi)), w4 = *(const LAS f32x4*)(PR + PD_EW + 4 * (32 * mt + 8 * g + 4 * hi));
#pragma unroll
                        for (int i = 0; i < 4; ++i) { o[mt][4 * g + i] = e4[i] * QS[mt][4 * g + i]; W[4 * g + i] = w4[i] * vn[mt][4 * g + i]; } }
                    Vb[mt][0] = PACK8(vn[mt], 0); Vb[mt][1] = PACK8(vn[mt], 8); Wb[mt][0] = PACK8(W, 0); Wb[mt][1] = PACK8(W, 8); }
                if (!(mode & 2)) {
                o[0] = MFMA32(TFR(PD_ATT, 0, 0), Vb[0][0], o[0]); o[0] = MFMA32(TFR(PD_ATT, 0, 1), Vb[0][1], o[0]);
                o[1] = MFMA32(TFR(PD_ATT, 2, 0), Vb[1][0], o[1]); o[1] = MFMA32(TFR(PD_ATT, 2, 1), Vb[1][1], o[1]);
                if (dir) { o[0] = MFMA32(TFR(PD_ATT, 1, 0), Vb[1][0], o[0]); o[0] = MFMA32(TFR(PD_ATT, 1, 1), Vb[1][1], o[0]); }
                else     { o[1] = MFMA32(TFR(PD_ATT, 1, 0), Vb[0][0], o[1]); o[1] = MFMA32(TFR(PD_ATT, 1, 1), Vb[0][1], o[1]); }
                }
#undef TFR
                asm volatile("" ::: "memory");
                const float cd = *(const LAS float*)(PR + PD_EG + 4 * (dir ? 0 : 63));
#pragma unroll
                for (int kt = 0; kt < 4; ++kt)
#pragma unroll
                    for (int i = 0; i < 16; ++i) S[kt][i] *= cd;
#pragma unroll
                for (int mt = 0; mt < 2; ++mt)
#pragma unroll
                    for (int s2 = 0; s2 < 2; ++s2) {
#pragma unroll
                        for (int kt = 0; kt < 4; ++kt) {
                            const s16x4 a0 = __builtin_bit_cast(s16x4, __builtin_amdgcn_ds_read_tr16_b64_v4i16((LAS v4i16_t*)(KI + 8192 * mt + 4096 * s2 + 512 * kt + trb[0])));
                            const s16x4 a1 = __builtin_bit_cast(s16x4, __builtin_amdgcn_ds_read_tr16_b64_v4i16((LAS v4i16_t*)(KI + 8192 * mt + 4096 * s2 + 512 * kt + trb[1])));
                            S[kt] = MFMA32(((bf16x8){a0[0], a0[1], a0[2], a0[3], a1[0], a1[1], a1[2], a1[3]}), Wb[mt][s2], S[kt]); }
                        asm volatile("" ::: "memory");
                    }
                if (!(mode & 1)) { bf16* ob_ = n < 4 ? (bf16*)(F.ws + WS_OFC) + ((size_t)dir * MC + (row0 - ML)) * D : (bf16*)F.out + ((size_t)dir * ML + row0) * D;
                    bf16* oc = ob_ + h * 128 + 32 * w + r;
#pragma unroll
                    for (int mt = 0; mt < 2; ++mt)
#pragma unroll
                        for (int i = 0; i < 16; ++i) oc[(size_t)(32 * mt + crow(i, hi)) * D] = (bf16)(pk2(o[mt][i], 0.f) & 0xffffu); }
                __syncthreads();
            }
        }
#undef CHUNK_OF
#undef ROW0_OF
    }
}
__device__ __forceinline__ void step_gdn_norm2(int j) {
    const Frame F = make_frame();
    const int gw = F.bid * NWAVES + F.wave, NGW = F.G * NWAVES;
    const bf16* Z = (const bf16*)(F.ws + WS_Z); bf16* Y = (bf16*)(F.ws + WS_Y); const float* ng = INP(I_GNG) + j * 128;
    for (int row = gw; row < M; row += NGW) {
        const bf16* of = row < ML ? (const bf16*)F.out + (size_t)row * D : (const bf16*)(F.ws + WS_OFC) + (size_t)(row - ML) * D;
        const bf16* ob = row < ML ? of + (size_t)ML * D : of + (size_t)MC * D;
        const u32x4* f4 = (const u32x4*)(of + 16 * F.lane); const u32x4* b4 = (const u32x4*)(ob + 16 * F.lane);
        float v[16]; float ss = 0.f;
#pragma unroll
        for (int q = 0; q < 2; ++q) { const u32x4 a = f4[q], bq = b4[q];
#pragma unroll
            for (int i = 0; i < 4; ++i) { const float x0 = bf2f(a[i] & 0xffffu) + bf2f(bq[i] & 0xffffu), x1 = bf2f(a[i] >> 16) + bf2f(bq[i] >> 16); v[8 * q + 2 * i] = x0; v[8 * q + 2 * i + 1] = x1; ss += x0 * x0 + x1 * x1; } }
        ss += __shfl_xor(ss, 1); ss += __shfl_xor(ss, 2); ss += __shfl_xor(ss, 4);
        const float rstd = 1.0f / sqrtf(ss * (1.f / 128.f) + EPS);
        const u32x4* g4 = (const u32x4*)(Z + (size_t)row * 4096 + 3072 + 16 * F.lane);
        const int e0 = (16 * F.lane) & 127;
        u32x4 o[2];
#pragma unroll
        for (int q = 0; q < 2; ++q) { const u32x4 gz = g4[q]; unsigned wv[4];
#pragma unroll
            for (int i = 0; i < 4; ++i) { const unsigned gg = gz[i]; const float g0 = bf2f(gg & 0xffffu), g1 = bf2f(gg >> 16); const int e = e0 + 8 * q + 2 * i;
                wv[i] = pk2(v[8 * q + 2 * i] * rstd * ng[e] * silu_f(g0), v[8 * q + 2 * i + 1] * rstd * ng[e + 1] * silu_f(g1)); }
            o[q] = (u32x4){wv[0], wv[1], wv[2], wv[3]}; }
        u32x4* dst = (u32x4*)(Y + (size_t)row * D + 16 * F.lane); dst[0] = o[0]; dst[1] = o[1];
    }
}

__device__ __forceinline__ void step_rope2() {
    const Frame F = make_frame();
    const int gw = F.bid * NWAVES + F.wave, NGW = F.G * NWAVES;
    bf16* Z = (bf16*)(F.ws + WS_Z); const f32x4* R = (const f32x4*)(F.ws + WS_ROPE);
    for (int row = gw; row < M; row += NGW) {
        u32x4* p = (u32x4*)(Z + (size_t)row * 3072 + 32 * F.lane);
        u32x4 v[4];
#pragma unroll
        for (int q = 0; q < 4; ++q) v[q] = p[q];
        const bool lat = row < ML; const float sc = F.lane < 32 ? QSCALE : 1.0f;
        const f32x4* tab = R + ((size_t)(row & (T - 1)) * 32 + 16 * (F.lane & 1)) / 2;
#pragma unroll
        for (int q = 0; q < 4; ++q) {
#pragma unroll
            for (int i = 0; i < 4; i += 2) {
                f32x4 cs = (f32x4){1.f, 0.f, 1.f, 0.f}; if (lat) cs = tab[(4 * q + i) / 2];
                { const unsigned w = v[q][i]; const float x0 = bf2f(w & 0xffffu), x1 = bf2f(w >> 16); v[q][i] = pk2((x0 * cs.x - x1 * cs.y) * sc, (x0 * cs.y + x1 * cs.x) * sc); }
                { const unsigned w = v[q][i + 1]; const float x0 = bf2f(w & 0xffffu), x1 = bf2f(w >> 16); v[q][i + 1] = pk2((x0 * cs.z - x1 * cs.w) * sc, (x0 * cs.w + x1 * cs.z) * sc); }
            }
        }
#pragma unroll
        for (int q = 0; q < 4; ++q) p[q] = v[q];
    }
}
#define ATT_THR 4.0f
__device__ __forceinline__ void att_softmax(f32x16& p0, f32x16& p1, float& m_reg, float& l, float& alpha, bf16x8 (&pf)[2][2]) {
    float mx = fmaxf(p0[0], p1[0]);
#pragma unroll
    for (int q = 1; q < 16; ++q) mx = fmaxf(mx, fmaxf(p0[q], p1[q]));
    mx = fmaxf(mx, __shfl_xor(mx, 32));
    const float mn = (mx - m_reg > ATT_THR) ? mx : m_reg; alpha = __builtin_amdgcn_exp2f(m_reg - mn); m_reg = mn;
    float ps = 0.f;
#pragma unroll
    for (int q = 0; q < 16; ++q) { p0[q] = __builtin_amdgcn_exp2f(p0[q] - m_reg); p1[q] = __builtin_amdgcn_exp2f(p1[q] - m_reg); ps += p0[q] + p1[q]; }
    l = l * alpha + ps;
    pf[0][0] = PACK8(p0, 0); pf[0][1] = PACK8(p0, 8); pf[1][0] = PACK8(p1, 0); pf[1][1] = PACK8(p1, 8);
}
__device__ __forceinline__ void step_attn2(int mode = 0) {
    const Frame F = make_frame();
    const bf16* Z = (const bf16*)(F.ws + WS_Z); bf16* Y = (bf16*)(F.ws + WS_Y);
    LAS float* EX = (LAS float*)F.lds;
    constexpr int KB0 = 0, VB0 = 65536;
    const int r = F.lane & 31, hi = F.lane >> 5, qs = F.wave & 3, m = F.wave >> 2;
    float lmb;
    { const float* lam = INP(I_DLAM); const float t1 = lam[F.lane] * lam[64 + F.lane], t2 = lam[128 + F.lane] * lam[192 + F.lane]; lmb = expf(wave_sum(t1)) - expf(wave_sum(t2)) + LAMBDA_INIT; }
    const float* ng = INP(I_DNG);
    const int kro = 2048 * (r >> 3) + 64 * (r & 7); const int xk = (r >> 2) & 3;
    int koff[2];
#pragma unroll
    for (int d0 = 0; d0 < 2; ++d0) koff[d0] = kro + 1024 * m + 16 * (((2 * d0 + hi) & 3) ^ xk);
    const int blk = (F.lane >> 4) & 1, q4 = (F.lane & 15) >> 2, p4 = F.lane & 3, cb = 2 * blk + (p4 >> 1);
    int trb[2];
#pragma unroll
    for (int t = 0; t < 2; ++t) trb[t] = 64 * (4 * hi + q4) + 8 * (p4 & 1) + 16 * (cb ^ ((2 * t + hi) & 3)) + 2048 * t;
    const int drow = 8 * F.wave + ((F.lane & 31) >> 2);
    const unsigned goff = (unsigned)(drow * 6144 + 16 * (4 * (F.lane >> 5) + ((F.lane & 3) ^ ((drow >> 2) & 3))));
    const unsigned ldsw = (unsigned)F.wave * 2048u;
    const int xcd = F.bid & 7, cux = F.bid >> 3;
    for (int ui = 0; ui < 5; ++ui) {
        int b, h, qrow0, nt;
        if (F.G == 256) {
            h = xcd;
            if (ui < 4) { b = ui >> 1; qrow0 = b * T + (cux + 32 * (ui & 1)) * 128; nt = NKV / 64; }
            else { if (cux >= 4) break; b = cux >> 1; qrow0 = ML + b * CT + (cux & 1) * 128; nt = CT / 64; }
        } else {
            const int u = F.bid + ui * F.G; if (u >= 1056) break;
            if (u < 1024) { b = u >> 9; h = (u >> 6) & 7; qrow0 = b * T + (u & 63) * 128; nt = NKV / 64; }
            else { const int v = u - 1024; b = v >> 4; h = (v >> 1) & 7; qrow0 = ML + b * CT + (v & 1) * 128; nt = CT / 64; }
        }
        const int row0 = qrow0 + 32 * qs;
        bf16x8 qf[4];
#pragma unroll
        for (int d0 = 0; d0 < 4; ++d0) qf[d0] = *(const bf16x8*)(Z + (size_t)(row0 + r) * 3072 + h * 128 + m * 64 + d0 * 16 + hi * 8);
        asm volatile("" : "+v"(qf[0]), "+v"(qf[1]), "+v"(qf[2]), "+v"(qf[3]));
        asm volatile("s_waitcnt vmcnt(0)" ::: "memory");
        const char* kgb = (const char*)(Z + 1024 + h * 128); const char* vgb = (const char*)(Z + 2048 + h * 128);
#define KVROW(t) ((t) < CT / 64 ? ML + b * CT + 64 * (t) : b * T + 64 * (t) - CT)
#define DMAK(t) do { if (mode & 8) break; const int t_ = (t) < nt ? (t) : nt - 1; const char* g_ = kgb + (size_t)KVROW(t_) * 6144 + goff; LAS unsigned char* d_ = F.lds + KB0 + ((t) & 3) * 16384 + ldsw; \
            __builtin_amdgcn_global_load_lds((const unsigned*)g_, (LAS unsigned*)d_, 16, 0, 0); __builtin_amdgcn_global_load_lds((const unsigned*)(g_ + 128), (LAS unsigned*)(d_ + 1024), 16, 0, 0); } while (0)
#define DMAV(t) do { if (mode & 8) break; const int t_ = (t) < nt ? (t) : nt - 1; const char* g_ = vgb + (size_t)KVROW(t_) * 6144 + goff; LAS unsigned char* d_ = F.lds + VB0 + ((t) & 3) * 16384 + ldsw; \
            __builtin_amdgcn_global_load_lds((const unsigned*)g_, (LAS unsigned*)d_, 16, 0, 0); __builtin_amdgcn_global_load_lds((const unsigned*)(g_ + 128), (LAS unsigned*)(d_ + 1024), 16, 0, 0); } while (0)
#define WAIT_BAR(N) do { asm volatile("s_waitcnt vmcnt(" #N ") lgkmcnt(0)" ::: "memory"); __builtin_amdgcn_s_barrier(); asm volatile("" ::: "memory"); } while (0)
#define KRD(KI_, f, S) S = *(const LAS bf16x8*)((KI_) + 8192 * ((f) & 1) + 512 * ((f) >> 2) + koff[((f) >> 1) & 1])
#define KMF(f, S, P0, P1) do { if ((f) & 1) P1 = MFMA32(S, qf[(f) >> 1], P1); else P0 = MFMA32(S, qf[(f) >> 1], P0); asm volatile("" ::: "memory"); } while (0)
#define QKT(P0, P1, t) do { LAS unsigned char* KI_ = F.lds + KB0 + ((t) & 3) * 16384; bf16x8 kA, kB, kC; \
            _Pragma("unroll") for (int q_ = 0; q_ < 16; ++q_) { P0[q_] = 0.f; P1[q_] = 0.f; } \
            KRD(KI_, 0, kA); KRD(KI_, 1, kB); \
            KRD(KI_, 2, kC); KMF(0, kA, P0, P1); KRD(KI_, 3, kA); KMF(1, kB, P0, P1); KRD(KI_, 4, kB); KMF(2, kC, P0, P1); KRD(KI_, 5, kC); KMF(3, kA, P0, P1); \
            KRD(KI_, 6, kA); KMF(4, kB, P0, P1); KRD(KI_, 7, kB); KMF(5, kC, P0, P1); KMF(6, kA, P0, P1); KMF(7, kB, P0, P1); } while (0)
#define VRD(VI_, f, S0, S1) do { S0 = __builtin_bit_cast(s16x4, __builtin_amdgcn_ds_read_tr16_b64_v4i16((LAS v4i16_t*)((VI_) + 8192 * (((f) >> 1) & 1) + 4096 * ((f) & 1) + 512 * ((f) >> 2) + trb[0]))); \
            S1 = __builtin_bit_cast(s16x4, __builtin_amdgcn_ds_read_tr16_b64_v4i16((LAS v4i16_t*)((VI_) + 8192 * (((f) >> 1) & 1) + 4096 * ((f) & 1) + 512 * ((f) >> 2) + trb[1]))); } while (0)
#define VMF(f, S0, S1, PF) do { if (!(mode & 4)) o[(f) >> 2] = MFMA32(((bf16x8){S0[0], S0[1], S0[2], S0[3], S1[0], S1[1], S1[2], S1[3]}), PF[((f) >> 1) & 1][(f) & 1], o[(f) >> 2]); asm volatile("" ::: "memory"); } while (0)
#define PVQ0(VI_, PF) do { VRD(VI_, 0, vA0, vA1); VRD(VI_, 1, vB0, vB1); VRD(VI_, 2, vC0, vC1); VMF(0, vA0, vA1, PF); VRD(VI_, 3, vA0, vA1); VMF(1, vB0, vB1, PF); VRD(VI_, 4, vB0, vB1); VMF(2, vC0, vC1, PF); VRD(VI_, 5, vC0, vC1); VMF(3, vA0, vA1, PF); } while (0)
#define PVQ1(VI_, PF) do { VRD(VI_, 6, vA0, vA1); VMF(4, vB0, vB1, PF); VRD(VI_, 7, vB0, vB1); VMF(5, vC0, vC1, PF); VRD(VI_, 8, vC0, vC1); VMF(6, vA0, vA1, PF); VRD(VI_, 9, vA0, vA1); VMF(7, vB0, vB1, PF); } while (0)
#define PVQ2(VI_, PF) do { VRD(VI_, 10, vB0, vB1); VMF(8, vC0, vC1, PF); VRD(VI_, 11, vC0, vC1); VMF(9, vA0, vA1, PF); VRD(VI_, 12, vA0, vA1); VMF(10, vB0, vB1, PF); VRD(VI_, 13, vB0, vB1); VMF(11, vC0, vC1, PF); } while (0)
#define PVQ3(VI_, PF) do { VRD(VI_, 14, vC0, vC1); VMF(12, vA0, vA1, PF); VRD(VI_, 15, vA0, vA1); VMF(13, vB0, vB1, PF); VMF(14, vC0, vC1, PF); VMF(15, vA0, vA1, PF); } while (0)
#define PVT(t, PF) do { LAS unsigned char* VI_ = F.lds + VB0 + ((t) & 3) * 16384; PVQ0(VI_, PF); PVQ1(VI_, PF); PVQ2(VI_, PF); PVQ3(VI_, PF); } while (0)
#define SM_MAX() do { float mx_ = fmaxf(c0[0], c1[0]); _Pragma("unroll") for (int q_ = 1; q_ < 16; ++q_) mx_ = fmaxf(mx_, fmaxf(c0[q_], c1[q_])); \
            mx_ = fmaxf(mx_, __shfl_xor(mx_, 32)); const float mn_ = (mx_ - mref > ATT_THR) ? mx_ : mref; al = __builtin_amdgcn_exp2f(mref - mn_); mref = mn_; ps = 0.f; } while (0)
#define SM_EXP(C, B, DST) do { if (!(mode & 2)) { _Pragma("unroll") for (int q_ = 0; q_ < 8; ++q_) { C[(B) + q_] = __builtin_amdgcn_exp2f(C[(B) + q_] - mref); ps += C[(B) + q_]; } } DST = PACK8(C, B); } while (0)
#define RESC(al) do { if (__any((al) < 1.f)) { _Pragma("unroll") for (int i = 0; i < 4; ++i) _Pragma("unroll") for (int q_ = 0; q_ < 16; ++q_) o[i][q_] *= (al); } } while (0)
#define SBAR() __builtin_amdgcn_sched_barrier(0)
#define ATT_STEP(j, PFC, PFP) do { \
            WAIT_BAR(8); DMAK((j) + 3); DMAV((j) + 2); \
            SBAR(); QKT(c0, c1, j); SBAR(); \
            { LAS unsigned char* VI_ = F.lds + VB0 + (((j) - 1) & 3) * 16384; \
              PVQ0(VI_, PFP); SM_MAX(); SBAR(); \
              PVQ1(VI_, PFP); SM_EXP(c0, 0, PFC[0][0]); SM_EXP(c0, 8, PFC[0][1]); SBAR(); \
              PVQ2(VI_, PFP); SM_EXP(c1, 0, PFC[1][0]); SBAR(); \
              PVQ3(VI_, PFP); SM_EXP(c1, 8, PFC[1][1]); l = l * al + ps; SBAR(); } \
            RESC(al); } while (0)
        s16x4 vA0, vA1, vB0, vB1, vC0, vC1;
        f32x16 o[4];
#pragma unroll
        for (int i = 0; i < 4; ++i)
#pragma unroll
            for (int q = 0; q < 16; ++q) o[i][q] = 0.f;
        float mref = -1e30f, l = 0.f, al = 1.f, ps = 0.f;
        f32x16 c0, c1; bf16x8 pfA[2][2], pfB[2][2];
        DMAK(0); DMAV(0); DMAK(1); DMAV(1); DMAK(2);
        WAIT_BAR(6); DMAK(3); DMAV(2);
        QKT(c0, c1, 0); SM_MAX(); SM_EXP(c0, 0, pfA[0][0]); SM_EXP(c0, 8, pfA[0][1]); SM_EXP(c1, 0, pfA[1][0]); SM_EXP(c1, 8, pfA[1][1]); l = l * al + ps;
        for (int j = 1; j + 1 < nt; j += 2) {
            ATT_STEP(j, pfB, pfA);
            ATT_STEP(j + 1, pfA, pfB);
        }
        ATT_STEP(nt - 1, pfB, pfA);
        WAIT_BAR(0);
        PVT(nt - 1, pfB);
        WAIT_BAR(0);
#undef DMAK
#undef DMAV
#undef WAIT_BAR
#undef QKT
#undef PVT
#undef PVQ0
#undef PVQ1
#undef PVQ2
#undef PVQ3
#undef VRD
#undef VMF
#undef KRD
#undef KMF
#undef SM_MAX
#undef SM_EXP
#undef RESC
#undef SBAR
#undef ATT_STEP
#undef KVROW
        l += __shfl_xor(l, 32);
        const float f = (m == 1 ? lmb : 1.0f) / l;
        LAS float* ex = EX + (size_t)m * 128 * 129 + (qs * 32 + r) * 129;
#pragma unroll
        for (int i = 0; i < 4; ++i)
#pragma unroll
            for (int q = 0; q < 16; ++q) ex[32 * i + crow(q, hi)] = o[i][q] * f;
        __syncthreads();
#pragma unroll 1
        for (int rr = 0; rr < 16; ++rr) { const int row = 16 * F.wave + rr;
            const float a0 = EX[row * 129 + F.lane] - EX[128 * 129 + row * 129 + F.lane], a1 = EX[row * 129 + 64 + F.lane] - EX[128 * 129 + row * 129 + 64 + F.lane];
            const float rstd = (1.0f - LAMBDA_INIT) / sqrtf(wave_sum(a0 * a0 + a1 * a1) * (1.f / 128.f) + EPS);
            bf16* yr = Y + (size_t)(qrow0 + row) * D + h * 128;
            if (!(mode & 1)) { yr[F.lane] = (bf16)(pk2(a0 * rstd * ng[F.lane], 0.f) & 0xffffu); yr[64 + F.lane] = (bf16)(pk2(a1 * rstd * ng[64 + F.lane], 0.f) & 0xffffu); } }
        __syncthreads();
    }
}

#define XB_TMO      128
#define XB_XCNT(j)  (256  + 64 * (j))
#define XB_XSUB(j)  (1280 + 64 * (j))
#define XB_XGEN(j)  (2304 + 64 * (j))
#define XB_TOP      3328
#define XB_TOPGEN   3392
#define XCD_BAR_WORDS 3456
#define XB_SPIN_CAP (1u << 18)

__device__ __forceinline__ unsigned xb_ld(unsigned* p)              { return __hip_atomic_load(p, __ATOMIC_RELAXED, __HIP_MEMORY_SCOPE_AGENT); }
__device__ __forceinline__ unsigned xb_add(unsigned* p, unsigned v) { return __hip_atomic_fetch_add(p, v, __ATOMIC_RELAXED, __HIP_MEMORY_SCOPE_AGENT); }
__device__ __forceinline__ unsigned xb_xcc_id() { return (unsigned)__builtin_amdgcn_s_getreg((3 << 11) | 20) & 0xFu; }
#define XB_SPIN(cond, bar) do { unsigned _sp = 0; while (cond) { __builtin_amdgcn_s_sleep(1); \
    if ((++_sp & 255u) == 0u) { if (xb_ld(&(bar)[XB_TMO])) break; if (_sp > XB_SPIN_CAP) { atomicAdd(&(bar)[XB_TMO], 1u); break; } } } } while (0)

struct XcdBarrier {
    unsigned* bar; unsigned x;
    volatile LAS unsigned* st;
};

__device__ __forceinline__ XcdBarrier xcd_barrier_post(unsigned* bar, volatile LAS unsigned* st) {
    XcdBarrier b; b.bar = bar; b.x = xb_xcc_id(); b.st = st;
    if (threadIdx.x == 0) (void)xb_add(&bar[XB_XCNT(b.x)], 1u);
    return b;
}
__device__ __forceinline__ void xcd_barrier_complete(unsigned* bar, unsigned x, unsigned& nloc, unsigned& nx) {
    const unsigned G = gridDim.x * gridDim.y * gridDim.z;
    unsigned sum, cnt, mine, sp = 0u;
    for (;;) {
        sum = 0u; cnt = 0u; mine = 0u;
#pragma unroll
        for (unsigned j = 0; j < 16; ++j) { const unsigned c = xb_ld(&bar[XB_XCNT(j)]); sum += c; cnt += (c > 0u) ? 1u : 0u; mine = (j == x) ? c : mine; }
        if (sum == G) break;
        __builtin_amdgcn_s_sleep(1);
        if ((++sp & 255u) == 0u) { if (xb_ld(&bar[XB_TMO])) break; if (sp > XB_SPIN_CAP) { atomicAdd(&bar[XB_TMO], 1u); break; } }
    }
    nloc = mine > 0u ? mine : 1u; nx = cnt > 0u ? cnt : 1u;
}

__device__ __forceinline__ void xcd_barrier(const XcdBarrier& b) {
    asm volatile("s_waitcnt vmcnt(0)" ::: "memory");
    __syncthreads();
    if (threadIdx.x == 0) {
        unsigned* bar = b.bar;
        __builtin_amdgcn_s_waitcnt(0);
        unsigned nloc = b.st[0], nx = b.st[1];
        if (nloc == 0u) { xcd_barrier_complete(bar, b.x, nloc, nx); b.st[0] = nloc; b.st[1] = nx; }
        const unsigned old = xb_add(&bar[XB_XSUB(b.x)], 1u);
        const unsigned gen = old / nloc;
        if (old + 1u == (gen + 1u) * nloc) {
            __builtin_amdgcn_fence(__ATOMIC_RELEASE, "agent");
            asm volatile("s_waitcnt vmcnt(0)" ::: "memory");
            const unsigned og = xb_add(&bar[XB_TOP], 1u);
            const unsigned tg = og / nx;
            if (og + 1u == (tg + 1u) * nx) xb_add(&bar[XB_TOPGEN], 1u);
            else XB_SPIN(xb_ld(&bar[XB_TOPGEN]) == tg, bar);
            __builtin_amdgcn_fence(__ATOMIC_ACQUIRE, "agent");
            xb_add(&bar[XB_XGEN(b.x)], 1u);
            asm volatile("s_waitcnt vmcnt(0)" ::: "memory");
        } else {
            XB_SPIN(xb_ld(&bar[XB_XGEN(b.x)]) == gen, bar);
            __builtin_amdgcn_fence(__ATOMIC_ACQUIRE, "agent");
            asm volatile("s_waitcnt vmcnt(0)" ::: "memory");
        }
    }
    __syncthreads();
}

#ifndef MK_SINGLE
#define MK_SINGLE 1
#endif
constexpr int NSTEPS = 1 + 9 + 7 + 8 + 9 + 1;
struct SEpiStore { bf16* O; int ldc; int act; bf16* halo;
    __device__ __forceinline__ void operator()(const float (&v8)[8], int m, int n0, int hi, int half) const {
#pragma unroll
        for (int g = 0; g < 2; ++g) { float v[4];
#pragma unroll
            for (int i = 0; i < 4; ++i) { v[i] = v8[4 * g + i]; if (act) { const float t = fmaxf(v[i], 0.f); v[i] = t * t; } }
            const u32x2 w = (u32x2){pk2(v[0], v[1]), pk2(v[2], v[3])}; const int n = n0 + 8 * (2 * half + g) + 4 * hi;
            *(u32x2*)(O + (size_t)m * ldc + n) = w;
            if (halo && n < 3072 && (((m & 63) == 0) || ((m & 63) == 63))) *(u32x2*)(halo + ((size_t)(m >> 6) * 2 + ((m & 63) ? 1 : 0)) * 3072 + n) = w; } } };
struct SEpiResid { float* X; const float* Xin; const float* gate;
    __device__ __forceinline__ void operator()(const float (&v8)[8], int m, int n0, int hi, int half) const {
#pragma unroll
        for (int g = 0; g < 2; ++g) { const int n = n0 + 8 * (2 * half + g) + 4 * hi; float* p = X + (size_t)m * D + n; const f32x4 gv = *(const f32x4*)(gate + n);
            *(f32x4*)p = *(const f32x4*)(Xin + (size_t)m * D + n) + gv * (f32x4){v8[4 * g], v8[4 * g + 1], v8[4 * g + 2], v8[4 * g + 3]}; } } };
struct SEpiAB { float* AB;
    __device__ __forceinline__ void operator()(const float (&v8)[8], int m, int n0, int hi, int half) const {
        if (n0 == 0) {
#pragma unroll
            for (int g = 0; g < 2; ++g) *(f32x4*)(AB + (size_t)m * 32 + 8 * (2 * half + g) + 4 * hi) = (f32x4){v8[4 * g], v8[4 * g + 1], v8[4 * g + 2], v8[4 * g + 3]}; } } };
template <class Epi> __device__ __forceinline__ void small_gemm(const bf16* A, const bf16* Bt, int row_lo, int nrows, int N, int K, const Epi& E) {
    int tid = threadIdx.x; asm volatile("" : "+v"(tid));
    const int lane = tid & 63, wave = __builtin_amdgcn_readfirstlane(tid >> 6), r = lane & 31, hi = lane >> 5;
    int G_ = gridDim.x, B_ = blockIdx.x; asm volatile("" : "+s"(G_), "+s"(B_));
    LAS float* red = (LAS float*)lds_raw;
    const int tn = N / 64, items = (nrows / 64) * tn, kw = K / 8;
    for (int it = B_; it < items; it += G_) {
        const int mi = it / tn, ni = it % tn;
        const bf16* ap = A + (size_t)(row_lo + 64 * mi + r) * K + wave * kw + 8 * hi;
        const bf16* bp = Bt + (size_t)(64 * ni + r) * K + wave * kw + 8 * hi;
        f32x16 acc[2][2];
#pragma unroll
        for (int x = 0; x < 2; ++x)
#pragma unroll
            for (int y = 0; y < 2; ++y)
#pragma unroll
                for (int i = 0; i < 16; ++i) acc[x][y][i] = 0.f;
#pragma unroll 8
        for (int k = 0; k < kw; k += 16) {
            const bf16x8 a0 = *(const bf16x8*)(ap + k), a1 = *(const bf16x8*)(ap + (size_t)32 * K + k), b0 = *(const bf16x8*)(bp + k), b1 = *(const bf16x8*)(bp + (size_t)32 * K + k);
            acc[0][0] = __builtin_amdgcn_mfma_f32_32x32x16_bf16(b0, a0, acc[0][0], 0, 0, 0); acc[0][1] = __builtin_amdgcn_mfma_f32_32x32x16_bf16(b0, a1, acc[0][1], 0, 0, 0);
            acc[1][0] = __builtin_amdgcn_mfma_f32_32x32x16_bf16(b1, a0, acc[1][0], 0, 0, 0); acc[1][1] = __builtin_amdgcn_mfma_f32_32x32x16_bf16(b1, a1, acc[1][1], 0, 0, 0);
        }
#pragma unroll
        for (int x = 0; x < 2; ++x)
#pragma unroll
            for (int y = 0; y < 2; ++y)
#pragma unroll
                for (int i = 0; i < 16; ++i) red[((wave * 4 + x * 2 + y) * 16 + i) * 64 + lane] = acc[x][y][i];
        __syncthreads();
        { const int tile = wave >> 1, half = wave & 1; float v8[8];
#pragma unroll
            for (int i = 0; i < 8; ++i) { float s = 0.f;
#pragma unroll
                for (int w = 0; w < 8; ++w) s += red[((w * 4 + tile) * 16 + 8 * half + i) * 64 + lane];
                v8[i] = s; }
            E(v8, row_lo + 64 * mi + 32 * (tile & 1) + r, 64 * ni + 32 * (tile >> 1), hi, half); }
        __syncthreads();
    }
}
template <int ACT> __device__ __forceinline__ void gemm_store(const bf16* A, const bf16* Bt, bool ctx, int N, int K, bf16* O, int ldc, bf16* halo) {
    { int G_ = gridDim.x, B_ = blockIdx.x; asm volatile("" : "+s"(G_), "+s"(B_));
      pg8::Gemm g{A, Bt, ML, N, K, K, K}; pg8::StaticOrder S; S.init(ML, N, G_, B_);
      pg8::EpiStore<ACT> E{O, ldc, nullptr, -1, halo};
      pg8::gemm_phase<pg8::EpiStore<ACT>, pg8::StaticOrder, true, true>((LAS unsigned char*)lds_raw, g, S, E); }
    if (ctx) { SEpiStore E2{O, ldc, ACT, halo}; small_gemm(A, Bt, ML, MC, N, K, E2); }
}
__device__ __forceinline__ void gemm_resid(const bf16* A, const bf16* Bt, bool ctx, int K, float* X, const float* gate, int dry = 0, bool from_inputs = false) {
    const float* XinL = from_inputs ? INP(I_X) : X; const float* XinC = from_inputs ? INP(I_CTX) - (size_t)ML * D : X;
    { int G_ = gridDim.x, B_ = blockIdx.x; asm volatile("" : "+s"(G_), "+s"(B_));
      pg8::Gemm g{A, Bt, ML, D, K, K, K}; pg8::StaticOrder S; S.init(ML, D, G_, B_);
      pg8::EpiResid E{X, XinL, D, gate, NADA, dry};
      pg8::gemm_phase<pg8::EpiResid, pg8::StaticOrder, true, true>((LAS unsigned char*)lds_raw, g, S, E); }
    if (ctx && !dry) { SEpiResid E2{X, XinC, gate + 2 * NADA}; small_gemm(A, Bt, ML, MC, D, K, E2); }
}
__global__ void __launch_bounds__(NTHR, 2) fwd_kernel(Args a) {
    unsigned char* ws = a.ws;
    const int lo = a.step_lo, hi = a.step_hi; const bool coop = a.coop != 0;
    volatile LAS unsigned* bst = (volatile LAS unsigned*)((LAS unsigned char*)lds_raw + LDS_BYTES - 64);
    if (threadIdx.x < 2) bst[threadIdx.x] = 0u;
    __syncthreads();
    XcdBarrier bar; bar.bar = (unsigned*)(ws + WS_CTL) + 4096; bar.x = 0; bar.st = bst;
    if (coop) bar = xcd_barrier_post((unsigned*)(ws + WS_CTL) + 4096, bst);
#ifndef REP_SET
#define REP_SET 0
#endif
#define REP_OF(k) ((REP_SET == 1 && ((k) == 8 || (k) == 15 || (k) == 23 || (k) == 32)) || (REP_SET == 2 && ((k) == 4 || (k) == 28)) || (REP_SET == 3 && ((k) == 2 || (k) == 11 || (k) == 18 || (k) == 26)) || \
    (REP_SET == 4 && ((k) == 1 || (k) == 7 || (k) == 10 || (k) == 14 || (k) == 17 || (k) == 22 || (k) == 25 || (k) == 31)) || (REP_SET == 5 && (k) == 0) || (REP_SET == 6 && (k) == 20) || (REP_SET == 7 && ((k) == 5 || (k) == 29 || (k) == 12 || (k) == 34)))
#define PHASE(k, body) do { if (lo <= (k) && (k) < hi) { __syncthreads(); body; if (REP_OF(k)) { __syncthreads(); body; } if ((k) + 1 < hi && coop) { xcd_barrier(bar); } } } while (0)
#define WB(off) ((bf16*)(ws + (off)))
#define MODP(layer, which) ((const float*)(ws + WS_MOD) + (size_t)(layer) * 3 * NADA + (which) * D)
#define TAIL(k0, layer, WoutT, Mrows, FIN) \
    PHASE((k0), { if (REP_SET == 31) { gemm_resid(WB(WS_Y), (WoutT), false, D, (float*)(ws + WS_X), MODP(layer, 2), a.coop); __syncthreads(); } gemm_resid(WB(WS_Y), (WoutT), (Mrows) == M, D, (float*)(ws + WS_X), MODP(layer, 2), 0, FIN); }); \
    PHASE((k0) + 1, step_norm((layer), 1, (Mrows), false)); \
    PHASE((k0) + 2, gemm_store<1>(WB(WS_H), WB(WS_W1T) + (size_t)(layer) * D * FF, (Mrows) == M, FF, D, WB(WS_Z), FF, nullptr)); \
    PHASE((k0) + 3, { if (REP_SET == 30) { gemm_resid(WB(WS_Z), WB(WS_W2T) + (size_t)(layer) * D * FF, false, FF, (float*)(ws + WS_X), MODP(layer, 5), a.coop); __syncthreads(); } gemm_resid(WB(WS_Z), WB(WS_W2T) + (size_t)(layer) * D * FF, (Mrows) == M, FF, (float*)(ws + WS_X), MODP(layer, 5)); })
#define LAYER_GDN(k0, layer, jj, Mrows, conv) \
    PHASE((k0), step_norm((layer), 0, M, (layer) == 0)); \
    PHASE((k0) + 1, { gemm_store<0>(WB(WS_H), WB(WS_GINT) + (size_t)(jj) * GDN_NP * D, true, 4096, D, WB(WS_Z), 4096, WB(WS_HALO)); \
        SEpiAB E3{(float*)(ws + WS_AB)}; small_gemm(WB(WS_H), WB(WS_GINT) + (size_t)(jj) * GDN_NP * D + (size_t)4096 * D, 0, M, 64, D, E3); }); \
    if (lo <= (k0) + 2 && (k0) + 2 < hi && !(coop && gridDim.x == 256)) { __syncthreads(); step_gdn_prep(jj, false, nullptr); if ((k0) + 3 < hi && coop) xcd_barrier(bar); } \
    PHASE((k0) + 3, { unsigned* fl_ = (unsigned*)(ws + WS_CTL) + 16384 + (jj) * 4096; \
        if (coop && gridDim.x == 256) { step_gdn_scan2(fl_); step_gdn_prep(jj, true, fl_); } else step_gdn_scan2(nullptr); \
        if (conv) step_convert_rest(); }); \
    PHASE((k0) + 4, step_gdn_norm2(jj)); \
    TAIL((k0) + 5, layer, WB(WS_GOUTT) + (size_t)(jj) * D * D, Mrows, (layer) == 0)
    PHASE(0, step_prologue());
    LAYER_GDN(1, 0, 0, M, true);
    PHASE(10, step_norm(1, 0, M, false));
    PHASE(11, gemm_store<0>(WB(WS_H), WB(WS_SINT), true, 3 * D, D, WB(WS_Z), 3 * D, nullptr));
    PHASE(12, step_sconv());
    TAIL(13, 1, WB(WS_SOUTT), M, false);
    PHASE(17, step_norm(2, 0, M, false));
    PHASE(18, gemm_store<0>(WB(WS_H), WB(WS_DINT), true, 3 * D, D, WB(WS_Z), 3 * D, nullptr));
    PHASE(19, step_rope2());
    PHASE(20, { if (REP_SET >= 40 && REP_SET < 56) { step_attn2(a.pad); __syncthreads(); } step_attn2(); });
    TAIL(21, 2, WB(WS_DOUTT), M, false);
    LAYER_GDN(25, 3, 1, ML, false);
    PHASE(34, step_final());
}

extern "C" void kernel_launch(void* const* d_in, const int* in_sizes, int n_in, void* d_out, int out_size, void* d_ws, size_t ws_size, hipStream_t stream) {
    static int grid = 0;
    if (grid == 0) {
        if (n_in != 24 || out_size != ML * D || ws_size < WS_END) { fprintf(stderr, "kernel_launch: unexpected problem (n_in %d, out %d, ws %zu); nothing launched\n", n_in, out_size, ws_size); grid = -1; return; }
        int dev = 0, cus = 0, per_cu = 0;
        if (hipGetDevice(&dev) != hipSuccess || hipDeviceGetAttribute(&cus, hipDeviceAttributeMultiprocessorCount, dev) != hipSuccess) { grid = -1; return; }
        if (hipFuncSetAttribute((const void*)fwd_kernel, hipFuncAttributeMaxDynamicSharedMemorySize, LDS_BYTES) != hipSuccess) { fprintf(stderr, "kernel_launch: hipFuncSetAttribute failed\n"); grid = -1; return; }
        if (hipOccupancyMaxActiveBlocksPerMultiprocessor(&per_cu, (const void*)fwd_kernel, NTHR, LDS_BYTES) != hipSuccess || per_cu < 1) { fprintf(stderr, "kernel_launch: occupancy query says %d blocks per CU\n", per_cu); (void)hipGetLastError(); per_cu = 1; }
        grid = cus;
        fprintf(stderr, "kernel_launch: %d CUs, occupancy %d per CU, grid %d\n", cus, per_cu, grid);
    }
    if (grid < 0) return;
    (void)hipMemsetAsync((char*)d_ws + WS_CTL, 0, CTL_ZERO_BYTES, stream);
    Args a{};
    for (int i = 0; i < 24; ++i) a.in[i] = (const float*)d_in[i];
    a.out = (float*)d_out; a.ws = (unsigned char*)d_ws;
#if MK_SINGLE
    a.step_lo = 0; a.step_hi = NSTEPS; a.coop = 1;
#if REP_SET >= 40 && REP_SET < 56
    a.pad = 1 | ((REP_SET - 40) << 1);
#elif REP_SET == 20
    a.pad = 1;
#elif REP_SET == 21
    a.pad = 3;
#elif REP_SET >= 8
    a.pad = REP_SET - 8;
#endif
    void* args[] = {&a};
    hipError_t e = hipLaunchCooperativeKernel((const void*)fwd_kernel, dim3(grid), dim3(NTHR), args, LDS_BYTES, stream);
    if (e != hipSuccess) fprintf(stderr, "cooperative launch failed: %s (grid %d)\n", hipGetErrorString(e), grid);
#else
    for (int s = 0; s < NSTEPS; ++s) { a.step_lo = s; a.step_hi = s + 1; a.coop = 0; hipLaunchKernelGGL(fwd_kernel, dim3(grid), dim3(NTHR), LDS_BYTES, stream, a); }
#endif
}
```

```cpp
#include <hip/hip_runtime.h>
#include <hip/hip_cooperative_groups.h>
#include <cstdio>
#include <cstdint>
namespace cg = cooperative_groups;
namespace pg8 {
#define PG8_LAS __attribute__((address_space(3)))
typedef unsigned short bf16_t;
typedef short bf16x8 __attribute__((ext_vector_type(8)));
typedef float f32x4 __attribute__((ext_vector_type(4)));
typedef unsigned u32x4 __attribute__((ext_vector_type(4)));
constexpr int BM = 256, BK = 64, HALF = 128, HTB = HALF * BK * 2  , STAGE_BYTES = 8 * HTB, NXCD = 8, WGM = 8;

__host__ __device__ __forceinline__ int lds_byte(int r, int c) { const int st = (r >> 4) * 2 + (c >> 5), rr = r & 15, cc = c & 31, ob = rr * 64 + cc * 2; return st * 1024 + (ob ^ (((ob >> 9) & 1) << 5)); }
__host__ __device__ __forceinline__ void stage_rc(int b, int& R, int& C) { const int st = b / 1024, sb = b % 1024, swz = sb ^ (((sb >> 9) & 1) << 5); R = (st >> 1) * 16 + swz / 64; C = (st & 1) * 32 + (swz % 64) / 2; }
__host__ __device__ __forceinline__ int perm32(int rho) { const int n = rho >> 4, i = rho & 15; return 8 * (i >> 2) + 4 * n + (i & 3); }

struct Unit { int pm, pn; };
struct Gemm { const bf16_t* A; const bf16_t* Bt; int M, N, K, lda, ldb; };

struct StaticOrder {
    int nM, nN, nwg, G, c;
    __host__ __device__ void init(int M, int N, int G_, int c_) { nM = M / BM; nN = N / BM; nwg = nM * nN; G = G_; c = c_; }
    __host__ __device__ bool next(int i, Unit& u) const {
        const long L = (long)i * G + c; if (L >= nwg) return false;
        int wgid = (int)L; { const int q = nwg / NXCD, r = nwg % NXCD, xcd = wgid % NXCD, off = wgid / NXCD; wgid = (xcd < r ? xcd * (q + 1) : r * (q + 1) + (xcd - r) * q) + off; }
        const int nig = WGM * nN, gid = wgid / nig, fm = gid * WGM, gsz = (nM - fm) < WGM ? (nM - fm) : WGM;
        u.pm = fm + ((wgid % nig) % gsz); u.pn = (wgid % nig) / gsz; return true;
    }
    __device__ __forceinline__ void a_ready(const Unit&) const {}
    __device__ __forceinline__ void done(const Unit&) const {}
};

typedef float f32x2 __attribute__((ext_vector_type(2)));
typedef __bf16 bf16x2_t __attribute__((ext_vector_type(2)));
typedef unsigned u32x2 __attribute__((ext_vector_type(2)));
__device__ __forceinline__ unsigned ss_enc(float s) { return (unsigned)(s * 1024.0f + 0.5f); }
__device__ __forceinline__ float ss_dec(const float* SS, int row) { return (float)((const unsigned*)SS)[row] * (1.0f / 1024.0f); }
__device__ __forceinline__ unsigned cvt_pk_bf16(float lo, float hi) { f32x2 v = {lo, hi}; bf16x2_t b = __builtin_convertvector(v, bf16x2_t); return __builtin_bit_cast(unsigned, b); }

template <int ACT> struct EpiStore {
    static constexpr bool PERM = true, AFTER_DRAIN = false;
    const float* SS; const float* bias; int bstride;
    bf16_t* O; int ldc; float* AB; int ab_tile; bf16_t* halo;
    const float* rope; float qscale;
    __device__ __forceinline__ void operator()(const f32x4 (&acc)[2][2][4][2], const Unit& u, int wr, int wc, int fr, int fq) const {
        const int row0 = u.pm * BM + wr * 64 + fr;
        if (u.pn == ab_tile) {
            if (wc == 0) {
#pragma unroll
                for (int ai = 0; ai < 2; ++ai)
#pragma unroll
                    for (int m = 0; m < 4; ++m) { float* p = AB + (size_t)(row0 + ai * HALF + m * 16) * 32 + 8 * fq; *(f32x4*)p = acc[ai][0][m][0]; *(f32x4*)(p + 4) = acc[ai][0][m][1]; }
            }
            return;
        }
        const int col0 = u.pn * BM + wc * 32 + 8 * fq;
        f32x4 bv[2][2];
#pragma unroll
        for (int bj = 0; bj < 2; ++bj)
#pragma unroll
            for (int n = 0; n < 2; ++n) bv[bj][n] = SS ? *(const f32x4*)(bias + (size_t)(u.pm < 32 ? 0 : (u.pm < 64 ? 1 : 2)) * bstride + col0 + bj * HALF + 4 * n) : (f32x4){0.f, 0.f, 0.f, 0.f};
#pragma unroll
        for (int ai = 0; ai < 2; ++ai)
#pragma unroll
            for (int m = 0; m < 4; ++m) { const int row = row0 + ai * HALF + m * 16; bf16_t* rowp = O + (size_t)row * ldc + col0;
                const float rs = SS ? 1.0f / sqrtf(ss_dec(SS, row) * (1.0f / 1024.0f) + 1e-6f) : 1.0f;
                f32x4 c0 = {1.f, 0.f, 1.f, 0.f}, c1 = c0; float qs = 1.f;
                if constexpr (ACT == 2) { if (u.pn < 8) { const f32x4* tab = (const f32x4*)rope + (size_t)(row & 8191) * 16 + (wc & 1) * 8 + 2 * fq; c0 = tab[0]; c1 = tab[1]; qs = u.pn < 4 ? qscale : 1.f; } }
#pragma unroll
                for (int bj = 0; bj < 2; ++bj) { f32x4 v0 = acc[ai][bj][m][0] * rs + bv[bj][0], v1 = acc[ai][bj][m][1] * rs + bv[bj][1];
                    if constexpr (ACT == 2) {
                        v0 = (f32x4){(v0[0] * c0[0] - v0[1] * c0[1]) * qs, (v0[0] * c0[1] + v0[1] * c0[0]) * qs, (v0[2] * c0[2] - v0[3] * c0[3]) * qs, (v0[2] * c0[3] + v0[3] * c0[2]) * qs};
                        v1 = (f32x4){(v1[0] * c1[0] - v1[1] * c1[1]) * qs, (v1[0] * c1[1] + v1[1] * c1[0]) * qs, (v1[2] * c1[2] - v1[3] * c1[3]) * qs, (v1[2] * c1[3] + v1[3] * c1[2]) * qs}; }
                    if (ACT == 1) {
#pragma unroll
                        for (int i = 0; i < 4; ++i) { const float a = fmaxf(v0[i], 0.f), b = fmaxf(v1[i], 0.f); v0[i] = a * a; v1[i] = b * b; } }
                    u32x4 w; w.x = cvt_pk_bf16(v0[0], v0[1]); w.y = cvt_pk_bf16(v0[2], v0[3]); w.z = cvt_pk_bf16(v1[0], v1[1]); w.w = cvt_pk_bf16(v1[2], v1[3]);
                    *(u32x4*)(rowp + bj * HALF) = w;
                    if (halo && u.pn < 12 && ((m == 0 && fr == 0) || (m == 3 && fr == 15)))
                        *(u32x4*)(halo + ((size_t)(row >> 6) * 2 + (m == 3 ? 1 : 0)) * 3072 + col0 + bj * HALF) = w; } }
    }
};
__device__ __forceinline__ float bf_lo(unsigned w) { return __uint_as_float(w << 16); }
__device__ __forceinline__ float bf_hi(unsigned w) { return __uint_as_float(w & 0xffff0000u); }
struct EpiResid {
    static constexpr bool PERM = true, AFTER_DRAIN = false;
    bf16_t* Hn; const float* cv; int cvstride; float* SSo;
    void* X; const void* Xin; int ldc; const float* gate; int gstride; int dry; int in_f32, out_f32;
    template <bool INF, bool OUTF> __device__ __forceinline__ void body(const f32x4 (&acc)[2][2][4][2], const Unit& u, int wr, int wc, int fr, int fq) const {
        const int row0 = u.pm * BM + wr * 64 + fr, col0 = u.pn * BM + wc * 32 + 8 * fq;
        const float* g = gate + (size_t)(u.pm < 32 ? 0 : (u.pm < 64 ? 1 : 2)) * gstride + col0;
        const int grp = u.pm < 32 ? 0 : (u.pm < 64 ? 1 : 2);
        f32x4 gv[2][2], cvv[2][2];
#pragma unroll
        for (int bj = 0; bj < 2; ++bj)
#pragma unroll
            for (int n = 0; n < 2; ++n) { gv[bj][n] = *(const f32x4*)(g + bj * HALF + n * 4); cvv[bj][n] = Hn ? *(const f32x4*)(cv + (size_t)grp * cvstride + col0 + bj * HALF + n * 4) : (f32x4){0.f, 0.f, 0.f, 0.f}; }
#pragma unroll
        for (int ai = 0; ai < 2; ++ai)
#pragma unroll
            for (int m = 0; m < 4; ++m) { const int row = row0 + ai * HALF + m * 16; const size_t off = (size_t)row * ldc + col0; float ss = 0.f;
#pragma unroll
                for (int bj = 0; bj < 2; ++bj) { f32x4 x0, x1;
                    if (INF) { const float* pi = (const float*)Xin + off + bj * HALF; x0 = *(const f32x4*)pi; x1 = *(const f32x4*)(pi + 4); }
                    else { const u32x4 w = *(const u32x4*)((const bf16_t*)Xin + off + bj * HALF); x0 = (f32x4){bf_lo(w.x), bf_hi(w.x), bf_lo(w.y), bf_hi(w.y)}; x1 = (f32x4){bf_lo(w.z), bf_hi(w.z), bf_lo(w.w), bf_hi(w.w)}; }
                    const f32x4 v0 = x0 + gv[bj][0] * acc[ai][bj][m][0], v1 = x1 + gv[bj][1] * acc[ai][bj][m][1];
                    if (!dry) { if (OUTF) { float* q = (float*)X + off + bj * HALF; *(f32x4*)q = v0; *(f32x4*)(q + 4) = v1; }
                        else *(u32x4*)((bf16_t*)X + off + bj * HALF) = (u32x4){cvt_pk_bf16(v0[0], v0[1]), cvt_pk_bf16(v0[2], v0[3]), cvt_pk_bf16(v1[0], v1[1]), cvt_pk_bf16(v1[2], v1[3])}; }
                    else asm volatile("" :: "v"(v0), "v"(v1));
                    if (Hn) { ss += ((v0[0] * v0[0] + v0[1] * v0[1]) + (v0[2] * v0[2] + v0[3] * v0[3])) + ((v1[0] * v1[0] + v1[1] * v1[1]) + (v1[2] * v1[2] + v1[3] * v1[3]));
                        const f32x4 h0 = v0 * cvv[bj][0], h1 = v1 * cvv[bj][1];
                        *(u32x4*)(Hn + off + bj * HALF) = (u32x4){cvt_pk_bf16(h0[0], h0[1]), cvt_pk_bf16(h0[2], h0[3]), cvt_pk_bf16(h1[0], h1[1]), cvt_pk_bf16(h1[2], h1[3])}; } }
                if (Hn) { ss += __shfl_xor(ss, 16); ss += __shfl_xor(ss, 32); if (fq == 0) atomicAdd((unsigned*)SSo + row, ss_enc(ss)); }
                if (m & 1) asm volatile("" ::: "memory"); }
    }
    __device__ __forceinline__ void operator()(const f32x4 (&acc)[2][2][4][2], const Unit& u, int wr, int wc, int fr, int fq) const {
        if (in_f32) body<true, false>(acc, u, wr, wc, fr, fq); else if (out_f32) body<false, true>(acc, u, wr, wc, fr, fq); else body<false, false>(acc, u, wr, wc, fr, fq);
    }
};

template <class Epi, class Sched, bool ALIGN_EPI = false, bool SP2 = false>
__device__ __forceinline__ void gemm_phase(PG8_LAS unsigned char* lds, const Gemm g, const Sched& S, const Epi& E) {
    int tid_ = threadIdx.x; asm volatile("" : "+v"(tid_)); const int tid = tid_, wid = __builtin_amdgcn_readfirstlane(tid >> 6), lane = tid & 63, wr = wid >> 2, wc = wid & 3, fr = lane & 15, fq = lane >> 4;
    const int K = g.K, nt = K / BK;
    unsigned voffA[2], voffB[2];
#pragma unroll
    for (int i = 0; i < 2; ++i) { int R, C; stage_rc(tid * 16 + i * 8192, R, C); const int Rb = Epi::PERM ? ((R & ~31) + perm32(R & 31)) : R;
        voffA[i] = (unsigned)(R * g.lda + C) * 2u; voffB[i] = (unsigned)(Rb * g.ldb + C) * 2u; }
    const size_t kstep = (size_t)(BK * 2);
    const int lda = g.lda, ldb = g.ldb;
    const size_t hstepA = (size_t)HALF * lda * 2, hstepB = (size_t)HALF * ldb * 2;
    const size_t tstepA = 2 * hstepA, tstepB = 2 * hstepB;
    const unsigned ldsw = (unsigned)wid * 1024u;
    const int aoff = lds_byte(wr * 64 + fr, fq * 8), boff = lds_byte(wc * 32 + fr, fq * 8);
#define PG8_SA(b, h) (((b) * 2 + (h)) * HTB)
#define PG8_SB(b, h) ((4 + (b) * 2 + (h)) * HTB)
#define PG8_STAGE(bufoff, gbase, voff) do { _Pragma("unroll") for (int _i = 0; _i < 2; ++_i) \
        __builtin_amdgcn_global_load_lds((const unsigned*)((const char*)(gbase) + (voff)[_i]), (PG8_LAS unsigned*)(lds + (bufoff) + ldsw + _i * 8192), 16, 0, 0); } while (0)
#define PG8_LDA(dst, b, h) do { _Pragma("unroll") for (int m = 0; m < 4; ++m) _Pragma("unroll") for (int k = 0; k < 2; ++k) dst[m][k] = *(const PG8_LAS bf16x8*)(lds + PG8_SA(b, h) + aoff + m * 2048 + k * 1024); } while (0)
#define PG8_LDB(dst, b, h) do { _Pragma("unroll") for (int n = 0; n < 2; ++n) _Pragma("unroll") for (int k = 0; k < 2; ++k) dst[n][k] = *(const PG8_LAS bf16x8*)(lds + PG8_SB(b, h) + boff + n * 2048 + k * 1024); } while (0)
#define PG8_MMA(ai, bj, At, Bt) do { __builtin_amdgcn_s_setprio(1); _Pragma("unroll") for (int m = 0; m < 4; ++m) _Pragma("unroll") for (int n = 0; n < 2; ++n) _Pragma("unroll") for (int k = 0; k < 2; ++k) \
        acc[ai][bj][m][n] = __builtin_amdgcn_mfma_f32_16x16x32_bf16(Bt[n][k], At[m][k], acc[ai][bj][m][n], 0, 0, 0); __builtin_amdgcn_s_setprio(0); } while (0)
#define PG8_WAIT_V(n) asm volatile("s_waitcnt vmcnt(" #n ")" ::: "memory")
#define PG8_WAIT_L(n) asm volatile("s_waitcnt lgkmcnt(" #n ")" ::: "memory")
#define PG8_BAR __builtin_amdgcn_s_barrier()
#define PG8_SCHED __builtin_amdgcn_sched_barrier(0)
    Unit cur, nxt; int ui = 0;
    if (!S.next(0, cur)) return;
    f32x4 acc[2][2][4][2];
#pragma unroll
    for (int a = 0; a < 2; ++a)
#pragma unroll
        for (int b = 0; b < 2; ++b)
#pragma unroll
            for (int m = 0; m < 4; ++m)
#pragma unroll
                for (int n = 0; n < 2; ++n) acc[a][b][m][n] = (f32x4){0.f, 0.f, 0.f, 0.f};
    bf16x8 At[4][2], B0[2][2], B1[2][2];
    const char* cA = (const char*)g.A + (size_t)cur.pm * tstepA; const char* cB = (const char*)g.Bt + (size_t)cur.pn * tstepB;
    S.a_ready(cur);
    if constexpr (SP2) {
        PG8_STAGE(PG8_SB(0, 0), cB, voffB); PG8_STAGE(PG8_SB(0, 1), cB + hstepB, voffB); PG8_STAGE(PG8_SA(0, 0), cA, voffA); PG8_STAGE(PG8_SA(0, 1), cA + hstepA, voffA);
        if (wr == 1) PG8_BAR;
        PG8_WAIT_V(2); PG8_BAR;
        PG8_STAGE(PG8_SB(1, 0), cB + kstep, voffB); PG8_STAGE(PG8_SA(1, 0), cA + kstep, voffA); PG8_STAGE(PG8_SB(1, 1), cB + hstepB + kstep, voffB);
        PG8_WAIT_V(6); PG8_BAR;
    } else {
        PG8_STAGE(PG8_SB(0, 0), cB, voffB); PG8_STAGE(PG8_SA(0, 0), cA, voffA); PG8_STAGE(PG8_SB(0, 1), cB + hstepB, voffB); PG8_STAGE(PG8_SA(0, 1), cA + hstepA, voffA);
        if (wr == 1) PG8_BAR;
        PG8_WAIT_V(4); PG8_BAR;
        PG8_STAGE(PG8_SB(1, 0), cB + kstep, voffB); PG8_STAGE(PG8_SA(1, 0), cA + kstep, voffA); PG8_STAGE(PG8_SB(1, 1), cB + hstepB + kstep, voffB);
        PG8_WAIT_V(6); PG8_BAR;
    }
    for (;;) {
        const bool has_next = S.next(ui + 1, nxt);
        const char* nA = has_next ? (const char*)g.A + (size_t)nxt.pm * tstepA : cA; const char* nB = has_next ? (const char*)g.Bt + (size_t)nxt.pn * tstepB : cB;
        for (int t = 0; t < nt; t += 2) {
            const bool last = (t == nt - 2);
            const char* a1 = cA + (size_t)(t + 1) * kstep;
            const char* a2 = last ? nA : cA + (size_t)(t + 2) * kstep; const char* b2 = last ? nB : cB + (size_t)(t + 2) * kstep;
            const char* a3 = a2 + kstep; const char* b3 = b2 + kstep;
            if (last && has_next) S.a_ready(nxt);
            if constexpr (SP2) {
            PG8_LDB(B0, 0, 0); PG8_LDB(B1, 0, 1); PG8_SCHED; PG8_LDA(At, 0, 0); PG8_STAGE(PG8_SA(1, 1), a1 + hstepA, voffA);
            PG8_WAIT_V(8); PG8_WAIT_L(0); PG8_BAR; PG8_MMA(0, 0, At, B0); PG8_MMA(0, 1, At, B1); PG8_BAR; PG8_SCHED;
            PG8_LDA(At, 0, 1); PG8_STAGE(PG8_SB(0, 0), b2, voffB); PG8_STAGE(PG8_SB(0, 1), b2 + hstepB, voffB); PG8_STAGE(PG8_SA(0, 0), a2, voffA);
            PG8_WAIT_V(8); PG8_WAIT_L(0); PG8_BAR; PG8_MMA(1, 0, At, B0); PG8_MMA(1, 1, At, B1); PG8_BAR; PG8_SCHED;
            PG8_LDB(B0, 1, 0); PG8_LDB(B1, 1, 1); PG8_SCHED; PG8_LDA(At, 1, 0); PG8_STAGE(PG8_SA(0, 1), a2 + hstepA, voffA);
            PG8_WAIT_V(8); PG8_WAIT_L(0); PG8_BAR; PG8_MMA(0, 0, At, B0); PG8_MMA(0, 1, At, B1); PG8_BAR; PG8_SCHED;
            PG8_LDA(At, 1, 1); PG8_STAGE(PG8_SB(1, 0), b3, voffB); PG8_STAGE(PG8_SB(1, 1), b3 + hstepB, voffB); PG8_STAGE(PG8_SA(1, 0), a3, voffA);
            PG8_WAIT_V(8); PG8_WAIT_L(0); PG8_BAR; PG8_MMA(1, 0, At, B0); PG8_MMA(1, 1, At, B1); PG8_BAR; PG8_SCHED;
            } else {
            PG8_LDB(B0, 0, 0); PG8_SCHED; PG8_LDA(At, 0, 0); PG8_STAGE(PG8_SA(1, 1), a1 + hstepA, voffA);
            PG8_WAIT_L(8); PG8_BAR; PG8_WAIT_L(0); PG8_MMA(0, 0, At, B0); PG8_BAR; PG8_SCHED;
            PG8_LDB(B1, 0, 1); PG8_STAGE(PG8_SB(0, 0), b2, voffB);
            PG8_BAR; PG8_WAIT_L(0); PG8_MMA(0, 1, At, B1); PG8_BAR;
            PG8_LDA(At, 0, 1); PG8_STAGE(PG8_SA(0, 0), a2, voffA);
            PG8_BAR; PG8_WAIT_L(0); PG8_MMA(1, 0, At, B0); PG8_BAR; PG8_SCHED;
            PG8_STAGE(PG8_SB(0, 1), b2 + hstepB, voffB);
            PG8_WAIT_V(6); PG8_BAR; PG8_MMA(1, 1, At, B1); PG8_BAR;
            PG8_LDB(B0, 1, 0); PG8_SCHED; PG8_LDA(At, 1, 0); PG8_STAGE(PG8_SA(0, 1), a2 + hstepA, voffA);
            PG8_WAIT_L(8); PG8_BAR; PG8_WAIT_L(0); PG8_MMA(0, 0, At, B0); PG8_BAR; PG8_SCHED;
            PG8_LDB(B1, 1, 1); PG8_STAGE(PG8_SB(1, 0), b3, voffB);
            PG8_BAR; PG8_WAIT_L(0); PG8_MMA(0, 1, At, B1); PG8_BAR;
            PG8_LDA(At, 1, 1); PG8_STAGE(PG8_SA(1, 0), a3, voffA);
            PG8_BAR; PG8_WAIT_L(0); PG8_MMA(1, 0, At, B0); PG8_BAR; PG8_SCHED;
            PG8_STAGE(PG8_SB(1, 1), b3 + hstepB, voffB);
            PG8_WAIT_V(6); PG8_BAR; PG8_MMA(1, 1, At, B1); PG8_BAR;
            }
        }
        if constexpr (ALIGN_EPI) { if (wr == 0) PG8_BAR; }
        if constexpr (!Epi::AFTER_DRAIN) { E(acc, cur, wr, wc, fr, fq); S.done(cur); }
        if (!has_next) break;
#pragma unroll
        for (int a = 0; a < 2; ++a)
#pragma unroll
            for (int b = 0; b < 2; ++b)
#pragma unroll
                for (int m = 0; m < 4; ++m)
#pragma unroll
                    for (int n = 0; n < 2; ++n) acc[a][b][m][n] = (f32x4){0.f, 0.f, 0.f, 0.f};
        cur = nxt; cA = nA; cB = nB; ++ui;
        if constexpr (ALIGN_EPI) { if (wr == 1) PG8_BAR; }
    }
    PG8_WAIT_V(0);
    if constexpr (!ALIGN_EPI) { if (wr == 0) PG8_BAR; }
    PG8_BAR;
    if constexpr (Epi::AFTER_DRAIN) { E.fused(acc, cur, wr, wc, fr, fq, lds, wid, lane); S.done(cur); }
#undef PG8_SA
#undef PG8_SB
#undef PG8_STAGE
#undef PG8_LDA
#undef PG8_LDB
#undef PG8_MMA
#undef PG8_WAIT_V
#undef PG8_WAIT_L
#undef PG8_BAR
#undef PG8_SCHED
}
}

constexpr int D = 1024, NB = 2, T = 8192, CT = 256, DEPTH = 4, FF = 4096;
constexpr int ML = NB * T, MC = NB * CT, M = ML + MC;
constexpr int NADA = 6 * D;
constexpr int GDN_N = 4128, GDN_NP = 4352;
constexpr int NH = 8, HD = 128;
constexpr int NKV = CT + T;
constexpr float EPS = 1e-6f;
constexpr int NWAVES = 8, NTHR = 512;
constexpr float QSCALE = 0.125f * 1.4426950408889634f;
constexpr float LAMBDA_INIT = 0.47071302f;

constexpr size_t MiB = 1u << 20;
constexpr size_t WS_CTL = 0, CTL_ZERO_BYTES = 1 * MiB;
constexpr size_t WS_MOD = 1 * MiB;
constexpr size_t WS_CV = 1 * MiB + 512 * 1024;
constexpr size_t WS_BIAS = 9 * MiB;
constexpr size_t CTL_SS = 128 * 1024;
constexpr size_t WS_ROPE = 2 * MiB;
constexpr size_t WS_AB = 4 * MiB;
constexpr size_t WS_OFC = 7 * MiB;
constexpr size_t WS_W1T = 10 * MiB, WS_W2T = 42 * MiB, WS_GINT = 74 * MiB, WS_GOUTT = 91 * MiB, WS_SINT = 95 * MiB, WS_SOUTT = 101 * MiB, WS_DINT = 103 * MiB, WS_DOUTT = 109 * MiB;
constexpr size_t WS_X = 112 * MiB;
constexpr size_t WS_XF = 178 * MiB;
constexpr size_t WS_H = 178 * MiB;
constexpr size_t WS_Y = 211 * MiB;
constexpr size_t WS_Z = 244 * MiB;
constexpr size_t WS_HALO = 376 * MiB;
constexpr size_t WS_END = 380 * MiB;
constexpr size_t WS_PD = WS_H;

constexpr int LDS_BYTES = 159744;

#define LAS __attribute__((address_space(3)))
typedef unsigned short bf16;
typedef unsigned u32x4 __attribute__((ext_vector_type(4)));
typedef unsigned u32x2 __attribute__((ext_vector_type(2)));
typedef float f32x4 __attribute__((ext_vector_type(4)));
typedef float f32x2 __attribute__((ext_vector_type(2)));
typedef float f32x16 __attribute__((ext_vector_type(16)));
typedef short bf16x8 __attribute__((ext_vector_type(8)));
typedef short s16x4 __attribute__((ext_vector_type(4)));
#define LDS_WAIT() asm volatile("s_waitcnt lgkmcnt(0)" ::: "memory")

__device__ __forceinline__ float bf2f(unsigned u) { return __uint_as_float(u << 16); }
__device__ __forceinline__ unsigned pk2(float lo, float hi) { return pg8::cvt_pk_bf16(lo, hi); }
__device__ __forceinline__ float wave_sum(float v) {
#pragma unroll
    for (int o = 1; o < 64; o <<= 1) v += __shfl_xor(v, o);
    return v;
}
__device__ __forceinline__ float silu_f(float x) { return x / (1.f + expf(-x)); }
__device__ __forceinline__ float silu_fast(float x) { return x * __builtin_amdgcn_rcpf(1.f + __builtin_amdgcn_exp2f(-1.4426950408889634f * x)); }
__device__ __forceinline__ float exp_fast(float x) { return __builtin_amdgcn_exp2f(1.4426950408889634f * x); }
__device__ __forceinline__ int crow(int r, int hi) { return (r & 3) + 8 * (r >> 2) + 4 * hi; }

struct Args { const float* in[24]; float* out; unsigned char* ws; int step_lo, step_hi, coop, pad; };
typedef const __attribute__((address_space(4))) Args* KArgs;
__device__ __forceinline__ KArgs kargs() { const unsigned long long p = (unsigned long long)__builtin_amdgcn_kernarg_segment_ptr();
    unsigned lo = __builtin_amdgcn_readfirstlane((unsigned)p), hi = __builtin_amdgcn_readfirstlane((unsigned)(p >> 32)); asm volatile("" : "+s"(lo), "+s"(hi)); return (KArgs)(((unsigned long long)hi << 32) | lo); }
#define INP(k) (kargs()->in[k])
extern __shared__ __attribute__((aligned(16))) unsigned char lds_raw[];
struct Frame { LAS unsigned char* lds; int tid, lane, wave, G, bid; float* out; unsigned char* ws; };
__device__ __forceinline__ Frame make_frame() {
    Frame F; F.lds = (LAS unsigned char*)lds_raw; F.tid = threadIdx.x; asm volatile("" : "+v"(F.tid)); F.lane = F.tid & 63; F.wave = __builtin_amdgcn_readfirstlane(F.tid >> 6); F.G = gridDim.x; F.bid = blockIdx.x; asm volatile("" : "+s"(F.G), "+s"(F.bid));
    KArgs a = kargs(); F.out = a->out; F.ws = a->ws; return F;
}
enum { I_X = 0, I_C, I_CTX, I_CCTX, I_N1G, I_N2G, I_ADAW, I_ADAB, I_W1, I_W2, I_GIN, I_GCONV, I_GALOG, I_GDT, I_GNG, I_GOUT, I_SIN, I_SCONV, I_SOUT, I_DIN, I_DLAM, I_DNG, I_DOUT, I_FG };

__device__ __forceinline__ void transpose_item(const float* W, int K, int ldw, bf16* WT, LAS float* scr, int item, int nblk, int lane) {
    const int kb = item / nblk, nb = item % nblk, k0 = 64 * kb, n0 = 32 * nb;
#pragma unroll 8
    for (int i = 0; i < 32; ++i) { const int kk = 2 * i + (lane >> 5); scr[kk * 33 + (lane & 31)] = W[(size_t)(k0 + kk) * ldw + n0 + (lane & 31)]; }
    LDS_WAIT(); asm volatile("" ::: "memory");
    const int c = lane & 7;
#pragma unroll
    for (int j = 0; j < 4; ++j) { const int n = (lane >> 3) + 8 * j; const LAS float* s = scr + (8 * c) * 33 + n;
        u32x4 o; o.x = pk2(s[0 * 33], s[1 * 33]); o.y = pk2(s[2 * 33], s[3 * 33]); o.z = pk2(s[4 * 33], s[5 * 33]); o.w = pk2(s[6 * 33], s[7 * 33]);
        *(u32x4*)(WT + (size_t)(n0 + n) * K + k0 + 8 * c) = o; }
    LDS_WAIT(); asm volatile("" ::: "memory");
}
__device__ __forceinline__ void get_mat(unsigned char* ws_, int idx, const float*& src, bf16*& dst, int& K, int& N, int& ld) {
    unsigned char* ws = ws_;
    if (idx < 4)       { src = INP(I_W1) + (size_t)idx * D * FF; dst = (bf16*)(ws + WS_W1T) + (size_t)idx * D * FF; K = D; N = FF; ld = FF; }
    else if (idx < 8)  { const int i = idx - 4; src = INP(I_W2) + (size_t)i * D * FF; dst = (bf16*)(ws + WS_W2T) + (size_t)i * D * FF; K = FF; N = D; ld = D; }
    else if (idx < 10) { const int j = idx - 8; src = INP(I_GIN) + (size_t)j * D * GDN_N; dst = (bf16*)(ws + WS_GINT) + (size_t)j * GDN_NP * D; K = D; N = GDN_N; ld = GDN_N; }
    else if (idx < 12) { const int j = idx - 10; src = INP(I_GOUT) + (size_t)j * D * D; dst = (bf16*)(ws + WS_GOUTT) + (size_t)j * D * D; K = D; N = D; ld = D; }
    else if (idx == 12) { src = INP(I_SIN); dst = (bf16*)(ws + WS_SINT); K = D; N = 3 * D; ld = 3 * D; }
    else if (idx == 13) { src = INP(I_SOUT); dst = (bf16*)(ws + WS_SOUTT); K = D; N = D; ld = D; }
    else if (idx == 14) { src = INP(I_DIN); dst = (bf16*)(ws + WS_DINT); K = D; N = 3 * D; ld = 3 * D; }
    else { src = INP(I_DOUT); dst = (bf16*)(ws + WS_DOUTT); K = D; N = D; ld = D; }
}
__device__ __forceinline__ void convert_weights(unsigned char* ws, unsigned mask, int gw, int NGW, int gt, int NGT, LAS unsigned char* lds, int wave, int lane) {
    LAS float* scr = (LAS float*)(lds + wave * 16384);
    for (int mi = 0; mi < 16; ++mi) {
        if (!((mask >> mi) & 1u)) continue;
        const float* src; bf16* dst; int K, N, ld; get_mat(ws, mi, src, dst, K, N, ld);
        const int nblk = N / 32, nitems = (K / 64) * nblk;
        for (int it = gw; it < nitems; it += NGW) transpose_item(src, K, ld, dst, scr, it, nblk, lane);
        if (mi == 8 || mi == 9) { u32x4* z = (u32x4*)((bf16*)(ws + WS_GINT) + (size_t)(mi - 8) * GDN_NP * D + (size_t)GDN_N * D);
            for (int i = gt; i < (GDN_NP - GDN_N) * D / 8; i += NGT) z[i] = (u32x4){0u, 0u, 0u, 0u}; }
    }
}
__device__ __forceinline__ void step_prologue() {
    const Frame F = make_frame();
    const int gw = F.bid * NWAVES + F.wave, NGW = F.G * NWAVES;
    const int gt = F.bid * NTHR + F.tid, NGT = F.G * NTHR;
    convert_weights(F.ws, (1u << 8) | (1u << 10), gw, NGW, gt, NGT, F.lds, F.wave, F.lane);
    __syncthreads();
    {
        LAS float* sv = (LAS float*)F.lds;
        LAS float* red = sv + 3 * D;
        for (int i = F.tid; i < 3 * D; i += NTHR) { const int g = i / D, k = i % D; const float c = g < 2 ? INP(I_C)[g * D + k] : INP(I_CCTX)[k]; sv[i] = silu_f(c); }
        __syncthreads();
        float* MOD = (float*)(F.ws + WS_MOD);
        const int c = F.tid & 63, ks = F.tid >> 6;
        for (int it = F.bid; it < DEPTH * (NADA / 64); it += F.G) {
            const int li = it / (NADA / 64), n0 = (it % (NADA / 64)) * 64;
            const float* w = INP(I_ADAW) + (size_t)li * D * NADA + (size_t)(ks * 128) * NADA + n0 + c;
            float a0 = 0.f, a1 = 0.f, a2 = 0.f;
#pragma unroll 16
            for (int k = 0; k < 128; ++k) { const float wv = w[(size_t)k * NADA]; const int kk = ks * 128 + k; a0 += sv[kk] * wv; a1 += sv[D + kk] * wv; a2 += sv[2 * D + kk] * wv; }
            red[(ks * 3 + 0) * 64 + c] = a0; red[(ks * 3 + 1) * 64 + c] = a1; red[(ks * 3 + 2) * 64 + c] = a2;
            __syncthreads();
            if (F.tid < 192) { const int g = F.tid >> 6; float s = INP(I_ADAB)[li * NADA + n0 + c];
#pragma unroll
                for (int q = 0; q < 8; ++q) s += red[(q * 3 + g) * 64 + c];
                MOD[((size_t)li * 3 + g) * NADA + n0 + c] = s; }
            __syncthreads();
        }
    }
    {
        f32x2* R = (f32x2*)(F.ws + WS_ROPE);
        for (int i = gt; i < T * 32; i += NGT) { const int t = i >> 5, p = i & 31, f = p & 15;
            const float inv = powf(10000.0f, -(float)f / 16.0f); const float pos = (float)(p < 16 ? (t >> 6) : (t & 63)); const float ang = pos * inv;
            R[i] = (f32x2){cosf(ang), sinf(ang)}; }
    }
}

__device__ __forceinline__ void step_norm(int layer, int which, int nrows, bool from_inputs) {
    const Frame F = make_frame();
    const int gw = F.bid * NWAVES + F.wave, NGW = F.G * NWAVES;
    const float* X = (const float*)(F.ws + WS_X); bf16* H = (bf16*)(F.ws + WS_H);
    const float* ng = (which ? INP(I_N2G) : INP(I_N1G)) + layer * D;
    const float* MOD = (const float*)(F.ws + WS_MOD) + (size_t)layer * 3 * NADA + which * 3 * D;
    for (int row = gw; row < nrows; row += NGW) {
        const int grp = row < T ? 0 : (row < ML ? 1 : 2);
        const float* xrow = from_inputs ? (row < ML ? INP(I_X) + (size_t)row * D : INP(I_CTX) + (size_t)(row - ML) * D) : X + (size_t)row * D;
        const f32x4* xr = (const f32x4*)xrow + F.lane;
        const f32x4* sh = (const f32x4*)(MOD + (size_t)grp * NADA) + F.lane; const f32x4* sc = (const f32x4*)(MOD + (size_t)grp * NADA + D) + F.lane; const f32x4* gg = (const f32x4*)ng + F.lane;
        f32x4 v[4]; float s = 0.f;
#pragma unroll
        for (int j = 0; j < 4; ++j) { v[j] = xr[64 * j]; s += (v[j].x * v[j].x + v[j].y * v[j].y) + (v[j].z * v[j].z + v[j].w * v[j].w); }
        const float rstd = 1.0f / sqrtf(wave_sum(s) * (1.f / D) + EPS);
        u32x2* o = (u32x2*)(H + (size_t)row * D) + F.lane;
#pragma unroll
        for (int j = 0; j < 4; ++j) { const f32x4 g4 = gg[64 * j], s4 = sc[64 * j], h4 = sh[64 * j]; const f32x4 y = (v[j] * rstd) * g4; const f32x4 h = y * (1.0f + s4) + h4;
            o[64 * j] = (u32x2){pk2(h.x, h.y), pk2(h.z, h.w)}; }
    }
}
__device__ __forceinline__ void step_norm0() {
    const Frame F = make_frame();
    const int gw = F.bid * NWAVES + F.wave, NGW = F.G * NWAVES, gt = F.bid * NTHR + F.tid, NGT = F.G * NTHR;
    bf16* H = (bf16*)(F.ws + WS_H); float* SS = (float*)(F.ws + WS_CTL + CTL_SS); const float* MOD = (const float*)(F.ws + WS_MOD);
    const bool split = F.G > 130; const int R1 = split ? 7680 : M;
    const float* ng = INP(I_N1G);
    auto do_row = [&](int row) {
        const int grp = row < T ? 0 : (row < ML ? 1 : 2);
        const float* xrow = row < ML ? INP(I_X) + (size_t)row * D : INP(I_CTX) + (size_t)(row - ML) * D;
        const f32x4* xr = (const f32x4*)xrow + F.lane; const f32x4* sc = (const f32x4*)(MOD + (size_t)grp * NADA + D) + F.lane; const f32x4* gg = (const f32x4*)ng + F.lane;
        f32x4 v[4]; float s = 0.f;
#pragma unroll
        for (int j = 0; j < 4; ++j) { v[j] = xr[64 * j]; s += (v[j].x * v[j].x + v[j].y * v[j].y) + (v[j].z * v[j].z + v[j].w * v[j].w); }
        s = wave_sum(s); if (F.lane == 0) ((unsigned*)SS)[row] = pg8::ss_enc(s);
        u32x2* o = (u32x2*)(H + (size_t)row * D) + F.lane;
#pragma unroll
        for (int j = 0; j < 4; ++j) { const f32x4 h = v[j] * (gg[64 * j] * (1.0f + sc[64 * j])); o[64 * j] = (u32x2){pk2(h.x, h.y), pk2(h.z, h.w)}; }
    };
    for (int row = gw; row < R1; row += NGW) do_row(row);
    if (split && F.bid >= 65) for (int row = R1 + gw - 65 * NWAVES; row < M; row += (F.G - 65) * NWAVES) do_row(row);
    { float* CV = (float*)(F.ws + WS_CV);
      for (int idx = gt; idx < DEPTH * 2 * 3 * D; idx += NGT) { const int col = idx & (D - 1), grp = (idx >> 10) % 3, which = (idx / (3 * D)) & 1, li = idx / (6 * D);
        const float g = (which ? INP(I_N2G) : INP(I_N1G))[li * D + col]; CV[idx] = g * (1.0f + MOD[((size_t)li * 3 + grp) * NADA + which * 3 * D + D + col]); } }
}
__device__ __forceinline__ void step_bias(int it_lo, int it_hi, int first_block) {
    const Frame F = make_frame();
    if (F.bid < first_block) return;
    __syncthreads();
    const float* MOD = (const float*)(F.ws + WS_MOD);
    LAS float* red = (LAS float*)F.lds;
    float* BIAS = (float*)(F.ws + WS_BIAS);
    const int c = F.tid & 63, ks = F.tid >> 6;
    constexpr int NB_IN = 65, NB_UP = 64;
    for (int it = it_lo + F.bid - first_block; it < it_hi; it += F.G - first_block) {
        const int li = it / (NB_IN + NB_UP), rr = it % (NB_IN + NB_UP); const bool up = rr >= NB_IN; const int n0 = (up ? rr - NB_IN : rr) * 64; const int kind = li % 3, jj = li / 3;
        const float* W; int ld, nv;
        if (up) { W = INP(I_W1) + (size_t)li * D * FF; ld = FF; nv = FF; }
        else if (kind == 0) { W = INP(I_GIN) + (size_t)jj * D * GDN_N; ld = GDN_N; nv = GDN_N; }
        else if (kind == 1) { W = INP(I_SIN); ld = 3 * D; nv = 3 * D; }
        else { W = INP(I_DIN); ld = 3 * D; nv = 3 * D; }
        const int n = n0 + c; const bool valid = n < nv;
        const float* sh = MOD + (size_t)li * 3 * NADA + (up ? 3 * D : 0);
        float a0 = 0.f, a1 = 0.f, a2 = 0.f;
        if (n0 < nv) {
#pragma unroll 16
            for (int k = 0; k < 128; ++k) { const int kk = ks * 128 + k; const float wv = valid ? W[(size_t)kk * ld + n] : 0.f; a0 += sh[kk] * wv; a1 += sh[NADA + kk] * wv; a2 += sh[2 * NADA + kk] * wv; } }
        red[(ks * 3 + 0) * 64 + c] = a0; red[(ks * 3 + 1) * 64 + c] = a1; red[(ks * 3 + 2) * 64 + c] = a2;
        __syncthreads();
        if (F.tid < 192 && valid) { const int g = F.tid >> 6; float s = 0.f;
#pragma unroll
            for (int q = 0; q < 8; ++q) s += red[(q * 3 + g) * 64 + c];
            BIAS[up ? (size_t)DEPTH * 3 * 4352 + ((size_t)li * 3 + g) * FF + n : ((size_t)li * 3 + g) * 4352 + n] = s; }
        __syncthreads();
    }
}
__device__ __forceinline__ void step_final() {
    const Frame F = make_frame();
    const int gw = F.bid * NWAVES + F.wave, NGW = F.G * NWAVES;
    const bf16* X = (const bf16*)(F.ws + WS_X);
    for (int row = gw; row < ML; row += NGW) {
        const u32x4* xr = (const u32x4*)(X + (size_t)row * D) + F.lane; const f32x4* gg = (const f32x4*)INP(I_FG) + 2 * F.lane;
        f32x4 v[4]; float s = 0.f;
#pragma unroll
        for (int j = 0; j < 2; ++j) { const u32x4 w = xr[64 * j];
            v[2 * j] = (f32x4){bf2f(w.x & 0xffffu), bf2f(w.x >> 16), bf2f(w.y & 0xffffu), bf2f(w.y >> 16)}; v[2 * j + 1] = (f32x4){bf2f(w.z & 0xffffu), bf2f(w.z >> 16), bf2f(w.w & 0xffffu), bf2f(w.w >> 16)};
            s += ((v[2 * j].x * v[2 * j].x + v[2 * j].y * v[2 * j].y) + (v[2 * j].z * v[2 * j].z + v[2 * j].w * v[2 * j].w)) + ((v[2 * j + 1].x * v[2 * j + 1].x + v[2 * j + 1].y * v[2 * j + 1].y) + (v[2 * j + 1].z * v[2 * j + 1].z + v[2 * j + 1].w * v[2 * j + 1].w)); }
        const float rstd = 1.0f / sqrtf(wave_sum(s) * (1.f / D) + EPS);
        f32x4* o = (f32x4*)(F.out + (size_t)row * D) + 2 * F.lane;
#pragma unroll
        for (int j = 0; j < 2; ++j) { o[128 * j] = (v[2 * j] * rstd) * gg[128 * j]; o[128 * j + 1] = (v[2 * j + 1] * rstd) * gg[128 * j + 1]; }
    }
}

__device__ __forceinline__ void step_gdn_scan(int j) {
    const Frame F = make_frame();
    LAS float* qs = (LAS float*)F.lds;
    LAS float* ks = qs + 64 * 128;
    LAS float* vs = ks + 64 * 128;
    LAS float* ga = vs + 64 * 128;
    LAS float* be = ga + 64;
    const bf16* Z = (const bf16*)(F.ws + WS_Z);
    const float* AB = (const float*)(F.ws + WS_AB);
    const float* cw = INP(I_GCONV) + (size_t)j * 3 * 3072;
    float* OFC = (float*)(F.ws + WS_OFC);
    for (int it = F.bid; it < 32; it += F.G) {
        const int b = it >> 4, h = (it >> 1) & 7, dir = it & 1;
        const float Aco = expf(INP(I_GALOG)[j * 16 + dir * 8 + h]); const float dtb = INP(I_GDT)[j * 16 + dir * 8 + h];
        float S[64];
#pragma unroll
        for (int i = 0; i < 64; ++i) S[i] = 0.f;
        const int jcol = F.tid >> 1, half = F.tid & 1;
        for (int n = 0; n < 132; ++n) {
            const bool isctx = n < 4; const int L = isctx ? CT : T; const int p0 = isctx ? 64 * n : 64 * (n - 4); const int rbase = isctx ? ML + b * CT : b * T;
            for (int idx = F.tid; idx < 64 * 384; idx += NTHR) {
                const int c = idx / 384, ch = idx % 384, part = ch >> 7, e = ch & 127;
                const int p = p0 + c; const int t = dir ? (L - 1 - p) : p; const int col = part * 1024 + h * 128 + e;
                float acc = 0.f;
#pragma unroll
                for (int tap = 0; tap < 3; ++tap) { const int tt = t + tap - 1; if (tt >= 0 && tt < L) acc += cw[tap * 3072 + col] * bf2f(Z[(size_t)(rbase + tt) * 4096 + col]); }
                acc = silu_f(acc);
                LAS float* dst = part == 0 ? qs : (part == 1 ? ks : vs); dst[c * 128 + e] = acc;
            }
            if (F.tid < 64) { const int p = p0 + F.tid; const int t = dir ? (L - 1 - p) : p; const size_t row = (size_t)(rbase + t);
                const float av = AB[row * 32 + dir * 8 + h], bv = AB[row * 32 + 16 + dir * 8 + h];
                const float x = av + dtb; const float sp = x > 20.f ? x : log1pf(expf(x));
                ga[F.tid] = expf(-Aco * sp); be[F.tid] = 1.f / (1.f + expf(-bv)); }
            __syncthreads();
#pragma unroll 1
            for (int rr = 0; rr < 8; ++rr) { const int c = F.wave * 8 + rr;
                const float q0 = qs[c * 128 + F.lane], q1 = qs[c * 128 + 64 + F.lane]; const float sq = 0.08838834764831845f / sqrtf(wave_sum(q0 * q0 + q1 * q1) + EPS);
                qs[c * 128 + F.lane] = q0 * sq; qs[c * 128 + 64 + F.lane] = q1 * sq;
                const float k0 = ks[c * 128 + F.lane], k1 = ks[c * 128 + 64 + F.lane]; const float sk = 1.0f / sqrtf(wave_sum(k0 * k0 + k1 * k1) + EPS);
                ks[c * 128 + F.lane] = k0 * sk; ks[c * 128 + 64 + F.lane] = k1 * sk; }
            __syncthreads();
            if (F.tid < 256) {
#pragma unroll 1
                for (int c = 0; c < 64; ++c) {
                    const float a = ga[c], bt = be[c];
                    const LAS f32x4* k4 = (const LAS f32x4*)(ks + c * 128 + 64 * half); const LAS f32x4* q4 = (const LAS f32x4*)(qs + c * 128 + 64 * half);
                    float dot = 0.f;
#pragma unroll
                    for (int i = 0; i < 16; ++i) { const f32x4 kv = k4[i]; dot += kv.x * S[4 * i] + kv.y * S[4 * i + 1] + kv.z * S[4 * i + 2] + kv.w * S[4 * i + 3]; }
                    dot += __shfl_xor(dot, 1);
                    const float tmp = bt * (vs[c * 128 + jcol] - a * dot);
                    float o = 0.f;
#pragma unroll
                    for (int i = 0; i < 16; ++i) { const f32x4 kv = k4[i]; const f32x4 qv = q4[i];
                        S[4 * i] = a * S[4 * i] + kv.x * tmp; S[4 * i + 1] = a * S[4 * i + 1] + kv.y * tmp; S[4 * i + 2] = a * S[4 * i + 2] + kv.z * tmp; S[4 * i + 3] = a * S[4 * i + 3] + kv.w * tmp;
                        o += qv.x * S[4 * i] + qv.y * S[4 * i + 1] + qv.z * S[4 * i + 2] + qv.w * S[4 * i + 3]; }
                    o += __shfl_xor(o, 1);
                    const int p = p0 + c; const int t = dir ? (L - 1 - p) : p;
                    float* dst = isctx ? OFC + (size_t)(b * CT + t) * D : F.out + (size_t)(b * T + t) * D;
                    if (half == 0) atomicAdd(dst + h * 128 + jcol, o);
                }
            }
            __syncthreads();
        }
    }
}
__device__ __forceinline__ void step_gdn_norm(int j) {
    const Frame F = make_frame();
    const int gw = F.bid * NWAVES + F.wave, NGW = F.G * NWAVES;
    const bf16* Z = (const bf16*)(F.ws + WS_Z); bf16* Y = (bf16*)(F.ws + WS_Y); const float* ng = INP(I_GNG) + j * 128;
    for (int row = gw; row < M; row += NGW) {
        const float* src = row < ML ? F.out + (size_t)row * D : (const float*)(F.ws + WS_OFC) + (size_t)(row - ML) * D;
        const f32x4* s4 = (const f32x4*)(src + 16 * F.lane);
        float v[16]; float ss = 0.f;
#pragma unroll
        for (int q = 0; q < 4; ++q) { const f32x4 x = s4[q]; v[4 * q] = x.x; v[4 * q + 1] = x.y; v[4 * q + 2] = x.z; v[4 * q + 3] = x.w; ss += (x.x * x.x + x.y * x.y) + (x.z * x.z + x.w * x.w); }
        ss += __shfl_xor(ss, 1); ss += __shfl_xor(ss, 2); ss += __shfl_xor(ss, 4);
        const float rstd = 1.0f / sqrtf(ss * (1.f / 128.f) + EPS);
        const u32x4* g4 = (const u32x4*)(Z + (size_t)row * 4096 + 3072 + 16 * F.lane);
        const int e0 = (16 * F.lane) & 127;
        u32x4 o[2];
#pragma unroll
        for (int q = 0; q < 2; ++q) { const u32x4 gz = g4[q]; unsigned w[4];
#pragma unroll
            for (int i = 0; i < 4; ++i) { const unsigned gg = gz[i]; const float g0 = bf2f(gg & 0xffffu), g1 = bf2f(gg >> 16); const int e = e0 + 8 * q + 2 * i;
                w[i] = pk2(v[8 * q + 2 * i] * rstd * ng[e] * silu_f(g0), v[8 * q + 2 * i + 1] * rstd * ng[e + 1] * silu_f(g1)); }
            o[q] = (u32x4){w[0], w[1], w[2], w[3]}; }
        u32x4* dst = (u32x4*)(Y + (size_t)row * D + 16 * F.lane); dst[0] = o[0]; dst[1] = o[1];
    }
}

__device__ __forceinline__ void step_sconv() {
    const Frame F = make_frame();
    const int gt = F.bid * NTHR + F.tid, NGT = F.G * NTHR;
    const bf16* Z = (const bf16*)(F.ws + WS_Z); bf16* Y = (bf16*)(F.ws + WS_Y); const float* cw = INP(I_SCONV);
    for (int idx = gt; idx < M * 128; idx += NGT) {
        const int row = idx >> 7, c0 = (idx & 127) * 8;
        int t, L, rbase; if (row < ML) { t = row & (T - 1); L = T; rbase = row - t; } else { const int r2 = row - ML; t = r2 & (CT - 1); L = CT; rbase = row - t; }
        float acc[8];
#pragma unroll
        for (int i = 0; i < 8; ++i) acc[i] = 0.f;
#pragma unroll
        for (int tap = 0; tap < 3; ++tap) { const int tt = t + tap - 1;
            if (tt >= 0 && tt < L) { const bf16* zr = Z + (size_t)(rbase + tt) * 3072; const u32x4 cg = *(const u32x4*)(zr + 1024 + c0), hv = *(const u32x4*)(zr + 2048 + c0);
                const f32x4 w0 = *(const f32x4*)(cw + tap * 1024 + c0), w1 = *(const f32x4*)(cw + tap * 1024 + c0 + 4); const float w[8] = {w0.x, w0.y, w0.z, w0.w, w1.x, w1.y, w1.z, w1.w};
#pragma unroll
                for (int i = 0; i < 4; ++i) { acc[2 * i] += w[2 * i] * bf2f(cg[i] & 0xffffu) * bf2f(hv[i] & 0xffffu); acc[2 * i + 1] += w[2 * i + 1] * bf2f(cg[i] >> 16) * bf2f(hv[i] >> 16); } } }
        const u32x4 bg = *(const u32x4*)(Z + (size_t)row * 3072 + c0); u32x4 o;
#pragma unroll
        for (int i = 0; i < 4; ++i) o[i] = pk2(bf2f(bg[i] & 0xffffu) * acc[2 * i], bf2f(bg[i] >> 16) * acc[2 * i + 1]);
        *(u32x4*)(Y + (size_t)row * D + c0) = o;
    }
}

__device__ __forceinline__ void step_rope() {
    const Frame F = make_frame();
    const int gw = F.bid * NWAVES + F.wave, NGW = F.G * NWAVES;
    bf16* Z = (bf16*)(F.ws + WS_Z); const f32x4* R = (const f32x4*)(F.ws + WS_ROPE);
    for (int row = gw; row < M; row += NGW) {
        u32x4* p = (u32x4*)(Z + (size_t)row * 3072 + 32 * F.lane);
        u32x4 v[4];
#pragma unroll
        for (int q = 0; q < 4; ++q) v[q] = p[q];
        const bool lat = row < ML; const float sc = F.lane < 32 ? QSCALE : 1.0f;
        const f32x4* tab = R + ((size_t)(row & (T - 1)) * 32 + 16 * (F.lane & 1)) / 2;
#pragma unroll
        for (int q = 0; q < 4; ++q) {
#pragma unroll
            for (int i = 0; i < 4; i += 2) {
                f32x4 cs = (f32x4){1.f, 0.f, 1.f, 0.f}; if (lat) cs = tab[(4 * q + i) / 2];
                { const unsigned w = v[q][i]; const float x0 = bf2f(w & 0xffffu), x1 = bf2f(w >> 16); v[q][i] = pk2((x0 * cs.x - x1 * cs.y) * sc, (x0 * cs.y + x1 * cs.x) * sc); }
                { const unsigned w = v[q][i + 1]; const float x0 = bf2f(w & 0xffffu), x1 = bf2f(w >> 16); v[q][i + 1] = pk2((x0 * cs.z - x1 * cs.w) * sc, (x0 * cs.w + x1 * cs.z) * sc); }
            }
        }
#pragma unroll
        for (int q = 0; q < 4; ++q) p[q] = v[q];
    }
    bf16* Vt = (bf16*)(F.ws + WS_H);
    LAS bf16* tl = (LAS bf16*)(F.lds + F.wave * 18432);
    for (int it = gw; it < NB * NH * (NKV / 64); it += NGW) {
        const int kt = it % (NKV / 64), bh = it / (NKV / 64), b = bh >> 3, h = bh & 7; const int kv0 = 64 * kt;
        const int srow = kv0 < CT ? ML + b * CT + kv0 : b * T + kv0 - CT;
#pragma unroll 4
        for (int i = 0; i < 16; ++i) { const int r = 4 * i + (F.lane >> 4), cc = (F.lane & 15) * 8;
            const u32x4 v = *(const u32x4*)(Z + (size_t)(srow + r) * 3072 + 2048 + h * 128 + cc);
#pragma unroll
            for (int q = 0; q < 4; ++q) { tl[(cc + 2 * q) * 72 + r] = (bf16)(v[q] & 0xffffu); tl[(cc + 2 * q + 1) * 72 + r] = (bf16)(v[q] >> 16); } }
        LDS_WAIT(); asm volatile("" ::: "memory");
#pragma unroll 4
        for (int i = 0; i < 16; ++i) { const int e = 8 * i + (F.lane >> 3), ch = F.lane & 7;
            const u32x4 v = *(const LAS u32x4*)(tl + e * 72 + ch * 8);
            *(u32x4*)(Vt + ((size_t)(bh * 128 + e)) * NKV + kv0 + ch * 8) = v; }
        LDS_WAIT(); asm volatile("" ::: "memory");
    }
}
__device__ __forceinline__ void step_attn() {
    const Frame F = make_frame();
    const bf16* Z = (const bf16*)(F.ws + WS_Z); const bf16* Vt = (const bf16*)(F.ws + WS_H); bf16* Y = (bf16*)(F.ws + WS_Y);
    LAS float* EX = (LAS float*)F.lds;
    const int r = F.lane & 31, hi = F.lane >> 5, qs = F.wave & 3, m = F.wave >> 2;
    float lmb;
    { const float* lam = INP(I_DLAM); const float t1 = lam[F.lane] * lam[64 + F.lane], t2 = lam[128 + F.lane] * lam[192 + F.lane]; lmb = expf(wave_sum(t1)) - expf(wave_sum(t2)) + LAMBDA_INIT; }
    const float* ng = INP(I_DNG);
    for (int u = F.bid; u < 1056; u += F.G) {
        int b, h, qrow0, nk;
        if (u < 1024) { b = u >> 9; h = (u >> 6) & 7; qrow0 = b * T + (u & 63) * 128; nk = NKV / 32; }
        else { const int v = u - 1024; b = v >> 4; h = (v >> 1) & 7; qrow0 = ML + b * CT + (v & 1) * 128; nk = CT / 32; }
        const int row0 = qrow0 + 32 * qs;
        bf16x8 qf[4];
#pragma unroll
        for (int d0 = 0; d0 < 4; ++d0) qf[d0] = *(const bf16x8*)(Z + (size_t)(row0 + r) * 3072 + h * 128 + m * 64 + d0 * 16 + hi * 8);
        const int kcol = 1024 + h * 128 + m * 64 + hi * 8;
        const bf16* vtb = Vt + (size_t)((b * 8 + h) * 128 + r) * NKV + 4 * hi;
        f32x16 o[4];
#pragma unroll
        for (int i = 0; i < 4; ++i)
#pragma unroll
            for (int q = 0; q < 16; ++q) o[i][q] = 0.f;
        float mref = 0.f, l = 0.f;
        for (int s = 0; s < nk; ++s) {
            const int kv0 = 32 * s; const int krow = kv0 < CT ? ML + b * CT + kv0 : b * T + kv0 - CT;
            const bf16* kp = Z + (size_t)(krow + r) * 3072 + kcol;
            bf16x8 kf[4];
#pragma unroll
            for (int d0 = 0; d0 < 4; ++d0) kf[d0] = *(const bf16x8*)(kp + d0 * 16);
            bf16x8 vf[4][2];
#pragma unroll
            for (int i = 0; i < 4; ++i)
#pragma unroll
                for (int s2 = 0; s2 < 2; ++s2) { const bf16* vp = vtb + (size_t)(32 * i) * NKV + kv0 + 16 * s2; const s16x4 lo = *(const s16x4*)vp, h8 = *(const s16x4*)(vp + 8);
                    vf[i][s2] = (bf16x8){lo[0], lo[1], lo[2], lo[3], h8[0], h8[1], h8[2], h8[3]}; }
            f32x16 S;
#pragma unroll
            for (int q = 0; q < 16; ++q) S[q] = 0.f;
#pragma unroll
            for (int d0 = 0; d0 < 4; ++d0) S = __builtin_amdgcn_mfma_f32_32x32x16_bf16(kf[d0], qf[d0], S, 0, 0, 0);
            float mx = S[0];
#pragma unroll
            for (int q = 1; q < 16; ++q) mx = fmaxf(mx, S[q]);
            mx = fmaxf(mx, __shfl_xor(mx, 32));
            if (s == 0) mref = mx;
            else if (__any(mx > mref)) { const float mn = fmaxf(mref, mx); const float al = __builtin_amdgcn_exp2f(mref - mn); l *= al; mref = mn;
#pragma unroll
                for (int i = 0; i < 4; ++i)
#pragma unroll
                    for (int q = 0; q < 16; ++q) o[i][q] *= al; }
            float ps = 0.f;
#pragma unroll
            for (int q = 0; q < 16; ++q) { S[q] = __builtin_amdgcn_exp2f(S[q] - mref); ps += S[q]; }
            l += ps;
            bf16x8 pf[2];
#pragma unroll
            for (int s2 = 0; s2 < 2; ++s2) { u32x4 w; w.x = pk2(S[8 * s2], S[8 * s2 + 1]); w.y = pk2(S[8 * s2 + 2], S[8 * s2 + 3]); w.z = pk2(S[8 * s2 + 4], S[8 * s2 + 5]); w.w = pk2(S[8 * s2 + 6], S[8 * s2 + 7]); pf[s2] = __builtin_bit_cast(bf16x8, w); }
#pragma unroll
            for (int i = 0; i < 4; ++i)
#pragma unroll
                for (int s2 = 0; s2 < 2; ++s2) o[i] = __builtin_amdgcn_mfma_f32_32x32x16_bf16(vf[i][s2], pf[s2], o[i], 0, 0, 0);
        }
        l += __shfl_xor(l, 32);
        const float f = (m == 1 ? lmb : 1.0f) / l;
        LAS float* ex = EX + (size_t)m * 128 * 129 + (qs * 32 + r) * 129;
#pragma unroll
        for (int i = 0; i < 4; ++i)
#pragma unroll
            for (int q = 0; q < 16; ++q) ex[32 * i + crow(q, hi)] = o[i][q] * f;
        __syncthreads();
#pragma unroll 1
        for (int rr = 0; rr < 16; ++rr) { const int row = 16 * F.wave + rr;
            const float a0 = EX[row * 129 + F.lane] - EX[128 * 129 + row * 129 + F.lane], a1 = EX[row * 129 + 64 + F.lane] - EX[128 * 129 + row * 129 + 64 + F.lane];
            const float rstd = (1.0f - LAMBDA_INIT) / sqrtf(wave_sum(a0 * a0 + a1 * a1) * (1.f / 128.f) + EPS);
            bf16* yr = Y + (size_t)(qrow0 + row) * D + h * 128;
            yr[F.lane] = (bf16)(pk2(a0 * rstd * ng[F.lane], 0.f) & 0xffffu); yr[64 + F.lane] = (bf16)(pk2(a1 * rstd * ng[64 + F.lane], 0.f) & 0xffffu); }
        __syncthreads();
    }
}

#define PACK8(x, b) __builtin_bit_cast(bf16x8, (u32x4){pk2((x)[(b)], (x)[(b) + 1]), pk2((x)[(b) + 2], (x)[(b) + 3]), pk2((x)[(b) + 4], (x)[(b) + 5]), pk2((x)[(b) + 6], (x)[(b) + 7])})
#define MFMA32(a, b, c) __builtin_amdgcn_mfma_f32_32x32x16_bf16((a), (b), (c), 0, 0, 0)
#if defined(SCAN_PROF) || defined(PREP_PROF)
__device__ unsigned long long g_scanprof = 0ull;
#endif
constexpr int PD_BYTES = 12800, PD_ATT = 6144, PD_EG = 12288, PD_EW = 12544;
__device__ __forceinline__ unsigned off_a(unsigned row, unsigned ch) { return 2048u * (row >> 3) + 512u * (ch >> 2) + 64u * (row & 7) + 16u * ((ch & 3) ^ ((row >> 2) & 3)); }
__device__ __forceinline__ int frag_off(int c, int s) {
    const int slot = (c >> 5) == (s >> 5) ? ((c >> 5) ? 2 : 0) : 1, s2 = (s & 31) >> 4, hh = ((s & 15) >> 2) & 1, jj = ((s & 15) >> 3) * 4 + (s & 3), r = c & 31;
    return slot * 2048 + s2 * 1024 + (hh * 32 + r) * 16 + jj * 2;
}
__device__ __forceinline__ void step_gdn_prep(int j, bool overlap, unsigned* flags, bool dry = false, int skip = 0) {
    const Frame F = make_frame();
    LAS float* STG = (LAS float*)F.lds;
    LAS float* KK = (LAS float*)F.lds;
    LAS float* QK = KK + 64 * 68;
    LAS float* LP = (LAS float*)(F.lds + 34816);
    LAS float* TS = (LAS float*)(F.lds + 67584);
    LAS unsigned char* QI = F.lds + 102400; LAS unsigned char* KI = F.lds + 118784;
    LAS float* SM = (LAS float*)(F.lds + 135168);
    LAS unsigned char* VI = F.lds + 136704;
    const __amdgpu_buffer_rsrc_t zrs = __builtin_amdgcn_make_buffer_rsrc((void*)(F.ws + WS_Z), (short)0, (int)((size_t)M * 4096 * 2), 0x00020000);
    const __amdgpu_buffer_rsrc_t prs = __builtin_amdgcn_make_buffer_rsrc((void*)(F.ws + WS_PD), (short)0, (int)((size_t)2 * 16 * 132 * PD_BYTES), 0x00020000);
#define ST16(rs, boff, val) __builtin_amdgcn_raw_buffer_store_b128(__builtin_bit_cast(u32x4, (val)), (rs), (int)(boff), 0, 16)
    bf16* Z = (bf16*)(F.ws + WS_Z); const float* AB = (const float*)(F.ws + WS_AB); const bf16* HALO = (const bf16*)(F.ws + WS_HALO); unsigned char* PD = F.ws + WS_PD;
    const float* cw = INP(I_GCONV) + (size_t)j * 3 * 3072;
    const int r = F.lane & 31, hi = F.lane >> 5;
#ifdef PREP_PROF
    unsigned long long pprof = 0ull, plast = 0ull;
#endif
    const int first = overlap ? 32 : 0;
    int pub = -1;
    for (int it = F.bid - first; it >= 0 && it < NB * NH * 132; it += F.G - first) {
        int n, bh;
        if (overlap) { bh = it & 15; const int pos = it >> 4;
            if (pos < 4) n = pos == 0 ? 0 : (pos == 1 ? 3 : (pos == 2 ? 1 : 2)); else { const int k = pos - 4; n = (k & 1) ? 131 - (k >> 1) : 4 + (k >> 1); } }
        else { n = it % 132; bh = it / 132; }
        const int b = bh >> 3, h = bh & 7;
        const bool isctx = n < 4; const int L = isctx ? CT : T; const int t0 = isctx ? 64 * n : 64 * (n - 4); const int row0 = (isctx ? ML + b * CT : b * T) + t0;
#ifdef PREP_PROF
        { unsigned long long tn_ = __builtin_amdgcn_s_memrealtime(); asm volatile("" : "+v"(tn_)); plast = tn_; }
#endif
        if (F.tid < 384) {
            const int g8 = F.tid % 48, rp = F.tid / 48, part = g8 >> 4, e0 = (g8 & 15) * 8; const int col = part * 1024 + h * 128 + e0;
            const float* wp = cw + col;
            f32x4 wt[3][2];
#pragma unroll
            for (int tap = 0; tap < 3; ++tap) { wt[tap][0] = *(const f32x4*)(wp + tap * 3072); wt[tap][1] = *(const f32x4*)(wp + tap * 3072 + 4); }
            u32x4 zr[10];
#pragma unroll
            for (int ri = 0; ri < 10; ++ri) { const int c = 8 * rp - 1 + ri; const int t = t0 + c;
                const bf16* src = c < 0 ? HALO + ((size_t)((row0 >> 6) - 1) * 2 + 1) * 3072 + col : (c > 63 ? HALO + ((size_t)((row0 >> 6) + 1) * 2) * 3072 + col : Z + (size_t)(row0 + c) * 4096 + col);
                const bool valid = t >= 0 && t < L;
                if (!valid) src = Z + (size_t)row0 * 4096 + col;
                zr[ri] = *(const u32x4*)src; if (!valid) zr[ri] = (u32x4){0u, 0u, 0u, 0u}; }
#pragma unroll
            for (int i = 0; i < 8; ++i) { float o[8];
#pragma unroll
                for (int q = 0; q < 4; ++q) { const unsigned a = zr[i][q], bq = zr[i + 1][q], cq = zr[i + 2][q];
                    o[2 * q] = silu_fast(wt[0][q >> 1][2 * (q & 1)] * bf2f(a & 0xffffu) + wt[1][q >> 1][2 * (q & 1)] * bf2f(bq & 0xffffu) + wt[2][q >> 1][2 * (q & 1)] * bf2f(cq & 0xffffu));
                    o[2 * q + 1] = silu_fast(wt[0][q >> 1][2 * (q & 1) + 1] * bf2f(a >> 16) + wt[1][q >> 1][2 * (q & 1) + 1] * bf2f(bq >> 16) + wt[2][q >> 1][2 * (q & 1) + 1] * bf2f(cq >> 16)); }
                LAS f32x4* dst = (LAS f32x4*)(STG + (8 * rp + i) * 388 + part * 128 + e0); dst[0] = (f32x4){o[0], o[1], o[2], o[3]}; dst[1] = (f32x4){o[4], o[5], o[6], o[7]}; }
        }
        if (F.wave >= 6) {
            const int d = F.wave - 6, c = F.lane; const size_t row = (size_t)(row0 + c);
            const float Aco = expf(INP(I_GALOG)[j * 16 + d * 8 + h]), dtb = INP(I_GDT)[j * 16 + d * 8 + h];
            const float x = AB[row * 32 + d * 8 + h] + dtb, bb = AB[row * 32 + 16 + d * 8 + h];
            const float sp = x > 20.f ? x : log1pf(expf(x));
            float s = -Aco * sp;
#pragma unroll
            for (int o = 1; o < 64; o <<= 1) { const float up = __shfl_up(s, o), dn = __shfl_down(s, o); if (d ? (c + o < 64) : (c >= o)) s += d ? dn : up; }
            SM[d * 64 + c] = 1.f / (1.f + expf(-bb)); SM[128 + d * 64 + c] = s;
        }
        if (pub >= 0) asm volatile("s_waitcnt vmcnt(0)" ::: "memory");
        __syncthreads();
        if (pub >= 0 && F.tid == 0) __hip_atomic_store(flags + pub, 1u, __ATOMIC_RELAXED, __HIP_MEMORY_SCOPE_AGENT);
        pub = -1;
        if (skip & 8) { if (overlap) pub = bh * 132 + n; continue; }
#ifdef PREP_PROF
        { unsigned long long tn_ = __builtin_amdgcn_s_memrealtime(); asm volatile("" : "+v"(tn_)); if (PREP_PROF == 0) pprof += tn_ - plast; plast = tn_; }
#endif
        { const int c = F.tid >> 3, p = F.tid & 7; const LAS float* sr = STG + c * 388 + 8 * p;
            f32x4 qa[2][2], ka[2][2], va[2][2];
#pragma unroll
            for (int i = 0; i < 2; ++i) { qa[i][0] = *(const LAS f32x4*)(sr + 64 * i); qa[i][1] = *(const LAS f32x4*)(sr + 64 * i + 4); ka[i][0] = *(const LAS f32x4*)(sr + 128 + 64 * i); ka[i][1] = *(const LAS f32x4*)(sr + 128 + 64 * i + 4);
                va[i][0] = *(const LAS f32x4*)(sr + 256 + 64 * i); va[i][1] = *(const LAS f32x4*)(sr + 256 + 64 * i + 4); }
            float sq = 0.f, sk = 0.f;
#pragma unroll
            for (int i = 0; i < 2; ++i)
#pragma unroll
                for (int hq = 0; hq < 2; ++hq)
#pragma unroll
                    for (int e = 0; e < 4; ++e) { sq += qa[i][hq][e] * qa[i][hq][e]; sk += ka[i][hq][e] * ka[i][hq][e]; }
#pragma unroll
            for (int o = 1; o < 8; o <<= 1) { sq += __shfl_xor(sq, o); sk += __shfl_xor(sk, o); }
            const float fq = 0.08838834764831845f / sqrtf(sq + EPS), fk = 1.0f / sqrtf(sk + EPS);
#pragma unroll
            for (int i = 0; i < 2; ++i) { const unsigned oo = off_a(c, p + 8 * i);
                *(LAS u32x4*)(QI + oo) = (u32x4){pk2(qa[i][0][0] * fq, qa[i][0][1] * fq), pk2(qa[i][0][2] * fq, qa[i][0][3] * fq), pk2(qa[i][1][0] * fq, qa[i][1][1] * fq), pk2(qa[i][1][2] * fq, qa[i][1][3] * fq)};
                *(LAS u32x4*)(KI + oo) = (u32x4){pk2(ka[i][0][0] * fk, ka[i][0][1] * fk), pk2(ka[i][0][2] * fk, ka[i][0][3] * fk), pk2(ka[i][1][0] * fk, ka[i][1][1] * fk), pk2(ka[i][1][2] * fk, ka[i][1][3] * fk)};
                *(LAS u32x4*)(VI + c * 256 + (p + 8 * i) * 16) = (u32x4){pk2(va[i][0][0], va[i][0][1]), pk2(va[i][0][2], va[i][0][3]), pk2(va[i][1][0], va[i][1][1]), pk2(va[i][1][2], va[i][1][3])}; } }
        __syncthreads();
        if (skip & 4) { if (overlap) pub = bh * 132 + n; continue; }
#ifdef PREP_PROF
        { unsigned long long tn_ = __builtin_amdgcn_s_memrealtime(); asm volatile("" : "+v"(tn_)); if (PREP_PROF == 1) pprof += tn_ - plast; plast = tn_; }
#endif
        { const int prod = F.wave >> 2, mt = (F.wave >> 1) & 1, nt = F.wave & 1; LAS unsigned char* AI = prod ? QI : KI;
            f32x16 acc;
#pragma unroll
            for (int i = 0; i < 16; ++i) acc[i] = 0.f;
#pragma unroll
            for (int ks = 0; ks < 8; ++ks) { const bf16x8 a = *(const LAS bf16x8*)(AI + off_a(32 * mt + r, 2 * ks + hi)), bq = *(const LAS bf16x8*)(KI + off_a(32 * nt + r, 2 * ks + hi));
                acc = __builtin_amdgcn_mfma_f32_32x32x16_bf16(a, bq, acc, 0, 0, 0); }
            LAS float* dst = prod ? QK : KK;
#pragma unroll
            for (int i = 0; i < 16; ++i) dst[(32 * mt + crow(i, hi)) * 68 + 32 * nt + r] = acc[i]; }
        __syncthreads();
        if (skip & 2) { if (overlap) pub = bh * 132 + n; continue; }
#ifdef PREP_PROF
        { unsigned long long tn_ = __builtin_amdgcn_s_memrealtime(); asm volatile("" : "+v"(tn_)); if (PREP_PROF == 2) pprof += tn_ - plast; plast = tn_; }
#endif
        { const int ps = F.tid & 63;
#pragma unroll 8
            for (int k = 0; k < 16; ++k) { const int d = k >> 3, p = (F.tid >> 6) + 8 * (k & 7); const int c = d ? 63 - p : p, s = d ? 63 - ps : ps;
                const float x = SM[d * 64 + c] * KK[c * 68 + s] * exp_fast(fminf(SM[128 + d * 64 + c] - SM[128 + d * 64 + s], 0.f));
                LP[d * 4096 + p * 64 + ps] = ps < p ? x : 0.f; } }
        __syncthreads();
        const unsigned rec = (unsigned)(((b * 8 + h) * 132 + n) * PD_BYTES);
        constexpr unsigned DSTRIDE = 16u * 132u * PD_BYTES;
#ifdef PREP_PROF
        { unsigned long long tn_ = __builtin_amdgcn_s_memrealtime(); asm volatile("" : "+v"(tn_)); if (PREP_PROF == 3) pprof += tn_ - plast; plast = tn_; }
#endif
        float Tc[32];
#pragma unroll
        for (int p = 0; p < 32; ++p) Tc[p] = 0.f;
        if (F.wave < 4) { if (!(skip & 1)) {
            const int d = F.wave >> 1, blk = F.wave & 1, jj = F.lane & 31;
            float Lr[32];
#pragma unroll
            for (int p = 1; p < 32; ++p) Lr[p] = LP[d * 4096 + (32 * blk + p) * 64 + 32 * blk + jj];
#pragma unroll
            for (int p = 0; p < 32; ++p) { float acc[4]; acc[0] = (p == jj) ? 1.f : 0.f; acc[1] = 0.f; acc[2] = 0.f; acc[3] = 0.f;
#pragma unroll
                for (int sx = 0; sx < p; ++sx) { const float l = __int_as_float(__builtin_amdgcn_readlane(__float_as_int(Lr[p]), sx)); acc[sx & 3] -= l * Tc[sx]; }
                Tc[p] = (acc[0] + acc[1]) + (acc[2] + acc[3]); }
            if (F.lane < 32) { const int pc = 32 * blk + jj;
#pragma unroll
                for (int p = 0; p < 32; ++p) { const int pr = 32 * blk + p; TS[d * 4352 + (d ? 63 - pr : pr) * 68 + (d ? 63 - pc : pc)] = Tc[p]; } } }
        } else {
            for (int q = F.tid - 256; q < 768; q += NTHR - 256) { const int d = q / 384, qq = q % 384, slot = qq >> 7, s2 = (qq >> 6) & 1, ln = qq & 63, hh = ln >> 5, rr = ln & 31;
                const int mtr = slot == 0 ? 0 : (slot == 2 ? 1 : (d ? 0 : 1)), mtc = slot == 0 ? 0 : (slot == 2 ? 1 : (d ? 1 : 0));
                const int c = 32 * mtr + rr, sa = 32 * mtc + 16 * s2 + 4 * hh; const float gcc = SM[128 + d * 64 + c];
                const f32x4 qa = *(const LAS f32x4*)(QK + c * 68 + sa), qb = *(const LAS f32x4*)(QK + c * 68 + sa + 8);
                const f32x4 ga = *(const LAS f32x4*)(SM + 128 + d * 64 + sa), gb = *(const LAS f32x4*)(SM + 128 + d * 64 + sa + 8);
                float v[8];
#pragma unroll
                for (int i = 0; i < 4; ++i) { const int s0 = sa + i, s1 = sa + 8 + i; const bool m0 = d ? (s0 >= c) : (s0 <= c), m1 = d ? (s1 >= c) : (s1 <= c);
                    v[i] = m0 ? qa[i] * exp_fast(gcc - ga[i]) : 0.f; v[4 + i] = m1 ? qb[i] * exp_fast(gcc - gb[i]) : 0.f; }
                if (!dry) ST16(prs, rec + d * DSTRIDE + PD_ATT + qq * 16, ((u32x4){pk2(v[0], v[1]), pk2(v[2], v[3]), pk2(v[4], v[5]), pk2(v[6], v[7])})); }
            if (F.tid >= 256 && F.tid < 320) { const int d = (F.tid - 256) >> 5, wh = (F.tid >> 4) & 1, c4 = (F.tid & 15) * 4;
                const float gl = SM[128 + d * 64 + (d ? 0 : 63)]; const f32x4 g4 = *(const LAS f32x4*)(SM + 128 + d * 64 + c4);
                const f32x4 o4 = wh ? (f32x4){expf(gl - g4[0]), expf(gl - g4[1]), expf(gl - g4[2]), expf(gl - g4[3])} : (f32x4){expf(g4[0]), expf(g4[1]), expf(g4[2]), expf(g4[3])};
                if (!dry) ST16(prs, rec + d * DSTRIDE + (wh ? PD_EW : PD_EG) + 4 * c4, o4); }
        }
        __syncthreads();
#ifdef PREP_PROF
        { unsigned long long tn_ = __builtin_amdgcn_s_memrealtime(); asm volatile("" : "+v"(tn_)); if (PREP_PROF == 4) pprof += tn_ - plast; plast = tn_; }
#endif
        if ((F.wave == 0 || F.wave == 2) && !(skip & 1)) {
            const int d = F.wave >> 1;
            f32x16 Mx, R2;
#pragma unroll
            for (int i = 0; i < 16; ++i) { Mx[i] = 0.f; R2[i] = 0.f; }
#define INV_M(ks) do { const LAS f32x4* lp = (const LAS f32x4*)(LP + d * 4096 + (32 + r) * 64 + 16 * (ks) + 8 * hi); const f32x4 l0 = lp[0], l1 = lp[1]; \
                const bf16x8 A_ = __builtin_bit_cast(bf16x8, (u32x4){pk2(l0[0], l0[1]), pk2(l0[2], l0[3]), pk2(l1[0], l1[1]), pk2(l1[2], l1[3])}); \
                const bf16x8 B_ = __builtin_bit_cast(bf16x8, (u32x4){pk2(hi ? Tc[16 * (ks) + 8] : Tc[16 * (ks)], hi ? Tc[16 * (ks) + 9] : Tc[16 * (ks) + 1]), pk2(hi ? Tc[16 * (ks) + 10] : Tc[16 * (ks) + 2], hi ? Tc[16 * (ks) + 11] : Tc[16 * (ks) + 3]), \
                    pk2(hi ? Tc[16 * (ks) + 12] : Tc[16 * (ks) + 4], hi ? Tc[16 * (ks) + 13] : Tc[16 * (ks) + 5]), pk2(hi ? Tc[16 * (ks) + 14] : Tc[16 * (ks) + 6], hi ? Tc[16 * (ks) + 15] : Tc[16 * (ks) + 7])}); \
                Mx = MFMA32(A_, B_, Mx); } while (0)
            INV_M(0); INV_M(1);
#undef INV_M
#pragma unroll
            for (int ks = 0; ks < 2; ++ks) {
                const int cn = d ? 31 - r : 32 + r, ps0 = 32 + 16 * ks + 4 * hi;
                f32x4 ta, tb;
                if (d) { const f32x4 x0 = *(const LAS f32x4*)(TS + 4352 + cn * 68 + (60 - ps0)), x1 = *(const LAS f32x4*)(TS + 4352 + cn * 68 + (52 - ps0));
                    ta = (f32x4){x0[3], x0[2], x0[1], x0[0]}; tb = (f32x4){x1[3], x1[2], x1[1], x1[0]}; }
                else { ta = *(const LAS f32x4*)(TS + cn * 68 + ps0); tb = *(const LAS f32x4*)(TS + cn * 68 + ps0 + 8); }
                const bf16x8 A2 = __builtin_bit_cast(bf16x8, (u32x4){pk2(ta[0], ta[1]), pk2(ta[2], ta[3]), pk2(tb[0], tb[1]), pk2(tb[2], tb[3])});
                const bf16x8 B2 = ks == 0 ? PACK8(Mx, 0) : PACK8(Mx, 8);
                R2 = MFMA32(A2, B2, R2); }
#pragma unroll
            for (int i = 0; i < 16; ++i) { const int pr = 32 + crow(i, hi), pc = r; TS[d * 4352 + (d ? 63 - pr : pr) * 68 + (d ? 63 - pc : pc)] = -R2[i]; }
        }
        __syncthreads();
#ifdef PREP_PROF
        { unsigned long long tn_ = __builtin_amdgcn_s_memrealtime(); asm volatile("" : "+v"(tn_)); if (PREP_PROF == 5) pprof += tn_ - plast; plast = tn_; }
#endif
        for (int q = F.tid; q < 768; q += NTHR) { const int d = q / 384, qq = q % 384, slot = qq >> 7, s2 = (qq >> 6) & 1, ln = qq & 63, hh = ln >> 5, rr = ln & 31;
            const int mtr = slot == 0 ? 0 : (slot == 2 ? 1 : (d ? 0 : 1)), mtc = slot == 0 ? 0 : (slot == 2 ? 1 : (d ? 1 : 0));
            const int c = 32 * mtr + rr, sa = 32 * mtc + 16 * s2 + 4 * hh;
            const f32x4 ta = *(const LAS f32x4*)(TS + d * 4352 + c * 68 + sa), tb = *(const LAS f32x4*)(TS + d * 4352 + c * 68 + sa + 8);
            const f32x4 ba = *(const LAS f32x4*)(SM + d * 64 + sa), bb = *(const LAS f32x4*)(SM + d * 64 + sa + 8);
            if (!dry) ST16(prs, rec + d * DSTRIDE + qq * 16, ((u32x4){pk2(ta[0] * ba[0], ta[1] * ba[1]), pk2(ta[2] * ba[2], ta[3] * ba[3]), pk2(tb[0] * bb[0], tb[1] * bb[1]), pk2(tb[2] * bb[2], tb[3] * bb[3])})); }
        if (!dry) for (int idx = F.tid; idx < 3072; idx += NTHR) { const int img = idx >> 10, pn = idx & 1023;
            ST16(zrs, (unsigned)(((row0 + (pn >> 4)) * 4096 + img * 1024 + h * 128) * 2 + (pn & 15) * 16), *(const LAS u32x4*)((img == 0 ? QI : (img == 1 ? KI : VI)) + pn * 16)); }
#ifdef PREP_PROF
        { unsigned long long tn_ = __builtin_amdgcn_s_memrealtime(); asm volatile("" : "+v"(tn_)); if (PREP_PROF == 6) pprof += tn_ - plast; plast = tn_; }
#endif
        if (overlap && !dry) pub = bh * 132 + n;
        __syncthreads();
#ifdef PREP_PROF
        { unsigned long long tn_ = __builtin_amdgcn_s_memrealtime(); asm volatile("" : "+v"(tn_)); if (PREP_PROF == 7) pprof += tn_ - plast; plast = tn_; }
#endif
    }
    if (pub >= 0) { asm volatile("s_waitcnt vmcnt(0)" ::: "memory"); __syncthreads(); if (F.tid == 0) __hip_atomic_store(flags + pub, 1u, __ATOMIC_RELAXED, __HIP_MEMORY_SCOPE_AGENT); }
#ifdef PREP_PROF
    if (F.bid == 32 && F.tid == 0) g_scanprof += pprof;
#endif
}

typedef short v4i16_t __attribute__((ext_vector_type(4)));
__device__ __forceinline__ float mul_s(float a, float b) { float r; asm("v_mul_f32_e32 %0, %1, %2" : "=v"(r) : "v"(a), "v"(b)); return r; }
__device__ __forceinline__ float fnma_s(float a, float b, float c) { float r; asm("v_fma_f32 %0, -%1, %2, %3" : "=v"(r) : "v"(a), "v"(b), "v"(c)); return r; }
__device__ __forceinline__ void step_convert_rest() {
    const Frame F = make_frame();
    if (F.bid >= 32 && F.G > 32)
        convert_weights(F.ws, 0xffffu & ~((1u << 8) | (1u << 10)), (F.bid - 32) * NWAVES + F.wave, (F.G - 32) * NWAVES, (F.bid - 32) * NTHR + F.tid, (F.G - 32) * NTHR, F.lds, F.wave, F.lane);
}
__device__ __forceinline__ void step_gdn_scan2(const unsigned* flags, int mode = 0) {
    const Frame F = make_frame();
    constexpr int BUF = 61952, B_K = 0, B_Q = 16384, B_V = 32768, B_PD = 49152, OT_BASE = 2 * BUF, OT_ROW = 272, OT_BYTES = 64 * OT_ROW;
    const bf16* Z = (const bf16*)(F.ws + WS_Z); const unsigned char* PD = F.ws + WS_PD;
    const int r = F.lane & 31, hi = F.lane >> 5;
    unsigned* prog = flags ? (unsigned*)flags + 2560 : nullptr;
    const __amdgpu_buffer_rsrc_t ors = __builtin_amdgcn_make_buffer_rsrc((void*)F.out, (short)0, (int)((size_t)2 * ML * D * 2), 0x00020000);
    const __amdgpu_buffer_rsrc_t crs = __builtin_amdgcn_make_buffer_rsrc((void*)(F.ws + WS_OFC), (short)0, (int)((size_t)2 * MC * D * 2), 0x00020000);
    for (int it = F.bid; it < 32; it += F.G) {
        const int b = it >> 4, h = (it >> 1) & 7, dir = it & 1;
        const unsigned char* pdb = PD + (size_t)(((dir * 2 + b) * 8 + h) * 132) * PD_BYTES;
#define CHUNK_OF(sp) (dir ? ((sp) < 4 ? 3 - (sp) : 135 - (sp)) : (sp))
#define ROW0_OF(n) ((n) < 4 ? ML + b * CT + 64 * (n) : b * T + 64 * ((n) - 4))
        if (F.wave >= 4) {
            const int lt = F.tid - 256;
            u32x4 rgA[16], rgB[16];
#define LOAD_CHUNK(rg, sp) do { const int n_ = CHUNK_OF(sp); const int row0_ = ROW0_OF(n_); \
                _Pragma("unroll") for (int i = 0; i < 4; ++i) { const int pn = lt + 256 * i; const unsigned char* src = (const unsigned char*)(Z + (size_t)(row0_ + (pn >> 4)) * 4096 + h * 128) + (pn & 15) * 16; \
                    rg[i] = *(const u32x4*)(src + 2048); rg[4 + i] = *(const u32x4*)src; rg[8 + i] = *(const u32x4*)(src + 4096); \
                    rg[12 + i] = pn < 800 ? *(const u32x4*)(pdb + (size_t)n_ * PD_BYTES + pn * 16) : (u32x4){0u, 0u, 0u, 0u}; } } while (0)
#define WRITE_CHUNK(rg, bufb) do { LAS unsigned char* base_ = F.lds + (bufb); \
                _Pragma("unroll") for (int i = 0; i < 4; ++i) { const int pn = lt + 256 * i; *(LAS u32x4*)(base_ + B_K + pn * 16) = rg[i]; *(LAS u32x4*)(base_ + B_Q + pn * 16) = rg[4 + i]; \
                    *(LAS u32x4*)(base_ + B_V + pn * 16) = rg[8 + i]; if (pn < 800) *(LAS u32x4*)(base_ + B_PD + pn * 16) = rg[12 + i]; } } while (0)
            int acq = flags ? -1 : 1000;
#define ENSURE(tgt) do { const int tg_ = (tgt); if (F.wave == 4 && tg_ < 132 && acq < tg_) { const unsigned* fb_ = flags + (b * 8 + h) * 132; unsigned spins_ = 0; \
                    while (__hip_atomic_load(fb_ + CHUNK_OF(tg_), __ATOMIC_RELAXED, __HIP_MEMORY_SCOPE_AGENT) == 0u) { __builtin_amdgcn_s_sleep(2); if (++spins_ > (1u << 24)) break; } \
                    int e_ = tg_; while (e_ + 1 < 132 && e_ < tg_ + 16 && __hip_atomic_load(fb_ + CHUNK_OF(e_ + 1), __ATOMIC_RELAXED, __HIP_MEMORY_SCOPE_AGENT) != 0u) ++e_; \
                    __builtin_amdgcn_fence(__ATOMIC_ACQUIRE, "agent"); asm volatile("s_waitcnt vmcnt(0)" ::: "memory"); acq = e_; } } while (0)
            ENSURE(0); ENSURE(1); ENSURE(2);
            __syncthreads();
            LOAD_CHUNK(rgA, 0); WRITE_CHUNK(rgA, 0); LOAD_CHUNK(rgA, 1); LOAD_CHUNK(rgB, 2); ENSURE(3);
            __syncthreads();
#define STORE_O(sq) do { const int n_ = CHUNK_OF(sq); const int row0_ = ROW0_OF(n_); \
                const LAS unsigned char* ot_ = F.lds + OT_BASE + ((sq) & 1) * OT_BYTES; \
                _Pragma("unroll") for (int i = 0; i < 4; ++i) { const int pn = lt + 256 * i; const u32x4 v_ = *(const LAS u32x4*)(ot_ + (pn >> 4) * OT_ROW + (pn & 15) * 16); \
                    if (!(mode & 1)) { if (n_ < 4) __builtin_amdgcn_raw_buffer_store_b128(v_, crs, (int)((((dir * MC + (row0_ - ML) + (pn >> 4)) * D + h * 128) * 2) + (pn & 15) * 16), 0, 16); \
                        else __builtin_amdgcn_raw_buffer_store_b128(v_, ors, (int)((((dir * ML + row0_ + (pn >> 4)) * D + h * 128) * 2) + (pn & 15) * 16), 0, 16); } } } while (0)
#define LOADER_ITER(rg, sp) do { \
                if (prog && (sp) >= 2 && F.tid == 256) (void)__hip_atomic_fetch_add(prog + (b * 132 + CHUNK_OF((sp) - 2)) * 4, 1u, __ATOMIC_RELAXED, __HIP_MEMORY_SCOPE_AGENT); \
                if ((sp) + 1 < 132 && !(mode & 4)) WRITE_CHUNK(rg, (((sp) + 1) & 1) * BUF); \
                if ((sp) > 0) STORE_O((sp) - 1); \
                asm volatile("" ::: "memory"); \
                if ((sp) + 3 < 132 && !(mode & 8)) LOAD_CHUNK(rg, (sp) + 3); \
                ENSURE((sp) + 4); \
                if ((sp) + 3 < 132 && !(mode & 8)) asm volatile("s_waitcnt vmcnt(15)" ::: "memory"); else asm volatile("s_waitcnt vmcnt(0)" ::: "memory"); \
                __syncthreads(); } while (0)
            for (int sp = 0; sp < 132; sp += 2) { LOADER_ITER(rgA, sp); LOADER_ITER(rgB, sp + 1); }
#undef LOADER_ITER
            STORE_O(131);
            asm volatile("s_waitcnt vmcnt(0)" ::: "memory");
            __syncthreads();
            if (prog && F.tid == 256) { for (int s_ = 130; s_ < 132; ++s_) (void)__hip_atomic_fetch_add(prog + (b * 132 + CHUNK_OF(s_)) * 4, 1u, __ATOMIC_RELAXED, __HIP_MEMORY_SCOPE_AGENT); }
#undef STORE_O
#undef ENSURE
#undef LOAD_CHUNK
#undef WRITE_CHUNK
        } else {
            const int w = F.wave;
#ifdef SCAN_PROF
            unsigned long long tprof = 0ull, tlast = 0ull;
#endif
            f32x16 S[4];
#pragma unroll
            for (int kt = 0; kt < 4; ++kt)
#pragma unroll
                for (int i = 0; i < 16; ++i) S[kt][i] = 0.f;
            const int x = (r >> 2) & 3; const int rowb = 2048 * (r >> 3) + 64 * (r & 7);
            int oa[2], ob[2];
#pragma unroll
            for (int s2 = 0; s2 < 2; ++s2) { oa[s2] = rowb + 16 * ((2 * s2) ^ x) + 8 * hi; ob[s2] = rowb + 16 * ((2 * s2 + 1) ^ x) + 8 * hi; }
            const int blk = (F.lane >> 4) & 1, q = (F.lane & 15) >> 2, p = F.lane & 3, cb = 2 * blk + (p >> 1);
            int trb[2];
#pragma unroll
            for (int t = 0; t < 2; ++t) trb[t] = 64 * (4 * hi + q) + 8 * (p & 1) + 16 * (cb ^ ((2 * t + hi) & 3)) + 2048 * t;
            const int vb = 4 * hi * 256 + (32 * w + r) * 2;
            __syncthreads();
            __syncthreads();
            for (int sp = 0; sp < 132; ++sp) {
                const int n = CHUNK_OF(sp); const int row0 = ROW0_OF(n);
                LAS unsigned char* B = F.lds + (sp & 1) * BUF;
                LAS unsigned char* KI = B + B_K; LAS unsigned char* QI = B + B_Q; LAS unsigned char* VI = B + B_V; LAS unsigned char* PR = B + B_PD;
#ifdef SCAN_PROF
                { const unsigned long long tn_ = __builtin_amdgcn_s_memrealtime(); if (SCAN_PROF == 7 && sp > 0) tprof += tn_ - tlast; tlast = tn_; }
#endif
                const int xk = dir ? 8192 : 0, xe = dir ? 128 : 0, xs = dir ? 4096 : 0, xo = dir ? 32 * OT_ROW : 0;
                LAS unsigned char* Kt[2] = {KI + xk, KI + (8192 - xk)}; LAS unsigned char* Qt[2] = {QI + xk, QI + (8192 - xk)}; LAS unsigned char* Vt[2] = {VI + vb + xk, VI + vb + (8192 - xk)};
                LAS unsigned char* Et[2] = {PR + xe, PR + (128 - xe)};
                LAS unsigned char* Tt[2] = {PR + xs + F.lane * 16, PR + (4096 - xs) + F.lane * 16}; LAS unsigned char* Tx = PR + 2048 + F.lane * 16;
#define LDF(dst, base, kt) do { _Pragma("unroll") for (int s2 = 0; s2 < 2; ++s2) _Pragma("unroll") for (int mt = 0; mt < 2; ++mt) { \
                    dst[s2][mt][0] = *(const volatile LAS s16x4*)(base[mt] + 512 * (kt) + oa[s2]); dst[s2][mt][1] = *(const volatile LAS s16x4*)(base[mt] + 512 * (kt) + ob[s2]); } } while (0)
#define FRAG(f) ((bf16x8){f[0][0], f[0][1], f[0][2], f[0][3], f[1][0], f[1][1], f[1][2], f[1][3]})
#define MM_KS(f, kt) do { _Pragma("unroll") for (int s2 = 0; s2 < 2; ++s2) _Pragma("unroll") for (int mt = 0; mt < 2; ++mt) KS[mt] = MFMA32(FRAG(f[s2][mt]), Sb[kt][s2], KS[mt]); \
                    _Pragma("unroll") for (int i = 0; i < 16; ++i) S[kt][i] *= cd; } while (0)
#define MM_QS(f, kt) do { if (!(mode & 2)) { _Pragma("unroll") for (int s2 = 0; s2 < 2; ++s2) _Pragma("unroll") for (int mt = 0; mt < 2; ++mt) QS[mt] = MFMA32(Sb[kt][s2], FRAG(f[s2][mt]), QS[mt]); } } while (0)
#define LDV(vd, ed, g) do { _Pragma("unroll") for (int mt = 0; mt < 2; ++mt) { ed[mt] = *(const LAS f32x4*)(Et[mt] + PD_EG + 4 * (8 * (g) + 4 * hi)); \
                    _Pragma("unroll") for (int i = 0; i < 4; ++i) vd[mt][i] = *(const LAS bf16*)(Vt[mt] + (8 * (g) + i) * 256); } } while (0)
#define RPART(vd, ed, g) do { _Pragma("unroll") for (int mt = 0; mt < 2; ++mt) _Pragma("unroll") for (int i = 0; i < 4; ++i) R8[mt][4 * ((g) & 1) + i] = bf2f(vd[mt][i]) - ed[mt][i] * KS[mt][4 * (g) + i]; \
                    if ((g) & 1) { Rb[0][(g) >> 1] = PACK8(R8[0], 0); Rb[1][(g) >> 1] = PACK8(R8[1], 0); } } while (0)
#define FENCE asm volatile("" ::: "memory")
                s16x4 fa[2][2][2], fb[2][2][2]; bf16 va[2][4]; f32x4 ea[2];
                LDF(fa, Kt, 0); FENCE;
                bf16x8 Sb[4][2];
#pragma unroll
                for (int kt = 0; kt < 4; ++kt) { Sb[kt][0] = PACK8(S[kt], 0); Sb[kt][1] = PACK8(S[kt], 8); }
                const float cd = *(const LAS float*)(PR + PD_EG + 4 * (dir ? 0 : 63));
                f32x16 KS[2], QS[2]; float R8[2][8]; bf16x8 Rb[2][2];
#pragma unroll
                for (int i = 0; i < 16; ++i) { KS[0][i] = 0.f; KS[1][i] = 0.f; }
                LDF(fb, Kt, 1); FENCE; MM_KS(fa, 0);
                LDF(fa, Kt, 2); FENCE; MM_KS(fb, 1);
                LDF(fb, Kt, 3); FENCE; MM_KS(fa, 2);
                LDF(fa, Qt, 0); FENCE; MM_KS(fb, 3);
#ifdef SCAN_PROF
                { const unsigned long long tn_ = __builtin_amdgcn_s_memrealtime(); if (SCAN_PROF == 0) tprof += tn_ - tlast; tlast = tn_; }
#endif
#pragma unroll
                for (int i = 0; i < 16; ++i) { QS[0][i] = 0.f; QS[1][i] = 0.f; }
                LDV(va, ea, 0); FENCE; MM_QS(fa, 0); LDF(fa, Qt, 1); FENCE; RPART(va, ea, 0);
                LDV(va, ea, 1); FENCE; MM_QS(fa, 1); LDF(fa, Qt, 2); FENCE; RPART(va, ea, 1);
                LDV(va, ea, 2); FENCE; MM_QS(fa, 2); LDF(fa, Qt, 3); FENCE; RPART(va, ea, 2);
                LDV(va, ea, 3);
                bf16x8 tf[6];
#pragma unroll
                for (int s2 = 0; s2 < 2; ++s2) { tf[s2] = *(const LAS bf16x8*)(Tt[0] + 1024 * s2); tf[2 + s2] = *(const LAS bf16x8*)(Tt[1] + 1024 * s2); tf[4 + s2] = *(const LAS bf16x8*)(Tx + 1024 * s2); }
                FENCE; MM_QS(fa, 3); RPART(va, ea, 3);
                asm volatile("" ::: "memory");
#ifdef SCAN_PROF
                { const unsigned long long tn_ = __builtin_amdgcn_s_memrealtime(); if (SCAN_PROF == 1) tprof += tn_ - tlast; tlast = tn_; }
#endif
                f32x16 vn[2], o[2];
#pragma unroll
                for (int i = 0; i < 16; ++i) { vn[0][i] = 0.f; vn[1][i] = 0.f; }
                vn[0] = MFMA32(tf[0], Rb[0][0], vn[0]); vn[1] = MFMA32(tf[2], Rb[1][0], vn[1]);
                vn[0] = MFMA32(tf[1], Rb[0][1], vn[0]); vn[1] = MFMA32(tf[3], Rb[1][1], vn[1]);
                vn[1] = MFMA32(tf[4], Rb[0][0], vn[1]); vn[1] = MFMA32(tf[5], Rb[0][1], vn[1]);
                f32x4 w4[2][4];
#pragma unroll
                for (int mt = 0; mt < 2; ++mt) { const float eq = *(const LAS float*)(Et[mt] + PD_EG + 4 * r);
#pragma unroll
                    for (int g = 0; g < 4; ++g) w4[mt][g] = *(const LAS f32x4*)(Et[mt] + PD_EW + 4 * (8 * g + 4 * hi));
#pragma unroll
                    for (int i = 0; i < 16; ++i) o[mt][i] = eq * QS[mt][i]; }
#pragma unroll
                for (int s2 = 0; s2 < 2; ++s2) { tf[s2] = *(const LAS bf16x8*)(Tt[0] + PD_ATT + 1024 * s2); tf[2 + s2] = *(const LAS bf16x8*)(Tt[1] + PD_ATT + 1024 * s2); tf[4 + s2] = *(const LAS bf16x8*)(Tx + PD_ATT + 1024 * s2); }
                asm volatile("" ::: "memory");
#ifdef SCAN_PROF
                { const unsigned long long tn_ = __builtin_amdgcn_s_memrealtime(); if (SCAN_PROF == 2) tprof += tn_ - tlast; tlast = tn_; }
#endif
                bf16x8 Vb[2][2], Wb[2][2];
#pragma unroll
                for (int mt = 0; mt < 2; ++mt) { f32x16 W;
#pragma unroll
                    for (int g = 0; g < 4; ++g)
#pragma unroll
                        for (int i = 0; i < 4; ++i) W[4 * g + i] = w4[mt][g][i] * vn[mt][4 * g + i];
                    Vb[mt][0] = PACK8(vn[mt], 0); Vb[mt][1] = PACK8(vn[mt], 8); Wb[mt][0] = PACK8(W, 0); Wb[mt][1] = PACK8(W, 8); }
#ifdef SCAN_PROF
                { const unsigned long long tn_ = __builtin_amdgcn_s_memrealtime(); if (SCAN_PROF == 3) tprof += tn_ - tlast; tlast = tn_; }
#endif
                if (!(mode & 2)) {
                o[0] = MFMA32(Vb[0][0], tf[0], o[0]); o[1] = MFMA32(Vb[1][0], tf[2], o[1]);
                o[0] = MFMA32(Vb[0][1], tf[1], o[0]); o[1] = MFMA32(Vb[1][1], tf[3], o[1]);
                o[1] = MFMA32(Vb[0][0], tf[4], o[1]); o[1] = MFMA32(Vb[0][1], tf[5], o[1]);
                }
#ifdef SCAN_PROF
                { const unsigned long long tn_ = __builtin_amdgcn_s_memrealtime(); if (SCAN_PROF == 4) tprof += tn_ - tlast; tlast = tn_; }
#endif
#define TRD(dst, n) do { _Pragma("unroll") for (int kt = 0; kt < 4; ++kt) { \
                    dst[kt][0] = __builtin_bit_cast(s16x4, __builtin_amdgcn_ds_read_tr16_b64_v4i16((LAS v4i16_t*)(Kt[(n) >> 1] + 4096 * ((n) & 1) + 512 * kt + trb[0]))); \
                    dst[kt][1] = __builtin_bit_cast(s16x4, __builtin_amdgcn_ds_read_tr16_b64_v4i16((LAS v4i16_t*)(Kt[(n) >> 1] + 4096 * ((n) & 1) + 512 * kt + trb[1]))); } } while (0)
#define MM_S(f, n) do { _Pragma("unroll") for (int kt = 0; kt < 4; ++kt) S[kt] = MFMA32(FRAG(f[kt]), Wb[(n) >> 1][(n) & 1], S[kt]); } while (0)
                s16x4 ta[4][2], tb[4][2];
                TRD(ta, 0); FENCE;
                TRD(tb, 1); FENCE; MM_S(ta, 0);
                TRD(ta, 2); FENCE; MM_S(tb, 1);
                TRD(tb, 3); FENCE; MM_S(ta, 2);
                {
                    LAS unsigned char* oc = F.lds + OT_BASE + (sp & 1) * OT_BYTES + r * OT_ROW + 64 * w + 8 * hi;
#pragma unroll
                    for (int m2 = 0; m2 < 2; ++m2)
#pragma unroll
                        for (int g = 0; g < 4; ++g) *(LAS u32x2*)(oc + (m2 ? 32 * OT_ROW - xo : xo) + 16 * g) = (u32x2){pk2(o[m2][4 * g], o[m2][4 * g + 1]), pk2(o[m2][4 * g + 2], o[m2][4 * g + 3])}; }
                FENCE; MM_S(tb, 3);
#undef TRD
#undef MM_S
#undef FENCE
#undef LDF
#undef FRAG
#undef MM_KS
#undef MM_QS
#undef LDV
#undef RPART
#ifdef SCAN_PROF
                { const unsigned long long tn_ = __builtin_amdgcn_s_memrealtime(); if (SCAN_PROF == 5) tprof += tn_ - tlast; tlast = tn_; }
#endif
                __syncthreads();
            }
            __syncthreads();
#ifdef SCAN_PROF
            if (it == 0 && w == 0 && F.lane == 0) g_scanprof += tprof;
#endif
        }
#undef CHUNK_OF
#undef ROW0_OF
    }
}
__device__ __forceinline__ void gdn_norm_rows(const Frame& F, int j, int row_first, int row_end, int row_step) {
    const bf16* Z = (const bf16*)(F.ws + WS_Z); bf16* Y = (bf16*)(F.ws + WS_Z); const float* ng = INP(I_GNG) + j * 128;
    const int e0 = (16 * F.lane) & 127;
    for (int row = row_first; row < row_end; row += 2 * row_step) {
        const int rowB = row + row_step; const bool hasB = rowB < row_end; const int rB = hasB ? rowB : row;
        u32x4 a[2][2], bq[2][2], gz[2][2];
#pragma unroll
        for (int t = 0; t < 2; ++t) { const int rr = t ? rB : row;
            const bf16* of = rr < ML ? (const bf16*)F.out + (size_t)rr * D : (const bf16*)(F.ws + WS_OFC) + (size_t)(rr - ML) * D;
            const bf16* ob = rr < ML ? of + (size_t)ML * D : of + (size_t)MC * D;
            const u32x4* f4 = (const u32x4*)(of + 16 * F.lane); const u32x4* b4 = (const u32x4*)(ob + 16 * F.lane); const u32x4* g4 = (const u32x4*)(Z + (size_t)rr * 4096 + 3072 + 16 * F.lane);
            a[t][0] = f4[0]; a[t][1] = f4[1]; bq[t][0] = b4[0]; bq[t][1] = b4[1]; gz[t][0] = g4[0]; gz[t][1] = g4[1]; }
#pragma unroll
        for (int t = 0; t < 2; ++t) { const int rr = t ? rB : row;
            float v[16]; float ss = 0.f;
#pragma unroll
            for (int q = 0; q < 2; ++q)
#pragma unroll
                for (int i = 0; i < 4; ++i) { const float x0 = bf2f(a[t][q][i] & 0xffffu) + bf2f(bq[t][q][i] & 0xffffu), x1 = bf2f(a[t][q][i] >> 16) + bf2f(bq[t][q][i] >> 16); v[8 * q + 2 * i] = x0; v[8 * q + 2 * i + 1] = x1; ss += x0 * x0 + x1 * x1; }
            ss += __shfl_xor(ss, 1); ss += __shfl_xor(ss, 2); ss += __shfl_xor(ss, 4);
            const float rstd = 1.0f / sqrtf(ss * (1.f / 128.f) + EPS);
            u32x4 o[2];
#pragma unroll
            for (int q = 0; q < 2; ++q) { unsigned wv[4];
#pragma unroll
                for (int i = 0; i < 4; ++i) { const unsigned gg = gz[t][q][i]; const float g0 = bf2f(gg & 0xffffu), g1 = bf2f(gg >> 16); const int e = e0 + 8 * q + 2 * i;
                    wv[i] = pk2(v[8 * q + 2 * i] * rstd * ng[e] * silu_f(g0), v[8 * q + 2 * i + 1] * rstd * ng[e + 1] * silu_f(g1)); }
                o[q] = (u32x4){wv[0], wv[1], wv[2], wv[3]}; }
            if (t == 0 || hasB) { u32x4* dst = (u32x4*)(Y + (size_t)rr * 4096 + 16 * F.lane); dst[0] = o[0]; dst[1] = o[1]; } }
    }
}
__device__ __forceinline__ void step_gdn_norm2(int j) {
    const Frame F = make_frame();
    gdn_norm_rows(F, j, F.bid * NWAVES + F.wave, M, F.G * NWAVES);
}
__device__ __forceinline__ void step_gdn_follow(int j, const unsigned* flags) {
    const Frame F = make_frame();
    if (F.bid < 32) return;
    const unsigned* prog = flags + 2560;
    for (int u = F.bid - 32; u < 264; u += F.G - 32) {
        int b, n;
        if (u < 8) { b = u & 1; n = u >> 1; } else { const int v = u - 8, wq = v >> 1, jq = wq >> 1; b = v & 1; n = (wq & 1) ? 68 + jq : 67 - jq; }
        if (F.wave == 0) {
            unsigned spins = 0;
            while ((unsigned)__builtin_amdgcn_readfirstlane(__hip_atomic_load(prog + (b * 132 + n) * 4, __ATOMIC_RELAXED, __HIP_MEMORY_SCOPE_AGENT)) < 16u) { __builtin_amdgcn_s_sleep(32); if (++spins > (1u << 20)) break; }
            __builtin_amdgcn_fence(__ATOMIC_ACQUIRE, "agent"); asm volatile("s_waitcnt vmcnt(0)" ::: "memory");
        }
        __syncthreads();
        const int row0 = n < 4 ? ML + b * CT + 64 * n : b * T + 64 * (n - 4);
        gdn_norm_rows(F, j, row0 + F.wave, row0 + 64, NWAVES);
    }
}

__device__ __forceinline__ void step_rope2() {
    const Frame F = make_frame();
    const int gw = F.bid * NWAVES + F.wave, NGW = F.G * NWAVES;
    bf16* Z = (bf16*)(F.ws + WS_Z); const f32x4* R = (const f32x4*)(F.ws + WS_ROPE);
    for (int row = gw; row < M; row += NGW) {
        u32x4* p = (u32x4*)(Z + (size_t)row * 3072 + 32 * F.lane);
        u32x4 v[4];
#pragma unroll
        for (int q = 0; q < 4; ++q) v[q] = p[q];
        const bool lat = row < ML; const float sc = F.lane < 32 ? QSCALE : 1.0f;
        const f32x4* tab = R + ((size_t)(row & (T - 1)) * 32 + 16 * (F.lane & 1)) / 2;
#pragma unroll
        for (int q = 0; q < 4; ++q) {
#pragma unroll
            for (int i = 0; i < 4; i += 2) {
                f32x4 cs = (f32x4){1.f, 0.f, 1.f, 0.f}; if (lat) cs = tab[(4 * q + i) / 2];
                { const unsigned w = v[q][i]; const float x0 = bf2f(w & 0xffffu), x1 = bf2f(w >> 16); v[q][i] = pk2((x0 * cs.x - x1 * cs.y) * sc, (x0 * cs.y + x1 * cs.x) * sc); }
                { const unsigned w = v[q][i + 1]; const float x0 = bf2f(w & 0xffffu), x1 = bf2f(w >> 16); v[q][i + 1] = pk2((x0 * cs.z - x1 * cs.w) * sc, (x0 * cs.w + x1 * cs.z) * sc); }
            }
        }
#pragma unroll
        for (int q = 0; q < 4; ++q) p[q] = v[q];
    }
}
#define ATT_THR 4.0f
__device__ __forceinline__ void att_softmax(f32x16& p0, f32x16& p1, float& m_reg, float& l, float& alpha, bf16x8 (&pf)[2][2]) {
    float mx = fmaxf(p0[0], p1[0]);
#pragma unroll
    for (int q = 1; q < 16; ++q) mx = fmaxf(mx, fmaxf(p0[q], p1[q]));
    mx = fmaxf(mx, __shfl_xor(mx, 32));
    const float mn = (mx - m_reg > ATT_THR) ? mx : m_reg; alpha = __builtin_amdgcn_exp2f(m_reg - mn); m_reg = mn;
    float ps = 0.f;
#pragma unroll
    for (int q = 0; q < 16; ++q) { p0[q] = __builtin_amdgcn_exp2f(p0[q] - m_reg); p1[q] = __builtin_amdgcn_exp2f(p1[q] - m_reg); ps += p0[q] + p1[q]; }
    l = l * alpha + ps;
    pf[0][0] = PACK8(p0, 0); pf[0][1] = PACK8(p0, 8); pf[1][0] = PACK8(p1, 0); pf[1][1] = PACK8(p1, 8);
}
__device__ __forceinline__ void step_attn2(int mode = 0) {
    const Frame F = make_frame();
    const bf16* Z = (const bf16*)(F.ws + WS_Z); bf16* Y = (bf16*)(F.ws + WS_Y);
    LAS float* EX = (LAS float*)F.lds;
    constexpr int KB0 = 0, VB0 = 65536;
    const int r = F.lane & 31, hi = F.lane >> 5, qs = F.wave & 3, m = F.wave >> 2;
    float lmb;
    { const float* lam = INP(I_DLAM); const float t1 = lam[F.lane] * lam[64 + F.lane], t2 = lam[128 + F.lane] * lam[192 + F.lane]; lmb = expf(wave_sum(t1)) - expf(wave_sum(t2)) + LAMBDA_INIT; }
    const float* ng = INP(I_DNG);
    const int kro = 2048 * (r >> 3) + 64 * (r & 7); const int xk = (r >> 2) & 3;
    int koff[2];
#pragma unroll
    for (int d0 = 0; d0 < 2; ++d0) koff[d0] = kro + 1024 * m + 16 * (((2 * d0 + hi) & 3) ^ xk);
    const int blk = (F.lane >> 4) & 1, q4 = (F.lane & 15) >> 2, p4 = F.lane & 3, cb = 2 * blk + (p4 >> 1);
    int trb[2];
#pragma unroll
    for (int t = 0; t < 2; ++t) trb[t] = 64 * (4 * hi + q4) + 8 * (p4 & 1) + 16 * (cb ^ ((2 * t + hi) & 3)) + 2048 * t;
    const int drow = 8 * F.wave + ((F.lane & 31) >> 2);
    const unsigned goff = (unsigned)(drow * 6144 + 16 * (4 * (F.lane >> 5) + ((F.lane & 3) ^ ((drow >> 2) & 3))));
    const unsigned ldsw = (unsigned)F.wave * 2048u;
    const int xcd = F.bid & 7, cux = F.bid >> 3;
    for (int ui = 0; ui < 5; ++ui) {
        int b, h, qrow0, nt;
        if (F.G == 256) {
            h = xcd;
            if (ui < 4) { b = ui >> 1; qrow0 = b * T + (cux + 32 * (ui & 1)) * 128; nt = NKV / 64; }
            else { if (cux >= 4) break; b = cux >> 1; qrow0 = ML + b * CT + (cux & 1) * 128; nt = CT / 64; }
        } else {
            const int u = F.bid + ui * F.G; if (u >= 1056) break;
            if (u < 1024) { b = u >> 9; h = (u >> 6) & 7; qrow0 = b * T + (u & 63) * 128; nt = NKV / 64; }
            else { const int v = u - 1024; b = v >> 4; h = (v >> 1) & 7; qrow0 = ML + b * CT + (v & 1) * 128; nt = CT / 64; }
        }
        const int row0 = qrow0 + 32 * qs;
        bf16x8 qf[4];
#pragma unroll
        for (int d0 = 0; d0 < 4; ++d0) qf[d0] = *(const bf16x8*)(Z + (size_t)(row0 + r) * 3072 + h * 128 + m * 64 + d0 * 16 + hi * 8);
        asm volatile("" : "+v"(qf[0]), "+v"(qf[1]), "+v"(qf[2]), "+v"(qf[3]));
        asm volatile("s_waitcnt vmcnt(0)" ::: "memory");
        const char* kgb = (const char*)(Z + 1024 + h * 128); const char* vgb = (const char*)(Z + 2048 + h * 128);
#define KVROW(t) ((t) < CT / 64 ? ML + b * CT + 64 * (t) : b * T + 64 * (t) - CT)
#define DMAK(t) do { if (mode & 8) break; const int t_ = (t) < nt ? (t) : nt - 1; const char* g_ = kgb + (size_t)KVROW(t_) * 6144 + goff; LAS unsigned char* d_ = F.lds + KB0 + ((t) & 3) * 16384 + ldsw; \
            __builtin_amdgcn_global_load_lds((const unsigned*)g_, (LAS unsigned*)d_, 16, 0, 0); __builtin_amdgcn_global_load_lds((const unsigned*)(g_ + 128), (LAS unsigned*)(d_ + 1024), 16, 0, 0); } while (0)
#define DMAV(t) do { if (mode & 8) break; const int t_ = (t) < nt ? (t) : nt - 1; const char* g_ = vgb + (size_t)KVROW(t_) * 6144 + goff; LAS unsigned char* d_ = F.lds + VB0 + ((t) & 3) * 16384 + ldsw; \
            __builtin_amdgcn_global_load_lds((const unsigned*)g_, (LAS unsigned*)d_, 16, 0, 0); __builtin_amdgcn_global_load_lds((const unsigned*)(g_ + 128), (LAS unsigned*)(d_ + 1024), 16, 0, 0); } while (0)
#define WAIT_BAR(N) do { asm volatile("s_waitcnt vmcnt(" #N ") lgkmcnt(0)" ::: "memory"); __builtin_amdgcn_s_barrier(); asm volatile("" ::: "memory"); } while (0)
#define KRD(KI_, f, S) S = *(const LAS bf16x8*)((KI_) + 8192 * ((f) & 1) + 512 * ((f) >> 2) + koff[((f) >> 1) & 1])
#define KMF(f, S, P0, P1) do { if ((f) & 1) P1 = MFMA32(S, qf[(f) >> 1], P1); else P0 = MFMA32(S, qf[(f) >> 1], P0); asm volatile("" ::: "memory"); } while (0)
#define QKT(P0, P1, t) do { LAS unsigned char* KI_ = F.lds + KB0 + ((t) & 3) * 16384; bf16x8 kA, kB, kC; \
            _Pragma("unroll") for (int q_ = 0; q_ < 16; ++q_) { P0[q_] = 0.f; P1[q_] = 0.f; } \
            KRD(KI_, 0, kA); KRD(KI_, 1, kB); \
            KRD(KI_, 2, kC); KMF(0, kA, P0, P1); KRD(KI_, 3, kA); KMF(1, kB, P0, P1); KRD(KI_, 4, kB); KMF(2, kC, P0, P1); KRD(KI_, 5, kC); KMF(3, kA, P0, P1); \
            KRD(KI_, 6, kA); KMF(4, kB, P0, P1); KRD(KI_, 7, kB); KMF(5, kC, P0, P1); KMF(6, kA, P0, P1); KMF(7, kB, P0, P1); } while (0)
#define VRD(VI_, f, S0, S1) do { S0 = __builtin_bit_cast(s16x4, __builtin_amdgcn_ds_read_tr16_b64_v4i16((LAS v4i16_t*)((VI_) + 8192 * (((f) >> 1) & 1) + 4096 * ((f) & 1) + 512 * ((f) >> 2) + trb[0]))); \
            S1 = __builtin_bit_cast(s16x4, __builtin_amdgcn_ds_read_tr16_b64_v4i16((LAS v4i16_t*)((VI_) + 8192 * (((f) >> 1) & 1) + 4096 * ((f) & 1) + 512 * ((f) >> 2) + trb[1]))); } while (0)
#define VMF(f, S0, S1, PF) do { if (!(mode & 4)) o[(f) >> 2] = MFMA32(((bf16x8){S0[0], S0[1], S0[2], S0[3], S1[0], S1[1], S1[2], S1[3]}), PF[((f) >> 1) & 1][(f) & 1], o[(f) >> 2]); asm volatile("" ::: "memory"); } while (0)
#define PVQ0(VI_, PF) do { VRD(VI_, 0, vA0, vA1); VRD(VI_, 1, vB0, vB1); VRD(VI_, 2, vC0, vC1); VMF(0, vA0, vA1, PF); VRD(VI_, 3, vA0, vA1); VMF(1, vB0, vB1, PF); VRD(VI_, 4, vB0, vB1); VMF(2, vC0, vC1, PF); VRD(VI_, 5, vC0, vC1); VMF(3, vA0, vA1, PF); } while (0)
#define PVQ1(VI_, PF) do { VRD(VI_, 6, vA0, vA1); VMF(4, vB0, vB1, PF); VRD(VI_, 7, vB0, vB1); VMF(5, vC0, vC1, PF); VRD(VI_, 8, vC0, vC1); VMF(6, vA0, vA1, PF); VRD(VI_, 9, vA0, vA1); VMF(7, vB0, vB1, PF); } while (0)
#define PVQ2(VI_, PF) do { VRD(VI_, 10, vB0, vB1); VMF(8, vC0, vC1, PF); VRD(VI_, 11, vC0, vC1); VMF(9, vA0, vA1, PF); VRD(VI_, 12, vA0, vA1); VMF(10, vB0, vB1, PF); VRD(VI_, 13, vB0, vB1); VMF(11, vC0, vC1, PF); } while (0)
#define PVQ3(VI_, PF) do { VRD(VI_, 14, vC0, vC1); VMF(12, vA0, vA1, PF); VRD(VI_, 15, vA0, vA1); VMF(13, vB0, vB1, PF); VMF(14, vC0, vC1, PF); VMF(15, vA0, vA1, PF); } while (0)
#define PVT(t, PF) do { LAS unsigned char* VI_ = F.lds + VB0 + ((t) & 3) * 16384; PVQ0(VI_, PF); PVQ1(VI_, PF); PVQ2(VI_, PF); PVQ3(VI_, PF); } while (0)
#define SM_MAX() do { float mx_ = fmaxf(c0[0], c1[0]); _Pragma("unroll") for (int q_ = 1; q_ < 16; ++q_) mx_ = fmaxf(mx_, fmaxf(c0[q_], c1[q_])); \
            mx_ = fmaxf(mx_, __shfl_xor(mx_, 32)); const float mn_ = (mx_ - mref > ATT_THR) ? mx_ : mref; al = __builtin_amdgcn_exp2f(mref - mn_); mref = mn_; ps = 0.f; } while (0)
#define SM_EXP(C, B, DST) do { if (!(mode & 2)) { _Pragma("unroll") for (int q_ = 0; q_ < 8; ++q_) { C[(B) + q_] = __builtin_amdgcn_exp2f(C[(B) + q_] - mref); ps += C[(B) + q_]; } } DST = PACK8(C, B); } while (0)
#define RESC(al) do { if (__any((al) < 1.f)) { _Pragma("unroll") for (int i = 0; i < 4; ++i) _Pragma("unroll") for (int q_ = 0; q_ < 16; ++q_) o[i][q_] *= (al); } } while (0)
#define SBAR() __builtin_amdgcn_sched_barrier(0)
#define ATT_STEP(j, PFC, PFP) do { \
            WAIT_BAR(8); DMAK((j) + 3); DMAV((j) + 2); \
            SBAR(); QKT(c0, c1, j); SBAR(); \
            { LAS unsigned char* VI_ = F.lds + VB0 + (((j) - 1) & 3) * 16384; \
              PVQ0(VI_, PFP); SM_MAX(); SBAR(); \
              PVQ1(VI_, PFP); SM_EXP(c0, 0, PFC[0][0]); SM_EXP(c0, 8, PFC[0][1]); SBAR(); \
              PVQ2(VI_, PFP); SM_EXP(c1, 0, PFC[1][0]); SBAR(); \
              PVQ3(VI_, PFP); SM_EXP(c1, 8, PFC[1][1]); l = l * al + ps; SBAR(); } \
            RESC(al); } while (0)
        s16x4 vA0, vA1, vB0, vB1, vC0, vC1;
        f32x16 o[4];
#pragma unroll
        for (int i = 0; i < 4; ++i)
#pragma unroll
            for (int q = 0; q < 16; ++q) o[i][q] = 0.f;
        float mref = -1e30f, l = 0.f, al = 1.f, ps = 0.f;
        f32x16 c0, c1; bf16x8 pfA[2][2], pfB[2][2];
        DMAK(0); DMAV(0); DMAK(1); DMAV(1); DMAK(2);
        WAIT_BAR(6); DMAK(3); DMAV(2);
        QKT(c0, c1, 0); SM_MAX(); SM_EXP(c0, 0, pfA[0][0]); SM_EXP(c0, 8, pfA[0][1]); SM_EXP(c1, 0, pfA[1][0]); SM_EXP(c1, 8, pfA[1][1]); l = l * al + ps;
        for (int j = 1; j + 1 < nt; j += 2) {
            ATT_STEP(j, pfB, pfA);
            ATT_STEP(j + 1, pfA, pfB);
        }
        ATT_STEP(nt - 1, pfB, pfA);
        WAIT_BAR(0);
        PVT(nt - 1, pfB);
        WAIT_BAR(0);
#undef DMAK
#undef DMAV
#undef WAIT_BAR
#undef QKT
#undef PVT
#undef PVQ0
#undef PVQ1
#undef PVQ2
#undef PVQ3
#undef VRD
#undef VMF
#undef KRD
#undef KMF
#undef SM_MAX
#undef SM_EXP
#undef RESC
#undef SBAR
#undef ATT_STEP
#undef KVROW
        l += __shfl_xor(l, 32);
        const float f = (m == 1 ? lmb : 1.0f) / l;
        LAS float* ex = EX + (size_t)m * 128 * 129 + (qs * 32 + r) * 129;
#pragma unroll
        for (int i = 0; i < 4; ++i)
#pragma unroll
            for (int q = 0; q < 16; ++q) ex[32 * i + crow(q, hi)] = o[i][q] * f;
        __syncthreads();
#pragma unroll 1
        for (int rr = 0; rr < 16; ++rr) { const int row = 16 * F.wave + rr;
            const float a0 = EX[row * 129 + F.lane] - EX[128 * 129 + row * 129 + F.lane], a1 = EX[row * 129 + 64 + F.lane] - EX[128 * 129 + row * 129 + 64 + F.lane];
            const float rstd = (1.0f - LAMBDA_INIT) / sqrtf(wave_sum(a0 * a0 + a1 * a1) * (1.f / 128.f) + EPS);
            bf16* yr = Y + (size_t)(qrow0 + row) * D + h * 128;
            if (!(mode & 1)) { yr[F.lane] = (bf16)(pk2(a0 * rstd * ng[F.lane], 0.f) & 0xffffu); yr[64 + F.lane] = (bf16)(pk2(a1 * rstd * ng[64 + F.lane], 0.f) & 0xffffu); } }
        __syncthreads();
    }
}

#define XB_TMO      128
#define XB_XCNT(j)  (256  + 64 * (j))
#define XB_XSUB(j)  (1280 + 64 * (j))
#define XB_XGEN(j)  (2304 + 64 * (j))
#define XB_TOP      3328
#define XB_TOPGEN   3392
#define XCD_BAR_WORDS 3456
#define XB_SPIN_CAP (1u << 18)

__device__ __forceinline__ unsigned xb_ld(unsigned* p)              { return __hip_atomic_load(p, __ATOMIC_RELAXED, __HIP_MEMORY_SCOPE_AGENT); }
__device__ __forceinline__ unsigned xb_add(unsigned* p, unsigned v) { return __hip_atomic_fetch_add(p, v, __ATOMIC_RELAXED, __HIP_MEMORY_SCOPE_AGENT); }
__device__ __forceinline__ unsigned xb_xcc_id() { return (unsigned)__builtin_amdgcn_s_getreg((3 << 11) | 20) & 0xFu; }
#define XB_SPIN(cond, bar) do { unsigned _sp = 0; while (cond) { __builtin_amdgcn_s_sleep(1); \
    if ((++_sp & 255u) == 0u) { if (xb_ld(&(bar)[XB_TMO])) break; if (_sp > XB_SPIN_CAP) { atomicAdd(&(bar)[XB_TMO], 1u); break; } } } } while (0)

struct XcdBarrier {
    unsigned* bar; unsigned x;
    volatile LAS unsigned* st;
};

__device__ __forceinline__ XcdBarrier xcd_barrier_post(unsigned* bar, volatile LAS unsigned* st) {
    XcdBarrier b; b.bar = bar; b.x = xb_xcc_id(); b.st = st;
    if (threadIdx.x == 0) (void)xb_add(&bar[XB_XCNT(b.x)], 1u);
    return b;
}
__device__ __forceinline__ void xcd_barrier_complete(unsigned* bar, unsigned x, unsigned& nloc, unsigned& nx) {
    const unsigned G = gridDim.x * gridDim.y * gridDim.z;
    unsigned sum, cnt, mine, sp = 0u;
    for (;;) {
        sum = 0u; cnt = 0u; mine = 0u;
#pragma unroll
        for (unsigned j = 0; j < 16; ++j) { const unsigned c = xb_ld(&bar[XB_XCNT(j)]); sum += c; cnt += (c > 0u) ? 1u : 0u; mine = (j == x) ? c : mine; }
        if (sum == G) break;
        __builtin_amdgcn_s_sleep(1);
        if ((++sp & 255u) == 0u) { if (xb_ld(&bar[XB_TMO])) break; if (sp > XB_SPIN_CAP) { atomicAdd(&bar[XB_TMO], 1u); break; } }
    }
    nloc = mine > 0u ? mine : 1u; nx = cnt > 0u ? cnt : 1u;
}

__device__ __forceinline__ void xcd_barrier(const XcdBarrier& b) {
    asm volatile("s_waitcnt vmcnt(0)" ::: "memory");
    __syncthreads();
    if (threadIdx.x == 0) {
        unsigned* bar = b.bar;
        __builtin_amdgcn_s_waitcnt(0);
        unsigned nloc = b.st[0], nx = b.st[1];
        if (nloc == 0u) { xcd_barrier_complete(bar, b.x, nloc, nx); b.st[0] = nloc; b.st[1] = nx; }
        const unsigned old = xb_add(&bar[XB_XSUB(b.x)], 1u);
        const unsigned gen = old / nloc;
        if (old + 1u == (gen + 1u) * nloc) {
            __builtin_amdgcn_fence(__ATOMIC_RELEASE, "agent");
            asm volatile("s_waitcnt vmcnt(0)" ::: "memory");
            const unsigned og = xb_add(&bar[XB_TOP], 1u);
            const unsigned tg = og / nx;
            if (og + 1u == (tg + 1u) * nx) xb_add(&bar[XB_TOPGEN], 1u);
            else XB_SPIN(xb_ld(&bar[XB_TOPGEN]) == tg, bar);
            __builtin_amdgcn_fence(__ATOMIC_ACQUIRE, "agent");
            xb_add(&bar[XB_XGEN(b.x)], 1u);
            asm volatile("s_waitcnt vmcnt(0)" ::: "memory");
        } else {
            XB_SPIN(xb_ld(&bar[XB_XGEN(b.x)]) == gen, bar);
            __builtin_amdgcn_fence(__ATOMIC_ACQUIRE, "agent");
            asm volatile("s_waitcnt vmcnt(0)" ::: "memory");
        }
    }
    __syncthreads();
}

#ifndef SCAN_MODE
#define SCAN_MODE 0
#endif
#ifndef PREP_SKIP
#define PREP_SKIP 0
#endif
#ifndef MK_SINGLE
#define MK_SINGLE 1
#endif
constexpr int NSTEPS = 28;
struct SEpiStore { bf16* O; int ldc; int act; bf16* halo; const float* SS; const float* bias; float qscale;
    __device__ __forceinline__ void operator()(const float (&v4)[4], int m, int n0, int hi, int g) const {
        const float rs = SS ? 1.0f / sqrtf(pg8::ss_dec(SS, m) * (1.0f / 1024.0f) + 1e-6f) : 1.0f;
        const int n = n0 + 8 * g + 4 * hi; const f32x4 bv = SS ? *(const f32x4*)(bias + n) : (f32x4){0.f, 0.f, 0.f, 0.f}; float v[4];
#pragma unroll
        for (int i = 0; i < 4; ++i) { v[i] = v4[i] * rs + bv[i]; if (act == 1) { const float t = fmaxf(v[i], 0.f); v[i] = t * t; } if (act == 2 && n < 1024) v[i] *= qscale; }
        const u32x2 w = (u32x2){pk2(v[0], v[1]), pk2(v[2], v[3])};
        *(u32x2*)(O + (size_t)m * ldc + n) = w;
        if (halo && n < 3072 && (((m & 63) == 0) || ((m & 63) == 63))) *(u32x2*)(halo + ((size_t)(m >> 6) * 2 + ((m & 63) ? 1 : 0)) * 3072 + n) = w; } };
struct SEpiResid { void* X; const void* Xin; const float* gate; bf16* Hn; const float* cv; float* SSo; int in_f32;
    __device__ __forceinline__ void operator()(const float (&v4)[4], int m, int n0, int hi, int g) const {
        const int n = n0 + 8 * g + 4 * hi; const size_t off = (size_t)m * D + n; const f32x4 gv = *(const f32x4*)(gate + n);
        f32x4 xi; if (in_f32) xi = *(const f32x4*)((const float*)Xin + off); else { const u32x2 w = *(const u32x2*)((const bf16*)Xin + off); xi = (f32x4){pg8::bf_lo(w.x), pg8::bf_hi(w.x), pg8::bf_lo(w.y), pg8::bf_hi(w.y)}; }
        const f32x4 v_ = xi + gv * (f32x4){v4[0], v4[1], v4[2], v4[3]};
        *(u32x2*)((bf16*)X + off) = (u32x2){pk2(v_[0], v_[1]), pk2(v_[2], v_[3])};
        if (Hn) { float ss = (v_[0] * v_[0] + v_[1] * v_[1]) + (v_[2] * v_[2] + v_[3] * v_[3]); const f32x4 h_ = v_ * *(const f32x4*)(cv + n);
            *(u32x2*)(Hn + off) = (u32x2){pk2(h_[0], h_[1]), pk2(h_[2], h_[3])};
            ss += __shfl_xor(ss, 32); if (hi == 0) atomicAdd((unsigned*)SSo + m, pg8::ss_enc(ss)); } } };
struct SEpiAB { float* AB; const float* SS; const float* bias; int bstride;
    __device__ __forceinline__ void operator()(const float (&v4)[4], int m, int n0, int hi, int g) const {
        if (n0 == 0) { const float rs = 1.0f / sqrtf(pg8::ss_dec(SS, m) * (1.0f / 1024.0f) + 1e-6f); const int n = 8 * g + 4 * hi;
            const f32x4 bv = *(const f32x4*)(bias + (size_t)(m < T ? 0 : (m < ML ? 1 : 2)) * bstride + 4096 + n);
            *(f32x4*)(AB + (size_t)m * 32 + n) = (f32x4){v4[0], v4[1], v4[2], v4[3]} * rs + bv; } } };
template <class Epi> __device__ __forceinline__ void small_gemm(const bf16* A, const bf16* Bt, int row_lo, int nrows, int N, int K, const Epi& E, int lda = 0) {
    if (lda == 0) lda = K;
    int tid = threadIdx.x; asm volatile("" : "+v"(tid));
    const int lane = tid & 63, wave = __builtin_amdgcn_readfirstlane(tid >> 6), r = lane & 31, hi = lane >> 5, lrow = lane >> 3, lch = lane & 7;
    int G_ = gridDim.x, B_ = blockIdx.x; asm volatile("" : "+s"(G_), "+s"(B_));
    LAS unsigned char* stg = (LAS unsigned char*)lds_raw + wave * 13824;
    LAS float* red = (LAS float*)lds_raw;
    const int tn = N / 64, items = (nrows / 32) * tn, kw = K / 8, nch = kw / 64;
    const size_t rstep = (size_t)8 * K * 2, rstepA = (size_t)8 * lda * 2;
    u32x4 ra[8], rb[16];
#define SG_PTRS(it_) const int mi_ = (it_) / tn, ni_ = (it_) % tn; \
        ag = (const char*)(A + (size_t)(row_lo + 32 * mi_ + lrow) * lda + wave * kw + lch * 8); bg = (const char*)(Bt + (size_t)(64 * ni_ + lrow) * K + wave * kw + lch * 8)
#define SG_LOAD_PAIR(c) do { _Pragma("unroll") for (int i = 0; i < 4; ++i) ra[i] = *(const u32x4*)(ag + i * rstepA + (c) * 128); _Pragma("unroll") for (int i = 0; i < 8; ++i) rb[i] = *(const u32x4*)(bg + i * rstep + (c) * 128); \
        if ((c) + 1 < nch) { _Pragma("unroll") for (int i = 0; i < 4; ++i) ra[4 + i] = *(const u32x4*)(ag + i * rstepA + ((c) + 1) * 128); _Pragma("unroll") for (int i = 0; i < 8; ++i) rb[8 + i] = *(const u32x4*)(bg + i * rstep + ((c) + 1) * 128); } } while (0)
#define SG_HALF(h_) do { _Pragma("unroll") for (int i = 0; i < 4; ++i) *(LAS u32x4*)(stg + (lrow + 8 * i) * 144 + lch * 16) = ra[4 * (h_) + i]; \
        _Pragma("unroll") for (int i = 0; i < 8; ++i) *(LAS u32x4*)(stg + (32 + lrow + 8 * i) * 144 + lch * 16) = rb[8 * (h_) + i]; } while (0)
#define SG_MMA() do { _Pragma("unroll") for (int ks = 0; ks < 4; ++ks) { const bf16x8 a = *(const LAS bf16x8*)(stg + r * 144 + ks * 32 + hi * 16); \
        const bf16x8 b0 = *(const LAS bf16x8*)(stg + (32 + r) * 144 + ks * 32 + hi * 16), b1 = *(const LAS bf16x8*)(stg + (64 + r) * 144 + ks * 32 + hi * 16); \
        acc[0] = __builtin_amdgcn_mfma_f32_32x32x16_bf16(b0, a, acc[0], 0, 0, 0); acc[1] = __builtin_amdgcn_mfma_f32_32x32x16_bf16(b1, a, acc[1], 0, 0, 0); } } while (0)
    const char* ag = nullptr; const char* bg = nullptr;
    if (B_ < items) { SG_PTRS(B_); SG_LOAD_PAIR(0); }
    for (int it = B_; it < items; it += G_) {
        const int mi = it / tn, ni = it % tn;
        f32x16 acc[2];
#pragma unroll
        for (int x = 0; x < 2; ++x)
#pragma unroll
            for (int i = 0; i < 16; ++i) acc[x][i] = 0.f;
        for (int c = 0; c < nch; c += 2) {
            SG_HALF(0); SG_MMA();
            asm volatile("" ::: "memory");
            const bool two = c + 1 < nch;
            u32x4 ta[4], tb[8];
#pragma unroll
            for (int i = 0; i < 4; ++i) ta[i] = ra[4 + i];
#pragma unroll
            for (int i = 0; i < 8; ++i) tb[i] = rb[8 + i];
            if (c + 2 < nch) SG_LOAD_PAIR(c + 2);
            else if (it + G_ < items) { SG_PTRS(it + G_); SG_LOAD_PAIR(0); }
            if (two) {
#pragma unroll
                for (int i = 0; i < 4; ++i) *(LAS u32x4*)(stg + (lrow + 8 * i) * 144 + lch * 16) = ta[i];
#pragma unroll
                for (int i = 0; i < 8; ++i) *(LAS u32x4*)(stg + (32 + lrow + 8 * i) * 144 + lch * 16) = tb[i];
                SG_MMA(); }
            asm volatile("" ::: "memory");
        }
        __syncthreads();
#pragma unroll
        for (int x = 0; x < 2; ++x)
#pragma unroll
            for (int i = 0; i < 16; ++i) red[((wave * 2 + x) * 16 + i) * 64 + lane] = acc[x][i];
        __syncthreads();
        { const int tile = wave >> 2, g = wave & 3; float v4[4];
#pragma unroll
            for (int i = 0; i < 4; ++i) { float s = 0.f;
#pragma unroll
                for (int w = 0; w < 8; ++w) s += red[((w * 2 + tile) * 16 + 4 * g + i) * 64 + lane];
                v4[i] = s; }
            E(v4, row_lo + 32 * mi + r, 64 * ni + 32 * tile, hi, g); }
        __syncthreads();
    }
#undef SG_PTRS
#undef SG_LOAD_PAIR
#undef SG_HALF
#undef SG_MMA
}
template <int ACT> __device__ __forceinline__ void gemm_store(const bf16* A, const bf16* Bt, bool ctx, int N, int K, bf16* O, int ldc, bf16* halo, const float* SS, const float* bias, int bstride) {
    { int G_ = gridDim.x, B_ = blockIdx.x; asm volatile("" : "+s"(G_), "+s"(B_));
      pg8::Gemm g{A, Bt, ML, N, K, K, K}; pg8::StaticOrder S; S.init(ML, N, G_, B_);
      pg8::EpiStore<ACT> E{SS, bias, bstride, O, ldc, nullptr, -1, halo, ACT == 2 ? (const float*)(kargs()->ws + WS_ROPE) : nullptr, QSCALE};
      pg8::gemm_phase<pg8::EpiStore<ACT>, pg8::StaticOrder, true, true>((LAS unsigned char*)lds_raw, g, S, E); }
    if (ctx) { SEpiStore E2{O, ldc, ACT, halo, SS, bias + 2 * (size_t)bstride, QSCALE}; small_gemm(A, Bt, ML, MC, N, K, E2); }
}
#ifdef TIME_SUB
__device__ unsigned long long g_diag = 0ull;
#endif
__device__ __forceinline__ void gemm_resid(const bf16* A, const bf16* Bt, bool ctx, int K, bf16* X, const float* gate, bool from_inputs, bf16* Hn, const float* cv, float* SSo, int lda = 0, float* Xf32 = nullptr) {
    if (lda == 0) lda = K;
    const void* XinL = from_inputs ? (const void*)INP(I_X) : (const void*)X; const void* XinC = from_inputs ? (const void*)(INP(I_CTX) - (size_t)ML * D) : (const void*)X;
    { int G_ = gridDim.x, B_ = blockIdx.x; asm volatile("" : "+s"(G_), "+s"(B_));
      pg8::Gemm g{A, Bt, ML, D, K, lda, K}; pg8::StaticOrder S; S.init(ML, D, G_, B_);
      pg8::EpiResid E{Hn, cv, D, SSo, Xf32 ? (void*)Xf32 : (void*)X, XinL, D, gate, NADA, 0, from_inputs ? 1 : 0, Xf32 ? 1 : 0};
      pg8::gemm_phase<pg8::EpiResid, pg8::StaticOrder, true, true>((LAS unsigned char*)lds_raw, g, S, E); }
#ifdef TIME_SUB
    const unsigned long long td0 = __builtin_amdgcn_s_memrealtime();
#endif
    if (ctx) { SEpiResid E2{X, XinC, gate + 2 * NADA, Hn, cv + 2 * D, SSo, from_inputs ? 1 : 0}; small_gemm(A, Bt, ML, MC, D, K, E2, lda); }
#ifdef TIME_SUB
    if (K == TIME_SUB && blockIdx.x == 0 && threadIdx.x == 0) g_diag += __builtin_amdgcn_s_memrealtime() - td0;
#endif
}
__device__ __forceinline__ void gemm_gdn_in(unsigned char* ws, int layer, int jj) {
    const float* SS = (const float*)(ws + WS_CTL + CTL_SS) + (size_t)(layer * 2) * M; const float* bin = (const float*)(ws + WS_BIAS) + (size_t)layer * 3 * 4352;
    const bf16* Wt = (const bf16*)(ws + WS_GINT) + (size_t)jj * GDN_NP * D;
    gemm_store<0>((const bf16*)(ws + WS_H), Wt, true, 4096, D, (bf16*)(ws + WS_Z), 4096, (bf16*)(ws + WS_HALO), SS, bin, 4352);
    SEpiAB E3{(float*)(ws + WS_AB), SS, bin, 4352}; small_gemm((const bf16*)(ws + WS_H), Wt + (size_t)4096 * D, 0, M, 64, D, E3);
}
__global__ void __launch_bounds__(NTHR, 2) fwd_kernel(Args a) {
    unsigned char* ws = a.ws;
    const int lo = a.step_lo, hi = a.step_hi; const bool coop = a.coop != 0;
    volatile LAS unsigned* bst = (volatile LAS unsigned*)((LAS unsigned char*)lds_raw + LDS_BYTES - 64);
    if (threadIdx.x < 2) bst[threadIdx.x] = 0u;
    __syncthreads();
    XcdBarrier bar; bar.bar = (unsigned*)(ws + WS_CTL) + 4096; bar.x = 0; bar.st = bst;
    if (coop) bar = xcd_barrier_post((unsigned*)(ws + WS_CTL) + 4096, bst);
#ifndef TIME_LO
#define TIME_LO -1
#define TIME_SCALE 1e-4f
#define TIME_HI -1
#endif
    unsigned long long t_acc = 0ull, t_0 = 0ull;
#ifdef TIME_MID
    unsigned long long t_mid = 0ull;
#define TIME_MID_STAMP(k, id) do { if ((k) == TIME_LO && (id) == TIME_MID) t_mid = __builtin_amdgcn_s_memrealtime() - t_0; } while (0)
#else
#define TIME_MID_STAMP(k, id) do { } while (0)
#endif
#ifndef TIME_BLK
#define TIME_BLK 0
#endif
#define PHASE(k, body) do { if (lo <= (k) && (k) < hi) { __syncthreads(); if ((k) == TIME_LO) t_0 = __builtin_amdgcn_s_memrealtime(); body; if ((k) + 1 < hi && coop) { xcd_barrier(bar); } \
        if ((k) == TIME_HI) t_acc = __builtin_amdgcn_s_memrealtime() - t_0; } } while (0)
#define WB(off) ((bf16*)(ws + (off)))
#define MODP(layer, which) ((const float*)(ws + WS_MOD) + (size_t)(layer) * 3 * NADA + (which) * D)
#define CVP(layer, which) ((const float*)(ws + WS_CV) + (size_t)((layer) * 2 + (which)) * 3 * D)
#define SSP(layer, which) ((float*)(ws + WS_CTL + CTL_SS) + (size_t)((layer) * 2 + (which)) * M)
#define BIN(layer) ((const float*)(ws + WS_BIAS) + (size_t)(layer) * 3 * 4352)
#define BUP(layer) ((const float*)(ws + WS_BIAS) + (size_t)DEPTH * 3 * 4352 + (size_t)(layer) * 3 * FF)
#define TAIL(k0, layer, YA, YLD, WoutT, CTX) \
    PHASE((k0), gemm_resid((YA), (WoutT), (CTX), D, WB(WS_X), MODP(layer, 2), (layer) == 0, WB(WS_H), CVP(layer, 1), SSP(layer, 1), (YLD))); \
    PHASE((k0) + 1, gemm_store<1>(WB(WS_H), WB(WS_W1T) + (size_t)(layer) * D * FF, (CTX), FF, D, WB(WS_Z), FF, nullptr, SSP(layer, 1), BUP(layer), FF)); \
    PHASE((k0) + 2, gemm_resid(WB(WS_Z), WB(WS_W2T) + (size_t)(layer) * D * FF, (CTX), FF, WB(WS_X), MODP(layer, 5), false, \
                               (layer) + 1 < DEPTH ? WB(WS_H) : nullptr, CVP((layer) + 1 < DEPTH ? (layer) + 1 : 0, 0), SSP((layer) + 1 < DEPTH ? (layer) + 1 : 0, 0)))
#define LAYER_GDN(k0, layer, jj, CTX, conv) \
    PHASE((k0), gemm_gdn_in(ws, layer, jj)); \
    if (lo <= (k0) + 1 && (k0) + 1 < hi && !(coop && gridDim.x == 256)) { __syncthreads(); step_gdn_prep(jj, false, nullptr); if ((k0) + 2 < hi && coop) xcd_barrier(bar); } \
    PHASE((k0) + 2, { unsigned* fl_ = (unsigned*)(ws + WS_CTL) + 16384 + (jj) * 4096; \
        if (coop && gridDim.x == 256) { step_gdn_scan2(fl_, SCAN_MODE); TIME_MID_STAMP((k0) + 2, 1); step_gdn_prep(jj, true, fl_, false, PREP_SKIP); TIME_MID_STAMP((k0) + 2, 2); } else step_gdn_scan2(nullptr); \
        if (conv) { step_convert_rest(); TIME_MID_STAMP((k0) + 2, 3); step_bias(65, DEPTH * 129, gridDim.x > 32 ? 32 : 0); TIME_MID_STAMP((k0) + 2, 4); } \
        if (coop && gridDim.x == 256) step_gdn_follow(jj, fl_); TIME_MID_STAMP((k0) + 2, 5); }); \
    if (!(coop && gridDim.x == 256)) PHASE((k0) + 3, step_gdn_norm2(jj)); \
    TAIL((k0) + 4, layer, WB(WS_Z), 4096, WB(WS_GOUTT) + (size_t)(jj) * D * D, CTX)
    PHASE(0, step_prologue());
    PHASE(1, { step_norm0(); step_bias(0, 65, 0); });
    LAYER_GDN(2, 0, 0, true, true);
    PHASE(9, gemm_store<0>(WB(WS_H), WB(WS_SINT), true, 3 * D, D, WB(WS_Z), 3 * D, nullptr, SSP(1, 0), BIN(1), 4352));
    PHASE(10, step_sconv());
    TAIL(11, 1, WB(WS_Y), D, WB(WS_SOUTT), true);
    PHASE(14, gemm_store<2>(WB(WS_H), WB(WS_DINT), true, 3 * D, D, WB(WS_Z), 3 * D, nullptr, SSP(2, 0), BIN(2), 4352));
#ifdef BAR_PROBE
    PHASE(15, {});
#endif
    PHASE(16, step_attn2());
    TAIL(17, 2, WB(WS_Y), D, WB(WS_DOUTT), true);
    LAYER_GDN(20, 3, 1, false, false);
    PHASE(27, step_final());
#ifdef TIME_SUB
    if (blockIdx.x == 0 && threadIdx.x == 0) { __threadfence(); a.out[0] += (float)g_diag * 1e-3f; g_diag = 0ull; }
#endif
#if defined(SCAN_PROF) || defined(PREP_PROF)
    if (blockIdx.x == 0 && threadIdx.x == 0) { __threadfence(); a.out[0] += (float)__hip_atomic_load(&g_scanprof, __ATOMIC_RELAXED, __HIP_MEMORY_SCOPE_AGENT) * 1e-4f; g_scanprof = 0ull; }
#endif
#ifdef PROBE_ZERO
    if (coop) { xcd_barrier(bar); for (size_t i = (size_t)blockIdx.x * NTHR + threadIdx.x; i < (size_t)ML * D / 4; i += (size_t)gridDim.x * NTHR) ((f32x4*)a.out)[i] = (f32x4){16.f, 16.f, 16.f, 16.f}; xcd_barrier(bar); }
    if (TIME_LO >= 0 && blockIdx.x == 0 && threadIdx.x == 0) { a.out[0] = (float)t_acc * TIME_SCALE; }
#else
#ifdef TIME_MID
    t_acc = t_mid;
#endif
    if (TIME_LO >= 0 && blockIdx.x == TIME_BLK && threadIdx.x == 0) { __threadfence(); a.out[0] += (float)t_acc * TIME_SCALE; }
#endif
}

extern "C" void kernel_launch(void* const* d_in, const int* in_sizes, int n_in, void* d_out, int out_size, void* d_ws, size_t ws_size, hipStream_t stream) {
    static int grid = 0;
    if (grid == 0) {
        if (n_in != 24 || out_size != ML * D || ws_size < WS_END) { fprintf(stderr, "kernel_launch: unexpected problem (n_in %d, out %d, ws %zu); nothing launched\n", n_in, out_size, ws_size); grid = -1; return; }
        int dev = 0, cus = 0, per_cu = 0;
        if (hipGetDevice(&dev) != hipSuccess || hipDeviceGetAttribute(&cus, hipDeviceAttributeMultiprocessorCount, dev) != hipSuccess) { grid = -1; return; }
        if (hipFuncSetAttribute((const void*)fwd_kernel, hipFuncAttributeMaxDynamicSharedMemorySize, LDS_BYTES) != hipSuccess) { fprintf(stderr, "kernel_launch: hipFuncSetAttribute failed\n"); grid = -1; return; }
        if (hipOccupancyMaxActiveBlocksPerMultiprocessor(&per_cu, (const void*)fwd_kernel, NTHR, LDS_BYTES) != hipSuccess || per_cu < 1) { fprintf(stderr, "kernel_launch: occupancy query says %d blocks per CU\n", per_cu); (void)hipGetLastError(); per_cu = 1; }
        grid = cus;
        fprintf(stderr, "kernel_launch: %d CUs, occupancy %d per CU, grid %d\n", cus, per_cu, grid);
    }
    if (grid < 0) return;
    (void)hipMemsetAsync((char*)d_ws + WS_CTL, 0, CTL_ZERO_BYTES, stream);
    Args a{};
    for (int i = 0; i < 24; ++i) a.in[i] = (const float*)d_in[i];
    a.out = (float*)d_out; a.ws = (unsigned char*)d_ws;
#if MK_SINGLE
    a.step_lo = 0; a.step_hi = NSTEPS; a.coop = 1;
    void* args[] = {&a};
    hipError_t e = hipLaunchCooperativeKernel((const void*)fwd_kernel, dim3(grid), dim3(NTHR), args, LDS_BYTES, stream);
    if (e != hipSuccess) fprintf(stderr, "cooperative launch failed: %s (grid %d)\n", hipGetErrorString(e), grid);
#else
    for (int s = 0; s < NSTEPS; ++s) { a.step_lo = s; a.step_hi = s + 1; a.coop = 0; hipLaunchKernelGGL(fwd_kernel, dim3(grid), dim3(NTHR), LDS_BYTES, stream, a); }
#endif
}
```

```cpp
#include <hip/hip_runtime.h>
#include <hip/hip_cooperative_groups.h>
#include <cstdio>
#include <cstdint>
namespace cg = cooperative_groups;
namespace pg8 {
#define PG8_LAS __attribute__((address_space(3)))
typedef unsigned short bf16_t;
typedef short bf16x8 __attribute__((ext_vector_type(8)));
typedef float f32x4 __attribute__((ext_vector_type(4)));
typedef unsigned u32x4 __attribute__((ext_vector_type(4)));
constexpr int BM = 256, BK = 64, HALF = 128, HTB = HALF * BK * 2  , STAGE_BYTES = 8 * HTB, NXCD = 8, WGM = 8;

__host__ __device__ __forceinline__ int lds_byte(int r, int c) { const int st = (r >> 4) * 2 + (c >> 5), rr = r & 15, cc = c & 31, ob = rr * 64 + cc * 2; return st * 1024 + (ob ^ (((ob >> 9) & 1) << 5)); }
__host__ __device__ __forceinline__ void stage_rc(int b, int& R, int& C) { const int st = b / 1024, sb = b % 1024, swz = sb ^ (((sb >> 9) & 1) << 5); R = (st >> 1) * 16 + swz / 64; C = (st & 1) * 32 + (swz % 64) / 2; }
__host__ __device__ __forceinline__ int perm32(int rho) { const int n = rho >> 4, i = rho & 15; return 8 * (i >> 2) + 4 * n + (i & 3); }

struct Unit { int pm, pn; };
struct Gemm { const bf16_t* A; const bf16_t* Bt; int M, N, K, lda, ldb; };

struct StaticOrder {
    int nM, nN, nwg, G, c;
    __host__ __device__ void init(int M, int N, int G_, int c_) { nM = M / BM; nN = N / BM; nwg = nM * nN; G = G_; c = c_; }
    __host__ __device__ bool next(int i, Unit& u) const {
        const long L = (long)i * G + c; if (L >= nwg) return false;
        int wgid = (int)L; { const int q = nwg / NXCD, r = nwg % NXCD, xcd = wgid % NXCD, off = wgid / NXCD; wgid = (xcd < r ? xcd * (q + 1) : r * (q + 1) + (xcd - r) * q) + off; }
        const int nig = WGM * nN, gid = wgid / nig, fm = gid * WGM, gsz = (nM - fm) < WGM ? (nM - fm) : WGM;
        u.pm = fm + ((wgid % nig) % gsz); u.pn = (wgid % nig) / gsz; return true;
    }
    __device__ __forceinline__ void a_ready(const Unit&) const {}
    __device__ __forceinline__ void done(const Unit&) const {}
};

typedef float f32x2 __attribute__((ext_vector_type(2)));
typedef __bf16 bf16x2_t __attribute__((ext_vector_type(2)));
typedef unsigned u32x2 __attribute__((ext_vector_type(2)));
__device__ __forceinline__ unsigned ss_enc(float s) { return (unsigned)(s * 1024.0f + 0.5f); }
__device__ __forceinline__ float ss_dec(const float* SS, int row) { return (float)((const unsigned*)SS)[row] * (1.0f / 1024.0f); }
__device__ __forceinline__ unsigned cvt_pk_bf16(float lo, float hi) { f32x2 v = {lo, hi}; bf16x2_t b = __builtin_convertvector(v, bf16x2_t); return __builtin_bit_cast(unsigned, b); }

template <int ACT> struct EpiStore {
    static constexpr bool PERM = true, AFTER_DRAIN = false;
    const float* SS; const float* bias; int bstride;
    bf16_t* O; int ldc; float* AB; int ab_tile; bf16_t* halo;
    const float* rope; float qscale;
    __device__ __forceinline__ void operator()(const f32x4 (&acc)[2][2][4][2], const Unit& u, int wr, int wc, int fr, int fq) const {
        const int row0 = u.pm * BM + wr * 64 + fr;
        if (u.pn == ab_tile) {
            if (wc == 0) {
#pragma unroll
                for (int ai = 0; ai < 2; ++ai)
#pragma unroll
                    for (int m = 0; m < 4; ++m) { float* p = AB + (size_t)(row0 + ai * HALF + m * 16) * 32 + 8 * fq; *(f32x4*)p = acc[ai][0][m][0]; *(f32x4*)(p + 4) = acc[ai][0][m][1]; }
            }
            return;
        }
        const int col0 = u.pn * BM + wc * 32 + 8 * fq;
        f32x4 bv[2][2];
#pragma unroll
        for (int bj = 0; bj < 2; ++bj)
#pragma unroll
            for (int n = 0; n < 2; ++n) bv[bj][n] = SS ? *(const f32x4*)(bias + (size_t)(u.pm < 32 ? 0 : (u.pm < 64 ? 1 : 2)) * bstride + col0 + bj * HALF + 4 * n) : (f32x4){0.f, 0.f, 0.f, 0.f};
#pragma unroll
        for (int ai = 0; ai < 2; ++ai)
#pragma unroll
            for (int m = 0; m < 4; ++m) { const int row = row0 + ai * HALF + m * 16; bf16_t* rowp = O + (size_t)row * ldc + col0;
                const float rs = SS ? 1.0f / sqrtf(ss_dec(SS, row) * (1.0f / 1024.0f) + 1e-6f) : 1.0f;
                f32x4 c0 = {1.f, 0.f, 1.f, 0.f}, c1 = c0; float qs = 1.f;
                if constexpr (ACT == 2) { if (u.pn < 8) { const f32x4* tab = (const f32x4*)rope + (size_t)(row & 8191) * 16 + (wc & 1) * 8 + 2 * fq; c0 = tab[0]; c1 = tab[1]; qs = u.pn < 4 ? qscale : 1.f; } }
#pragma unroll
                for (int bj = 0; bj < 2; ++bj) { f32x4 v0 = acc[ai][bj][m][0] * rs + bv[bj][0], v1 = acc[ai][bj][m][1] * rs + bv[bj][1];
                    if constexpr (ACT == 2) {
                        v0 = (f32x4){(v0[0] * c0[0] - v0[1] * c0[1]) * qs, (v0[0] * c0[1] + v0[1] * c0[0]) * qs, (v0[2] * c0[2] - v0[3] * c0[3]) * qs, (v0[2] * c0[3] + v0[3] * c0[2]) * qs};
                        v1 = (f32x4){(v1[0] * c1[0] - v1[1] * c1[1]) * qs, (v1[0] * c1[1] + v1[1] * c1[0]) * qs, (v1[2] * c1[2] - v1[3] * c1[3]) * qs, (v1[2] * c1[3] + v1[3] * c1[2]) * qs}; }
                    if (ACT == 1) {
#pragma unroll
                        for (int i = 0; i < 4; ++i) { const float a = fmaxf(v0[i], 0.f), b = fmaxf(v1[i], 0.f); v0[i] = a * a; v1[i] = b * b; } }
                    u32x4 w; w.x = cvt_pk_bf16(v0[0], v0[1]); w.y = cvt_pk_bf16(v0[2], v0[3]); w.z = cvt_pk_bf16(v1[0], v1[1]); w.w = cvt_pk_bf16(v1[2], v1[3]);
                    *(u32x4*)(rowp + bj * HALF) = w;
                    if (halo && u.pn < 12 && ((m == 0 && fr == 0) || (m == 3 && fr == 15)))
                        *(u32x4*)(halo + ((size_t)(row >> 6) * 2 + (m == 3 ? 1 : 0)) * 3072 + col0 + bj * HALF) = w; } }
    }
};
__device__ __forceinline__ float bf_lo(unsigned w) { return __uint_as_float(w << 16); }
__device__ __forceinline__ float bf_hi(unsigned w) { return __uint_as_float(w & 0xffff0000u); }
struct EpiResid {
    static constexpr bool PERM = true, AFTER_DRAIN = false;
    bf16_t* Hn; const float* cv; int cvstride; float* SSo;
    void* X; const void* Xin; int ldc; const float* gate; int gstride; int dry; int in_f32, out_f32;
    template <bool INF, bool OUTF> __device__ __forceinline__ void body(const f32x4 (&acc)[2][2][4][2], const Unit& u, int wr, int wc, int fr, int fq) const {
        const int row0 = u.pm * BM + wr * 64 + fr, col0 = u.pn * BM + wc * 32 + 8 * fq;
        const float* g = gate + (size_t)(u.pm < 32 ? 0 : (u.pm < 64 ? 1 : 2)) * gstride + col0;
        const int grp = u.pm < 32 ? 0 : (u.pm < 64 ? 1 : 2);
        f32x4 gv[2][2], cvv[2][2];
#pragma unroll
        for (int bj = 0; bj < 2; ++bj)
#pragma unroll
            for (int n = 0; n < 2; ++n) { gv[bj][n] = *(const f32x4*)(g + bj * HALF + n * 4); cvv[bj][n] = Hn ? *(const f32x4*)(cv + (size_t)grp * cvstride + col0 + bj * HALF + n * 4) : (f32x4){0.f, 0.f, 0.f, 0.f}; }
#pragma unroll
        for (int ai = 0; ai < 2; ++ai)
#pragma unroll
            for (int m = 0; m < 4; ++m) { const int row = row0 + ai * HALF + m * 16; const size_t off = (size_t)row * ldc + col0; float ss = 0.f;
#pragma unroll
                for (int bj = 0; bj < 2; ++bj) { f32x4 x0, x1;
                    if (INF) { const float* pi = (const float*)Xin + off + bj * HALF; x0 = *(const f32x4*)pi; x1 = *(const f32x4*)(pi + 4); }
                    else { const u32x4 w = *(const u32x4*)((const bf16_t*)Xin + off + bj * HALF); x0 = (f32x4){bf_lo(w.x), bf_hi(w.x), bf_lo(w.y), bf_hi(w.y)}; x1 = (f32x4){bf_lo(w.z), bf_hi(w.z), bf_lo(w.w), bf_hi(w.w)}; }
                    const f32x4 v0 = x0 + gv[bj][0] * acc[ai][bj][m][0], v1 = x1 + gv[bj][1] * acc[ai][bj][m][1];
                    if (!dry) { if (OUTF) { float* q = (float*)X + off + bj * HALF; *(f32x4*)q = v0; *(f32x4*)(q + 4) = v1; }
                        else *(u32x4*)((bf16_t*)X + off + bj * HALF) = (u32x4){cvt_pk_bf16(v0[0], v0[1]), cvt_pk_bf16(v0[2], v0[3]), cvt_pk_bf16(v1[0], v1[1]), cvt_pk_bf16(v1[2], v1[3])}; }
                    else asm volatile("" :: "v"(v0), "v"(v1));
                    if (Hn) { ss += ((v0[0] * v0[0] + v0[1] * v0[1]) + (v0[2] * v0[2] + v0[3] * v0[3])) + ((v1[0] * v1[0] + v1[1] * v1[1]) + (v1[2] * v1[2] + v1[3] * v1[3]));
                        const f32x4 h0 = v0 * cvv[bj][0], h1 = v1 * cvv[bj][1];
                        *(u32x4*)(Hn + off + bj * HALF) = (u32x4){cvt_pk_bf16(h0[0], h0[1]), cvt_pk_bf16(h0[2], h0[3]), cvt_pk_bf16(h1[0], h1[1]), cvt_pk_bf16(h1[2], h1[3])}; } }
                if (Hn) { ss += __shfl_xor(ss, 16); ss += __shfl_xor(ss, 32); if (fq == 0) atomicAdd((unsigned*)SSo + row, ss_enc(ss)); }
                if (m & 1) asm volatile("" ::: "memory"); }
    }
    __device__ __forceinline__ void operator()(const f32x4 (&acc)[2][2][4][2], const Unit& u, int wr, int wc, int fr, int fq) const {
        if (in_f32) body<true, false>(acc, u, wr, wc, fr, fq); else if (out_f32) body<false, true>(acc, u, wr, wc, fr, fq); else body<false, false>(acc, u, wr, wc, fr, fq);
    }
};

template <class Epi, class Sched, bool ALIGN_EPI = false, bool SP2 = false>
__device__ __forceinline__ void gemm_phase(PG8_LAS unsigned char* lds, const Gemm g, const Sched& S, const Epi& E) {
    int tid_ = threadIdx.x; asm volatile("" : "+v"(tid_)); const int tid = tid_, wid = __builtin_amdgcn_readfirstlane(tid >> 6), lane = tid & 63, wr = wid >> 2, wc = wid & 3, fr = lane & 15, fq = lane >> 4;
    const int K = g.K, nt = K / BK;
    unsigned voffA[2], voffB[2];
#pragma unroll
    for (int i = 0; i < 2; ++i) { int R, C; stage_rc(tid * 16 + i * 8192, R, C); const int Rb = Epi::PERM ? ((R & ~31) + perm32(R & 31)) : R;
        voffA[i] = (unsigned)(R * g.lda + C) * 2u; voffB[i] = (unsigned)(Rb * g.ldb + C) * 2u; }
    const size_t kstep = (size_t)(BK * 2);
    const int lda = g.lda, ldb = g.ldb;
    const size_t hstepA = (size_t)HALF * lda * 2, hstepB = (size_t)HALF * ldb * 2;
    const size_t tstepA = 2 * hstepA, tstepB = 2 * hstepB;
    const unsigned ldsw = (unsigned)wid * 1024u;
    const int aoff = lds_byte(wr * 64 + fr, fq * 8), boff = lds_byte(wc * 32 + fr, fq * 8);
#define PG8_SA(b, h) (((b) * 2 + (h)) * HTB)
#define PG8_SB(b, h) ((4 + (b) * 2 + (h)) * HTB)
#define PG8_STAGE(bufoff, gbase, voff) do { _Pragma("unroll") for (int _i = 0; _i < 2; ++_i) \
        __builtin_amdgcn_global_load_lds((const unsigned*)((const char*)(gbase) + (voff)[_i]), (PG8_LAS unsigned*)(lds + (bufoff) + ldsw + _i * 8192), 16, 0, 0); } while (0)
#define PG8_LDA(dst, b, h) do { _Pragma("unroll") for (int m = 0; m < 4; ++m) _Pragma("unroll") for (int k = 0; k < 2; ++k) dst[m][k] = *(const PG8_LAS bf16x8*)(lds + PG8_SA(b, h) + aoff + m * 2048 + k * 1024); } while (0)
#define PG8_LDB(dst, b, h) do { _Pragma("unroll") for (int n = 0; n < 2; ++n) _Pragma("unroll") for (int k = 0; k < 2; ++k) dst[n][k] = *(const PG8_LAS bf16x8*)(lds + PG8_SB(b, h) + boff + n * 2048 + k * 1024); } while (0)
#define PG8_MMA(ai, bj, At, Bt) do { __builtin_amdgcn_s_setprio(1); _Pragma("unroll") for (int m = 0; m < 4; ++m) _Pragma("unroll") for (int n = 0; n < 2; ++n) _Pragma("unroll") for (int k = 0; k < 2; ++k) \
        acc[ai][bj][m][n] = __builtin_amdgcn_mfma_f32_16x16x32_bf16(Bt[n][k], At[m][k], acc[ai][bj][m][n], 0, 0, 0); __builtin_amdgcn_s_setprio(0); } while (0)
#define PG8_WAIT_V(n) asm volatile("s_waitcnt vmcnt(" #n ")" ::: "memory")
#define PG8_WAIT_L(n) asm volatile("s_waitcnt lgkmcnt(" #n ")" ::: "memory")
#define PG8_BAR __builtin_amdgcn_s_barrier()
#define PG8_SCHED __builtin_amdgcn_sched_barrier(0)
    Unit cur, nxt; int ui = 0;
    if (!S.next(0, cur)) return;
    f32x4 acc[2][2][4][2];
#pragma unroll
    for (int a = 0; a < 2; ++a)
#pragma unroll
        for (int b = 0; b < 2; ++b)
#pragma unroll
            for (int m = 0; m < 4; ++m)
#pragma unroll
                for (int n = 0; n < 2; ++n) acc[a][b][m][n] = (f32x4){0.f, 0.f, 0.f, 0.f};
    bf16x8 At[4][2], B0[2][2], B1[2][2];
    const char* cA = (const char*)g.A + (size_t)cur.pm * tstepA; const char* cB = (const char*)g.Bt + (size_t)cur.pn * tstepB;
    S.a_ready(cur);
    if constexpr (SP2) {
        PG8_STAGE(PG8_SB(0, 0), cB, voffB); PG8_STAGE(PG8_SB(0, 1), cB + hstepB, voffB); PG8_STAGE(PG8_SA(0, 0), cA, voffA); PG8_STAGE(PG8_SA(0, 1), cA + hstepA, voffA);
        if (wr == 1) PG8_BAR;
        PG8_WAIT_V(2); PG8_BAR;
        PG8_STAGE(PG8_SB(1, 0), cB + kstep, voffB); PG8_STAGE(PG8_SA(1, 0), cA + kstep, voffA); PG8_STAGE(PG8_SB(1, 1), cB + hstepB + kstep, voffB);
        PG8_WAIT_V(6); PG8_BAR;
    } else {
        PG8_STAGE(PG8_SB(0, 0), cB, voffB); PG8_STAGE(PG8_SA(0, 0), cA, voffA); PG8_STAGE(PG8_SB(0, 1), cB + hstepB, voffB); PG8_STAGE(PG8_SA(0, 1), cA + hstepA, voffA);
        if (wr == 1) PG8_BAR;
        PG8_WAIT_V(4); PG8_BAR;
        PG8_STAGE(PG8_SB(1, 0), cB + kstep, voffB); PG8_STAGE(PG8_SA(1, 0), cA + kstep, voffA); PG8_STAGE(PG8_SB(1, 1), cB + hstepB + kstep, voffB);
        PG8_WAIT_V(6); PG8_BAR;
    }
    for (;;) {
        const bool has_next = S.next(ui + 1, nxt);
        const char* nA = has_next ? (const char*)g.A + (size_t)nxt.pm * tstepA : cA; const char* nB = has_next ? (const char*)g.Bt + (size_t)nxt.pn * tstepB : cB;
        for (int t = 0; t < nt; t += 2) {
            const bool last = (t == nt - 2);
            const char* a1 = cA + (size_t)(t + 1) * kstep;
            const char* a2 = last ? nA : cA + (size_t)(t + 2) * kstep; const char* b2 = last ? nB : cB + (size_t)(t + 2) * kstep;
            const char* a3 = a2 + kstep; const char* b3 = b2 + kstep;
            if (last && has_next) S.a_ready(nxt);
            if constexpr (SP2) {
            PG8_LDB(B0, 0, 0); PG8_LDB(B1, 0, 1); PG8_SCHED; PG8_LDA(At, 0, 0); PG8_STAGE(PG8_SA(1, 1), a1 + hstepA, voffA);
            PG8_WAIT_V(8); PG8_WAIT_L(0); PG8_BAR; PG8_MMA(0, 0, At, B0); PG8_MMA(0, 1, At, B1); PG8_BAR; PG8_SCHED;
            PG8_LDA(At, 0, 1); PG8_STAGE(PG8_SB(0, 0), b2, voffB); PG8_STAGE(PG8_SB(0, 1), b2 + hstepB, voffB); PG8_STAGE(PG8_SA(0, 0), a2, voffA);
            PG8_WAIT_V(8); PG8_WAIT_L(0); PG8_BAR; PG8_MMA(1, 0, At, B0); PG8_MMA(1, 1, At, B1); PG8_BAR; PG8_SCHED;
            PG8_LDB(B0, 1, 0); PG8_LDB(B1, 1, 1); PG8_SCHED; PG8_LDA(At, 1, 0); PG8_STAGE(PG8_SA(0, 1), a2 + hstepA, voffA);
            PG8_WAIT_V(8); PG8_WAIT_L(0); PG8_BAR; PG8_MMA(0, 0, At, B0); PG8_MMA(0, 1, At, B1); PG8_BAR; PG8_SCHED;
            PG8_LDA(At, 1, 1); PG8_STAGE(PG8_SB(1, 0), b3, voffB); PG8_STAGE(PG8_SB(1, 1), b3 + hstepB, voffB); PG8_STAGE(PG8_SA(1, 0), a3, voffA);
            PG8_WAIT_V(8); PG8_WAIT_L(0); PG8_BAR; PG8_MMA(1, 0, At, B0); PG8_MMA(1, 1, At, B1); PG8_BAR; PG8_SCHED;
            } else {
            PG8_LDB(B0, 0, 0); PG8_SCHED; PG8_LDA(At, 0, 0); PG8_STAGE(PG8_SA(1, 1), a1 + hstepA, voffA);
            PG8_WAIT_L(8); PG8_BAR; PG8_WAIT_L(0); PG8_MMA(0, 0, At, B0); PG8_BAR; PG8_SCHED;
            PG8_LDB(B1, 0, 1); PG8_STAGE(PG8_SB(0, 0), b2, voffB);
            PG8_BAR; PG8_WAIT_L(0); PG8_MMA(0, 1, At, B1); PG8_BAR;
            PG8_LDA(At, 0, 1); PG8_STAGE(PG8_SA(0, 0), a2, voffA);
            PG8_BAR; PG8_WAIT_L(0); PG8_MMA(1, 0, At, B0); PG8_BAR; PG8_SCHED;
            PG8_STAGE(PG8_SB(0, 1), b2 + hstepB, voffB);
            PG8_WAIT_V(6); PG8_BAR; PG8_MMA(1, 1, At, B1); PG8_BAR;
            PG8_LDB(B0, 1, 0); PG8_SCHED; PG8_LDA(At, 1, 0); PG8_STAGE(PG8_SA(0, 1), a2 + hstepA, voffA);
            PG8_WAIT_L(8); PG8_BAR; PG8_WAIT_L(0); PG8_MMA(0, 0, At, B0); PG8_BAR; PG8_SCHED;
            PG8_LDB(B1, 1, 1); PG8_STAGE(PG8_SB(1, 0), b3, voffB);
            PG8_BAR; PG8_WAIT_L(0); PG8_MMA(0, 1, At, B1); PG8_BAR;
            PG8_LDA(At, 1, 1); PG8_STAGE(PG8_SA(1, 0), a3, voffA);
            PG8_BAR; PG8_WAIT_L(0); PG8_MMA(1, 0, At, B0); PG8_BAR; PG8_SCHED;
            PG8_STAGE(PG8_SB(1, 1), b3 + hstepB, voffB);
            PG8_WAIT_V(6); PG8_BAR; PG8_MMA(1, 1, At, B1); PG8_BAR;
            }
        }
        if constexpr (ALIGN_EPI) { if (wr == 0) PG8_BAR; }
        if constexpr (!Epi::AFTER_DRAIN) { E(acc, cur, wr, wc, fr, fq); S.done(cur); }
        if (!has_next) break;
#pragma unroll
        for (int a = 0; a < 2; ++a)
#pragma unroll
            for (int b = 0; b < 2; ++b)
#pragma unroll
                for (int m = 0; m < 4; ++m)
#pragma unroll
                    for (int n = 0; n < 2; ++n) acc[a][b][m][n] = (f32x4){0.f, 0.f, 0.f, 0.f};
        cur = nxt; cA = nA; cB = nB; ++ui;
        if constexpr (ALIGN_EPI) { if (wr == 1) PG8_BAR; }
    }
    PG8_WAIT_V(0);
    if constexpr (!ALIGN_EPI) { if (wr == 0) PG8_BAR; }
    PG8_BAR;
    if constexpr (Epi::AFTER_DRAIN) { E.fused(acc, cur, wr, wc, fr, fq, lds, wid, lane); S.done(cur); }
#undef PG8_SA
#undef PG8_SB
#undef PG8_STAGE
#undef PG8_LDA
#undef PG8_LDB
#undef PG8_MMA
#undef PG8_WAIT_V
#undef PG8_WAIT_L
#undef PG8_BAR
#undef PG8_SCHED
}
}

constexpr int D = 1024, NB = 2, T = 8192, CT = 256, DEPTH = 4, FF = 4096;
constexpr int ML = NB * T, MC = NB * CT, M = ML + MC;
constexpr int NADA = 6 * D;
constexpr int GDN_N = 4128, GDN_NP = 4352;
constexpr int NH = 8, HD = 128;
constexpr int NKV = CT + T;
constexpr float EPS = 1e-6f;
constexpr int NWAVES = 8, NTHR = 512;
constexpr float QSCALE = 0.125f * 1.4426950408889634f;
constexpr float LAMBDA_INIT = 0.47071302f;

constexpr size_t MiB = 1u << 20;
constexpr size_t WS_CTL = 0, CTL_ZERO_BYTES = 1 * MiB;
constexpr size_t WS_MOD = 1 * MiB;
constexpr size_t WS_CV = 1 * MiB + 512 * 1024;
constexpr size_t WS_BIAS = 9 * MiB;
constexpr size_t CTL_SS = 128 * 1024;
constexpr size_t WS_ROPE = 2 * MiB;
constexpr size_t WS_AB = 4 * MiB;
constexpr size_t WS_OFC = 7 * MiB;
constexpr size_t WS_W1T = 10 * MiB, WS_W2T = 42 * MiB, WS_GINT = 74 * MiB, WS_GOUTT = 91 * MiB, WS_SINT = 95 * MiB, WS_SOUTT = 101 * MiB, WS_DINT = 103 * MiB, WS_DOUTT = 109 * MiB;
constexpr size_t WS_X = 112 * MiB;
constexpr size_t WS_XF = 178 * MiB;
constexpr size_t WS_H = 178 * MiB;
constexpr size_t WS_Y = 211 * MiB;
constexpr size_t WS_Z = 244 * MiB;
constexpr size_t WS_HALO = 376 * MiB;
constexpr size_t WS_END = 380 * MiB;
constexpr size_t WS_PD = WS_H;

constexpr int LDS_BYTES = 159744;

#define LAS __attribute__((address_space(3)))
typedef unsigned short bf16;
typedef unsigned u32x4 __attribute__((ext_vector_type(4)));
typedef unsigned u32x2 __attribute__((ext_vector_type(2)));
typedef float f32x4 __attribute__((ext_vector_type(4)));
typedef float f32x2 __attribute__((ext_vector_type(2)));
typedef float f32x16 __attribute__((ext_vector_type(16)));
typedef short bf16x8 __attribute__((ext_vector_type(8)));
typedef short s16x4 __attribute__((ext_vector_type(4)));
#define LDS_WAIT() asm volatile("s_waitcnt lgkmcnt(0)" ::: "memory")

__device__ __forceinline__ float bf2f(unsigned u) { return __uint_as_float(u << 16); }
__device__ __forceinline__ unsigned pk2(float lo, float hi) { return pg8::cvt_pk_bf16(lo, hi); }
__device__ __forceinline__ float wave_sum(float v) {
#pragma unroll
    for (int o = 1; o < 64; o <<= 1) v += __shfl_xor(v, o);
    return v;
}
__device__ __forceinline__ float silu_f(float x) { return x / (1.f + expf(-x)); }
__device__ __forceinline__ float silu_fast(float x) { return x * __builtin_amdgcn_rcpf(1.f + __builtin_amdgcn_exp2f(-1.4426950408889634f * x)); }
__device__ __forceinline__ float exp_fast(float x) { return __builtin_amdgcn_exp2f(1.4426950408889634f * x); }
__device__ __forceinline__ int crow(int r, int hi) { return (r & 3) + 8 * (r >> 2) + 4 * hi; }

struct Args { const float* in[24]; float* out; unsigned char* ws; int step_lo, step_hi, coop, pad; };
typedef const __attribute__((address_space(4))) Args* KArgs;
__device__ __forceinline__ KArgs kargs() { const unsigned long long p = (unsigned long long)__builtin_amdgcn_kernarg_segment_ptr();
    unsigned lo = __builtin_amdgcn_readfirstlane((unsigned)p), hi = __builtin_amdgcn_readfirstlane((unsigned)(p >> 32)); asm volatile("" : "+s"(lo), "+s"(hi)); return (KArgs)(((unsigned long long)hi << 32) | lo); }
#define INP(k) (kargs()->in[k])
extern __shared__ __attribute__((aligned(16))) unsigned char lds_raw[];
struct Frame { LAS unsigned char* lds; int tid, lane, wave, G, bid; float* out; unsigned char* ws; };
__device__ __forceinline__ Frame make_frame() {
    Frame F; F.lds = (LAS unsigned char*)lds_raw; F.tid = threadIdx.x; asm volatile("" : "+v"(F.tid)); F.lane = F.tid & 63; F.wave = __builtin_amdgcn_readfirstlane(F.tid >> 6); F.G = gridDim.x; F.bid = blockIdx.x; asm volatile("" : "+s"(F.G), "+s"(F.bid));
    KArgs a = kargs(); F.out = a->out; F.ws = a->ws; return F;
}
enum { I_X = 0, I_C, I_CTX, I_CCTX, I_N1G, I_N2G, I_ADAW, I_ADAB, I_W1, I_W2, I_GIN, I_GCONV, I_GALOG, I_GDT, I_GNG, I_GOUT, I_SIN, I_SCONV, I_SOUT, I_DIN, I_DLAM, I_DNG, I_DOUT, I_FG };

__device__ __forceinline__ void transpose_item(const float* W, int K, int ldw, bf16* WT, LAS float* scr, int item, int nblk, int lane) {
    const int kb = item / nblk, nb = item % nblk, k0 = 64 * kb, n0 = 32 * nb;
#pragma unroll 8
    for (int i = 0; i < 32; ++i) { const int kk = 2 * i + (lane >> 5); scr[kk * 33 + (lane & 31)] = W[(size_t)(k0 + kk) * ldw + n0 + (lane & 31)]; }
    LDS_WAIT(); asm volatile("" ::: "memory");
    const int c = lane & 7;
#pragma unroll
    for (int j = 0; j < 4; ++j) { const int n = (lane >> 3) + 8 * j; const LAS float* s = scr + (8 * c) * 33 + n;
        u32x4 o; o.x = pk2(s[0 * 33], s[1 * 33]); o.y = pk2(s[2 * 33], s[3 * 33]); o.z = pk2(s[4 * 33], s[5 * 33]); o.w = pk2(s[6 * 33], s[7 * 33]);
        *(u32x4*)(WT + (size_t)(n0 + n) * K + k0 + 8 * c) = o; }
    LDS_WAIT(); asm volatile("" ::: "memory");
}
__device__ __forceinline__ void get_mat(unsigned char* ws_, int idx, const float*& src, bf16*& dst, int& K, int& N, int& ld) {
    unsigned char* ws = ws_;
    if (idx < 4)       { src = INP(I_W1) + (size_t)idx * D * FF; dst = (bf16*)(ws + WS_W1T) + (size_t)idx * D * FF; K = D; N = FF; ld = FF; }
    else if (idx < 8)  { const int i = idx - 4; src = INP(I_W2) + (size_t)i * D * FF; dst = (bf16*)(ws + WS_W2T) + (size_t)i * D * FF; K = FF; N = D; ld = D; }
    else if (idx < 10) { const int j = idx - 8; src = INP(I_GIN) + (size_t)j * D * GDN_N; dst = (bf16*)(ws + WS_GINT) + (size_t)j * GDN_NP * D; K = D; N = GDN_N; ld = GDN_N; }
    else if (idx < 12) { const int j = idx - 10; src = INP(I_GOUT) + (size_t)j * D * D; dst = (bf16*)(ws + WS_GOUTT) + (size_t)j * D * D; K = D; N = D; ld = D; }
    else if (idx == 12) { src = INP(I_SIN); dst = (bf16*)(ws + WS_SINT); K = D; N = 3 * D; ld = 3 * D; }
    else if (idx == 13) { src = INP(I_SOUT); dst = (bf16*)(ws + WS_SOUTT); K = D; N = D; ld = D; }
    else if (idx == 14) { src = INP(I_DIN); dst = (bf16*)(ws + WS_DINT); K = D; N = 3 * D; ld = 3 * D; }
    else { src = INP(I_DOUT); dst = (bf16*)(ws + WS_DOUTT); K = D; N = D; ld = D; }
}
__device__ __forceinline__ void convert_weights(unsigned char* ws, unsigned mask, int gw, int NGW, int gt, int NGT, LAS unsigned char* lds, int wave, int lane) {
    LAS float* scr = (LAS float*)(lds + wave * 16384);
    for (int mi = 0; mi < 16; ++mi) {
        if (!((mask >> mi) & 1u)) continue;
        const float* src; bf16* dst; int K, N, ld; get_mat(ws, mi, src, dst, K, N, ld);
        const int nblk = N / 32, nitems = (K / 64) * nblk;
        for (int it = gw; it < nitems; it += NGW) transpose_item(src, K, ld, dst, scr, it, nblk, lane);
        if (mi == 8 || mi == 9) { u32x4* z = (u32x4*)((bf16*)(ws + WS_GINT) + (size_t)(mi - 8) * GDN_NP * D + (size_t)GDN_N * D);
            for (int i = gt; i < (GDN_NP - GDN_N) * D / 8; i += NGT) z[i] = (u32x4){0u, 0u, 0u, 0u}; }
    }
}
__device__ __forceinline__ void step_prologue() {
    const Frame F = make_frame();
    const int gw = F.bid * NWAVES + F.wave, NGW = F.G * NWAVES;
    const int gt = F.bid * NTHR + F.tid, NGT = F.G * NTHR;
    convert_weights(F.ws, (1u << 8) | (1u << 10), gw, NGW, gt, NGT, F.lds, F.wave, F.lane);
    __syncthreads();
    {
        LAS float* sv = (LAS float*)F.lds;
        LAS float* red = sv + 3 * D;
        for (int i = F.tid; i < 3 * D; i += NTHR) { const int g = i / D, k = i % D; const float c = g < 2 ? INP(I_C)[g * D + k] : INP(I_CCTX)[k]; sv[i] = silu_f(c); }
        __syncthreads();
        float* MOD = (float*)(F.ws + WS_MOD);
        const int c = F.tid & 63, ks = F.tid >> 6;
        for (int it = F.bid; it < DEPTH * (NADA / 64); it += F.G) {
            const int li = it / (NADA / 64), n0 = (it % (NADA / 64)) * 64;
            const float* w = INP(I_ADAW) + (size_t)li * D * NADA + (size_t)(ks * 128) * NADA + n0 + c;
            float a0 = 0.f, a1 = 0.f, a2 = 0.f;
#pragma unroll 16
            for (int k = 0; k < 128; ++k) { const float wv = w[(size_t)k * NADA]; const int kk = ks * 128 + k; a0 += sv[kk] * wv; a1 += sv[D + kk] * wv; a2 += sv[2 * D + kk] * wv; }
            red[(ks * 3 + 0) * 64 + c] = a0; red[(ks * 3 + 1) * 64 + c] = a1; red[(ks * 3 + 2) * 64 + c] = a2;
            __syncthreads();
            if (F.tid < 192) { const int g = F.tid >> 6; float s = INP(I_ADAB)[li * NADA + n0 + c];
#pragma unroll
                for (int q = 0; q < 8; ++q) s += red[(q * 3 + g) * 64 + c];
                MOD[((size_t)li * 3 + g) * NADA + n0 + c] = s; }
            __syncthreads();
        }
    }
    {
        f32x2* R = (f32x2*)(F.ws + WS_ROPE);
        for (int i = gt; i < T * 32; i += NGT) { const int t = i >> 5, p = i & 31, f = p & 15;
            const float inv = powf(10000.0f, -(float)f / 16.0f); const float pos = (float)(p < 16 ? (t >> 6) : (t & 63)); const float ang = pos * inv;
            R[i] = (f32x2){cosf(ang), sinf(ang)}; }
    }
}

__device__ __forceinline__ void step_norm(int layer, int which, int nrows, bool from_inputs) {
    const Frame F = make_frame();
    const int gw = F.bid * NWAVES + F.wave, NGW = F.G * NWAVES;
    const float* X = (const float*)(F.ws + WS_X); bf16* H = (bf16*)(F.ws + WS_H);
    const float* ng = (which ? INP(I_N2G) : INP(I_N1G)) + layer * D;
    const float* MOD = (const float*)(F.ws + WS_MOD) + (size_t)layer * 3 * NADA + which * 3 * D;
    for (int row = gw; row < nrows; row += NGW) {
        const int grp = row < T ? 0 : (row < ML ? 1 : 2);
        const float* xrow = from_inputs ? (row < ML ? INP(I_X) + (size_t)row * D : INP(I_CTX) + (size_t)(row - ML) * D) : X + (size_t)row * D;
        const f32x4* xr = (const f32x4*)xrow + F.lane;
        const f32x4* sh = (const f32x4*)(MOD + (size_t)grp * NADA) + F.lane; const f32x4* sc = (const f32x4*)(MOD + (size_t)grp * NADA + D) + F.lane; const f32x4* gg = (const f32x4*)ng + F.lane;
        f32x4 v[4]; float s = 0.f;
#pragma unroll
        for (int j = 0; j < 4; ++j) { v[j] = xr[64 * j]; s += (v[j].x * v[j].x + v[j].y * v[j].y) + (v[j].z * v[j].z + v[j].w * v[j].w); }
        const float rstd = 1.0f / sqrtf(wave_sum(s) * (1.f / D) + EPS);
        u32x2* o = (u32x2*)(H + (size_t)row * D) + F.lane;
#pragma unroll
        for (int j = 0; j < 4; ++j) { const f32x4 g4 = gg[64 * j], s4 = sc[64 * j], h4 = sh[64 * j]; const f32x4 y = (v[j] * rstd) * g4; const f32x4 h = y * (1.0f + s4) + h4;
            o[64 * j] = (u32x2){pk2(h.x, h.y), pk2(h.z, h.w)}; }
    }
}
__device__ __forceinline__ void step_norm0() {
    const Frame F = make_frame();
    const int gw = F.bid * NWAVES + F.wave, NGW = F.G * NWAVES, gt = F.bid * NTHR + F.tid, NGT = F.G * NTHR;
    bf16* H = (bf16*)(F.ws + WS_H); float* SS = (float*)(F.ws + WS_CTL + CTL_SS); const float* MOD = (const float*)(F.ws + WS_MOD);
    const bool split = F.G > 130; const int R1 = split ? 7680 : M;
    const float* ng = INP(I_N1G);
    auto do_row = [&](int row) {
        const int grp = row < T ? 0 : (row < ML ? 1 : 2);
        const float* xrow = row < ML ? INP(I_X) + (size_t)row * D : INP(I_CTX) + (size_t)(row - ML) * D;
        const f32x4* xr = (const f32x4*)xrow + F.lane; const f32x4* sc = (const f32x4*)(MOD + (size_t)grp * NADA + D) + F.lane; const f32x4* gg = (const f32x4*)ng + F.lane;
        f32x4 v[4]; float s = 0.f;
#pragma unroll
        for (int j = 0; j < 4; ++j) { v[j] = xr[64 * j]; s += (v[j].x * v[j].x + v[j].y * v[j].y) + (v[j].z * v[j].z + v[j].w * v[j].w); }
        s = wave_sum(s); if (F.lane == 0) ((unsigned*)SS)[row] = pg8::ss_enc(s);
        u32x2* o = (u32x2*)(H + (size_t)row * D) + F.lane;
#pragma unroll
        for (int j = 0; j < 4; ++j) { const f32x4 h = v[j] * (gg[64 * j] * (1.0f + sc[64 * j])); o[64 * j] = (u32x2){pk2(h.x, h.y), pk2(h.z, h.w)}; }
    };
    for (int row = gw; row < R1; row += NGW) do_row(row);
    if (split && F.bid >= 65) for (int row = R1 + gw - 65 * NWAVES; row < M; row += (F.G - 65) * NWAVES) do_row(row);
    { float* CV = (float*)(F.ws + WS_CV);
      for (int idx = gt; idx < DEPTH * 2 * 3 * D; idx += NGT) { const int col = idx & (D - 1), grp = (idx >> 10) % 3, which = (idx / (3 * D)) & 1, li = idx / (6 * D);
        const float g = (which ? INP(I_N2G) : INP(I_N1G))[li * D + col]; CV[idx] = g * (1.0f + MOD[((size_t)li * 3 + grp) * NADA + which * 3 * D + D + col]); } }
}
__device__ __forceinline__ void step_bias(int it_lo, int it_hi, int first_block) {
    const Frame F = make_frame();
    if (F.bid < first_block) return;
    __syncthreads();
    const float* MOD = (const float*)(F.ws + WS_MOD);
    LAS float* red = (LAS float*)F.lds;
    float* BIAS = (float*)(F.ws + WS_BIAS);
    const int c = F.tid & 63, ks = F.tid >> 6;
    constexpr int NB_IN = 65, NB_UP = 64;
    for (int it = it_lo + F.bid - first_block; it < it_hi; it += F.G - first_block) {
        const int li = it / (NB_IN + NB_UP), rr = it % (NB_IN + NB_UP); const bool up = rr >= NB_IN; const int n0 = (up ? rr - NB_IN : rr) * 64; const int kind = li % 3, jj = li / 3;
        const float* W; int ld, nv;
        if (up) { W = INP(I_W1) + (size_t)li * D * FF; ld = FF; nv = FF; }
        else if (kind == 0) { W = INP(I_GIN) + (size_t)jj * D * GDN_N; ld = GDN_N; nv = GDN_N; }
        else if (kind == 1) { W = INP(I_SIN); ld = 3 * D; nv = 3 * D; }
        else { W = INP(I_DIN); ld = 3 * D; nv = 3 * D; }
        const int n = n0 + c; const bool valid = n < nv;
        const float* sh = MOD + (size_t)li * 3 * NADA + (up ? 3 * D : 0);
        float a0 = 0.f, a1 = 0.f, a2 = 0.f;
        if (n0 < nv) {
#pragma unroll 16
            for (int k = 0; k < 128; ++k) { const int kk = ks * 128 + k; const float wv = valid ? W[(size_t)kk * ld + n] : 0.f; a0 += sh[kk] * wv; a1 += sh[NADA + kk] * wv; a2 += sh[2 * NADA + kk] * wv; } }
        red[(ks * 3 + 0) * 64 + c] = a0; red[(ks * 3 + 1) * 64 + c] = a1; red[(ks * 3 + 2) * 64 + c] = a2;
        __syncthreads();
        if (F.tid < 192 && valid) { const int g = F.tid >> 6; float s = 0.f;
#pragma unroll
            for (int q = 0; q < 8; ++q) s += red[(q * 3 + g) * 64 + c];
            BIAS[up ? (size_t)DEPTH * 3 * 4352 + ((size_t)li * 3 + g) * FF + n : ((size_t)li * 3 + g) * 4352 + n] = s; }
        __syncthreads();
    }
}
__device__ __forceinline__ void step_final() {
    const Frame F = make_frame();
    const int gw = F.bid * NWAVES + F.wave, NGW = F.G * NWAVES;
    const bf16* X = (const bf16*)(F.ws + WS_X);
    for (int row = gw; row < ML; row += NGW) {
        const u32x4* xr = (const u32x4*)(X + (size_t)row * D) + F.lane; const f32x4* gg = (const f32x4*)INP(I_FG) + 2 * F.lane;
        f32x4 v[4]; float s = 0.f;
#pragma unroll
        for (int j = 0; j < 2; ++j) { const u32x4 w = xr[64 * j];
            v[2 * j] = (f32x4){bf2f(w.x & 0xffffu), bf2f(w.x >> 16), bf2f(w.y & 0xffffu), bf2f(w.y >> 16)}; v[2 * j + 1] = (f32x4){bf2f(w.z & 0xffffu), bf2f(w.z >> 16), bf2f(w.w & 0xffffu), bf2f(w.w >> 16)};
            s += ((v[2 * j].x * v[2 * j].x + v[2 * j].y * v[2 * j].y) + (v[2 * j].z * v[2 * j].z + v[2 * j].w * v[2 * j].w)) + ((v[2 * j + 1].x * v[2 * j + 1].x + v[2 * j + 1].y * v[2 * j + 1].y) + (v[2 * j + 1].z * v[2 * j + 1].z + v[2 * j + 1].w * v[2 * j + 1].w)); }
        const float rstd = 1.0f / sqrtf(wave_sum(s) * (1.f / D) + EPS);
        f32x4* o = (f32x4*)(F.out + (size_t)row * D) + 2 * F.lane;
#pragma unroll
        for (int j = 0; j < 2; ++j) { o[128 * j] = (v[2 * j] * rstd) * gg[128 * j]; o[128 * j + 1] = (v[2 * j + 1] * rstd) * gg[128 * j + 1]; }
    }
}

__device__ __forceinline__ void step_gdn_scan(int j) {
    const Frame F = make_frame();
    LAS float* qs = (LAS float*)F.lds;
    LAS float* ks = qs + 64 * 128;
    LAS float* vs = ks + 64 * 128;
    LAS float* ga = vs + 64 * 128;
    LAS float* be = ga + 64;
    const bf16* Z = (const bf16*)(F.ws + WS_Z);
    const float* AB = (const float*)(F.ws + WS_AB);
    const float* cw = INP(I_GCONV) + (size_t)j * 3 * 3072;
    float* OFC = (float*)(F.ws + WS_OFC);
    for (int it = F.bid; it < 32; it += F.G) {
        const int b = it >> 4, h = (it >> 1) & 7, dir = it & 1;
        const float Aco = expf(INP(I_GALOG)[j * 16 + dir * 8 + h]); const float dtb = INP(I_GDT)[j * 16 + dir * 8 + h];
        float S[64];
#pragma unroll
        for (int i = 0; i < 64; ++i) S[i] = 0.f;
        const int jcol = F.tid >> 1, half = F.tid & 1;
        for (int n = 0; n < 132; ++n) {
            const bool isctx = n < 4; const int L = isctx ? CT : T; const int p0 = isctx ? 64 * n : 64 * (n - 4); const int rbase = isctx ? ML + b * CT : b * T;
            for (int idx = F.tid; idx < 64 * 384; idx += NTHR) {
                const int c = idx / 384, ch = idx % 384, part = ch >> 7, e = ch & 127;
                const int p = p0 + c; const int t = dir ? (L - 1 - p) : p; const int col = part * 1024 + h * 128 + e;
                float acc = 0.f;
#pragma unroll
                for (int tap = 0; tap < 3; ++tap) { const int tt = t + tap - 1; if (tt >= 0 && tt < L) acc += cw[tap * 3072 + col] * bf2f(Z[(size_t)(rbase + tt) * 4096 + col]); }
                acc = silu_f(acc);
                LAS float* dst = part == 0 ? qs : (part == 1 ? ks : vs); dst[c * 128 + e] = acc;
            }
            if (F.tid < 64) { const int p = p0 + F.tid; const int t = dir ? (L - 1 - p) : p; const size_t row = (size_t)(rbase + t);
                const float av = AB[row * 32 + dir * 8 + h], bv = AB[row * 32 + 16 + dir * 8 + h];
                const float x = av + dtb; const float sp = x > 20.f ? x : log1pf(expf(x));
                ga[F.tid] = expf(-Aco * sp); be[F.tid] = 1.f / (1.f + expf(-bv)); }
            __syncthreads();
#pragma unroll 1
            for (int rr = 0; rr < 8; ++rr) { const int c = F.wave * 8 + rr;
                const float q0 = qs[c * 128 + F.lane], q1 = qs[c * 128 + 64 + F.lane]; const float sq = 0.08838834764831845f / sqrtf(wave_sum(q0 * q0 + q1 * q1) + EPS);
                qs[c * 128 + F.lane] = q0 * sq; qs[c * 128 + 64 + F.lane] = q1 * sq;
                const float k0 = ks[c * 128 + F.lane], k1 = ks[c * 128 + 64 + F.lane]; const float sk = 1.0f / sqrtf(wave_sum(k0 * k0 + k1 * k1) + EPS);
                ks[c * 128 + F.lane] = k0 * sk; ks[c * 128 + 64 + F.lane] = k1 * sk; }
            __syncthreads();
            if (F.tid < 256) {
#pragma unroll 1
                for (int c = 0; c < 64; ++c) {
                    const float a = ga[c], bt = be[c];
                    const LAS f32x4* k4 = (const LAS f32x4*)(ks + c * 128 + 64 * half); const LAS f32x4* q4 = (const LAS f32x4*)(qs + c * 128 + 64 * half);
                    float dot = 0.f;
#pragma unroll
                    for (int i = 0; i < 16; ++i) { const f32x4 kv = k4[i]; dot += kv.x * S[4 * i] + kv.y * S[4 * i + 1] + kv.z * S[4 * i + 2] + kv.w * S[4 * i + 3]; }
                    dot += __shfl_xor(dot, 1);
                    const float tmp = bt * (vs[c * 128 + jcol] - a * dot);
                    float o = 0.f;
#pragma unroll
                    for (int i = 0; i < 16; ++i) { const f32x4 kv = k4[i]; const f32x4 qv = q4[i];
                        S[4 * i] = a * S[4 * i] + kv.x * tmp; S[4 * i + 1] = a * S[4 * i + 1] + kv.y * tmp; S[4 * i + 2] = a * S[4 * i + 2] + kv.z * tmp; S[4 * i + 3] = a * S[4 * i + 3] + kv.w * tmp;
                        o += qv.x * S[4 * i] + qv.y * S[4 * i + 1] + qv.z * S[4 * i + 2] + qv.w * S[4 * i + 3]; }
                    o += __shfl_xor(o, 1);
                    const int p = p0 + c; const int t = dir ? (L - 1 - p) : p;
                    float* dst = isctx ? OFC + (size_t)(b * CT + t) * D : F.out + (size_t)(b * T + t) * D;
                    if (half == 0) atomicAdd(dst + h * 128 + jcol, o);
                }
            }
            __syncthreads();
        }
    }
}
__device__ __forceinline__ void step_gdn_norm(int j) {
    const Frame F = make_frame();
    const int gw = F.bid * NWAVES + F.wave, NGW = F.G * NWAVES;
    const bf16* Z = (const bf16*)(F.ws + WS_Z); bf16* Y = (bf16*)(F.ws + WS_Y); const float* ng = INP(I_GNG) + j * 128;
    for (int row = gw; row < M; row += NGW) {
        const float* src = row < ML ? F.out + (size_t)row * D : (const float*)(F.ws + WS_OFC) + (size_t)(row - ML) * D;
        const f32x4* s4 = (const f32x4*)(src + 16 * F.lane);
        float v[16]; float ss = 0.f;
#pragma unroll
        for (int q = 0; q < 4; ++q) { const f32x4 x = s4[q]; v[4 * q] = x.x; v[4 * q + 1] = x.y; v[4 * q + 2] = x.z; v[4 * q + 3] = x.w; ss += (x.x * x.x + x.y * x.y) + (x.z * x.z + x.w * x.w); }
        ss += __shfl_xor(ss, 1); ss += __shfl_xor(ss, 2); ss += __shfl_xor(ss, 4);
        const float rstd = 1.0f / sqrtf(ss * (1.f / 128.f) + EPS);
        const u32x4* g4 = (const u32x4*)(Z + (size_t)row * 4096 + 3072 + 16 * F.lane);
        const int e0 = (16 * F.lane) & 127;
        u32x4 o[2];
#pragma unroll
        for (int q = 0; q < 2; ++q) { const u32x4 gz = g4[q]; unsigned w[4];
#pragma unroll
            for (int i = 0; i < 4; ++i) { const unsigned gg = gz[i]; const float g0 = bf2f(gg & 0xffffu), g1 = bf2f(gg >> 16); const int e = e0 + 8 * q + 2 * i;
                w[i] = pk2(v[8 * q + 2 * i] * rstd * ng[e] * silu_f(g0), v[8 * q + 2 * i + 1] * rstd * ng[e + 1] * silu_f(g1)); }
            o[q] = (u32x4){w[0], w[1], w[2], w[3]}; }
        u32x4* dst = (u32x4*)(Y + (size_t)row * D + 16 * F.lane); dst[0] = o[0]; dst[1] = o[1];
    }
}

__device__ __forceinline__ void step_sconv() {
    const Frame F = make_frame();
    const int gt = F.bid * NTHR + F.tid, NGT = F.G * NTHR;
    const bf16* Z = (const bf16*)(F.ws + WS_Z); bf16* Y = (bf16*)(F.ws + WS_Y); const float* cw = INP(I_SCONV);
    for (int idx = gt; idx < M * 128; idx += NGT) {
        const int row = idx >> 7, c0 = (idx & 127) * 8;
        int t, L, rbase; if (row < ML) { t = row & (T - 1); L = T; rbase = row - t; } else { const int r2 = row - ML; t = r2 & (CT - 1); L = CT; rbase = row - t; }
        float acc[8];
#pragma unroll
        for (int i = 0; i < 8; ++i) acc[i] = 0.f;
#pragma unroll
        for (int tap = 0; tap < 3; ++tap) { const int tt = t + tap - 1;
            if (tt >= 0 && tt < L) { const bf16* zr = Z + (size_t)(rbase + tt) * 3072; const u32x4 cg = *(const u32x4*)(zr + 1024 + c0), hv = *(const u32x4*)(zr + 2048 + c0);
                const f32x4 w0 = *(const f32x4*)(cw + tap * 1024 + c0), w1 = *(const f32x4*)(cw + tap * 1024 + c0 + 4); const float w[8] = {w0.x, w0.y, w0.z, w0.w, w1.x, w1.y, w1.z, w1.w};
#pragma unroll
                for (int i = 0; i < 4; ++i) { acc[2 * i] += w[2 * i] * bf2f(cg[i] & 0xffffu) * bf2f(hv[i] & 0xffffu); acc[2 * i + 1] += w[2 * i + 1] * bf2f(cg[i] >> 16) * bf2f(hv[i] >> 16); } } }
        const u32x4 bg = *(const u32x4*)(Z + (size_t)row * 3072 + c0); u32x4 o;
#pragma unroll
        for (int i = 0; i < 4; ++i) o[i] = pk2(bf2f(bg[i] & 0xffffu) * acc[2 * i], bf2f(bg[i] >> 16) * acc[2 * i + 1]);
        *(u32x4*)(Y + (size_t)row * D + c0) = o;
    }
}

__device__ __forceinline__ void step_rope() {
    const Frame F = make_frame();
    const int gw = F.bid * NWAVES + F.wave, NGW = F.G * NWAVES;
    bf16* Z = (bf16*)(F.ws + WS_Z); const f32x4* R = (const f32x4*)(F.ws + WS_ROPE);
    for (int row = gw; row < M; row += NGW) {
        u32x4* p = (u32x4*)(Z + (size_t)row * 3072 + 32 * F.lane);
        u32x4 v[4];
#pragma unroll
        for (int q = 0; q < 4; ++q) v[q] = p[q];
        const bool lat = row < ML; const float sc = F.lane < 32 ? QSCALE : 1.0f;
        const f32x4* tab = R + ((size_t)(row & (T - 1)) * 32 + 16 * (F.lane & 1)) / 2;
#pragma unroll
        for (int q = 0; q < 4; ++q) {
#pragma unroll
            for (int i = 0; i < 4; i += 2) {
                f32x4 cs = (f32x4){1.f, 0.f, 1.f, 0.f}; if (lat) cs = tab[(4 * q + i) / 2];
                { const unsigned w = v[q][i]; const float x0 = bf2f(w & 0xffffu), x1 = bf2f(w >> 16); v[q][i] = pk2((x0 * cs.x - x1 * cs.y) * sc, (x0 * cs.y + x1 * cs.x) * sc); }
                { const unsigned w = v[q][i + 1]; const float x0 = bf2f(w & 0xffffu), x1 = bf2f(w >> 16); v[q][i + 1] = pk2((x0 * cs.z - x1 * cs.w) * sc, (x0 * cs.w + x1 * cs.z) * sc); }
            }
        }
#pragma unroll
        for (int q = 0; q < 4; ++q) p[q] = v[q];
    }
    bf16* Vt = (bf16*)(F.ws + WS_H);
    LAS bf16* tl = (LAS bf16*)(F.lds + F.wave * 18432);
    for (int it = gw; it < NB * NH * (NKV / 64); it += NGW) {
        const int kt = it % (NKV / 64), bh = it / (NKV / 64), b = bh >> 3, h = bh & 7; const int kv0 = 64 * kt;
        const int srow = kv0 < CT ? ML + b * CT + kv0 : b * T + kv0 - CT;
#pragma unroll 4
        for (int i = 0; i < 16; ++i) { const int r = 4 * i + (F.lane >> 4), cc = (F.lane & 15) * 8;
            const u32x4 v = *(const u32x4*)(Z + (size_t)(srow + r) * 3072 + 2048 + h * 128 + cc);
#pragma unroll
            for (int q = 0; q < 4; ++q) { tl[(cc + 2 * q) * 72 + r] = (bf16)(v[q] & 0xffffu); tl[(cc + 2 * q + 1) * 72 + r] = (bf16)(v[q] >> 16); } }
        LDS_WAIT(); asm volatile("" ::: "memory");
#pragma unroll 4
        for (int i = 0; i < 16; ++i) { const int e = 8 * i + (F.lane >> 3), ch = F.lane & 7;
            const u32x4 v = *(const LAS u32x4*)(tl + e * 72 + ch * 8);
            *(u32x4*)(Vt + ((size_t)(bh * 128 + e)) * NKV + kv0 + ch * 8) = v; }
        LDS_WAIT(); asm volatile("" ::: "memory");
    }
}
__device__ __forceinline__ void step_attn() {
    const Frame F = make_frame();
    const bf16* Z = (const bf16*)(F.ws + WS_Z); const bf16* Vt = (const bf16*)(F.ws + WS_H); bf16* Y = (bf16*)(F.ws + WS_Y);
    LAS float* EX = (LAS float*)F.lds;
    const int r = F.lane & 31, hi = F.lane >> 5, qs = F.wave & 3, m = F.wave >> 2;
    float lmb;
    { const float* lam = INP(I_DLAM); const float t1 = lam[F.lane] * lam[64 + F.lane], t2 = lam[128 + F.lane] * lam[192 + F.lane]; lmb = expf(wave_sum(t1)) - expf(wave_sum(t2)) + LAMBDA_INIT; }
    const float* ng = INP(I_DNG);
    for (int u = F.bid; u < 1056; u += F.G) {
        int b, h, qrow0, nk;
        if (u < 1024) { b = u >> 9; h = (u >> 6) & 7; qrow0 = b * T + (u & 63) * 128; nk = NKV / 32; }
        else { const int v = u - 1024; b = v >> 4; h = (v >> 1) & 7; qrow0 = ML + b * CT + (v & 1) * 128; nk = CT / 32; }
        const int row0 = qrow0 + 32 * qs;
        bf16x8 qf[4];
#pragma unroll
        for (int d0 = 0; d0 < 4; ++d0) qf[d0] = *(const bf16x8*)(Z + (size_t)(row0 + r) * 3072 + h * 128 + m * 64 + d0 * 16 + hi * 8);
        const int kcol = 1024 + h * 128 + m * 64 + hi * 8;
        const bf16* vtb = Vt + (size_t)((b * 8 + h) * 128 + r) * NKV + 4 * hi;
        f32x16 o[4];
#pragma unroll
        for (int i = 0; i < 4; ++i)
#pragma unroll
            for (int q = 0; q < 16; ++q) o[i][q] = 0.f;
        float mref = 0.f, l = 0.f;
        for (int s = 0; s < nk; ++s) {
            const int kv0 = 32 * s; const int krow = kv0 < CT ? ML + b * CT + kv0 : b * T + kv0 - CT;
            const bf16* kp = Z + (size_t)(krow + r) * 3072 + kcol;
            bf16x8 kf[4];
#pragma unroll
            for (int d0 = 0; d0 < 4; ++d0) kf[d0] = *(const bf16x8*)(kp + d0 * 16);
            bf16x8 vf[4][2];
#pragma unroll
            for (int i = 0; i < 4; ++i)
#pragma unroll
                for (int s2 = 0; s2 < 2; ++s2) { const bf16* vp = vtb + (size_t)(32 * i) * NKV + kv0 + 16 * s2; const s16x4 lo = *(const s16x4*)vp, h8 = *(const s16x4*)(vp + 8);
                    vf[i][s2] = (bf16x8){lo[0], lo[1], lo[2], lo[3], h8[0], h8[1], h8[2], h8[3]}; }
            f32x16 S;
#pragma unroll
            for (int q = 0; q < 16; ++q) S[q] = 0.f;
#pragma unroll
            for (int d0 = 0; d0 < 4; ++d0) S = __builtin_amdgcn_mfma_f32_32x32x16_bf16(kf[d0], qf[d0], S, 0, 0, 0);
            float mx = S[0];
#pragma unroll
            for (int q = 1; q < 16; ++q) mx = fmaxf(mx, S[q]);
            mx = fmaxf(mx, __shfl_xor(mx, 32));
            if (s == 0) mref = mx;
            else if (__any(mx > mref)) { const float mn = fmaxf(mref, mx); const float al = __builtin_amdgcn_exp2f(mref - mn); l *= al; mref = mn;
#pragma unroll
                for (int i = 0; i < 4; ++i)
#pragma unroll
                    for (int q = 0; q < 16; ++q) o[i][q] *= al; }
            float ps = 0.f;
#pragma unroll
            for (int q = 0; q < 16; ++q) { S[q] = __builtin_amdgcn_exp2f(S[q] - mref); ps += S[q]; }
            l += ps;
            bf16x8 pf[2];
#pragma unroll
            for (int s2 = 0; s2 < 2; ++s2) { u32x4 w; w.x = pk2(S[8 * s2], S[8 * s2 + 1]); w.y = pk2(S[8 * s2 + 2], S[8 * s2 + 3]); w.z = pk2(S[8 * s2 + 4], S[8 * s2 + 5]); w.w = pk2(S[8 * s2 + 6], S[8 * s2 + 7]); pf[s2] = __builtin_bit_cast(bf16x8, w); }
#pragma unroll
            for (int i = 0; i < 4; ++i)
#pragma unroll
                for (int s2 = 0; s2 < 2; ++s2) o[i] = __builtin_amdgcn_mfma_f32_32x32x16_bf16(vf[i][s2], pf[s2], o[i], 0, 0, 0);
        }
        l += __shfl_xor(l, 32);
        const float f = (m == 1 ? lmb : 1.0f) / l;
        LAS float* ex = EX + (size_t)m * 128 * 129 + (qs * 32 + r) * 129;
#pragma unroll
        for (int i = 0; i < 4; ++i)
#pragma unroll
            for (int q = 0; q < 16; ++q) ex[32 * i + crow(q, hi)] = o[i][q] * f;
        __syncthreads();
#pragma unroll 1
        for (int rr = 0; rr < 16; ++rr) { const int row = 16 * F.wave + rr;
            const float a0 = EX[row * 129 + F.lane] - EX[128 * 129 + row * 129 + F.lane], a1 = EX[row * 129 + 64 + F.lane] - EX[128 * 129 + row * 129 + 64 + F.lane];
            const float rstd = (1.0f - LAMBDA_INIT) / sqrtf(wave_sum(a0 * a0 + a1 * a1) * (1.f / 128.f) + EPS);
            bf16* yr = Y + (size_t)(qrow0 + row) * D + h * 128;
            yr[F.lane] = (bf16)(pk2(a0 * rstd * ng[F.lane], 0.f) & 0xffffu); yr[64 + F.lane] = (bf16)(pk2(a1 * rstd * ng[64 + F.lane], 0.f) & 0xffffu); }
        __syncthreads();
    }
}

#define PACK8(x, b) __builtin_bit_cast(bf16x8, (u32x4){pk2((x)[(b)], (x)[(b) + 1]), pk2((x)[(b) + 2], (x)[(b) + 3]), pk2((x)[(b) + 4], (x)[(b) + 5]), pk2((x)[(b) + 6], (x)[(b) + 7])})
#define MFMA32(a, b, c) __builtin_amdgcn_mfma_f32_32x32x16_bf16((a), (b), (c), 0, 0, 0)
#if defined(SCAN_PROF) || defined(PREP_PROF)
__device__ unsigned long long g_scanprof = 0ull;
#endif
constexpr int PD_BYTES = 12800, PD_ATT = 6144, PD_EG = 12288, PD_EW = 12544;
__device__ __forceinline__ unsigned off_a(unsigned row, unsigned ch) { return 2048u * (row >> 3) + 512u * (ch >> 2) + 64u * (row & 7) + 16u * ((ch & 3) ^ ((row >> 2) & 3)); }
__device__ __forceinline__ int frag_off(int c, int s) {
    const int slot = (c >> 5) == (s >> 5) ? ((c >> 5) ? 2 : 0) : 1, s2 = (s & 31) >> 4, hh = ((s & 15) >> 2) & 1, jj = ((s & 15) >> 3) * 4 + (s & 3), r = c & 31;
    return slot * 2048 + s2 * 1024 + (hh * 32 + r) * 16 + jj * 2;
}
__device__ __forceinline__ void step_gdn_prep(int j, bool overlap, unsigned* flags, bool dry = false, int skip = 0) {
    const Frame F = make_frame();
    LAS float* STG = (LAS float*)F.lds;
    LAS float* KK = (LAS float*)F.lds;
    LAS float* QK = KK + 64 * 68;
    LAS float* LP = (LAS float*)(F.lds + 34816);
    LAS float* TS = (LAS float*)(F.lds + 67584);
    LAS unsigned char* QI = F.lds + 102400; LAS unsigned char* KI = F.lds + 118784;
    LAS float* SM = (LAS float*)(F.lds + 135168);
    LAS unsigned char* VI = F.lds + 136704;
    const __amdgpu_buffer_rsrc_t zrs = __builtin_amdgcn_make_buffer_rsrc((void*)(F.ws + WS_Z), (short)0, (int)((size_t)M * 4096 * 2), 0x00020000);
    const __amdgpu_buffer_rsrc_t prs = __builtin_amdgcn_make_buffer_rsrc((void*)(F.ws + WS_PD), (short)0, (int)((size_t)2 * 16 * 132 * PD_BYTES), 0x00020000);
#define ST16(rs, boff, val) __builtin_amdgcn_raw_buffer_store_b128(__builtin_bit_cast(u32x4, (val)), (rs), (int)(boff), 0, 16)
    bf16* Z = (bf16*)(F.ws + WS_Z); const float* AB = (const float*)(F.ws + WS_AB); const bf16* HALO = (const bf16*)(F.ws + WS_HALO); unsigned char* PD = F.ws + WS_PD;
    const float* cw = INP(I_GCONV) + (size_t)j * 3 * 3072;
    const int r = F.lane & 31, hi = F.lane >> 5;
#ifdef PREP_PROF
    unsigned long long pprof = 0ull, plast = 0ull;
#endif
    const int first = overlap ? 32 : 0;
    int pub = -1;
    for (int it = F.bid - first; it >= 0 && it < NB * NH * 132; it += F.G - first) {
        int n, bh;
        if (overlap) { bh = it & 15; const int pos = it >> 4;
            if (pos < 4) n = pos == 0 ? 0 : (pos == 1 ? 3 : (pos == 2 ? 1 : 2)); else { const int k = pos - 4; n = (k & 1) ? 131 - (k >> 1) : 4 + (k >> 1); } }
        else { n = it % 132; bh = it / 132; }
        const int b = bh >> 3, h = bh & 7;
        const bool isctx = n < 4; const int L = isctx ? CT : T; const int t0 = isctx ? 64 * n : 64 * (n - 4); const int row0 = (isctx ? ML + b * CT : b * T) + t0;
#ifdef PREP_PROF
        { unsigned long long tn_ = __builtin_amdgcn_s_memrealtime(); asm volatile("" : "+v"(tn_)); plast = tn_; }
#endif
        if (F.tid < 384) {
            const int g8 = F.tid % 48, rp = F.tid / 48, part = g8 >> 4, e0 = (g8 & 15) * 8; const int col = part * 1024 + h * 128 + e0;
            const float* wp = cw + col;
            f32x4 wt[3][2];
#pragma unroll
            for (int tap = 0; tap < 3; ++tap) { wt[tap][0] = *(const f32x4*)(wp + tap * 3072); wt[tap][1] = *(const f32x4*)(wp + tap * 3072 + 4); }
            u32x4 zr[10];
#pragma unroll
            for (int ri = 0; ri < 10; ++ri) { const int c = 8 * rp - 1 + ri; const int t = t0 + c;
                const bf16* src = c < 0 ? HALO + ((size_t)((row0 >> 6) - 1) * 2 + 1) * 3072 + col : (c > 63 ? HALO + ((size_t)((row0 >> 6) + 1) * 2) * 3072 + col : Z + (size_t)(row0 + c) * 4096 + col);
                const bool valid = t >= 0 && t < L;
                if (!valid) src = Z + (size_t)row0 * 4096 + col;
                zr[ri] = *(const u32x4*)src; if (!valid) zr[ri] = (u32x4){0u, 0u, 0u, 0u}; }
#pragma unroll
            for (int i = 0; i < 8; ++i) { float o[8];
#pragma unroll
                for (int q = 0; q < 4; ++q) { const unsigned a = zr[i][q], bq = zr[i + 1][q], cq = zr[i + 2][q];
                    o[2 * q] = silu_fast(wt[0][q >> 1][2 * (q & 1)] * bf2f(a & 0xffffu) + wt[1][q >> 1][2 * (q & 1)] * bf2f(bq & 0xffffu) + wt[2][q >> 1][2 * (q & 1)] * bf2f(cq & 0xffffu));
                    o[2 * q + 1] = silu_fast(wt[0][q >> 1][2 * (q & 1) + 1] * bf2f(a >> 16) + wt[1][q >> 1][2 * (q & 1) + 1] * bf2f(bq >> 16) + wt[2][q >> 1][2 * (q & 1) + 1] * bf2f(cq >> 16)); }
                LAS f32x4* dst = (LAS f32x4*)(STG + (8 * rp + i) * 388 + part * 128 + e0); dst[0] = (f32x4){o[0], o[1], o[2], o[3]}; dst[1] = (f32x4){o[4], o[5], o[6], o[7]}; }
        }
        if (F.wave >= 6) {
            const int d = F.wave - 6, c = F.lane; const size_t row = (size_t)(row0 + c);
            const float Aco = expf(INP(I_GALOG)[j * 16 + d * 8 + h]), dtb = INP(I_GDT)[j * 16 + d * 8 + h];
            const float x = AB[row * 32 + d * 8 + h] + dtb, bb = AB[row * 32 + 16 + d * 8 + h];
            const float sp = x > 20.f ? x : log1pf(expf(x));
            float s = -Aco * sp;
#pragma unroll
            for (int o = 1; o < 64; o <<= 1) { const float up = __shfl_up(s, o), dn = __shfl_down(s, o); if (d ? (c + o < 64) : (c >= o)) s += d ? dn : up; }
            SM[d * 64 + c] = 1.f / (1.f + expf(-bb)); SM[128 + d * 64 + c] = s;
        }
        if (pub >= 0) asm volatile("s_waitcnt vmcnt(0)" ::: "memory");
        __syncthreads();
        if (pub >= 0 && F.tid == 0) __hip_atomic_store(flags + pub, 1u, __ATOMIC_RELAXED, __HIP_MEMORY_SCOPE_AGENT);
        pub = -1;
        if (skip & 8) { if (overlap) pub = bh * 132 + n; continue; }
#ifdef PREP_PROF
        { unsigned long long tn_ = __builtin_amdgcn_s_memrealtime(); asm volatile("" : "+v"(tn_)); if (PREP_PROF == 0) pprof += tn_ - plast; plast = tn_; }
#endif
        { const int c = F.tid >> 3, p = F.tid & 7; const LAS float* sr = STG + c * 388 + 8 * p;
            f32x4 qa[2][2], ka[2][2], va[2][2];
#pragma unroll
            for (int i = 0; i < 2; ++i) { qa[i][0] = *(const LAS f32x4*)(sr + 64 * i); qa[i][1] = *(const LAS f32x4*)(sr + 64 * i + 4); ka[i][0] = *(const LAS f32x4*)(sr + 128 + 64 * i); ka[i][1] = *(const LAS f32x4*)(sr + 128 + 64 * i + 4);
                va[i][0] = *(const LAS f32x4*)(sr + 256 + 64 * i); va[i][1] = *(const LAS f32x4*)(sr + 256 + 64 * i + 4); }
            float sq = 0.f, sk = 0.f;
#pragma unroll
            for (int i = 0; i < 2; ++i)
#pragma unroll
                for (int hq = 0; hq < 2; ++hq)
#pragma unroll
                    for (int e = 0; e < 4; ++e) { sq += qa[i][hq][e] * qa[i][hq][e]; sk += ka[i][hq][e] * ka[i][hq][e]; }
#pragma unroll
            for (int o = 1; o < 8; o <<= 1) { sq += __shfl_xor(sq, o); sk += __shfl_xor(sk, o); }
            const float fq = 0.08838834764831845f / sqrtf(sq + EPS), fk = 1.0f / sqrtf(sk + EPS);
#pragma unroll
            for (int i = 0; i < 2; ++i) { const unsigned oo = off_a(c, p + 8 * i);
                *(LAS u32x4*)(QI + oo) = (u32x4){pk2(qa[i][0][0] * fq, qa[i][0][1] * fq), pk2(qa[i][0][2] * fq, qa[i][0][3] * fq), pk2(qa[i][1][0] * fq, qa[i][1][1] * fq), pk2(qa[i][1][2] * fq, qa[i][1][3] * fq)};
                *(LAS u32x4*)(KI + oo) = (u32x4){pk2(ka[i][0][0] * fk, ka[i][0][1] * fk), pk2(ka[i][0][2] * fk, ka[i][0][3] * fk), pk2(ka[i][1][0] * fk, ka[i][1][1] * fk), pk2(ka[i][1][2] * fk, ka[i][1][3] * fk)};
                *(LAS u32x4*)(VI + c * 256 + (p + 8 * i) * 16) = (u32x4){pk2(va[i][0][0], va[i][0][1]), pk2(va[i][0][2], va[i][0][3]), pk2(va[i][1][0], va[i][1][1]), pk2(va[i][1][2], va[i][1][3])}; } }
        __syncthreads();
        if (skip & 4) { if (overlap) pub = bh * 132 + n; continue; }
#ifdef PREP_PROF
        { unsigned long long tn_ = __builtin_amdgcn_s_memrealtime(); asm volatile("" : "+v"(tn_)); if (PREP_PROF == 1) pprof += tn_ - plast; plast = tn_; }
#endif
        { const int prod = F.wave >> 2, mt = (F.wave >> 1) & 1, nt = F.wave & 1; LAS unsigned char* AI = prod ? QI : KI;
            f32x16 acc;
#pragma unroll
            for (int i = 0; i < 16; ++i) acc[i] = 0.f;
#pragma unroll
            for (int ks = 0; ks < 8; ++ks) { const bf16x8 a = *(const LAS bf16x8*)(AI + off_a(32 * mt + r, 2 * ks + hi)), bq = *(const LAS bf16x8*)(KI + off_a(32 * nt + r, 2 * ks + hi));
                acc = __builtin_amdgcn_mfma_f32_32x32x16_bf16(a, bq, acc, 0, 0, 0); }
            LAS float* dst = prod ? QK : KK;
#pragma unroll
            for (int i = 0; i < 16; ++i) dst[(32 * mt + crow(i, hi)) * 68 + 32 * nt + r] = acc[i]; }
        __syncthreads();
        if (skip & 2) { if (overlap) pub = bh * 132 + n; continue; }
#ifdef PREP_PROF
        { unsigned long long tn_ = __builtin_amdgcn_s_memrealtime(); asm volatile("" : "+v"(tn_)); if (PREP_PROF == 2) pprof += tn_ - plast; plast = tn_; }
#endif
        { const int ps = F.tid & 63;
#pragma unroll 8
            for (int k = 0; k < 16; ++k) { const int d = k >> 3, p = (F.tid >> 6) + 8 * (k & 7); const int c = d ? 63 - p : p, s = d ? 63 - ps : ps;
                const float x = SM[d * 64 + c] * KK[c * 68 + s] * exp_fast(fminf(SM[128 + d * 64 + c] - SM[128 + d * 64 + s], 0.f));
                LP[d * 4096 + p * 64 + ps] = ps < p ? x : 0.f; } }
        __syncthreads();
        const unsigned rec = (unsigned)(((b * 8 + h) * 132 + n) * PD_BYTES);
        constexpr unsigned DSTRIDE = 16u * 132u * PD_BYTES;
#ifdef PREP_PROF
        { unsigned long long tn_ = __builtin_amdgcn_s_memrealtime(); asm volatile("" : "+v"(tn_)); if (PREP_PROF == 3) pprof += tn_ - plast; plast = tn_; }
#endif
        float Tc[32];
#pragma unroll
        for (int p = 0; p < 32; ++p) Tc[p] = 0.f;
        if (F.wave < 4) { if (!(skip & 1)) {
            const int d = F.wave >> 1, blk = F.wave & 1, jj = F.lane & 31;
            float Lr[32];
#pragma unroll
            for (int p = 1; p < 32; ++p) Lr[p] = LP[d * 4096 + (32 * blk + p) * 64 + 32 * blk + jj];
#pragma unroll
            for (int p = 0; p < 32; ++p) { float acc[4]; acc[0] = (p == jj) ? 1.f : 0.f; acc[1] = 0.f; acc[2] = 0.f; acc[3] = 0.f;
#pragma unroll
                for (int sx = 0; sx < p; ++sx) { const float l = __int_as_float(__builtin_amdgcn_readlane(__float_as_int(Lr[p]), sx)); acc[sx & 3] -= l * Tc[sx]; }
                Tc[p] = (acc[0] + acc[1]) + (acc[2] + acc[3]); }
            if (F.lane < 32) { const int pc = 32 * blk + jj;
#pragma unroll
                for (int p = 0; p < 32; ++p) { const int pr = 32 * blk + p; TS[d * 4352 + (d ? 63 - pr : pr) * 68 + (d ? 63 - pc : pc)] = Tc[p]; } } }
        } else {
            for (int q = F.tid - 256; q < 768; q += NTHR - 256) { const int d = q / 384, qq = q % 384, slot = qq >> 7, s2 = (qq >> 6) & 1, ln = qq & 63, hh = ln >> 5, rr = ln & 31;
                const int mtr = slot == 0 ? 0 : (slot == 2 ? 1 : (d ? 0 : 1)), mtc = slot == 0 ? 0 : (slot == 2 ? 1 : (d ? 1 : 0));
                const int c = 32 * mtr + rr, sa = 32 * mtc + 16 * s2 + 4 * hh; const float gcc = SM[128 + d * 64 + c];
                const f32x4 qa = *(const LAS f32x4*)(QK + c * 68 + sa), qb = *(const LAS f32x4*)(QK + c * 68 + sa + 8);
                const f32x4 ga = *(const LAS f32x4*)(SM + 128 + d * 64 + sa), gb = *(const LAS f32x4*)(SM + 128 + d * 64 + sa + 8);
                float v[8];
#pragma unroll
                for (int i = 0; i < 4; ++i) { const int s0 = sa + i, s1 = sa + 8 + i; const bool m0 = d ? (s0 >= c) : (s0 <= c), m1 = d ? (s1 >= c) : (s1 <= c);
                    v[i] = m0 ? qa[i] * exp_fast(gcc - ga[i]) : 0.f; v[4 + i] = m1 ? qb[i] * exp_fast(gcc - gb[i]) : 0.f; }
                if (!dry) ST16(prs, rec + d * DSTRIDE + PD_ATT + qq * 16, ((u32x4){pk2(v[0], v[1]), pk2(v[2], v[3]), pk2(v[4], v[5]), pk2(v[6], v[7])})); }
            if (F.tid >= 256 && F.tid < 320) { const int d = (F.tid - 256) >> 5, wh = (F.tid >> 4) & 1, c4 = (F.tid & 15) * 4;
                const float gl = SM[128 + d * 64 + (d ? 0 : 63)]; const f32x4 g4 = *(const LAS f32x4*)(SM + 128 + d * 64 + c4);
                const f32x4 o4 = wh ? (f32x4){expf(gl - g4[0]), expf(gl - g4[1]), expf(gl - g4[2]), expf(gl - g4[3])} : (f32x4){expf(g4[0]), expf(g4[1]), expf(g4[2]), expf(g4[3])};
                if (!dry) ST16(prs, rec + d * DSTRIDE + (wh ? PD_EW : PD_EG) + 4 * c4, o4); }
        }
        __syncthreads();
#ifdef PREP_PROF
        { unsigned long long tn_ = __builtin_amdgcn_s_memrealtime(); asm volatile("" : "+v"(tn_)); if (PREP_PROF == 4) pprof += tn_ - plast; plast = tn_; }
#endif
        if ((F.wave == 0 || F.wave == 2) && !(skip & 1)) {
            const int d = F.wave >> 1;
            f32x16 Mx, R2;
#pragma unroll
            for (int i = 0; i < 16; ++i) { Mx[i] = 0.f; R2[i] = 0.f; }
#define INV_M(ks) do { const LAS f32x4* lp = (const LAS f32x4*)(LP + d * 4096 + (32 + r) * 64 + 16 * (ks) + 8 * hi); const f32x4 l0 = lp[0], l1 = lp[1]; \
                const bf16x8 A_ = __builtin_bit_cast(bf16x8, (u32x4){pk2(l0[0], l0[1]), pk2(l0[2], l0[3]), pk2(l1[0], l1[1]), pk2(l1[2], l1[3])}); \
                const bf16x8 B_ = __builtin_bit_cast(bf16x8, (u32x4){pk2(hi ? Tc[16 * (ks) + 8] : Tc[16 * (ks)], hi ? Tc[16 * (ks) + 9] : Tc[16 * (ks) + 1]), pk2(hi ? Tc[16 * (ks) + 10] : Tc[16 * (ks) + 2], hi ? Tc[16 * (ks) + 11] : Tc[16 * (ks) + 3]), \
                    pk2(hi ? Tc[16 * (ks) + 12] : Tc[16 * (ks) + 4], hi ? Tc[16 * (ks) + 13] : Tc[16 * (ks) + 5]), pk2(hi ? Tc[16 * (ks) + 14] : Tc[16 * (ks) + 6], hi ? Tc[16 * (ks) + 15] : Tc[16 * (ks) + 7])}); \
                Mx = MFMA32(A_, B_, Mx); } while (0)
            INV_M(0); INV_M(1);
#undef INV_M
#pragma unroll
            for (int ks = 0; ks < 2; ++ks) {
                const int cn = d ? 31 - r : 32 + r, ps0 = 32 + 16 * ks + 4 * hi;
                f32x4 ta, tb;
                if (d) { const f32x4 x0 = *(const LAS f32x4*)(TS + 4352 + cn * 68 + (60 - ps0)), x1 = *(const LAS f32x4*)(TS + 4352 + cn * 68 + (52 - ps0));
                    ta = (f32x4){x0[3], x0[2], x0[1], x0[0]}; tb = (f32x4){x1[3], x1[2], x1[1], x1[0]}; }
                else { ta = *(const LAS f32x4*)(TS + cn * 68 + ps0); tb = *(const LAS f32x4*)(TS + cn * 68 + ps0 + 8); }
                const bf16x8 A2 = __builtin_bit_cast(bf16x8, (u32x4){pk2(ta[0], ta[1]), pk2(ta[2], ta[3]), pk2(tb[0], tb[1]), pk2(tb[2], tb[3])});
                const bf16x8 B2 = ks == 0 ? PACK8(Mx, 0) : PACK8(Mx, 8);
                R2 = MFMA32(A2, B2, R2); }
#pragma unroll
            for (int i = 0; i < 16; ++i) { const int pr = 32 + crow(i, hi), pc = r; TS[d * 4352 + (d ? 63 - pr : pr) * 68 + (d ? 63 - pc : pc)] = -R2[i]; }
        }
        __syncthreads();
#ifdef PREP_PROF
        { unsigned long long tn_ = __builtin_amdgcn_s_memrealtime(); asm volatile("" : "+v"(tn_)); if (PREP_PROF == 5) pprof += tn_ - plast; plast = tn_; }
#endif
        for (int q = F.tid; q < 768; q += NTHR) { const int d = q / 384, qq = q % 384, slot = qq >> 7, s2 = (qq >> 6) & 1, ln = qq & 63, hh = ln >> 5, rr = ln & 31;
            const int mtr = slot == 0 ? 0 : (slot == 2 ? 1 : (d ? 0 : 1)), mtc = slot == 0 ? 0 : (slot == 2 ? 1 : (d ? 1 : 0));
            const int c = 32 * mtr + rr, sa = 32 * mtc + 16 * s2 + 4 * hh;
            const f32x4 ta = *(const LAS f32x4*)(TS + d * 4352 + c * 68 + sa), tb = *(const LAS f32x4*)(TS + d * 4352 + c * 68 + sa + 8);
            const f32x4 ba = *(const LAS f32x4*)(SM + d * 64 + sa), bb = *(const LAS f32x4*)(SM + d * 64 + sa + 8);
            if (!dry) ST16(prs, rec + d * DSTRIDE + qq * 16, ((u32x4){pk2(ta[0] * ba[0], ta[1] * ba[1]), pk2(ta[2] * ba[2], ta[3] * ba[3]), pk2(tb[0] * bb[0], tb[1] * bb[1]), pk2(tb[2] * bb[2], tb[3] * bb[3])})); }
        if (!dry) for (int idx = F.tid; idx < 3072; idx += NTHR) { const int img = idx >> 10, pn = idx & 1023;
            ST16(zrs, (unsigned)(((row0 + (pn >> 4)) * 4096 + img * 1024 + h * 128) * 2 + (pn & 15) * 16), *(const LAS u32x4*)((img == 0 ? QI : (img == 1 ? KI : VI)) + pn * 16)); }
#ifdef PREP_PROF
        { unsigned long long tn_ = __builtin_amdgcn_s_memrealtime(); asm volatile("" : "+v"(tn_)); if (PREP_PROF == 6) pprof += tn_ - plast; plast = tn_; }
#endif
        if (overlap && !dry) pub = bh * 132 + n;
        __syncthreads();
#ifdef PREP_PROF
        { unsigned long long tn_ = __builtin_amdgcn_s_memrealtime(); asm volatile("" : "+v"(tn_)); if (PREP_PROF == 7) pprof += tn_ - plast; plast = tn_; }
#endif
    }
    if (pub >= 0) { asm volatile("s_waitcnt vmcnt(0)" ::: "memory"); __syncthreads(); if (F.tid == 0) __hip_atomic_store(flags + pub, 1u, __ATOMIC_RELAXED, __HIP_MEMORY_SCOPE_AGENT); }
#ifdef PREP_PROF
    if (F.bid == 32 && F.tid == 0) g_scanprof += pprof;
#endif
}

typedef short v4i16_t __attribute__((ext_vector_type(4)));
__device__ __forceinline__ float mul_s(float a, float b) { float r; asm("v_mul_f32_e32 %0, %1, %2" : "=v"(r) : "v"(a), "v"(b)); return r; }
__device__ __forceinline__ float fnma_s(float a, float b, float c) { float r; asm("v_fma_f32 %0, -%1, %2, %3" : "=v"(r) : "v"(a), "v"(b), "v"(c)); return r; }
__device__ __forceinline__ void step_convert_rest() {
    const Frame F = make_frame();
    if (F.bid >= 32 && F.G > 32)
        convert_weights(F.ws, 0xffffu & ~((1u << 8) | (1u << 10)), (F.bid - 32) * NWAVES + F.wave, (F.G - 32) * NWAVES, (F.bid - 32) * NTHR + F.tid, (F.G - 32) * NTHR, F.lds, F.wave, F.lane);
}
__device__ __forceinline__ void step_gdn_scan2(const unsigned* flags, int mode = 0) {
    const Frame F = make_frame();
    constexpr int BUF = 61952, B_K = 0, B_Q = 16384, B_V = 32768, B_PD = 49152, OT_BASE = 2 * BUF, OT_ROW = 272, OT_BYTES = 64 * OT_ROW;
    const bf16* Z = (const bf16*)(F.ws + WS_Z); const unsigned char* PD = F.ws + WS_PD;
    const int r = F.lane & 31, hi = F.lane >> 5;
    unsigned* prog = flags ? (unsigned*)flags + 2560 : nullptr;
    const __amdgpu_buffer_rsrc_t ors = __builtin_amdgcn_make_buffer_rsrc((void*)F.out, (short)0, (int)((size_t)2 * ML * D * 2), 0x00020000);
    const __amdgpu_buffer_rsrc_t crs = __builtin_amdgcn_make_buffer_rsrc((void*)(F.ws + WS_OFC), (short)0, (int)((size_t)2 * MC * D * 2), 0x00020000);
    for (int it = F.bid; it < 32; it += F.G) {
        const int b = it >> 4, h = (it >> 1) & 7, dir = it & 1;
        const unsigned char* pdb = PD + (size_t)(((dir * 2 + b) * 8 + h) * 132) * PD_BYTES;
#define CHUNK_OF(sp) (dir ? ((sp) < 4 ? 3 - (sp) : 135 - (sp)) : (sp))
#define ROW0_OF(n) ((n) < 4 ? ML + b * CT + 64 * (n) : b * T + 64 * ((n) - 4))
        if (F.wave >= 4) {
            const int lt = F.tid - 256;
            u32x4 rgA[16], rgB[16];
#define LOAD_CHUNK(rg, sp) do { const int n_ = CHUNK_OF(sp); const int row0_ = ROW0_OF(n_); \
                _Pragma("unroll") for (int i = 0; i < 4; ++i) { const int pn = lt + 256 * i; const unsigned char* src = (const unsigned char*)(Z + (size_t)(row0_ + (pn >> 4)) * 4096 + h * 128) + (pn & 15) * 16; \
                    rg[i] = *(const u32x4*)(src + 2048); rg[4 + i] = *(const u32x4*)src; rg[8 + i] = *(const u32x4*)(src + 4096); \
                    rg[12 + i] = pn < 800 ? *(const u32x4*)(pdb + (size_t)n_ * PD_BYTES + pn * 16) : (u32x4){0u, 0u, 0u, 0u}; } } while (0)
#define WRITE_CHUNK(rg, bufb) do { LAS unsigned char* base_ = F.lds + (bufb); \
                _Pragma("unroll") for (int i = 0; i < 4; ++i) { const int pn = lt + 256 * i; *(LAS u32x4*)(base_ + B_K + pn * 16) = rg[i]; *(LAS u32x4*)(base_ + B_Q + pn * 16) = rg[4 + i]; \
                    *(LAS u32x4*)(base_ + B_V + pn * 16) = rg[8 + i]; if (pn < 800) *(LAS u32x4*)(base_ + B_PD + pn * 16) = rg[12 + i]; } } while (0)
            int acq = flags ? -1 : 1000;
#define ENSURE(tgt) do { const int tg_ = (tgt); if (F.wave == 4 && tg_ < 132 && acq < tg_) { const unsigned* fb_ = flags + (b * 8 + h) * 132; unsigned spins_ = 0; \
                    while (__hip_atomic_load(fb_ + CHUNK_OF(tg_), __ATOMIC_RELAXED, __HIP_MEMORY_SCOPE_AGENT) == 0u) { __builtin_amdgcn_s_sleep(2); if (++spins_ > (1u << 24)) break; } \
                    int e_ = tg_; while (e_ + 1 < 132 && e_ < tg_ + 16 && __hip_atomic_load(fb_ + CHUNK_OF(e_ + 1), __ATOMIC_RELAXED, __HIP_MEMORY_SCOPE_AGENT) != 0u) ++e_; \
                    __builtin_amdgcn_fence(__ATOMIC_ACQUIRE, "agent"); asm volatile("s_waitcnt vmcnt(0)" ::: "memory"); acq = e_; } } while (0)
            ENSURE(0); ENSURE(1); ENSURE(2);
            __syncthreads();
            LOAD_CHUNK(rgA, 0); WRITE_CHUNK(rgA, 0); LOAD_CHUNK(rgA, 1); LOAD_CHUNK(rgB, 2); ENSURE(3);
            __syncthreads();
#define STORE_O(sq) do { const int n_ = CHUNK_OF(sq); const int row0_ = ROW0_OF(n_); \
                const LAS unsigned char* ot_ = F.lds + OT_BASE + ((sq) & 1) * OT_BYTES; \
                _Pragma("unroll") for (int i = 0; i < 4; ++i) { const int pn = lt + 256 * i; const u32x4 v_ = *(const LAS u32x4*)(ot_ + (pn >> 4) * OT_ROW + (pn & 15) * 16); \
                    if (!(mode & 1)) { if (n_ < 4) __builtin_amdgcn_raw_buffer_store_b128(v_, crs, (int)((((dir * MC + (row0_ - ML) + (pn >> 4)) * D + h * 128) * 2) + (pn & 15) * 16), 0, 16); \
                        else __builtin_amdgcn_raw_buffer_store_b128(v_, ors, (int)((((dir * ML + row0_ + (pn >> 4)) * D + h * 128) * 2) + (pn & 15) * 16), 0, 16); } } } while (0)
#define LOADER_ITER(rg, sp) do { \
                asm volatile("s_waitcnt vmcnt(19)" ::: "memory"); \
                if (prog && (sp) >= 4 && F.tid == 256) (void)__hip_atomic_fetch_add(prog + (b * 132 + CHUNK_OF((sp) - 4)) * 4, 1u, __ATOMIC_RELAXED, __HIP_MEMORY_SCOPE_AGENT); \
                if ((sp) + 1 < 132 && !(mode & 4)) WRITE_CHUNK(rg, (((sp) + 1) & 1) * BUF); \
                if ((sp) + 3 < 132 && !(mode & 8)) LOAD_CHUNK(rg, (sp) + 3); \
                if ((sp) > 0) STORE_O((sp) - 1); \
                ENSURE((sp) + 4); \
                __syncthreads(); } while (0)
            for (int sp = 0; sp < 132; sp += 2) { LOADER_ITER(rgA, sp); LOADER_ITER(rgB, sp + 1); }
#undef LOADER_ITER
            STORE_O(131);
            asm volatile("s_waitcnt vmcnt(0)" ::: "memory");
            __syncthreads();
            if (prog && F.tid == 256) { for (int s_ = 128; s_ < 132; ++s_) (void)__hip_atomic_fetch_add(prog + (b * 132 + CHUNK_OF(s_)) * 4, 1u, __ATOMIC_RELAXED, __HIP_MEMORY_SCOPE_AGENT); }
#undef STORE_O
#undef ENSURE
#undef LOAD_CHUNK
#undef WRITE_CHUNK
        } else {
            const int w = F.wave;
#ifdef SCAN_PROF
            unsigned long long tprof = 0ull, tlast = 0ull;
#endif
            f32x16 S[4];
#pragma unroll
            for (int kt = 0; kt < 4; ++kt)
#pragma unroll
                for (int i = 0; i < 16; ++i) S[kt][i] = 0.f;
            const int x = (r >> 2) & 3; const int rowb = 2048 * (r >> 3) + 64 * (r & 7);
            int oa[2], ob[2];
#pragma unroll
            for (int s2 = 0; s2 < 2; ++s2) { oa[s2] = rowb + 16 * ((2 * s2) ^ x) + 8 * hi; ob[s2] = rowb + 16 * ((2 * s2 + 1) ^ x) + 8 * hi; }
            const int blk = (F.lane >> 4) & 1, q = (F.lane & 15) >> 2, p = F.lane & 3, cb = 2 * blk + (p >> 1);
            int trb[2];
#pragma unroll
            for (int t = 0; t < 2; ++t) trb[t] = 64 * (4 * hi + q) + 8 * (p & 1) + 16 * (cb ^ ((2 * t + hi) & 3)) + 2048 * t;
            const int vb = 4 * hi * 256 + (32 * w + r) * 2;
            __syncthreads();
            __syncthreads();
            for (int sp = 0; sp < 132; ++sp) {
                const int n = CHUNK_OF(sp); const int row0 = ROW0_OF(n);
                LAS unsigned char* B = F.lds + (sp & 1) * BUF;
                LAS unsigned char* KI = B + B_K; LAS unsigned char* QI = B + B_Q; LAS unsigned char* VI = B + B_V; LAS unsigned char* PR = B + B_PD;
#ifdef SCAN_PROF
                { const unsigned long long tn_ = __builtin_amdgcn_s_memrealtime(); if (SCAN_PROF == 7 && sp > 0) tprof += tn_ - tlast; tlast = tn_; }
#endif
                const int xk = dir ? 8192 : 0, xe = dir ? 128 : 0, xs = dir ? 4096 : 0, xo = dir ? 32 * OT_ROW : 0;
                LAS unsigned char* Kt[2] = {KI + xk, KI + (8192 - xk)}; LAS unsigned char* Qt[2] = {QI + xk, QI + (8192 - xk)}; LAS unsigned char* Vt[2] = {VI + vb + xk, VI + vb + (8192 - xk)};
                LAS unsigned char* Et[2] = {PR + xe, PR + (128 - xe)};
                LAS unsigned char* Tt[2] = {PR + xs + F.lane * 16, PR + (4096 - xs) + F.lane * 16}; LAS unsigned char* Tx = PR + 2048 + F.lane * 16;
#define LDF(dst, base, kt) do { _Pragma("unroll") for (int s2 = 0; s2 < 2; ++s2) _Pragma("unroll") for (int mt = 0; mt < 2; ++mt) { \
                    dst[s2][mt][0] = *(const volatile LAS s16x4*)(base[mt] + 512 * (kt) + oa[s2]); dst[s2][mt][1] = *(const volatile LAS s16x4*)(base[mt] + 512 * (kt) + ob[s2]); } } while (0)
#define FRAG(f) ((bf16x8){f[0][0], f[0][1], f[0][2], f[0][3], f[1][0], f[1][1], f[1][2], f[1][3]})
#define MM_KS(f, kt) do { _Pragma("unroll") for (int s2 = 0; s2 < 2; ++s2) _Pragma("unroll") for (int mt = 0; mt < 2; ++mt) KS[mt] = MFMA32(FRAG(f[s2][mt]), Sb[kt][s2], KS[mt]); \
                    _Pragma("unroll") for (int i = 0; i < 16; ++i) S[kt][i] *= cd; } while (0)
#define MM_QS(f, kt) do { if (!(mode & 2)) { _Pragma("unroll") for (int s2 = 0; s2 < 2; ++s2) _Pragma("unroll") for (int mt = 0; mt < 2; ++mt) QS[mt] = MFMA32(Sb[kt][s2], FRAG(f[s2][mt]), QS[mt]); } } while (0)
#define LDV(vd, ed, g) do { _Pragma("unroll") for (int mt = 0; mt < 2; ++mt) { ed[mt] = *(const LAS f32x4*)(Et[mt] + PD_EG + 4 * (8 * (g) + 4 * hi)); \
                    _Pragma("unroll") for (int i = 0; i < 4; ++i) vd[mt][i] = *(const LAS bf16*)(Vt[mt] + (8 * (g) + i) * 256); } } while (0)
#define RPART(vd, ed, g) do { _Pragma("unroll") for (int mt = 0; mt < 2; ++mt) _Pragma("unroll") for (int i = 0; i < 4; ++i) R8[mt][4 * ((g) & 1) + i] = bf2f(vd[mt][i]) - ed[mt][i] * KS[mt][4 * (g) + i]; \
                    if ((g) & 1) { Rb[0][(g) >> 1] = PACK8(R8[0], 0); Rb[1][(g) >> 1] = PACK8(R8[1], 0); } } while (0)
#define FENCE asm volatile("" ::: "memory")
                s16x4 fa[2][2][2], fb[2][2][2]; bf16 va[2][4]; f32x4 ea[2];
                LDF(fa, Kt, 0); FENCE;
                bf16x8 Sb[4][2];
#pragma unroll
                for (int kt = 0; kt < 4; ++kt) { Sb[kt][0] = PACK8(S[kt], 0); Sb[kt][1] = PACK8(S[kt], 8); }
                const float cd = *(const LAS float*)(PR + PD_EG + 4 * (dir ? 0 : 63));
                f32x16 KS[2], QS[2]; float R8[2][8]; bf16x8 Rb[2][2];
#pragma unroll
                for (int i = 0; i < 16; ++i) { KS[0][i] = 0.f; KS[1][i] = 0.f; }
                LDF(fb, Kt, 1); FENCE; MM_KS(fa, 0);
                LDF(fa, Kt, 2); FENCE; MM_KS(fb, 1);
                LDF(fb, Kt, 3); FENCE; MM_KS(fa, 2);
                LDF(fa, Qt, 0); FENCE; MM_KS(fb, 3);
#ifdef SCAN_PROF
                { const unsigned long long tn_ = __builtin_amdgcn_s_memrealtime(); if (SCAN_PROF == 0) tprof += tn_ - tlast; tlast = tn_; }
#endif
#pragma unroll
                for (int i = 0; i < 16; ++i) { QS[0][i] = 0.f; QS[1][i] = 0.f; }
                LDV(va, ea, 0); FENCE; MM_QS(fa, 0); LDF(fa, Qt, 1); FENCE; RPART(va, ea, 0);
                LDV(va, ea, 1); FENCE; MM_QS(fa, 1); LDF(fa, Qt, 2); FENCE; RPART(va, ea, 1);
                LDV(va, ea, 2); FENCE; MM_QS(fa, 2); LDF(fa, Qt, 3); FENCE; RPART(va, ea, 2);
                LDV(va, ea, 3);
                bf16x8 tf[6];
#pragma unroll
                for (int s2 = 0; s2 < 2; ++s2) { tf[s2] = *(const LAS bf16x8*)(Tt[0] + 1024 * s2); tf[2 + s2] = *(const LAS bf16x8*)(Tt[1] + 1024 * s2); tf[4 + s2] = *(const LAS bf16x8*)(Tx + 1024 * s2); }
                FENCE; MM_QS(fa, 3); RPART(va, ea, 3);
                asm volatile("" ::: "memory");
#ifdef SCAN_PROF
                { const unsigned long long tn_ = __builtin_amdgcn_s_memrealtime(); if (SCAN_PROF == 1) tprof += tn_ - tlast; tlast = tn_; }
#endif
                f32x16 vn[2], o[2];
#pragma unroll
                for (int i = 0; i < 16; ++i) { vn[0][i] = 0.f; vn[1][i] = 0.f; }
                vn[0] = MFMA32(tf[0], Rb[0][0], vn[0]); vn[1] = MFMA32(tf[2], Rb[1][0], vn[1]);
                vn[0] = MFMA32(tf[1], Rb[0][1], vn[0]); vn[1] = MFMA32(tf[3], Rb[1][1], vn[1]);
                vn[1] = MFMA32(tf[4], Rb[0][0], vn[1]); vn[1] = MFMA32(tf[5], Rb[0][1], vn[1]);
                f32x4 w4[2][4];
#pragma unroll
                for (int mt = 0; mt < 2; ++mt) { const float eq = *(const LAS float*)(Et[mt] + PD_EG + 4 * r);
#pragma unroll
                    for (int g = 0; g < 4; ++g) w4[mt][g] = *(const LAS f32x4*)(Et[mt] + PD_EW + 4 * (8 * g + 4 * hi));
#pragma unroll
                    for (int i = 0; i < 16; ++i) o[mt][i] = eq * QS[mt][i]; }
#pragma unroll
                for (int s2 = 0; s2 < 2; ++s2) { tf[s2] = *(const LAS bf16x8*)(Tt[0] + PD_ATT + 1024 * s2); tf[2 + s2] = *(const LAS bf16x8*)(Tt[1] + PD_ATT + 1024 * s2); tf[4 + s2] = *(const LAS bf16x8*)(Tx + PD_ATT + 1024 * s2); }
                asm volatile("" ::: "memory");
#ifdef SCAN_PROF
                { const unsigned long long tn_ = __builtin_amdgcn_s_memrealtime(); if (SCAN_PROF == 2) tprof += tn_ - tlast; tlast = tn_; }
#endif
                bf16x8 Vb[2][2], Wb[2][2];
#pragma unroll
                for (int mt = 0; mt < 2; ++mt) { f32x16 W;
#pragma unroll
                    for (int g = 0; g < 4; ++g)
#pragma unroll
                        for (int i = 0; i < 4; ++i) W[4 * g + i] = w4[mt][g][i] * vn[mt][4 * g + i];
                    Vb[mt][0] = PACK8(vn[mt], 0); Vb[mt][1] = PACK8(vn[mt], 8); Wb[mt][0] = PACK8(W, 0); Wb[mt][1] = PACK8(W, 8); }
#ifdef SCAN_PROF
                { const unsigned long long tn_ = __builtin_amdgcn_s_memrealtime(); if (SCAN_PROF == 3) tprof += tn_ - tlast; tlast = tn_; }
#endif
                if (!(mode & 2)) {
                o[0] = MFMA32(Vb[0][0], tf[0], o[0]); o[1] = MFMA32(Vb[1][0], tf[2], o[1]);
                o[0] = MFMA32(Vb[0][1], tf[1], o[0]); o[1] = MFMA32(Vb[1][1], tf[3], o[1]);
                o[1] = MFMA32(Vb[0][0], tf[4], o[1]); o[1] = MFMA32(Vb[0][1], tf[5], o[1]);
                }
#ifdef SCAN_PROF
                { const unsigned long long tn_ = __builtin_amdgcn_s_memrealtime(); if (SCAN_PROF == 4) tprof += tn_ - tlast; tlast = tn_; }
#endif
#define TRD(dst, n) do { _Pragma("unroll") for (int kt = 0; kt < 4; ++kt) { \
                    dst[kt][0] = __builtin_bit_cast(s16x4, __builtin_amdgcn_ds_read_tr16_b64_v4i16((LAS v4i16_t*)(Kt[(n) >> 1] + 4096 * ((n) & 1) + 512 * kt + trb[0]))); \
                    dst[kt][1] = __builtin_bit_cast(s16x4, __builtin_amdgcn_ds_read_tr16_b64_v4i16((LAS v4i16_t*)(Kt[(n) >> 1] + 4096 * ((n) & 1) + 512 * kt + trb[1]))); } } while (0)
#define MM_S(f, n) do { _Pragma("unroll") for (int kt = 0; kt < 4; ++kt) S[kt] = MFMA32(FRAG(f[kt]), Wb[(n) >> 1][(n) & 1], S[kt]); } while (0)
                s16x4 ta[4][2], tb[4][2];
                TRD(ta, 0); FENCE;
                TRD(tb, 1); FENCE; MM_S(ta, 0);
                TRD(ta, 2); FENCE; MM_S(tb, 1);
                TRD(tb, 3); FENCE; MM_S(ta, 2);
                {
                    LAS unsigned char* oc = F.lds + OT_BASE + (sp & 1) * OT_BYTES + r * OT_ROW + 64 * w + 8 * hi;
#pragma unroll
                    for (int m2 = 0; m2 < 2; ++m2)
#pragma unroll
                        for (int g = 0; g < 4; ++g) *(LAS u32x2*)(oc + (m2 ? 32 * OT_ROW - xo : xo) + 16 * g) = (u32x2){pk2(o[m2][4 * g], o[m2][4 * g + 1]), pk2(o[m2][4 * g + 2], o[m2][4 * g + 3])}; }
                FENCE; MM_S(tb, 3);
#undef TRD
#undef MM_S
#undef FENCE
#undef LDF
#undef FRAG
#undef MM_KS
#undef MM_QS
#undef LDV
#undef RPART
#ifdef SCAN_PROF
                { const unsigned long long tn_ = __builtin_amdgcn_s_memrealtime(); if (SCAN_PROF == 5) tprof += tn_ - tlast; tlast = tn_; }
#endif
                __syncthreads();
            }
            __syncthreads();
#ifdef SCAN_PROF
            if (it == 0 && w == 0 && F.lane == 0) g_scanprof += tprof;
#endif
        }
#undef CHUNK_OF
#undef ROW0_OF
    }
}
__device__ __forceinline__ void gdn_norm_rows(const Frame& F, int j, int row_first, int row_end, int row_step) {
    const bf16* Z = (const bf16*)(F.ws + WS_Z); bf16* Y = (bf16*)(F.ws + WS_Z); const float* ng = INP(I_GNG) + j * 128;
    const int e0 = (16 * F.lane) & 127;
    for (int row = row_first; row < row_end; row += 2 * row_step) {
        const int rowB = row + row_step; const bool hasB = rowB < row_end; const int rB = hasB ? rowB : row;
        u32x4 a[2][2], bq[2][2], gz[2][2];
#pragma unroll
        for (int t = 0; t < 2; ++t) { const int rr = t ? rB : row;
            const bf16* of = rr < ML ? (const bf16*)F.out + (size_t)rr * D : (const bf16*)(F.ws + WS_OFC) + (size_t)(rr - ML) * D;
            const bf16* ob = rr < ML ? of + (size_t)ML * D : of + (size_t)MC * D;
            const u32x4* f4 = (const u32x4*)(of + 16 * F.lane); const u32x4* b4 = (const u32x4*)(ob + 16 * F.lane); const u32x4* g4 = (const u32x4*)(Z + (size_t)rr * 4096 + 3072 + 16 * F.lane);
            a[t][0] = f4[0]; a[t][1] = f4[1]; bq[t][0] = b4[0]; bq[t][1] = b4[1]; gz[t][0] = g4[0]; gz[t][1] = g4[1]; }
#pragma unroll
        for (int t = 0; t < 2; ++t) { const int rr = t ? rB : row;
            float v[16]; float ss = 0.f;
#pragma unroll
            for (int q = 0; q < 2; ++q)
#pragma unroll
                for (int i = 0; i < 4; ++i) { const float x0 = bf2f(a[t][q][i] & 0xffffu) + bf2f(bq[t][q][i] & 0xffffu), x1 = bf2f(a[t][q][i] >> 16) + bf2f(bq[t][q][i] >> 16); v[8 * q + 2 * i] = x0; v[8 * q + 2 * i + 1] = x1; ss += x0 * x0 + x1 * x1; }
            ss += __shfl_xor(ss, 1); ss += __shfl_xor(ss, 2); ss += __shfl_xor(ss, 4);
            const float rstd = 1.0f / sqrtf(ss * (1.f / 128.f) + EPS);
            u32x4 o[2];
#pragma unroll
            for (int q = 0; q < 2; ++q) { unsigned wv[4];
#pragma unroll
                for (int i = 0; i < 4; ++i) { const unsigned gg = gz[t][q][i]; const float g0 = bf2f(gg & 0xffffu), g1 = bf2f(gg >> 16); const int e = e0 + 8 * q + 2 * i;
                    wv[i] = pk2(v[8 * q + 2 * i] * rstd * ng[e] * silu_f(g0), v[8 * q + 2 * i + 1] * rstd * ng[e + 1] * silu_f(g1)); }
                o[q] = (u32x4){wv[0], wv[1], wv[2], wv[3]}; }
            if (t == 0 || hasB) { u32x4* dst = (u32x4*)(Y + (size_t)rr * 4096 + 16 * F.lane); dst[0] = o[0]; dst[1] = o[1]; } }
    }
}
__device__ __forceinline__ void step_gdn_norm2(int j) {
    const Frame F = make_frame();
    gdn_norm_rows(F, j, F.bid * NWAVES + F.wave, M, F.G * NWAVES);
}
__device__ __forceinline__ void step_gdn_follow(int j, const unsigned* flags) {
    const Frame F = make_frame();
    if (F.bid < 32) return;
    const unsigned* prog = flags + 2560;
    for (int uu = F.bid - 32; uu < 528; uu += F.G - 32) {
        const int u = uu >> 1, half = uu & 1;
        int b, n;
        if (u < 8) { b = u & 1; n = u >> 1; } else { const int v = u - 8, wq = v >> 1, jq = wq >> 1; b = v & 1; n = (wq & 1) ? 68 + jq : 67 - jq; }
        if (F.wave == 0) {
            unsigned spins = 0;
            while ((unsigned)__builtin_amdgcn_readfirstlane(__hip_atomic_load(prog + (b * 132 + n) * 4, __ATOMIC_RELAXED, __HIP_MEMORY_SCOPE_AGENT)) < 16u) { __builtin_amdgcn_s_sleep(32); if (++spins > (1u << 20)) break; }
            __builtin_amdgcn_fence(__ATOMIC_ACQUIRE, "agent"); asm volatile("s_waitcnt vmcnt(0)" ::: "memory");
        }
        __syncthreads();
        const int row0 = (n < 4 ? ML + b * CT + 64 * n : b * T + 64 * (n - 4)) + 32 * half;
        gdn_norm_rows(F, j, row0 + F.wave, row0 + 32, NWAVES);
    }
}

__device__ __forceinline__ void step_rope2() {
    const Frame F = make_frame();
    const int gw = F.bid * NWAVES + F.wave, NGW = F.G * NWAVES;
    bf16* Z = (bf16*)(F.ws + WS_Z); const f32x4* R = (const f32x4*)(F.ws + WS_ROPE);
    for (int row = gw; row < M; row += NGW) {
        u32x4* p = (u32x4*)(Z + (size_t)row * 3072 + 32 * F.lane);
        u32x4 v[4];
#pragma unroll
        for (int q = 0; q < 4; ++q) v[q] = p[q];
        const bool lat = row < ML; const float sc = F.lane < 32 ? QSCALE : 1.0f;
        const f32x4* tab = R + ((size_t)(row & (T - 1)) * 32 + 16 * (F.lane & 1)) / 2;
#pragma unroll
        for (int q = 0; q < 4; ++q) {
#pragma unroll
            for (int i = 0; i < 4; i += 2) {
                f32x4 cs = (f32x4){1.f, 0.f, 1.f, 0.f}; if (lat) cs = tab[(4 * q + i) / 2];
                { const unsigned w = v[q][i]; const float x0 = bf2f(w & 0xffffu), x1 = bf2f(w >> 16); v[q][i] = pk2((x0 * cs.x - x1 * cs.y) * sc, (x0 * cs.y + x1 * cs.x) * sc); }
                { const unsigned w = v[q][i + 1]; const float x0 = bf2f(w & 0xffffu), x1 = bf2f(w >> 16); v[q][i + 1] = pk2((x0 * cs.z - x1 * cs.w) * sc, (x0 * cs.w + x1 * cs.z) * sc); }
            }
        }
#pragma unroll
        for (int q = 0; q < 4; ++q) p[q] = v[q];
    }
}
#define ATT_THR 4.0f
__device__ __forceinline__ void att_softmax(f32x16& p0, f32x16& p1, float& m_reg, float& l, float& alpha, bf16x8 (&pf)[2][2]) {
    float mx = fmaxf(p0[0], p1[0]);
#pragma unroll
    for (int q = 1; q < 16; ++q) mx = fmaxf(mx, fmaxf(p0[q], p1[q]));
    mx = fmaxf(mx, __shfl_xor(mx, 32));
    const float mn = (mx - m_reg > ATT_THR) ? mx : m_reg; alpha = __builtin_amdgcn_exp2f(m_reg - mn); m_reg = mn;
    float ps = 0.f;
#pragma unroll
    for (int q = 0; q < 16; ++q) { p0[q] = __builtin_amdgcn_exp2f(p0[q] - m_reg); p1[q] = __builtin_amdgcn_exp2f(p1[q] - m_reg); ps += p0[q] + p1[q]; }
    l = l * alpha + ps;
    pf[0][0] = PACK8(p0, 0); pf[0][1] = PACK8(p0, 8); pf[1][0] = PACK8(p1, 0); pf[1][1] = PACK8(p1, 8);
}
__device__ __forceinline__ void step_attn2(int mode = 0) {
    const Frame F = make_frame();
    const bf16* Z = (const bf16*)(F.ws + WS_Z); bf16* Y = (bf16*)(F.ws + WS_Y);
    LAS float* EX = (LAS float*)F.lds;
    constexpr int KB0 = 0, VB0 = 65536;
    const int r = F.lane & 31, hi = F.lane >> 5, qs = F.wave & 3, m = F.wave >> 2;
    float lmb;
    { const float* lam = INP(I_DLAM); const float t1 = lam[F.lane] * lam[64 + F.lane], t2 = lam[128 + F.lane] * lam[192 + F.lane]; lmb = expf(wave_sum(t1)) - expf(wave_sum(t2)) + LAMBDA_INIT; }
    const float* ng = INP(I_DNG);
    const int kro = 2048 * (r >> 3) + 64 * (r & 7); const int xk = (r >> 2) & 3;
    int koff[2];
#pragma unroll
    for (int d0 = 0; d0 < 2; ++d0) koff[d0] = kro + 1024 * m + 16 * (((2 * d0 + hi) & 3) ^ xk);
    const int blk = (F.lane >> 4) & 1, q4 = (F.lane & 15) >> 2, p4 = F.lane & 3, cb = 2 * blk + (p4 >> 1);
    int trb[2];
#pragma unroll
    for (int t = 0; t < 2; ++t) trb[t] = 64 * (4 * hi + q4) + 8 * (p4 & 1) + 16 * (cb ^ ((2 * t + hi) & 3)) + 2048 * t;
    const int drow = 8 * F.wave + ((F.lane & 31) >> 2);
    const unsigned goff = (unsigned)(drow * 6144 + 16 * (4 * (F.lane >> 5) + ((F.lane & 3) ^ ((drow >> 2) & 3))));
    const unsigned ldsw = (unsigned)F.wave * 2048u;
    const int xcd = F.bid & 7, cux = F.bid >> 3;
    for (int ui = 0; ui < 5; ++ui) {
        int b, h, qrow0, nt;
        if (F.G == 256) {
            h = xcd;
            if (ui < 4) { b = ui >> 1; qrow0 = b * T + (cux + 32 * (ui & 1)) * 128; nt = NKV / 64; }
            else { if (cux >= 4) break; b = cux >> 1; qrow0 = ML + b * CT + (cux & 1) * 128; nt = CT / 64; }
        } else {
            const int u = F.bid + ui * F.G; if (u >= 1056) break;
            if (u < 1024) { b = u >> 9; h = (u >> 6) & 7; qrow0 = b * T + (u & 63) * 128; nt = NKV / 64; }
            else { const int v = u - 1024; b = v >> 4; h = (v >> 1) & 7; qrow0 = ML + b * CT + (v & 1) * 128; nt = CT / 64; }
        }
        const int row0 = qrow0 + 32 * qs;
        bf16x8 qf[4];
#pragma unroll
        for (int d0 = 0; d0 < 4; ++d0) qf[d0] = *(const bf16x8*)(Z + (size_t)(row0 + r) * 3072 + h * 128 + m * 64 + d0 * 16 + hi * 8);
        asm volatile("" : "+v"(qf[0]), "+v"(qf[1]), "+v"(qf[2]), "+v"(qf[3]));
        asm volatile("s_waitcnt vmcnt(0)" ::: "memory");
        const char* kgb = (const char*)(Z + 1024 + h * 128); const char* vgb = (const char*)(Z + 2048 + h * 128);
#define KVROW(t) ((t) < CT / 64 ? ML + b * CT + 64 * (t) : b * T + 64 * (t) - CT)
#define DMAK(t) do { if (mode & 8) break; const int t_ = (t) < nt ? (t) : nt - 1; const char* g_ = kgb + (size_t)KVROW(t_) * 6144 + goff; LAS unsigned char* d_ = F.lds + KB0 + ((t) & 3) * 16384 + ldsw; \
            __builtin_amdgcn_global_load_lds((const unsigned*)g_, (LAS unsigned*)d_, 16, 0, 0); __builtin_amdgcn_global_load_lds((const unsigned*)(g_ + 128), (LAS unsigned*)(d_ + 1024), 16, 0, 0); } while (0)
#define DMAV(t) do { if (mode & 8) break; const int t_ = (t) < nt ? (t) : nt - 1; const char* g_ = vgb + (size_t)KVROW(t_) * 6144 + goff; LAS unsigned char* d_ = F.lds + VB0 + ((t) & 3) * 16384 + ldsw; \
            __builtin_amdgcn_global_load_lds((const unsigned*)g_, (LAS unsigned*)d_, 16, 0, 0); __builtin_amdgcn_global_load_lds((const unsigned*)(g_ + 128), (LAS unsigned*)(d_ + 1024), 16, 0, 0); } while (0)
#define WAIT_BAR(N) do { asm volatile("s_waitcnt vmcnt(" #N ") lgkmcnt(0)" ::: "memory"); __builtin_amdgcn_s_barrier(); asm volatile("" ::: "memory"); } while (0)
#define KRD(KI_, f, S) S = *(const LAS bf16x8*)((KI_) + 8192 * ((f) & 1) + 512 * ((f) >> 2) + koff[((f) >> 1) & 1])
#define KMF(f, S, P0, P1) do { if ((f) & 1) P1 = MFMA32(S, qf[(f) >> 1], P1); else P0 = MFMA32(S, qf[(f) >> 1], P0); asm volatile("" ::: "memory"); } while (0)
#define QKT(P0, P1, t) do { LAS unsigned char* KI_ = F.lds + KB0 + ((t) & 3) * 16384; bf16x8 kA, kB, kC; \
            _Pragma("unroll") for (int q_ = 0; q_ < 16; ++q_) { P0[q_] = 0.f; P1[q_] = 0.f; } \
            KRD(KI_, 0, kA); KRD(KI_, 1, kB); \
            KRD(KI_, 2, kC); KMF(0, kA, P0, P1); KRD(KI_, 3, kA); KMF(1, kB, P0, P1); KRD(KI_, 4, kB); KMF(2, kC, P0, P1); KRD(KI_, 5, kC); KMF(3, kA, P0, P1); \
            KRD(KI_, 6, kA); KMF(4, kB, P0, P1); KRD(KI_, 7, kB); KMF(5, kC, P0, P1); KMF(6, kA, P0, P1); KMF(7, kB, P0, P1); } while (0)
#define VRD(VI_, f, S0, S1) do { S0 = __builtin_bit_cast(s16x4, __builtin_amdgcn_ds_read_tr16_b64_v4i16((LAS v4i16_t*)((VI_) + 8192 * (((f) >> 1) & 1) + 4096 * ((f) & 1) + 512 * ((f) >> 2) + trb[0]))); \
            S1 = __builtin_bit_cast(s16x4, __builtin_amdgcn_ds_read_tr16_b64_v4i16((LAS v4i16_t*)((VI_) + 8192 * (((f) >> 1) & 1) + 4096 * ((f) & 1) + 512 * ((f) >> 2) + trb[1]))); } while (0)
#define VMF(f, S0, S1, PF) do { if (!(mode & 4)) o[(f) >> 2] = MFMA32(((bf16x8){S0[0], S0[1], S0[2], S0[3], S1[0], S1[1], S1[2], S1[3]}), PF[((f) >> 1) & 1][(f) & 1], o[(f) >> 2]); asm volatile("" ::: "memory"); } while (0)
#define PVQ0(VI_, PF) do { VRD(VI_, 0, vA0, vA1); VRD(VI_, 1, vB0, vB1); VRD(VI_, 2, vC0, vC1); VMF(0, vA0, vA1, PF); VRD(VI_, 3, vA0, vA1); VMF(1, vB0, vB1, PF); VRD(VI_, 4, vB0, vB1); VMF(2, vC0, vC1, PF); VRD(VI_, 5, vC0, vC1); VMF(3, vA0, vA1, PF); } while (0)
#define PVQ1(VI_, PF) do { VRD(VI_, 6, vA0, vA1); VMF(4, vB0, vB1, PF); VRD(VI_, 7, vB0, vB1); VMF(5, vC0, vC1, PF); VRD(VI_, 8, vC0, vC1); VMF(6, vA0, vA1, PF); VRD(VI_, 9, vA0, vA1); VMF(7, vB0, vB1, PF); } while (0)
#define PVQ2(VI_, PF) do { VRD(VI_, 10, vB0, vB1); VMF(8, vC0, vC1, PF); VRD(VI_, 11, vC0, vC1); VMF(9, vA0, vA1, PF); VRD(VI_, 12, vA0, vA1); VMF(10, vB0, vB1, PF); VRD(VI_, 13, vB0, vB1); VMF(11, vC0, vC1, PF); } while (0)
#define PVQ3(VI_, PF) do { VRD(VI_, 14, vC0, vC1); VMF(12, vA0, vA1, PF); VRD(VI_, 15, vA0, vA1); VMF(13, vB0, vB1, PF); VMF(14, vC0, vC1, PF); VMF(15, vA0, vA1, PF); } while (0)
#define PVT(t, PF) do { LAS unsigned char* VI_ = F.lds + VB0 + ((t) & 3) * 16384; PVQ0(VI_, PF); PVQ1(VI_, PF); PVQ2(VI_, PF); PVQ3(VI_, PF); } while (0)
#define SM_MAX() do { float mx_ = fmaxf(c0[0], c1[0]); _Pragma("unroll") for (int q_ = 1; q_ < 16; ++q_) mx_ = fmaxf(mx_, fmaxf(c0[q_], c1[q_])); \
            mx_ = fmaxf(mx_, __shfl_xor(mx_, 32)); const float mn_ = (mx_ - mref > ATT_THR) ? mx_ : mref; al = __builtin_amdgcn_exp2f(mref - mn_); mref = mn_; ps = 0.f; } while (0)
#define SM_EXP(C, B, DST) do { if (!(mode & 2)) { _Pragma("unroll") for (int q_ = 0; q_ < 8; ++q_) { C[(B) + q_] = __builtin_amdgcn_exp2f(C[(B) + q_] - mref); ps += C[(B) + q_]; } } DST = PACK8(C, B); } while (0)
#define RESC(al) do { if (__any((al) < 1.f)) { _Pragma("unroll") for (int i = 0; i < 4; ++i) _Pragma("unroll") for (int q_ = 0; q_ < 16; ++q_) o[i][q_] *= (al); } } while (0)
#define SBAR() __builtin_amdgcn_sched_barrier(0)
#define ATT_STEP(j, PFC, PFP) do { \
            WAIT_BAR(8); DMAK((j) + 3); DMAV((j) + 2); \
            SBAR(); QKT(c0, c1, j); SBAR(); \
            { LAS unsigned char* VI_ = F.lds + VB0 + (((j) - 1) & 3) * 16384; \
              PVQ0(VI_, PFP); SM_MAX(); SBAR(); \
              PVQ1(VI_, PFP); SM_EXP(c0, 0, PFC[0][0]); SM_EXP(c0, 8, PFC[0][1]); SBAR(); \
              PVQ2(VI_, PFP); SM_EXP(c1, 0, PFC[1][0]); SBAR(); \
              PVQ3(VI_, PFP); SM_EXP(c1, 8, PFC[1][1]); l = l * al + ps; SBAR(); } \
            RESC(al); } while (0)
        s16x4 vA0, vA1, vB0, vB1, vC0, vC1;
        f32x16 o[4];
#pragma unroll
        for (int i = 0; i < 4; ++i)
#pragma unroll
            for (int q = 0; q < 16; ++q) o[i][q] = 0.f;
        float mref = -1e30f, l = 0.f, al = 1.f, ps = 0.f;
        f32x16 c0, c1; bf16x8 pfA[2][2], pfB[2][2];
        DMAK(0); DMAV(0); DMAK(1); DMAV(1); DMAK(2);
        WAIT_BAR(6); DMAK(3); DMAV(2);
        QKT(c0, c1, 0); SM_MAX(); SM_EXP(c0, 0, pfA[0][0]); SM_EXP(c0, 8, pfA[0][1]); SM_EXP(c1, 0, pfA[1][0]); SM_EXP(c1, 8, pfA[1][1]); l = l * al + ps;
        for (int j = 1; j + 1 < nt; j += 2) {
            ATT_STEP(j, pfB, pfA);
            ATT_STEP(j + 1, pfA, pfB);
        }
        ATT_STEP(nt - 1, pfB, pfA);
        WAIT_BAR(0);
        PVT(nt - 1, pfB);
        WAIT_BAR(0);
#undef DMAK
#undef DMAV
#undef WAIT_BAR
#undef QKT
#undef PVT
#undef PVQ0
#undef PVQ1
#undef PVQ2
#undef PVQ3
#undef VRD
#undef VMF
#undef KRD
#undef KMF
#undef SM_MAX
#undef SM_EXP
#undef RESC
#undef SBAR
#undef ATT_STEP
#undef KVROW
        l += __shfl_xor(l, 32);
        const float f = (m == 1 ? lmb : 1.0f) / l;
        LAS float* ex = EX + (size_t)m * 128 * 129 + (qs * 32 + r) * 129;
#pragma unroll
        for (int i = 0; i < 4; ++i)
#pragma unroll
            for (int q = 0; q < 16; ++q) ex[32 * i + crow(q, hi)] = o[i][q] * f;
        __syncthreads();
#pragma unroll 1
        for (int rr = 0; rr < 16; ++rr) { const int row = 16 * F.wave + rr;
            const float a0 = EX[row * 129 + F.lane] - EX[128 * 129 + row * 129 + F.lane], a1 = EX[row * 129 + 64 + F.lane] - EX[128 * 129 + row * 129 + 64 + F.lane];
            const float rstd = (1.0f - LAMBDA_INIT) / sqrtf(wave_sum(a0 * a0 + a1 * a1) * (1.f / 128.f) + EPS);
            bf16* yr = Y + (size_t)(qrow0 + row) * D + h * 128;
            if (!(mode & 1)) { yr[F.lane] = (bf16)(pk2(a0 * rstd * ng[F.lane], 0.f) & 0xffffu); yr[64 + F.lane] = (bf16)(pk2(a1 * rstd * ng[64 + F.lane], 0.f) & 0xffffu); } }
        __syncthreads();
    }
}

#define XB_TMO      128
#define XB_XCNT(j)  (256  + 64 * (j))
#define XB_XSUB(j)  (1280 + 64 * (j))
#define XB_XGEN(j)  (2304 + 64 * (j))
#define XB_TOP      3328
#define XB_TOPGEN   3392
#define XCD_BAR_WORDS 3456
#define XB_SPIN_CAP (1u << 18)

__device__ __forceinline__ unsigned xb_ld(unsigned* p)              { return __hip_atomic_load(p, __ATOMIC_RELAXED, __HIP_MEMORY_SCOPE_AGENT); }
__device__ __forceinline__ unsigned xb_add(unsigned* p, unsigned v) { return __hip_atomic_fetch_add(p, v, __ATOMIC_RELAXED, __HIP_MEMORY_SCOPE_AGENT); }
__device__ __forceinline__ unsigned xb_xcc_id() { return (unsigned)__builtin_amdgcn_s_getreg((3 << 11) | 20) & 0xFu; }
#define XB_SPIN(cond, bar) do { unsigned _sp = 0; while (cond) { __builtin_amdgcn_s_sleep(1); \
    if ((++_sp & 255u) == 0u) { if (xb_ld(&(bar)[XB_TMO])) break; if (_sp > XB_SPIN_CAP) { atomicAdd(&(bar)[XB_TMO], 1u); break; } } } } while (0)

struct XcdBarrier {
    unsigned* bar; unsigned x;
    volatile LAS unsigned* st;
};

__device__ __forceinline__ XcdBarrier xcd_barrier_post(unsigned* bar, volatile LAS unsigned* st) {
    XcdBarrier b; b.bar = bar; b.x = xb_xcc_id(); b.st = st;
    if (threadIdx.x == 0) (void)xb_add(&bar[XB_XCNT(b.x)], 1u);
    return b;
}
__device__ __forceinline__ void xcd_barrier_complete(unsigned* bar, unsigned x, unsigned& nloc, unsigned& nx) {
    const unsigned G = gridDim.x * gridDim.y * gridDim.z;
    unsigned sum, cnt, mine, sp = 0u;
    for (;;) {
        sum = 0u; cnt = 0u; mine = 0u;
#pragma unroll
        for (unsigned j = 0; j < 16; ++j) { const unsigned c = xb_ld(&bar[XB_XCNT(j)]); sum += c; cnt += (c > 0u) ? 1u : 0u; mine = (j == x) ? c : mine; }
        if (sum == G) break;
        __builtin_amdgcn_s_sleep(1);
        if ((++sp & 255u) == 0u) { if (xb_ld(&bar[XB_TMO])) break; if (sp > XB_SPIN_CAP) { atomicAdd(&bar[XB_TMO], 1u); break; } }
    }
    nloc = mine > 0u ? mine : 1u; nx = cnt > 0u ? cnt : 1u;
}

__device__ __forceinline__ void xcd_barrier(const XcdBarrier& b) {
    asm volatile("s_waitcnt vmcnt(0)" ::: "memory");
    __syncthreads();
    if (threadIdx.x == 0) {
        unsigned* bar = b.bar;
        __builtin_amdgcn_s_waitcnt(0);
        unsigned nloc = b.st[0], nx = b.st[1];
        if (nloc == 0u) { xcd_barrier_complete(bar, b.x, nloc, nx); b.st[0] = nloc; b.st[1] = nx; }
        const unsigned old = xb_add(&bar[XB_XSUB(b.x)], 1u);
        const unsigned gen = old / nloc;
        if (old + 1u == (gen + 1u) * nloc) {
            __builtin_amdgcn_fence(__ATOMIC_RELEASE, "agent");
            asm volatile("s_waitcnt vmcnt(0)" ::: "memory");
            const unsigned og = xb_add(&bar[XB_TOP], 1u);
            const unsigned tg = og / nx;
            if (og + 1u == (tg + 1u) * nx) xb_add(&bar[XB_TOPGEN], 1u);
            else XB_SPIN(xb_ld(&bar[XB_TOPGEN]) == tg, bar);
            __builtin_amdgcn_fence(__ATOMIC_ACQUIRE, "agent");
            xb_add(&bar[XB_XGEN(b.x)], 1u);
            asm volatile("s_waitcnt vmcnt(0)" ::: "memory");
        } else {
            XB_SPIN(xb_ld(&bar[XB_XGEN(b.x)]) == gen, bar);
            __builtin_amdgcn_fence(__ATOMIC_ACQUIRE, "agent");
            asm volatile("s_waitcnt vmcnt(0)" ::: "memory");
        }
    }
    __syncthreads();
}

#ifndef SCAN_MODE
#define SCAN_MODE 0
#endif
#ifndef PREP_SKIP
#define PREP_SKIP 0
#endif
#ifndef MK_SINGLE
#define MK_SINGLE 1
#endif
constexpr int NSTEPS = 28;
struct SEpiStore { bf16* O; int ldc; int act; bf16* halo; const float* SS; const float* bias; float qscale;
    __device__ __forceinline__ void operator()(const float (&v4)[4], int m, int n0, int hi, int g) const {
        const float rs = SS ? 1.0f / sqrtf(pg8::ss_dec(SS, m) * (1.0f / 1024.0f) + 1e-6f) : 1.0f;
        const int n = n0 + 8 * g + 4 * hi; const f32x4 bv = SS ? *(const f32x4*)(bias + n) : (f32x4){0.f, 0.f, 0.f, 0.f}; float v[4];
#pragma unroll
        for (int i = 0; i < 4; ++i) { v[i] = v4[i] * rs + bv[i]; if (act == 1) { const float t = fmaxf(v[i], 0.f); v[i] = t * t; } if (act == 2 && n < 1024) v[i] *= qscale; }
        const u32x2 w = (u32x2){pk2(v[0], v[1]), pk2(v[2], v[3])};
        *(u32x2*)(O + (size_t)m * ldc + n) = w;
        if (halo && n < 3072 && (((m & 63) == 0) || ((m & 63) == 63))) *(u32x2*)(halo + ((size_t)(m >> 6) * 2 + ((m & 63) ? 1 : 0)) * 3072 + n) = w; } };
struct SEpiResid { void* X; const void* Xin; const float* gate; bf16* Hn; const float* cv; float* SSo; int in_f32;
    __device__ __forceinline__ void operator()(const float (&v4)[4], int m, int n0, int hi, int g) const {
        const int n = n0 + 8 * g + 4 * hi; const size_t off = (size_t)m * D + n; const f32x4 gv = *(const f32x4*)(gate + n);
        f32x4 xi; if (in_f32) xi = *(const f32x4*)((const float*)Xin + off); else { const u32x2 w = *(const u32x2*)((const bf16*)Xin + off); xi = (f32x4){pg8::bf_lo(w.x), pg8::bf_hi(w.x), pg8::bf_lo(w.y), pg8::bf_hi(w.y)}; }
        const f32x4 v_ = xi + gv * (f32x4){v4[0], v4[1], v4[2], v4[3]};
        *(u32x2*)((bf16*)X + off) = (u32x2){pk2(v_[0], v_[1]), pk2(v_[2], v_[3])};
        if (Hn) { float ss = (v_[0] * v_[0] + v_[1] * v_[1]) + (v_[2] * v_[2] + v_[3] * v_[3]); const f32x4 h_ = v_ * *(const f32x4*)(cv + n);
            *(u32x2*)(Hn + off) = (u32x2){pk2(h_[0], h_[1]), pk2(h_[2], h_[3])};
            ss += __shfl_xor(ss, 32); if (hi == 0) atomicAdd((unsigned*)SSo + m, pg8::ss_enc(ss)); } } };
struct SEpiAB { float* AB; const float* SS; const float* bias; int bstride;
    __device__ __forceinline__ void operator()(const float (&v4)[4], int m, int n0, int hi, int g) const {
        if (n0 == 0) { const float rs = 1.0f / sqrtf(pg8::ss_dec(SS, m) * (1.0f / 1024.0f) + 1e-6f); const int n = 8 * g + 4 * hi;
            const f32x4 bv = *(const f32x4*)(bias + (size_t)(m < T ? 0 : (m < ML ? 1 : 2)) * bstride + 4096 + n);
            *(f32x4*)(AB + (size_t)m * 32 + n) = (f32x4){v4[0], v4[1], v4[2], v4[3]} * rs + bv; } } };
template <class Epi> __device__ __forceinline__ void small_gemm(const bf16* A, const bf16* Bt, int row_lo, int nrows, int N, int K, const Epi& E, int lda = 0) {
    if (lda == 0) lda = K;
    int tid = threadIdx.x; asm volatile("" : "+v"(tid));
    const int lane = tid & 63, wave = __builtin_amdgcn_readfirstlane(tid >> 6), r = lane & 31, hi = lane >> 5, lrow = lane >> 3, lch = lane & 7;
    int G_ = gridDim.x, B_ = blockIdx.x; asm volatile("" : "+s"(G_), "+s"(B_));
    LAS unsigned char* stg = (LAS unsigned char*)lds_raw + wave * 13824;
    LAS float* red = (LAS float*)lds_raw;
    const int tn = N / 64, items = (nrows / 32) * tn, kw = K / 8, nch = kw / 64;
    const size_t rstep = (size_t)8 * K * 2, rstepA = (size_t)8 * lda * 2;
    u32x4 ra[8], rb[16];
#define SG_PTRS(it_) const int mi_ = (it_) / tn, ni_ = (it_) % tn; \
        ag = (const char*)(A + (size_t)(row_lo + 32 * mi_ + lrow) * lda + wave * kw + lch * 8); bg = (const char*)(Bt + (size_t)(64 * ni_ + lrow) * K + wave * kw + lch * 8)
#define SG_LOAD_PAIR(c) do { _Pragma("unroll") for (int i = 0; i < 4; ++i) ra[i] = *(const u32x4*)(ag + i * rstepA + (c) * 128); _Pragma("unroll") for (int i = 0; i < 8; ++i) rb[i] = *(const u32x4*)(bg + i * rstep + (c) * 128); \
        if ((c) + 1 < nch) { _Pragma("unroll") for (int i = 0; i < 4; ++i) ra[4 + i] = *(const u32x4*)(ag + i * rstepA + ((c) + 1) * 128); _Pragma("unroll") for (int i = 0; i < 8; ++i) rb[8 + i] = *(const u32x4*)(bg + i * rstep + ((c) + 1) * 128); } } while (0)
#define SG_HALF(h_) do { _Pragma("unroll") for (int i = 0; i < 4; ++i) *(LAS u32x4*)(stg + (lrow + 8 * i) * 144 + lch * 16) = ra[4 * (h_) + i]; \
        _Pragma("unroll") for (int i = 0; i < 8; ++i) *(LAS u32x4*)(stg + (32 + lrow + 8 * i) * 144 + lch * 16) = rb[8 * (h_) + i]; } while (0)
#define SG_MMA() do { _Pragma("unroll") for (int ks = 0; ks < 4; ++ks) { const bf16x8 a = *(const LAS bf16x8*)(stg + r * 144 + ks * 32 + hi * 16); \
        const bf16x8 b0 = *(const LAS bf16x8*)(stg + (32 + r) * 144 + ks * 32 + hi * 16), b1 = *(const LAS bf16x8*)(stg + (64 + r) * 144 + ks * 32 + hi * 16); \
        acc[0] = __builtin_amdgcn_mfma_f32_32x32x16_bf16(b0, a, acc[0], 0, 0, 0); acc[1] = __builtin_amdgcn_mfma_f32_32x32x16_bf16(b1, a, acc[1], 0, 0, 0); } } while (0)
    const char* ag = nullptr; const char* bg = nullptr;
    if (B_ < items) { SG_PTRS(B_); SG_LOAD_PAIR(0); }
    for (int it = B_; it < items; it += G_) {
        const int mi = it / tn, ni = it % tn;
        f32x16 acc[2];
#pragma unroll
        for (int x = 0; x < 2; ++x)
#pragma unroll
            for (int i = 0; i < 16; ++i) acc[x][i] = 0.f;
        for (int c = 0; c < nch; c += 2) {
            SG_HALF(0); SG_MMA();
            asm volatile("" ::: "memory");
            const bool two = c + 1 < nch;
            u32x4 ta[4], tb[8];
#pragma unroll
            for (int i = 0; i < 4; ++i) ta[i] = ra[4 + i];
#pragma unroll
            for (int i = 0; i < 8; ++i) tb[i] = rb[8 + i];
            if (c + 2 < nch) SG_LOAD_PAIR(c + 2);
            else if (it + G_ < items) { SG_PTRS(it + G_); SG_LOAD_PAIR(0); }
            if (two) {
#pragma unroll
                for (int i = 0; i < 4; ++i) *(LAS u32x4*)(stg + (lrow + 8 * i) * 144 + lch * 16) = ta[i];
#pragma unroll
                for (int i = 0; i < 8; ++i) *(LAS u32x4*)(stg + (32 + lrow + 8 * i) * 144 + lch * 16) = tb[i];
                SG_MMA(); }
            asm volatile("" ::: "memory");
        }
        __syncthreads();
#pragma unroll
        for (int x = 0; x < 2; ++x)
#pragma unroll
            for (int i = 0; i < 16; ++i) red[((wave * 2 + x) * 16 + i) * 64 + lane] = acc[x][i];
        __syncthreads();
        { const int tile = wave >> 2, g = wave & 3; float v4[4];
#pragma unroll
            for (int i = 0; i < 4; ++i) { float s = 0.f;
#pragma unroll
                for (int w = 0; w < 8; ++w) s += red[((w * 2 + tile) * 16 + 4 * g + i) * 64 + lane];
                v4[i] = s; }
            E(v4, row_lo + 32 * mi + r, 64 * ni + 32 * tile, hi, g); }
        __syncthreads();
    }
#undef SG_PTRS
#undef SG_LOAD_PAIR
#undef SG_HALF
#undef SG_MMA
}
template <int ACT> __device__ __forceinline__ void gemm_store(const bf16* A, const bf16* Bt, bool ctx, int N, int K, bf16* O, int ldc, bf16* halo, const float* SS, const float* bias, int bstride) {
    { int G_ = gridDim.x, B_ = blockIdx.x; asm volatile("" : "+s"(G_), "+s"(B_));
      pg8::Gemm g{A, Bt, ML, N, K, K, K}; pg8::StaticOrder S; S.init(ML, N, G_, B_);
      pg8::EpiStore<ACT> E{SS, bias, bstride, O, ldc, nullptr, -1, halo, ACT == 2 ? (const float*)(kargs()->ws + WS_ROPE) : nullptr, QSCALE};
      pg8::gemm_phase<pg8::EpiStore<ACT>, pg8::StaticOrder, true, true>((LAS unsigned char*)lds_raw, g, S, E); }
    if (ctx) { SEpiStore E2{O, ldc, ACT, halo, SS, bias + 2 * (size_t)bstride, QSCALE}; small_gemm(A, Bt, ML, MC, N, K, E2); }
}
#ifdef TIME_SUB
__device__ unsigned long long g_diag = 0ull;
#endif
__device__ __forceinline__ void gemm_resid(const bf16* A, const bf16* Bt, bool ctx, int K, bf16* X, const float* gate, bool from_inputs, bf16* Hn, const float* cv, float* SSo, int lda = 0, float* Xf32 = nullptr) {
    if (lda == 0) lda = K;
    const void* XinL = from_inputs ? (const void*)INP(I_X) : (const void*)X; const void* XinC = from_inputs ? (const void*)(INP(I_CTX) - (size_t)ML * D) : (const void*)X;
    { int G_ = gridDim.x, B_ = blockIdx.x; asm volatile("" : "+s"(G_), "+s"(B_));
      pg8::Gemm g{A, Bt, ML, D, K, lda, K}; pg8::StaticOrder S; S.init(ML, D, G_, B_);
      pg8::EpiResid E{Hn, cv, D, SSo, Xf32 ? (void*)Xf32 : (void*)X, XinL, D, gate, NADA, 0, from_inputs ? 1 : 0, Xf32 ? 1 : 0};
      pg8::gemm_phase<pg8::EpiResid, pg8::StaticOrder, true, true>((LAS unsigned char*)lds_raw, g, S, E); }
#ifdef TIME_SUB
    const unsigned long long td0 = __builtin_amdgcn_s_memrealtime();
#endif
    if (ctx) { SEpiResid E2{X, XinC, gate + 2 * NADA, Hn, cv + 2 * D, SSo, from_inputs ? 1 : 0}; small_gemm(A, Bt, ML, MC, D, K, E2, lda); }
#ifdef TIME_SUB
    if (K == TIME_SUB && blockIdx.x == 0 && threadIdx.x == 0) g_diag += __builtin_amdgcn_s_memrealtime() - td0;
#endif
}
__device__ __forceinline__ void gemm_gdn_in(unsigned char* ws, int layer, int jj) {
    const float* SS = (const float*)(ws + WS_CTL + CTL_SS) + (size_t)(layer * 2) * M; const float* bin = (const float*)(ws + WS_BIAS) + (size_t)layer * 3 * 4352;
    const bf16* Wt = (const bf16*)(ws + WS_GINT) + (size_t)jj * GDN_NP * D;
    gemm_store<0>((const bf16*)(ws + WS_H), Wt, true, 4096, D, (bf16*)(ws + WS_Z), 4096, (bf16*)(ws + WS_HALO), SS, bin, 4352);
    SEpiAB E3{(float*)(ws + WS_AB), SS, bin, 4352}; small_gemm((const bf16*)(ws + WS_H), Wt + (size_t)4096 * D, 0, M, 64, D, E3);
}
__global__ void __launch_bounds__(NTHR, 2) fwd_kernel(Args a) {
    unsigned char* ws = a.ws;
    const int lo = a.step_lo, hi = a.step_hi; const bool coop = a.coop != 0;
    volatile LAS unsigned* bst = (volatile LAS unsigned*)((LAS unsigned char*)lds_raw + LDS_BYTES - 64);
    if (threadIdx.x < 2) bst[threadIdx.x] = 0u;
    __syncthreads();
    XcdBarrier bar; bar.bar = (unsigned*)(ws + WS_CTL) + 4096; bar.x = 0; bar.st = bst;
    if (coop) bar = xcd_barrier_post((unsigned*)(ws + WS_CTL) + 4096, bst);
#ifndef TIME_LO
#define TIME_LO -1
#define TIME_SCALE 1e-4f
#define TIME_HI -1
#endif
    unsigned long long t_acc = 0ull, t_0 = 0ull;
#ifdef TIME_MID
    unsigned long long t_mid = 0ull;
#define TIME_MID_STAMP(k, id) do { if ((k) == TIME_LO && (id) == TIME_MID) t_mid = __builtin_amdgcn_s_memrealtime() - t_0; } while (0)
#else
#define TIME_MID_STAMP(k, id) do { } while (0)
#endif
#ifndef TIME_BLK
#define TIME_BLK 0
#endif
#define PHASE(k, body) do { if (lo <= (k) && (k) < hi) { __syncthreads(); if ((k) == TIME_LO) t_0 = __builtin_amdgcn_s_memrealtime(); body; if ((k) + 1 < hi && coop) { xcd_barrier(bar); } \
        if ((k) == TIME_HI) t_acc = __builtin_amdgcn_s_memrealtime() - t_0; } } while (0)
#define WB(off) ((bf16*)(ws + (off)))
#define MODP(layer, which) ((const float*)(ws + WS_MOD) + (size_t)(layer) * 3 * NADA + (which) * D)
#define CVP(layer, which) ((const float*)(ws + WS_CV) + (size_t)((layer) * 2 + (which)) * 3 * D)
#define SSP(layer, which) ((float*)(ws + WS_CTL + CTL_SS) + (size_t)((layer) * 2 + (which)) * M)
#define BIN(layer) ((const float*)(ws + WS_BIAS) + (size_t)(layer) * 3 * 4352)
#define BUP(layer) ((const float*)(ws + WS_BIAS) + (size_t)DEPTH * 3 * 4352 + (size_t)(layer) * 3 * FF)
#define TAIL(k0, layer, YA, YLD, WoutT, CTX) \
    PHASE((k0), gemm_resid((YA), (WoutT), (CTX), D, WB(WS_X), MODP(layer, 2), (layer) == 0, WB(WS_H), CVP(layer, 1), SSP(layer, 1), (YLD))); \
    PHASE((k0) + 1, gemm_store<1>(WB(WS_H), WB(WS_W1T) + (size_t)(layer) * D * FF, (CTX), FF, D, WB(WS_Z), FF, nullptr, SSP(layer, 1), BUP(layer), FF)); \
    PHASE((k0) + 2, gemm_resid(WB(WS_Z), WB(WS_W2T) + (size_t)(layer) * D * FF, (CTX), FF, WB(WS_X), MODP(layer, 5), false, \
                               (layer) + 1 < DEPTH ? WB(WS_H) : nullptr, CVP((layer) + 1 < DEPTH ? (layer) + 1 : 0, 0), SSP((layer) + 1 < DEPTH ? (layer) + 1 : 0, 0)))
#define LAYER_GDN(k0, layer, jj, CTX, conv) \
    PHASE((k0), gemm_gdn_in(ws, layer, jj)); \
    if (lo <= (k0) + 1 && (k0) + 1 < hi && !(coop && gridDim.x == 256)) { __syncthreads(); step_gdn_prep(jj, false, nullptr); if ((k0) + 2 < hi && coop) xcd_barrier(bar); } \
    PHASE((k0) + 2, { unsigned* fl_ = (unsigned*)(ws + WS_CTL) + 16384 + (jj) * 4096; \
        if (coop && gridDim.x == 256) { step_gdn_scan2(fl_, SCAN_MODE); TIME_MID_STAMP((k0) + 2, 1); step_gdn_prep(jj, true, fl_, false, PREP_SKIP); TIME_MID_STAMP((k0) + 2, 2); } else step_gdn_scan2(nullptr); \
        if (conv) { step_convert_rest(); TIME_MID_STAMP((k0) + 2, 3); step_bias(65, DEPTH * 129, gridDim.x > 32 ? 32 : 0); TIME_MID_STAMP((k0) + 2, 4); } \
        if (coop && gridDim.x == 256) step_gdn_follow(jj, fl_); TIME_MID_STAMP((k0) + 2, 5); }); \
    if (!(coop && gridDim.x == 256)) PHASE((k0) + 3, step_gdn_norm2(jj)); \
    TAIL((k0) + 4, layer, WB(WS_Z), 4096, WB(WS_GOUTT) + (size_t)(jj) * D * D, CTX)
    PHASE(0, step_prologue());
    PHASE(1, { step_norm0(); step_bias(0, 65, 0); });
    LAYER_GDN(2, 0, 0, true, true);
    PHASE(9, gemm_store<0>(WB(WS_H), WB(WS_SINT), true, 3 * D, D, WB(WS_Z), 3 * D, nullptr, SSP(1, 0), BIN(1), 4352));
    PHASE(10, step_sconv());
    TAIL(11, 1, WB(WS_Y), D, WB(WS_SOUTT), true);
    PHASE(14, gemm_store<2>(WB(WS_H), WB(WS_DINT), true, 3 * D, D, WB(WS_Z), 3 * D, nullptr, SSP(2, 0), BIN(2), 4352));
#ifdef BAR_PROBE
    PHASE(15, {});
#endif
    PHASE(16, step_attn2());
    TAIL(17, 2, WB(WS_Y), D, WB(WS_DOUTT), true);
    LAYER_GDN(20, 3, 1, false, false);
    PHASE(27, step_final());
#ifdef TIME_SUB
    if (blockIdx.x == 0 && threadIdx.x == 0) { __threadfence(); a.out[0] += (float)g_diag * 1e-3f; g_diag = 0ull; }
#endif
#if defined(SCAN_PROF) || defined(PREP_PROF)
    if (blockIdx.x == 0 && threadIdx.x == 0) { __threadfence(); a.out[0] += (float)__hip_atomic_load(&g_scanprof, __ATOMIC_RELAXED, __HIP_MEMORY_SCOPE_AGENT) * 1e-4f; g_scanprof = 0ull; }
#endif
#ifdef PROBE_ZERO
    if (coop) { xcd_barrier(bar); for (size_t i = (size_t)blockIdx.x * NTHR + threadIdx.x; i < (size_t)ML * D / 4; i += (size_t)gridDim.x * NTHR) ((f32x4*)a.out)[i] = (f32x4){16.f, 16.f, 16.f, 16.f}; xcd_barrier(bar); }
    if (TIME_LO >= 0 && blockIdx.x == 0 && threadIdx.x == 0) { a.out[0] = (float)t_acc * TIME_SCALE; }
#else
#ifdef TIME_MID
    t_acc = t_mid;
#endif
    if (TIME_LO >= 0 && blockIdx.x == TIME_BLK && threadIdx.x == 0) { __threadfence(); a.out[0] += (float)t_acc * TIME_SCALE; }
#endif
}

extern "C" void kernel_launch(void* const* d_in, const int* in_sizes, int n_in, void* d_out, int out_size, void* d_ws, size_t ws_size, hipStream_t stream) {
    static int grid = 0;
    if (grid == 0) {
        if (n_in != 24 || out_size != ML * D || ws_size < WS_END) { fprintf(stderr, "kernel_launch: unexpected problem (n_in %d, out %d, ws %zu); nothing launched\n", n_in, out_size, ws_size); grid = -1; return; }
        int dev = 0, cus = 0, per_cu = 0;
        if (hipGetDevice(&dev) != hipSuccess || hipDeviceGetAttribute(&cus, hipDeviceAttributeMultiprocessorCount, dev) != hipSuccess) { grid = -1; return; }
        if (hipFuncSetAttribute((const void*)fwd_kernel, hipFuncAttributeMaxDynamicSharedMemorySize, LDS_BYTES) != hipSuccess) { fprintf(stderr, "kernel_launch: hipFuncSetAttribute failed\n"); grid = -1; return; }
        if (hipOccupancyMaxActiveBlocksPerMultiprocessor(&per_cu, (const void*)fwd_kernel, NTHR, LDS_BYTES) != hipSuccess || per_cu < 1) { fprintf(stderr, "kernel_launch: occupancy query says %d blocks per CU\n", per_cu); (void)hipGetLastError(); per_cu = 1; }
        grid = cus;
        fprintf(stderr, "kernel_launch: %d CUs, occupancy %d per CU, grid %d\n", cus, per_cu, grid);
    }
    if (grid < 0) return;
    (void)hipMemsetAsync((char*)d_ws + WS_CTL, 0, CTL_ZERO_BYTES, stream);
    Args a{};
    for (int i = 0; i < 24; ++i) a.in[i] = (const float*)d_in[i];
    a.out = (float*)d_out; a.ws = (unsigned char*)d_ws;
#if MK_SINGLE
    a.step_lo = 0; a.step_hi = NSTEPS; a.coop = 1;
    void* args[] = {&a};
    hipError_t e = hipLaunchCooperativeKernel((const void*)fwd_kernel, dim3(grid), dim3(NTHR), args, LDS_BYTES, stream);
    if (e != hipSuccess) fprintf(stderr, "cooperative launch failed: %s (grid %d)\n", hipGetErrorString(e), grid);
#else
    for (int s = 0; s < NSTEPS; ++s) { a.step_lo = s; a.step_hi = s + 1; a.coop = 0; hipLaunchKernelGGL(fwd_kernel, dim3(grid), dim3(NTHR), LDS_BYTES, stream, a); }
#endif
}
```

```cpp
#include <hip/hip_runtime.h>
#include <hip/hip_cooperative_groups.h>
#include <cstdio>
#include <cstdint>
namespace cg = cooperative_groups;
namespace pg8 {
#define PG8_LAS __attribute__((address_space(3)))
typedef unsigned short bf16_t;
typedef short bf16x8 __attribute__((ext_vector_type(8)));
typedef float f32x4 __attribute__((ext_vector_type(4)));
typedef unsigned u32x4 __attribute__((ext_vector_type(4)));
constexpr int BM = 256, BK = 64, HALF = 128, HTB = HALF * BK * 2  , STAGE_BYTES = 8 * HTB, NXCD = 8, WGM = 8;

__host__ __device__ __forceinline__ int lds_byte(int r, int c) { const int st = (r >> 4) * 2 + (c >> 5), rr = r & 15, cc = c & 31, ob = rr * 64 + cc * 2; return st * 1024 + (ob ^ (((ob >> 9) & 1) << 5)); }
__host__ __device__ __forceinline__ void stage_rc(int b, int& R, int& C) { const int st = b / 1024, sb = b % 1024, swz = sb ^ (((sb >> 9) & 1) << 5); R = (st >> 1) * 16 + swz / 64; C = (st & 1) * 32 + (swz % 64) / 2; }
__host__ __device__ __forceinline__ int perm32(int rho) { const int n = rho >> 4, i = rho & 15; return 8 * (i >> 2) + 4 * n + (i & 3); }

struct Unit { int pm, pn; };
struct Gemm { const bf16_t* A; const bf16_t* Bt; int M, N, K, lda, ldb; };

struct StaticOrder {
    int nM, nN, nwg, G, c;
    __host__ __device__ void init(int M, int N, int G_, int c_) { nM = M / BM; nN = N / BM; nwg = nM * nN; G = G_; c = c_; }
    __host__ __device__ bool next(int i, Unit& u) const {
        const long L = (long)i * G + c; if (L >= nwg) return false;
        int wgid = (int)L; { const int q = nwg / NXCD, r = nwg % NXCD, xcd = wgid % NXCD, off = wgid / NXCD; wgid = (xcd < r ? xcd * (q + 1) : r * (q + 1) + (xcd - r) * q) + off; }
        const int nig = WGM * nN, gid = wgid / nig, fm = gid * WGM, gsz = (nM - fm) < WGM ? (nM - fm) : WGM;
        u.pm = fm + ((wgid % nig) % gsz); u.pn = (wgid % nig) / gsz; return true;
    }
    __device__ __forceinline__ void a_ready(const Unit&) const {}
    __device__ __forceinline__ void done(const Unit&) const {}
};

typedef float f32x2 __attribute__((ext_vector_type(2)));
typedef __bf16 bf16x2_t __attribute__((ext_vector_type(2)));
typedef unsigned u32x2 __attribute__((ext_vector_type(2)));
__device__ __forceinline__ unsigned ss_enc(float s) { return (unsigned)(s * 1024.0f + 0.5f); }
__device__ __forceinline__ float ss_dec(const float* SS, int row) { return (float)((const unsigned*)SS)[row] * (1.0f / 1024.0f); }
__device__ __forceinline__ unsigned cvt_pk_bf16(float lo, float hi) { f32x2 v = {lo, hi}; bf16x2_t b = __builtin_convertvector(v, bf16x2_t); return __builtin_bit_cast(unsigned, b); }

template <int ACT> struct EpiStore {
    static constexpr bool PERM = true, AFTER_DRAIN = false;
    const float* SS; const float* bias; int bstride;
    bf16_t* O; int ldc; float* AB; int ab_tile; bf16_t* halo;
    const float* rope; float qscale;
    __device__ __forceinline__ void operator()(const f32x4 (&acc)[2][2][4][2], const Unit& u, int wr, int wc, int fr, int fq) const {
        const int row0 = u.pm * BM + wr * 64 + fr;
        if (u.pn == ab_tile) {
            if (wc == 0) {
#pragma unroll
                for (int ai = 0; ai < 2; ++ai)
#pragma unroll
                    for (int m = 0; m < 4; ++m) { float* p = AB + (size_t)(row0 + ai * HALF + m * 16) * 32 + 8 * fq; *(f32x4*)p = acc[ai][0][m][0]; *(f32x4*)(p + 4) = acc[ai][0][m][1]; }
            }
            return;
        }
        const int col0 = u.pn * BM + wc * 32 + 8 * fq;
        f32x4 bv[2][2];
#pragma unroll
        for (int bj = 0; bj < 2; ++bj)
#pragma unroll
            for (int n = 0; n < 2; ++n) bv[bj][n] = SS ? *(const f32x4*)(bias + (size_t)(u.pm < 32 ? 0 : (u.pm < 64 ? 1 : 2)) * bstride + col0 + bj * HALF + 4 * n) : (f32x4){0.f, 0.f, 0.f, 0.f};
#pragma unroll
        for (int ai = 0; ai < 2; ++ai)
#pragma unroll
            for (int m = 0; m < 4; ++m) { const int row = row0 + ai * HALF + m * 16; bf16_t* rowp = O + (size_t)row * ldc + col0;
                const float rs = SS ? 1.0f / sqrtf(ss_dec(SS, row) * (1.0f / 1024.0f) + 1e-6f) : 1.0f;
                f32x4 c0 = {1.f, 0.f, 1.f, 0.f}, c1 = c0; float qs = 1.f;
                if constexpr (ACT == 2) { if (u.pn < 8) { const f32x4* tab = (const f32x4*)rope + (size_t)(row & 8191) * 16 + (wc & 1) * 8 + 2 * fq; c0 = tab[0]; c1 = tab[1]; qs = u.pn < 4 ? qscale : 1.f; } }
#pragma unroll
                for (int bj = 0; bj < 2; ++bj) { f32x4 v0 = acc[ai][bj][m][0] * rs + bv[bj][0], v1 = acc[ai][bj][m][1] * rs + bv[bj][1];
                    if constexpr (ACT == 2) {
                        v0 = (f32x4){(v0[0] * c0[0] - v0[1] * c0[1]) * qs, (v0[0] * c0[1] + v0[1] * c0[0]) * qs, (v0[2] * c0[2] - v0[3] * c0[3]) * qs, (v0[2] * c0[3] + v0[3] * c0[2]) * qs};
                        v1 = (f32x4){(v1[0] * c1[0] - v1[1] * c1[1]) * qs, (v1[0] * c1[1] + v1[1] * c1[0]) * qs, (v1[2] * c1[2] - v1[3] * c1[3]) * qs, (v1[2] * c1[3] + v1[3] * c1[2]) * qs}; }
                    if (ACT == 1) {
#pragma unroll
                        for (int i = 0; i < 4; ++i) { const float a = fmaxf(v0[i], 0.f), b = fmaxf(v1[i], 0.f); v0[i] = a * a; v1[i] = b * b; } }
                    u32x4 w; w.x = cvt_pk_bf16(v0[0], v0[1]); w.y = cvt_pk_bf16(v0[2], v0[3]); w.z = cvt_pk_bf16(v1[0], v1[1]); w.w = cvt_pk_bf16(v1[2], v1[3]);
                    *(u32x4*)(rowp + bj * HALF) = w;
                    if (halo && u.pn < 12 && ((m == 0 && fr == 0) || (m == 3 && fr == 15)))
                        *(u32x4*)(halo + ((size_t)(row >> 6) * 2 + (m == 3 ? 1 : 0)) * 3072 + col0 + bj * HALF) = w; } }
    }
};
__device__ __forceinline__ float bf_lo(unsigned w) { return __uint_as_float(w << 16); }
__device__ __forceinline__ float bf_hi(unsigned w) { return __uint_as_float(w & 0xffff0000u); }
struct EpiResid {
    static constexpr bool PERM = true, AFTER_DRAIN = false;
    bf16_t* Hn; const float* cv; int cvstride; float* SSo;
    void* X; const void* Xin; int ldc; const float* gate; int gstride; int dry; int in_f32, out_f32;
    template <bool INF, bool OUTF> __device__ __forceinline__ void body(const f32x4 (&acc)[2][2][4][2], const Unit& u, int wr, int wc, int fr, int fq) const {
        const int row0 = u.pm * BM + wr * 64 + fr, col0 = u.pn * BM + wc * 32 + 8 * fq;
        const float* g = gate + (size_t)(u.pm < 32 ? 0 : (u.pm < 64 ? 1 : 2)) * gstride + col0;
        const int grp = u.pm < 32 ? 0 : (u.pm < 64 ? 1 : 2);
        f32x4 gv[2][2], cvv[2][2];
#pragma unroll
        for (int bj = 0; bj < 2; ++bj)
#pragma unroll
            for (int n = 0; n < 2; ++n) { gv[bj][n] = *(const f32x4*)(g + bj * HALF + n * 4); cvv[bj][n] = Hn ? *(const f32x4*)(cv + (size_t)grp * cvstride + col0 + bj * HALF + n * 4) : (f32x4){0.f, 0.f, 0.f, 0.f}; }
#pragma unroll
        for (int ai = 0; ai < 2; ++ai)
#pragma unroll
            for (int m = 0; m < 4; ++m) { const int row = row0 + ai * HALF + m * 16; const size_t off = (size_t)row * ldc + col0; float ss = 0.f;
#pragma unroll
                for (int bj = 0; bj < 2; ++bj) { f32x4 x0, x1;
                    if (INF) { const float* pi = (const float*)Xin + off + bj * HALF; x0 = *(const f32x4*)pi; x1 = *(const f32x4*)(pi + 4); }
                    else { const u32x4 w = *(const u32x4*)((const bf16_t*)Xin + off + bj * HALF); x0 = (f32x4){bf_lo(w.x), bf_hi(w.x), bf_lo(w.y), bf_hi(w.y)}; x1 = (f32x4){bf_lo(w.z), bf_hi(w.z), bf_lo(w.w), bf_hi(w.w)}; }
                    const f32x4 v0 = x0 + gv[bj][0] * acc[ai][bj][m][0], v1 = x1 + gv[bj][1] * acc[ai][bj][m][1];
                    if (!dry) { if (OUTF) { float* q = (float*)X + off + bj * HALF; *(f32x4*)q = v0; *(f32x4*)(q + 4) = v1; }
                        else *(u32x4*)((bf16_t*)X + off + bj * HALF) = (u32x4){cvt_pk_bf16(v0[0], v0[1]), cvt_pk_bf16(v0[2], v0[3]), cvt_pk_bf16(v1[0], v1[1]), cvt_pk_bf16(v1[2], v1[3])}; }
                    else asm volatile("" :: "v"(v0), "v"(v1));
                    if (Hn) { ss += ((v0[0] * v0[0] + v0[1] * v0[1]) + (v0[2] * v0[2] + v0[3] * v0[3])) + ((v1[0] * v1[0] + v1[1] * v1[1]) + (v1[2] * v1[2] + v1[3] * v1[3]));
                        const f32x4 h0 = v0 * cvv[bj][0], h1 = v1 * cvv[bj][1];
                        *(u32x4*)(Hn + off + bj * HALF) = (u32x4){cvt_pk_bf16(h0[0], h0[1]), cvt_pk_bf16(h0[2], h0[3]), cvt_pk_bf16(h1[0], h1[1]), cvt_pk_bf16(h1[2], h1[3])}; } }
                if (Hn) { ss += __shfl_xor(ss, 16); ss += __shfl_xor(ss, 32); if (fq == 0) atomicAdd((unsigned*)SSo + row, ss_enc(ss)); }
                if (m & 1) asm volatile("" ::: "memory"); }
    }
    __device__ __forceinline__ void operator()(const f32x4 (&acc)[2][2][4][2], const Unit& u, int wr, int wc, int fr, int fq) const {
        if (in_f32) body<true, false>(acc, u, wr, wc, fr, fq); else if (out_f32) body<false, true>(acc, u, wr, wc, fr, fq); else body<false, false>(acc, u, wr, wc, fr, fq);
    }
};

template <class Epi, class Sched, bool ALIGN_EPI = false, bool SP2 = false>
__device__ __forceinline__ void gemm_phase(PG8_LAS unsigned char* lds, const Gemm g, const Sched& S, const Epi& E) {
    int tid_ = threadIdx.x; asm volatile("" : "+v"(tid_)); const int tid = tid_, wid = __builtin_amdgcn_readfirstlane(tid >> 6), lane = tid & 63, wr = wid >> 2, wc = wid & 3, fr = lane & 15, fq = lane >> 4;
    const int K = g.K, nt = K / BK;
    unsigned voffA[2], voffB[2];
#pragma unroll
    for (int i = 0; i < 2; ++i) { int R, C; stage_rc(tid * 16 + i * 8192, R, C); const int Rb = Epi::PERM ? ((R & ~31) + perm32(R & 31)) : R;
        voffA[i] = (unsigned)(R * g.lda + C) * 2u; voffB[i] = (unsigned)(Rb * g.ldb + C) * 2u; }
    const size_t kstep = (size_t)(BK * 2);
    const int lda = g.lda, ldb = g.ldb;
    const size_t hstepA = (size_t)HALF * lda * 2, hstepB = (size_t)HALF * ldb * 2;
    const size_t tstepA = 2 * hstepA, tstepB = 2 * hstepB;
    const unsigned ldsw = (unsigned)wid * 1024u;
    const int aoff = lds_byte(wr * 64 + fr, fq * 8), boff = lds_byte(wc * 32 + fr, fq * 8);
#define PG8_SA(b, h) (((b) * 2 + (h)) * HTB)
#define PG8_SB(b, h) ((4 + (b) * 2 + (h)) * HTB)
#define PG8_STAGE(bufoff, gbase, voff) do { _Pragma("unroll") for (int _i = 0; _i < 2; ++_i) \
        __builtin_amdgcn_global_load_lds((const unsigned*)((const char*)(gbase) + (voff)[_i]), (PG8_LAS unsigned*)(lds + (bufoff) + ldsw + _i * 8192), 16, 0, 0); } while (0)
#define PG8_LDA(dst, b, h) do { _Pragma("unroll") for (int m = 0; m < 4; ++m) _Pragma("unroll") for (int k = 0; k < 2; ++k) dst[m][k] = *(const PG8_LAS bf16x8*)(lds + PG8_SA(b, h) + aoff + m * 2048 + k * 1024); } while (0)
#define PG8_LDB(dst, b, h) do { _Pragma("unroll") for (int n = 0; n < 2; ++n) _Pragma("unroll") for (int k = 0; k < 2; ++k) dst[n][k] = *(const PG8_LAS bf16x8*)(lds + PG8_SB(b, h) + boff + n * 2048 + k * 1024); } while (0)
#define PG8_MMA(ai, bj, At, Bt) do { __builtin_amdgcn_s_setprio(1); _Pragma("unroll") for (int m = 0; m < 4; ++m) _Pragma("unroll") for (int n = 0; n < 2; ++n) _Pragma("unroll") for (int k = 0; k < 2; ++k) \
        acc[ai][bj][m][n] = __builtin_amdgcn_mfma_f32_16x16x32_bf16(Bt[n][k], At[m][k], acc[ai][bj][m][n], 0, 0, 0); __builtin_amdgcn_s_setprio(0); } while (0)
#define PG8_WAIT_V(n) asm volatile("s_waitcnt vmcnt(" #n ")" ::: "memory")
#define PG8_WAIT_L(n) asm volatile("s_waitcnt lgkmcnt(" #n ")" ::: "memory")
#define PG8_BAR __builtin_amdgcn_s_barrier()
#define PG8_SCHED __builtin_amdgcn_sched_barrier(0)
    Unit cur, nxt; int ui = 0;
    if (!S.next(0, cur)) return;
    f32x4 acc[2][2][4][2];
#pragma unroll
    for (int a = 0; a < 2; ++a)
#pragma unroll
        for (int b = 0; b < 2; ++b)
#pragma unroll
            for (int m = 0; m < 4; ++m)
#pragma unroll
                for (int n = 0; n < 2; ++n) acc[a][b][m][n] = (f32x4){0.f, 0.f, 0.f, 0.f};
    bf16x8 At[4][2], B0[2][2], B1[2][2];
    const char* cA = (const char*)g.A + (size_t)cur.pm * tstepA; const char* cB = (const char*)g.Bt + (size_t)cur.pn * tstepB;
    S.a_ready(cur);
    if constexpr (SP2) {
        PG8_STAGE(PG8_SB(0, 0), cB, voffB); PG8_STAGE(PG8_SB(0, 1), cB + hstepB, voffB); PG8_STAGE(PG8_SA(0, 0), cA, voffA); PG8_STAGE(PG8_SA(0, 1), cA + hstepA, voffA);
        if (wr == 1) PG8_BAR;
        PG8_WAIT_V(2); PG8_BAR;
        PG8_STAGE(PG8_SB(1, 0), cB + kstep, voffB); PG8_STAGE(PG8_SA(1, 0), cA + kstep, voffA); PG8_STAGE(PG8_SB(1, 1), cB + hstepB + kstep, voffB);
        PG8_WAIT_V(6); PG8_BAR;
    } else {
        PG8_STAGE(PG8_SB(0, 0), cB, voffB); PG8_STAGE(PG8_SA(0, 0), cA, voffA); PG8_STAGE(PG8_SB(0, 1), cB + hstepB, voffB); PG8_STAGE(PG8_SA(0, 1), cA + hstepA, voffA);
        if (wr == 1) PG8_BAR;
        PG8_WAIT_V(4); PG8_BAR;
        PG8_STAGE(PG8_SB(1, 0), cB + kstep, voffB); PG8_STAGE(PG8_SA(1, 0), cA + kstep, voffA); PG8_STAGE(PG8_SB(1, 1), cB + hstepB + kstep, voffB);
        PG8_WAIT_V(6); PG8_BAR;
    }
    for (;;) {
        const bool has_next = S.next(ui + 1, nxt);
        const char* nA = has_next ? (const char*)g.A + (size_t)nxt.pm * tstepA : cA; const char* nB = has_next ? (const char*)g.Bt + (size_t)nxt.pn * tstepB : cB;
        for (int t = 0; t < nt; t += 2) {
            const bool last = (t == nt - 2);
            const char* a1 = cA + (size_t)(t + 1) * kstep;
            const char* a2 = last ? nA : cA + (size_t)(t + 2) * kstep; const char* b2 = last ? nB : cB + (size_t)(t + 2) * kstep;
            const char* a3 = a2 + kstep; const char* b3 = b2 + kstep;
            if (last && has_next) S.a_ready(nxt);
            if constexpr (SP2) {
            PG8_LDB(B0, 0, 0); PG8_LDB(B1, 0, 1); PG8_SCHED; PG8_LDA(At, 0, 0); PG8_STAGE(PG8_SA(1, 1), a1 + hstepA, voffA);
            PG8_WAIT_V(8); PG8_WAIT_L(0); PG8_BAR; PG8_MMA(0, 0, At, B0); PG8_MMA(0, 1, At, B1); PG8_BAR; PG8_SCHED;
            PG8_LDA(At, 0, 1); PG8_STAGE(PG8_SB(0, 0), b2, voffB); PG8_STAGE(PG8_SB(0, 1), b2 + hstepB, voffB); PG8_STAGE(PG8_SA(0, 0), a2, voffA);
            PG8_WAIT_V(8); PG8_WAIT_L(0); PG8_BAR; PG8_MMA(1, 0, At, B0); PG8_MMA(1, 1, At, B1); PG8_BAR; PG8_SCHED;
            PG8_LDB(B0, 1, 0); PG8_LDB(B1, 1, 1); PG8_SCHED; PG8_LDA(At, 1, 0); PG8_STAGE(PG8_SA(0, 1), a2 + hstepA, voffA);
            PG8_WAIT_V(8); PG8_WAIT_L(0); PG8_BAR; PG8_MMA(0, 0, At, B0); PG8_MMA(0, 1, At, B1); PG8_BAR; PG8_SCHED;
            PG8_LDA(At, 1, 1); PG8_STAGE(PG8_SB(1, 0), b3, voffB); PG8_STAGE(PG8_SB(1, 1), b3 + hstepB, voffB); PG8_STAGE(PG8_SA(1, 0), a3, voffA);
            PG8_WAIT_V(8); PG8_WAIT_L(0); PG8_BAR; PG8_MMA(1, 0, At, B0); PG8_MMA(1, 1, At, B1); PG8_BAR; PG8_SCHED;
            } else {
            PG8_LDB(B0, 0, 0); PG8_SCHED; PG8_LDA(At, 0, 0); PG8_STAGE(PG8_SA(1, 1), a1 + hstepA, voffA);
            PG8_WAIT_L(8); PG8_BAR; PG8_WAIT_L(0); PG8_MMA(0, 0, At, B0); PG8_BAR; PG8_SCHED;
            PG8_LDB(B1, 0, 1); PG8_STAGE(PG8_SB(0, 0), b2, voffB);
            PG8_BAR; PG8_WAIT_L(0); PG8_MMA(0, 1, At, B1); PG8_BAR;
            PG8_LDA(At, 0, 1); PG8_STAGE(PG8_SA(0, 0), a2, voffA);
            PG8_BAR; PG8_WAIT_L(0); PG8_MMA(1, 0, At, B0); PG8_BAR; PG8_SCHED;
            PG8_STAGE(PG8_SB(0, 1), b2 + hstepB, voffB);
            PG8_WAIT_V(6); PG8_BAR; PG8_MMA(1, 1, At, B1); PG8_BAR;
            PG8_LDB(B0, 1, 0); PG8_SCHED; PG8_LDA(At, 1, 0); PG8_STAGE(PG8_SA(0, 1), a2 + hstepA, voffA);
            PG8_WAIT_L(8); PG8_BAR; PG8_WAIT_L(0); PG8_MMA(0, 0, At, B0); PG8_BAR; PG8_SCHED;
            PG8_LDB(B1, 1, 1); PG8_STAGE(PG8_SB(1, 0), b3, voffB);
            PG8_BAR; PG8_WAIT_L(0); PG8_MMA(0, 1, At, B1); PG8_BAR;
            PG8_LDA(At, 1, 1); PG8_STAGE(PG8_SA(1, 0), a3, voffA);
            PG8_BAR; PG8_WAIT_L(0); PG8_MMA(1, 0, At, B0); PG8_BAR; PG8_SCHED;
            PG8_STAGE(PG8_SB(1, 1), b3 + hstepB, voffB);
            PG8_WAIT_V(6); PG8_BAR; PG8_MMA(1, 1, At, B1); PG8_BAR;
            }
        }
        if constexpr (ALIGN_EPI) { if (wr == 0) PG8_BAR; }
        if constexpr (!Epi::AFTER_DRAIN) { E(acc, cur, wr, wc, fr, fq); S.done(cur); }
        if (!has_next) break;
#pragma unroll
        for (int a = 0; a < 2; ++a)
#pragma unroll
            for (int b = 0; b < 2; ++b)
#pragma unroll
                for (int m = 0; m < 4; ++m)
#pragma unroll
                    for (int n = 0; n < 2; ++n) acc[a][b][m][n] = (f32x4){0.f, 0.f, 0.f, 0.f};
        cur = nxt; cA = nA; cB = nB; ++ui;
        if constexpr (ALIGN_EPI) { if (wr == 1) PG8_BAR; }
    }
    PG8_WAIT_V(0);
    if constexpr (!ALIGN_EPI) { if (wr == 0) PG8_BAR; }
    PG8_BAR;
    if constexpr (Epi::AFTER_DRAIN) { E.fused(acc, cur, wr, wc, fr, fq, lds, wid, lane); S.done(cur); }
#undef PG8_SA
#undef PG8_SB
#undef PG8_STAGE
#undef PG8_LDA
#undef PG8_LDB
#undef PG8_MMA
#undef PG8_WAIT_V
#undef PG8_WAIT_L
#undef PG8_BAR
#undef PG8_SCHED
}
}

constexpr int D = 1024, NB = 2, T = 8192, CT = 256, DEPTH = 4, FF = 4096;
constexpr int ML = NB * T, MC = NB * CT, M = ML + MC;
constexpr int NADA = 6 * D;
constexpr int GDN_N = 4128, GDN_NP = 4352;
constexpr int NH = 8, HD = 128;
constexpr int NKV = CT + T;
constexpr float EPS = 1e-6f;
constexpr int NWAVES = 8, NTHR = 512;
constexpr float QSCALE = 0.125f * 1.4426950408889634f;
constexpr float LAMBDA_INIT = 0.47071302f;

constexpr size_t MiB = 1u << 20;
constexpr size_t WS_CTL = 0, CTL_ZERO_BYTES = 1 * MiB;
constexpr size_t WS_MOD = 1 * MiB;
constexpr size_t WS_CV = 1 * MiB + 512 * 1024;
constexpr size_t WS_BIAS = 9 * MiB;
constexpr size_t CTL_SS = 128 * 1024;
constexpr size_t WS_ROPE = 2 * MiB;
constexpr size_t WS_AB = 4 * MiB;
constexpr size_t WS_OFC = 7 * MiB;
constexpr size_t WS_W1T = 10 * MiB, WS_W2T = 42 * MiB, WS_GINT = 74 * MiB, WS_GOUTT = 91 * MiB, WS_SINT = 95 * MiB, WS_SOUTT = 101 * MiB, WS_DINT = 103 * MiB, WS_DOUTT = 109 * MiB;
constexpr size_t WS_X = 112 * MiB;
constexpr size_t WS_XF = 178 * MiB;
constexpr size_t WS_H = 178 * MiB;
constexpr size_t WS_Y = 211 * MiB;
constexpr size_t WS_Z = 244 * MiB;
constexpr size_t WS_HALO = 376 * MiB;
constexpr size_t WS_END = 380 * MiB;
constexpr size_t WS_PD = WS_H;

constexpr int LDS_BYTES = 159744;

#define LAS __attribute__((address_space(3)))
typedef unsigned short bf16;
typedef unsigned u32x4 __attribute__((ext_vector_type(4)));
typedef unsigned u32x2 __attribute__((ext_vector_type(2)));
typedef float f32x4 __attribute__((ext_vector_type(4)));
typedef float f32x2 __attribute__((ext_vector_type(2)));
typedef float f32x16 __attribute__((ext_vector_type(16)));
typedef short bf16x8 __attribute__((ext_vector_type(8)));
typedef short s16x4 __attribute__((ext_vector_type(4)));
#define LDS_WAIT() asm volatile("s_waitcnt lgkmcnt(0)" ::: "memory")

__device__ __forceinline__ float bf2f(unsigned u) { return __uint_as_float(u << 16); }
__device__ __forceinline__ unsigned pk2(float lo, float hi) { return pg8::cvt_pk_bf16(lo, hi); }
__device__ __forceinline__ float wave_sum(float v) {
#pragma unroll
    for (int o = 1; o < 64; o <<= 1) v += __shfl_xor(v, o);
    return v;
}
__device__ __forceinline__ float silu_f(float x) { return x / (1.f + expf(-x)); }
__device__ __forceinline__ float silu_fast(float x) { return x * __builtin_amdgcn_rcpf(1.f + __builtin_amdgcn_exp2f(-1.4426950408889634f * x)); }
__device__ __forceinline__ float exp_fast(float x) { return __builtin_amdgcn_exp2f(1.4426950408889634f * x); }
__device__ __forceinline__ int crow(int r, int hi) { return (r & 3) + 8 * (r >> 2) + 4 * hi; }

struct Args { const float* in[24]; float* out; unsigned char* ws; int step_lo, step_hi, coop, pad; };
typedef const __attribute__((address_space(4))) Args* KArgs;
__device__ __forceinline__ KArgs kargs() { const unsigned long long p = (unsigned long long)__builtin_amdgcn_kernarg_segment_ptr();
    unsigned lo = __builtin_amdgcn_readfirstlane((unsigned)p), hi = __builtin_amdgcn_readfirstlane((unsigned)(p >> 32)); asm volatile("" : "+s"(lo), "+s"(hi)); return (KArgs)(((unsigned long long)hi << 32) | lo); }
#define INP(k) (kargs()->in[k])
extern __shared__ __attribute__((aligned(16))) unsigned char lds_raw[];
struct Frame { LAS unsigned char* lds; int tid, lane, wave, G, bid; float* out; unsigned char* ws; };
__device__ __forceinline__ Frame make_frame() {
    Frame F; F.lds = (LAS unsigned char*)lds_raw; F.tid = threadIdx.x; asm volatile("" : "+v"(F.tid)); F.lane = F.tid & 63; F.wave = __builtin_amdgcn_readfirstlane(F.tid >> 6); F.G = gridDim.x; F.bid = blockIdx.x; asm volatile("" : "+s"(F.G), "+s"(F.bid));
    KArgs a = kargs(); F.out = a->out; F.ws = a->ws; return F;
}
enum { I_X = 0, I_C, I_CTX, I_CCTX, I_N1G, I_N2G, I_ADAW, I_ADAB, I_W1, I_W2, I_GIN, I_GCONV, I_GALOG, I_GDT, I_GNG, I_GOUT, I_SIN, I_SCONV, I_SOUT, I_DIN, I_DLAM, I_DNG, I_DOUT, I_FG };

__device__ __forceinline__ void transpose_item(const float* W, int K, int ldw, bf16* WT, LAS float* scr, int item, int nblk, int lane) {
    const int kb = item / nblk, nb = item % nblk, k0 = 64 * kb, n0 = 32 * nb;
#pragma unroll 8
    for (int i = 0; i < 32; ++i) { const int kk = 2 * i + (lane >> 5); scr[kk * 33 + (lane & 31)] = W[(size_t)(k0 + kk) * ldw + n0 + (lane & 31)]; }
    LDS_WAIT(); asm volatile("" ::: "memory");
    const int c = lane & 7;
#pragma unroll
    for (int j = 0; j < 4; ++j) { const int n = (lane >> 3) + 8 * j; const LAS float* s = scr + (8 * c) * 33 + n;
        u32x4 o; o.x = pk2(s[0 * 33], s[1 * 33]); o.y = pk2(s[2 * 33], s[3 * 33]); o.z = pk2(s[4 * 33], s[5 * 33]); o.w = pk2(s[6 * 33], s[7 * 33]);
        *(u32x4*)(WT + (size_t)(n0 + n) * K + k0 + 8 * c) = o; }
    LDS_WAIT(); asm volatile("" ::: "memory");
}
__device__ __forceinline__ void get_mat(unsigned char* ws_, int idx, const float*& src, bf16*& dst, int& K, int& N, int& ld) {
    unsigned char* ws = ws_;
    if (idx < 4)       { src = INP(I_W1) + (size_t)idx * D * FF; dst = (bf16*)(ws + WS_W1T) + (size_t)idx * D * FF; K = D; N = FF; ld = FF; }
    else if (idx < 8)  { const int i = idx - 4; src = INP(I_W2) + (size_t)i * D * FF; dst = (bf16*)(ws + WS_W2T) + (size_t)i * D * FF; K = FF; N = D; ld = D; }
    else if (idx < 10) { const int j = idx - 8; src = INP(I_GIN) + (size_t)j * D * GDN_N; dst = (bf16*)(ws + WS_GINT) + (size_t)j * GDN_NP * D; K = D; N = GDN_N; ld = GDN_N; }
    else if (idx < 12) { const int j = idx - 10; src = INP(I_GOUT) + (size_t)j * D * D; dst = (bf16*)(ws + WS_GOUTT) + (size_t)j * D * D; K = D; N = D; ld = D; }
    else if (idx == 12) { src = INP(I_SIN); dst = (bf16*)(ws + WS_SINT); K = D; N = 3 * D; ld = 3 * D; }
    else if (idx == 13) { src = INP(I_SOUT); dst = (bf16*)(ws + WS_SOUTT); K = D; N = D; ld = D; }
    else if (idx == 14) { src = INP(I_DIN); dst = (bf16*)(ws + WS_DINT); K = D; N = 3 * D; ld = 3 * D; }
    else { src = INP(I_DOUT); dst = (bf16*)(ws + WS_DOUTT); K = D; N = D; ld = D; }
}
__device__ __forceinline__ void convert_weights(unsigned char* ws, unsigned mask, int gw, int NGW, int gt, int NGT, LAS unsigned char* lds, int wave, int lane) {
    LAS float* scr = (LAS float*)(lds + wave * 16384);
    for (int mi = 0; mi < 16; ++mi) {
        if (!((mask >> mi) & 1u)) continue;
        const float* src; bf16* dst; int K, N, ld; get_mat(ws, mi, src, dst, K, N, ld);
        const int nblk = N / 32, nitems = (K / 64) * nblk;
        for (int it = gw; it < nitems; it += NGW) transpose_item(src, K, ld, dst, scr, it, nblk, lane);
        if (mi == 8 || mi == 9) { u32x4* z = (u32x4*)((bf16*)(ws + WS_GINT) + (size_t)(mi - 8) * GDN_NP * D + (size_t)GDN_N * D);
            for (int i = gt; i < (GDN_NP - GDN_N) * D / 8; i += NGT) z[i] = (u32x4){0u, 0u, 0u, 0u}; }
    }
}
__device__ __forceinline__ void step_prologue() {
    const Frame F = make_frame();
    const int gw = F.bid * NWAVES + F.wave, NGW = F.G * NWAVES;
    const int gt = F.bid * NTHR + F.tid, NGT = F.G * NTHR;
    convert_weights(F.ws, (1u << 8) | (1u << 10), gw, NGW, gt, NGT, F.lds, F.wave, F.lane);
    __syncthreads();
    {
        LAS float* sv = (LAS float*)F.lds;
        LAS float* red = sv + 3 * D;
        for (int i = F.tid; i < 3 * D; i += NTHR) { const int g = i / D, k = i % D; const float c = g < 2 ? INP(I_C)[g * D + k] : INP(I_CCTX)[k]; sv[i] = silu_f(c); }
        __syncthreads();
        float* MOD = (float*)(F.ws + WS_MOD);
        const int c = F.tid & 63, ks = F.tid >> 6;
        for (int it = F.bid; it < DEPTH * (NADA / 64); it += F.G) {
            const int li = it / (NADA / 64), n0 = (it % (NADA / 64)) * 64;
            const float* w = INP(I_ADAW) + (size_t)li * D * NADA + (size_t)(ks * 128) * NADA + n0 + c;
            float a0 = 0.f, a1 = 0.f, a2 = 0.f;
#pragma unroll 16
            for (int k = 0; k < 128; ++k) { const float wv = w[(size_t)k * NADA]; const int kk = ks * 128 + k; a0 += sv[kk] * wv; a1 += sv[D + kk] * wv; a2 += sv[2 * D + kk] * wv; }
            red[(ks * 3 + 0) * 64 + c] = a0; red[(ks * 3 + 1) * 64 + c] = a1; red[(ks * 3 + 2) * 64 + c] = a2;
            __syncthreads();
            if (F.tid < 192) { const int g = F.tid >> 6; float s = INP(I_ADAB)[li * NADA + n0 + c];
#pragma unroll
                for (int q = 0; q < 8; ++q) s += red[(q * 3 + g) * 64 + c];
                MOD[((size_t)li * 3 + g) * NADA + n0 + c] = s; }
            __syncthreads();
        }
    }
    {
        f32x2* R = (f32x2*)(F.ws + WS_ROPE);
        for (int i = gt; i < T * 32; i += NGT) { const int t = i >> 5, p = i & 31, f = p & 15;
            const float inv = powf(10000.0f, -(float)f / 16.0f); const float pos = (float)(p < 16 ? (t >> 6) : (t & 63)); const float ang = pos * inv;
            R[i] = (f32x2){cosf(ang), sinf(ang)}; }
    }
}

__device__ __forceinline__ void step_norm(int layer, int which, int nrows, bool from_inputs) {
    const Frame F = make_frame();
    const int gw = F.bid * NWAVES + F.wave, NGW = F.G * NWAVES;
    const float* X = (const float*)(F.ws + WS_X); bf16* H = (bf16*)(F.ws + WS_H);
    const float* ng = (which ? INP(I_N2G) : INP(I_N1G)) + layer * D;
    const float* MOD = (const float*)(F.ws + WS_MOD) + (size_t)layer * 3 * NADA + which * 3 * D;
    for (int row = gw; row < nrows; row += NGW) {
        const int grp = row < T ? 0 : (row < ML ? 1 : 2);
        const float* xrow = from_inputs ? (row < ML ? INP(I_X) + (size_t)row * D : INP(I_CTX) + (size_t)(row - ML) * D) : X + (size_t)row * D;
        const f32x4* xr = (const f32x4*)xrow + F.lane;
        const f32x4* sh = (const f32x4*)(MOD + (size_t)grp * NADA) + F.lane; const f32x4* sc = (const f32x4*)(MOD + (size_t)grp * NADA + D) + F.lane; const f32x4* gg = (const f32x4*)ng + F.lane;
        f32x4 v[4]; float s = 0.f;
#pragma unroll
        for (int j = 0; j < 4; ++j) { v[j] = xr[64 * j]; s += (v[j].x * v[j].x + v[j].y * v[j].y) + (v[j].z * v[j].z + v[j].w * v[j].w); }
        const float rstd = 1.0f / sqrtf(wave_sum(s) * (1.f / D) + EPS);
        u32x2* o = (u32x2*)(H + (size_t)row * D) + F.lane;
#pragma unroll
        for (int j = 0; j < 4; ++j) { const f32x4 g4 = gg[64 * j], s4 = sc[64 * j], h4 = sh[64 * j]; const f32x4 y = (v[j] * rstd) * g4; const f32x4 h = y * (1.0f + s4) + h4;
            o[64 * j] = (u32x2){pk2(h.x, h.y), pk2(h.z, h.w)}; }
    }
}
__device__ __forceinline__ void step_norm0() {
    const Frame F = make_frame();
    const int gw = F.bid * NWAVES + F.wave, NGW = F.G * NWAVES, gt = F.bid * NTHR + F.tid, NGT = F.G * NTHR;
    bf16* H = (bf16*)(F.ws + WS_H); float* SS = (float*)(F.ws + WS_CTL + CTL_SS); const float* MOD = (const float*)(F.ws + WS_MOD);
    const bool split = F.G > 130; const int R1 = split ? 7680 : M;
    const float* ng = INP(I_N1G);
    auto do_row = [&](int row) {
        const int grp = row < T ? 0 : (row < ML ? 1 : 2);
        const float* xrow = row < ML ? INP(I_X) + (size_t)row * D : INP(I_CTX) + (size_t)(row - ML) * D;
        const f32x4* xr = (const f32x4*)xrow + F.lane; const f32x4* sc = (const f32x4*)(MOD + (size_t)grp * NADA + D) + F.lane; const f32x4* gg = (const f32x4*)ng + F.lane;
        f32x4 v[4]; float s = 0.f;
#pragma unroll
        for (int j = 0; j < 4; ++j) { v[j] = xr[64 * j]; s += (v[j].x * v[j].x + v[j].y * v[j].y) + (v[j].z * v[j].z + v[j].w * v[j].w); }
        s = wave_sum(s); if (F.lane == 0) ((unsigned*)SS)[row] = pg8::ss_enc(s);
        u32x2* o = (u32x2*)(H + (size_t)row * D) + F.lane;
#pragma unroll
        for (int j = 0; j < 4; ++j) { const f32x4 h = v[j] * (gg[64 * j] * (1.0f + sc[64 * j])); o[64 * j] = (u32x2){pk2(h.x, h.y), pk2(h.z, h.w)}; }
    };
    for (int row = gw; row < R1; row += NGW) do_row(row);
    if (split && F.bid >= 65) for (int row = R1 + gw - 65 * NWAVES; row < M; row += (F.G - 65) * NWAVES) do_row(row);
    { float* CV = (float*)(F.ws + WS_CV);
      for (int idx = gt; idx < DEPTH * 2 * 3 * D; idx += NGT) { const int col = idx & (D - 1), grp = (idx >> 10) % 3, which = (idx / (3 * D)) & 1, li = idx / (6 * D);
        const float g = (which ? INP(I_N2G) : INP(I_N1G))[li * D + col]; CV[idx] = g * (1.0f + MOD[((size_t)li * 3 + grp) * NADA + which * 3 * D + D + col]); } }
}
__device__ __forceinline__ void step_bias(int it_lo, int it_hi, int first_block) {
    const Frame F = make_frame();
    if (F.bid < first_block) return;
    __syncthreads();
    const float* MOD = (const float*)(F.ws + WS_MOD);
    LAS float* red = (LAS float*)F.lds;
    float* BIAS = (float*)(F.ws + WS_BIAS);
    const int c = F.tid & 63, ks = F.tid >> 6;
    constexpr int NB_IN = 65, NB_UP = 64;
    for (int it = it_lo + F.bid - first_block; it < it_hi; it += F.G - first_block) {
        const int li = it / (NB_IN + NB_UP), rr = it % (NB_IN + NB_UP); const bool up = rr >= NB_IN; const int n0 = (up ? rr - NB_IN : rr) * 64; const int kind = li % 3, jj = li / 3;
        const float* W; int ld, nv;
        if (up) { W = INP(I_W1) + (size_t)li * D * FF; ld = FF; nv = FF; }
        else if (kind == 0) { W = INP(I_GIN) + (size_t)jj * D * GDN_N; ld = GDN_N; nv = GDN_N; }
        else if (kind == 1) { W = INP(I_SIN); ld = 3 * D; nv = 3 * D; }
        else { W = INP(I_DIN); ld = 3 * D; nv = 3 * D; }
        const int n = n0 + c; const bool valid = n < nv;
        const float* sh = MOD + (size_t)li * 3 * NADA + (up ? 3 * D : 0);
        float a0 = 0.f, a1 = 0.f, a2 = 0.f;
        if (n0 < nv) {
#pragma unroll 16
            for (int k = 0; k < 128; ++k) { const int kk = ks * 128 + k; const float wv = valid ? W[(size_t)kk * ld + n] : 0.f; a0 += sh[kk] * wv; a1 += sh[NADA + kk] * wv; a2 += sh[2 * NADA + kk] * wv; } }
        red[(ks * 3 + 0) * 64 + c] = a0; red[(ks * 3 + 1) * 64 + c] = a1; red[(ks * 3 + 2) * 64 + c] = a2;
        __syncthreads();
        if (F.tid < 192 && valid) { const int g = F.tid >> 6; float s = 0.f;
#pragma unroll
            for (int q = 0; q < 8; ++q) s += red[(q * 3 + g) * 64 + c];
            BIAS[up ? (size_t)DEPTH * 3 * 4352 + ((size_t)li * 3 + g) * FF + n : ((size_t)li * 3 + g) * 4352 + n] = s; }
        __syncthreads();
    }
}
__device__ __forceinline__ void step_final() {
    const Frame F = make_frame();
    const int gw = F.bid * NWAVES + F.wave, NGW = F.G * NWAVES;
    const bf16* X = (const bf16*)(F.ws + WS_X);
    for (int row = gw; row < ML; row += NGW) {
        const u32x4* xr = (const u32x4*)(X + (size_t)row * D) + F.lane; const f32x4* gg = (const f32x4*)INP(I_FG) + 2 * F.lane;
        f32x4 v[4]; float s = 0.f;
#pragma unroll
        for (int j = 0; j < 2; ++j) { const u32x4 w = xr[64 * j];
            v[2 * j] = (f32x4){bf2f(w.x & 0xffffu), bf2f(w.x >> 16), bf2f(w.y & 0xffffu), bf2f(w.y >> 16)}; v[2 * j + 1] = (f32x4){bf2f(w.z & 0xffffu), bf2f(w.z >> 16), bf2f(w.w & 0xffffu), bf2f(w.w >> 16)};
            s += ((v[2 * j].x * v[2 * j].x + v[2 * j].y * v[2 * j].y) + (v[2 * j].z * v[2 * j].z + v[2 * j].w * v[2 * j].w)) + ((v[2 * j + 1].x * v[2 * j + 1].x + v[2 * j + 1].y * v[2 * j + 1].y) + (v[2 * j + 1].z * v[2 * j + 1].z + v[2 * j + 1].w * v[2 * j + 1].w)); }
        const float rstd = 1.0f / sqrtf(wave_sum(s) * (1.f / D) + EPS);
        f32x4* o = (f32x4*)(F.out + (size_t)row * D) + 2 * F.lane;
#pragma unroll
        for (int j = 0; j < 2; ++j) { o[128 * j] = (v[2 * j] * rstd) * gg[128 * j]; o[128 * j + 1] = (v[2 * j + 1] * rstd) * gg[128 * j + 1]; }
    }
}

__device__ __forceinline__ void step_gdn_scan(int j) {
    const Frame F = make_frame();
    LAS float* qs = (LAS float*)F.lds;
    LAS float* ks = qs + 64 * 128;
    LAS float* vs = ks + 64 * 128;
    LAS float* ga = vs + 64 * 128;
    LAS float* be = ga + 64;
    const bf16* Z = (const bf16*)(F.ws + WS_Z);
    const float* AB = (const float*)(F.ws + WS_AB);
    const float* cw = INP(I_GCONV) + (size_t)j * 3 * 3072;
    float* OFC = (float*)(F.ws + WS_OFC);
    for (int it = F.bid; it < 32; it += F.G) {
        const int b = it >> 4, h = (it >> 1) & 7, dir = it & 1;
        const float Aco = expf(INP(I_GALOG)[j * 16 + dir * 8 + h]); const float dtb = INP(I_GDT)[j * 16 + dir * 8 + h];
        float S[64];
#pragma unroll
        for (int i = 0; i < 64; ++i) S[i] = 0.f;
        const int jcol = F.tid >> 1, half = F.tid & 1;
        for (int n = 0; n < 132; ++n) {
            const bool isctx = n < 4; const int L = isctx ? CT : T; const int p0 = isctx ? 64 * n : 64 * (n - 4); const int rbase = isctx ? ML + b * CT : b * T;
            for (int idx = F.tid; idx < 64 * 384; idx += NTHR) {
                const int c = idx / 384, ch = idx % 384, part = ch >> 7, e = ch & 127;
                const int p = p0 + c; const int t = dir ? (L - 1 - p) : p; const int col = part * 1024 + h * 128 + e;
                float acc = 0.f;
#pragma unroll
                for (int tap = 0; tap < 3; ++tap) { const int tt = t + tap - 1; if (tt >= 0 && tt < L) acc += cw[tap * 3072 + col] * bf2f(Z[(size_t)(rbase + tt) * 4096 + col]); }
                acc = silu_f(acc);
                LAS float* dst = part == 0 ? qs : (part == 1 ? ks : vs); dst[c * 128 + e] = acc;
            }
            if (F.tid < 64) { const int p = p0 + F.tid; const int t = dir ? (L - 1 - p) : p; const size_t row = (size_t)(rbase + t);
                const float av = AB[row * 32 + dir * 8 + h], bv = AB[row * 32 + 16 + dir * 8 + h];
                const float x = av + dtb; const float sp = x > 20.f ? x : log1pf(expf(x));
                ga[F.tid] = expf(-Aco * sp); be[F.tid] = 1.f / (1.f + expf(-bv)); }
            __syncthreads();
#pragma unroll 1
            for (int rr = 0; rr < 8; ++rr) { const int c = F.wave * 8 + rr;
                const float q0 = qs[c * 128 + F.lane], q1 = qs[c * 128 + 64 + F.lane]; const float sq = 0.08838834764831845f / sqrtf(wave_sum(q0 * q0 + q1 * q1) + EPS);
                qs[c * 128 + F.lane] = q0 * sq; qs[c * 128 + 64 + F.lane] = q1 * sq;
                const float k0 = ks[c * 128 + F.lane], k1 = ks[c * 128 + 64 + F.lane]; const float sk = 1.0f / sqrtf(wave_sum(k0 * k0 + k1 * k1) + EPS);
                ks[c * 128 + F.lane] = k0 * sk; ks[c * 128 + 64 + F.lane] = k1 * sk; }
            __syncthreads();
            if (F.tid < 256) {
#pragma unroll 1
                for (int c = 0; c < 64; ++c) {
                    const float a = ga[c], bt = be[c];
                    const LAS f32x4* k4 = (const LAS f32x4*)(ks + c * 128 + 64 * half); const LAS f32x4* q4 = (const LAS f32x4*)(qs + c * 128 + 64 * half);
                    float dot = 0.f;
#pragma unroll
                    for (int i = 0; i < 16; ++i) { const f32x4 kv = k4[i]; dot += kv.x * S[4 * i] + kv.y * S[4 * i + 1] + kv.z * S[4 * i + 2] + kv.w * S[4 * i + 3]; }
                    dot += __shfl_xor(dot, 1);
                    const float tmp = bt * (vs[c * 128 + jcol] - a * dot);
                    float o = 0.f;
#pragma unroll
                    for (int i = 0; i < 16; ++i) { const f32x4 kv = k4[i]; const f32x4 qv = q4[i];
                        S[4 * i] = a * S[4 * i] + kv.x * tmp; S[4 * i + 1] = a * S[4 * i + 1] + kv.y * tmp; S[4 * i + 2] = a * S[4 * i + 2] + kv.z * tmp; S[4 * i + 3] = a * S[4 * i + 3] + kv.w * tmp;
                        o += qv.x * S[4 * i] + qv.y * S[4 * i + 1] + qv.z * S[4 * i + 2] + qv.w * S[4 * i + 3]; }
                    o += __shfl_xor(o, 1);
                    const int p = p0 + c; const int t = dir ? (L - 1 - p) : p;
                    float* dst = isctx ? OFC + (size_t)(b * CT + t) * D : F.out + (size_t)(b * T + t) * D;
                    if (half == 0) atomicAdd(dst + h * 128 + jcol, o);
                }
            }
            __syncthreads();
        }
    }
}
__device__ __forceinline__ void step_gdn_norm(int j) {
    const Frame F = make_frame();
    const int gw = F.bid * NWAVES + F.wave, NGW = F.G * NWAVES;
    const bf16* Z = (const bf16*)(F.ws + WS_Z); bf16* Y = (bf16*)(F.ws + WS_Y); const float* ng = INP(I_GNG) + j * 128;
    for (int row = gw; row < M; row += NGW) {
        const float* src = row < ML ? F.out + (size_t)row * D : (const float*)(F.ws + WS_OFC) + (size_t)(row - ML) * D;
        const f32x4* s4 = (const f32x4*)(src + 16 * F.lane);
        float v[16]; float ss = 0.f;
#pragma unroll
        for (int q = 0; q < 4; ++q) { const f32x4 x = s4[q]; v[4 * q] = x.x; v[4 * q + 1] = x.y; v[4 * q + 2] = x.z; v[4 * q + 3] = x.w; ss += (x.x * x.x + x.y * x.y) + (x.z * x.z + x.w * x.w); }
        ss += __shfl_xor(ss, 1); ss += __shfl_xor(ss, 2); ss += __shfl_xor(ss, 4);
        const float rstd = 1.0f / sqrtf(ss * (1.f / 128.f) + EPS);
        const u32x4* g4 = (const u32x4*)(Z + (size_t)row * 4096 + 3072 + 16 * F.lane);
        const int e0 = (16 * F.lane) & 127;
        u32x4 o[2];
#pragma unroll
        for (int q = 0; q < 2; ++q) { const u32x4 gz = g4[q]; unsigned w[4];
#pragma unroll
            for (int i = 0; i < 4; ++i) { const unsigned gg = gz[i]; const float g0 = bf2f(gg & 0xffffu), g1 = bf2f(gg >> 16); const int e = e0 + 8 * q + 2 * i;
                w[i] = pk2(v[8 * q + 2 * i] * rstd * ng[e] * silu_f(g0), v[8 * q + 2 * i + 1] * rstd * ng[e + 1] * silu_f(g1)); }
            o[q] = (u32x4){w[0], w[1], w[2], w[3]}; }
        u32x4* dst = (u32x4*)(Y + (size_t)row * D + 16 * F.lane); dst[0] = o[0]; dst[1] = o[1];
    }
}

__device__ __forceinline__ void step_sconv() {
    const Frame F = make_frame();
    const int gt = F.bid * NTHR + F.tid, NGT = F.G * NTHR;
    const bf16* Z = (const bf16*)(F.ws + WS_Z); bf16* Y = (bf16*)(F.ws + WS_Y); const float* cw = INP(I_SCONV);
    for (int idx = gt; idx < M * 128; idx += NGT) {
        const int row = idx >> 7, c0 = (idx & 127) * 8;
        int t, L, rbase; if (row < ML) { t = row & (T - 1); L = T; rbase = row - t; } else { const int r2 = row - ML; t = r2 & (CT - 1); L = CT; rbase = row - t; }
        float acc[8];
#pragma unroll
        for (int i = 0; i < 8; ++i) acc[i] = 0.f;
#pragma unroll
        for (int tap = 0; tap < 3; ++tap) { const int tt = t + tap - 1;
            if (tt >= 0 && tt < L) { const bf16* zr = Z + (size_t)(rbase + tt) * 3072; const u32x4 cg = *(const u32x4*)(zr + 1024 + c0), hv = *(const u32x4*)(zr + 2048 + c0);
                const f32x4 w0 = *(const f32x4*)(cw + tap * 1024 + c0), w1 = *(const f32x4*)(cw + tap * 1024 + c0 + 4); const float w[8] = {w0.x, w0.y, w0.z, w0.w, w1.x, w1.y, w1.z, w1.w};
#pragma unroll
                for (int i = 0; i < 4; ++i) { acc[2 * i] += w[2 * i] * bf2f(cg[i] & 0xffffu) * bf2f(hv[i] & 0xffffu); acc[2 * i + 1] += w[2 * i + 1] * bf2f(cg[i] >> 16) * bf2f(hv[i] >> 16); } } }
        const u32x4 bg = *(const u32x4*)(Z + (size_t)row * 3072 + c0); u32x4 o;
#pragma unroll
        for (int i = 0; i < 4; ++i) o[i] = pk2(bf2f(bg[i] & 0xffffu) * acc[2 * i], bf2f(bg[i] >> 16) * acc[2 * i + 1]);
        *(u32x4*)(Y + (size_t)row * D + c0) = o;
    }
}

__device__ __forceinline__ void step_rope() {
    const Frame F = make_frame();
    const int gw = F.bid * NWAVES + F.wave, NGW = F.G * NWAVES;
    bf16* Z = (bf16*)(F.ws + WS_Z); const f32x4* R = (const f32x4*)(F.ws + WS_ROPE);
    for (int row = gw; row < M; row += NGW) {
        u32x4* p = (u32x4*)(Z + (size_t)row * 3072 + 32 * F.lane);
        u32x4 v[4];
#pragma unroll
        for (int q = 0; q < 4; ++q) v[q] = p[q];
        const bool lat = row < ML; const float sc = F.lane < 32 ? QSCALE : 1.0f;
        const f32x4* tab = R + ((size_t)(row & (T - 1)) * 32 + 16 * (F.lane & 1)) / 2;
#pragma unroll
        for (int q = 0; q < 4; ++q) {
#pragma unroll
            for (int i = 0; i < 4; i += 2) {
                f32x4 cs = (f32x4){1.f, 0.f, 1.f, 0.f}; if (lat) cs = tab[(4 * q + i) / 2];
                { const unsigned w = v[q][i]; const float x0 = bf2f(w & 0xffffu), x1 = bf2f(w >> 16); v[q][i] = pk2((x0 * cs.x - x1 * cs.y) * sc, (x0 * cs.y + x1 * cs.x) * sc); }
                { const unsigned w = v[q][i + 1]; const float x0 = bf2f(w & 0xffffu), x1 = bf2f(w >> 16); v[q][i + 1] = pk2((x0 * cs.z - x1 * cs.w) * sc, (x0 * cs.w + x1 * cs.z) * sc); }
            }
        }
#pragma unroll
        for (int q = 0; q < 4; ++q) p[q] = v[q];
    }
    bf16* Vt = (bf16*)(F.ws + WS_H);
    LAS bf16* tl = (LAS bf16*)(F.lds + F.wave * 18432);
    for (int it = gw; it < NB * NH * (NKV / 64); it += NGW) {
        const int kt = it % (NKV / 64), bh = it / (NKV / 64), b = bh >> 3, h = bh & 7; const int kv0 = 64 * kt;
        const int srow = kv0 < CT ? ML + b * CT + kv0 : b * T + kv0 - CT;
#pragma unroll 4
        for (int i = 0; i < 16; ++i) { const int r = 4 * i + (F.lane >> 4), cc = (F.lane & 15) * 8;
            const u32x4 v = *(const u32x4*)(Z + (size_t)(srow + r) * 3072 + 2048 + h * 128 + cc);
#pragma unroll
            for (int q = 0; q < 4; ++q) { tl[(cc + 2 * q) * 72 + r] = (bf16)(v[q] & 0xffffu); tl[(cc + 2 * q + 1) * 72 + r] = (bf16)(v[q] >> 16); } }
        LDS_WAIT(); asm volatile("" ::: "memory");
#pragma unroll 4
        for (int i = 0; i < 16; ++i) { const int e = 8 * i + (F.lane >> 3), ch = F.lane & 7;
            const u32x4 v = *(const LAS u32x4*)(tl + e * 72 + ch * 8);
            *(u32x4*)(Vt + ((size_t)(bh * 128 + e)) * NKV + kv0 + ch * 8) = v; }
        LDS_WAIT(); asm volatile("" ::: "memory");
    }
}
__device__ __forceinline__ void step_attn() {
    const Frame F = make_frame();
    const bf16* Z = (const bf16*)(F.ws + WS_Z); const bf16* Vt = (const bf16*)(F.ws + WS_H); bf16* Y = (bf16*)(F.ws + WS_Y);
    LAS float* EX = (LAS float*)F.lds;
    const int r = F.lane & 31, hi = F.lane >> 5, qs = F.wave & 3, m = F.wave >> 2;
    float lmb;
    { const float* lam = INP(I_DLAM); const float t1 = lam[F.lane] * lam[64 + F.lane], t2 = lam[128 + F.lane] * lam[192 + F.lane]; lmb = expf(wave_sum(t1)) - expf(wave_sum(t2)) + LAMBDA_INIT; }
    const float* ng = INP(I_DNG);
    for (int u = F.bid; u < 1056; u += F.G) {
        int b, h, qrow0, nk;
        if (u < 1024) { b = u >> 9; h = (u >> 6) & 7; qrow0 = b * T + (u & 63) * 128; nk = NKV / 32; }
        else { const int v = u - 1024; b = v >> 4; h = (v >> 1) & 7; qrow0 = ML + b * CT + (v & 1) * 128; nk = CT / 32; }
        const int row0 = qrow0 + 32 * qs;
        bf16x8 qf[4];
#pragma unroll
        for (int d0 = 0; d0 < 4; ++d0) qf[d0] = *(const bf16x8*)(Z + (size_t)(row0 + r) * 3072 + h * 128 + m * 64 + d0 * 16 + hi * 8);
        const int kcol = 1024 + h * 128 + m * 64 + hi * 8;
        const bf16* vtb = Vt + (size_t)((b * 8 + h) * 128 + r) * NKV + 4 * hi;
        f32x16 o[4];
#pragma unroll
        for (int i = 0; i < 4; ++i)
#pragma unroll
            for (int q = 0; q < 16; ++q) o[i][q] = 0.f;
        float mref = 0.f, l = 0.f;
        for (int s = 0; s < nk; ++s) {
            const int kv0 = 32 * s; const int krow = kv0 < CT ? ML + b * CT + kv0 : b * T + kv0 - CT;
            const bf16* kp = Z + (size_t)(krow + r) * 3072 + kcol;
            bf16x8 kf[4];
#pragma unroll
            for (int d0 = 0; d0 < 4; ++d0) kf[d0] = *(const bf16x8*)(kp + d0 * 16);
            bf16x8 vf[4][2];
#pragma unroll
            for (int i = 0; i < 4; ++i)
#pragma unroll
                for (int s2 = 0; s2 < 2; ++s2) { const bf16* vp = vtb + (size_t)(32 * i) * NKV + kv0 + 16 * s2; const s16x4 lo = *(const s16x4*)vp, h8 = *(const s16x4*)(vp + 8);
                    vf[i][s2] = (bf16x8){lo[0], lo[1], lo[2], lo[3], h8[0], h8[1], h8[2], h8[3]}; }
            f32x16 S;
#pragma unroll
            for (int q = 0; q < 16; ++q) S[q] = 0.f;
#pragma unroll
            for (int d0 = 0; d0 < 4; ++d0) S = __builtin_amdgcn_mfma_f32_32x32x16_bf16(kf[d0], qf[d0], S, 0, 0, 0);
            float mx = S[0];
#pragma unroll
            for (int q = 1; q < 16; ++q) mx = fmaxf(mx, S[q]);
            mx = fmaxf(mx, __shfl_xor(mx, 32));
            if (s == 0) mref = mx;
            else if (__any(mx > mref)) { const float mn = fmaxf(mref, mx); const float al = __builtin_amdgcn_exp2f(mref - mn); l *= al; mref = mn;
#pragma unroll
                for (int i = 0; i < 4; ++i)
#pragma unroll
                    for (int q = 0; q < 16; ++q) o[i][q] *= al; }
            float ps = 0.f;
#pragma unroll
            for (int q = 0; q < 16; ++q) { S[q] = __builtin_amdgcn_exp2f(S[q] - mref); ps += S[q]; }
            l += ps;
            bf16x8 pf[2];
#pragma unroll
            for (int s2 = 0; s2 < 2; ++s2) { u32x4 w; w.x = pk2(S[8 * s2], S[8 * s2 + 1]); w.y = pk2(S[8 * s2 + 2], S[8 * s2 + 3]); w.z = pk2(S[8 * s2 + 4], S[8 * s2 + 5]); w.w = pk2(S[8 * s2 + 6], S[8 * s2 + 7]); pf[s2] = __builtin_bit_cast(bf16x8, w); }
#pragma unroll
            for (int i = 0; i < 4; ++i)
#pragma unroll
                for (int s2 = 0; s2 < 2; ++s2) o[i] = __builtin_amdgcn_mfma_f32_32x32x16_bf16(vf[i][s2], pf[s2], o[i], 0, 0, 0);
        }
        l += __shfl_xor(l, 32);
        const float f = (m == 1 ? lmb : 1.0f) / l;
        LAS float* ex = EX + (size_t)m * 128 * 129 + (qs * 32 + r) * 129;
#pragma unroll
        for (int i = 0; i < 4; ++i)
#pragma unroll
            for (int q = 0; q < 16; ++q) ex[32 * i + crow(q, hi)] = o[i][q] * f;
        __syncthreads();
#pragma unroll 1
        for (int rr = 0; rr < 16; ++rr) { const int row = 16 * F.wave + rr;
            const float a0 = EX[row * 129 + F.lane] - EX[128 * 129 + row * 129 + F.lane], a1 = EX[row * 129 + 64 + F.lane] - EX[128 * 129 + row * 129 + 64 + F.lane];
            const float rstd = (1.0f - LAMBDA_INIT) / sqrtf(wave_sum(a0 * a0 + a1 * a1) * (1.f / 128.f) + EPS);
            bf16* yr = Y + (size_t)(qrow0 + row) * D + h * 128;
            yr[F.lane] = (bf16)(pk2(a0 * rstd * ng[F.lane], 0.f) & 0xffffu); yr[64 + F.lane] = (bf16)(pk2(a1 * rstd * ng[64 + F.lane], 0.f) & 0xffffu); }
        __syncthreads();
    }
}

#define PACK8(x, b) __builtin_bit_cast(bf16x8, (u32x4){pk2((x)[(b)], (x)[(b) + 1]), pk2((x)[(b) + 2], (x)[(b) + 3]), pk2((x)[(b) + 4], (x)[(b) + 5]), pk2((x)[(b) + 6], (x)[(b) + 7])})
#define MFMA32(a, b, c) __builtin_amdgcn_mfma_f32_32x32x16_bf16((a), (b), (c), 0, 0, 0)
#if defined(SCAN_PROF) || defined(PREP_PROF)
__device__ unsigned long long g_scanprof = 0ull;
#endif
constexpr int PD_BYTES = 12800, PD_ATT = 6144, PD_EG = 12288, PD_EW = 12544;
__device__ __forceinline__ unsigned off_a(unsigned row, unsigned ch) { return 2048u * (row >> 3) + 512u * (ch >> 2) + 64u * (row & 7) + 16u * ((ch & 3) ^ ((row >> 2) & 3)); }
__device__ __forceinline__ int frag_off(int c, int s) {
    const int slot = (c >> 5) == (s >> 5) ? ((c >> 5) ? 2 : 0) : 1, s2 = (s & 31) >> 4, hh = ((s & 15) >> 2) & 1, jj = ((s & 15) >> 3) * 4 + (s & 3), r = c & 31;
    return slot * 2048 + s2 * 1024 + (hh * 32 + r) * 16 + jj * 2;
}
__device__ __forceinline__ void step_gdn_prep(int j, bool overlap, unsigned* flags, bool dry = false, int skip = 0) {
    const Frame F = make_frame();
    LAS float* STG = (LAS float*)F.lds;
    LAS float* KK = (LAS float*)F.lds;
    LAS float* QK = KK + 64 * 68;
    LAS float* LP = (LAS float*)(F.lds + 34816);
    LAS float* TS = (LAS float*)(F.lds + 67584);
    LAS unsigned char* QI = F.lds + 102400; LAS unsigned char* KI = F.lds + 118784;
    LAS float* SM = (LAS float*)(F.lds + 135168);
    LAS unsigned char* VI = F.lds + 136704;
    const __amdgpu_buffer_rsrc_t zrs = __builtin_amdgcn_make_buffer_rsrc((void*)(F.ws + WS_Z), (short)0, (int)((size_t)M * 4096 * 2), 0x00020000);
    const __amdgpu_buffer_rsrc_t prs = __builtin_amdgcn_make_buffer_rsrc((void*)(F.ws + WS_PD), (short)0, (int)((size_t)2 * 16 * 132 * PD_BYTES), 0x00020000);
#define ST16(rs, boff, val) __builtin_amdgcn_raw_buffer_store_b128(__builtin_bit_cast(u32x4, (val)), (rs), (int)(boff), 0, 16)
    bf16* Z = (bf16*)(F.ws + WS_Z); const float* AB = (const float*)(F.ws + WS_AB); const bf16* HALO = (const bf16*)(F.ws + WS_HALO); unsigned char* PD = F.ws + WS_PD;
    const float* cw = INP(I_GCONV) + (size_t)j * 3 * 3072;
    const int r = F.lane & 31, hi = F.lane >> 5;
#ifdef PREP_PROF
    unsigned long long pprof = 0ull, plast = 0ull;
#endif
    const int first = overlap ? 32 : 0;
    int pub = -1;
    for (int it = F.bid - first; it >= 0 && it < NB * NH * 132; it += F.G - first) {
        int n, bh;
        if (overlap) { bh = it & 15; const int pos = it >> 4;
            if (pos < 4) n = pos == 0 ? 0 : (pos == 1 ? 3 : (pos == 2 ? 1 : 2)); else { const int k = pos - 4; n = (k & 1) ? 131 - (k >> 1) : 4 + (k >> 1); } }
        else { n = it % 132; bh = it / 132; }
        const int b = bh >> 3, h = bh & 7;
        const bool isctx = n < 4; const int L = isctx ? CT : T; const int t0 = isctx ? 64 * n : 64 * (n - 4); const int row0 = (isctx ? ML + b * CT : b * T) + t0;
#ifdef PREP_PROF
        { unsigned long long tn_ = __builtin_amdgcn_s_memrealtime(); asm volatile("" : "+v"(tn_)); plast = tn_; }
#endif
        if (F.tid < 384) {
            const int g8 = F.tid % 48, rp = F.tid / 48, part = g8 >> 4, e0 = (g8 & 15) * 8; const int col = part * 1024 + h * 128 + e0;
            const float* wp = cw + col;
            f32x4 wt[3][2];
#pragma unroll
            for (int tap = 0; tap < 3; ++tap) { wt[tap][0] = *(const f32x4*)(wp + tap * 3072); wt[tap][1] = *(const f32x4*)(wp + tap * 3072 + 4); }
            u32x4 zr[10];
#pragma unroll
            for (int ri = 0; ri < 10; ++ri) { const int c = 8 * rp - 1 + ri; const int t = t0 + c;
                const bf16* src = c < 0 ? HALO + ((size_t)((row0 >> 6) - 1) * 2 + 1) * 3072 + col : (c > 63 ? HALO + ((size_t)((row0 >> 6) + 1) * 2) * 3072 + col : Z + (size_t)(row0 + c) * 4096 + col);
                const bool valid = t >= 0 && t < L;
                if (!valid) src = Z + (size_t)row0 * 4096 + col;
                zr[ri] = *(const u32x4*)src; if (!valid) zr[ri] = (u32x4){0u, 0u, 0u, 0u}; }
#pragma unroll
            for (int i = 0; i < 8; ++i) { float o[8];
#pragma unroll
                for (int q = 0; q < 4; ++q) { const unsigned a = zr[i][q], bq = zr[i + 1][q], cq = zr[i + 2][q];
                    o[2 * q] = silu_fast(wt[0][q >> 1][2 * (q & 1)] * bf2f(a & 0xffffu) + wt[1][q >> 1][2 * (q & 1)] * bf2f(bq & 0xffffu) + wt[2][q >> 1][2 * (q & 1)] * bf2f(cq & 0xffffu));
                    o[2 * q + 1] = silu_fast(wt[0][q >> 1][2 * (q & 1) + 1] * bf2f(a >> 16) + wt[1][q >> 1][2 * (q & 1) + 1] * bf2f(bq >> 16) + wt[2][q >> 1][2 * (q & 1) + 1] * bf2f(cq >> 16)); }
                LAS f32x4* dst = (LAS f32x4*)(STG + (8 * rp + i) * 388 + part * 128 + e0); dst[0] = (f32x4){o[0], o[1], o[2], o[3]}; dst[1] = (f32x4){o[4], o[5], o[6], o[7]}; }
        }
        if (F.wave >= 6) {
            const int d = F.wave - 6, c = F.lane; const size_t row = (size_t)(row0 + c);
            const float Aco = expf(INP(I_GALOG)[j * 16 + d * 8 + h]), dtb = INP(I_GDT)[j * 16 + d * 8 + h];
            const float x = AB[row * 32 + d * 8 + h] + dtb, bb = AB[row * 32 + 16 + d * 8 + h];
            const float sp = x > 20.f ? x : log1pf(expf(x));
            float s = -Aco * sp;
#pragma unroll
            for (int o = 1; o < 64; o <<= 1) { const float up = __shfl_up(s, o), dn = __shfl_down(s, o); if (d ? (c + o < 64) : (c >= o)) s += d ? dn : up; }
            SM[d * 64 + c] = 1.f / (1.f + expf(-bb)); SM[128 + d * 64 + c] = s;
        }
        if (pub >= 0) asm volatile("s_waitcnt vmcnt(0)" ::: "memory");
        __syncthreads();
        if (pub >= 0 && F.tid == 0) __hip_atomic_store(flags + pub, 1u, __ATOMIC_RELAXED, __HIP_MEMORY_SCOPE_AGENT);
        pub = -1;
        if (skip & 8) { if (overlap) pub = bh * 132 + n; continue; }
#ifdef PREP_PROF
        { unsigned long long tn_ = __builtin_amdgcn_s_memrealtime(); asm volatile("" : "+v"(tn_)); if (PREP_PROF == 0) pprof += tn_ - plast; plast = tn_; }
#endif
        { const int c = F.tid >> 3, p = F.tid & 7; const LAS float* sr = STG + c * 388 + 8 * p;
            f32x4 qa[2][2], ka[2][2], va[2][2];
#pragma unroll
            for (int i = 0; i < 2; ++i) { qa[i][0] = *(const LAS f32x4*)(sr + 64 * i); qa[i][1] = *(const LAS f32x4*)(sr + 64 * i + 4); ka[i][0] = *(const LAS f32x4*)(sr + 128 + 64 * i); ka[i][1] = *(const LAS f32x4*)(sr + 128 + 64 * i + 4);
                va[i][0] = *(const LAS f32x4*)(sr + 256 + 64 * i); va[i][1] = *(const LAS f32x4*)(sr + 256 + 64 * i + 4); }
            float sq = 0.f, sk = 0.f;
#pragma unroll
            for (int i = 0; i < 2; ++i)
#pragma unroll
                for (int hq = 0; hq < 2; ++hq)
#pragma unroll
                    for (int e = 0; e < 4; ++e) { sq += qa[i][hq][e] * qa[i][hq][e]; sk += ka[i][hq][e] * ka[i][hq][e]; }
#pragma unroll
            for (int o = 1; o < 8; o <<= 1) { sq += __shfl_xor(sq, o); sk += __shfl_xor(sk, o); }
            const float fq = 0.08838834764831845f / sqrtf(sq + EPS), fk = 1.0f / sqrtf(sk + EPS);
#pragma unroll
            for (int i = 0; i < 2; ++i) { const unsigned oo = off_a(c, p + 8 * i);
                *(LAS u32x4*)(QI + oo) = (u32x4){pk2(qa[i][0][0] * fq, qa[i][0][1] * fq), pk2(qa[i][0][2] * fq, qa[i][0][3] * fq), pk2(qa[i][1][0] * fq, qa[i][1][1] * fq), pk2(qa[i][1][2] * fq, qa[i][1][3] * fq)};
                *(LAS u32x4*)(KI + oo) = (u32x4){pk2(ka[i][0][0] * fk, ka[i][0][1] * fk), pk2(ka[i][0][2] * fk, ka[i][0][3] * fk), pk2(ka[i][1][0] * fk, ka[i][1][1] * fk), pk2(ka[i][1][2] * fk, ka[i][1][3] * fk)};
                *(LAS u32x4*)(VI + c * 256 + (p + 8 * i) * 16) = (u32x4){pk2(va[i][0][0], va[i][0][1]), pk2(va[i][0][2], va[i][0][3]), pk2(va[i][1][0], va[i][1][1]), pk2(va[i][1][2], va[i][1][3])}; } }
        __syncthreads();
        if (skip & 4) { if (overlap) pub = bh * 132 + n; continue; }
#ifdef PREP_PROF
        { unsigned long long tn_ = __builtin_amdgcn_s_memrealtime(); asm volatile("" : "+v"(tn_)); if (PREP_PROF == 1) pprof += tn_ - plast; plast = tn_; }
#endif
        { const int prod = F.wave >> 2, mt = (F.wave >> 1) & 1, nt = F.wave & 1; LAS unsigned char* AI = prod ? QI : KI;
            f32x16 acc;
#pragma unroll
            for (int i = 0; i < 16; ++i) acc[i] = 0.f;
#pragma unroll
            for (int ks = 0; ks < 8; ++ks) { const bf16x8 a = *(const LAS bf16x8*)(AI + off_a(32 * mt + r, 2 * ks + hi)), bq = *(const LAS bf16x8*)(KI + off_a(32 * nt + r, 2 * ks + hi));
                acc = __builtin_amdgcn_mfma_f32_32x32x16_bf16(a, bq, acc, 0, 0, 0); }
            LAS float* dst = prod ? QK : KK;
#pragma unroll
            for (int i = 0; i < 16; ++i) dst[(32 * mt + crow(i, hi)) * 68 + 32 * nt + r] = acc[i]; }
        __syncthreads();
        if (skip & 2) { if (overlap) pub = bh * 132 + n; continue; }
#ifdef PREP_PROF
        { unsigned long long tn_ = __builtin_amdgcn_s_memrealtime(); asm volatile("" : "+v"(tn_)); if (PREP_PROF == 2) pprof += tn_ - plast; plast = tn_; }
#endif
        { const int ps = F.tid & 63;
#pragma unroll 8
            for (int k = 0; k < 16; ++k) { const int d = k >> 3, p = (F.tid >> 6) + 8 * (k & 7); const int c = d ? 63 - p : p, s = d ? 63 - ps : ps;
                const float x = SM[d * 64 + c] * KK[c * 68 + s] * exp_fast(fminf(SM[128 + d * 64 + c] - SM[128 + d * 64 + s], 0.f));
                LP[d * 4096 + p * 64 + ps] = ps < p ? x : 0.f; } }
        __syncthreads();
        const unsigned rec = (unsigned)(((b * 8 + h) * 132 + n) * PD_BYTES);
        constexpr unsigned DSTRIDE = 16u * 132u * PD_BYTES;
#ifdef PREP_PROF
        { unsigned long long tn_ = __builtin_amdgcn_s_memrealtime(); asm volatile("" : "+v"(tn_)); if (PREP_PROF == 3) pprof += tn_ - plast; plast = tn_; }
#endif
        float Tc[32];
#pragma unroll
        for (int p = 0; p < 32; ++p) Tc[p] = 0.f;
        if (F.wave < 4) { if (!(skip & 1)) {
            const int d = F.wave >> 1, blk = F.wave & 1, jj = F.lane & 31;
            float Lr[32];
#pragma unroll
            for (int p = 1; p < 32; ++p) Lr[p] = LP[d * 4096 + (32 * blk + p) * 64 + 32 * blk + jj];
#pragma unroll
            for (int p = 0; p < 32; ++p) { float acc[4]; acc[0] = (p == jj) ? 1.f : 0.f; acc[1] = 0.f; acc[2] = 0.f; acc[3] = 0.f;
#pragma unroll
                for (int sx = 0; sx < p; ++sx) { const float l = __int_as_float(__builtin_amdgcn_readlane(__float_as_int(Lr[p]), sx)); acc[sx & 3] -= l * Tc[sx]; }
                Tc[p] = (acc[0] + acc[1]) + (acc[2] + acc[3]); }
            if (F.lane < 32) { const int pc = 32 * blk + jj;
#pragma unroll
                for (int p = 0; p < 32; ++p) { const int pr = 32 * blk + p; TS[d * 4352 + (d ? 63 - pr : pr) * 68 + (d ? 63 - pc : pc)] = Tc[p]; } } }
        } else {
            for (int q = F.tid - 256; q < 768; q += NTHR - 256) { const int d = q / 384, qq = q % 384, slot = qq >> 7, s2 = (qq >> 6) & 1, ln = qq & 63, hh = ln >> 5, rr = ln & 31;
                const int mtr = slot == 0 ? 0 : (slot == 2 ? 1 : (d ? 0 : 1)), mtc = slot == 0 ? 0 : (slot == 2 ? 1 : (d ? 1 : 0));
                const int c = 32 * mtr + rr, sa = 32 * mtc + 16 * s2 + 4 * hh; const float gcc = SM[128 + d * 64 + c];
                const f32x4 qa = *(const LAS f32x4*)(QK + c * 68 + sa), qb = *(const LAS f32x4*)(QK + c * 68 + sa + 8);
                const f32x4 ga = *(const LAS f32x4*)(SM + 128 + d * 64 + sa), gb = *(const LAS f32x4*)(SM + 128 + d * 64 + sa + 8);
                float v[8];
#pragma unroll
                for (int i = 0; i < 4; ++i) { const int s0 = sa + i, s1 = sa + 8 + i; const bool m0 = d ? (s0 >= c) : (s0 <= c), m1 = d ? (s1 >= c) : (s1 <= c);
                    v[i] = m0 ? qa[i] * exp_fast(gcc - ga[i]) : 0.f; v[4 + i] = m1 ? qb[i] * exp_fast(gcc - gb[i]) : 0.f; }
                if (!dry) ST16(prs, rec + d * DSTRIDE + PD_ATT + qq * 16, ((u32x4){pk2(v[0], v[1]), pk2(v[2], v[3]), pk2(v[4], v[5]), pk2(v[6], v[7])})); }
            if (F.tid >= 256 && F.tid < 320) { const int d = (F.tid - 256) >> 5, wh = (F.tid >> 4) & 1, c4 = (F.tid & 15) * 4;
                const float gl = SM[128 + d * 64 + (d ? 0 : 63)]; const f32x4 g4 = *(const LAS f32x4*)(SM + 128 + d * 64 + c4);
                const f32x4 o4 = wh ? (f32x4){expf(gl - g4[0]), expf(gl - g4[1]), expf(gl - g4[2]), expf(gl - g4[3])} : (f32x4){expf(g4[0]), expf(g4[1]), expf(g4[2]), expf(g4[3])};
                if (!dry) ST16(prs, rec + d * DSTRIDE + (wh ? PD_EW : PD_EG) + 4 * c4, o4); }
        }
        __syncthreads();
#ifdef PREP_PROF
        { unsigned long long tn_ = __builtin_amdgcn_s_memrealtime(); asm volatile("" : "+v"(tn_)); if (PREP_PROF == 4) pprof += tn_ - plast; plast = tn_; }
#endif
        if ((F.wave == 0 || F.wave == 2) && !(skip & 1)) {
            const int d = F.wave >> 1;
            f32x16 Mx, R2;
#pragma unroll
            for (int i = 0; i < 16; ++i) { Mx[i] = 0.f; R2[i] = 0.f; }
#define INV_M(ks) do { const LAS f32x4* lp = (const LAS f32x4*)(LP + d * 4096 + (32 + r) * 64 + 16 * (ks) + 8 * hi); const f32x4 l0 = lp[0], l1 = lp[1]; \
                const bf16x8 A_ = __builtin_bit_cast(bf16x8, (u32x4){pk2(l0[0], l0[1]), pk2(l0[2], l0[3]), pk2(l1[0], l1[1]), pk2(l1[2], l1[3])}); \
                const bf16x8 B_ = __builtin_bit_cast(bf16x8, (u32x4){pk2(hi ? Tc[16 * (ks) + 8] : Tc[16 * (ks)], hi ? Tc[16 * (ks) + 9] : Tc[16 * (ks) + 1]), pk2(hi ? Tc[16 * (ks) + 10] : Tc[16 * (ks) + 2], hi ? Tc[16 * (ks) + 11] : Tc[16 * (ks) + 3]), \
                    pk2(hi ? Tc[16 * (ks) + 12] : Tc[16 * (ks) + 4], hi ? Tc[16 * (ks) + 13] : Tc[16 * (ks) + 5]), pk2(hi ? Tc[16 * (ks) + 14] : Tc[16 * (ks) + 6], hi ? Tc[16 * (ks) + 15] : Tc[16 * (ks) + 7])}); \
                Mx = MFMA32(A_, B_, Mx); } while (0)
            INV_M(0); INV_M(1);
#undef INV_M
#pragma unroll
            for (int ks = 0; ks < 2; ++ks) {
                const int cn = d ? 31 - r : 32 + r, ps0 = 32 + 16 * ks + 4 * hi;
                f32x4 ta, tb;
                if (d) { const f32x4 x0 = *(const LAS f32x4*)(TS + 4352 + cn * 68 + (60 - ps0)), x1 = *(const LAS f32x4*)(TS + 4352 + cn * 68 + (52 - ps0));
                    ta = (f32x4){x0[3], x0[2], x0[1], x0[0]}; tb = (f32x4){x1[3], x1[2], x1[1], x1[0]}; }
                else { ta = *(const LAS f32x4*)(TS + cn * 68 + ps0); tb = *(const LAS f32x4*)(TS + cn * 68 + ps0 + 8); }
                const bf16x8 A2 = __builtin_bit_cast(bf16x8, (u32x4){pk2(ta[0], ta[1]), pk2(ta[2], ta[3]), pk2(tb[0], tb[1]), pk2(tb[2], tb[3])});
                const bf16x8 B2 = ks == 0 ? PACK8(Mx, 0) : PACK8(Mx, 8);
                R2 = MFMA32(A2, B2, R2); }
#pragma unroll
            for (int i = 0; i < 16; ++i) { const int pr = 32 + crow(i, hi), pc = r; TS[d * 4352 + (d ? 63 - pr : pr) * 68 + (d ? 63 - pc : pc)] = -R2[i]; }
        }
        __syncthreads();
#ifdef PREP_PROF
        { unsigned long long tn_ = __builtin_amdgcn_s_memrealtime(); asm volatile("" : "+v"(tn_)); if (PREP_PROF == 5) pprof += tn_ - plast; plast = tn_; }
#endif
        for (int q = F.tid; q < 768; q += NTHR) { const int d = q / 384, qq = q % 384, slot = qq >> 7, s2 = (qq >> 6) & 1, ln = qq & 63, hh = ln >> 5, rr = ln & 31;
            const int mtr = slot == 0 ? 0 : (slot == 2 ? 1 : (d ? 0 : 1)), mtc = slot == 0 ? 0 : (slot == 2 ? 1 : (d ? 1 : 0));
            const int c = 32 * mtr + rr, sa = 32 * mtc + 16 * s2 + 4 * hh;
            const f32x4 ta = *(const LAS f32x4*)(TS + d * 4352 + c * 68 + sa), tb = *(const LAS f32x4*)(TS + d * 4352 + c * 68 + sa + 8);
            const f32x4 ba = *(const LAS f32x4*)(SM + d * 64 + sa), bb = *(const LAS f32x4*)(SM + d * 64 + sa + 8);
            if (!dry) ST16(prs, rec + d * DSTRIDE + qq * 16, ((u32x4){pk2(ta[0] * ba[0], ta[1] * ba[1]), pk2(ta[2] * ba[2], ta[3] * ba[3]), pk2(tb[0] * bb[0], tb[1] * bb[1]), pk2(tb[2] * bb[2], tb[3] * bb[3])})); }
        if (!dry) for (int idx = F.tid; idx < 3072; idx += NTHR) { const int img = idx >> 10, pn = idx & 1023;
            ST16(zrs, (unsigned)(((row0 + (pn >> 4)) * 4096 + img * 1024 + h * 128) * 2 + (pn & 15) * 16), *(const LAS u32x4*)((img == 0 ? QI : (img == 1 ? KI : VI)) + pn * 16)); }
#ifdef PREP_PROF
        { unsigned long long tn_ = __builtin_amdgcn_s_memrealtime(); asm volatile("" : "+v"(tn_)); if (PREP_PROF == 6) pprof += tn_ - plast; plast = tn_; }
#endif
        if (overlap && !dry) pub = bh * 132 + n;
        __syncthreads();
#ifdef PREP_PROF
        { unsigned long long tn_ = __builtin_amdgcn_s_memrealtime(); asm volatile("" : "+v"(tn_)); if (PREP_PROF == 7) pprof += tn_ - plast; plast = tn_; }
#endif
    }
    if (pub >= 0) { asm volatile("s_waitcnt vmcnt(0)" ::: "memory"); __syncthreads(); if (F.tid == 0) __hip_atomic_store(flags + pub, 1u, __ATOMIC_RELAXED, __HIP_MEMORY_SCOPE_AGENT); }
#ifdef PREP_PROF
    if (F.bid == 32 && F.tid == 0) g_scanprof += pprof;
#endif
}

typedef short v4i16_t __attribute__((ext_vector_type(4)));
__device__ __forceinline__ float mul_s(float a, float b) { float r; asm("v_mul_f32_e32 %0, %1, %2" : "=v"(r) : "v"(a), "v"(b)); return r; }
__device__ __forceinline__ float fnma_s(float a, float b, float c) { float r; asm("v_fma_f32 %0, -%1, %2, %3" : "=v"(r) : "v"(a), "v"(b), "v"(c)); return r; }
__device__ __forceinline__ void step_convert_rest() {
    const Frame F = make_frame();
    if (F.bid >= 32 && F.G > 32)
        convert_weights(F.ws, 0xffffu & ~((1u << 8) | (1u << 10)), (F.bid - 32) * NWAVES + F.wave, (F.G - 32) * NWAVES, (F.bid - 32) * NTHR + F.tid, (F.G - 32) * NTHR, F.lds, F.wave, F.lane);
}
__device__ __forceinline__ void step_gdn_scan2(const unsigned* flags, int mode = 0) {
    const Frame F = make_frame();
    constexpr int BUF = 61952, B_K = 0, B_Q = 16384, B_V = 32768, B_PD = 49152, OT_BASE = 2 * BUF, OT_ROW = 272, OT_BYTES = 64 * OT_ROW;
    const bf16* Z = (const bf16*)(F.ws + WS_Z); const unsigned char* PD = F.ws + WS_PD;
    const int r = F.lane & 31, hi = F.lane >> 5;
    unsigned* prog = flags ? (unsigned*)flags + 2560 : nullptr;
    const __amdgpu_buffer_rsrc_t ors = __builtin_amdgcn_make_buffer_rsrc((void*)F.out, (short)0, (int)((size_t)2 * ML * D * 2), 0x00020000);
    const __amdgpu_buffer_rsrc_t crs = __builtin_amdgcn_make_buffer_rsrc((void*)(F.ws + WS_OFC), (short)0, (int)((size_t)2 * MC * D * 2), 0x00020000);
    for (int it = F.bid; it < 32; it += F.G) {
        const int b = it >> 4, h = (it >> 1) & 7, dir = it & 1;
        const unsigned char* pdb = PD + (size_t)(((dir * 2 + b) * 8 + h) * 132) * PD_BYTES;
#define CHUNK_OF(sp) (dir ? ((sp) < 4 ? 3 - (sp) : 135 - (sp)) : (sp))
#define ROW0_OF(n) ((n) < 4 ? ML + b * CT + 64 * (n) : b * T + 64 * ((n) - 4))
        if (F.wave >= 4) {
            const int lt = F.tid - 256;
            u32x4 rgA[16], rgB[16];
#define LOAD_CHUNK(rg, sp) do { const int n_ = CHUNK_OF(sp); const int row0_ = ROW0_OF(n_); \
                _Pragma("unroll") for (int i = 0; i < 4; ++i) { const int pn = lt + 256 * i; const unsigned char* src = (const unsigned char*)(Z + (size_t)(row0_ + (pn >> 4)) * 4096 + h * 128) + (pn & 15) * 16; \
                    rg[i] = *(const u32x4*)(src + 2048); rg[4 + i] = *(const u32x4*)src; rg[8 + i] = *(const u32x4*)(src + 4096); \
                    rg[12 + i] = pn < 800 ? *(const u32x4*)(pdb + (size_t)n_ * PD_BYTES + pn * 16) : (u32x4){0u, 0u, 0u, 0u}; } } while (0)
#define WRITE_CHUNK(rg, bufb) do { LAS unsigned char* base_ = F.lds + (bufb); \
                _Pragma("unroll") for (int i = 0; i < 4; ++i) { const int pn = lt + 256 * i; *(LAS u32x4*)(base_ + B_K + pn * 16) = rg[i]; *(LAS u32x4*)(base_ + B_Q + pn * 16) = rg[4 + i]; \
                    *(LAS u32x4*)(base_ + B_V + pn * 16) = rg[8 + i]; if (pn < 800) *(LAS u32x4*)(base_ + B_PD + pn * 16) = rg[12 + i]; } } while (0)
            int acq = flags ? -1 : 1000;
#define ENSURE(tgt) do { const int tg_ = (tgt); if (F.wave == 4 && tg_ < 132 && acq < tg_) { const unsigned* fb_ = flags + (b * 8 + h) * 132; unsigned spins_ = 0; \
                    while (__hip_atomic_load(fb_ + CHUNK_OF(tg_), __ATOMIC_RELAXED, __HIP_MEMORY_SCOPE_AGENT) == 0u) { __builtin_amdgcn_s_sleep(2); if (++spins_ > (1u << 24)) break; } \
                    int e_ = tg_; while (e_ + 1 < 132 && e_ < tg_ + 16 && __hip_atomic_load(fb_ + CHUNK_OF(e_ + 1), __ATOMIC_RELAXED, __HIP_MEMORY_SCOPE_AGENT) != 0u) ++e_; \
                    __builtin_amdgcn_fence(__ATOMIC_ACQUIRE, "agent"); asm volatile("s_waitcnt vmcnt(0)" ::: "memory"); acq = e_; } } while (0)
            ENSURE(0); ENSURE(1); ENSURE(2);
            __syncthreads();
            LOAD_CHUNK(rgA, 0); WRITE_CHUNK(rgA, 0); LOAD_CHUNK(rgA, 1); LOAD_CHUNK(rgB, 2); ENSURE(3);
            __syncthreads();
#define STORE_O(sq) do { const int n_ = CHUNK_OF(sq); const int row0_ = ROW0_OF(n_); \
                const LAS unsigned char* ot_ = F.lds + OT_BASE + ((sq) & 1) * OT_BYTES; \
                _Pragma("unroll") for (int i = 0; i < 4; ++i) { const int pn = lt + 256 * i; const u32x4 v_ = *(const LAS u32x4*)(ot_ + (pn >> 4) * OT_ROW + (pn & 15) * 16); \
                    if (!(mode & 1)) { if (n_ < 4) __builtin_amdgcn_raw_buffer_store_b128(v_, crs, (int)((((dir * MC + (row0_ - ML) + (pn >> 4)) * D + h * 128) * 2) + (pn & 15) * 16), 0, 16); \
                        else __builtin_amdgcn_raw_buffer_store_b128(v_, ors, (int)((((dir * ML + row0_ + (pn >> 4)) * D + h * 128) * 2) + (pn & 15) * 16), 0, 16); } } } while (0)
#define LOADER_ITER(rg, sp) do { \
                if (prog && (sp) >= 2 && F.tid == 256) (void)__hip_atomic_fetch_add(prog + (b * 132 + CHUNK_OF((sp) - 2)) * 4, 1u, __ATOMIC_RELAXED, __HIP_MEMORY_SCOPE_AGENT); \
                if ((sp) + 1 < 132 && !(mode & 4)) WRITE_CHUNK(rg, (((sp) + 1) & 1) * BUF); \
                if ((sp) > 0) STORE_O((sp) - 1); \
                asm volatile("" ::: "memory"); \
                if ((sp) + 3 < 132 && !(mode & 8)) LOAD_CHUNK(rg, (sp) + 3); \
                ENSURE((sp) + 4); \
                if ((sp) + 3 < 132 && !(mode & 8)) asm volatile("s_waitcnt vmcnt(15)" ::: "memory"); else asm volatile("s_waitcnt vmcnt(0)" ::: "memory"); \
                __syncthreads(); } while (0)
            for (int sp = 0; sp < 132; sp += 2) { LOADER_ITER(rgA, sp); LOADER_ITER(rgB, sp + 1); }
#undef LOADER_ITER
            STORE_O(131);
            asm volatile("s_waitcnt vmcnt(0)" ::: "memory");
            __syncthreads();
            if (prog && F.tid == 256) { for (int s_ = 130; s_ < 132; ++s_) (void)__hip_atomic_fetch_add(prog + (b * 132 + CHUNK_OF(s_)) * 4, 1u, __ATOMIC_RELAXED, __HIP_MEMORY_SCOPE_AGENT); }
#undef STORE_O
#undef ENSURE
#undef LOAD_CHUNK
#undef WRITE_CHUNK
        } else {
            const int w = F.wave;
#ifdef SCAN_PROF
            unsigned long long tprof = 0ull, tlast = 0ull;
#endif
            f32x16 S[4];
#pragma unroll
            for (int kt = 0; kt < 4; ++kt)
#pragma unroll
                for (int i = 0; i < 16; ++i) S[kt][i] = 0.f;
            const int x = (r >> 2) & 3; const int rowb = 2048 * (r >> 3) + 64 * (r & 7);
            int oa[2], ob[2];
#pragma unroll
            for (int s2 = 0; s2 < 2; ++s2) { oa[s2] = rowb + 16 * ((2 * s2) ^ x) + 8 * hi; ob[s2] = rowb + 16 * ((2 * s2 + 1) ^ x) + 8 * hi; }
            const int blk = (F.lane >> 4) & 1, q = (F.lane & 15) >> 2, p = F.lane & 3, cb = 2 * blk + (p >> 1);
            int trb[2];
#pragma unroll
            for (int t = 0; t < 2; ++t) trb[t] = 64 * (4 * hi + q) + 8 * (p & 1) + 16 * (cb ^ ((2 * t + hi) & 3)) + 2048 * t;
            const int vb = 4 * hi * 256 + (32 * w + r) * 2;
            __syncthreads();
            __syncthreads();
            for (int sp = 0; sp < 132; ++sp) {
                const int n = CHUNK_OF(sp); const int row0 = ROW0_OF(n);
                LAS unsigned char* B = F.lds + (sp & 1) * BUF;
                LAS unsigned char* KI = B + B_K; LAS unsigned char* QI = B + B_Q; LAS unsigned char* VI = B + B_V; LAS unsigned char* PR = B + B_PD;
#ifdef SCAN_PROF
                { const unsigned long long tn_ = __builtin_amdgcn_s_memrealtime(); if (SCAN_PROF == 7 && sp > 0) tprof += tn_ - tlast; tlast = tn_; }
#endif
                const int xk = dir ? 8192 : 0, xe = dir ? 128 : 0, xs = dir ? 4096 : 0, xo = dir ? 32 * OT_ROW : 0;
                LAS unsigned char* Kt[2] = {KI + xk, KI + (8192 - xk)}; LAS unsigned char* Qt[2] = {QI + xk, QI + (8192 - xk)}; LAS unsigned char* Vt[2] = {VI + vb + xk, VI + vb + (8192 - xk)};
                LAS unsigned char* Et[2] = {PR + xe, PR + (128 - xe)};
                LAS unsigned char* Tt[2] = {PR + xs + F.lane * 16, PR + (4096 - xs) + F.lane * 16}; LAS unsigned char* Tx = PR + 2048 + F.lane * 16;
#define LDF(dst, base, kt) do { _Pragma("unroll") for (int s2 = 0; s2 < 2; ++s2) _Pragma("unroll") for (int mt = 0; mt < 2; ++mt) { \
                    dst[s2][mt][0] = *(const volatile LAS s16x4*)(base[mt] + 512 * (kt) + oa[s2]); dst[s2][mt][1] = *(const volatile LAS s16x4*)(base[mt] + 512 * (kt) + ob[s2]); } } while (0)
#define FRAG(f) ((bf16x8){f[0][0], f[0][1], f[0][2], f[0][3], f[1][0], f[1][1], f[1][2], f[1][3]})
#define MM_KS(f, kt) do { _Pragma("unroll") for (int s2 = 0; s2 < 2; ++s2) _Pragma("unroll") for (int mt = 0; mt < 2; ++mt) KS[mt] = MFMA32(FRAG(f[s2][mt]), Sb[kt][s2], KS[mt]); \
                    _Pragma("unroll") for (int i = 0; i < 16; ++i) S[kt][i] *= cd; } while (0)
#define MM_QS(f, kt) do { if (!(mode & 2)) { _Pragma("unroll") for (int s2 = 0; s2 < 2; ++s2) _Pragma("unroll") for (int mt = 0; mt < 2; ++mt) QS[mt] = MFMA32(Sb[kt][s2], FRAG(f[s2][mt]), QS[mt]); } } while (0)
#define LDV(vd, ed, g) do { _Pragma("unroll") for (int mt = 0; mt < 2; ++mt) { ed[mt] = *(const LAS f32x4*)(Et[mt] + PD_EG + 4 * (8 * (g) + 4 * hi)); \
                    _Pragma("unroll") for (int i = 0; i < 4; ++i) vd[mt][i] = *(const LAS bf16*)(Vt[mt] + (8 * (g) + i) * 256); } } while (0)
#define RPART(vd, ed, g) do { _Pragma("unroll") for (int mt = 0; mt < 2; ++mt) _Pragma("unroll") for (int i = 0; i < 4; ++i) R8[mt][4 * ((g) & 1) + i] = bf2f(vd[mt][i]) - ed[mt][i] * KS[mt][4 * (g) + i]; \
                    if ((g) & 1) { Rb[0][(g) >> 1] = PACK8(R8[0], 0); Rb[1][(g) >> 1] = PACK8(R8[1], 0); } } while (0)
#define FENCE asm volatile("" ::: "memory")
                s16x4 fa[2][2][2], fb[2][2][2]; bf16 va[2][4]; f32x4 ea[2];
                LDF(fa, Kt, 0); FENCE;
                bf16x8 Sb[4][2];
#pragma unroll
                for (int kt = 0; kt < 4; ++kt) { Sb[kt][0] = PACK8(S[kt], 0); Sb[kt][1] = PACK8(S[kt], 8); }
                const float cd = *(const LAS float*)(PR + PD_EG + 4 * (dir ? 0 : 63));
                f32x16 KS[2], QS[2]; float R8[2][8]; bf16x8 Rb[2][2];
#pragma unroll
                for (int i = 0; i < 16; ++i) { KS[0][i] = 0.f; KS[1][i] = 0.f; }
                LDF(fb, Kt, 1); FENCE; MM_KS(fa, 0);
                LDF(fa, Kt, 2); FENCE; MM_KS(fb, 1);
                LDF(fb, Kt, 3); FENCE; MM_KS(fa, 2);
                LDF(fa, Qt, 0); FENCE; MM_KS(fb, 3);
#ifdef SCAN_PROF
                { const unsigned long long tn_ = __builtin_amdgcn_s_memrealtime(); if (SCAN_PROF == 0) tprof += tn_ - tlast; tlast = tn_; }
#endif
#pragma unroll
                for (int i = 0; i < 16; ++i) { QS[0][i] = 0.f; QS[1][i] = 0.f; }
                LDV(va, ea, 0); FENCE; MM_QS(fa, 0); LDF(fa, Qt, 1); FENCE; RPART(va, ea, 0);
                LDV(va, ea, 1); FENCE; MM_QS(fa, 1); LDF(fa, Qt, 2); FENCE; RPART(va, ea, 1);
                LDV(va, ea, 2); FENCE; MM_QS(fa, 2); LDF(fa, Qt, 3); FENCE; RPART(va, ea, 2);
                LDV(va, ea, 3);
                bf16x8 tf[6];
#pragma unroll
                for (int s2 = 0; s2 < 2; ++s2) { tf[s2] = *(const LAS bf16x8*)(Tt[0] + 1024 * s2); tf[2 + s2] = *(const LAS bf16x8*)(Tt[1] + 1024 * s2); tf[4 + s2] = *(const LAS bf16x8*)(Tx + 1024 * s2); }
                FENCE; MM_QS(fa, 3); RPART(va, ea, 3);
                asm volatile("" ::: "memory");
#ifdef SCAN_PROF
                { const unsigned long long tn_ = __builtin_amdgcn_s_memrealtime(); if (SCAN_PROF == 1) tprof += tn_ - tlast; tlast = tn_; }
#endif
                f32x16 vn[2], o[2];
#pragma unroll
                for (int i = 0; i < 16; ++i) { vn[0][i] = 0.f; vn[1][i] = 0.f; }
                vn[0] = MFMA32(tf[0], Rb[0][0], vn[0]); vn[1] = MFMA32(tf[2], Rb[1][0], vn[1]);
                vn[0] = MFMA32(tf[1], Rb[0][1], vn[0]); vn[1] = MFMA32(tf[3], Rb[1][1], vn[1]);
                vn[1] = MFMA32(tf[4], Rb[0][0], vn[1]); vn[1] = MFMA32(tf[5], Rb[0][1], vn[1]);
                f32x4 w4[2][4];
#pragma unroll
                for (int mt = 0; mt < 2; ++mt) { const float eq = *(const LAS float*)(Et[mt] + PD_EG + 4 * r);
#pragma unroll
                    for (int g = 0; g < 4; ++g) w4[mt][g] = *(const LAS f32x4*)(Et[mt] + PD_EW + 4 * (8 * g + 4 * hi));
#pragma unroll
                    for (int i = 0; i < 16; ++i) o[mt][i] = eq * QS[mt][i]; }
#pragma unroll
                for (int s2 = 0; s2 < 2; ++s2) { tf[s2] = *(const LAS bf16x8*)(Tt[0] + PD_ATT + 1024 * s2); tf[2 + s2] = *(const LAS bf16x8*)(Tt[1] + PD_ATT + 1024 * s2); tf[4 + s2] = *(const LAS bf16x8*)(Tx + PD_ATT + 1024 * s2); }
                asm volatile("" ::: "memory");
#ifdef SCAN_PROF
                { const unsigned long long tn_ = __builtin_amdgcn_s_memrealtime(); if (SCAN_PROF == 2) tprof += tn_ - tlast; tlast = tn_; }
#endif
                bf16x8 Vb[2][2], Wb[2][2];
#pragma unroll
                for (int mt = 0; mt < 2; ++mt) { f32x16 W;
#pragma unroll
                    for (int g = 0; g < 4; ++g)
#pragma unroll
                        for (int i = 0; i < 4; ++i) W[4 * g + i] = w4[mt][g][i] * vn[mt][4 * g + i];
                    Vb[mt][0] = PACK8(vn[mt], 0); Vb[mt][1] = PACK8(vn[mt], 8); Wb[mt][0] = PACK8(W, 0); Wb[mt][1] = PACK8(W, 8); }
#ifdef SCAN_PROF
                { const unsigned long long tn_ = __builtin_amdgcn_s_memrealtime(); if (SCAN_PROF == 3) tprof += tn_ - tlast; tlast = tn_; }
#endif
                if (!(mode & 2)) {
                o[0] = MFMA32(Vb[0][0], tf[0], o[0]); o[1] = MFMA32(Vb[1][0], tf[2], o[1]);
                o[0] = MFMA32(Vb[0][1], tf[1], o[0]); o[1] = MFMA32(Vb[1][1], tf[3], o[1]);
                o[1] = MFMA32(Vb[0][0], tf[4], o[1]); o[1] = MFMA32(Vb[0][1], tf[5], o[1]);
                }
#ifdef SCAN_PROF
                { const unsigned long long tn_ = __builtin_amdgcn_s_memrealtime(); if (SCAN_PROF == 4) tprof += tn_ - tlast; tlast = tn_; }
#endif
#define TRD(dst, n) do { _Pragma("unroll") for (int kt = 0; kt < 4; ++kt) { \
                    dst[kt][0] = __builtin_bit_cast(s16x4, __builtin_amdgcn_ds_read_tr16_b64_v4i16((LAS v4i16_t*)(Kt[(n) >> 1] + 4096 * ((n) & 1) + 512 * kt + trb[0]))); \
                    dst[kt][1] = __builtin_bit_cast(s16x4, __builtin_amdgcn_ds_read_tr16_b64_v4i16((LAS v4i16_t*)(Kt[(n) >> 1] + 4096 * ((n) & 1) + 512 * kt + trb[1]))); } } while (0)
#define MM_S(f, n) do { _Pragma("unroll") for (int kt = 0; kt < 4; ++kt) S[kt] = MFMA32(FRAG(f[kt]), Wb[(n) >> 1][(n) & 1], S[kt]); } while (0)
                s16x4 ta[4][2], tb[4][2];
                TRD(ta, 0); FENCE;
                TRD(tb, 1); FENCE; MM_S(ta, 0);
                TRD(ta, 2); FENCE; MM_S(tb, 1);
                TRD(tb, 3); FENCE; MM_S(ta, 2);
                {
                    LAS unsigned char* oc = F.lds + OT_BASE + (sp & 1) * OT_BYTES + r * OT_ROW + 64 * w + 8 * hi;
#pragma unroll
                    for (int m2 = 0; m2 < 2; ++m2)
#pragma unroll
                        for (int g = 0; g < 4; ++g) *(LAS u32x2*)(oc + (m2 ? 32 * OT_ROW - xo : xo) + 16 * g) = (u32x2){pk2(o[m2][4 * g], o[m2][4 * g + 1]), pk2(o[m2][4 * g + 2], o[m2][4 * g + 3])}; }
                FENCE; MM_S(tb, 3);
#undef TRD
#undef MM_S
#undef FENCE
#undef LDF
#undef FRAG
#undef MM_KS
#undef MM_QS
#undef LDV
#undef RPART
#ifdef SCAN_PROF
                { const unsigned long long tn_ = __builtin_amdgcn_s_memrealtime(); if (SCAN_PROF == 5) tprof += tn_ - tlast; tlast = tn_; }
#endif
                __syncthreads();
            }
            __syncthreads();
#ifdef SCAN_PROF
            if (it == 0 && w == 0 && F.lane == 0) g_scanprof += tprof;
#endif
        }
#undef CHUNK_OF
#undef ROW0_OF
    }
}
__device__ __forceinline__ void gdn_norm_rows(const Frame& F, int j, int row_first, int row_end, int row_step) {
    const bf16* Z = (const bf16*)(F.ws + WS_Z); bf16* Y = (bf16*)(F.ws + WS_Z); const float* ng = INP(I_GNG) + j * 128;
    const int e0 = (16 * F.lane) & 127;
    for (int row = row_first; row < row_end; row += 2 * row_step) {
        const int rowB = row + row_step; const bool hasB = rowB < row_end; const int rB = hasB ? rowB : row;
        u32x4 a[2][2], bq[2][2], gz[2][2];
#pragma unroll
        for (int t = 0; t < 2; ++t) { const int rr = t ? rB : row;
            const bf16* of = rr < ML ? (const bf16*)F.out + (size_t)rr * D : (const bf16*)(F.ws + WS_OFC) + (size_t)(rr - ML) * D;
            const bf16* ob = rr < ML ? of + (size_t)ML * D : of + (size_t)MC * D;
            const u32x4* f4 = (const u32x4*)(of + 16 * F.lane); const u32x4* b4 = (const u32x4*)(ob + 16 * F.lane); const u32x4* g4 = (const u32x4*)(Z + (size_t)rr * 4096 + 3072 + 16 * F.lane);
            a[t][0] = f4[0]; a[t][1] = f4[1]; bq[t][0] = b4[0]; bq[t][1] = b4[1]; gz[t][0] = g4[0]; gz[t][1] = g4[1]; }
#pragma unroll
        for (int t = 0; t < 2; ++t) { const int rr = t ? rB : row;
            float v[16]; float ss = 0.f;
#pragma unroll
            for (int q = 0; q < 2; ++q)
#pragma unroll
                for (int i = 0; i < 4; ++i) { const float x0 = bf2f(a[t][q][i] & 0xffffu) + bf2f(bq[t][q][i] & 0xffffu), x1 = bf2f(a[t][q][i] >> 16) + bf2f(bq[t][q][i] >> 16); v[8 * q + 2 * i] = x0; v[8 * q + 2 * i + 1] = x1; ss += x0 * x0 + x1 * x1; }
            ss += __shfl_xor(ss, 1); ss += __shfl_xor(ss, 2); ss += __shfl_xor(ss, 4);
            const float rstd = 1.0f / sqrtf(ss * (1.f / 128.f) + EPS);
            u32x4 o[2];
#pragma unroll
            for (int q = 0; q < 2; ++q) { unsigned wv[4];
#pragma unroll
                for (int i = 0; i < 4; ++i) { const unsigned gg = gz[t][q][i]; const float g0 = bf2f(gg & 0xffffu), g1 = bf2f(gg >> 16); const int e = e0 + 8 * q + 2 * i;
                    wv[i] = pk2(v[8 * q + 2 * i] * rstd * ng[e] * silu_f(g0), v[8 * q + 2 * i + 1] * rstd * ng[e + 1] * silu_f(g1)); }
                o[q] = (u32x4){wv[0], wv[1], wv[2], wv[3]}; }
            if (t == 0 || hasB) { u32x4* dst = (u32x4*)(Y + (size_t)rr * 4096 + 16 * F.lane); dst[0] = o[0]; dst[1] = o[1]; } }
    }
}
__device__ __forceinline__ void step_gdn_norm2(int j) {
    const Frame F = make_frame();
    gdn_norm_rows(F, j, F.bid * NWAVES + F.wave, M, F.G * NWAVES);
}
__device__ __forceinline__ void step_gdn_follow(int j, const unsigned* flags) {
    const Frame F = make_frame();
    if (F.bid < 32) return;
    const unsigned* prog = flags + 2560;
    for (int uu = F.bid - 32; uu < 528; uu += F.G - 32) {
        const int u = uu >> 1, half = uu & 1;
        int b, n;
        if (u < 8) { b = u & 1; n = u >> 1; } else { const int v = u - 8, wq = v >> 1, jq = wq >> 1; b = v & 1; n = (wq & 1) ? 68 + jq : 67 - jq; }
        if (F.wave == 0) {
            unsigned spins = 0;
            while ((unsigned)__builtin_amdgcn_readfirstlane(__hip_atomic_load(prog + (b * 132 + n) * 4, __ATOMIC_RELAXED, __HIP_MEMORY_SCOPE_AGENT)) < 16u) { __builtin_amdgcn_s_sleep(32); if (++spins > (1u << 20)) break; }
            __builtin_amdgcn_fence(__ATOMIC_ACQUIRE, "agent"); asm volatile("s_waitcnt vmcnt(0)" ::: "memory");
        }
        __syncthreads();
        const int row0 = (n < 4 ? ML + b * CT + 64 * n : b * T + 64 * (n - 4)) + 32 * half;
        gdn_norm_rows(F, j, row0 + F.wave, row0 + 32, NWAVES);
    }
}

__device__ __forceinline__ void step_rope2() {
    const Frame F = make_frame();
    const int gw = F.bid * NWAVES + F.wave, NGW = F.G * NWAVES;
    bf16* Z = (bf16*)(F.ws + WS_Z); const f32x4* R = (const f32x4*)(F.ws + WS_ROPE);
    for (int row = gw; row < M; row += NGW) {
        u32x4* p = (u32x4*)(Z + (size_t)row * 3072 + 32 * F.lane);
        u32x4 v[4];
#pragma unroll
        for (int q = 0; q < 4; ++q) v[q] = p[q];
        const bool lat = row < ML; const float sc = F.lane < 32 ? QSCALE : 1.0f;
        const f32x4* tab = R + ((size_t)(row & (T - 1)) * 32 + 16 * (F.lane & 1)) / 2;
#pragma unroll
        for (int q = 0; q < 4; ++q) {
#pragma unroll
            for (int i = 0; i < 4; i += 2) {
                f32x4 cs = (f32x4){1.f, 0.f, 1.f, 0.f}; if (lat) cs = tab[(4 * q + i) / 2];
                { const unsigned w = v[q][i]; const float x0 = bf2f(w & 0xffffu), x1 = bf2f(w >> 16); v[q][i] = pk2((x0 * cs.x - x1 * cs.y) * sc, (x0 * cs.y + x1 * cs.x) * sc); }
                { const unsigned w = v[q][i + 1]; const float x0 = bf2f(w & 0xffffu), x1 = bf2f(w >> 16); v[q][i + 1] = pk2((x0 * cs.z - x1 * cs.w) * sc, (x0 * cs.w + x1 * cs.z) * sc); }
            }
        }
#pragma unroll
        for (int q = 0; q < 4; ++q) p[q] = v[q];
    }
}
#define ATT_THR 4.0f
__device__ __forceinline__ void att_softmax(f32x16& p0, f32x16& p1, float& m_reg, float& l, float& alpha, bf16x8 (&pf)[2][2]) {
    float mx = fmaxf(p0[0], p1[0]);
#pragma unroll
    for (int q = 1; q < 16; ++q) mx = fmaxf(mx, fmaxf(p0[q], p1[q]));
    mx = fmaxf(mx, __shfl_xor(mx, 32));
    const float mn = (mx - m_reg > ATT_THR) ? mx : m_reg; alpha = __builtin_amdgcn_exp2f(m_reg - mn); m_reg = mn;
    float ps = 0.f;
#pragma unroll
    for (int q = 0; q < 16; ++q) { p0[q] = __builtin_amdgcn_exp2f(p0[q] - m_reg); p1[q] = __builtin_amdgcn_exp2f(p1[q] - m_reg); ps += p0[q] + p1[q]; }
    l = l * alpha + ps;
    pf[0][0] = PACK8(p0, 0); pf[0][1] = PACK8(p0, 8); pf[1][0] = PACK8(p1, 0); pf[1][1] = PACK8(p1, 8);
}
__device__ __forceinline__ void step_attn2(int mode = 0) {
    const Frame F = make_frame();
    const bf16* Z = (const bf16*)(F.ws + WS_Z); bf16* Y = (bf16*)(F.ws + WS_Y);
    LAS float* EX = (LAS float*)F.lds;
    constexpr int KB0 = 0, VB0 = 65536;
    const int r = F.lane & 31, hi = F.lane >> 5, qs = F.wave & 3, m = F.wave >> 2;
    float lmb;
    { const float* lam = INP(I_DLAM); const float t1 = lam[F.lane] * lam[64 + F.lane], t2 = lam[128 + F.lane] * lam[192 + F.lane]; lmb = expf(wave_sum(t1)) - expf(wave_sum(t2)) + LAMBDA_INIT; }
    const float* ng = INP(I_DNG);
    const int kro = 2048 * (r >> 3) + 64 * (r & 7); const int xk = (r >> 2) & 3;
    int koff[2];
#pragma unroll
    for (int d0 = 0; d0 < 2; ++d0) koff[d0] = kro + 1024 * m + 16 * (((2 * d0 + hi) & 3) ^ xk);
    const int blk = (F.lane >> 4) & 1, q4 = (F.lane & 15) >> 2, p4 = F.lane & 3, cb = 2 * blk + (p4 >> 1);
    int trb[2];
#pragma unroll
    for (int t = 0; t < 2; ++t) trb[t] = 64 * (4 * hi + q4) + 8 * (p4 & 1) + 16 * (cb ^ ((2 * t + hi) & 3)) + 2048 * t;
    const int drow = 8 * F.wave + ((F.lane & 31) >> 2);
    const unsigned goff = (unsigned)(drow * 6144 + 16 * (4 * (F.lane >> 5) + ((F.lane & 3) ^ ((drow >> 2) & 3))));
    const unsigned ldsw = (unsigned)F.wave * 2048u;
    const int xcd = F.bid & 7, cux = F.bid >> 3;
    for (int ui = 0; ui < 5; ++ui) {
        int b, h, qrow0, nt;
        if (F.G == 256) {
            h = xcd;
            if (ui < 4) { b = ui >> 1; qrow0 = b * T + (cux + 32 * (ui & 1)) * 128; nt = NKV / 64; }
            else { if (cux >= 4) break; b = cux >> 1; qrow0 = ML + b * CT + (cux & 1) * 128; nt = CT / 64; }
        } else {
            const int u = F.bid + ui * F.G; if (u >= 1056) break;
            if (u < 1024) { b = u >> 9; h = (u >> 6) & 7; qrow0 = b * T + (u & 63) * 128; nt = NKV / 64; }
            else { const int v = u - 1024; b = v >> 4; h = (v >> 1) & 7; qrow0 = ML + b * CT + (v & 1) * 128; nt = CT / 64; }
        }
        const int row0 = qrow0 + 32 * qs;
        bf16x8 qf[4];
#pragma unroll
        for (int d0 = 0; d0 < 4; ++d0) qf[d0] = *(const bf16x8*)(Z + (size_t)(row0 + r) * 3072 + h * 128 + m * 64 + d0 * 16 + hi * 8);
        asm volatile("" : "+v"(qf[0]), "+v"(qf[1]), "+v"(qf[2]), "+v"(qf[3]));
        asm volatile("s_waitcnt vmcnt(0)" ::: "memory");
        const char* kgb = (const char*)(Z + 1024 + h * 128); const char* vgb = (const char*)(Z + 2048 + h * 128);
#define KVROW(t) ((t) < CT / 64 ? ML + b * CT + 64 * (t) : b * T + 64 * (t) - CT)
#define DMAK(t) do { if (mode & 8) break; const int t_ = (t) < nt ? (t) : nt - 1; const char* g_ = kgb + (size_t)KVROW(t_) * 6144 + goff; LAS unsigned char* d_ = F.lds + KB0 + ((t) & 3) * 16384 + ldsw; \
            __builtin_amdgcn_global_load_lds((const unsigned*)g_, (LAS unsigned*)d_, 16, 0, 0); __builtin_amdgcn_global_load_lds((const unsigned*)(g_ + 128), (LAS unsigned*)(d_ + 1024), 16, 0, 0); } while (0)
#define DMAV(t) do { if (mode & 8) break; const int t_ = (t) < nt ? (t) : nt - 1; const char* g_ = vgb + (size_t)KVROW(t_) * 6144 + goff; LAS unsigned char* d_ = F.lds + VB0 + ((t) & 3) * 16384 + ldsw; \
            __builtin_amdgcn_global_load_lds((const unsigned*)g_, (LAS unsigned*)d_, 16, 0, 0); __builtin_amdgcn_global_load_lds((const unsigned*)(g_ + 128), (LAS unsigned*)(d_ + 1024), 16, 0, 0); } while (0)
#define WAIT_BAR(N) do { asm volatile("s_waitcnt vmcnt(" #N ") lgkmcnt(0)" ::: "memory"); __builtin_amdgcn_s_barrier(); asm volatile("" ::: "memory"); } while (0)
#define KRD(KI_, f, S) S = *(const LAS bf16x8*)((KI_) + 8192 * ((f) & 1) + 512 * ((f) >> 2) + koff[((f) >> 1) & 1])
#define KMF(f, S, P0, P1) do { if ((f) & 1) P1 = MFMA32(S, qf[(f) >> 1], P1); else P0 = MFMA32(S, qf[(f) >> 1], P0); asm volatile("" ::: "memory"); } while (0)
#define QKT(P0, P1, t) do { LAS unsigned char* KI_ = F.lds + KB0 + ((t) & 3) * 16384; bf16x8 kA, kB, kC; \
            _Pragma("unroll") for (int q_ = 0; q_ < 16; ++q_) { P0[q_] = 0.f; P1[q_] = 0.f; } \
            KRD(KI_, 0, kA); KRD(KI_, 1, kB); \
            KRD(KI_, 2, kC); KMF(0, kA, P0, P1); KRD(KI_, 3, kA); KMF(1, kB, P0, P1); KRD(KI_, 4, kB); KMF(2, kC, P0, P1); KRD(KI_, 5, kC); KMF(3, kA, P0, P1); \
            KRD(KI_, 6, kA); KMF(4, kB, P0, P1); KRD(KI_, 7, kB); KMF(5, kC, P0, P1); KMF(6, kA, P0, P1); KMF(7, kB, P0, P1); } while (0)
#define VRD(VI_, f, S0, S1) do { S0 = __builtin_bit_cast(s16x4, __builtin_amdgcn_ds_read_tr16_b64_v4i16((LAS v4i16_t*)((VI_) + 8192 * (((f) >> 1) & 1) + 4096 * ((f) & 1) + 512 * ((f) >> 2) + trb[0]))); \
            S1 = __builtin_bit_cast(s16x4, __builtin_amdgcn_ds_read_tr16_b64_v4i16((LAS v4i16_t*)((VI_) + 8192 * (((f) >> 1) & 1) + 4096 * ((f) & 1) + 512 * ((f) >> 2) + trb[1]))); } while (0)
#define VMF(f, S0, S1, PF) do { if (!(mode & 4)) o[(f) >> 2] = MFMA32(((bf16x8){S0[0], S0[1], S0[2], S0[3], S1[0], S1[1], S1[2], S1[3]}), PF[((f) >> 1) & 1][(f) & 1], o[(f) >> 2]); asm volatile("" ::: "memory"); } while (0)
#define PVQ0(VI_, PF) do { VRD(VI_, 0, vA0, vA1); VRD(VI_, 1, vB0, vB1); VRD(VI_, 2, vC0, vC1); VMF(0, vA0, vA1, PF); VRD(VI_, 3, vA0, vA1); VMF(1, vB0, vB1, PF); VRD(VI_, 4, vB0, vB1); VMF(2, vC0, vC1, PF); VRD(VI_, 5, vC0, vC1); VMF(3, vA0, vA1, PF); } while (0)
#define PVQ1(VI_, PF) do { VRD(VI_, 6, vA0, vA1); VMF(4, vB0, vB1, PF); VRD(VI_, 7, vB0, vB1); VMF(5, vC0, vC1, PF); VRD(VI_, 8, vC0, vC1); VMF(6, vA0, vA1, PF); VRD(VI_, 9, vA0, vA1); VMF(7, vB0, vB1, PF); } while (0)
#define PVQ2(VI_, PF) do { VRD(VI_, 10, vB0, vB1); VMF(8, vC0, vC1, PF); VRD(VI_, 11, vC0, vC1); VMF(9, vA0, vA1, PF); VRD(VI_, 12, vA0, vA1); VMF(10, vB0, vB1, PF); VRD(VI_, 13, vB0, vB1); VMF(11, vC0, vC1, PF); } while (0)
#define PVQ3(VI_, PF) do { VRD(VI_, 14, vC0, vC1); VMF(12, vA0, vA1, PF); VRD(VI_, 15, vA0, vA1); VMF(13, vB0, vB1, PF); VMF(14, vC0, vC1, PF); VMF(15, vA0, vA1, PF); } while (0)
#define PVT(t, PF) do { LAS unsigned char* VI_ = F.lds + VB0 + ((t) & 3) * 16384; PVQ0(VI_, PF); PVQ1(VI_, PF); PVQ2(VI_, PF); PVQ3(VI_, PF); } while (0)
#define SM_MAX() do { float mx_ = fmaxf(c0[0], c1[0]); _Pragma("unroll") for (int q_ = 1; q_ < 16; ++q_) mx_ = fmaxf(mx_, fmaxf(c0[q_], c1[q_])); \
            mx_ = fmaxf(mx_, __shfl_xor(mx_, 32)); const float mn_ = (mx_ - mref > ATT_THR) ? mx_ : mref; al = __builtin_amdgcn_exp2f(mref - mn_); mref = mn_; ps = 0.f; } while (0)
#define SM_EXP(C, B, DST) do { if (!(mode & 2)) { _Pragma("unroll") for (int q_ = 0; q_ < 8; ++q_) { C[(B) + q_] = __builtin_amdgcn_exp2f(C[(B) + q_] - mref); ps += C[(B) + q_]; } } DST = PACK8(C, B); } while (0)
#define RESC(al) do { if (__any((al) < 1.f)) { _Pragma("unroll") for (int i = 0; i < 4; ++i) _Pragma("unroll") for (int q_ = 0; q_ < 16; ++q_) o[i][q_] *= (al); } } while (0)
#define SBAR() __builtin_amdgcn_sched_barrier(0)
#define ATT_STEP(j, PFC, PFP) do { \
            WAIT_BAR(8); DMAK((j) + 3); DMAV((j) + 2); \
            SBAR(); QKT(c0, c1, j); SBAR(); \
            { LAS unsigned char* VI_ = F.lds + VB0 + (((j) - 1) & 3) * 16384; \
              PVQ0(VI_, PFP); SM_MAX(); SBAR(); \
              PVQ1(VI_, PFP); SM_EXP(c0, 0, PFC[0][0]); SM_EXP(c0, 8, PFC[0][1]); SBAR(); \
              PVQ2(VI_, PFP); SM_EXP(c1, 0, PFC[1][0]); SBAR(); \
              PVQ3(VI_, PFP); SM_EXP(c1, 8, PFC[1][1]); l = l * al + ps; SBAR(); } \
            RESC(al); } while (0)
        s16x4 vA0, vA1, vB0, vB1, vC0, vC1;
        f32x16 o[4];
#pragma unroll
        for (int i = 0; i < 4; ++i)
#pragma unroll
            for (int q = 0; q < 16; ++q) o[i][q] = 0.f;
        float mref = -1e30f, l = 0.f, al = 1.f, ps = 0.f;
        f32x16 c0, c1; bf16x8 pfA[2][2], pfB[2][2];
        DMAK(0); DMAV(0); DMAK(1); DMAV(1); DMAK(2);
        WAIT_BAR(6); DMAK(3); DMAV(2);
        QKT(c0, c1, 0); SM_MAX(); SM_EXP(c0, 0, pfA[0][0]); SM_EXP(c0, 8, pfA[0][1]); SM_EXP(c1, 0, pfA[1][0]); SM_EXP(c1, 8, pfA[1][1]); l = l * al + ps;
        for (int j = 1; j + 1 < nt; j += 2) {
            ATT_STEP(j, pfB, pfA);
            ATT_STEP(j + 1, pfA, pfB);
        }
        ATT_STEP(nt - 1, pfB, pfA);
        WAIT_BAR(0);
        PVT(nt - 1, pfB);
        WAIT_BAR(0);
#undef DMAK
#undef DMAV
#undef WAIT_BAR
#undef QKT
#undef PVT
#undef PVQ0
#undef PVQ1
#undef PVQ2
#undef PVQ3
#undef VRD
#undef VMF
#undef KRD
#undef KMF
#undef SM_MAX
#undef SM_EXP
#undef RESC
#undef SBAR
#undef ATT_STEP
#undef KVROW
        l += __shfl_xor(l, 32);
        const float f = (m == 1 ? lmb : 1.0f) / l;
        LAS float* ex = EX + (size_t)m * 128 * 129 + (qs * 32 + r) * 129;
#pragma unroll
        for (int i = 0; i < 4; ++i)
#pragma unroll
            for (int q = 0; q < 16; ++q) ex[32 * i + crow(q, hi)] = o[i][q] * f;
        __syncthreads();
#pragma unroll 1
        for (int rr = 0; rr < 16; ++rr) { const int row = 16 * F.wave + rr;
            const float a0 = EX[row * 129 + F.lane] - EX[128 * 129 + row * 129 + F.lane], a1 = EX[row * 129 + 64 + F.lane] - EX[128 * 129 + row * 129 + 64 + F.lane];
            const float rstd = (1.0f - LAMBDA_INIT) / sqrtf(wave_sum(a0 * a0 + a1 * a1) * (1.f / 128.f) + EPS);
            bf16* yr = Y + (size_t)(qrow0 + row) * D + h * 128;
            if (!(mode & 1)) { yr[F.lane] = (bf16)(pk2(a0 * rstd * ng[F.lane], 0.f) & 0xffffu); yr[64 + F.lane] = (bf16)(pk2(a1 * rstd * ng[64 + F.lane], 0.f) & 0xffffu); } }
        __syncthreads();
    }
}

#define XB_TMO      128
#define XB_XCNT(j)  (256  + 64 * (j))
#define XB_XSUB(j)  (1280 + 64 * (j))
#define XB_XGEN(j)  (2304 + 64 * (j))
#define XB_TOP      3328
#define XB_TOPGEN   3392
#define XCD_BAR_WORDS 3456
#define XB_SPIN_CAP (1u << 18)

__device__ __forceinline__ unsigned xb_ld(unsigned* p)              { return __hip_atomic_load(p, __ATOMIC_RELAXED, __HIP_MEMORY_SCOPE_AGENT); }
__device__ __forceinline__ unsigned xb_add(unsigned* p, unsigned v) { return __hip_atomic_fetch_add(p, v, __ATOMIC_RELAXED, __HIP_MEMORY_SCOPE_AGENT); }
__device__ __forceinline__ unsigned xb_xcc_id() { return (unsigned)__builtin_amdgcn_s_getreg((3 << 11) | 20) & 0xFu; }
#define XB_SPIN(cond, bar) do { unsigned _sp = 0; while (cond) { __builtin_amdgcn_s_sleep(1); \
    if ((++_sp & 255u) == 0u) { if (xb_ld(&(bar)[XB_TMO])) break; if (_sp > XB_SPIN_CAP) { atomicAdd(&(bar)[XB_TMO], 1u); break; } } } } while (0)

struct XcdBarrier {
    unsigned* bar; unsigned x;
    volatile LAS unsigned* st;
};

__device__ __forceinline__ XcdBarrier xcd_barrier_post(unsigned* bar, volatile LAS unsigned* st) {
    XcdBarrier b; b.bar = bar; b.x = xb_xcc_id(); b.st = st;
    if (threadIdx.x == 0) (void)xb_add(&bar[XB_XCNT(b.x)], 1u);
    return b;
}
__device__ __forceinline__ void xcd_barrier_complete(unsigned* bar, unsigned x, unsigned& nloc, unsigned& nx) {
    const unsigned G = gridDim.x * gridDim.y * gridDim.z;
    unsigned sum, cnt, mine, sp = 0u;
    for (;;) {
        sum = 0u; cnt = 0u; mine = 0u;
#pragma unroll
        for (unsigned j = 0; j < 16; ++j) { const unsigned c = xb_ld(&bar[XB_XCNT(j)]); sum += c; cnt += (c > 0u) ? 1u : 0u; mine = (j == x) ? c : mine; }
        if (sum == G) break;
        __builtin_amdgcn_s_sleep(1);
        if ((++sp & 255u) == 0u) { if (xb_ld(&bar[XB_TMO])) break; if (sp > XB_SPIN_CAP) { atomicAdd(&bar[XB_TMO], 1u); break; } }
    }
    nloc = mine > 0u ? mine : 1u; nx = cnt > 0u ? cnt : 1u;
}

__device__ __forceinline__ void xcd_barrier(const XcdBarrier& b) {
    asm volatile("s_waitcnt vmcnt(0)" ::: "memory");
    __syncthreads();
    if (threadIdx.x == 0) {
        unsigned* bar = b.bar;
        __builtin_amdgcn_s_waitcnt(0);
        unsigned nloc = b.st[0], nx = b.st[1];
        if (nloc == 0u) { xcd_barrier_complete(bar, b.x, nloc, nx); b.st[0] = nloc; b.st[1] = nx; }
        const unsigned old = xb_add(&bar[XB_XSUB(b.x)], 1u);
        const unsigned gen = old / nloc;
        if (old + 1u == (gen + 1u) * nloc) {
            __builtin_amdgcn_fence(__ATOMIC_RELEASE, "agent");
            asm volatile("s_waitcnt vmcnt(0)" ::: "memory");
            const unsigned og = xb_add(&bar[XB_TOP], 1u);
            const unsigned tg = og / nx;
            if (og + 1u == (tg + 1u) * nx) xb_add(&bar[XB_TOPGEN], 1u);
            else XB_SPIN(xb_ld(&bar[XB_TOPGEN]) == tg, bar);
            __builtin_amdgcn_fence(__ATOMIC_ACQUIRE, "agent");
            xb_add(&bar[XB_XGEN(b.x)], 1u);
            asm volatile("s_waitcnt vmcnt(0)" ::: "memory");
        } else {
            XB_SPIN(xb_ld(&bar[XB_XGEN(b.x)]) == gen, bar);
            __builtin_amdgcn_fence(__ATOMIC_ACQUIRE, "agent");
            asm volatile("s_waitcnt vmcnt(0)" ::: "memory");
        }
    }
    __syncthreads();
}

#ifndef SCAN_MODE
#define SCAN_MODE 0
#endif
#ifndef PREP_SKIP
#define PREP_SKIP 0
#endif
#ifndef MK_SINGLE
#define MK_SINGLE 1
#endif
constexpr int NSTEPS = 28;
struct SEpiStore { bf16* O; int ldc; int act; bf16* halo; const float* SS; const float* bias; float qscale;
    __device__ __forceinline__ void operator()(const float (&v4)[4], int m, int n0, int hi, int g) const {
        const float rs = SS ? 1.0f / sqrtf(pg8::ss_dec(SS, m) * (1.0f / 1024.0f) + 1e-6f) : 1.0f;
        const int n = n0 + 8 * g + 4 * hi; const f32x4 bv = SS ? *(const f32x4*)(bias + n) : (f32x4){0.f, 0.f, 0.f, 0.f}; float v[4];
#pragma unroll
        for (int i = 0; i < 4; ++i) { v[i] = v4[i] * rs + bv[i]; if (act == 1) { const float t = fmaxf(v[i], 0.f); v[i] = t * t; } if (act == 2 && n < 1024) v[i] *= qscale; }
        const u32x2 w = (u32x2){pk2(v[0], v[1]), pk2(v[2], v[3])};
        *(u32x2*)(O + (size_t)m * ldc + n) = w;
        if (halo && n < 3072 && (((m & 63) == 0) || ((m & 63) == 63))) *(u32x2*)(halo + ((size_t)(m >> 6) * 2 + ((m & 63) ? 1 : 0)) * 3072 + n) = w; } };
struct SEpiResid { void* X; const void* Xin; const float* gate; bf16* Hn; const float* cv; float* SSo; int in_f32;
    __device__ __forceinline__ void operator()(const float (&v4)[4], int m, int n0, int hi, int g) const {
        const int n = n0 + 8 * g + 4 * hi; const size_t off = (size_t)m * D + n; const f32x4 gv = *(const f32x4*)(gate + n);
        f32x4 xi; if (in_f32) xi = *(const f32x4*)((const float*)Xin + off); else { const u32x2 w = *(const u32x2*)((const bf16*)Xin + off); xi = (f32x4){pg8::bf_lo(w.x), pg8::bf_hi(w.x), pg8::bf_lo(w.y), pg8::bf_hi(w.y)}; }
        const f32x4 v_ = xi + gv * (f32x4){v4[0], v4[1], v4[2], v4[3]};
        *(u32x2*)((bf16*)X + off) = (u32x2){pk2(v_[0], v_[1]), pk2(v_[2], v_[3])};
        if (Hn) { float ss = (v_[0] * v_[0] + v_[1] * v_[1]) + (v_[2] * v_[2] + v_[3] * v_[3]); const f32x4 h_ = v_ * *(const f32x4*)(cv + n);
            *(u32x2*)(Hn + off) = (u32x2){pk2(h_[0], h_[1]), pk2(h_[2], h_[3])};
            ss += __shfl_xor(ss, 32); if (hi == 0) atomicAdd((unsigned*)SSo + m, pg8::ss_enc(ss)); } } };
struct SEpiAB { float* AB; const float* SS; const float* bias; int bstride;
    __device__ __forceinline__ void operator()(const float (&v4)[4], int m, int n0, int hi, int g) const {
        if (n0 == 0) { const float rs = 1.0f / sqrtf(pg8::ss_dec(SS, m) * (1.0f / 1024.0f) + 1e-6f); const int n = 8 * g + 4 * hi;
            const f32x4 bv = *(const f32x4*)(bias + (size_t)(m < T ? 0 : (m < ML ? 1 : 2)) * bstride + 4096 + n);
            *(f32x4*)(AB + (size_t)m * 32 + n) = (f32x4){v4[0], v4[1], v4[2], v4[3]} * rs + bv; } } };
template <class Epi> __device__ __forceinline__ void small_gemm(const bf16* A, const bf16* Bt, int row_lo, int nrows, int N, int K, const Epi& E, int lda = 0) {
    if (lda == 0) lda = K;
    int tid = threadIdx.x; asm volatile("" : "+v"(tid));
    const int lane = tid & 63, wave = __builtin_amdgcn_readfirstlane(tid >> 6), r = lane & 31, hi = lane >> 5, lrow = lane >> 3, lch = lane & 7;
    int G_ = gridDim.x, B_ = blockIdx.x; asm volatile("" : "+s"(G_), "+s"(B_));
    LAS unsigned char* stg = (LAS unsigned char*)lds_raw + wave * 13824;
    LAS float* red = (LAS float*)lds_raw;
    const int tn = N / 64, items = (nrows / 32) * tn, kw = K / 8, nch = kw / 64;
    const size_t rstep = (size_t)8 * K * 2, rstepA = (size_t)8 * lda * 2;
    u32x4 ra[8], rb[16];
#define SG_PTRS(it_) const int mi_ = (it_) / tn, ni_ = (it_) % tn; \
        ag = (const char*)(A + (size_t)(row_lo + 32 * mi_ + lrow) * lda + wave * kw + lch * 8); bg = (const char*)(Bt + (size_t)(64 * ni_ + lrow) * K + wave * kw + lch * 8)
#define SG_LOAD_PAIR(c) do { _Pragma("unroll") for (int i = 0; i < 4; ++i) ra[i] = *(const u32x4*)(ag + i * rstepA + (c) * 128); _Pragma("unroll") for (int i = 0; i < 8; ++i) rb[i] = *(const u32x4*)(bg + i * rstep + (c) * 128); \
        if ((c) + 1 < nch) { _Pragma("unroll") for (int i = 0; i < 4; ++i) ra[4 + i] = *(const u32x4*)(ag + i * rstepA + ((c) + 1) * 128); _Pragma("unroll") for (int i = 0; i < 8; ++i) rb[8 + i] = *(const u32x4*)(bg + i * rstep + ((c) + 1) * 128); } } while (0)
#define SG_HALF(h_) do { _Pragma("unroll") for (int i = 0; i < 4; ++i) *(LAS u32x4*)(stg + (lrow + 8 * i) * 144 + lch * 16) = ra[4 * (h_) + i]; \
        _Pragma("unroll") for (int i = 0; i < 8; ++i) *(LAS u32x4*)(stg + (32 + lrow + 8 * i) * 144 + lch * 16) = rb[8 * (h_) + i]; } while (0)
#define SG_MMA() do { _Pragma("unroll") for (int ks = 0; ks < 4; ++ks) { const bf16x8 a = *(const LAS bf16x8*)(stg + r * 144 + ks * 32 + hi * 16); \
        const bf16x8 b0 = *(const LAS bf16x8*)(stg + (32 + r) * 144 + ks * 32 + hi * 16), b1 = *(const LAS bf16x8*)(stg + (64 + r) * 144 + ks * 32 + hi * 16); \
        acc[0] = __builtin_amdgcn_mfma_f32_32x32x16_bf16(b0, a, acc[0], 0, 0, 0); acc[1] = __builtin_amdgcn_mfma_f32_32x32x16_bf16(b1, a, acc[1], 0, 0, 0); } } while (0)
    const char* ag = nullptr; const char* bg = nullptr;
    if (B_ < items) { SG_PTRS(B_); SG_LOAD_PAIR(0); }
    for (int it = B_; it < items; it += G_) {
        const int mi = it / tn, ni = it % tn;
        f32x16 acc[2];
#pragma unroll
        for (int x = 0; x < 2; ++x)
#pragma unroll
            for (int i = 0; i < 16; ++i) acc[x][i] = 0.f;
        for (int c = 0; c < nch; c += 2) {
            SG_HALF(0); SG_MMA();
            asm volatile("" ::: "memory");
            const bool two = c + 1 < nch;
            u32x4 ta[4], tb[8];
#pragma unroll
            for (int i = 0; i < 4; ++i) ta[i] = ra[4 + i];
#pragma unroll
            for (int i = 0; i < 8; ++i) tb[i] = rb[8 + i];
            if (c + 2 < nch) SG_LOAD_PAIR(c + 2);
            else if (it + G_ < items) { SG_PTRS(it + G_); SG_LOAD_PAIR(0); }
            if (two) {
#pragma unroll
                for (int i = 0; i < 4; ++i) *(LAS u32x4*)(stg + (lrow + 8 * i) * 144 + lch * 16) = ta[i];
#pragma unroll
                for (int i = 0; i < 8; ++i) *(LAS u32x4*)(stg + (32 + lrow + 8 * i) * 144 + lch * 16) = tb[i];
                SG_MMA(); }
            asm volatile("" ::: "memory");
        }
        __syncthreads();
#pragma unroll
        for (int x = 0; x < 2; ++x)
#pragma unroll
            for (int i = 0; i < 16; ++i) red[((wave * 2 + x) * 16 + i) * 64 + lane] = acc[x][i];
        __syncthreads();
        { const int tile = wave >> 2, g = wave & 3; float v4[4];
#pragma unroll
            for (int i = 0; i < 4; ++i) { float s = 0.f;
#pragma unroll
                for (int w = 0; w < 8; ++w) s += red[((w * 2 + tile) * 16 + 4 * g + i) * 64 + lane];
                v4[i] = s; }
            E(v4, row_lo + 32 * mi + r, 64 * ni + 32 * tile, hi, g); }
        __syncthreads();
    }
#undef SG_PTRS
#undef SG_LOAD_PAIR
#undef SG_HALF
#undef SG_MMA
}
template <int ACT> __device__ __forceinline__ void gemm_store(const bf16* A, const bf16* Bt, bool ctx, int N, int K, bf16* O, int ldc, bf16* halo, const float* SS, const float* bias, int bstride) {
    { int G_ = gridDim.x, B_ = blockIdx.x; asm volatile("" : "+s"(G_), "+s"(B_));
      pg8::Gemm g{A, Bt, ML, N, K, K, K}; pg8::StaticOrder S; S.init(ML, N, G_, B_);
      pg8::EpiStore<ACT> E{SS, bias, bstride, O, ldc, nullptr, -1, halo, ACT == 2 ? (const float*)(kargs()->ws + WS_ROPE) : nullptr, QSCALE};
      pg8::gemm_phase<pg8::EpiStore<ACT>, pg8::StaticOrder, true, true>((LAS unsigned char*)lds_raw, g, S, E); }
    if (ctx) { SEpiStore E2{O, ldc, ACT, halo, SS, bias + 2 * (size_t)bstride, QSCALE}; small_gemm(A, Bt, ML, MC, N, K, E2); }
}
#ifdef TIME_SUB
__device__ unsigned long long g_diag = 0ull;
#endif
__device__ __forceinline__ void gemm_resid(const bf16* A, const bf16* Bt, bool ctx, int K, bf16* X, const float* gate, bool from_inputs, bf16* Hn, const float* cv, float* SSo, int lda = 0, float* Xf32 = nullptr) {
    if (lda == 0) lda = K;
    const void* XinL = from_inputs ? (const void*)INP(I_X) : (const void*)X; const void* XinC = from_inputs ? (const void*)(INP(I_CTX) - (size_t)ML * D) : (const void*)X;
    { int G_ = gridDim.x, B_ = blockIdx.x; asm volatile("" : "+s"(G_), "+s"(B_));
      pg8::Gemm g{A, Bt, ML, D, K, lda, K}; pg8::StaticOrder S; S.init(ML, D, G_, B_);
      pg8::EpiResid E{Hn, cv, D, SSo, Xf32 ? (void*)Xf32 : (void*)X, XinL, D, gate, NADA, 0, from_inputs ? 1 : 0, Xf32 ? 1 : 0};
      pg8::gemm_phase<pg8::EpiResid, pg8::StaticOrder, true, true>((LAS unsigned char*)lds_raw, g, S, E); }
#ifdef TIME_SUB
    const unsigned long long td0 = __builtin_amdgcn_s_memrealtime();
#endif
    if (ctx) { SEpiResid E2{X, XinC, gate + 2 * NADA, Hn, cv + 2 * D, SSo, from_inputs ? 1 : 0}; small_gemm(A, Bt, ML, MC, D, K, E2, lda); }
#ifdef TIME_SUB
    if (K == TIME_SUB && blockIdx.x == 0 && threadIdx.x == 0) g_diag += __builtin_amdgcn_s_memrealtime() - td0;
#endif
}
__device__ __forceinline__ void gemm_gdn_in(unsigned char* ws, int layer, int jj) {
    const float* SS = (const float*)(ws + WS_CTL + CTL_SS) + (size_t)(layer * 2) * M; const float* bin = (const float*)(ws + WS_BIAS) + (size_t)layer * 3 * 4352;
    const bf16* Wt = (const bf16*)(ws + WS_GINT) + (size_t)jj * GDN_NP * D;
    gemm_store<0>((const bf16*)(ws + WS_H), Wt, true, 4096, D, (bf16*)(ws + WS_Z), 4096, (bf16*)(ws + WS_HALO), SS, bin, 4352);
    SEpiAB E3{(float*)(ws + WS_AB), SS, bin, 4352}; small_gemm((const bf16*)(ws + WS_H), Wt + (size_t)4096 * D, 0, M, 64, D, E3);
}
__global__ void __launch_bounds__(NTHR, 2) fwd_kernel(Args a) {
    unsigned char* ws = a.ws;
    const int lo = a.step_lo, hi = a.step_hi; const bool coop = a.coop != 0;
    volatile LAS unsigned* bst = (volatile LAS unsigned*)((LAS unsigned char*)lds_raw + LDS_BYTES - 64);
    if (threadIdx.x < 2) bst[threadIdx.x] = 0u;
    __syncthreads();
    XcdBarrier bar; bar.bar = (unsigned*)(ws + WS_CTL) + 4096; bar.x = 0; bar.st = bst;
    if (coop) bar = xcd_barrier_post((unsigned*)(ws + WS_CTL) + 4096, bst);
#ifndef TIME_LO
#define TIME_LO -1
#define TIME_SCALE 1e-4f
#define TIME_HI -1
#endif
    unsigned long long t_acc = 0ull, t_0 = 0ull;
#ifdef TIME_MID
    unsigned long long t_mid = 0ull;
#define TIME_MID_STAMP(k, id) do { if ((k) == TIME_LO && (id) == TIME_MID) t_mid = __builtin_amdgcn_s_memrealtime() - t_0; } while (0)
#else
#define TIME_MID_STAMP(k, id) do { } while (0)
#endif
#ifndef TIME_BLK
#define TIME_BLK 0
#endif
#define PHASE(k, body) do { if (lo <= (k) && (k) < hi) { __syncthreads(); if ((k) == TIME_LO) t_0 = __builtin_amdgcn_s_memrealtime(); body; if ((k) + 1 < hi && coop) { xcd_barrier(bar); } \
        if ((k) == TIME_HI) t_acc = __builtin_amdgcn_s_memrealtime() - t_0; } } while (0)
#define WB(off) ((bf16*)(ws + (off)))
#define MODP(layer, which) ((const float*)(ws + WS_MOD) + (size_t)(layer) * 3 * NADA + (which) * D)
#define CVP(layer, which) ((const float*)(ws + WS_CV) + (size_t)((layer) * 2 + (which)) * 3 * D)
#define SSP(layer, which) ((float*)(ws + WS_CTL + CTL_SS) + (size_t)((layer) * 2 + (which)) * M)
#define BIN(layer) ((const float*)(ws + WS_BIAS) + (size_t)(layer) * 3 * 4352)
#define BUP(layer) ((const float*)(ws + WS_BIAS) + (size_t)DEPTH * 3 * 4352 + (size_t)(layer) * 3 * FF)
#define TAIL(k0, layer, YA, YLD, WoutT, CTX) \
    PHASE((k0), gemm_resid((YA), (WoutT), (CTX), D, WB(WS_X), MODP(layer, 2), (layer) == 0, WB(WS_H), CVP(layer, 1), SSP(layer, 1), (YLD))); \
    PHASE((k0) + 1, gemm_store<1>(WB(WS_H), WB(WS_W1T) + (size_t)(layer) * D * FF, (CTX), FF, D, WB(WS_Z), FF, nullptr, SSP(layer, 1), BUP(layer), FF)); \
    PHASE((k0) + 2, gemm_resid(WB(WS_Z), WB(WS_W2T) + (size_t)(layer) * D * FF, (CTX), FF, WB(WS_X), MODP(layer, 5), false, \
                               (layer) + 1 < DEPTH ? WB(WS_H) : nullptr, CVP((layer) + 1 < DEPTH ? (layer) + 1 : 0, 0), SSP((layer) + 1 < DEPTH ? (layer) + 1 : 0, 0)))
#define LAYER_GDN(k0, layer, jj, CTX, conv) \
    PHASE((k0), gemm_gdn_in(ws, layer, jj)); \
    if (lo <= (k0) + 1 && (k0) + 1 < hi && !(coop && gridDim.x == 256)) { __syncthreads(); step_gdn_prep(jj, false, nullptr); if ((k0) + 2 < hi && coop) xcd_barrier(bar); } \
    PHASE((k0) + 2, { unsigned* fl_ = (unsigned*)(ws + WS_CTL) + 16384 + (jj) * 4096; \
        if (coop && gridDim.x == 256) { step_gdn_scan2(fl_, SCAN_MODE); TIME_MID_STAMP((k0) + 2, 1); step_gdn_prep(jj, true, fl_, false, PREP_SKIP); TIME_MID_STAMP((k0) + 2, 2); } else step_gdn_scan2(nullptr); \
        if (conv) { step_convert_rest(); TIME_MID_STAMP((k0) + 2, 3); step_bias(65, DEPTH * 129, gridDim.x > 32 ? 32 : 0); TIME_MID_STAMP((k0) + 2, 4); } \
        if (coop && gridDim.x == 256) step_gdn_follow(jj, fl_); TIME_MID_STAMP((k0) + 2, 5); }); \
    if (!(coop && gridDim.x == 256)) PHASE((k0) + 3, step_gdn_norm2(jj)); \
    TAIL((k0) + 4, layer, WB(WS_Z), 4096, WB(WS_GOUTT) + (size_t)(jj) * D * D, CTX)
    PHASE(0, step_prologue());
    PHASE(1, { step_norm0(); step_bias(0, 65, 0); });
    LAYER_GDN(2, 0, 0, true, true);
    PHASE(9, gemm_store<0>(WB(WS_H), WB(WS_SINT), true, 3 * D, D, WB(WS_Z), 3 * D, nullptr, SSP(1, 0), BIN(1), 4352));
    PHASE(10, step_sconv());
    TAIL(11, 1, WB(WS_Y), D, WB(WS_SOUTT), true);
    PHASE(14, gemm_store<2>(WB(WS_H), WB(WS_DINT), true, 3 * D, D, WB(WS_Z), 3 * D, nullptr, SSP(2, 0), BIN(2), 4352));
#ifdef BAR_PROBE
    PHASE(15, {});
#endif
    PHASE(16, step_attn2());
    TAIL(17, 2, WB(WS_Y), D, WB(WS_DOUTT), true);
    LAYER_GDN(20, 3, 1, false, false);
    PHASE(27, step_final());
#ifdef TIME_SUB
    if (blockIdx.x == 0 && threadIdx.x == 0) { __threadfence(); a.out[0] += (float)g_diag * 1e-3f; g_diag = 0ull; }
#endif
#if defined(SCAN_PROF) || defined(PREP_PROF)
    if (blockIdx.x == 0 && threadIdx.x == 0) { __threadfence(); a.out[0] += (float)__hip_atomic_load(&g_scanprof, __ATOMIC_RELAXED, __HIP_MEMORY_SCOPE_AGENT) * 1e-4f; g_scanprof = 0ull; }
#endif
#ifdef PROBE_ZERO
    if (coop) { xcd_barrier(bar); for (size_t i = (size_t)blockIdx.x * NTHR + threadIdx.x; i < (size_t)ML * D / 4; i += (size_t)gridDim.x * NTHR) ((f32x4*)a.out)[i] = (f32x4){16.f, 16.f, 16.f, 16.f}; xcd_barrier(bar); }
    if (TIME_LO >= 0 && blockIdx.x == 0 && threadIdx.x == 0) { a.out[0] = (float)t_acc * TIME_SCALE; }
#else
#ifdef TIME_MID
    t_acc = t_mid;
#endif
    if (TIME_LO >= 0 && blockIdx.x == TIME_BLK && threadIdx.x == 0) { __threadfence(); a.out[0] += (float)t_acc * TIME_SCALE; }
#endif
}

extern "C" void kernel_launch(void* const* d_in, const int* in_sizes, int n_in, void* d_out, int out_size, void* d_ws, size_t ws_size, hipStream_t stream) {
    static int grid = 0;
    if (grid == 0) {
        if (n_in != 24 || out_size != ML * D || ws_size < WS_END) { fprintf(stderr, "kernel_launch: unexpected problem (n_in %d, out %d, ws %zu); nothing launched\n", n_in, out_size, ws_size); grid = -1; return; }
        int dev = 0, cus = 0, per_cu = 0;
        if (hipGetDevice(&dev) != hipSuccess || hipDeviceGetAttribute(&cus, hipDeviceAttributeMultiprocessorCount, dev) != hipSuccess) { grid = -1; return; }
        if (hipFuncSetAttribute((const void*)fwd_kernel, hipFuncAttributeMaxDynamicSharedMemorySize, LDS_BYTES) != hipSuccess) { fprintf(stderr, "kernel_launch: hipFuncSetAttribute failed\n"); grid = -1; return; }
        if (hipOccupancyMaxActiveBlocksPerMultiprocessor(&per_cu, (const void*)fwd_kernel, NTHR, LDS_BYTES) != hipSuccess || per_cu < 1) { fprintf(stderr, "kernel_launch: occupancy query says %d blocks per CU\n", per_cu); (void)hipGetLastError(); per_cu = 1; }
        grid = cus;
        fprintf(stderr, "kernel_launch: %d CUs, occupancy %d per CU, grid %d\n", cus, per_cu, grid);
    }
    if (grid < 0) return;
    (void)hipMemsetAsync((char*)d_ws + WS_CTL, 0, CTL_ZERO_BYTES, stream);
    Args a{};
    for (int i = 0; i < 24; ++i) a.in[i] = (const float*)d_in[i];
    a.out = (float*)d_out; a.ws = (unsigned char*)d_ws;
#if MK_SINGLE
    a.step_lo = 0; a.step_hi = NSTEPS; a.coop = 1;
    void* args[] = {&a};
    hipError_t e = hipLaunchCooperativeKernel((const void*)fwd_kernel, dim3(grid), dim3(NTHR), args, LDS_BYTES, stream);
    if (e != hipSuccess) fprintf(stderr, "cooperative launch failed: %s (grid %d)\n", hipGetErrorString(e), grid);
#else
    for (int s = 0; s < NSTEPS; ++s) { a.step_lo = s; a.step_hi = s + 1; a.coop = 0; hipLaunchKernelGGL(fwd_kernel, dim3(grid), dim3(NTHR), LDS_BYTES, stream, a); }
#endif
}
```
